# Optimizing an MI355X kernel written in HIP

```python
import math
import jax
import jax.numpy as jnp
from jax import lax
import numpy as np

D_MODEL = 1024
BATCH = 4
SEQ = 4096
DEPTH = 2

NORM_EPS = 1e-6
S5_WIDTH = D_MODEL // 2
S5_GROUP = 16
S5_GROUPS = S5_WIDTH // S5_GROUP
S5_STATE = 64
HEAD_DIM = 64
ATTN_HEADS = D_MODEL // 128
ATTN_KV_HEADS = 2
WINDOW = 128
ATTN_BLOCK = 128
ROPE_THETA = 10000.0
SSD_WIDTH = D_MODEL
SSD_HEAD_DIM = 64
SSD_HEADS = SSD_WIDTH // SSD_HEAD_DIM
SSD_GROUPS = 2
SSD_STATE = 64
SSD_CONV = 4
SSD_CHUNK = 128
N_BRANCH = 3
MOE_GROUPS = 4
MOE_PER_GROUP = 8
MOE_EXPERTS = MOE_GROUPS * MOE_PER_GROUP
MOE_TOPK = 2
MOE_FF = D_MODEL // 2

ATTN_Q = ATTN_HEADS * HEAD_DIM
ATTN_KV = ATTN_KV_HEADS * HEAD_DIM
SSD_BC = SSD_GROUPS * SSD_STATE
SSD_CONV_CH = SSD_WIDTH + 2 * SSD_BC
IN_WIDTHS = (S5_WIDTH, ATTN_Q, ATTN_KV, ATTN_KV, SSD_WIDTH, SSD_CONV_CH, SSD_HEADS, N_BRANCH * D_MODEL)
N_IN = S5_WIDTH + ATTN_Q + 2 * ATTN_KV + SSD_WIDTH + SSD_CONV_CH + SSD_HEADS + N_BRANCH * D_MODEL

kernel_name = 'hybrid_s5_swa_ssd_hmoe'


def _rmsnorm(x, g):
    xf = x.astype(jnp.float32)
    y = xf * lax.rsqrt(jnp.mean(xf * xf, axis=-1, keepdims=True) + NORM_EPS)
    return (y * g.astype(jnp.float32)).astype(x.dtype)


def _split_in(proj):
    idx = []
    off = 0
    for w in IN_WIDTHS[:-1]:
        off += w
        idx.append(off)
    return jnp.split(proj, idx, axis=-1)


def _rope(x, pos):
    hd = x.shape[-1]
    half = hd // 2
    inv = jnp.power(ROPE_THETA, -jnp.arange(half, dtype=jnp.float32) * 2.0 / hd)
    ang = pos.astype(jnp.float32)[:, None] * inv[None, :]
    cos = jnp.cos(ang)[None, :, None, :]
    sin = jnp.sin(ang)[None, :, None, :]
    xf = x.astype(jnp.float32)
    x1, x2 = xf[..., :half], xf[..., half:]
    return jnp.concatenate([x1 * cos - x2 * sin, x2 * cos + x1 * sin], axis=-1).astype(x.dtype)


def _s5_mixer(u, lam_re, lam_im, b_re, b_im, c_re, c_im, d_skip, log_dt, w_glu1, w_glu2):
    bsz, seq, _ = u.shape
    f32 = jnp.float32
    lr = lam_re.astype(f32)
    li = lam_im.astype(f32)
    dt = jnp.exp(log_dt.astype(f32))[:, None]
    mag = jnp.exp(lr * dt)
    ab_re = mag * jnp.cos(li * dt)
    ab_im = mag * jnp.sin(li * dt)
    nr = ab_re - 1.0
    den = lr * lr + li * li
    f_re = (nr * lr + ab_im * li) / den
    f_im = (ab_im * lr - nr * li) / den
    br = b_re.astype(f32)
    bi = b_im.astype(f32)
    bb_re = f_re[..., None] * br - f_im[..., None] * bi
    bb_im = f_re[..., None] * bi + f_im[..., None] * br
    ug = u.astype(f32).reshape(bsz, seq, S5_GROUPS, S5_GROUP)
    bu_re = jnp.einsum('gpc,blgc->blgp', bb_re, ug)
    bu_im = jnp.einsum('gpc,blgc->blgp', bb_im, ug)
    a_re = jnp.broadcast_to(ab_re[None, None], (1, seq, S5_GROUPS, S5_STATE))
    a_im = jnp.broadcast_to(ab_im[None, None], (1, seq, S5_GROUPS, S5_STATE))

    def combine(e1, e2):
        a1r, a1i, b1r, b1i = e1
        a2r, a2i, b2r, b2i = e2
        return (a2r * a1r - a2i * a1i,
                a2r * a1i + a2i * a1r,
                a2r * b1r - a2i * b1i + b2r,
                a2r * b1i + a2i * b1r + b2i)

    _, _, h_re, h_im = lax.associative_scan(combine, (a_re, a_im, bu_re, bu_im), axis=1)
    y = (jnp.einsum('gcp,blgp->blgc', c_re.astype(f32), h_re)
         - jnp.einsum('gcp,blgp->blgc', c_im.astype(f32), h_im))
    y = y.reshape(bsz, seq, S5_WIDTH) + d_skip.astype(f32) * u.astype(f32)
    y = jax.nn.gelu(y)
    y = (y @ w_glu1.astype(f32)) * jax.nn.sigmoid(y @ w_glu2.astype(f32))
    return y.astype(u.dtype)


def _swa_attention(q, k, v, q_g, k_g, sinks, pos):
    bsz, seq, _ = q.shape
    f32 = jnp.float32
    rep = ATTN_HEADS // ATTN_KV_HEADS
    nb = seq // ATTN_BLOCK
    q = _rope(_rmsnorm(q.reshape(bsz, seq, ATTN_HEADS, HEAD_DIM), q_g), pos)
    k = _rope(_rmsnorm(k.reshape(bsz, seq, ATTN_KV_HEADS, HEAD_DIM), k_g), pos)
    v = v.reshape(bsz, seq, ATTN_KV_HEADS, HEAD_DIM)
    qb = q.reshape(bsz, nb, ATTN_BLOCK, ATTN_KV_HEADS, rep, HEAD_DIM).astype(f32)

    def band(t):
        tp = jnp.pad(t, ((0, 0), (ATTN_BLOCK, 0), (0, 0), (0, 0)))
        prev = tp[:, :seq].reshape(bsz, nb, ATTN_BLOCK, ATTN_KV_HEADS, HEAD_DIM)
        cur = t.reshape(bsz, nb, ATTN_BLOCK, ATTN_KV_HEADS, HEAD_DIM)
        return jnp.concatenate([prev, cur], axis=2).astype(f32)

    kb = band(k)
    vb = band(v)
    scores = jnp.einsum('bnqkrd,bnskd->bnkrqs', qb, kb) * (HEAD_DIM ** -0.5)
    qi = jnp.arange(ATTN_BLOCK)[:, None] + ATTN_BLOCK
    kj = jnp.arange(2 * ATTN_BLOCK)[None, :]
    band_ok = (kj <= qi) & (qi - kj < WINDOW)
    abs_k = (jnp.arange(nb) * ATTN_BLOCK)[:, None] - ATTN_BLOCK + kj
    mask = band_ok[None] & (abs_k >= 0)[:, None, :]
    scores = jnp.where(mask[None, :, None, None], scores, -jnp.inf)
    sink = sinks.astype(f32).reshape(ATTN_KV_HEADS, rep)[None, None, :, :, None, None]
    m = jnp.maximum(jnp.max(scores, axis=-1, keepdims=True), sink)
    p = jnp.exp(scores - m)
    denom = jnp.sum(p, axis=-1, keepdims=True) + jnp.exp(sink - m)
    out = jnp.einsum('bnkrqs,bnskd->bnqkrd', p / denom, vb)
    return out.reshape(bsz, seq, ATTN_Q).astype(q.dtype)


def _ssd_chunked(x, a, b, c):
    bsz, seq, nh, hp = x.shape
    ns = b.shape[-1]
    nc = seq // SSD_CHUNK
    x = x.reshape(bsz, nc, SSD_CHUNK, nh, hp)
    b = b.reshape(bsz, nc, SSD_CHUNK, nh, ns)
    c = c.reshape(bsz, nc, SSD_CHUNK, nh, ns)
    a = a.reshape(bsz, nc, SSD_CHUNK, nh).transpose(0, 3, 1, 2)
    a_cs = jnp.cumsum(a, axis=-1)
    causal = jnp.tril(jnp.ones((SSD_CHUNK, SSD_CHUNK), dtype=bool))
    seg = a_cs[..., :, None] - a_cs[..., None, :]
    lmat = jnp.exp(jnp.where(causal, seg, -jnp.inf))
    cb = jnp.einsum('bclhn,bcshn->bhcls', c, b) * lmat
    y_diag = jnp.einsum('bhcls,bcshp->bclhp', cb, x)
    decay_states = jnp.exp(a_cs[..., -1:] - a_cs)
    states = jnp.einsum('bclhn,bhcl,bclhp->bchpn', b, decay_states, x)
    chunk_decay = jnp.exp(a_cs[..., -1])

    def step(s, inp):
        st, dec = inp
        return s * dec[..., None, None] + st, s

    init = jnp.zeros((bsz, nh, hp, ns), dtype=x.dtype)
    _, prev_states = lax.scan(step, init, (jnp.moveaxis(states, 1, 0), jnp.moveaxis(chunk_decay, 2, 0)))
    prev_states = jnp.moveaxis(prev_states, 0, 1)
    y_off = jnp.einsum('bclhn,bchpn,bhcl->bclhp', c, prev_states, jnp.exp(a_cs))
    return (y_diag + y_off).reshape(bsz, seq, nh, hp)


def _ssd_mixer(z, xbc, dt_raw, conv_w, conv_b, dt_bias, a_log, d_skip, norm_g):
    bsz, seq, _ = xbc.shape
    f32 = jnp.float32
    conv = lax.conv_general_dilated(
        xbc, conv_w.astype(xbc.dtype)[:, None, :], window_strides=(1,),
        padding=[(SSD_CONV - 1, 0)], dimension_numbers=('NWC', 'WIO', 'NWC'),
        feature_group_count=SSD_CONV_CH)
    xbc = jax.nn.silu(conv.astype(f32) + conv_b.astype(f32))
    xs = xbc[..., :SSD_WIDTH].reshape(bsz, seq, SSD_HEADS, SSD_HEAD_DIM)
    bm = xbc[..., SSD_WIDTH:SSD_WIDTH + SSD_BC].reshape(bsz, seq, SSD_GROUPS, SSD_STATE)
    cm = xbc[..., SSD_WIDTH + SSD_BC:].reshape(bsz, seq, SSD_GROUPS, SSD_STATE)
    hpg = SSD_HEADS // SSD_GROUPS
    bm = jnp.repeat(bm, hpg, axis=2)
    cm = jnp.repeat(cm, hpg, axis=2)
    dt = jax.nn.softplus(dt_raw.astype(f32) + dt_bias.astype(f32))
    a_h = -jnp.exp(a_log.astype(f32))
    y = _ssd_chunked(xs * dt[..., None], dt * a_h, bm, cm)
    y = y + xs * d_skip.astype(f32)[:, None]
    y = y.reshape(bsz, seq, SSD_WIDTH) * jax.nn.silu(z.astype(f32))
    yg = y.reshape(bsz, seq, SSD_GROUPS, SSD_WIDTH // SSD_GROUPS)
    yg = yg * lax.rsqrt(jnp.mean(yg * yg, axis=-1, keepdims=True) + NORM_EPS)
    y = yg.reshape(bsz, seq, SSD_WIDTH) * norm_g.astype(f32)
    return y.astype(z.dtype)


def _hier_moe(h, w_rg, b_rg, w_re, b_re, w_gate, w_up, w_down):
    bsz, seq, dm = h.shape
    t = h.reshape(bsz * seq, dm)
    n_tok = t.shape[0]
    g_logits = (t @ w_rg).astype(jnp.float32) + b_rg.astype(jnp.float32)
    g_prob = jax.nn.softmax(g_logits, axis=-1)
    g_sel = jnp.argmax(g_logits, axis=-1)
    p_group = jnp.take_along_axis(g_prob, g_sel[:, None], axis=-1)
    e_logits = ((t @ w_re).astype(jnp.float32) + b_re.astype(jnp.float32)).reshape(n_tok, MOE_GROUPS, MOE_PER_GROUP)
    in_group = jnp.take_along_axis(e_logits, g_sel[:, None, None], axis=1)[:, 0]
    top_v, top_i = lax.top_k(in_group, MOE_TOPK)
    top_w = jax.nn.softmax(top_v, axis=-1) * p_group
    expert_id = g_sel[:, None] * MOE_PER_GROUP + top_i
    combine = jnp.einsum('tk,tke->te', top_w, jax.nn.one_hot(expert_id, MOE_EXPERTS, dtype=jnp.float32)).astype(t.dtype)
    out = jnp.zeros_like(t)
    for e in range(MOE_EXPERTS):
        hid = jax.nn.silu(t @ w_gate[e]) * (t @ w_up[e])
        out = out + combine[:, e:e + 1] * (hid @ w_down[e])
    return out.reshape(bsz, seq, dm)


def setup_inputs(seed: int = 0) -> dict:
    key = jax.random.key(seed)
    ks = iter(jax.random.split(key, 48))
    nrm = lambda shape, s: jax.random.normal(next(ks), shape, jnp.float32) * s
    gain = lambda shape: 1.0 + 0.02 * jax.random.normal(next(ks), shape, jnp.float32)
    L = DEPTH
    x = jax.random.normal(next(ks), (BATCH, SEQ, D_MODEL), jnp.float32)
    norm1_g = gain((L, D_MODEL))
    w_in = nrm((L, D_MODEL, N_IN), D_MODEL ** -0.5)
    b_gate = nrm((L, N_BRANCH, D_MODEL), 0.1)
    s5_lambda_re = -0.5 + nrm((L, S5_GROUPS, S5_STATE), 0.01)
    s5_lambda_im = jnp.pi * jnp.arange(S5_STATE, dtype=jnp.float32) + nrm((L, S5_GROUPS, S5_STATE), 0.01)
    s5_b_re = nrm((L, S5_GROUPS, S5_STATE, S5_GROUP), (2.0 * S5_GROUP) ** -0.5)
    s5_b_im = nrm((L, S5_GROUPS, S5_STATE, S5_GROUP), (2.0 * S5_GROUP) ** -0.5)
    s5_c_re = nrm((L, S5_GROUPS, S5_GROUP, S5_STATE), S5_STATE ** -0.5)
    s5_c_im = nrm((L, S5_GROUPS, S5_GROUP, S5_STATE), S5_STATE ** -0.5)
    s5_d = nrm((L, S5_WIDTH), 1.0)
    s5_log_dt = jax.random.uniform(next(ks), (L, S5_GROUPS), jnp.float32, math.log(1e-3), math.log(1e-1))
    s5_glu_w1 = nrm((L, S5_WIDTH, S5_WIDTH), S5_WIDTH ** -0.5)
    s5_glu_w2 = nrm((L, S5_WIDTH, S5_WIDTH), S5_WIDTH ** -0.5)
    q_norm_g = gain((L, HEAD_DIM))
    k_norm_g = gain((L, HEAD_DIM))
    attn_sinks = nrm((L, ATTN_HEADS), 0.5)
    ssd_conv_w = nrm((L, SSD_CONV, SSD_CONV_CH), SSD_CONV ** -0.5)
    ssd_conv_b = nrm((L, SSD_CONV_CH), 0.02)
    dt0 = jnp.exp(jax.random.uniform(next(ks), (L, SSD_HEADS), jnp.float32, math.log(1e-3), math.log(1e-1)))
    ssd_dt_bias = dt0 + jnp.log(-jnp.expm1(-dt0))
    ssd_a_log = jnp.log(jax.random.uniform(next(ks), (L, SSD_HEADS), jnp.float32, 1.0, 16.0))
    ssd_d = gain((L, SSD_HEADS))
    ssd_norm_g = gain((L, SSD_WIDTH))
    p_s5 = nrm((L, S5_WIDTH, D_MODEL), S5_WIDTH ** -0.5)
    p_attn = nrm((L, ATTN_Q, D_MODEL), ATTN_Q ** -0.5)
    p_ssd = nrm((L, SSD_WIDTH, D_MODEL), SSD_WIDTH ** -0.5)
    w_out = nrm((L, D_MODEL, D_MODEL), D_MODEL ** -0.5)
    norm2_g = gain((L, D_MODEL))
    w_router_group = nrm((L, D_MODEL, MOE_GROUPS), D_MODEL ** -0.5)
    b_router_group = nrm((L, MOE_GROUPS), 0.01)
    w_router_expert = nrm((L, D_MODEL, MOE_EXPERTS), D_MODEL ** -0.5)
    b_router_expert = nrm((L, MOE_EXPERTS), 0.01)
    w_exp_gate = nrm((L, MOE_EXPERTS, D_MODEL, MOE_FF), D_MODEL ** -0.5)
    w_exp_up = nrm((L, MOE_EXPERTS, D_MODEL, MOE_FF), D_MODEL ** -0.5)
    w_exp_down = nrm((L, MOE_EXPERTS, MOE_FF, D_MODEL), MOE_FF ** -0.5)
    return {'x': x, 'norm1_g': norm1_g, 'w_in': w_in, 'b_gate': b_gate,
            's5_lambda_re': s5_lambda_re, 's5_lambda_im': s5_lambda_im,
            's5_b_re': s5_b_re, 's5_b_im': s5_b_im, 's5_c_re': s5_c_re, 's5_c_im': s5_c_im,
            's5_d': s5_d, 's5_log_dt': s5_log_dt, 's5_glu_w1': s5_glu_w1, 's5_glu_w2': s5_glu_w2,
            'q_norm_g': q_norm_g, 'k_norm_g': k_norm_g, 'attn_sinks': attn_sinks,
            'ssd_conv_w': ssd_conv_w, 'ssd_conv_b': ssd_conv_b, 'ssd_dt_bias': ssd_dt_bias,
            'ssd_a_log': ssd_a_log, 'ssd_d': ssd_d, 'ssd_norm_g': ssd_norm_g,
            'p_s5': p_s5, 'p_attn': p_attn, 'p_ssd': p_ssd, 'w_out': w_out, 'norm2_g': norm2_g,
            'w_router_group': w_router_group, 'b_router_group': b_router_group,
            'w_router_expert': w_router_expert, 'b_router_expert': b_router_expert,
            'w_exp_gate': w_exp_gate, 'w_exp_up': w_exp_up, 'w_exp_down': w_exp_down}


def reference(x, norm1_g, w_in, b_gate, s5_lambda_re, s5_lambda_im, s5_b_re, s5_b_im,
              s5_c_re, s5_c_im, s5_d, s5_log_dt, s5_glu_w1, s5_glu_w2, q_norm_g, k_norm_g,
              attn_sinks, ssd_conv_w, ssd_conv_b, ssd_dt_bias, ssd_a_log, ssd_d, ssd_norm_g,
              p_s5, p_attn, p_ssd, w_out, norm2_g, w_router_group, b_router_group,
              w_router_expert, b_router_expert, w_exp_gate, w_exp_up, w_exp_down):
    bsz, seq, _ = x.shape
    pos = jnp.arange(seq, dtype=jnp.int32)
    for l in range(DEPTH):
        h = _rmsnorm(x, norm1_g[l])
        proj = h @ w_in[l]
        u_s5, q, k, v, z, xbc, dt_raw, gate_logits = _split_in(proj)
        y_a = _s5_mixer(u_s5, s5_lambda_re[l], s5_lambda_im[l], s5_b_re[l], s5_b_im[l],
                        s5_c_re[l], s5_c_im[l], s5_d[l], s5_log_dt[l], s5_glu_w1[l], s5_glu_w2[l])
        y_b = _swa_attention(q, k, v, q_norm_g[l], k_norm_g[l], attn_sinks[l], pos)
        y_c = _ssd_mixer(z, xbc, dt_raw, ssd_conv_w[l], ssd_conv_b[l], ssd_dt_bias[l],
                         ssd_a_log[l], ssd_d[l], ssd_norm_g[l])
        gates = jax.nn.sigmoid(gate_logits.reshape(bsz, seq, N_BRANCH, D_MODEL).astype(jnp.float32)
                               + b_gate[l].astype(jnp.float32)).astype(x.dtype)
        merged = (gates[:, :, 0] * (y_a @ p_s5[l])
                  + gates[:, :, 1] * (y_b @ p_attn[l])
                  + gates[:, :, 2] * (y_c @ p_ssd[l]))
        x = x + merged @ w_out[l]
        x = x + _hier_moe(_rmsnorm(x, norm2_g[l]), w_router_group[l], b_router_group[l],
                          w_router_expert[l], b_router_expert[l], w_exp_gate[l], w_exp_up[l], w_exp_down[l])
    return x
```

```cpp
#include <hip/hip_runtime.h>
#include <cstdio>
#include <cstdint>

#define LAS __attribute__((address_space(3)))
#define GAS __attribute__((address_space(1)))
typedef unsigned short bf16_t;
typedef short bf16x8 __attribute__((ext_vector_type(8)));
typedef float f32x4 __attribute__((ext_vector_type(4)));
typedef float f32x2 __attribute__((ext_vector_type(2)));
typedef unsigned u32x4 __attribute__((ext_vector_type(4)));
typedef unsigned u32x2 __attribute__((ext_vector_type(2)));

constexpr int BATCH = 4, SEQ = 4096, DM = 1024, T = BATCH * SEQ, DEPTH = 2;
constexpr int NIN = 6672, NINP = 6912;
constexpr int C_U = 0, C_Q = 512, C_K = 1024, C_V = 1152, C_Z = 1280, C_XS = 2304, C_B = 3328, C_C = 3456, C_DT = 3584, C_G = 3840;
constexpr int S5_TC = 32, S5_ROWS = T / S5_TC  , S5_K = 128 + S5_TC * 16  , S5_N = S5_TC * 16  ;
constexpr int SSD_NCH = SEQ / 128;
constexpr int MOE_MAXROWS = 2 * T + 32 * 256;
constexpr float NORM_EPS = 1e-6f;

constexpr size_t MiB = 1u << 20;
constexpr size_t WS_CTL = 0, CTL_ZERO_BYTES = 1 * MiB;
constexpr size_t WS_WIN = 1 * MiB;
constexpr size_t WS_WGLU = WS_WIN + (size_t)NINP * DM * 2;
constexpr size_t WS_PCAT = WS_WGLU + 1 * MiB;
constexpr size_t WS_WOUT = WS_PCAT + 4 * MiB;
constexpr size_t WS_EGU = WS_WOUT + 2 * MiB;
constexpr size_t WS_EDN = WS_EGU + 64 * MiB;
constexpr size_t WS_MG = WS_EDN + 32 * MiB;
constexpr size_t WS_EG = WS_MG + 20 * MiB;
constexpr size_t WS_XN = WS_EG + 8 * MiB;
constexpr size_t WS_P = WS_XN + 32 * MiB;
constexpr size_t WS_XG = WS_P;
constexpr size_t WS_HID = WS_XG + (size_t)MOE_MAXROWS * 1024 * 2;
constexpr size_t WS_YEXP = WS_HID + (size_t)MOE_MAXROWS * 512 * 2;
constexpr size_t WS_DT = WS_P + 216 * MiB;
constexpr size_t WS_UH = WS_DT + 1 * MiB;
constexpr size_t WS_HLOC = WS_UH + 20 * MiB;
constexpr size_t WS_YCAT = WS_HLOC + 8 * MiB;
constexpr size_t WS_SST = WS_YCAT + 64 * MiB;
constexpr size_t WS_MOE = WS_SST + 32 * MiB;
constexpr size_t WS_ASUM = WS_MOE + 1 * MiB;
constexpr size_t WS_END = WS_ASUM + 64 * 1024;
static_assert(WS_YEXP + (size_t)MOE_MAXROWS * 1024 * 2 <= WS_DT, "MoE overlay fits in P");
constexpr int CW_BAR = 4096;
constexpr int CW_CNT = 16384;

constexpr int NWAVES = 8, NTHR = 512;
constexpr int LDS_BYTES = 163840;
constexpr int RING_BYTES = 131072;
constexpr int MISC_OFF = 160 * 1024 - 256;

__device__ __forceinline__ unsigned f2bf(float f) { unsigned u = __builtin_bit_cast(unsigned, f); return (u + 0x7fffu + ((u >> 16) & 1u)) >> 16; }
__device__ __forceinline__ unsigned pk2(float lo, float hi) { return f2bf(lo) | (f2bf(hi) << 16); }
__device__ __forceinline__ float bf2f(unsigned b) { return __builtin_bit_cast(float, b << 16); }
__device__ __forceinline__ float bflo(unsigned w) { return __builtin_bit_cast(float, w << 16); }
__device__ __forceinline__ float bfhi(unsigned w) { return __builtin_bit_cast(float, w & 0xffff0000u); }
__device__ __forceinline__ float wave_sum(float v) {
#pragma unroll
    for (int o = 1; o < 64; o <<= 1) v += __shfl_xor(v, o);
    return v;
}
__device__ __forceinline__ float sigmoidf_(float x) { return 1.0f / (1.0f + __expf(-x)); }
__device__ __forceinline__ float siluf_(float x) { return x / (1.0f + __expf(-x)); }
__device__ __forceinline__ float gelu_tanh_(float x) { const float u = 0.7978845608f * (x + 0.044715f * x * x * x); return x / (1.0f + __expf(-2.0f * u)); }
__device__ __forceinline__ float softplusf_(float x) { return x > 20.f ? x : log1pf(__expf(x)); }

#define XB_TMO      128
#define XB_XCNT(j)  (256  + 64 * (j))
#define XB_XSUB(j)  (1280 + 64 * (j))
#define XB_XGEN(j)  (2304 + 64 * (j))
#define XB_TOP      3328
#define XB_TOPGEN   3392
#define XCD_BAR_WORDS 3456
#define XB_SPIN_CAP (1u << 18)
__device__ __forceinline__ unsigned xb_ld(unsigned* p)              { return __hip_atomic_load(p, __ATOMIC_RELAXED, __HIP_MEMORY_SCOPE_AGENT); }
__device__ __forceinline__ unsigned xb_add(unsigned* p, unsigned v) { return __hip_atomic_fetch_add(p, v, __ATOMIC_RELAXED, __HIP_MEMORY_SCOPE_AGENT); }
__device__ __forceinline__ unsigned xb_xcc_id() { return (unsigned)__builtin_amdgcn_s_getreg((3 << 11) | 20) & 0xFu; }
#define XB_SPIN(cond, bar) do { unsigned _sp = 0; while (cond) { __builtin_amdgcn_s_sleep(1); \
    if ((++_sp & 255u) == 0u) { if (xb_ld(&(bar)[XB_TMO])) break; if (_sp > XB_SPIN_CAP) { atomicAdd(&(bar)[XB_TMO], 1u); break; } } } } while (0)
struct XcdBarrier { unsigned* bar; unsigned x; volatile LAS unsigned* st; };
__device__ __forceinline__ XcdBarrier xcd_barrier_post(unsigned* bar, volatile LAS unsigned* st) {
    XcdBarrier b; b.bar = bar; b.x = xb_xcc_id(); b.st = st;
    if (threadIdx.x == 0) (void)xb_add(&bar[XB_XCNT(b.x)], 1u);
    return b;
}
__device__ __forceinline__ void xcd_barrier_complete(unsigned* bar, unsigned x, unsigned& nloc, unsigned& nx) {
    const unsigned G = gridDim.x * gridDim.y * gridDim.z;
    unsigned sum, cnt, mine, sp = 0u;
    for (;;) {
        sum = 0u; cnt = 0u; mine = 0u;
#pragma unroll
        for (unsigned j = 0; j < 16; ++j) { const unsigned c = xb_ld(&bar[XB_XCNT(j)]); sum += c; cnt += (c > 0u) ? 1u : 0u; mine = (j == x) ? c : mine; }
        if (sum == G) break;
        __builtin_amdgcn_s_sleep(1);
        if ((++sp & 255u) == 0u) { if (xb_ld(&bar[XB_TMO])) break; if (sp > XB_SPIN_CAP) { atomicAdd(&bar[XB_TMO], 1u); break; } }
    }
    nloc = mine > 0u ? mine : 1u; nx = cnt > 0u ? cnt : 1u;
}
__device__ __forceinline__ void xcd_barrier(const XcdBarrier& b) {
    asm volatile("s_waitcnt vmcnt(0)" ::: "memory");
    __syncthreads();
    if (threadIdx.x == 0) {
        unsigned* bar = b.bar;
        __builtin_amdgcn_s_waitcnt(0);
        unsigned nloc = b.st[0], nx = b.st[1];
        if (nloc == 0u) { xcd_barrier_complete(bar, b.x, nloc, nx); b.st[0] = nloc; b.st[1] = nx; }
        const unsigned old = xb_add(&bar[XB_XSUB(b.x)], 1u);
        const unsigned gen = old / nloc;
        if (old + 1u == (gen + 1u) * nloc) {
            __builtin_amdgcn_fence(__ATOMIC_RELEASE, "agent");
            asm volatile("s_waitcnt vmcnt(0)" ::: "memory");
            const unsigned og = xb_add(&bar[XB_TOP], 1u);
            const unsigned tg = og / nx;
            if (og + 1u == (tg + 1u) * nx) xb_add(&bar[XB_TOPGEN], 1u);
            else XB_SPIN(xb_ld(&bar[XB_TOPGEN]) == tg, bar);
            __builtin_amdgcn_fence(__ATOMIC_ACQUIRE, "agent");
            xb_add(&bar[XB_XGEN(b.x)], 1u);
            asm volatile("s_waitcnt vmcnt(0)" ::: "memory");
        } else {
            XB_SPIN(xb_ld(&bar[XB_XGEN(b.x)]) == gen, bar);
            __builtin_amdgcn_fence(__ATOMIC_ACQUIRE, "agent");
            asm volatile("s_waitcnt vmcnt(0)" ::: "memory");
        }
    }
    __syncthreads();
}

namespace pg8 {
constexpr int BM = 256, BK = 64, HALF = 128, HTB = HALF * BK * 2, STAGE_BYTES = 8 * HTB, NXCD = 8, WGM = 8;
__host__ __device__ __forceinline__ int lds_byte(int r, int c) { const int st = (r >> 4) * 2 + (c >> 5), rr = r & 15, cc = c & 31, ob = rr * 64 + cc * 2; return st * 1024 + (ob ^ (((ob >> 9) & 1) << 5)); }
__host__ __device__ __forceinline__ void stage_rc(int b, int& R, int& C) { const int st = b / 1024, sb = b % 1024, swz = sb ^ (((sb >> 9) & 1) << 5); R = (st >> 1) * 16 + swz / 64; C = (st & 1) * 32 + (swz % 64) / 2; }
__host__ __device__ __forceinline__ int perm32(int rho) { const int n = rho >> 4, i = rho & 15; return 8 * (i >> 2) + 4 * n + (i & 3); }

struct Unit { const char* A; const char* B; int nt; int pm, pn, aux; };

__device__ __forceinline__ void tile_order(int L, int nM, int nN, int& pm, int& pn) {
    const int nwg = nM * nN; int wgid = L;
    { const int q = nwg / NXCD, r = nwg % NXCD, xcd = wgid % NXCD, off = wgid / NXCD; wgid = (xcd < r ? xcd * (q + 1) : r * (q + 1) + (xcd - r) * q) + off; }
    const int nig = WGM * nN, gid = wgid / nig, fm = gid * WGM, gsz = (nM - fm) < WGM ? (nM - fm) : WGM;
    pm = fm + ((wgid % nig) % gsz); pn = (wgid % nig) / gsz;
}
__device__ __forceinline__ unsigned cvt_pk_bf16(float lo, float hi) { unsigned r; asm volatile("v_cvt_pk_bf16_f32 %0, %1, %2" : "=v"(r) : "v"(lo), "v"(hi)); return r; }
__device__ __forceinline__ u32x4 pack8(const f32x4 v0, const f32x4 v1) { u32x4 w; w.x = cvt_pk_bf16(v0[0], v0[1]); w.y = cvt_pk_bf16(v0[2], v0[3]); w.z = cvt_pk_bf16(v1[0], v1[1]); w.w = cvt_pk_bf16(v1[2], v1[3]); return w; }

template <unsigned lda, unsigned ldb, class Epi, class Sched>
__device__ __forceinline__ void gemm_phase(const int tid, LAS unsigned char* lds, const Sched& S, const Epi& E) {
    const int wid = __builtin_amdgcn_readfirstlane(tid >> 6), lane = tid & 63, wr = wid >> 2, wc = wid & 3, fr = lane & 15, fq = lane >> 4;
    unsigned voffA[2], voffB[2];
#pragma unroll
    for (int i = 0; i < 2; ++i) { int R, C; stage_rc(tid * 16 + i * 8192, R, C); const int Rb = Epi::PERM ? ((R & ~31) + perm32(R & 31)) : R;
        voffA[i] = (unsigned)R * lda + (unsigned)C * 2u; voffB[i] = (unsigned)Rb * ldb + (unsigned)C * 2u; }
    const size_t kstep = (size_t)(BK * 2);
    const size_t hstepA = (size_t)HALF * lda, hstepB = (size_t)HALF * ldb;
    const unsigned ldsw = (unsigned)wid * 1024u;
    const int aoff = lds_byte(wr * 64 + fr, fq * 8), boff = lds_byte(wc * 32 + fr, fq * 8);
#define PG8_SA(b, h) (((b) * 2 + (h)) * HTB)
#define PG8_SB(b, h) ((4 + (b) * 2 + (h)) * HTB)
#define PG8_STAGE(bufoff, gbase, voff) do { const char* _gb = (const char*)(gbase); asm volatile("" : "+s"(_gb)); _Pragma("unroll") for (int _i = 0; _i < 2; ++_i) \
        __builtin_amdgcn_global_load_lds((const unsigned*)(_gb + (voff)[_i]), (LAS unsigned*)(lds + (bufoff) + ldsw + _i * 8192), 16, 0, 0); } while (0)
#define PG8_LDA(dst, b, h) do { _Pragma("unroll") for (int m = 0; m < 4; ++m) _Pragma("unroll") for (int k = 0; k < 2; ++k) dst[m][k] = *(const LAS bf16x8*)(lds + PG8_SA(b, h) + aoff + m * 2048 + k * 1024); } while (0)
#define PG8_LDB(dst, b, h) do { _Pragma("unroll") for (int n = 0; n < 2; ++n) _Pragma("unroll") for (int k = 0; k < 2; ++k) dst[n][k] = *(const LAS bf16x8*)(lds + PG8_SB(b, h) + boff + n * 2048 + k * 1024); } while (0)
#define PG8_MMA(ai, bj, At, Bt) do { __builtin_amdgcn_s_setprio(1); _Pragma("unroll") for (int m = 0; m < 4; ++m) _Pragma("unroll") for (int n = 0; n < 2; ++n) _Pragma("unroll") for (int k = 0; k < 2; ++k) \
        acc[ai][bj][m][n] = __builtin_amdgcn_mfma_f32_16x16x32_bf16(Bt[n][k], At[m][k], acc[ai][bj][m][n], 0, 0, 0); __builtin_amdgcn_s_setprio(0); } while (0)
#define PG8_WAIT_V(n) asm volatile("s_waitcnt vmcnt(" #n ")" ::: "memory")
#define PG8_WAIT_L(n) asm volatile("s_waitcnt lgkmcnt(" #n ")" ::: "memory")
#define PG8_BAR __builtin_amdgcn_s_barrier()
#define PG8_SCHED __builtin_amdgcn_sched_barrier(0)
    Unit cur, nxt; int ui = 0;
    if (!S.next(0, cur)) return;
    f32x4 acc[2][2][4][2];
#pragma unroll
    for (int a = 0; a < 2; ++a)
#pragma unroll
        for (int b = 0; b < 2; ++b)
#pragma unroll
            for (int m = 0; m < 4; ++m)
#pragma unroll
                for (int n = 0; n < 2; ++n) acc[a][b][m][n] = (f32x4){0.f, 0.f, 0.f, 0.f};
    bf16x8 At[4][2], B0[2][2], B1[2][2];
    const char* cA = cur.A; const char* cB = cur.B;
    PG8_STAGE(PG8_SB(0, 0), cB, voffB); PG8_STAGE(PG8_SB(0, 1), cB + hstepB, voffB); PG8_STAGE(PG8_SA(0, 0), cA, voffA); PG8_STAGE(PG8_SA(0, 1), cA + hstepA, voffA);
    if (wr == 1) PG8_BAR;
    PG8_WAIT_V(2); PG8_BAR;
    PG8_STAGE(PG8_SB(1, 0), cB + kstep, voffB); PG8_STAGE(PG8_SA(1, 0), cA + kstep, voffA); PG8_STAGE(PG8_SB(1, 1), cB + hstepB + kstep, voffB);
    PG8_WAIT_V(6); PG8_BAR;
    for (;;) {
        const bool has_next = S.next(ui + 1, nxt);
        const char* nA = has_next ? nxt.A : cA; const char* nB = has_next ? nxt.B : cB;
        const int nt = cur.nt;
        for (int t = 0; t < nt; t += 2) {
            const bool last = (t == nt - 2);
            const char* a1 = cA + (size_t)(t + 1) * kstep;
            const char* a2 = last ? nA : cA + (size_t)(t + 2) * kstep; const char* b2 = last ? nB : cB + (size_t)(t + 2) * kstep;
            const char* a3 = a2 + kstep; const char* b3 = b2 + kstep;
            PG8_LDB(B0, 0, 0); PG8_LDB(B1, 0, 1); PG8_SCHED; PG8_LDA(At, 0, 0); PG8_STAGE(PG8_SA(1, 1), a1 + hstepA, voffA);
            PG8_WAIT_V(8); PG8_WAIT_L(0); PG8_BAR; PG8_MMA(0, 0, At, B0); PG8_MMA(0, 1, At, B1); PG8_BAR; PG8_SCHED;
            PG8_LDA(At, 0, 1); PG8_STAGE(PG8_SB(0, 0), b2, voffB); PG8_STAGE(PG8_SB(0, 1), b2 + hstepB, voffB); PG8_STAGE(PG8_SA(0, 0), a2, voffA);
            PG8_WAIT_V(8); PG8_WAIT_L(0); PG8_BAR; PG8_MMA(1, 0, At, B0); PG8_MMA(1, 1, At, B1); PG8_BAR; PG8_SCHED;
            PG8_LDB(B0, 1, 0); PG8_LDB(B1, 1, 1); PG8_SCHED; PG8_LDA(At, 1, 0); PG8_STAGE(PG8_SA(0, 1), a2 + hstepA, voffA);
            PG8_WAIT_V(8); PG8_WAIT_L(0); PG8_BAR; PG8_MMA(0, 0, At, B0); PG8_MMA(0, 1, At, B1); PG8_BAR; PG8_SCHED;
            PG8_LDA(At, 1, 1); PG8_STAGE(PG8_SB(1, 0), b3, voffB); PG8_STAGE(PG8_SB(1, 1), b3 + hstepB, voffB); PG8_STAGE(PG8_SA(1, 0), a3, voffA);
            PG8_WAIT_V(8); PG8_WAIT_L(0); PG8_BAR; PG8_MMA(1, 0, At, B0); PG8_MMA(1, 1, At, B1); PG8_BAR; PG8_SCHED;
            if constexpr (Epi::HAS_MID) { if (t + 2 == 8 || t + 2 == 16) { E.mid(acc, cur, t + 2, wr, wc, fr, fq); PG8_SCHED; } }
        }
        if (wr == 0) PG8_BAR;
        E(acc, cur, wr, wc, fr, fq);
        if (!has_next) break;
#pragma unroll
        for (int a = 0; a < 2; ++a)
#pragma unroll
            for (int b = 0; b < 2; ++b)
#pragma unroll
                for (int m = 0; m < 4; ++m)
#pragma unroll
                    for (int n = 0; n < 2; ++n) acc[a][b][m][n] = (f32x4){0.f, 0.f, 0.f, 0.f};
        cur = nxt; cA = nA; cB = nB; ++ui;
        if (wr == 1) PG8_BAR;
    }
    PG8_WAIT_V(0);
    PG8_BAR;
#undef PG8_SA
#undef PG8_SB
#undef PG8_STAGE
#undef PG8_LDA
#undef PG8_LDB
#undef PG8_MMA
#undef PG8_WAIT_V
#undef PG8_WAIT_L
#undef PG8_BAR
#undef PG8_SCHED
}
}

struct Frame {
    LAS unsigned char* lds;
    volatile LAS unsigned* MISC;
    unsigned* ctl;
    int tid, lane, wave, G, bid;
    const float* const __attribute__((address_space(4)))* in;
    float* out; unsigned char* ws;
};
enum { IN_X = 0, IN_NORM1, IN_WIN, IN_BGATE, IN_LRE, IN_LIM, IN_BRE, IN_BIM, IN_CRE, IN_CIM, IN_S5D, IN_LOGDT, IN_GLU1, IN_GLU2, IN_QG, IN_KG, IN_SINK,
       IN_CONVW, IN_CONVB, IN_DTB, IN_ALOG, IN_SSDD, IN_SSDG, IN_PS5, IN_PATTN, IN_PSSD, IN_WOUT, IN_NORM2, IN_WRG, IN_BRG, IN_WRE, IN_BRE_, IN_EG, IN_EU, IN_ED, N_INPUTS };

#define LDS_WAIT() asm volatile("s_waitcnt lgkmcnt(0)" ::: "memory")
#define VM_WAIT() asm volatile("s_waitcnt vmcnt(0)" ::: "memory")

using pg8::Unit; using pg8::pack8;
struct EpiProj {
    static constexpr bool PERM = true, HAS_MID = false;
    unsigned char* ws; const float* bgate;
    __device__ __forceinline__ void operator()(const f32x4 (&acc)[2][2][4][2], const Unit& u, int wr, int wc, int fr, int fq) const {
        bf16_t* P = (bf16_t*)(ws + WS_P); bf16_t* UH = (bf16_t*)(ws + WS_UH); float* DT = (float*)(ws + WS_DT);
        const int row0 = u.pm * 256 + wr * 64 + fr;
        if (u.pn < 2) {
#pragma unroll
            for (int ai = 0; ai < 2; ++ai)
#pragma unroll
                for (int m = 0; m < 4; ++m) { const int row = row0 + ai * 128 + m * 16, r = row >> 5, s = row & 31;
#pragma unroll
                    for (int bj = 0; bj < 2; ++bj) { const int col = u.pn * 256 + bj * 128 + wc * 32 + 8 * fq, g = col >> 4, c0 = col & 15;
                        *(u32x4*)(UH + ((size_t)(g * S5_ROWS + r) * S5_K + 128 + s * 16 + c0)) = pack8(acc[ai][bj][m][0], acc[ai][bj][m][1]); } }
        } else {
            const int colb = u.pn * 256 + wc * 32 + 8 * fq;
            f32x4 bv[2][2];
#pragma unroll
            for (int bj = 0; bj < 2; ++bj)
#pragma unroll
                for (int n = 0; n < 2; ++n) bv[bj][n] = (u.pn >= 15) ? *(const f32x4*)(bgate + (colb - C_G) + bj * 128 + 4 * n) : (f32x4){0.f, 0.f, 0.f, 0.f};
#pragma unroll
            for (int ai = 0; ai < 2; ++ai)
#pragma unroll
                for (int m = 0; m < 4; ++m) { const int row = row0 + ai * 128 + m * 16;
#pragma unroll
                    for (int bj = 0; bj < 2; ++bj) *(u32x4*)(P + (size_t)row * NINP + colb + bj * 128) = pack8(acc[ai][bj][m][0] + bv[bj][0], acc[ai][bj][m][1] + bv[bj][1]);
                    if (u.pn == 14 && wc == 0 && fq < 2) { float* d = DT + (size_t)row * 16 + 8 * fq; *(f32x4*)d = acc[ai][0][m][0]; *(f32x4*)(d + 4) = acc[ai][0][m][1]; } }
        }
    }
};
struct EpiHloc {
    static constexpr bool PERM = false, HAS_MID = false;
    float* H;
    __device__ __forceinline__ void operator()(const f32x4 (&acc)[2][2][4][2], const Unit& u, int wr, int wc, int fr, int fq) const {
#pragma unroll
        for (int ai = 0; ai < 2; ++ai)
#pragma unroll
            for (int m = 0; m < 4; ++m) { const int r = u.pm * 256 + ai * 128 + wr * 64 + m * 16 + fr; float* rowp = H + ((size_t)(u.aux * S5_ROWS + r) * 128) + wc * 32 + 4 * fq;
#pragma unroll
                for (int n = 0; n < 2; ++n) *(f32x4*)(rowp + 16 * n) = acc[ai][0][m][n]; }
    }
};
struct EpiS5Y {
    static constexpr bool PERM = true, HAS_MID = false;
    bf16_t* Y;
    __device__ __forceinline__ void operator()(const f32x4 (&acc)[2][2][4][2], const Unit& u, int wr, int wc, int fr, int fq) const {
#pragma unroll
        for (int ai = 0; ai < 2; ++ai)
#pragma unroll
            for (int m = 0; m < 4; ++m) { const int r = u.pm * 256 + ai * 128 + wr * 64 + m * 16 + fr;
#pragma unroll
                for (int bj = 0; bj < 2; ++bj) { const int n0 = u.pn * 256 + bj * 128 + wc * 32 + 8 * fq, t = n0 >> 4, c0 = n0 & 15;
                    f32x4 v0 = acc[ai][bj][m][0], v1 = acc[ai][bj][m][1];
#pragma unroll
                    for (int j = 0; j < 4; ++j) { v0[j] = gelu_tanh_(v0[j]); v1[j] = gelu_tanh_(v1[j]); }
                    *(u32x4*)(Y + ((size_t)(r * S5_TC + t) * 512 + u.aux * 16 + c0)) = pack8(v0, v1); } }
    }
};
struct EpiGlu {
    static constexpr bool PERM = true, HAS_MID = false;
    bf16_t* Y;
    __device__ __forceinline__ void operator()(const f32x4 (&acc)[2][2][4][2], const Unit& u, int wr, int wc, int fr, int fq) const {
#pragma unroll
        for (int ai = 0; ai < 2; ++ai)
#pragma unroll
            for (int m = 0; m < 4; ++m) { const int row = u.pm * 256 + ai * 128 + wr * 64 + m * 16 + fr;
                f32x4 v0 = acc[ai][0][m][0], v1 = acc[ai][0][m][1]; const f32x4 g0 = acc[ai][1][m][0], g1 = acc[ai][1][m][1];
#pragma unroll
                for (int j = 0; j < 4; ++j) { v0[j] *= sigmoidf_(g0[j]); v1[j] *= sigmoidf_(g1[j]); }
                *(u32x4*)(Y + (size_t)row * 2048 + u.pn * 128 + wc * 32 + 8 * fq) = pack8(v0, v1); }
    }
};
struct EpiSwiGlu {
    static constexpr bool PERM = true, HAS_MID = false;
    bf16_t* Y;
    __device__ __forceinline__ void operator()(const f32x4 (&acc)[2][2][4][2], const Unit& u, int wr, int wc, int fr, int fq) const {
#pragma unroll
        for (int ai = 0; ai < 2; ++ai)
#pragma unroll
            for (int m = 0; m < 4; ++m) { const int row = u.pm * 256 + ai * 128 + wr * 64 + m * 16 + fr;
                f32x4 v0 = acc[ai][0][m][0], v1 = acc[ai][0][m][1]; const f32x4 g0 = acc[ai][1][m][0], g1 = acc[ai][1][m][1];
#pragma unroll
                for (int j = 0; j < 4; ++j) { v0[j] = siluf_(v0[j]) * g0[j]; v1[j] = siluf_(v1[j]) * g1[j]; }
                *(u32x4*)(Y + (size_t)row * 512 + u.pn * 128 + wc * 32 + 8 * fq) = pack8(v0, v1); }
    }
};
struct EpiPlainBf16 {
    static constexpr bool PERM = true, HAS_MID = false;
    bf16_t* O;
    __device__ __forceinline__ void operator()(const f32x4 (&acc)[2][2][4][2], const Unit& u, int wr, int wc, int fr, int fq) const {
#pragma unroll
        for (int ai = 0; ai < 2; ++ai)
#pragma unroll
            for (int m = 0; m < 4; ++m) { const int row = u.pm * 256 + ai * 128 + wr * 64 + m * 16 + fr;
#pragma unroll
                for (int bj = 0; bj < 2; ++bj) *(u32x4*)(O + (size_t)row * 1024 + u.pn * 256 + bj * 128 + wc * 32 + 8 * fq) = pack8(acc[ai][bj][m][0], acc[ai][bj][m][1]); }
    }
};
struct EpiMerged {
    static constexpr bool PERM = true, HAS_MID = true;
    unsigned char* ws;
    __device__ __forceinline__ static float lclamp(float l) { return fminf(fmaxf(l, -30.f), 30.f); }
    __device__ __forceinline__ void mid(f32x4 (&acc)[2][2][4][2], const Unit& u, int kt, int wr, int wc, int fr, int fq) const {
        const int br = (kt == 8) ? 0 : 1; const bf16_t* P = (const bf16_t*)(ws + WS_P);
#pragma unroll
        for (int ai = 0; ai < 2; ++ai)
#pragma unroll
            for (int m = 0; m < 4; ++m) { const int row = u.pm * 256 + ai * 128 + wr * 64 + m * 16 + fr;
#pragma unroll
                for (int bj = 0; bj < 2; ++bj) { const bf16_t* gp = P + (size_t)row * NINP + C_G + br * 1024 + u.pn * 256 + bj * 128 + wc * 32 + 8 * fq;
                    const u32x4 la = *(const u32x4*)gp, lb = *(const u32x4*)(gp + 1024);
#pragma unroll
                    for (int j = 0; j < 4; ++j) { const unsigned wa = la[j], wb = lb[j];
                        const float r0 = (1.f + __expf(-lclamp(bflo(wb)))) / (1.f + __expf(-lclamp(bflo(wa)))), r1 = (1.f + __expf(-lclamp(bfhi(wb)))) / (1.f + __expf(-lclamp(bfhi(wa))));
                        if (j < 2) { acc[ai][bj][m][0][2 * j] *= r0; acc[ai][bj][m][0][2 * j + 1] *= r1; } else { acc[ai][bj][m][1][2 * j - 4] *= r0; acc[ai][bj][m][1][2 * j - 3] *= r1; } } }
                asm volatile("" ::: "memory"); }
    }
    __device__ __forceinline__ void operator()(const f32x4 (&acc)[2][2][4][2], const Unit& u, int wr, int wc, int fr, int fq) const {
        const bf16_t* P = (const bf16_t*)(ws + WS_P); bf16_t* O = (bf16_t*)(ws + WS_XN);
#pragma unroll
        for (int ai = 0; ai < 2; ++ai)
#pragma unroll
            for (int m = 0; m < 4; ++m) { const int row = u.pm * 256 + ai * 128 + wr * 64 + m * 16 + fr;
#pragma unroll
                for (int bj = 0; bj < 2; ++bj) { const int col = u.pn * 256 + bj * 128 + wc * 32 + 8 * fq;
                    const u32x4 lc = *(const u32x4*)(P + (size_t)row * NINP + C_G + 2048 + col);
                    f32x4 v0 = acc[ai][bj][m][0], v1 = acc[ai][bj][m][1];
                    v0[0] *= sigmoidf_(lclamp(bflo(lc[0]))); v0[1] *= sigmoidf_(lclamp(bfhi(lc[0]))); v0[2] *= sigmoidf_(lclamp(bflo(lc[1]))); v0[3] *= sigmoidf_(lclamp(bfhi(lc[1])));
                    v1[0] *= sigmoidf_(lclamp(bflo(lc[2]))); v1[1] *= sigmoidf_(lclamp(bfhi(lc[2]))); v1[2] *= sigmoidf_(lclamp(bflo(lc[3]))); v1[3] *= sigmoidf_(lclamp(bfhi(lc[3])));
                    *(u32x4*)(O + (size_t)row * 1024 + col) = pack8(v0, v1); }
                asm volatile("" ::: "memory"); }
    }
};
struct EpiResid {
    static constexpr bool PERM = false, HAS_MID = false;
    const float* resid; float* out;
    __device__ __forceinline__ void operator()(const f32x4 (&acc)[2][2][4][2], const Unit& u, int wr, int wc, int fr, int fq) const {
#pragma unroll
        for (int ai = 0; ai < 2; ++ai)
#pragma unroll
            for (int m = 0; m < 4; ++m) { const size_t off = (size_t)(u.pm * 256 + ai * 128 + wr * 64 + m * 16 + fr) * 1024 + u.pn * 256 + wc * 32 + 4 * fq;
#pragma unroll
                for (int bj = 0; bj < 2; ++bj)
#pragma unroll
                    for (int n = 0; n < 2; ++n) { const f32x4 rv = *(const f32x4*)(resid + off + bj * 128 + n * 16); *(f32x4*)(out + off + bj * 128 + n * 16) = rv + acc[ai][bj][m][n]; } }
    }
};

template <unsigned lda, unsigned ldb, int nM, int nN, int NT>
struct SchedDense {
    const char* A; const char* B; int G, c;
    __device__ __forceinline__ bool next(int i, Unit& u) const {
        const int L = i * G + c; if (L >= nM * nN) return false;
        int pm, pn; pg8::tile_order(L, nM, nN, pm, pn);
        u.A = A + (size_t)pm * 256 * lda; u.B = B + (size_t)pn * 256 * ldb; u.nt = NT; u.pm = pm; u.pn = pn; u.aux = 0; return true;
    }
};
struct SchedS5P1 {
    const char* UH; const char* EG; int G, c;
    __device__ __forceinline__ bool next(int i, Unit& u) const {
        const int L = i * G + c; if (L >= 64) return false;
        const int g = L >> 1, pm = L & 1;
        u.A = UH + ((size_t)(g * S5_ROWS + pm * 256) * S5_K + 128) * 2; u.B = EG + (size_t)g * 256 * 512 * 2; u.nt = 8; u.pm = pm; u.pn = 0; u.aux = g; return true;
    }
};
struct SchedS5Main {
    const char* UH; const char* MG; int G, c;
    __device__ __forceinline__ bool next(int i, Unit& u) const {
        const int L = i * G + c; if (L >= 128) return false;
        const int g = L >> 2, pm = (L >> 1) & 1, pn = L & 1;
        u.A = UH + (size_t)(g * S5_ROWS + pm * 256) * S5_K * 2; u.B = MG + (size_t)(g * S5_N + pn * 256) * S5_K * 2; u.nt = 2 + 4 * (pn + 1); u.pm = pm; u.pn = pn; u.aux = g; return true;
    }
};
template <unsigned lda, size_t bexp  , size_t btile  , int NT>
struct SchedMoe {
    const char* A; const char* B; int ntiles, G, c; const volatile LAS int* tile_e;
    __device__ __forceinline__ bool next(int i, Unit& u) const {
        const int L = i * G + c; if (L >= ntiles * 4) return false;
        int pm, pn; pg8::tile_order(L, ntiles, 4, pm, pn);
        const int e = __builtin_amdgcn_readfirstlane(tile_e[pm]);
        u.A = A + (size_t)pm * 256 * lda; u.B = B + (size_t)e * bexp + (size_t)pn * btile; u.nt = NT; u.pm = pm; u.pn = pn; u.aux = e; return true;
    }
};

__device__ __forceinline__ void transpose_item(const float* W, int ldw, int ncols, bf16_t* WT, int ldt, int kofs, int mode, int p0, int p1, LAS float* scr, int k0, int n0, int lane) {
#pragma unroll 8
    for (int i = 0; i < 32; ++i) { const int kk = 2 * i + (lane >> 5), n = n0 + (lane & 31); scr[kk * 33 + (lane & 31)] = (n < ncols) ? W[(size_t)(k0 + kk) * ldw + n] : 0.f; }
    LDS_WAIT(); asm volatile("" ::: "memory");
    const int c = lane & 7;
#pragma unroll
    for (int j = 0; j < 4; ++j) { const int nn = (lane >> 3) + 8 * j, n = n0 + nn; const LAS float* s = scr + (8 * c) * 33 + nn;
        u32x4 o; o.x = pk2(s[0 * 33], s[1 * 33]); o.y = pk2(s[2 * 33], s[3 * 33]); o.z = pk2(s[4 * 33], s[5 * 33]); o.w = pk2(s[6 * 33], s[7 * 33]);
        const int drow = (mode == 0) ? n + (n >= p0 ? p1 : 0) : ((n >> 7) * 256 + (n & 127) + 128 * p0);
        if (n < ncols) *(u32x4*)(WT + (size_t)drow * ldt + kofs + k0 + 8 * c) = o; }
    LDS_WAIT(); asm volatile("" ::: "memory");
}
__device__ __forceinline__ void convert_weights(Frame& F, int layer) {
    LAS float* scr = (LAS float*)(F.lds + F.wave * 16384);
    const int gw = F.bid * NWAVES + F.wave, NGW = F.G * NWAVES;
    bf16_t* WIN = (bf16_t*)(F.ws + WS_WIN); bf16_t* WGLU = (bf16_t*)(F.ws + WS_WGLU); bf16_t* PCAT = (bf16_t*)(F.ws + WS_PCAT); bf16_t* WOUT = (bf16_t*)(F.ws + WS_WOUT);
    bf16_t* EGU = (bf16_t*)(F.ws + WS_EGU); bf16_t* EDN = (bf16_t*)(F.ws + WS_EDN);
    constexpr int I_WIN = 16 * 209, I_GLU = 8 * 16, I_P5 = 8 * 32, I_PS = 16 * 32, I_WO = 16 * 32, I_EG = 32 * 256, I_ED = 32 * 256;
    constexpr int NITEMS = I_WIN + 2 * I_GLU + 2 * I_P5 + I_PS + I_WO + 2 * I_EG + I_ED;
    for (int it = gw; it < NITEMS; it += NGW) {
        int r = it;
        if (r < I_WIN) { transpose_item(F.in[IN_WIN] + (size_t)layer * DM * NIN, NIN, NIN, WIN, DM, 0, 0, 3600, 240, scr, 64 * (r / 209), 32 * (r % 209), F.lane); continue; } r -= I_WIN;
        if (r < I_GLU) { transpose_item(F.in[IN_GLU1] + (size_t)layer * 512 * 512, 512, 512, WGLU, 512, 0, 1, 0, 0, scr, 64 * (r / 16), 32 * (r % 16), F.lane); continue; } r -= I_GLU;
        if (r < I_GLU) { transpose_item(F.in[IN_GLU2] + (size_t)layer * 512 * 512, 512, 512, WGLU, 512, 0, 1, 1, 0, scr, 64 * (r / 16), 32 * (r % 16), F.lane); continue; } r -= I_GLU;
        if (r < I_P5) { transpose_item(F.in[IN_PS5] + (size_t)layer * 512 * 1024, 1024, 1024, PCAT, 2048, 0, 0, 1 << 30, 0, scr, 64 * (r / 32), 32 * (r % 32), F.lane); continue; } r -= I_P5;
        if (r < I_P5) { transpose_item(F.in[IN_PATTN] + (size_t)layer * 512 * 1024, 1024, 1024, PCAT, 2048, 512, 0, 1 << 30, 0, scr, 64 * (r / 32), 32 * (r % 32), F.lane); continue; } r -= I_P5;
        if (r < I_PS) { transpose_item(F.in[IN_PSSD] + (size_t)layer * 1024 * 1024, 1024, 1024, PCAT, 2048, 1024, 0, 1 << 30, 0, scr, 64 * (r / 32), 32 * (r % 32), F.lane); continue; } r -= I_PS;
        if (r < I_WO) { transpose_item(F.in[IN_WOUT] + (size_t)layer * 1024 * 1024, 1024, 1024, WOUT, 1024, 0, 0, 1 << 30, 0, scr, 64 * (r / 32), 32 * (r % 32), F.lane); continue; } r -= I_WO;
        if (r < I_EG) { const int e = r >> 8, q = r & 255; transpose_item(F.in[IN_EG] + ((size_t)layer * 32 + e) * 1024 * 512, 512, 512, EGU + (size_t)e * 1024 * 1024, 1024, 0, 1, 0, 0, scr, 64 * (q / 16), 32 * (q % 16), F.lane); continue; } r -= I_EG;
        if (r < I_EG) { const int e = r >> 8, q = r & 255; transpose_item(F.in[IN_EU] + ((size_t)layer * 32 + e) * 1024 * 512, 512, 512, EGU + (size_t)e * 1024 * 1024, 1024, 0, 1, 1, 0, scr, 64 * (q / 16), 32 * (q % 16), F.lane); continue; } r -= I_EG;
        { const int e = r >> 8, q = r & 255; transpose_item(F.in[IN_ED] + ((size_t)layer * 32 + e) * 512 * 1024, 1024, 1024, EDN + (size_t)e * 1024 * 512, 512, 0, 0, 1 << 30, 0, scr, 64 * (q / 32), 32 * (q % 32), F.lane); }
    }
}
__device__ __forceinline__ void sincos_fast(float x, float& s, float& c) {
    const float k = rintf(x * 0.15915494309189535f);
    float r = fmaf(-k, 6.2831854820251465f, x); r = fmaf(-k, -1.7484555e-07f, r);
    s = __sinf(r); c = __cosf(r);
}
__device__ __forceinline__ void sincos_red(float x, float& s, float& c) {
    const float k = rintf(x * 0.15915494309189535f);
    float r = fmaf(-k, 6.2831854820251465f, x); r = fmaf(-k, -1.7484555e-07f, r);
    s = sinf(r); c = cosf(r);
}
__device__ __forceinline__ void s5_build(Frame& F, int layer) {
    LAS float* pw = (LAS float*)F.lds;
    LAS float* Bb = pw + 33 * 64 * 2;
    LAS float* Cc = Bb + 64 * 16 * 2;
    LAS float* Kd = Cc + 16 * 64 * 2;
    bf16_t* MG = (bf16_t*)(F.ws + WS_MG); bf16_t* EG = (bf16_t*)(F.ws + WS_EG);
    for (int w = F.bid; w < 256; w += F.G) {
        const int g = w >> 3, part = w & 7, gi = layer * 32 + g;
        __syncthreads();
        const float dt = __expf(F.in[IN_LOGDT][gi]);
        for (int i = F.tid; i < 33 * 64; i += NTHR) { const int d = i >> 6, p = i & 63; const float lr = F.in[IN_LRE][gi * 64 + p], li = F.in[IN_LIM][gi * 64 + p];
            float s, c; sincos_red((float)d * li * dt, s, c); const float mg = __expf((float)d * lr * dt); pw[2 * i] = mg * c; pw[2 * i + 1] = mg * s; }
        for (int i = F.tid; i < 64 * 16; i += NTHR) { const int p = i >> 4; const float lr = F.in[IN_LRE][gi * 64 + p], li = F.in[IN_LIM][gi * 64 + p];
            float s, c; sincos_red(li * dt, s, c); const float mg = __expf(lr * dt), are = mg * c, aim = mg * s, nr = are - 1.f, den = lr * lr + li * li;
            const float fre = (nr * lr + aim * li) / den, fim = (aim * lr - nr * li) / den;
            const float br = F.in[IN_BRE][(size_t)gi * 1024 + i], bi = F.in[IN_BIM][(size_t)gi * 1024 + i];
            Bb[2 * i] = fre * br - fim * bi; Bb[2 * i + 1] = fre * bi + fim * br; }
        for (int i = F.tid; i < 16 * 64; i += NTHR) { Cc[2 * i] = F.in[IN_CRE][(size_t)gi * 1024 + i]; Cc[2 * i + 1] = F.in[IN_CIM][(size_t)gi * 1024 + i]; }
        __syncthreads();
        for (int i = F.tid; i < 32 * 256; i += NTHR) { const int d = i >> 8, c = (i >> 4) & 15, c2 = i & 15; float acc = 0.f;
            for (int p = 0; p < 64; ++p) { const float cr = Cc[2 * (c * 64 + p)], ci = Cc[2 * (c * 64 + p) + 1], pr = pw[2 * (d * 64 + p)], pi = pw[2 * (d * 64 + p) + 1];
                const float xr = cr * pr - ci * pi, xi = cr * pi + ci * pr; acc += xr * Bb[2 * (p * 16 + c2)] - xi * Bb[2 * (p * 16 + c2) + 1]; }
            Kd[i] = acc; }
        __syncthreads();
        for (int v = F.tid; v < 64 * 80; v += NTHR) { const int n = part * 64 + v / 80, k0 = (v % 80) * 8, t = n >> 4, c = n & 15; float o[8];
            if (k0 < 128) { const int im = k0 >= 64, p0 = k0 & 63;
#pragma unroll
                for (int j = 0; j < 8; ++j) { const int p = p0 + j; const float cr = Cc[2 * (c * 64 + p)], ci = Cc[2 * (c * 64 + p) + 1], pr = pw[2 * ((t + 1) * 64 + p)], pi = pw[2 * ((t + 1) * 64 + p) + 1];
                    o[j] = im ? -(cr * pi + ci * pr) : (cr * pr - ci * pi); }
            } else { const int s = (k0 - 128) >> 4, c0 = (k0 - 128) & 15;
#pragma unroll
                for (int j = 0; j < 8; ++j) { float x = 0.f; if (s <= t) { x = Kd[(t - s) * 256 + c * 16 + c0 + j]; if (s == t && c == c0 + j) x += F.in[IN_S5D][layer * 512 + g * 16 + c]; } o[j] = x; } }
            u32x4 q; q.x = pk2(o[0], o[1]); q.y = pk2(o[2], o[3]); q.z = pk2(o[4], o[5]); q.w = pk2(o[6], o[7]);
            *(u32x4*)(MG + ((size_t)(g * S5_N + n) * S5_K + k0)) = q; }
        for (int v = F.tid; v < 16 * 64; v += NTHR) { const int jr = part * 16 + v / 64, k0 = (v % 64) * 8, im = jr >= 64, p = jr & 63, s = k0 >> 4, c0 = k0 & 15; float o[8];
            const float pr = pw[2 * ((S5_TC - 1 - s) * 64 + p)], pi = pw[2 * ((S5_TC - 1 - s) * 64 + p) + 1];
#pragma unroll
            for (int j = 0; j < 8; ++j) { const float br = Bb[2 * (p * 16 + c0 + j)], bi = Bb[2 * (p * 16 + c0 + j) + 1]; o[j] = im ? (pr * bi + pi * br) : (pr * br - pi * bi); }
            u32x4 q; q.x = pk2(o[0], o[1]); q.y = pk2(o[2], o[3]); q.z = pk2(o[4], o[5]); q.w = pk2(o[6], o[7]);
            *(u32x4*)(EG + ((size_t)(g * 256 + jr) * 512 + k0)) = q; }
    }
    __syncthreads();
}
__device__ __forceinline__ void rms_row_to_bf16(const float* xrow, const float* gain, bf16_t* orow, int lane) {
    const f32x4* xr = (const f32x4*)xrow + lane; const f32x4* gr = (const f32x4*)gain + lane;
    f32x4 v[4]; float s = 0.f;
#pragma unroll
    for (int j = 0; j < 4; ++j) { v[j] = xr[64 * j]; s += (v[j].x * v[j].x + v[j].y * v[j].y) + (v[j].z * v[j].z + v[j].w * v[j].w); }
    const float rstd = 1.f / sqrtf(wave_sum(s) * (1.f / DM) + NORM_EPS);
    unsigned long long* o8 = (unsigned long long*)orow + lane;
#pragma unroll
    for (int j = 0; j < 4; ++j) { const f32x4 gv = gr[64 * j]; o8[64 * j] = (unsigned long long)pk2(v[j].x * rstd * gv.x, v[j].y * rstd * gv.y) | ((unsigned long long)pk2(v[j].z * rstd * gv.z, v[j].w * rstd * gv.w) << 32); }
}
__device__ __forceinline__ void rmsnorm_rows(Frame& F, const float* x, const float* gain, bf16_t* o) {
    const int gw = F.bid * NWAVES + F.wave, NGW = F.G * NWAVES;
    for (int m = gw; m < T; m += NGW) rms_row_to_bf16(x + (size_t)m * DM, gain, o + (size_t)m * DM, F.lane);
}

__device__ __forceinline__ void s5_scan(Frame& F, int layer) {
    const float* HL = (const float*)(F.ws + WS_HLOC); bf16_t* UH = (bf16_t*)(F.ws + WS_UH);
    for (int i = F.bid * NTHR + F.tid; i < BATCH * 32 * 64; i += F.G * NTHR) {
        const int p = i & 63, g = (i >> 6) & 31, b = i >> 11, gi = layer * 32 + g;
        const float dt = __expf(F.in[IN_LOGDT][gi]), lr = F.in[IN_LRE][gi * 64 + p], li = F.in[IN_LIM][gi * 64 + p];
        float s, c; sincos_red((float)S5_TC * li * dt, s, c); const float mg = __expf((float)S5_TC * lr * dt), ar = mg * c, ai = mg * s;
        float hr = 0.f, hi = 0.f;
        const int nch = SEQ / S5_TC;
#pragma unroll 8
        for (int ch = 0; ch < nch; ++ch) { const size_t r = (size_t)g * S5_ROWS + b * nch + ch;
            const float lr_ = HL[r * 128 + p], li_ = HL[r * 128 + 64 + p];
            UH[r * S5_K + p] = (bf16_t)f2bf(hr); UH[r * S5_K + 64 + p] = (bf16_t)f2bf(hi);
            const float nr = ar * hr - ai * hi + lr_, ni = ar * hi + ai * hr + li_; hr = nr; hi = ni; }
    }
}

__device__ __forceinline__ void ssd_stage_bc(Frame& F, int layer, int b, int ch, int grp, LAS float* Bs, LAS float* Cs, LAS float* dts, LAS float* das) {
    const bf16_t* P = (const bf16_t*)(F.ws + WS_P); const float* DT = (const float*)(F.ws + WS_DT);
    const float* cw = F.in[IN_CONVW] + layer * 4 * 1280; const float* cb = F.in[IN_CONVB] + layer * 1280;
    const int l0 = ch * 128; const size_t row0 = (size_t)b * SEQ + l0;
    for (int i = F.tid; i < 2 * 128 * 64; i += NTHR) { const int isC = i >> 13, t = (i >> 6) & 127, n = i & 63;
        const int col = (isC ? C_C : C_B) + grp * 64 + n, cc = 1024 + isC * 128 + grp * 64 + n; float a = cb[cc];
#pragma unroll
        for (int j = 0; j < 4; ++j) { const int l = l0 + t - 3 + j; if (l >= 0) a += cw[j * 1280 + cc] * bf2f(P[(row0 + t - 3 + j) * NINP + col]); }
        (isC ? Cs : Bs)[t * 64 + n] = siluf_(a); }
    for (int i = F.tid; i < 128 * 8; i += NTHR) { const int t = i >> 3, hh = i & 7, h = grp * 8 + hh;
        const float dt = softplusf_(DT[(row0 + t) * 16 + h] + F.in[IN_DTB][layer * 16 + h]); dts[i] = dt; das[i] = dt * (-__expf(F.in[IN_ALOG][layer * 16 + h])); }
}
template <bool OUT>
__device__ __forceinline__ void ssd_units(Frame& F, int layer) {
    LAS float* Bs = (LAS float*)F.lds; LAS float* Cs = Bs + 128 * 64; LAS float* dts = Cs + 128 * 64; LAS float* das = dts + 128 * 8; LAS float* ssq = das + 128 * 8;
    const bf16_t* P = (const bf16_t*)(F.ws + WS_P); float* SST = (float*)(F.ws + WS_SST); float* ASUM = (float*)(F.ws + WS_ASUM); bf16_t* YC = (bf16_t*)(F.ws + WS_YCAT);
    const float* cw = F.in[IN_CONVW] + layer * 4 * 1280; const float* cb = F.in[IN_CONVB] + layer * 1280;
    for (int u = F.bid; u < BATCH * SSD_NCH * 2; u += F.G) {
        const int grp = u & 1, ch = (u >> 1) & 31, b = u >> 6;
        __syncthreads();
        ssd_stage_bc(F, layer, b, ch, grp, Bs, Cs, dts, das);
        __syncthreads();
        const int hh = F.wave, h = grp * 8 + hh, p = F.lane, cx = h * 64 + p;
        const float w0 = cw[cx], w1 = cw[1280 + cx], w2 = cw[2560 + cx], w3 = cw[3840 + cx], bias = cb[cx], dsk = F.in[IN_SSDD][layer * 16 + h];
        const int l0 = ch * 128; const size_t row0 = (size_t)b * SEQ + l0;
        const bf16_t* xp = P + row0 * NINP + C_XS + cx;
        float x0 = 0.f, x1 = 0.f, x2 = 0.f;
        if (l0 > 0) { x0 = bf2f(xp[-3 * (ptrdiff_t)NINP]); x1 = bf2f(xp[-2 * (ptrdiff_t)NINP]); x2 = bf2f(xp[-1 * (ptrdiff_t)NINP]); }
        float st[64];
        float* sp = SST + ((((size_t)b * SSD_NCH + ch) * 16 + h) * 64 + p) * 64;
        if (OUT) {
#pragma unroll
            for (int n = 0; n < 64; n += 4) { const f32x4 v = *(const f32x4*)(sp + n); st[n] = v.x; st[n + 1] = v.y; st[n + 2] = v.z; st[n + 3] = v.w; }
        } else {
#pragma unroll
            for (int n = 0; n < 64; ++n) st[n] = 0.f;
        }
        float asum = 0.f;
#pragma unroll 4
        for (int t = 0; t < 128; ++t) {
            const float x3 = bf2f(xp[(size_t)t * NINP]);
            const float xs = siluf_(bias + w0 * x0 + w1 * x1 + w2 * x2 + w3 * x3);
            x0 = x1; x1 = x2; x2 = x3;
            const float dt = dts[t * 8 + hh], a = das[t * 8 + hh], da = __expf(a), xdt = xs * dt;
            asum += a;
            float y = 0.f;
#pragma unroll
            for (int n = 0; n < 64; n += 4) { const f32x4 bv = *(const LAS f32x4*)(Bs + t * 64 + n);
                st[n] = da * st[n] + bv.x * xdt; st[n + 1] = da * st[n + 1] + bv.y * xdt; st[n + 2] = da * st[n + 2] + bv.z * xdt; st[n + 3] = da * st[n + 3] + bv.w * xdt;
                if (OUT) { const f32x4 cv = *(const LAS f32x4*)(Cs + t * 64 + n); y += (cv.x * st[n] + cv.y * st[n + 1]) + (cv.z * st[n + 2] + cv.w * st[n + 3]); } }
            if (OUT) {
                const float z = bf2f(P[(row0 + t) * NINP + C_Z + cx]);
                const float yz = (y + dsk * xs) * siluf_(z);
                const float q = wave_sum(yz * yz);
                if (p == 0) ssq[t * 8 + hh] = q;
                YC[(row0 + t) * 2048 + 1024 + cx] = (bf16_t)f2bf(yz);
            }
        }
        if (!OUT) {
#pragma unroll
            for (int n = 0; n < 64; n += 4) *(f32x4*)(sp + n) = (f32x4){st[n], st[n + 1], st[n + 2], st[n + 3]};
            if (p == 0) ASUM[((size_t)b * SSD_NCH + ch) * 16 + h] = asum;
        } else {
            __syncthreads();
            const float ng = F.in[IN_SSDG][layer * 1024 + cx];
            for (int t = 0; t < 128; ++t) { float q = 0.f;
#pragma unroll
                for (int j = 0; j < 8; ++j) q += ssq[t * 8 + j];
                const float rs = 1.f / sqrtf(q * (1.f / 512.f) + NORM_EPS);
                bf16_t* yp = YC + (row0 + t) * 2048 + 1024 + cx; *yp = (bf16_t)f2bf(bf2f(*yp) * rs * ng); }
        }
    }
}
__device__ __forceinline__ void ssd_scan(Frame& F) {
    float* SST = (float*)(F.ws + WS_SST); const float* ASUM = (const float*)(F.ws + WS_ASUM);
    for (int i = F.bid * NTHR + F.tid; i < BATCH * 16 * 64 * 64; i += F.G * NTHR) {
        const int pn = i & 4095, h = (i >> 12) & 15, b = i >> 16; float s = 0.f;
#pragma unroll 8
        for (int ch = 0; ch < SSD_NCH; ++ch) { const size_t o = (((size_t)b * SSD_NCH + ch) * 16 + h) * 4096 + pn; const float loc = SST[o], dec = __expf(ASUM[((size_t)b * SSD_NCH + ch) * 16 + h]);
            SST[o] = s; s = s * dec + loc; }
    }
}

__device__ __forceinline__ void attn_units(Frame& F, int layer) {
    LAS float* Ks = (LAS float*)F.lds; LAS float* Vs = Ks + 256 * 64;
    const bf16_t* P = (const bf16_t*)(F.ws + WS_P); bf16_t* YC = (bf16_t*)(F.ws + WS_YCAT);
    const float* qg = F.in[IN_QG] + layer * 64; const float* kg = F.in[IN_KG] + layer * 64;
    for (int u = F.bid; u < BATCH * 32 * 2; u += F.G) {
        const int kvh = u & 1, qb = (u >> 1) & 31, b = u >> 6, q0 = qb * 128;
        int lane = F.lane; asm volatile("" : "+v"(lane));
        __syncthreads();
        for (int jr = F.wave; jr < 256; jr += NWAVES) { const int l = q0 - 128 + jr; float kv = 0.f, vv = 0.f;
            if (l >= 0) { const size_t row = (size_t)b * SEQ + l; const float x = bf2f(P[row * NINP + C_K + kvh * 64 + lane]); vv = bf2f(P[row * NINP + C_V + kvh * 64 + lane]);
                const float rs = 1.f / sqrtf(wave_sum(x * x) * (1.f / 64.f) + NORM_EPS); const float xn = x * rs * kg[lane];
                const float other = __shfl_xor(xn, 32); const int i = lane & 31; const float inv = exp2f(-(float)i * (13.287712379549449f / 32.f));
                float s, c; sincos_fast((float)l * inv, s, c);
                kv = (lane < 32) ? (xn * c - other * s) : (xn * c + other * s); }
            Ks[jr * 64 + lane] = kv; Vs[jr * 64 + lane] = vv; }
        __syncthreads();
        const int hh = F.wave >> 1, head = kvh * 4 + hh, qi = q0 + (F.wave & 1) * 64 + lane; const size_t row = (size_t)b * SEQ + qi;
        float q[64];
        { const u32x4* qp = (const u32x4*)(P + row * NINP + C_Q + head * 64); float ss = 0.f;
#pragma unroll
          for (int j = 0; j < 8; ++j) { const u32x4 w = qp[j];
#pragma unroll
              for (int e = 0; e < 4; ++e) { q[8 * j + 2 * e] = bflo(w[e]); q[8 * j + 2 * e + 1] = bfhi(w[e]); } }
#pragma unroll
          for (int d = 0; d < 64; ++d) ss += q[d] * q[d];
          const float rs = 1.f / sqrtf(ss * (1.f / 64.f) + NORM_EPS);
#pragma unroll
          for (int d = 0; d < 64; ++d) q[d] = q[d] * rs * qg[d];
#pragma unroll
          for (int i = 0; i < 32; ++i) { const float inv = exp2f(-(float)i * (13.287712379549449f / 32.f)); float s, c; sincos_fast((float)qi * inv, s, c);
              const float a = q[i], bq = q[i + 32]; q[i] = (a * c - bq * s) * 0.125f; q[i + 32] = (bq * c + a * s) * 0.125f; } }
        float o[64];
#pragma unroll
        for (int d = 0; d < 64; ++d) o[d] = 0.f;
        float mx = F.in[IN_SINK][layer * 8 + head], l = 1.f;
        const int qa = q0 + (F.wave & 1) * 64;
        int jlo = qa - 127 - (q0 - 128); if (q0 == 0 && jlo < 128) jlo = 128; const int jhi = qa + 63 - (q0 - 128);
        for (int jr = jlo; jr <= jhi; ++jr) { const int j = q0 - 128 + jr; const bool ok = (j <= qi) && (qi - j < 128);
            float s = 0.f;
#pragma unroll
            for (int d = 0; d < 64; d += 4) { const f32x4 kv = *(const LAS f32x4*)(Ks + jr * 64 + d); s += (q[d] * kv.x + q[d + 1] * kv.y) + (q[d + 2] * kv.z + q[d + 3] * kv.w); if ((d & 12) == 12) __builtin_amdgcn_sched_barrier(0); }
            if (ok) { const float mn = fmaxf(mx, s), al = __expf(mx - mn), pe = __expf(s - mn); l = l * al + pe; mx = mn;
#pragma unroll
                for (int d = 0; d < 64; d += 4) { const f32x4 vv = *(const LAS f32x4*)(Vs + jr * 64 + d); o[d] = o[d] * al + pe * vv.x; o[d + 1] = o[d + 1] * al + pe * vv.y; o[d + 2] = o[d + 2] * al + pe * vv.z; o[d + 3] = o[d + 3] * al + pe * vv.w; if ((d & 12) == 12) __builtin_amdgcn_sched_barrier(0); } } }
        const float il = 1.f / l; u32x4* op = (u32x4*)(YC + row * 2048 + 512 + head * 64);
#pragma unroll
        for (int j = 0; j < 8; ++j) { u32x4 w; w.x = pk2(o[8 * j] * il, o[8 * j + 1] * il); w.y = pk2(o[8 * j + 2] * il, o[8 * j + 3] * il); w.z = pk2(o[8 * j + 4] * il, o[8 * j + 5] * il); w.w = pk2(o[8 * j + 6] * il, o[8 * j + 7] * il); op[j] = w; }
    }
}

__device__ __forceinline__ void router_phase(Frame& F, int layer) {
    LAS float* Wt = (LAS float*)F.lds;
    const float* wrg = F.in[IN_WRG] + (size_t)layer * 1024 * 4; const float* wre = F.in[IN_WRE] + (size_t)layer * 1024 * 32;
    for (int i = F.tid; i < 1024 * 4; i += NTHR) Wt[(i & 3) * 1024 + (i >> 2)] = wrg[i];
    for (int i = F.tid; i < 1024 * 32; i += NTHR) Wt[(4 + (i & 31)) * 1024 + (i >> 5)] = wre[i];
    __syncthreads();
    const float* X = F.out; const float* gain = F.in[IN_NORM2] + layer * 1024; bf16_t* H2 = (bf16_t*)(F.ws + WS_XN);
    int* EID = (int*)(F.ws + WS_MOE); float* EW = (float*)(F.ws + WS_MOE + 128 * 1024); int* SLOT = (int*)(F.ws + WS_MOE + 256 * 1024);
    unsigned* cnt = F.ctl + CW_CNT + layer * 32;
    const int gw = F.bid * NWAVES + F.wave, NGW = F.G * NWAVES;
    for (int m = gw; m < T; m += NGW) {
        const f32x4* xr = (const f32x4*)(X + (size_t)m * DM) + F.lane; const f32x4* gr = (const f32x4*)gain + F.lane;
        f32x4 v[4]; float s = 0.f;
#pragma unroll
        for (int j = 0; j < 4; ++j) { v[j] = xr[64 * j]; s += (v[j].x * v[j].x + v[j].y * v[j].y) + (v[j].z * v[j].z + v[j].w * v[j].w); }
        const float rstd = 1.f / sqrtf(wave_sum(s) * (1.f / DM) + NORM_EPS);
        unsigned long long* o8 = (unsigned long long*)(H2 + (size_t)m * DM) + F.lane;
#pragma unroll
        for (int j = 0; j < 4; ++j) { const f32x4 gv = gr[64 * j]; v[j].x *= rstd * gv.x; v[j].y *= rstd * gv.y; v[j].z *= rstd * gv.z; v[j].w *= rstd * gv.w;
            o8[64 * j] = (unsigned long long)pk2(v[j].x, v[j].y) | ((unsigned long long)pk2(v[j].z, v[j].w) << 32); }
        float mylog = 0.f;
#pragma unroll 2
        for (int e = 0; e < 36; ++e) { float a = 0.f;
#pragma unroll
            for (int j = 0; j < 4; ++j) { const f32x4 w = *(const LAS f32x4*)(Wt + e * 1024 + 256 * j + 4 * F.lane); a += (v[j].x * w.x + v[j].y * w.y) + (v[j].z * w.z + v[j].w * w.w); }
            a = wave_sum(a); mylog = (F.lane == e) ? a : mylog; }
        float lg4[4];
#pragma unroll
        for (int k = 0; k < 4; ++k) lg4[k] = __shfl(mylog, k);
        float gl[4];
#pragma unroll
        for (int k = 0; k < 4; ++k) gl[k] = lg4[k] + F.in[IN_BRG][layer * 4 + k];
        int gs = 0; float gbest = gl[0];
#pragma unroll
        for (int k = 1; k < 4; ++k) if (gl[k] > gbest) { gbest = gl[k]; gs = k; }
        float elv[8];
#pragma unroll
        for (int k = 0; k < 8; ++k) elv[k] = __shfl(mylog, 4 + gs * 8 + k);
        if (F.lane == 0) {
            float den = 0.f;
#pragma unroll
            for (int k = 0; k < 4; ++k) den += __expf(gl[k] - gbest);
            const float pgrp = 1.f / den;
            float el[8];
#pragma unroll
            for (int k = 0; k < 8; ++k) el[k] = elv[k] + F.in[IN_BRE_][layer * 32 + gs * 8 + k];
            int i0 = 0; float v0 = el[0];
#pragma unroll
            for (int k = 1; k < 8; ++k) if (el[k] > v0) { v0 = el[k]; i0 = k; }
            int i1 = -1; float v1 = -3.0e38f;
#pragma unroll
            for (int k = 0; k < 8; ++k) if (k != i0 && el[k] > v1) { v1 = el[k]; i1 = k; }
            const float e1 = __expf(v1 - v0), w0 = pgrp / (1.f + e1), w1 = pgrp * e1 / (1.f + e1);
            const int ea = gs * 8 + i0, eb = gs * 8 + i1;
            EID[2 * m] = ea; EID[2 * m + 1] = eb; EW[2 * m] = w0; EW[2 * m + 1] = w1;
            SLOT[2 * m] = (int)__hip_atomic_fetch_add(cnt + ea, 1u, __ATOMIC_RELAXED, __HIP_MEMORY_SCOPE_AGENT);
            SLOT[2 * m + 1] = (int)__hip_atomic_fetch_add(cnt + eb, 1u, __ATOMIC_RELAXED, __HIP_MEMORY_SCOPE_AGENT);
        }
    }
}
__device__ __forceinline__ int moe_tables(Frame& F, int layer, volatile LAS int* offs, volatile LAS int* tile_e) {
    __syncthreads();
    if (F.tid == 0) { unsigned* cnt = F.ctl + CW_CNT + layer * 32; int o = 0, nt = 0;
        for (int e = 0; e < 32; ++e) { const int c = (int)__hip_atomic_load(cnt + e, __ATOMIC_RELAXED, __HIP_MEMORY_SCOPE_AGENT); offs[e] = o; const int tl = (c + 255) >> 8; for (int k = 0; k < tl; ++k) tile_e[nt + k] = e; nt += tl; o += tl * 256; }
        offs[32] = nt; }
    __syncthreads();
    return __builtin_amdgcn_readfirstlane(offs[32]);
}
__device__ __forceinline__ void gather_phase(Frame& F, int layer, volatile LAS int* offs) {
    const bf16_t* H2 = (const bf16_t*)(F.ws + WS_XN); bf16_t* XG = (bf16_t*)(F.ws + WS_XG);
    const int* EID = (const int*)(F.ws + WS_MOE); const int* SLOT = (const int*)(F.ws + WS_MOE + 256 * 1024); int* POS = (int*)(F.ws + WS_MOE + 384 * 1024);
    const int gw = F.bid * NWAVES + F.wave, NGW = F.G * NWAVES;
    for (int m = gw; m < T; m += NGW) {
        const u32x4* src = (const u32x4*)(H2 + (size_t)m * DM) + F.lane; const u32x4 a = src[0], b = src[64];
#pragma unroll
        for (int k = 0; k < 2; ++k) { const int pos = offs[EID[2 * m + k]] + SLOT[2 * m + k]; u32x4* dst = (u32x4*)(XG + (size_t)pos * DM) + F.lane; dst[0] = a; dst[64] = b; if (F.lane == 0) POS[2 * m + k] = pos; }
    }
}
__device__ __forceinline__ void combine_phase(Frame& F, const float* gain_next) {
    const bf16_t* Y = (const bf16_t*)(F.ws + WS_YEXP); const float* EW = (const float*)(F.ws + WS_MOE + 128 * 1024); const int* POS = (const int*)(F.ws + WS_MOE + 384 * 1024);
    bf16_t* XN = (bf16_t*)(F.ws + WS_XN);
    const int gw = F.bid * NWAVES + F.wave, NGW = F.G * NWAVES;
    for (int m = gw; m < T; m += NGW) {
        const float w0 = EW[2 * m], w1 = EW[2 * m + 1]; const int p0 = POS[2 * m], p1 = POS[2 * m + 1];
        f32x4* xr = (f32x4*)(F.out + (size_t)m * DM) + F.lane;
        const u32x2* y0 = (const u32x2*)(Y + (size_t)p0 * DM) + F.lane; const u32x2* y1 = (const u32x2*)(Y + (size_t)p1 * DM) + F.lane;
        f32x4 v[4]; float s = 0.f;
#pragma unroll
        for (int j = 0; j < 4; ++j) { v[j] = xr[64 * j]; const u32x2 a = y0[64 * j], b = y1[64 * j];
            v[j].x += w0 * bflo(a.x) + w1 * bflo(b.x); v[j].y += w0 * bfhi(a.x) + w1 * bfhi(b.x); v[j].z += w0 * bflo(a.y) + w1 * bflo(b.y); v[j].w += w0 * bfhi(a.y) + w1 * bfhi(b.y);
            xr[64 * j] = v[j]; s += (v[j].x * v[j].x + v[j].y * v[j].y) + (v[j].z * v[j].z + v[j].w * v[j].w); }
        if (gain_next) { const float rstd = 1.f / sqrtf(wave_sum(s) * (1.f / DM) + NORM_EPS); const f32x4* gr = (const f32x4*)gain_next + F.lane;
            unsigned long long* o8 = (unsigned long long*)(XN + (size_t)m * DM) + F.lane;
#pragma unroll
            for (int j = 0; j < 4; ++j) { const f32x4 gv = gr[64 * j]; o8[64 * j] = (unsigned long long)pk2(v[j].x * rstd * gv.x, v[j].y * rstd * gv.y) | ((unsigned long long)pk2(v[j].z * rstd * gv.z, v[j].w * rstd * gv.w) << 32); } }
    }
}

#ifndef MK_PER_PHASE
#define MK_PER_PHASE 1
#endif
constexpr int NPH = 13;
constexpr int TAB_OFF = 150 * 1024;
struct Args { const float* in[N_INPUTS]; float* out; unsigned char* ws; int gp_lo, gp_hi; };
static_assert(sizeof(Args) == (N_INPUTS + 2) * 8 + 8, "no padding in Args");

#define LAUNDER() do { asm volatile("" : "+s"(F.in), "+s"(F.ws), "+s"(F.out), "+s"(F.ctl), "+s"(F.bid), "+s"(F.G)); asm volatile("" : "+v"(F.tid)); F.lane = F.tid & 63; F.wave = __builtin_amdgcn_readfirstlane(F.tid >> 6); } while (0)
template <int layer>
__device__ __forceinline__ void layer_body(Frame& F, const int lo, const int hi) {
    volatile LAS int* offs = (volatile LAS int*)(F.lds + TAB_OFF); volatile LAS int* tile_e = offs + 64;
    XcdBarrier bar; bar.bar = F.ctl + CW_BAR; bar.x = xb_xcc_id(); bar.st = F.MISC;
#define GP(k) (layer * NPH + (k))
#ifdef ONLY_PH
#define IN(k) (((k) == ONLY_PH) && lo <= GP(k) && GP(k) < hi)
#else
#define IN(k) (lo <= GP(k) && GP(k) < hi)
#endif
#define WSB ((const char*)F.ws)
#define SEAM(k) do { if (!MK_PER_PHASE && IN(k) && GP(k) + 1 < hi) xcd_barrier(bar); } while (0)
        if (IN(0) && layer == 0) { LAUNDER();
            convert_weights(F, 0); __syncthreads(); s5_build(F, 0);
            rmsnorm_rows(F, F.in[IN_X], F.in[IN_NORM1], (bf16_t*)(F.ws + WS_XN));
            SEAM(0);
        }
        if (IN(1)) { LAUNDER();
            SchedDense<2048u, 2048u, T / 256, NINP / 256, 16> S{WSB + WS_XN, WSB + WS_WIN, F.G, F.bid};
            EpiProj E{F.ws, F.in[IN_BGATE] + layer * 3072};
            pg8::gemm_phase<2048u, 2048u>(F.tid, F.lds, S, E);
            SEAM(1);
        }
        if (IN(2)) { LAUNDER();
            SchedS5P1 S{WSB + WS_UH, WSB + WS_EG, F.G, F.bid};
            EpiHloc E{(float*)(F.ws + WS_HLOC)};
            pg8::gemm_phase<(unsigned)(S5_K * 2), 1024u>(F.tid, F.lds, S, E);
            ssd_units<false>(F, layer);
            SEAM(2);
        }
        if (IN(3)) { LAUNDER();
            s5_scan(F, layer);
            ssd_scan(F);
            attn_units(F, layer);
            SEAM(3);
        }
        if (IN(4)) { LAUNDER();
            SchedS5Main S{WSB + WS_UH, WSB + WS_MG, F.G, F.bid};
            EpiS5Y E{(bf16_t*)(F.ws + WS_XN)};
            pg8::gemm_phase<(unsigned)(S5_K * 2), (unsigned)(S5_K * 2)>(F.tid, F.lds, S, E);
            ssd_units<true>(F, layer);
            SEAM(4);
        }
        if (IN(5)) { LAUNDER();
            SchedDense<1024u, 1024u, T / 256, 4, 8> S{WSB + WS_XN, WSB + WS_WGLU, F.G, F.bid};
            EpiGlu E{(bf16_t*)(F.ws + WS_YCAT)};
            pg8::gemm_phase<1024u, 1024u>(F.tid, F.lds, S, E);
            SEAM(5);
        }
        if (IN(6)) { LAUNDER();
            SchedDense<4096u, 4096u, T / 256, 4, 32> S{WSB + WS_YCAT, WSB + WS_PCAT, F.G, F.bid};
            EpiMerged E{F.ws};
            pg8::gemm_phase<4096u, 4096u>(F.tid, F.lds, S, E);
            SEAM(6);
        }
        if (IN(7)) { LAUNDER();
            SchedDense<2048u, 2048u, T / 256, 4, 16> S{WSB + WS_XN, WSB + WS_WOUT, F.G, F.bid};
            EpiResid E{layer == 0 ? F.in[IN_X] : (const float*)F.out, F.out};
            pg8::gemm_phase<2048u, 2048u>(F.tid, F.lds, S, E);
            SEAM(7);
        }
        if (IN(8)) { LAUNDER(); router_phase(F, layer); SEAM(8); }
        if (IN(9)) { LAUNDER(); (void)moe_tables(F, layer, offs, tile_e); gather_phase(F, layer, offs); SEAM(9); }
        if (IN(10)) { LAUNDER();
            const int ntiles = moe_tables(F, layer, offs, tile_e);
            SchedMoe<2048u, (size_t)1024 * 1024 * 2, (size_t)256 * 2048, 16> S{WSB + WS_XG, WSB + WS_EGU, ntiles, F.G, F.bid, tile_e};
            EpiSwiGlu E{(bf16_t*)(F.ws + WS_HID)};
            pg8::gemm_phase<2048u, 2048u>(F.tid, F.lds, S, E);
            SEAM(10);
        }
        if (IN(11)) { LAUNDER();
            const int ntiles = moe_tables(F, layer, offs, tile_e);
            SchedMoe<1024u, (size_t)1024 * 512 * 2, (size_t)256 * 1024, 8> S{WSB + WS_HID, WSB + WS_EDN, ntiles, F.G, F.bid, tile_e};
            EpiPlainBf16 E{(bf16_t*)(F.ws + WS_YEXP)};
            pg8::gemm_phase<1024u, 1024u>(F.tid, F.lds, S, E);
            SEAM(11);
        }
        if (IN(12)) { LAUNDER();
            combine_phase(F, layer + 1 < DEPTH ? F.in[IN_NORM1] + (layer + 1) * 1024 : nullptr);
            if (layer + 1 < DEPTH) { __syncthreads(); convert_weights(F, layer + 1); __syncthreads(); s5_build(F, layer + 1); }
            SEAM(12);
        }
#undef GP
#undef IN
#undef SEAM
#undef WSB
}
__global__ void __launch_bounds__(NTHR, 2) fwd(Args args) {
    extern __shared__ __attribute__((aligned(16))) unsigned char lds_raw[];
    Frame F;
    F.lds = (LAS unsigned char*)lds_raw;
    F.MISC = (volatile LAS unsigned*)(F.lds + MISC_OFF);
    F.tid = threadIdx.x; F.lane = F.tid & 63; F.wave = __builtin_amdgcn_readfirstlane(F.tid >> 6);
    F.G = gridDim.x; F.bid = blockIdx.x;
    const __attribute__((address_space(4))) char* ka = (const __attribute__((address_space(4))) char*)__builtin_amdgcn_kernarg_segment_ptr();
    F.in = (const float* const __attribute__((address_space(4)))*)ka;
    F.out = *(float* const __attribute__((address_space(4)))*)(ka + N_INPUTS * 8); F.ws = *(unsigned char* const __attribute__((address_space(4)))*)(ka + N_INPUTS * 8 + 8); F.ctl = (unsigned*)(F.ws + WS_CTL);
    if (F.tid < 64) F.MISC[F.tid] = 0u;
    __syncthreads();
    XcdBarrier bar; bar.bar = F.ctl + CW_BAR; bar.x = 0; bar.st = nullptr;
    if (!MK_PER_PHASE) bar = xcd_barrier_post(F.ctl + CW_BAR, F.MISC);
    const int lo = *(const __attribute__((address_space(4))) int*)(ka + N_INPUTS * 8 + 16), hi = *(const __attribute__((address_space(4))) int*)(ka + N_INPUTS * 8 + 20);

    layer_body<0>(F, lo, hi);
    layer_body<1>(F, lo, hi);
}

extern "C" void kernel_launch(void* const* d_in, const int* in_sizes, int n_in, void* d_out, int out_size, void* d_ws, size_t ws_size, hipStream_t stream) {
    static int grid = 0;
    if (grid == 0) {
        if (n_in != N_INPUTS || out_size != T * DM || ws_size < WS_END) { fprintf(stderr, "kernel_launch: unexpected shapes (n_in %d out %d ws %zu need %zu)\n", n_in, out_size, ws_size, (size_t)WS_END); grid = -1; return; }
        int dev = 0, cus = 0, per_cu = 0;
        if (hipGetDevice(&dev) != hipSuccess || hipDeviceGetAttribute(&cus, hipDeviceAttributeMultiprocessorCount, dev) != hipSuccess) { grid = -1; return; }
        if (hipFuncSetAttribute((const void*)fwd, hipFuncAttributeMaxDynamicSharedMemorySize, LDS_BYTES) != hipSuccess) { fprintf(stderr, "kernel_launch: hipFuncSetAttribute failed\n"); grid = -1; return; }
        if (hipOccupancyMaxActiveBlocksPerMultiprocessor(&per_cu, (const void*)fwd, NTHR, LDS_BYTES) != hipSuccess || per_cu < 1) fprintf(stderr, "kernel_launch: occupancy query reports %d\n", per_cu);
        (void)hipGetLastError();
        grid = cus;
    }
    if (grid < 0) return;
    (void)hipMemsetAsync((char*)d_ws + WS_CTL, 0, CTL_ZERO_BYTES, stream);
    Args a{};
    for (int i = 0; i < N_INPUTS; ++i) a.in[i] = (const float*)d_in[i];
    a.out = (float*)d_out; a.ws = (unsigned char*)d_ws;
#if MK_PER_PHASE
    for (int gp = 0; gp < DEPTH * NPH; ++gp) {
        if (gp == NPH) continue;
        a.gp_lo = gp; a.gp_hi = gp + 1;
        hipLaunchKernelGGL(fwd, dim3(grid), dim3(NTHR), LDS_BYTES, stream, a);
    }
#else
    a.gp_lo = 0; a.gp_hi = DEPTH * NPH;
    hipLaunchKernelGGL(fwd, dim3(grid), dim3(NTHR), LDS_BYTES, stream, a);
#endif
}
```

```cpp
#include <hip/hip_runtime.h>
#include <cstdio>
#include <cstdint>

#define LAS __attribute__((address_space(3)))
#define GAS __attribute__((address_space(1)))
typedef unsigned short bf16_t;
typedef short bf16x8 __attribute__((ext_vector_type(8)));
typedef float f32x4 __attribute__((ext_vector_type(4)));
typedef float f32x2 __attribute__((ext_vector_type(2)));
typedef unsigned u32x4 __attribute__((ext_vector_type(4)));
typedef unsigned u32x2 __attribute__((ext_vector_type(2)));

constexpr int BATCH = 4, SEQ = 4096, DM = 1024, T = BATCH * SEQ, DEPTH = 2;
constexpr int NIN = 6672, NINP = 6912;
constexpr int C_U = 0, C_Q = 512, C_K = 1024, C_V = 1152, C_Z = 1280, C_XS = 2304, C_B = 3328, C_C = 3456, C_DT = 3584, C_G = 3840;
constexpr int S5_TC = 32, S5_ROWS = T / S5_TC  , S5_K = 128 + S5_TC * 16  , S5_N = S5_TC * 16  ;
constexpr int SSD_NCH = SEQ / 128;
constexpr int MOE_MAXROWS = 2 * T + 32 * 256;
constexpr float NORM_EPS = 1e-6f;

constexpr size_t MiB = 1u << 20;
constexpr size_t WS_CTL = 0, CTL_ZERO_BYTES = 1 * MiB;
constexpr size_t WS_WIN = 1 * MiB;
constexpr size_t WS_WGLU = WS_WIN + (size_t)NINP * DM * 2;
constexpr size_t WS_PCAT = WS_WGLU + 1 * MiB;
constexpr size_t WS_WOUT = WS_PCAT + 4 * MiB;
constexpr size_t WS_EGU = WS_WOUT + 2 * MiB;
constexpr size_t WS_EDN = WS_EGU + 64 * MiB;
constexpr size_t WS_MG = WS_EDN + 32 * MiB;
constexpr size_t WS_EG = WS_MG + 20 * MiB;
constexpr size_t WS_XN = WS_EG + 8 * MiB;
constexpr size_t WS_P = WS_XN + 32 * MiB;
constexpr size_t WS_XG = WS_P;
constexpr size_t WS_HID = WS_XG + (size_t)MOE_MAXROWS * 1024 * 2;
constexpr size_t WS_YEXP = WS_HID + (size_t)MOE_MAXROWS * 512 * 2;
constexpr size_t WS_DT = WS_P + 216 * MiB;
constexpr size_t WS_UH = WS_DT + 1 * MiB;
constexpr size_t WS_HLOC = WS_UH + 20 * MiB;
constexpr size_t WS_YCAT = WS_HLOC + 8 * MiB;
constexpr size_t WS_SST = WS_YCAT + 64 * MiB;
constexpr size_t WS_MOE = WS_SST + 32 * MiB;
constexpr size_t WS_ASUM = WS_MOE + 1 * MiB;
constexpr size_t WS_END = WS_ASUM + 64 * 1024;
static_assert(WS_YEXP + (size_t)MOE_MAXROWS * 1024 * 2 <= WS_DT, "MoE overlay fits in P");
constexpr int CW_BAR = 4096;
constexpr int CW_CNT = 16384;

constexpr int NWAVES = 8, NTHR = 512;
constexpr int LDS_BYTES = 163840;
constexpr int RING_BYTES = 131072;
constexpr int MISC_OFF = 160 * 1024 - 256;

__device__ __forceinline__ unsigned f2bf(float f) { unsigned u = __builtin_bit_cast(unsigned, f); return (u + 0x7fffu + ((u >> 16) & 1u)) >> 16; }
__device__ __forceinline__ unsigned pk2(float lo, float hi) { return f2bf(lo) | (f2bf(hi) << 16); }
__device__ __forceinline__ float bf2f(unsigned b) { return __builtin_bit_cast(float, b << 16); }
__device__ __forceinline__ float bflo(unsigned w) { return __builtin_bit_cast(float, w << 16); }
__device__ __forceinline__ float bfhi(unsigned w) { return __builtin_bit_cast(float, w & 0xffff0000u); }
__device__ __forceinline__ float wave_sum(float v) {
#pragma unroll
    for (int o = 1; o < 64; o <<= 1) v += __shfl_xor(v, o);
    return v;
}
__device__ __forceinline__ float sigmoidf_(float x) { return 1.0f / (1.0f + __expf(-x)); }
__device__ __forceinline__ float siluf_(float x) { return x / (1.0f + __expf(-x)); }
__device__ __forceinline__ float gelu_tanh_(float x) { const float u = 0.7978845608f * (x + 0.044715f * x * x * x); return x / (1.0f + __expf(-2.0f * u)); }
__device__ __forceinline__ float softplusf_(float x) { return x > 20.f ? x : log1pf(__expf(x)); }

#define XB_TMO      128
#define XB_XCNT(j)  (256  + 64 * (j))
#define XB_XSUB(j)  (1280 + 64 * (j))
#define XB_XGEN(j)  (2304 + 64 * (j))
#define XB_TOP      3328
#define XB_TOPGEN   3392
#define XCD_BAR_WORDS 3456
#define XB_SPIN_CAP (1u << 18)
__device__ __forceinline__ unsigned xb_ld(unsigned* p)              { return __hip_atomic_load(p, __ATOMIC_RELAXED, __HIP_MEMORY_SCOPE_AGENT); }
__device__ __forceinline__ unsigned xb_add(unsigned* p, unsigned v) { return __hip_atomic_fetch_add(p, v, __ATOMIC_RELAXED, __HIP_MEMORY_SCOPE_AGENT); }
__device__ __forceinline__ unsigned xb_xcc_id() { return (unsigned)__builtin_amdgcn_s_getreg((3 << 11) | 20) & 0xFu; }
#define XB_SPIN(cond, bar) do { unsigned _sp = 0; while (cond) { __builtin_amdgcn_s_sleep(1); \
    if ((++_sp & 255u) == 0u) { if (xb_ld(&(bar)[XB_TMO])) break; if (_sp > XB_SPIN_CAP) { atomicAdd(&(bar)[XB_TMO], 1u); break; } } } } while (0)
struct XcdBarrier { unsigned* bar; unsigned x; volatile LAS unsigned* st; };
__device__ __forceinline__ XcdBarrier xcd_barrier_post(unsigned* bar, volatile LAS unsigned* st) {
    XcdBarrier b; b.bar = bar; b.x = xb_xcc_id(); b.st = st;
    if (threadIdx.x == 0) (void)xb_add(&bar[XB_XCNT(b.x)], 1u);
    return b;
}
__device__ __forceinline__ void xcd_barrier_complete(unsigned* bar, unsigned x, unsigned& nloc, unsigned& nx) {
    const unsigned G = gridDim.x * gridDim.y * gridDim.z;
    unsigned sum, cnt, mine, sp = 0u;
    for (;;) {
        sum = 0u; cnt = 0u; mine = 0u;
#pragma unroll
        for (unsigned j = 0; j < 16; ++j) { const unsigned c = xb_ld(&bar[XB_XCNT(j)]); sum += c; cnt += (c > 0u) ? 1u : 0u; mine = (j == x) ? c : mine; }
        if (sum == G) break;
        __builtin_amdgcn_s_sleep(1);
        if ((++sp & 255u) == 0u) { if (xb_ld(&bar[XB_TMO])) break; if (sp > XB_SPIN_CAP) { atomicAdd(&bar[XB_TMO], 1u); break; } }
    }
    nloc = mine > 0u ? mine : 1u; nx = cnt > 0u ? cnt : 1u;
}
__device__ __forceinline__ void xcd_barrier(const XcdBarrier& b) {
    asm volatile("s_waitcnt vmcnt(0)" ::: "memory");
    __syncthreads();
    if (threadIdx.x == 0) {
        unsigned* bar = b.bar;
        __builtin_amdgcn_s_waitcnt(0);
        unsigned nloc = b.st[0], nx = b.st[1];
        if (nloc == 0u) { xcd_barrier_complete(bar, b.x, nloc, nx); b.st[0] = nloc; b.st[1] = nx; }
        const unsigned old = xb_add(&bar[XB_XSUB(b.x)], 1u);
        const unsigned gen = old / nloc;
        if (old + 1u == (gen + 1u) * nloc) {
            __builtin_amdgcn_fence(__ATOMIC_RELEASE, "agent");
            asm volatile("s_waitcnt vmcnt(0)" ::: "memory");
            const unsigned og = xb_add(&bar[XB_TOP], 1u);
            const unsigned tg = og / nx;
            if (og + 1u == (tg + 1u) * nx) xb_add(&bar[XB_TOPGEN], 1u);
            else XB_SPIN(xb_ld(&bar[XB_TOPGEN]) == tg, bar);
            __builtin_amdgcn_fence(__ATOMIC_ACQUIRE, "agent");
            xb_add(&bar[XB_XGEN(b.x)], 1u);
            asm volatile("s_waitcnt vmcnt(0)" ::: "memory");
        } else {
            XB_SPIN(xb_ld(&bar[XB_XGEN(b.x)]) == gen, bar);
            __builtin_amdgcn_fence(__ATOMIC_ACQUIRE, "agent");
            asm volatile("s_waitcnt vmcnt(0)" ::: "memory");
        }
    }
    __syncthreads();
}

namespace pg8 {
constexpr int BM = 256, BK = 64, HALF = 128, HTB = HALF * BK * 2, STAGE_BYTES = 8 * HTB, NXCD = 8, WGM = 8;
__host__ __device__ __forceinline__ int lds_byte(int r, int c) { const int st = (r >> 4) * 2 + (c >> 5), rr = r & 15, cc = c & 31, ob = rr * 64 + cc * 2; return st * 1024 + (ob ^ (((ob >> 9) & 1) << 5)); }
__host__ __device__ __forceinline__ void stage_rc(int b, int& R, int& C) { const int st = b / 1024, sb = b % 1024, swz = sb ^ (((sb >> 9) & 1) << 5); R = (st >> 1) * 16 + swz / 64; C = (st & 1) * 32 + (swz % 64) / 2; }
__host__ __device__ __forceinline__ int perm32(int rho) { const int n = rho >> 4, i = rho & 15; return 8 * (i >> 2) + 4 * n + (i & 3); }

struct Unit { const char* A; const char* B; int nt; int pm, pn, aux; };

__device__ __forceinline__ void tile_order(int L, int nM, int nN, int& pm, int& pn) {
    const int nwg = nM * nN; int wgid = L;
    { const int q = nwg / NXCD, r = nwg % NXCD, xcd = wgid % NXCD, off = wgid / NXCD; wgid = (xcd < r ? xcd * (q + 1) : r * (q + 1) + (xcd - r) * q) + off; }
    const int nig = WGM * nN, gid = wgid / nig, fm = gid * WGM, gsz = (nM - fm) < WGM ? (nM - fm) : WGM;
    pm = fm + ((wgid % nig) % gsz); pn = (wgid % nig) / gsz;
}
__device__ __forceinline__ unsigned cvt_pk_bf16(float lo, float hi) { unsigned r; asm volatile("v_cvt_pk_bf16_f32 %0, %1, %2" : "=v"(r) : "v"(lo), "v"(hi)); return r; }
__device__ __forceinline__ u32x4 pack8(const f32x4 v0, const f32x4 v1) { u32x4 w; w.x = cvt_pk_bf16(v0[0], v0[1]); w.y = cvt_pk_bf16(v0[2], v0[3]); w.z = cvt_pk_bf16(v1[0], v1[1]); w.w = cvt_pk_bf16(v1[2], v1[3]); return w; }

template <unsigned lda, unsigned ldb, class Epi, class Sched>
__device__ __forceinline__ void gemm_phase(const int tid, LAS unsigned char* lds, const Sched& S, const Epi& E) {
    const int wid = __builtin_amdgcn_readfirstlane(tid >> 6), lane = tid & 63, wr = wid >> 2, wc = wid & 3, fr = lane & 15, fq = lane >> 4;
    unsigned voffA[2], voffB[2];
#pragma unroll
    for (int i = 0; i < 2; ++i) { int R, C; stage_rc(tid * 16 + i * 8192, R, C); const int Rb = Epi::PERM ? ((R & ~31) + perm32(R & 31)) : R;
        voffA[i] = (unsigned)R * lda + (unsigned)C * 2u; voffB[i] = (unsigned)Rb * ldb + (unsigned)C * 2u; }
    const size_t kstep = (size_t)(BK * 2);
    const size_t hstepA = (size_t)HALF * lda, hstepB = (size_t)HALF * ldb;
    const unsigned ldsw = (unsigned)wid * 1024u;
    const int aoff = lds_byte(wr * 64 + fr, fq * 8), boff = lds_byte(wc * 32 + fr, fq * 8);
#define PG8_SA(b, h) (((b) * 2 + (h)) * HTB)
#define PG8_SB(b, h) ((4 + (b) * 2 + (h)) * HTB)
#define PG8_STAGE(bufoff, gbase, voff) do { const char* _gb = (const char*)(gbase); asm volatile("" : "+s"(_gb)); _Pragma("unroll") for (int _i = 0; _i < 2; ++_i) \
        __builtin_amdgcn_global_load_lds((const unsigned*)(_gb + (voff)[_i]), (LAS unsigned*)(lds + (bufoff) + ldsw + _i * 8192), 16, 0, 0); } while (0)
#define PG8_LDA(dst, b, h) do { _Pragma("unroll") for (int m = 0; m < 4; ++m) _Pragma("unroll") for (int k = 0; k < 2; ++k) dst[m][k] = *(const LAS bf16x8*)(lds + PG8_SA(b, h) + aoff + m * 2048 + k * 1024); } while (0)
#define PG8_LDB(dst, b, h) do { _Pragma("unroll") for (int n = 0; n < 2; ++n) _Pragma("unroll") for (int k = 0; k < 2; ++k) dst[n][k] = *(const LAS bf16x8*)(lds + PG8_SB(b, h) + boff + n * 2048 + k * 1024); } while (0)
#define PG8_MMA(ai, bj, At, Bt) do { __builtin_amdgcn_s_setprio(1); _Pragma("unroll") for (int m = 0; m < 4; ++m) _Pragma("unroll") for (int n = 0; n < 2; ++n) _Pragma("unroll") for (int k = 0; k < 2; ++k) \
        acc[ai][bj][m][n] = __builtin_amdgcn_mfma_f32_16x16x32_bf16(Bt[n][k], At[m][k], acc[ai][bj][m][n], 0, 0, 0); __builtin_amdgcn_s_setprio(0); } while (0)
#define PG8_WAIT_V(n) asm volatile("s_waitcnt vmcnt(" #n ")" ::: "memory")
#define PG8_WAIT_L(n) asm volatile("s_waitcnt lgkmcnt(" #n ")" ::: "memory")
#define PG8_BAR __builtin_amdgcn_s_barrier()
#define PG8_SCHED __builtin_amdgcn_sched_barrier(0)
    Unit cur, nxt; int ui = 0;
    if (!S.next(0, cur)) return;
    f32x4 acc[2][2][4][2];
#pragma unroll
    for (int a = 0; a < 2; ++a)
#pragma unroll
        for (int b = 0; b < 2; ++b)
#pragma unroll
            for (int m = 0; m < 4; ++m)
#pragma unroll
                for (int n = 0; n < 2; ++n) acc[a][b][m][n] = (f32x4){0.f, 0.f, 0.f, 0.f};
    bf16x8 At[4][2], B0[2][2], B1[2][2];
    const char* cA = cur.A; const char* cB = cur.B;
    PG8_STAGE(PG8_SB(0, 0), cB, voffB); PG8_STAGE(PG8_SB(0, 1), cB + hstepB, voffB); PG8_STAGE(PG8_SA(0, 0), cA, voffA); PG8_STAGE(PG8_SA(0, 1), cA + hstepA, voffA);
    if (wr == 1) PG8_BAR;
    PG8_WAIT_V(2); PG8_BAR;
    PG8_STAGE(PG8_SB(1, 0), cB + kstep, voffB); PG8_STAGE(PG8_SA(1, 0), cA + kstep, voffA); PG8_STAGE(PG8_SB(1, 1), cB + hstepB + kstep, voffB);
    PG8_WAIT_V(6); PG8_BAR;
    for (;;) {
        const bool has_next = S.next(ui + 1, nxt);
        const char* nA = has_next ? nxt.A : cA; const char* nB = has_next ? nxt.B : cB;
        const int nt = cur.nt;
        for (int t = 0; t < nt; t += 2) {
            const bool last = (t == nt - 2);
            const char* a1 = cA + (size_t)(t + 1) * kstep;
            const char* a2 = last ? nA : cA + (size_t)(t + 2) * kstep; const char* b2 = last ? nB : cB + (size_t)(t + 2) * kstep;
            const char* a3 = a2 + kstep; const char* b3 = b2 + kstep;
            PG8_LDB(B0, 0, 0); PG8_LDB(B1, 0, 1); PG8_SCHED; PG8_LDA(At, 0, 0); PG8_STAGE(PG8_SA(1, 1), a1 + hstepA, voffA);
            PG8_WAIT_V(8); PG8_WAIT_L(0); PG8_BAR; PG8_MMA(0, 0, At, B0); PG8_MMA(0, 1, At, B1); PG8_BAR; PG8_SCHED;
            PG8_LDA(At, 0, 1); PG8_STAGE(PG8_SB(0, 0), b2, voffB); PG8_STAGE(PG8_SB(0, 1), b2 + hstepB, voffB); PG8_STAGE(PG8_SA(0, 0), a2, voffA);
            PG8_WAIT_V(8); PG8_WAIT_L(0); PG8_BAR; PG8_MMA(1, 0, At, B0); PG8_MMA(1, 1, At, B1); PG8_BAR; PG8_SCHED;
            PG8_LDB(B0, 1, 0); PG8_LDB(B1, 1, 1); PG8_SCHED; PG8_LDA(At, 1, 0); PG8_STAGE(PG8_SA(0, 1), a2 + hstepA, voffA);
            PG8_WAIT_V(8); PG8_WAIT_L(0); PG8_BAR; PG8_MMA(0, 0, At, B0); PG8_MMA(0, 1, At, B1); PG8_BAR; PG8_SCHED;
            PG8_LDA(At, 1, 1); PG8_STAGE(PG8_SB(1, 0), b3, voffB); PG8_STAGE(PG8_SB(1, 1), b3 + hstepB, voffB); PG8_STAGE(PG8_SA(1, 0), a3, voffA);
            PG8_WAIT_V(8); PG8_WAIT_L(0); PG8_BAR; PG8_MMA(1, 0, At, B0); PG8_MMA(1, 1, At, B1); PG8_BAR; PG8_SCHED;
            if constexpr (Epi::HAS_MID) { if (t + 2 == 8 || t + 2 == 16) { E.mid(acc, cur, t + 2, wr, wc, fr, fq); PG8_SCHED; } }
        }
        if (wr == 0) PG8_BAR;
        E(acc, cur, wr, wc, fr, fq);
        if (!has_next) break;
#pragma unroll
        for (int a = 0; a < 2; ++a)
#pragma unroll
            for (int b = 0; b < 2; ++b)
#pragma unroll
                for (int m = 0; m < 4; ++m)
#pragma unroll
                    for (int n = 0; n < 2; ++n) acc[a][b][m][n] = (f32x4){0.f, 0.f, 0.f, 0.f};
        cur = nxt; cA = nA; cB = nB; ++ui;
        if (wr == 1) PG8_BAR;
    }
    PG8_WAIT_V(0);
    PG8_BAR;
#undef PG8_SA
#undef PG8_SB
#undef PG8_STAGE
#undef PG8_LDA
#undef PG8_LDB
#undef PG8_MMA
#undef PG8_WAIT_V
#undef PG8_WAIT_L
#undef PG8_BAR
#undef PG8_SCHED
}
}

struct Frame {
    LAS unsigned char* lds;
    volatile LAS unsigned* MISC;
    unsigned* ctl;
    int tid, lane, wave, G, bid;
    const float* const __attribute__((address_space(4)))* in;
    float* out; unsigned char* ws;
};
enum { IN_X = 0, IN_NORM1, IN_WIN, IN_BGATE, IN_LRE, IN_LIM, IN_BRE, IN_BIM, IN_CRE, IN_CIM, IN_S5D, IN_LOGDT, IN_GLU1, IN_GLU2, IN_QG, IN_KG, IN_SINK,
       IN_CONVW, IN_CONVB, IN_DTB, IN_ALOG, IN_SSDD, IN_SSDG, IN_PS5, IN_PATTN, IN_PSSD, IN_WOUT, IN_NORM2, IN_WRG, IN_BRG, IN_WRE, IN_BRE_, IN_EG, IN_EU, IN_ED, N_INPUTS };

#define LDS_WAIT() asm volatile("s_waitcnt lgkmcnt(0)" ::: "memory")
#define VM_WAIT() asm volatile("s_waitcnt vmcnt(0)" ::: "memory")

using pg8::Unit; using pg8::pack8;
struct EpiProj {
    static constexpr bool PERM = true, HAS_MID = false;
    unsigned char* ws; const float* bgate;
    __device__ __forceinline__ void operator()(const f32x4 (&acc)[2][2][4][2], const Unit& u, int wr, int wc, int fr, int fq) const {
        bf16_t* P = (bf16_t*)(ws + WS_P); bf16_t* UH = (bf16_t*)(ws + WS_UH); float* DT = (float*)(ws + WS_DT);
        const int row0 = u.pm * 256 + wr * 64 + fr;
        if (u.pn < 2) {
#pragma unroll
            for (int ai = 0; ai < 2; ++ai)
#pragma unroll
                for (int m = 0; m < 4; ++m) { const int row = row0 + ai * 128 + m * 16, r = row >> 5, s = row & 31;
#pragma unroll
                    for (int bj = 0; bj < 2; ++bj) { const int col = u.pn * 256 + bj * 128 + wc * 32 + 8 * fq, g = col >> 4, c0 = col & 15;
                        *(u32x4*)(UH + ((size_t)(g * S5_ROWS + r) * S5_K + 128 + s * 16 + c0)) = pack8(acc[ai][bj][m][0], acc[ai][bj][m][1]); } }
        } else {
            const int colb = u.pn * 256 + wc * 32 + 8 * fq;
            f32x4 bv[2][2];
#pragma unroll
            for (int bj = 0; bj < 2; ++bj)
#pragma unroll
                for (int n = 0; n < 2; ++n) bv[bj][n] = (u.pn >= 15) ? *(const f32x4*)(bgate + (colb - C_G) + bj * 128 + 4 * n) : (f32x4){0.f, 0.f, 0.f, 0.f};
#pragma unroll
            for (int ai = 0; ai < 2; ++ai)
#pragma unroll
                for (int m = 0; m < 4; ++m) { const int row = row0 + ai * 128 + m * 16;
#pragma unroll
                    for (int bj = 0; bj < 2; ++bj) *(u32x4*)(P + (size_t)row * NINP + colb + bj * 128) = pack8(acc[ai][bj][m][0] + bv[bj][0], acc[ai][bj][m][1] + bv[bj][1]);
                    if (u.pn == 14 && wc == 0 && fq < 2) { float* d = DT + (size_t)row * 16 + 8 * fq; *(f32x4*)d = acc[ai][0][m][0]; *(f32x4*)(d + 4) = acc[ai][0][m][1]; } }
        }
    }
};
struct EpiHloc {
    static constexpr bool PERM = false, HAS_MID = false;
    float* H;
    __device__ __forceinline__ void operator()(const f32x4 (&acc)[2][2][4][2], const Unit& u, int wr, int wc, int fr, int fq) const {
#pragma unroll
        for (int ai = 0; ai < 2; ++ai)
#pragma unroll
            for (int m = 0; m < 4; ++m) { const int r = u.pm * 256 + ai * 128 + wr * 64 + m * 16 + fr; float* rowp = H + ((size_t)(u.aux * S5_ROWS + r) * 128) + wc * 32 + 4 * fq;
#pragma unroll
                for (int n = 0; n < 2; ++n) *(f32x4*)(rowp + 16 * n) = acc[ai][0][m][n]; }
    }
};
struct EpiS5Y {
    static constexpr bool PERM = true, HAS_MID = false;
    bf16_t* Y;
    __device__ __forceinline__ void operator()(const f32x4 (&acc)[2][2][4][2], const Unit& u, int wr, int wc, int fr, int fq) const {
#pragma unroll
        for (int ai = 0; ai < 2; ++ai)
#pragma unroll
            for (int m = 0; m < 4; ++m) { const int r = u.pm * 256 + ai * 128 + wr * 64 + m * 16 + fr;
#pragma unroll
                for (int bj = 0; bj < 2; ++bj) { const int n0 = u.pn * 256 + bj * 128 + wc * 32 + 8 * fq, t = n0 >> 4, c0 = n0 & 15;
                    f32x4 v0 = acc[ai][bj][m][0], v1 = acc[ai][bj][m][1];
#pragma unroll
                    for (int j = 0; j < 4; ++j) { v0[j] = gelu_tanh_(v0[j]); v1[j] = gelu_tanh_(v1[j]); }
                    *(u32x4*)(Y + ((size_t)(r * S5_TC + t) * 512 + u.aux * 16 + c0)) = pack8(v0, v1); } }
    }
};
struct EpiGlu {
    static constexpr bool PERM = true, HAS_MID = false;
    bf16_t* Y;
    __device__ __forceinline__ void operator()(const f32x4 (&acc)[2][2][4][2], const Unit& u, int wr, int wc, int fr, int fq) const {
#pragma unroll
        for (int ai = 0; ai < 2; ++ai)
#pragma unroll
            for (int m = 0; m < 4; ++m) { const int row = u.pm * 256 + ai * 128 + wr * 64 + m * 16 + fr;
                f32x4 v0 = acc[ai][0][m][0], v1 = acc[ai][0][m][1]; const f32x4 g0 = acc[ai][1][m][0], g1 = acc[ai][1][m][1];
#pragma unroll
                for (int j = 0; j < 4; ++j) { v0[j] *= sigmoidf_(g0[j]); v1[j] *= sigmoidf_(g1[j]); }
                *(u32x4*)(Y + (size_t)row * 2048 + u.pn * 128 + wc * 32 + 8 * fq) = pack8(v0, v1); }
    }
};
struct EpiSwiGlu {
    static constexpr bool PERM = true, HAS_MID = false;
    bf16_t* Y;
    __device__ __forceinline__ void operator()(const f32x4 (&acc)[2][2][4][2], const Unit& u, int wr, int wc, int fr, int fq) const {
#pragma unroll
        for (int ai = 0; ai < 2; ++ai)
#pragma unroll
            for (int m = 0; m < 4; ++m) { const int row = u.pm * 256 + ai * 128 + wr * 64 + m * 16 + fr;
                f32x4 v0 = acc[ai][0][m][0], v1 = acc[ai][0][m][1]; const f32x4 g0 = acc[ai][1][m][0], g1 = acc[ai][1][m][1];
#pragma unroll
                for (int j = 0; j < 4; ++j) { v0[j] = siluf_(v0[j]) * g0[j]; v1[j] = siluf_(v1[j]) * g1[j]; }
                *(u32x4*)(Y + (size_t)row * 512 + u.pn * 128 + wc * 32 + 8 * fq) = pack8(v0, v1); }
    }
};
struct EpiPlainBf16 {
    static constexpr bool PERM = true, HAS_MID = false;
    bf16_t* O;
    __device__ __forceinline__ void operator()(const f32x4 (&acc)[2][2][4][2], const Unit& u, int wr, int wc, int fr, int fq) const {
#pragma unroll
        for (int ai = 0; ai < 2; ++ai)
#pragma unroll
            for (int m = 0; m < 4; ++m) { const int row = u.pm * 256 + ai * 128 + wr * 64 + m * 16 + fr;
#pragma unroll
                for (int bj = 0; bj < 2; ++bj) *(u32x4*)(O + (size_t)row * 1024 + u.pn * 256 + bj * 128 + wc * 32 + 8 * fq) = pack8(acc[ai][bj][m][0], acc[ai][bj][m][1]); }
    }
};
struct EpiMerged {
    static constexpr bool PERM = true, HAS_MID = true;
    unsigned char* ws;
    __device__ __forceinline__ static float lclamp(float l) { return fminf(fmaxf(l, -30.f), 30.f); }
    __device__ __forceinline__ void mid(f32x4 (&acc)[2][2][4][2], const Unit& u, int kt, int wr, int wc, int fr, int fq) const {
        const int br = (kt == 8) ? 0 : 1; const bf16_t* P = (const bf16_t*)(ws + WS_P);
#pragma unroll
        for (int ai = 0; ai < 2; ++ai)
#pragma unroll
            for (int m = 0; m < 4; ++m) { const int row = u.pm * 256 + ai * 128 + wr * 64 + m * 16 + fr;
#pragma unroll
                for (int bj = 0; bj < 2; ++bj) { const bf16_t* gp = P + (size_t)row * NINP + C_G + br * 1024 + u.pn * 256 + bj * 128 + wc * 32 + 8 * fq;
                    const u32x4 la = *(const u32x4*)gp, lb = *(const u32x4*)(gp + 1024);
#pragma unroll
                    for (int j = 0; j < 4; ++j) { const unsigned wa = la[j], wb = lb[j];
                        const float r0 = (1.f + __expf(-lclamp(bflo(wb)))) / (1.f + __expf(-lclamp(bflo(wa)))), r1 = (1.f + __expf(-lclamp(bfhi(wb)))) / (1.f + __expf(-lclamp(bfhi(wa))));
                        if (j < 2) { acc[ai][bj][m][0][2 * j] *= r0; acc[ai][bj][m][0][2 * j + 1] *= r1; } else { acc[ai][bj][m][1][2 * j - 4] *= r0; acc[ai][bj][m][1][2 * j - 3] *= r1; } } }
                asm volatile("" ::: "memory"); }
    }
    __device__ __forceinline__ void operator()(const f32x4 (&acc)[2][2][4][2], const Unit& u, int wr, int wc, int fr, int fq) const {
        const bf16_t* P = (const bf16_t*)(ws + WS_P); bf16_t* O = (bf16_t*)(ws + WS_XN);
#pragma unroll
        for (int ai = 0; ai < 2; ++ai)
#pragma unroll
            for (int m = 0; m < 4; ++m) { const int row = u.pm * 256 + ai * 128 + wr * 64 + m * 16 + fr;
#pragma unroll
                for (int bj = 0; bj < 2; ++bj) { const int col = u.pn * 256 + bj * 128 + wc * 32 + 8 * fq;
                    const u32x4 lc = *(const u32x4*)(P + (size_t)row * NINP + C_G + 2048 + col);
                    f32x4 v0 = acc[ai][bj][m][0], v1 = acc[ai][bj][m][1];
                    v0[0] *= sigmoidf_(lclamp(bflo(lc[0]))); v0[1] *= sigmoidf_(lclamp(bfhi(lc[0]))); v0[2] *= sigmoidf_(lclamp(bflo(lc[1]))); v0[3] *= sigmoidf_(lclamp(bfhi(lc[1])));
                    v1[0] *= sigmoidf_(lclamp(bflo(lc[2]))); v1[1] *= sigmoidf_(lclamp(bfhi(lc[2]))); v1[2] *= sigmoidf_(lclamp(bflo(lc[3]))); v1[3] *= sigmoidf_(lclamp(bfhi(lc[3])));
                    *(u32x4*)(O + (size_t)row * 1024 + col) = pack8(v0, v1); }
                asm volatile("" ::: "memory"); }
    }
};
struct EpiResid {
    static constexpr bool PERM = false, HAS_MID = false;
    const float* resid; float* out;
    __device__ __forceinline__ void operator()(const f32x4 (&acc)[2][2][4][2], const Unit& u, int wr, int wc, int fr, int fq) const {
#pragma unroll
        for (int ai = 0; ai < 2; ++ai)
#pragma unroll
            for (int m = 0; m < 4; ++m) { const size_t off = (size_t)(u.pm * 256 + ai * 128 + wr * 64 + m * 16 + fr) * 1024 + u.pn * 256 + wc * 32 + 4 * fq;
#pragma unroll
                for (int bj = 0; bj < 2; ++bj)
#pragma unroll
                    for (int n = 0; n < 2; ++n) { const f32x4 rv = *(const f32x4*)(resid + off + bj * 128 + n * 16); *(f32x4*)(out + off + bj * 128 + n * 16) = rv + acc[ai][bj][m][n]; } }
    }
};

template <unsigned lda, unsigned ldb, int nM, int nN, int NT>
struct SchedDense {
    const char* A; const char* B; int G, c;
    __device__ __forceinline__ bool next(int i, Unit& u) const {
        const int L = i * G + c; if (L >= nM * nN) return false;
        int pm, pn; pg8::tile_order(L, nM, nN, pm, pn);
        u.A = A + (size_t)pm * 256 * lda; u.B = B + (size_t)pn * 256 * ldb; u.nt = NT; u.pm = pm; u.pn = pn; u.aux = 0; return true;
    }
};
struct SchedS5P1 {
    const char* UH; const char* EG; int G, c;
    __device__ __forceinline__ bool next(int i, Unit& u) const {
        const int L = i * G + c; if (L >= 64) return false;
        const int g = L >> 1, pm = L & 1;
        u.A = UH + ((size_t)(g * S5_ROWS + pm * 256) * S5_K + 128) * 2; u.B = EG + (size_t)g * 256 * 512 * 2; u.nt = 8; u.pm = pm; u.pn = 0; u.aux = g; return true;
    }
};
struct SchedS5Main {
    const char* UH; const char* MG; int G, c;
    __device__ __forceinline__ bool next(int i, Unit& u) const {
        const int L = i * G + c; if (L >= 128) return false;
        const int g = L >> 2, pm = (L >> 1) & 1, pn = L & 1;
        u.A = UH + (size_t)(g * S5_ROWS + pm * 256) * S5_K * 2; u.B = MG + (size_t)(g * S5_N + pn * 256) * S5_K * 2; u.nt = 2 + 4 * (pn + 1); u.pm = pm; u.pn = pn; u.aux = g; return true;
    }
};
template <unsigned lda, size_t bexp  , size_t btile  , int NT>
struct SchedMoe {
    const char* A; const char* B; int ntiles, G, c; const volatile LAS int* tile_e;
    __device__ __forceinline__ bool next(int i, Unit& u) const {
        const int L = i * G + c; if (L >= ntiles * 4) return false;
        int pm, pn; pg8::tile_order(L, ntiles, 4, pm, pn);
        const int e = __builtin_amdgcn_readfirstlane(tile_e[pm]);
        u.A = A + (size_t)pm * 256 * lda; u.B = B + (size_t)e * bexp + (size_t)pn * btile; u.nt = NT; u.pm = pm; u.pn = pn; u.aux = e; return true;
    }
};

__device__ __forceinline__ void transpose_item(const float* W, int ldw, int ncols, bf16_t* WT, int ldt, int kofs, int mode, int p0, int p1, LAS float* scr, int k0, int n0, int lane) {
#pragma unroll 8
    for (int i = 0; i < 32; ++i) { const int kk = 2 * i + (lane >> 5), n = n0 + (lane & 31); scr[kk * 33 + (lane & 31)] = (n < ncols) ? W[(size_t)(k0 + kk) * ldw + n] : 0.f; }
    LDS_WAIT(); asm volatile("" ::: "memory");
    const int c = lane & 7;
#pragma unroll
    for (int j = 0; j < 4; ++j) { const int nn = (lane >> 3) + 8 * j, n = n0 + nn; const LAS float* s = scr + (8 * c) * 33 + nn;
        u32x4 o; o.x = pk2(s[0 * 33], s[1 * 33]); o.y = pk2(s[2 * 33], s[3 * 33]); o.z = pk2(s[4 * 33], s[5 * 33]); o.w = pk2(s[6 * 33], s[7 * 33]);
        const int drow = (mode == 0) ? n + (n >= p0 ? p1 : 0) : ((n >> 7) * 256 + (n & 127) + 128 * p0);
        if (n < ncols) *(u32x4*)(WT + (size_t)drow * ldt + kofs + k0 + 8 * c) = o; }
    LDS_WAIT(); asm volatile("" ::: "memory");
}
__device__ __forceinline__ void convert_weights(Frame& F, int layer) {
    LAS float* scr = (LAS float*)(F.lds + F.wave * 16384);
    const int gw = F.bid * NWAVES + F.wave, NGW = F.G * NWAVES;
    bf16_t* WIN = (bf16_t*)(F.ws + WS_WIN); bf16_t* WGLU = (bf16_t*)(F.ws + WS_WGLU); bf16_t* PCAT = (bf16_t*)(F.ws + WS_PCAT); bf16_t* WOUT = (bf16_t*)(F.ws + WS_WOUT);
    bf16_t* EGU = (bf16_t*)(F.ws + WS_EGU); bf16_t* EDN = (bf16_t*)(F.ws + WS_EDN);
    constexpr int I_WIN = 16 * 209, I_GLU = 8 * 16, I_P5 = 8 * 32, I_PS = 16 * 32, I_WO = 16 * 32, I_EG = 32 * 256, I_ED = 32 * 256;
    constexpr int NITEMS = I_WIN + 2 * I_GLU + 2 * I_P5 + I_PS + I_WO + 2 * I_EG + I_ED;
    for (int it = gw; it < NITEMS; it += NGW) {
        int r = it;
        if (r < I_WIN) { transpose_item(F.in[IN_WIN] + (size_t)layer * DM * NIN, NIN, NIN, WIN, DM, 0, 0, 3600, 240, scr, 64 * (r / 209), 32 * (r % 209), F.lane); continue; } r -= I_WIN;
        if (r < I_GLU) { transpose_item(F.in[IN_GLU1] + (size_t)layer * 512 * 512, 512, 512, WGLU, 512, 0, 1, 0, 0, scr, 64 * (r / 16), 32 * (r % 16), F.lane); continue; } r -= I_GLU;
        if (r < I_GLU) { transpose_item(F.in[IN_GLU2] + (size_t)layer * 512 * 512, 512, 512, WGLU, 512, 0, 1, 1, 0, scr, 64 * (r / 16), 32 * (r % 16), F.lane); continue; } r -= I_GLU;
        if (r < I_P5) { transpose_item(F.in[IN_PS5] + (size_t)layer * 512 * 1024, 1024, 1024, PCAT, 2048, 0, 0, 1 << 30, 0, scr, 64 * (r / 32), 32 * (r % 32), F.lane); continue; } r -= I_P5;
        if (r < I_P5) { transpose_item(F.in[IN_PATTN] + (size_t)layer * 512 * 1024, 1024, 1024, PCAT, 2048, 512, 0, 1 << 30, 0, scr, 64 * (r / 32), 32 * (r % 32), F.lane); continue; } r -= I_P5;
        if (r < I_PS) { transpose_item(F.in[IN_PSSD] + (size_t)layer * 1024 * 1024, 1024, 1024, PCAT, 2048, 1024, 0, 1 << 30, 0, scr, 64 * (r / 32), 32 * (r % 32), F.lane); continue; } r -= I_PS;
        if (r < I_WO) { transpose_item(F.in[IN_WOUT] + (size_t)layer * 1024 * 1024, 1024, 1024, WOUT, 1024, 0, 0, 1 << 30, 0, scr, 64 * (r / 32), 32 * (r % 32), F.lane); continue; } r -= I_WO;
        if (r < I_EG) { const int e = r >> 8, q = r & 255; transpose_item(F.in[IN_EG] + ((size_t)layer * 32 + e) * 1024 * 512, 512, 512, EGU + (size_t)e * 1024 * 1024, 1024, 0, 1, 0, 0, scr, 64 * (q / 16), 32 * (q % 16), F.lane); continue; } r -= I_EG;
        if (r < I_EG) { const int e = r >> 8, q = r & 255; transpose_item(F.in[IN_EU] + ((size_t)layer * 32 + e) * 1024 * 512, 512, 512, EGU + (size_t)e * 1024 * 1024, 1024, 0, 1, 1, 0, scr, 64 * (q / 16), 32 * (q % 16), F.lane); continue; } r -= I_EG;
        { const int e = r >> 8, q = r & 255; transpose_item(F.in[IN_ED] + ((size_t)layer * 32 + e) * 512 * 1024, 1024, 1024, EDN + (size_t)e * 1024 * 512, 512, 0, 0, 1 << 30, 0, scr, 64 * (q / 32), 32 * (q % 32), F.lane); }
    }
}
__device__ __forceinline__ void sincos_fast(float x, float& s, float& c) {
    const float k = rintf(x * 0.15915494309189535f);
    float r = fmaf(-k, 6.2831854820251465f, x); r = fmaf(-k, -1.7484555e-07f, r);
    s = __sinf(r); c = __cosf(r);
}
__device__ __forceinline__ void sincos_red(float x, float& s, float& c) {
    const float k = rintf(x * 0.15915494309189535f);
    float r = fmaf(-k, 6.2831854820251465f, x); r = fmaf(-k, -1.7484555e-07f, r);
    s = sinf(r); c = cosf(r);
}
__device__ __forceinline__ void s5_build(Frame& F, int layer) {
    LAS float* pw = (LAS float*)F.lds;
    LAS float* Bb = pw + 33 * 64 * 2;
    LAS float* Cc = Bb + 64 * 16 * 2;
    LAS float* Kd = Cc + 16 * 64 * 2;
    bf16_t* MG = (bf16_t*)(F.ws + WS_MG); bf16_t* EG = (bf16_t*)(F.ws + WS_EG);
    for (int w = F.bid; w < 256; w += F.G) {
        const int g = w >> 3, part = w & 7, gi = layer * 32 + g;
        __syncthreads();
        const float dt = __expf(F.in[IN_LOGDT][gi]);
        for (int i = F.tid; i < 33 * 64; i += NTHR) { const int d = i >> 6, p = i & 63; const float lr = F.in[IN_LRE][gi * 64 + p], li = F.in[IN_LIM][gi * 64 + p];
            float s, c; sincos_red((float)d * li * dt, s, c); const float mg = __expf((float)d * lr * dt); pw[2 * i] = mg * c; pw[2 * i + 1] = mg * s; }
        for (int i = F.tid; i < 64 * 16; i += NTHR) { const int p = i >> 4; const float lr = F.in[IN_LRE][gi * 64 + p], li = F.in[IN_LIM][gi * 64 + p];
            float s, c; sincos_red(li * dt, s, c); const float mg = __expf(lr * dt), are = mg * c, aim = mg * s, nr = are - 1.f, den = lr * lr + li * li;
            const float fre = (nr * lr + aim * li) / den, fim = (aim * lr - nr * li) / den;
            const float br = F.in[IN_BRE][(size_t)gi * 1024 + i], bi = F.in[IN_BIM][(size_t)gi * 1024 + i];
            Bb[2 * i] = fre * br - fim * bi; Bb[2 * i + 1] = fre * bi + fim * br; }
        for (int i = F.tid; i < 16 * 64; i += NTHR) { Cc[2 * i] = F.in[IN_CRE][(size_t)gi * 1024 + i]; Cc[2 * i + 1] = F.in[IN_CIM][(size_t)gi * 1024 + i]; }
        __syncthreads();
        for (int i = F.tid; i < 32 * 256; i += NTHR) { const int d = i >> 8, c = (i >> 4) & 15, c2 = i & 15; float acc = 0.f;
            for (int p = 0; p < 64; ++p) { const float cr = Cc[2 * (c * 64 + p)], ci = Cc[2 * (c * 64 + p) + 1], pr = pw[2 * (d * 64 + p)], pi = pw[2 * (d * 64 + p) + 1];
                const float xr = cr * pr - ci * pi, xi = cr * pi + ci * pr; acc += xr * Bb[2 * (p * 16 + c2)] - xi * Bb[2 * (p * 16 + c2) + 1]; }
            Kd[i] = acc; }
        __syncthreads();
        for (int v = F.tid; v < 64 * 80; v += NTHR) { const int n = part * 64 + v / 80, k0 = (v % 80) * 8, t = n >> 4, c = n & 15; float o[8];
            if (k0 < 128) { const int im = k0 >= 64, p0 = k0 & 63;
#pragma unroll
                for (int j = 0; j < 8; ++j) { const int p = p0 + j; const float cr = Cc[2 * (c * 64 + p)], ci = Cc[2 * (c * 64 + p) + 1], pr = pw[2 * ((t + 1) * 64 + p)], pi = pw[2 * ((t + 1) * 64 + p) + 1];
                    o[j] = im ? -(cr * pi + ci * pr) : (cr * pr - ci * pi); }
            } else { const int s = (k0 - 128) >> 4, c0 = (k0 - 128) & 15;
#pragma unroll
                for (int j = 0; j < 8; ++j) { float x = 0.f; if (s <= t) { x = Kd[(t - s) * 256 + c * 16 + c0 + j]; if (s == t && c == c0 + j) x += F.in[IN_S5D][layer * 512 + g * 16 + c]; } o[j] = x; } }
            u32x4 q; q.x = pk2(o[0], o[1]); q.y = pk2(o[2], o[3]); q.z = pk2(o[4], o[5]); q.w = pk2(o[6], o[7]);
            *(u32x4*)(MG + ((size_t)(g * S5_N + n) * S5_K + k0)) = q; }
        for (int v = F.tid; v < 16 * 64; v += NTHR) { const int jr = part * 16 + v / 64, k0 = (v % 64) * 8, im = jr >= 64, p = jr & 63, s = k0 >> 4, c0 = k0 & 15; float o[8];
            const float pr = pw[2 * ((S5_TC - 1 - s) * 64 + p)], pi = pw[2 * ((S5_TC - 1 - s) * 64 + p) + 1];
#pragma unroll
            for (int j = 0; j < 8; ++j) { const float br = Bb[2 * (p * 16 + c0 + j)], bi = Bb[2 * (p * 16 + c0 + j) + 1]; o[j] = im ? (pr * bi + pi * br) : (pr * br - pi * bi); }
            u32x4 q; q.x = pk2(o[0], o[1]); q.y = pk2(o[2], o[3]); q.z = pk2(o[4], o[5]); q.w = pk2(o[6], o[7]);
            *(u32x4*)(EG + ((size_t)(g * 256 + jr) * 512 + k0)) = q; }
    }
    __syncthreads();
}
__device__ __forceinline__ void rms_row_to_bf16(const float* xrow, const float* gain, bf16_t* orow, int lane) {
    const f32x4* xr = (const f32x4*)xrow + lane; const f32x4* gr = (const f32x4*)gain + lane;
    f32x4 v[4]; float s = 0.f;
#pragma unroll
    for (int j = 0; j < 4; ++j) { v[j] = xr[64 * j]; s += (v[j].x * v[j].x + v[j].y * v[j].y) + (v[j].z * v[j].z + v[j].w * v[j].w); }
    const float rstd = 1.f / sqrtf(wave_sum(s) * (1.f / DM) + NORM_EPS);
    unsigned long long* o8 = (unsigned long long*)orow + lane;
#pragma unroll
    for (int j = 0; j < 4; ++j) { const f32x4 gv = gr[64 * j]; o8[64 * j] = (unsigned long long)pk2(v[j].x * rstd * gv.x, v[j].y * rstd * gv.y) | ((unsigned long long)pk2(v[j].z * rstd * gv.z, v[j].w * rstd * gv.w) << 32); }
}
__device__ __forceinline__ void rmsnorm_rows(Frame& F, const float* x, const float* gain, bf16_t* o) {
    const int gw = F.bid * NWAVES + F.wave, NGW = F.G * NWAVES;
    for (int m = gw; m < T; m += NGW) rms_row_to_bf16(x + (size_t)m * DM, gain, o + (size_t)m * DM, F.lane);
}

__device__ __forceinline__ void s5_scan(Frame& F, int layer) {
    const float* HL = (const float*)(F.ws + WS_HLOC); bf16_t* UH = (bf16_t*)(F.ws + WS_UH);
    for (int i = F.bid * NTHR + F.tid; i < BATCH * 32 * 64; i += F.G * NTHR) {
        const int p = i & 63, g = (i >> 6) & 31, b = i >> 11, gi = layer * 32 + g;
        const float dt = __expf(F.in[IN_LOGDT][gi]), lr = F.in[IN_LRE][gi * 64 + p], li = F.in[IN_LIM][gi * 64 + p];
        float s, c; sincos_red((float)S5_TC * li * dt, s, c); const float mg = __expf((float)S5_TC * lr * dt), ar = mg * c, ai = mg * s;
        float hr = 0.f, hi = 0.f;
        const int nch = SEQ / S5_TC;
#pragma unroll 8
        for (int ch = 0; ch < nch; ++ch) { const size_t r = (size_t)g * S5_ROWS + b * nch + ch;
            const float lr_ = HL[r * 128 + p], li_ = HL[r * 128 + 64 + p];
            UH[r * S5_K + p] = (bf16_t)f2bf(hr); UH[r * S5_K + 64 + p] = (bf16_t)f2bf(hi);
            const float nr = ar * hr - ai * hi + lr_, ni = ar * hi + ai * hr + li_; hr = nr; hi = ni; }
    }
}

__device__ __forceinline__ void ssd_stage_bc(Frame& F, int layer, int b, int ch, int grp, LAS float* Bs, LAS float* Cs, LAS float* dts, LAS float* das) {
    const bf16_t* P = (const bf16_t*)(F.ws + WS_P); const float* DT = (const float*)(F.ws + WS_DT);
    const float* cw = F.in[IN_CONVW] + layer * 4 * 1280; const float* cb = F.in[IN_CONVB] + layer * 1280;
    const int l0 = ch * 128; const size_t row0 = (size_t)b * SEQ + l0;
    for (int i = F.tid; i < 2 * 128 * 64; i += NTHR) { const int isC = i >> 13, t = (i >> 6) & 127, n = i & 63;
        const int col = (isC ? C_C : C_B) + grp * 64 + n, cc = 1024 + isC * 128 + grp * 64 + n; float a = cb[cc];
#pragma unroll
        for (int j = 0; j < 4; ++j) { const int l = l0 + t - 3 + j; if (l >= 0) a += cw[j * 1280 + cc] * bf2f(P[(row0 + t - 3 + j) * NINP + col]); }
        (isC ? Cs : Bs)[t * 64 + n] = siluf_(a); }
    for (int i = F.tid; i < 128 * 8; i += NTHR) { const int t = i >> 3, hh = i & 7, h = grp * 8 + hh;
        const float dt = softplusf_(DT[(row0 + t) * 16 + h] + F.in[IN_DTB][layer * 16 + h]); dts[i] = dt; das[i] = dt * (-__expf(F.in[IN_ALOG][layer * 16 + h])); }
}
template <bool OUT>
__device__ __forceinline__ void ssd_units(Frame& F, int layer) {
    LAS float* Bs = (LAS float*)F.lds; LAS float* Cs = Bs + 128 * 64; LAS float* dts = Cs + 128 * 64; LAS float* das = dts + 128 * 8; LAS float* ssq = das + 128 * 8;
    const bf16_t* P = (const bf16_t*)(F.ws + WS_P); float* SST = (float*)(F.ws + WS_SST); float* ASUM = (float*)(F.ws + WS_ASUM); bf16_t* YC = (bf16_t*)(F.ws + WS_YCAT);
    const float* cw = F.in[IN_CONVW] + layer * 4 * 1280; const float* cb = F.in[IN_CONVB] + layer * 1280;
    for (int u = F.bid; u < BATCH * SSD_NCH * 2; u += F.G) {
        const int grp = u & 1, ch = (u >> 1) & 31, b = u >> 6;
        __syncthreads();
        ssd_stage_bc(F, layer, b, ch, grp, Bs, Cs, dts, das);
        __syncthreads();
        const int hh = F.wave, h = grp * 8 + hh, p = F.lane, cx = h * 64 + p;
        const float w0 = cw[cx], w1 = cw[1280 + cx], w2 = cw[2560 + cx], w3 = cw[3840 + cx], bias = cb[cx], dsk = F.in[IN_SSDD][layer * 16 + h];
        const int l0 = ch * 128; const size_t row0 = (size_t)b * SEQ + l0;
        const bf16_t* xp = P + row0 * NINP + C_XS + cx;
        float x0 = 0.f, x1 = 0.f, x2 = 0.f;
        if (l0 > 0) { x0 = bf2f(xp[-3 * (ptrdiff_t)NINP]); x1 = bf2f(xp[-2 * (ptrdiff_t)NINP]); x2 = bf2f(xp[-1 * (ptrdiff_t)NINP]); }
        float st[64];
        float* sp = SST + ((((size_t)b * SSD_NCH + ch) * 16 + h) * 64 + p) * 64;
        if (OUT) {
#pragma unroll
            for (int n = 0; n < 64; n += 4) { const f32x4 v = *(const f32x4*)(sp + n); st[n] = v.x; st[n + 1] = v.y; st[n + 2] = v.z; st[n + 3] = v.w; }
        } else {
#pragma unroll
            for (int n = 0; n < 64; ++n) st[n] = 0.f;
        }
        float asum = 0.f;
#pragma unroll 4
        for (int t = 0; t < 128; ++t) {
            const float x3 = bf2f(xp[(size_t)t * NINP]);
            const float xs = siluf_(bias + w0 * x0 + w1 * x1 + w2 * x2 + w3 * x3);
            x0 = x1; x1 = x2; x2 = x3;
            const float dt = dts[t * 8 + hh], a = das[t * 8 + hh], da = __expf(a), xdt = xs * dt;
            asum += a;
            float y = 0.f;
#pragma unroll
            for (int n = 0; n < 64; n += 4) { const f32x4 bv = *(const LAS f32x4*)(Bs + t * 64 + n);
                st[n] = da * st[n] + bv.x * xdt; st[n + 1] = da * st[n + 1] + bv.y * xdt; st[n + 2] = da * st[n + 2] + bv.z * xdt; st[n + 3] = da * st[n + 3] + bv.w * xdt;
                if (OUT) { const f32x4 cv = *(const LAS f32x4*)(Cs + t * 64 + n); y += (cv.x * st[n] + cv.y * st[n + 1]) + (cv.z * st[n + 2] + cv.w * st[n + 3]); } }
            if (OUT) {
                const float z = bf2f(P[(row0 + t) * NINP + C_Z + cx]);
                const float yz = (y + dsk * xs) * siluf_(z);
                const float q = wave_sum(yz * yz);
                if (p == 0) ssq[t * 8 + hh] = q;
                YC[(row0 + t) * 2048 + 1024 + cx] = (bf16_t)f2bf(yz);
            }
        }
        if (!OUT) {
#pragma unroll
            for (int n = 0; n < 64; n += 4) *(f32x4*)(sp + n) = (f32x4){st[n], st[n + 1], st[n + 2], st[n + 3]};
            if (p == 0) ASUM[((size_t)b * SSD_NCH + ch) * 16 + h] = asum;
        } else {
            __syncthreads();
            const float ng = F.in[IN_SSDG][layer * 1024 + cx];
            for (int t = 0; t < 128; ++t) { float q = 0.f;
#pragma unroll
                for (int j = 0; j < 8; ++j) q += ssq[t * 8 + j];
                const float rs = 1.f / sqrtf(q * (1.f / 512.f) + NORM_EPS);
                bf16_t* yp = YC + (row0 + t) * 2048 + 1024 + cx; *yp = (bf16_t)f2bf(bf2f(*yp) * rs * ng); }
        }
    }
}
__device__ __forceinline__ void ssd_scan(Frame& F) {
    float* SST = (float*)(F.ws + WS_SST); const float* ASUM = (const float*)(F.ws + WS_ASUM);
    for (int i = F.bid * NTHR + F.tid; i < BATCH * 16 * 64 * 64; i += F.G * NTHR) {
        const int pn = i & 4095, h = (i >> 12) & 15, b = i >> 16; float s = 0.f;
#pragma unroll 8
        for (int ch = 0; ch < SSD_NCH; ++ch) { const size_t o = (((size_t)b * SSD_NCH + ch) * 16 + h) * 4096 + pn; const float loc = SST[o], dec = __expf(ASUM[((size_t)b * SSD_NCH + ch) * 16 + h]);
            SST[o] = s; s = s * dec + loc; }
    }
}

__device__ __forceinline__ void attn_units(Frame& F, int layer) {
    LAS float* Ks = (LAS float*)F.lds; LAS float* Vs = Ks + 256 * 64;
    const bf16_t* P = (const bf16_t*)(F.ws + WS_P); bf16_t* YC = (bf16_t*)(F.ws + WS_YCAT);
    const float* qg = F.in[IN_QG] + layer * 64; const float* kg = F.in[IN_KG] + layer * 64;
    for (int u = F.bid; u < BATCH * 32 * 2; u += F.G) {
        const int kvh = u & 1, qb = (u >> 1) & 31, b = u >> 6, q0 = qb * 128;
        int lane = F.lane; asm volatile("" : "+v"(lane));
        __syncthreads();
        for (int jr = F.wave; jr < 256; jr += NWAVES) { const int l = q0 - 128 + jr; float kv = 0.f, vv = 0.f;
            if (l >= 0) { const size_t row = (size_t)b * SEQ + l; const float x = bf2f(P[row * NINP + C_K + kvh * 64 + lane]); vv = bf2f(P[row * NINP + C_V + kvh * 64 + lane]);
                const float rs = 1.f / sqrtf(wave_sum(x * x) * (1.f / 64.f) + NORM_EPS); const float xn = x * rs * kg[lane];
                const float other = __shfl_xor(xn, 32); const int i = lane & 31; const float inv = exp2f(-(float)i * (13.287712379549449f / 32.f));
                float s, c; sincos_fast((float)l * inv, s, c);
                kv = (lane < 32) ? (xn * c - other * s) : (xn * c + other * s); }
            Ks[jr * 64 + lane] = kv; Vs[jr * 64 + lane] = vv; }
        __syncthreads();
        const int hh = F.wave >> 1, head = kvh * 4 + hh, qi = q0 + (F.wave & 1) * 64 + lane; const size_t row = (size_t)b * SEQ + qi;
        float q[64];
        { const u32x4* qp = (const u32x4*)(P + row * NINP + C_Q + head * 64); float ss = 0.f;
#pragma unroll
          for (int j = 0; j < 8; ++j) { const u32x4 w = qp[j];
#pragma unroll
              for (int e = 0; e < 4; ++e) { q[8 * j + 2 * e] = bflo(w[e]); q[8 * j + 2 * e + 1] = bfhi(w[e]); } }
#pragma unroll
          for (int d = 0; d < 64; ++d) ss += q[d] * q[d];
          const float rs = 1.f / sqrtf(ss * (1.f / 64.f) + NORM_EPS);
#pragma unroll
          for (int d = 0; d < 64; ++d) q[d] = q[d] * rs * qg[d];
#pragma unroll
          for (int i = 0; i < 32; ++i) { const float inv = exp2f(-(float)i * (13.287712379549449f / 32.f)); float s, c; sincos_fast((float)qi * inv, s, c);
              const float a = q[i], bq = q[i + 32]; q[i] = (a * c - bq * s) * 0.125f; q[i + 32] = (bq * c + a * s) * 0.125f; } }
        float o[64];
#pragma unroll
        for (int d = 0; d < 64; ++d) o[d] = 0.f;
        float mx = F.in[IN_SINK][layer * 8 + head], l = 1.f;
        const int qa = q0 + (F.wave & 1) * 64;
        int jlo = qa - 127 - (q0 - 128); if (q0 == 0 && jlo < 128) jlo = 128; const int jhi = qa + 63 - (q0 - 128);
        for (int jr = jlo; jr <= jhi; ++jr) { const int j = q0 - 128 + jr; const bool ok = (j <= qi) && (qi - j < 128);
            float s = 0.f;
#pragma unroll
            for (int d = 0; d < 64; d += 4) { const f32x4 kv = *(const LAS f32x4*)(Ks + jr * 64 + d); s += (q[d] * kv.x + q[d + 1] * kv.y) + (q[d + 2] * kv.z + q[d + 3] * kv.w); if ((d & 12) == 12) __builtin_amdgcn_sched_barrier(0); }
            if (ok) { const float mn = fmaxf(mx, s), al = __expf(mx - mn), pe = __expf(s - mn); l = l * al + pe; mx = mn;
#pragma unroll
                for (int d = 0; d < 64; d += 4) { const f32x4 vv = *(const LAS f32x4*)(Vs + jr * 64 + d); o[d] = o[d] * al + pe * vv.x; o[d + 1] = o[d + 1] * al + pe * vv.y; o[d + 2] = o[d + 2] * al + pe * vv.z; o[d + 3] = o[d + 3] * al + pe * vv.w; if ((d & 12) == 12) __builtin_amdgcn_sched_barrier(0); } } }
        const float il = 1.f / l; u32x4* op = (u32x4*)(YC + row * 2048 + 512 + head * 64);
#pragma unroll
        for (int j = 0; j < 8; ++j) { u32x4 w; w.x = pk2(o[8 * j] * il, o[8 * j + 1] * il); w.y = pk2(o[8 * j + 2] * il, o[8 * j + 3] * il); w.z = pk2(o[8 * j + 4] * il, o[8 * j + 5] * il); w.w = pk2(o[8 * j + 6] * il, o[8 * j + 7] * il); op[j] = w; }
    }
}

__device__ __forceinline__ void router_phase(Frame& F, int layer) {
    LAS float* Wt = (LAS float*)F.lds;
    const float* wrg = F.in[IN_WRG] + (size_t)layer * 1024 * 4; const float* wre = F.in[IN_WRE] + (size_t)layer * 1024 * 32;
    for (int i = F.tid; i < 1024 * 4; i += NTHR) Wt[(i & 3) * 1024 + (i >> 2)] = wrg[i];
    for (int i = F.tid; i < 1024 * 32; i += NTHR) Wt[(4 + (i & 31)) * 1024 + (i >> 5)] = wre[i];
    __syncthreads();
    const float* X = F.out; const float* gain = F.in[IN_NORM2] + layer * 1024; bf16_t* H2 = (bf16_t*)(F.ws + WS_XN);
    int* EID = (int*)(F.ws + WS_MOE); float* EW = (float*)(F.ws + WS_MOE + 128 * 1024); int* SLOT = (int*)(F.ws + WS_MOE + 256 * 1024);
    unsigned* cnt = F.ctl + CW_CNT + layer * 32;
    const int gw = F.bid * NWAVES + F.wave, NGW = F.G * NWAVES;
    for (int m = gw; m < T; m += NGW) {
        const f32x4* xr = (const f32x4*)(X + (size_t)m * DM) + F.lane; const f32x4* gr = (const f32x4*)gain + F.lane;
        f32x4 v[4]; float s = 0.f;
#pragma unroll
        for (int j = 0; j < 4; ++j) { v[j] = xr[64 * j]; s += (v[j].x * v[j].x + v[j].y * v[j].y) + (v[j].z * v[j].z + v[j].w * v[j].w); }
        const float rstd = 1.f / sqrtf(wave_sum(s) * (1.f / DM) + NORM_EPS);
        unsigned long long* o8 = (unsigned long long*)(H2 + (size_t)m * DM) + F.lane;
#pragma unroll
        for (int j = 0; j < 4; ++j) { const f32x4 gv = gr[64 * j]; v[j].x *= rstd * gv.x; v[j].y *= rstd * gv.y; v[j].z *= rstd * gv.z; v[j].w *= rstd * gv.w;
            o8[64 * j] = (unsigned long long)pk2(v[j].x, v[j].y) | ((unsigned long long)pk2(v[j].z, v[j].w) << 32); }
        float mylog = 0.f;
#pragma unroll 2
        for (int e = 0; e < 36; ++e) { float a = 0.f;
#pragma unroll
            for (int j = 0; j < 4; ++j) { const f32x4 w = *(const LAS f32x4*)(Wt + e * 1024 + 256 * j + 4 * F.lane); a += (v[j].x * w.x + v[j].y * w.y) + (v[j].z * w.z + v[j].w * w.w); }
            a = wave_sum(a); mylog = (F.lane == e) ? a : mylog; }
        float lg4[4];
#pragma unroll
        for (int k = 0; k < 4; ++k) lg4[k] = __shfl(mylog, k);
        float gl[4];
#pragma unroll
        for (int k = 0; k < 4; ++k) gl[k] = lg4[k] + F.in[IN_BRG][layer * 4 + k];
        int gs = 0; float gbest = gl[0];
#pragma unroll
        for (int k = 1; k < 4; ++k) if (gl[k] > gbest) { gbest = gl[k]; gs = k; }
        float elv[8];
#pragma unroll
        for (int k = 0; k < 8; ++k) elv[k] = __shfl(mylog, 4 + gs * 8 + k);
        if (F.lane == 0) {
            float den = 0.f;
#pragma unroll
            for (int k = 0; k < 4; ++k) den += __expf(gl[k] - gbest);
            const float pgrp = 1.f / den;
            float el[8];
#pragma unroll
            for (int k = 0; k < 8; ++k) el[k] = elv[k] + F.in[IN_BRE_][layer * 32 + gs * 8 + k];
            int i0 = 0; float v0 = el[0];
#pragma unroll
            for (int k = 1; k < 8; ++k) if (el[k] > v0) { v0 = el[k]; i0 = k; }
            int i1 = -1; float v1 = -3.0e38f;
#pragma unroll
            for (int k = 0; k < 8; ++k) if (k != i0 && el[k] > v1) { v1 = el[k]; i1 = k; }
            const float e1 = __expf(v1 - v0), w0 = pgrp / (1.f + e1), w1 = pgrp * e1 / (1.f + e1);
            const int ea = gs * 8 + i0, eb = gs * 8 + i1;
            EID[2 * m] = ea; EID[2 * m + 1] = eb; EW[2 * m] = w0; EW[2 * m + 1] = w1;
            SLOT[2 * m] = (int)__hip_atomic_fetch_add(cnt + ea, 1u, __ATOMIC_RELAXED, __HIP_MEMORY_SCOPE_AGENT);
            SLOT[2 * m + 1] = (int)__hip_atomic_fetch_add(cnt + eb, 1u, __ATOMIC_RELAXED, __HIP_MEMORY_SCOPE_AGENT);
        }
    }
}
__device__ __forceinline__ int moe_tables(Frame& F, int layer, volatile LAS int* offs, volatile LAS int* tile_e) {
    __syncthreads();
    if (F.tid == 0) { unsigned* cnt = F.ctl + CW_CNT + layer * 32; int o = 0, nt = 0;
        for (int e = 0; e < 32; ++e) { const int c = (int)__hip_atomic_load(cnt + e, __ATOMIC_RELAXED, __HIP_MEMORY_SCOPE_AGENT); offs[e] = o; const int tl = (c + 255) >> 8; for (int k = 0; k < tl; ++k) tile_e[nt + k] = e; nt += tl; o += tl * 256; }
        offs[32] = nt; }
    __syncthreads();
    return __builtin_amdgcn_readfirstlane(offs[32]);
}
__device__ __forceinline__ void gather_phase(Frame& F, int layer, volatile LAS int* offs) {
    const bf16_t* H2 = (const bf16_t*)(F.ws + WS_XN); bf16_t* XG = (bf16_t*)(F.ws + WS_XG);
    const int* EID = (const int*)(F.ws + WS_MOE); const int* SLOT = (const int*)(F.ws + WS_MOE + 256 * 1024); int* POS = (int*)(F.ws + WS_MOE + 384 * 1024);
    const int gw = F.bid * NWAVES + F.wave, NGW = F.G * NWAVES;
    for (int m = gw; m < T; m += NGW) {
        const u32x4* src = (const u32x4*)(H2 + (size_t)m * DM) + F.lane; const u32x4 a = src[0], b = src[64];
#pragma unroll
        for (int k = 0; k < 2; ++k) { const int pos = offs[EID[2 * m + k]] + SLOT[2 * m + k]; u32x4* dst = (u32x4*)(XG + (size_t)pos * DM) + F.lane; dst[0] = a; dst[64] = b; if (F.lane == 0) POS[2 * m + k] = pos; }
    }
}
__device__ __forceinline__ void combine_phase(Frame& F, const float* gain_next) {
    const bf16_t* Y = (const bf16_t*)(F.ws + WS_YEXP); const float* EW = (const float*)(F.ws + WS_MOE + 128 * 1024); const int* POS = (const int*)(F.ws + WS_MOE + 384 * 1024);
    bf16_t* XN = (bf16_t*)(F.ws + WS_XN);
    const int gw = F.bid * NWAVES + F.wave, NGW = F.G * NWAVES;
    for (int m = gw; m < T; m += NGW) {
        const float w0 = EW[2 * m], w1 = EW[2 * m + 1]; const int p0 = POS[2 * m], p1 = POS[2 * m + 1];
        f32x4* xr = (f32x4*)(F.out + (size_t)m * DM) + F.lane;
        const u32x2* y0 = (const u32x2*)(Y + (size_t)p0 * DM) + F.lane; const u32x2* y1 = (const u32x2*)(Y + (size_t)p1 * DM) + F.lane;
        f32x4 v[4]; float s = 0.f;
#pragma unroll
        for (int j = 0; j < 4; ++j) { v[j] = xr[64 * j]; const u32x2 a = y0[64 * j], b = y1[64 * j];
            v[j].x += w0 * bflo(a.x) + w1 * bflo(b.x); v[j].y += w0 * bfhi(a.x) + w1 * bfhi(b.x); v[j].z += w0 * bflo(a.y) + w1 * bflo(b.y); v[j].w += w0 * bfhi(a.y) + w1 * bfhi(b.y);
            xr[64 * j] = v[j]; s += (v[j].x * v[j].x + v[j].y * v[j].y) + (v[j].z * v[j].z + v[j].w * v[j].w); }
        if (gain_next) { const float rstd = 1.f / sqrtf(wave_sum(s) * (1.f / DM) + NORM_EPS); const f32x4* gr = (const f32x4*)gain_next + F.lane;
            unsigned long long* o8 = (unsigned long long*)(XN + (size_t)m * DM) + F.lane;
#pragma unroll
            for (int j = 0; j < 4; ++j) { const f32x4 gv = gr[64 * j]; o8[64 * j] = (unsigned long long)pk2(v[j].x * rstd * gv.x, v[j].y * rstd * gv.y) | ((unsigned long long)pk2(v[j].z * rstd * gv.z, v[j].w * rstd * gv.w) << 32); } }
    }
}

#ifndef MK_PER_PHASE
#define MK_PER_PHASE 0
#endif
constexpr int NPH = 13;
constexpr int TAB_OFF = 150 * 1024;
struct Args { const float* in[N_INPUTS]; float* out; unsigned char* ws; int gp_lo, gp_hi; };
static_assert(sizeof(Args) == (N_INPUTS + 2) * 8 + 8, "no padding in Args");

#define LAUNDER() do { asm volatile("" : "+s"(F.in), "+s"(F.ws), "+s"(F.out), "+s"(F.ctl), "+s"(F.bid), "+s"(F.G)); asm volatile("" : "+v"(F.tid)); F.lane = F.tid & 63; F.wave = __builtin_amdgcn_readfirstlane(F.tid >> 6); } while (0)
template <int layer>
__device__ __forceinline__ void layer_body(Frame& F, const int lo, const int hi) {
    volatile LAS int* offs = (volatile LAS int*)(F.lds + TAB_OFF); volatile LAS int* tile_e = offs + 64;
    XcdBarrier bar; bar.bar = F.ctl + CW_BAR; bar.x = xb_xcc_id(); bar.st = F.MISC;
#define GP(k) (layer * NPH + (k))
#ifdef ONLY_PH
#define IN(k) (((k) == ONLY_PH) && lo <= GP(k) && GP(k) < hi)
#else
#define IN(k) (lo <= GP(k) && GP(k) < hi)
#endif
#define WSB ((const char*)F.ws)
#define SEAM(k) do { if (!MK_PER_PHASE && IN(k) && GP(k) + 1 < hi) xcd_barrier(bar); } while (0)
        if (IN(0) && layer == 0) { LAUNDER();
            convert_weights(F, 0); __syncthreads(); s5_build(F, 0);
            rmsnorm_rows(F, F.in[IN_X], F.in[IN_NORM1], (bf16_t*)(F.ws + WS_XN));
            SEAM(0);
        }
        if (IN(1)) { LAUNDER();
            SchedDense<2048u, 2048u, T / 256, NINP / 256, 16> S{WSB + WS_XN, WSB + WS_WIN, F.G, F.bid};
            EpiProj E{F.ws, F.in[IN_BGATE] + layer * 3072};
            pg8::gemm_phase<2048u, 2048u>(F.tid, F.lds, S, E);
            SEAM(1);
        }
        if (IN(2)) { LAUNDER();
            SchedS5P1 S{WSB + WS_UH, WSB + WS_EG, F.G, F.bid};
            EpiHloc E{(float*)(F.ws + WS_HLOC)};
            pg8::gemm_phase<(unsigned)(S5_K * 2), 1024u>(F.tid, F.lds, S, E);
            ssd_units<false>(F, layer);
            SEAM(2);
        }
        if (IN(3)) { LAUNDER();
            s5_scan(F, layer);
            ssd_scan(F);
            attn_units(F, layer);
            SEAM(3);
        }
        if (IN(4)) { LAUNDER();
            SchedS5Main S{WSB + WS_UH, WSB + WS_MG, F.G, F.bid};
            EpiS5Y E{(bf16_t*)(F.ws + WS_XN)};
            pg8::gemm_phase<(unsigned)(S5_K * 2), (unsigned)(S5_K * 2)>(F.tid, F.lds, S, E);
            ssd_units<true>(F, layer);
            SEAM(4);
        }
        if (IN(5)) { LAUNDER();
            SchedDense<1024u, 1024u, T / 256, 4, 8> S{WSB + WS_XN, WSB + WS_WGLU, F.G, F.bid};
            EpiGlu E{(bf16_t*)(F.ws + WS_YCAT)};
            pg8::gemm_phase<1024u, 1024u>(F.tid, F.lds, S, E);
            SEAM(5);
        }
        if (IN(6)) { LAUNDER();
            SchedDense<4096u, 4096u, T / 256, 4, 32> S{WSB + WS_YCAT, WSB + WS_PCAT, F.G, F.bid};
            EpiMerged E{F.ws};
            pg8::gemm_phase<4096u, 4096u>(F.tid, F.lds, S, E);
            SEAM(6);
        }
        if (IN(7)) { LAUNDER();
            SchedDense<2048u, 2048u, T / 256, 4, 16> S{WSB + WS_XN, WSB + WS_WOUT, F.G, F.bid};
            EpiResid E{layer == 0 ? F.in[IN_X] : (const float*)F.out, F.out};
            pg8::gemm_phase<2048u, 2048u>(F.tid, F.lds, S, E);
            SEAM(7);
        }
        if (IN(8)) { LAUNDER(); router_phase(F, layer); SEAM(8); }
        if (IN(9)) { LAUNDER(); (void)moe_tables(F, layer, offs, tile_e); gather_phase(F, layer, offs); SEAM(9); }
        if (IN(10)) { LAUNDER();
            const int ntiles = moe_tables(F, layer, offs, tile_e);
            SchedMoe<2048u, (size_t)1024 * 1024 * 2, (size_t)256 * 2048, 16> S{WSB + WS_XG, WSB + WS_EGU, ntiles, F.G, F.bid, tile_e};
            EpiSwiGlu E{(bf16_t*)(F.ws + WS_HID)};
            pg8::gemm_phase<2048u, 2048u>(F.tid, F.lds, S, E);
            SEAM(10);
        }
        if (IN(11)) { LAUNDER();
            const int ntiles = moe_tables(F, layer, offs, tile_e);
            SchedMoe<1024u, (size_t)1024 * 512 * 2, (size_t)256 * 1024, 8> S{WSB + WS_HID, WSB + WS_EDN, ntiles, F.G, F.bid, tile_e};
            EpiPlainBf16 E{(bf16_t*)(F.ws + WS_YEXP)};
            pg8::gemm_phase<1024u, 1024u>(F.tid, F.lds, S, E);
            SEAM(11);
        }
        if (IN(12)) { LAUNDER();
            combine_phase(F, layer + 1 < DEPTH ? F.in[IN_NORM1] + (layer + 1) * 1024 : nullptr);
            if (layer + 1 < DEPTH) { __syncthreads(); convert_weights(F, layer + 1); __syncthreads(); s5_build(F, layer + 1); }
            SEAM(12);
        }
#undef GP
#undef IN
#undef SEAM
#undef WSB
}
__global__ void __launch_bounds__(NTHR, 2) fwd(Args args) {
    extern __shared__ __attribute__((aligned(16))) unsigned char lds_raw[];
    Frame F;
    F.lds = (LAS unsigned char*)lds_raw;
    F.MISC = (volatile LAS unsigned*)(F.lds + MISC_OFF);
    F.tid = threadIdx.x; F.lane = F.tid & 63; F.wave = __builtin_amdgcn_readfirstlane(F.tid >> 6);
    F.G = gridDim.x; F.bid = blockIdx.x;
    const __attribute__((address_space(4))) char* ka = (const __attribute__((address_space(4))) char*)__builtin_amdgcn_kernarg_segment_ptr();
    F.in = (const float* const __attribute__((address_space(4)))*)ka;
    F.out = *(float* const __attribute__((address_space(4)))*)(ka + N_INPUTS * 8); F.ws = *(unsigned char* const __attribute__((address_space(4)))*)(ka + N_INPUTS * 8 + 8); F.ctl = (unsigned*)(F.ws + WS_CTL);
    if (F.tid < 64) F.MISC[F.tid] = 0u;
    __syncthreads();
    XcdBarrier bar; bar.bar = F.ctl + CW_BAR; bar.x = 0; bar.st = nullptr;
    if (!MK_PER_PHASE) bar = xcd_barrier_post(F.ctl + CW_BAR, F.MISC);
    const int lo = *(const __attribute__((address_space(4))) int*)(ka + N_INPUTS * 8 + 16), hi = *(const __attribute__((address_space(4))) int*)(ka + N_INPUTS * 8 + 20);

    layer_body<0>(F, lo, hi);
    layer_body<1>(F, lo, hi);
}

extern "C" void kernel_launch(void* const* d_in, const int* in_sizes, int n_in, void* d_out, int out_size, void* d_ws, size_t ws_size, hipStream_t stream) {
    static int grid = 0;
    if (grid == 0) {
        if (n_in != N_INPUTS || out_size != T * DM || ws_size < WS_END) { fprintf(stderr, "kernel_launch: unexpected shapes (n_in %d out %d ws %zu need %zu)\n", n_in, out_size, ws_size, (size_t)WS_END); grid = -1; return; }
        int dev = 0, cus = 0, per_cu = 0;
        if (hipGetDevice(&dev) != hipSuccess || hipDeviceGetAttribute(&cus, hipDeviceAttributeMultiprocessorCount, dev) != hipSuccess) { grid = -1; return; }
        if (hipFuncSetAttribute((const void*)fwd, hipFuncAttributeMaxDynamicSharedMemorySize, LDS_BYTES) != hipSuccess) { fprintf(stderr, "kernel_launch: hipFuncSetAttribute failed\n"); grid = -1; return; }
        if (hipOccupancyMaxActiveBlocksPerMultiprocessor(&per_cu, (const void*)fwd, NTHR, LDS_BYTES) != hipSuccess || per_cu < 1) fprintf(stderr, "kernel_launch: occupancy query reports %d\n", per_cu);
        (void)hipGetLastError();
        grid = cus;
    }
    if (grid < 0) return;
    (void)hipMemsetAsync((char*)d_ws + WS_CTL, 0, CTL_ZERO_BYTES, stream);
    Args a{};
    for (int i = 0; i < N_INPUTS; ++i) a.in[i] = (const float*)d_in[i];
    a.out = (float*)d_out; a.ws = (unsigned char*)d_ws;
#if MK_PER_PHASE
    for (int gp = 0; gp < DEPTH * NPH; ++gp) {
        if (gp == NPH) continue;
        a.gp_lo = gp; a.gp_hi = gp + 1;
        hipLaunchKernelGGL(fwd, dim3(grid), dim3(NTHR), LDS_BYTES, stream, a);
    }
#else
    a.gp_lo = 0; a.gp_hi = DEPTH * NPH;
    hipLaunchKernelGGL(fwd, dim3(grid), dim3(NTHR), LDS_BYTES, stream, a);
#endif
}
```

```cpp
#include <hip/hip_runtime.h>
#include <cstdio>
#include <cstdint>

#define LAS __attribute__((address_space(3)))
#define GAS __attribute__((address_space(1)))
typedef unsigned short bf16_t;
typedef short bf16x8 __attribute__((ext_vector_type(8)));
typedef float f32x4 __attribute__((ext_vector_type(4)));
typedef float f32x2 __attribute__((ext_vector_type(2)));
typedef unsigned u32x4 __attribute__((ext_vector_type(4)));
typedef unsigned u32x2 __attribute__((ext_vector_type(2)));

constexpr int BATCH = 4, SEQ = 4096, DM = 1024, T = BATCH * SEQ, DEPTH = 2;
constexpr int NIN = 6672, NINP = 6912;
constexpr int C_U = 0, C_Q = 512, C_K = 1024, C_V = 1152, C_Z = 1280, C_XS = 2304, C_B = 3328, C_C = 3456, C_DT = 3584, C_G = 3840;
constexpr int S5_TC = 32, S5_ROWS = T / S5_TC  , S5_K = 128 + S5_TC * 16  , S5_N = S5_TC * 16  ;
constexpr int SSD_NCH = SEQ / 128;
constexpr int MOE_MAXROWS = 2 * T + 32 * 256;
constexpr float NORM_EPS = 1e-6f;

constexpr size_t MiB = 1u << 20;
constexpr size_t WS_CTL = 0, CTL_ZERO_BYTES = 1 * MiB;
constexpr size_t WS_WIN = 1 * MiB;
constexpr size_t WS_WGLU = WS_WIN + (size_t)NINP * DM * 2;
constexpr size_t WS_PCAT = WS_WGLU + 1 * MiB;
constexpr size_t WS_WOUT = WS_PCAT + 4 * MiB;
constexpr size_t WS_EGU = WS_WOUT + 2 * MiB;
constexpr size_t WS_EDN = WS_EGU + 64 * MiB;
constexpr size_t WS_MG = WS_EDN + 32 * MiB;
constexpr size_t WS_EG = WS_MG + 20 * MiB;
constexpr size_t WS_XN = WS_EG + 8 * MiB;
constexpr size_t WS_P = WS_XN + 32 * MiB;
constexpr size_t WS_XG = WS_P;
constexpr size_t WS_HID = WS_XG + (size_t)MOE_MAXROWS * 1024 * 2;
constexpr size_t WS_YEXP = WS_HID + (size_t)MOE_MAXROWS * 512 * 2;
constexpr size_t WS_DT = WS_P + 216 * MiB;
constexpr size_t WS_UH = WS_DT + 1 * MiB;
constexpr size_t WS_HLOC = WS_UH + 20 * MiB;
constexpr size_t WS_YCAT = WS_HLOC + 8 * MiB;
constexpr size_t WS_SST = WS_YCAT + 64 * MiB;
constexpr size_t WS_MOE = WS_SST + 32 * MiB;
constexpr size_t WS_ASUM = WS_MOE + 1 * MiB;
constexpr size_t WS_END = WS_ASUM + 64 * 1024;
static_assert(WS_YEXP + (size_t)MOE_MAXROWS * 1024 * 2 <= WS_DT, "MoE overlay fits in P");
constexpr int CW_BAR = 4096;
constexpr int CW_CNT = 16384;

constexpr int NWAVES = 8, NTHR = 512;
constexpr int LDS_BYTES = 163840;
constexpr int RING_BYTES = 131072;
constexpr int MISC_OFF = 160 * 1024 - 256;

__device__ __forceinline__ unsigned f2bf(float f) { unsigned u = __builtin_bit_cast(unsigned, f); return (u + 0x7fffu + ((u >> 16) & 1u)) >> 16; }
__device__ __forceinline__ unsigned pk2(float lo, float hi) { return f2bf(lo) | (f2bf(hi) << 16); }
__device__ __forceinline__ float bf2f(unsigned b) { return __builtin_bit_cast(float, b << 16); }
__device__ __forceinline__ float bflo(unsigned w) { return __builtin_bit_cast(float, w << 16); }
__device__ __forceinline__ float bfhi(unsigned w) { return __builtin_bit_cast(float, w & 0xffff0000u); }
#define WS_DPP(v, ctrl, rmask) __builtin_bit_cast(float, __builtin_amdgcn_update_dpp(0, __builtin_bit_cast(int, v), ctrl, rmask, 0xF, false))
__device__ __forceinline__ float wave_sum(float v) {
    v += WS_DPP(v, 0xB1, 0xF);
    v += WS_DPP(v, 0x4E, 0xF);
    v += WS_DPP(v, 0x141, 0xF);
    v += WS_DPP(v, 0x140, 0xF);
    v += WS_DPP(v, 0x142, 0xA);
    v += WS_DPP(v, 0x143, 0xC);
    return __builtin_bit_cast(float, __builtin_amdgcn_readlane(__builtin_bit_cast(int, v), 63));
}
__device__ __forceinline__ float sigmoidf_(float x) { return 1.0f / (1.0f + __expf(-x)); }
__device__ __forceinline__ float siluf_(float x) { return x / (1.0f + __expf(-x)); }
__device__ __forceinline__ float gelu_tanh_(float x) { const float u = 0.7978845608f * (x + 0.044715f * x * x * x); return x / (1.0f + __expf(-2.0f * u)); }
__device__ __forceinline__ float softplusf_(float x) { return x > 20.f ? x : log1pf(__expf(x)); }

#define XB_TMO      128
#define XB_XCNT(j)  (256  + 64 * (j))
#define XB_XSUB(j)  (1280 + 64 * (j))
#define XB_XGEN(j)  (2304 + 64 * (j))
#define XB_TOP      3328
#define XB_TOPGEN   3392
#define XCD_BAR_WORDS 3456
#define XB_SPIN_CAP (1u << 18)
__device__ __forceinline__ unsigned xb_ld(unsigned* p)              { return __hip_atomic_load(p, __ATOMIC_RELAXED, __HIP_MEMORY_SCOPE_AGENT); }
__device__ __forceinline__ unsigned xb_add(unsigned* p, unsigned v) { return __hip_atomic_fetch_add(p, v, __ATOMIC_RELAXED, __HIP_MEMORY_SCOPE_AGENT); }
__device__ __forceinline__ unsigned xb_xcc_id() { return (unsigned)__builtin_amdgcn_s_getreg((3 << 11) | 20) & 0xFu; }
#define XB_SPIN(cond, bar) do { unsigned _sp = 0; while (cond) { __builtin_amdgcn_s_sleep(1); \
    if ((++_sp & 255u) == 0u) { if (xb_ld(&(bar)[XB_TMO])) break; if (_sp > XB_SPIN_CAP) { atomicAdd(&(bar)[XB_TMO], 1u); break; } } } } while (0)
struct XcdBarrier { unsigned* bar; unsigned x; volatile LAS unsigned* st; };
__device__ __forceinline__ XcdBarrier xcd_barrier_post(unsigned* bar, volatile LAS unsigned* st) {
    XcdBarrier b; b.bar = bar; b.x = xb_xcc_id(); b.st = st;
    if (threadIdx.x == 0) (void)xb_add(&bar[XB_XCNT(b.x)], 1u);
    return b;
}
__device__ __forceinline__ void xcd_barrier_complete(unsigned* bar, unsigned x, unsigned& nloc, unsigned& nx) {
    const unsigned G = gridDim.x * gridDim.y * gridDim.z;
    unsigned sum, cnt, mine, sp = 0u;
    for (;;) {
        sum = 0u; cnt = 0u; mine = 0u;
#pragma unroll
        for (unsigned j = 0; j < 16; ++j) { const unsigned c = xb_ld(&bar[XB_XCNT(j)]); sum += c; cnt += (c > 0u) ? 1u : 0u; mine = (j == x) ? c : mine; }
        if (sum == G) break;
        __builtin_amdgcn_s_sleep(1);
        if ((++sp & 255u) == 0u) { if (xb_ld(&bar[XB_TMO])) break; if (sp > XB_SPIN_CAP) { atomicAdd(&bar[XB_TMO], 1u); break; } }
    }
    nloc = mine > 0u ? mine : 1u; nx = cnt > 0u ? cnt : 1u;
}
__device__ __forceinline__ void xcd_barrier(const XcdBarrier& b) {
    asm volatile("s_waitcnt vmcnt(0)" ::: "memory");
    __syncthreads();
    if (threadIdx.x == 0) {
        unsigned* bar = b.bar;
        __builtin_amdgcn_s_waitcnt(0);
        unsigned nloc = b.st[0], nx = b.st[1];
        if (nloc == 0u) { xcd_barrier_complete(bar, b.x, nloc, nx); b.st[0] = nloc; b.st[1] = nx; }
        const unsigned old = xb_add(&bar[XB_XSUB(b.x)], 1u);
        const unsigned gen = old / nloc;
        if (old + 1u == (gen + 1u) * nloc) {
            __builtin_amdgcn_fence(__ATOMIC_RELEASE, "agent");
            asm volatile("s_waitcnt vmcnt(0)" ::: "memory");
            const unsigned og = xb_add(&bar[XB_TOP], 1u);
            const unsigned tg = og / nx;
            if (og + 1u == (tg + 1u) * nx) xb_add(&bar[XB_TOPGEN], 1u);
            else XB_SPIN(xb_ld(&bar[XB_TOPGEN]) == tg, bar);
            __builtin_amdgcn_fence(__ATOMIC_ACQUIRE, "agent");
            xb_add(&bar[XB_XGEN(b.x)], 1u);
            asm volatile("s_waitcnt vmcnt(0)" ::: "memory");
        } else {
            XB_SPIN(xb_ld(&bar[XB_XGEN(b.x)]) == gen, bar);
            __builtin_amdgcn_fence(__ATOMIC_ACQUIRE, "agent");
            asm volatile("s_waitcnt vmcnt(0)" ::: "memory");
        }
    }
    __syncthreads();
}

namespace pg8 {
constexpr int BM = 256, BK = 64, HALF = 128, HTB = HALF * BK * 2, STAGE_BYTES = 8 * HTB, NXCD = 8, WGM = 8;
__host__ __device__ __forceinline__ int lds_byte(int r, int c) { const int st = (r >> 4) * 2 + (c >> 5), rr = r & 15, cc = c & 31, ob = rr * 64 + cc * 2; return st * 1024 + (ob ^ (((ob >> 9) & 1) << 5)); }
__host__ __device__ __forceinline__ void stage_rc(int b, int& R, int& C) { const int st = b / 1024, sb = b % 1024, swz = sb ^ (((sb >> 9) & 1) << 5); R = (st >> 1) * 16 + swz / 64; C = (st & 1) * 32 + (swz % 64) / 2; }
__host__ __device__ __forceinline__ int perm32(int rho) { const int n = rho >> 4, i = rho & 15; return 8 * (i >> 2) + 4 * n + (i & 3); }

struct Unit { const char* A; const char* B; int nt; int pm, pn, aux; };

__device__ __forceinline__ void tile_order(int L, int nM, int nN, int& pm, int& pn) {
    const int nwg = nM * nN; int wgid = L;
    { const int q = nwg / NXCD, r = nwg % NXCD, xcd = wgid % NXCD, off = wgid / NXCD; wgid = (xcd < r ? xcd * (q + 1) : r * (q + 1) + (xcd - r) * q) + off; }
    const int nig = WGM * nN, gid = wgid / nig, fm = gid * WGM, gsz = (nM - fm) < WGM ? (nM - fm) : WGM;
    pm = fm + ((wgid % nig) % gsz); pn = (wgid % nig) / gsz;
}
__device__ __forceinline__ unsigned cvt_pk_bf16(float lo, float hi) { unsigned r; asm volatile("v_cvt_pk_bf16_f32 %0, %1, %2" : "=v"(r) : "v"(lo), "v"(hi)); return r; }
__device__ __forceinline__ u32x4 pack8(const f32x4 v0, const f32x4 v1) { u32x4 w; w.x = cvt_pk_bf16(v0[0], v0[1]); w.y = cvt_pk_bf16(v0[2], v0[3]); w.z = cvt_pk_bf16(v1[0], v1[1]); w.w = cvt_pk_bf16(v1[2], v1[3]); return w; }

template <unsigned lda, unsigned ldb, class Epi, class Sched>
__device__ __forceinline__ void gemm_phase(const int tid, LAS unsigned char* lds, const Sched& S, const Epi& E) {
    const int wid = __builtin_amdgcn_readfirstlane(tid >> 6), lane = tid & 63, wr = wid >> 2, wc = wid & 3, fr = lane & 15, fq = lane >> 4;
    unsigned voffA[2], voffB[2];
#pragma unroll
    for (int i = 0; i < 2; ++i) { int R, C; stage_rc(tid * 16 + i * 8192, R, C); const int Rb = Epi::PERM ? ((R & ~31) + perm32(R & 31)) : R;
        voffA[i] = (unsigned)R * lda + (unsigned)C * 2u; voffB[i] = (unsigned)Rb * ldb + (unsigned)C * 2u; }
    const size_t kstep = (size_t)(BK * 2);
    const size_t hstepA = (size_t)HALF * lda, hstepB = (size_t)HALF * ldb;
    const unsigned ldsw = (unsigned)wid * 1024u;
    const int aoff = lds_byte(wr * 64 + fr, fq * 8), boff = lds_byte(wc * 32 + fr, fq * 8);
#define PG8_SA(b, h) (((b) * 2 + (h)) * HTB)
#define PG8_SB(b, h) ((4 + (b) * 2 + (h)) * HTB)
#define PG8_STAGE(bufoff, gbase, voff) do { const char* _gb = (const char*)(gbase); asm volatile("" : "+s"(_gb)); _Pragma("unroll") for (int _i = 0; _i < 2; ++_i) \
        __builtin_amdgcn_global_load_lds((const unsigned*)(_gb + (voff)[_i]), (LAS unsigned*)(lds + (bufoff) + ldsw + _i * 8192), 16, 0, 0); } while (0)
#define PG8_LDA(dst, b, h) do { _Pragma("unroll") for (int m = 0; m < 4; ++m) _Pragma("unroll") for (int k = 0; k < 2; ++k) dst[m][k] = *(const LAS bf16x8*)(lds + PG8_SA(b, h) + aoff + m * 2048 + k * 1024); } while (0)
#define PG8_LDB(dst, b, h) do { _Pragma("unroll") for (int n = 0; n < 2; ++n) _Pragma("unroll") for (int k = 0; k < 2; ++k) dst[n][k] = *(const LAS bf16x8*)(lds + PG8_SB(b, h) + boff + n * 2048 + k * 1024); } while (0)
#define PG8_MMA(ai, bj, At, Bt) do { __builtin_amdgcn_s_setprio(1); _Pragma("unroll") for (int m = 0; m < 4; ++m) _Pragma("unroll") for (int n = 0; n < 2; ++n) _Pragma("unroll") for (int k = 0; k < 2; ++k) \
        acc[ai][bj][m][n] = __builtin_amdgcn_mfma_f32_16x16x32_bf16(Bt[n][k], At[m][k], acc[ai][bj][m][n], 0, 0, 0); __builtin_amdgcn_s_setprio(0); } while (0)
#define PG8_WAIT_V(n) asm volatile("s_waitcnt vmcnt(" #n ")" ::: "memory")
#define PG8_WAIT_L(n) asm volatile("s_waitcnt lgkmcnt(" #n ")" ::: "memory")
#define PG8_BAR __builtin_amdgcn_s_barrier()
#define PG8_SCHED __builtin_amdgcn_sched_barrier(0)
    Unit cur, nxt; int ui = 0;
    if (!S.next(0, cur)) return;
    f32x4 acc[2][2][4][2];
#pragma unroll
    for (int a = 0; a < 2; ++a)
#pragma unroll
        for (int b = 0; b < 2; ++b)
#pragma unroll
            for (int m = 0; m < 4; ++m)
#pragma unroll
                for (int n = 0; n < 2; ++n) acc[a][b][m][n] = (f32x4){0.f, 0.f, 0.f, 0.f};
    bf16x8 At[4][2], B0[2][2], B1[2][2];
    const char* cA = cur.A; const char* cB = cur.B;
    PG8_STAGE(PG8_SB(0, 0), cB, voffB); PG8_STAGE(PG8_SB(0, 1), cB + hstepB, voffB); PG8_STAGE(PG8_SA(0, 0), cA, voffA); PG8_STAGE(PG8_SA(0, 1), cA + hstepA, voffA);
    if (wr == 1) PG8_BAR;
    PG8_WAIT_V(2); PG8_BAR;
    PG8_STAGE(PG8_SB(1, 0), cB + kstep, voffB); PG8_STAGE(PG8_SA(1, 0), cA + kstep, voffA); PG8_STAGE(PG8_SB(1, 1), cB + hstepB + kstep, voffB);
    PG8_WAIT_V(6); PG8_BAR;
    for (;;) {
        const bool has_next = S.next(ui + 1, nxt);
        const char* nA = has_next ? nxt.A : cA; const char* nB = has_next ? nxt.B : cB;
        const int nt = cur.nt;
        for (int t = 0; t < nt; t += 2) {
            const bool last = (t == nt - 2);
            const char* a1 = cA + (size_t)(t + 1) * kstep;
            const char* a2 = last ? nA : cA + (size_t)(t + 2) * kstep; const char* b2 = last ? nB : cB + (size_t)(t + 2) * kstep;
            const char* a3 = a2 + kstep; const char* b3 = b2 + kstep;
            PG8_LDB(B0, 0, 0); PG8_LDB(B1, 0, 1); PG8_SCHED; PG8_LDA(At, 0, 0); PG8_STAGE(PG8_SA(1, 1), a1 + hstepA, voffA);
            PG8_WAIT_V(8); PG8_WAIT_L(0); PG8_BAR; PG8_MMA(0, 0, At, B0); PG8_MMA(0, 1, At, B1); PG8_BAR; PG8_SCHED;
            PG8_LDA(At, 0, 1); PG8_STAGE(PG8_SB(0, 0), b2, voffB); PG8_STAGE(PG8_SB(0, 1), b2 + hstepB, voffB); PG8_STAGE(PG8_SA(0, 0), a2, voffA);
            PG8_WAIT_V(8); PG8_WAIT_L(0); PG8_BAR; PG8_MMA(1, 0, At, B0); PG8_MMA(1, 1, At, B1); PG8_BAR; PG8_SCHED;
            PG8_LDB(B0, 1, 0); PG8_LDB(B1, 1, 1); PG8_SCHED; PG8_LDA(At, 1, 0); PG8_STAGE(PG8_SA(0, 1), a2 + hstepA, voffA);
            PG8_WAIT_V(8); PG8_WAIT_L(0); PG8_BAR; PG8_MMA(0, 0, At, B0); PG8_MMA(0, 1, At, B1); PG8_BAR; PG8_SCHED;
            PG8_LDA(At, 1, 1); PG8_STAGE(PG8_SB(1, 0), b3, voffB); PG8_STAGE(PG8_SB(1, 1), b3 + hstepB, voffB); PG8_STAGE(PG8_SA(1, 0), a3, voffA);
            PG8_WAIT_V(8); PG8_WAIT_L(0); PG8_BAR; PG8_MMA(1, 0, At, B0); PG8_MMA(1, 1, At, B1); PG8_BAR; PG8_SCHED;
            if constexpr (Epi::HAS_MID) { if (t + 2 == 8 || t + 2 == 16) { E.mid(acc, cur, t + 2, wr, wc, fr, fq); PG8_SCHED; } }
        }
        if (wr == 0) PG8_BAR;
        E(acc, cur, wr, wc, fr, fq);
        if (!has_next) break;
#pragma unroll
        for (int a = 0; a < 2; ++a)
#pragma unroll
            for (int b = 0; b < 2; ++b)
#pragma unroll
                for (int m = 0; m < 4; ++m)
#pragma unroll
                    for (int n = 0; n < 2; ++n) acc[a][b][m][n] = (f32x4){0.f, 0.f, 0.f, 0.f};
        cur = nxt; cA = nA; cB = nB; ++ui;
        if (wr == 1) PG8_BAR;
    }
    PG8_WAIT_V(0);
    PG8_BAR;
#undef PG8_SA
#undef PG8_SB
#undef PG8_STAGE
#undef PG8_LDA
#undef PG8_LDB
#undef PG8_MMA
#undef PG8_WAIT_V
#undef PG8_WAIT_L
#undef PG8_BAR
#undef PG8_SCHED
}
}

struct Frame {
    LAS unsigned char* lds;
    volatile LAS unsigned* MISC;
    unsigned* ctl;
    int tid, lane, wave, G, bid;
    const float* const __attribute__((address_space(4)))* in;
    float* out; unsigned char* ws;
};
enum { IN_X = 0, IN_NORM1, IN_WIN, IN_BGATE, IN_LRE, IN_LIM, IN_BRE, IN_BIM, IN_CRE, IN_CIM, IN_S5D, IN_LOGDT, IN_GLU1, IN_GLU2, IN_QG, IN_KG, IN_SINK,
       IN_CONVW, IN_CONVB, IN_DTB, IN_ALOG, IN_SSDD, IN_SSDG, IN_PS5, IN_PATTN, IN_PSSD, IN_WOUT, IN_NORM2, IN_WRG, IN_BRG, IN_WRE, IN_BRE_, IN_EG, IN_EU, IN_ED, N_INPUTS };

#define LDS_WAIT() asm volatile("s_waitcnt lgkmcnt(0)" ::: "memory")
#define VM_WAIT() asm volatile("s_waitcnt vmcnt(0)" ::: "memory")

using pg8::Unit; using pg8::pack8;
struct EpiProj {
    static constexpr bool PERM = true, HAS_MID = false;
    unsigned char* ws; const float* bgate;
    __device__ __forceinline__ void operator()(const f32x4 (&acc)[2][2][4][2], const Unit& u, int wr, int wc, int fr, int fq) const {
        bf16_t* P = (bf16_t*)(ws + WS_P); bf16_t* UH = (bf16_t*)(ws + WS_UH); float* DT = (float*)(ws + WS_DT);
        const int row0 = u.pm * 256 + wr * 64 + fr;
        if (u.pn < 2) {
#pragma unroll
            for (int ai = 0; ai < 2; ++ai)
#pragma unroll
                for (int m = 0; m < 4; ++m) { const int row = row0 + ai * 128 + m * 16, r = row >> 5, s = row & 31;
#pragma unroll
                    for (int bj = 0; bj < 2; ++bj) { const int col = u.pn * 256 + bj * 128 + wc * 32 + 8 * fq, g = col >> 4, c0 = col & 15;
                        *(u32x4*)(UH + ((size_t)(g * S5_ROWS + r) * S5_K + 128 + s * 16 + c0)) = pack8(acc[ai][bj][m][0], acc[ai][bj][m][1]); } }
        } else {
            const int colb = u.pn * 256 + wc * 32 + 8 * fq;
            f32x4 bv[2][2];
#pragma unroll
            for (int bj = 0; bj < 2; ++bj)
#pragma unroll
                for (int n = 0; n < 2; ++n) bv[bj][n] = (u.pn >= 15) ? *(const f32x4*)(bgate + (colb - C_G) + bj * 128 + 4 * n) : (f32x4){0.f, 0.f, 0.f, 0.f};
#pragma unroll
            for (int ai = 0; ai < 2; ++ai)
#pragma unroll
                for (int m = 0; m < 4; ++m) { const int row = row0 + ai * 128 + m * 16;
#pragma unroll
                    for (int bj = 0; bj < 2; ++bj) *(u32x4*)(P + (size_t)row * NINP + colb + bj * 128) = pack8(acc[ai][bj][m][0] + bv[bj][0], acc[ai][bj][m][1] + bv[bj][1]);
                    if (u.pn == 14 && wc == 0 && fq < 2) { float* d = DT + (size_t)row * 16 + 8 * fq; *(f32x4*)d = acc[ai][0][m][0]; *(f32x4*)(d + 4) = acc[ai][0][m][1]; } }
        }
    }
};
struct EpiHloc {
    static constexpr bool PERM = false, HAS_MID = false;
    float* H;
    __device__ __forceinline__ void operator()(const f32x4 (&acc)[2][2][4][2], const Unit& u, int wr, int wc, int fr, int fq) const {
#pragma unroll
        for (int ai = 0; ai < 2; ++ai)
#pragma unroll
            for (int m = 0; m < 4; ++m) { const int r = u.pm * 256 + ai * 128 + wr * 64 + m * 16 + fr; float* rowp = H + ((size_t)(u.aux * S5_ROWS + r) * 128) + wc * 32 + 4 * fq;
#pragma unroll
                for (int n = 0; n < 2; ++n) *(f32x4*)(rowp + 16 * n) = acc[ai][0][m][n]; }
    }
};
struct EpiS5Y {
    static constexpr bool PERM = true, HAS_MID = false;
    bf16_t* Y;
    __device__ __forceinline__ void operator()(const f32x4 (&acc)[2][2][4][2], const Unit& u, int wr, int wc, int fr, int fq) const {
#pragma unroll
        for (int ai = 0; ai < 2; ++ai)
#pragma unroll
            for (int m = 0; m < 4; ++m) { const int r = u.pm * 256 + ai * 128 + wr * 64 + m * 16 + fr;
#pragma unroll
                for (int bj = 0; bj < 2; ++bj) { const int n0 = u.pn * 256 + bj * 128 + wc * 32 + 8 * fq, t = n0 >> 4, c0 = n0 & 15;
                    f32x4 v0 = acc[ai][bj][m][0], v1 = acc[ai][bj][m][1];
#pragma unroll
                    for (int j = 0; j < 4; ++j) { v0[j] = gelu_tanh_(v0[j]); v1[j] = gelu_tanh_(v1[j]); }
                    *(u32x4*)(Y + ((size_t)(r * S5_TC + t) * 512 + u.aux * 16 + c0)) = pack8(v0, v1); } }
    }
};
struct EpiGlu {
    static constexpr bool PERM = true, HAS_MID = false;
    bf16_t* Y;
    __device__ __forceinline__ void operator()(const f32x4 (&acc)[2][2][4][2], const Unit& u, int wr, int wc, int fr, int fq) const {
#pragma unroll
        for (int ai = 0; ai < 2; ++ai)
#pragma unroll
            for (int m = 0; m < 4; ++m) { const int row = u.pm * 256 + ai * 128 + wr * 64 + m * 16 + fr;
                f32x4 v0 = acc[ai][0][m][0], v1 = acc[ai][0][m][1]; const f32x4 g0 = acc[ai][1][m][0], g1 = acc[ai][1][m][1];
#pragma unroll
                for (int j = 0; j < 4; ++j) { v0[j] *= sigmoidf_(g0[j]); v1[j] *= sigmoidf_(g1[j]); }
                *(u32x4*)(Y + (size_t)row * 2048 + u.pn * 128 + wc * 32 + 8 * fq) = pack8(v0, v1); }
    }
};
struct EpiSwiGlu {
    static constexpr bool PERM = true, HAS_MID = false;
    bf16_t* Y;
    __device__ __forceinline__ void operator()(const f32x4 (&acc)[2][2][4][2], const Unit& u, int wr, int wc, int fr, int fq) const {
#pragma unroll
        for (int ai = 0; ai < 2; ++ai)
#pragma unroll
            for (int m = 0; m < 4; ++m) { const int row = u.pm * 256 + ai * 128 + wr * 64 + m * 16 + fr;
                f32x4 v0 = acc[ai][0][m][0], v1 = acc[ai][0][m][1]; const f32x4 g0 = acc[ai][1][m][0], g1 = acc[ai][1][m][1];
#pragma unroll
                for (int j = 0; j < 4; ++j) { v0[j] = siluf_(v0[j]) * g0[j]; v1[j] = siluf_(v1[j]) * g1[j]; }
                *(u32x4*)(Y + (size_t)row * 512 + u.pn * 128 + wc * 32 + 8 * fq) = pack8(v0, v1); }
    }
};
struct EpiPlainBf16 {
    static constexpr bool PERM = true, HAS_MID = false;
    bf16_t* O;
    __device__ __forceinline__ void operator()(const f32x4 (&acc)[2][2][4][2], const Unit& u, int wr, int wc, int fr, int fq) const {
#pragma unroll
        for (int ai = 0; ai < 2; ++ai)
#pragma unroll
            for (int m = 0; m < 4; ++m) { const int row = u.pm * 256 + ai * 128 + wr * 64 + m * 16 + fr;
#pragma unroll
                for (int bj = 0; bj < 2; ++bj) *(u32x4*)(O + (size_t)row * 1024 + u.pn * 256 + bj * 128 + wc * 32 + 8 * fq) = pack8(acc[ai][bj][m][0], acc[ai][bj][m][1]); }
    }
};
struct EpiMerged {
    static constexpr bool PERM = true, HAS_MID = true;
    unsigned char* ws;
    __device__ __forceinline__ static float lclamp(float l) { return fminf(fmaxf(l, -30.f), 30.f); }
    __device__ __forceinline__ void mid(f32x4 (&acc)[2][2][4][2], const Unit& u, int kt, int wr, int wc, int fr, int fq) const {
        const int br = (kt == 8) ? 0 : 1; const bf16_t* P = (const bf16_t*)(ws + WS_P);
#pragma unroll
        for (int ai = 0; ai < 2; ++ai)
#pragma unroll
            for (int m = 0; m < 4; ++m) { const int row = u.pm * 256 + ai * 128 + wr * 64 + m * 16 + fr;
#pragma unroll
                for (int bj = 0; bj < 2; ++bj) { const bf16_t* gp = P + (size_t)row * NINP + C_G + br * 1024 + u.pn * 256 + bj * 128 + wc * 32 + 8 * fq;
                    const u32x4 la = *(const u32x4*)gp, lb = *(const u32x4*)(gp + 1024);
#pragma unroll
                    for (int j = 0; j < 4; ++j) { const unsigned wa = la[j], wb = lb[j];
                        const float r0 = (1.f + __expf(-lclamp(bflo(wb)))) / (1.f + __expf(-lclamp(bflo(wa)))), r1 = (1.f + __expf(-lclamp(bfhi(wb)))) / (1.f + __expf(-lclamp(bfhi(wa))));
                        if (j < 2) { acc[ai][bj][m][0][2 * j] *= r0; acc[ai][bj][m][0][2 * j + 1] *= r1; } else { acc[ai][bj][m][1][2 * j - 4] *= r0; acc[ai][bj][m][1][2 * j - 3] *= r1; } } }
                asm volatile("" ::: "memory"); }
    }
    __device__ __forceinline__ void operator()(const f32x4 (&acc)[2][2][4][2], const Unit& u, int wr, int wc, int fr, int fq) const {
        const bf16_t* P = (const bf16_t*)(ws + WS_P); bf16_t* O = (bf16_t*)(ws + WS_XN);
#pragma unroll
        for (int ai = 0; ai < 2; ++ai)
#pragma unroll
            for (int m = 0; m < 4; ++m) { const int row = u.pm * 256 + ai * 128 + wr * 64 + m * 16 + fr;
#pragma unroll
                for (int bj = 0; bj < 2; ++bj) { const int col = u.pn * 256 + bj * 128 + wc * 32 + 8 * fq;
                    const u32x4 lc = *(const u32x4*)(P + (size_t)row * NINP + C_G + 2048 + col);
                    f32x4 v0 = acc[ai][bj][m][0], v1 = acc[ai][bj][m][1];
                    v0[0] *= sigmoidf_(lclamp(bflo(lc[0]))); v0[1] *= sigmoidf_(lclamp(bfhi(lc[0]))); v0[2] *= sigmoidf_(lclamp(bflo(lc[1]))); v0[3] *= sigmoidf_(lclamp(bfhi(lc[1])));
                    v1[0] *= sigmoidf_(lclamp(bflo(lc[2]))); v1[1] *= sigmoidf_(lclamp(bfhi(lc[2]))); v1[2] *= sigmoidf_(lclamp(bflo(lc[3]))); v1[3] *= sigmoidf_(lclamp(bfhi(lc[3])));
                    *(u32x4*)(O + (size_t)row * 1024 + col) = pack8(v0, v1); }
                asm volatile("" ::: "memory"); }
    }
};
struct EpiResid {
    static constexpr bool PERM = false, HAS_MID = false;
    const float* resid; float* out;
    __device__ __forceinline__ void operator()(const f32x4 (&acc)[2][2][4][2], const Unit& u, int wr, int wc, int fr, int fq) const {
#pragma unroll
        for (int ai = 0; ai < 2; ++ai)
#pragma unroll
            for (int m = 0; m < 4; ++m) { const size_t off = (size_t)(u.pm * 256 + ai * 128 + wr * 64 + m * 16 + fr) * 1024 + u.pn * 256 + wc * 32 + 4 * fq;
#pragma unroll
                for (int bj = 0; bj < 2; ++bj)
#pragma unroll
                    for (int n = 0; n < 2; ++n) { const f32x4 rv = *(const f32x4*)(resid + off + bj * 128 + n * 16); *(f32x4*)(out + off + bj * 128 + n * 16) = rv + acc[ai][bj][m][n]; } }
    }
};

template <unsigned lda, unsigned ldb, int nM, int nN, int NT>
struct SchedDense {
    const char* A; const char* B; int G, c;
    __device__ __forceinline__ bool next(int i, Unit& u) const {
        const int L = i * G + c; if (L >= nM * nN) return false;
        int pm, pn; pg8::tile_order(L, nM, nN, pm, pn);
        u.A = A + (size_t)pm * 256 * lda; u.B = B + (size_t)pn * 256 * ldb; u.nt = NT; u.pm = pm; u.pn = pn; u.aux = 0; return true;
    }
};
struct SchedS5P1 {
    const char* UH; const char* EG; int G, c;
    __device__ __forceinline__ bool next(int i, Unit& u) const {
        const int L = i * G + c; if (L >= 64) return false;
        const int g = L >> 1, pm = L & 1;
        u.A = UH + ((size_t)(g * S5_ROWS + pm * 256) * S5_K + 128) * 2; u.B = EG + (size_t)g * 256 * 512 * 2; u.nt = 8; u.pm = pm; u.pn = 0; u.aux = g; return true;
    }
};
struct SchedS5Main {
    const char* UH; const char* MG; int G, c;
    __device__ __forceinline__ bool next(int i, Unit& u) const {
        const int L = i * G + c; if (L >= 128) return false;
        const int g = L >> 2, pm = (L >> 1) & 1, pn = L & 1;
        u.A = UH + (size_t)(g * S5_ROWS + pm * 256) * S5_K * 2; u.B = MG + (size_t)(g * S5_N + pn * 256) * S5_K * 2; u.nt = 2 + 4 * (pn + 1); u.pm = pm; u.pn = pn; u.aux = g; return true;
    }
};
template <unsigned lda, size_t bexp  , size_t btile  , int NT>
struct SchedMoe {
    const char* A; const char* B; int ntiles, G, c; const volatile LAS int* tile_e;
    __device__ __forceinline__ bool next(int i, Unit& u) const {
        const int L = i * G + c; if (L >= ntiles * 4) return false;
        int pm, pn; pg8::tile_order(L, ntiles, 4, pm, pn);
        const int e = __builtin_amdgcn_readfirstlane(tile_e[pm]);
        u.A = A + (size_t)pm * 256 * lda; u.B = B + (size_t)e * bexp + (size_t)pn * btile; u.nt = NT; u.pm = pm; u.pn = pn; u.aux = e; return true;
    }
};

__device__ __forceinline__ void transpose_item(const float* W, int ldw, int ncols, bf16_t* WT, int ldt, int kofs, int mode, int p0, int p1, LAS float* scr, int k0, int n0, int lane) {
#pragma unroll 8
    for (int i = 0; i < 32; ++i) { const int kk = 2 * i + (lane >> 5), n = n0 + (lane & 31); scr[kk * 33 + (lane & 31)] = (n < ncols) ? W[(size_t)(k0 + kk) * ldw + n] : 0.f; }
    LDS_WAIT(); asm volatile("" ::: "memory");
    const int c = lane & 7;
#pragma unroll
    for (int j = 0; j < 4; ++j) { const int nn = (lane >> 3) + 8 * j, n = n0 + nn; const LAS float* s = scr + (8 * c) * 33 + nn;
        u32x4 o; o.x = pk2(s[0 * 33], s[1 * 33]); o.y = pk2(s[2 * 33], s[3 * 33]); o.z = pk2(s[4 * 33], s[5 * 33]); o.w = pk2(s[6 * 33], s[7 * 33]);
        const int drow = (mode == 0) ? n + (n >= p0 ? p1 : 0) : ((n >> 7) * 256 + (n & 127) + 128 * p0);
        if (n < ncols) *(u32x4*)(WT + (size_t)drow * ldt + kofs + k0 + 8 * c) = o; }
    LDS_WAIT(); asm volatile("" ::: "memory");
}
__device__ __forceinline__ void convert_weights(Frame& F, int layer) {
    LAS float* scr = (LAS float*)(F.lds + F.wave * 16384);
    const int gw = F.bid * NWAVES + F.wave, NGW = F.G * NWAVES;
    bf16_t* WIN = (bf16_t*)(F.ws + WS_WIN); bf16_t* WGLU = (bf16_t*)(F.ws + WS_WGLU); bf16_t* PCAT = (bf16_t*)(F.ws + WS_PCAT); bf16_t* WOUT = (bf16_t*)(F.ws + WS_WOUT);
    bf16_t* EGU = (bf16_t*)(F.ws + WS_EGU); bf16_t* EDN = (bf16_t*)(F.ws + WS_EDN);
    constexpr int I_WIN = 16 * 209, I_GLU = 8 * 16, I_P5 = 8 * 32, I_PS = 16 * 32, I_WO = 16 * 32, I_EG = 32 * 256, I_ED = 32 * 256;
    constexpr int NITEMS = I_WIN + 2 * I_GLU + 2 * I_P5 + I_PS + I_WO + 2 * I_EG + I_ED;
    for (int it = gw; it < NITEMS; it += NGW) {
        int r = it;
        if (r < I_WIN) { transpose_item(F.in[IN_WIN] + (size_t)layer * DM * NIN, NIN, NIN, WIN, DM, 0, 0, 3600, 240, scr, 64 * (r / 209), 32 * (r % 209), F.lane); continue; } r -= I_WIN;
        if (r < I_GLU) { transpose_item(F.in[IN_GLU1] + (size_t)layer * 512 * 512, 512, 512, WGLU, 512, 0, 1, 0, 0, scr, 64 * (r / 16), 32 * (r % 16), F.lane); continue; } r -= I_GLU;
        if (r < I_GLU) { transpose_item(F.in[IN_GLU2] + (size_t)layer * 512 * 512, 512, 512, WGLU, 512, 0, 1, 1, 0, scr, 64 * (r / 16), 32 * (r % 16), F.lane); continue; } r -= I_GLU;
        if (r < I_P5) { transpose_item(F.in[IN_PS5] + (size_t)layer * 512 * 1024, 1024, 1024, PCAT, 2048, 0, 0, 1 << 30, 0, scr, 64 * (r / 32), 32 * (r % 32), F.lane); continue; } r -= I_P5;
        if (r < I_P5) { transpose_item(F.in[IN_PATTN] + (size_t)layer * 512 * 1024, 1024, 1024, PCAT, 2048, 512, 0, 1 << 30, 0, scr, 64 * (r / 32), 32 * (r % 32), F.lane); continue; } r -= I_P5;
        if (r < I_PS) { transpose_item(F.in[IN_PSSD] + (size_t)layer * 1024 * 1024, 1024, 1024, PCAT, 2048, 1024, 0, 1 << 30, 0, scr, 64 * (r / 32), 32 * (r % 32), F.lane); continue; } r -= I_PS;
        if (r < I_WO) { transpose_item(F.in[IN_WOUT] + (size_t)layer * 1024 * 1024, 1024, 1024, WOUT, 1024, 0, 0, 1 << 30, 0, scr, 64 * (r / 32), 32 * (r % 32), F.lane); continue; } r -= I_WO;
        if (r < I_EG) { const int e = r >> 8, q = r & 255; transpose_item(F.in[IN_EG] + ((size_t)layer * 32 + e) * 1024 * 512, 512, 512, EGU + (size_t)e * 1024 * 1024, 1024, 0, 1, 0, 0, scr, 64 * (q / 16), 32 * (q % 16), F.lane); continue; } r -= I_EG;
        if (r < I_EG) { const int e = r >> 8, q = r & 255; transpose_item(F.in[IN_EU] + ((size_t)layer * 32 + e) * 1024 * 512, 512, 512, EGU + (size_t)e * 1024 * 1024, 1024, 0, 1, 1, 0, scr, 64 * (q / 16), 32 * (q % 16), F.lane); continue; } r -= I_EG;
        { const int e = r >> 8, q = r & 255; transpose_item(F.in[IN_ED] + ((size_t)layer * 32 + e) * 512 * 1024, 1024, 1024, EDN + (size_t)e * 1024 * 512, 512, 0, 0, 1 << 30, 0, scr, 64 * (q / 32), 32 * (q % 32), F.lane); }
    }
}
__device__ __forceinline__ void sincos_fast(float x, float& s, float& c) {
    const float k = rintf(x * 0.15915494309189535f);
    float r = fmaf(-k, 6.2831854820251465f, x); r = fmaf(-k, -1.7484555e-07f, r);
    s = __sinf(r); c = __cosf(r);
}
__device__ __forceinline__ void sincos_red(float x, float& s, float& c) {
    const float k = rintf(x * 0.15915494309189535f);
    float r = fmaf(-k, 6.2831854820251465f, x); r = fmaf(-k, -1.7484555e-07f, r);
    s = sinf(r); c = cosf(r);
}
__device__ __forceinline__ void s5_build(Frame& F, int layer) {
    LAS float* pw = (LAS float*)F.lds;
    LAS float* Bb = pw + 33 * 64 * 2;
    LAS float* Cc = Bb + 64 * 16 * 2;
    LAS float* Kd = Cc + 16 * 64 * 2;
    bf16_t* MG = (bf16_t*)(F.ws + WS_MG); bf16_t* EG = (bf16_t*)(F.ws + WS_EG);
    for (int w = F.bid; w < 256; w += F.G) {
        const int g = w >> 3, part = w & 7, gi = layer * 32 + g;
        __syncthreads();
        const float dt = __expf(F.in[IN_LOGDT][gi]);
        for (int i = F.tid; i < 33 * 64; i += NTHR) { const int d = i >> 6, p = i & 63; const float lr = F.in[IN_LRE][gi * 64 + p], li = F.in[IN_LIM][gi * 64 + p];
            float s, c; sincos_red((float)d * li * dt, s, c); const float mg = __expf((float)d * lr * dt); pw[2 * i] = mg * c; pw[2 * i + 1] = mg * s; }
        for (int i = F.tid; i < 64 * 16; i += NTHR) { const int p = i >> 4; const float lr = F.in[IN_LRE][gi * 64 + p], li = F.in[IN_LIM][gi * 64 + p];
            float s, c; sincos_red(li * dt, s, c); const float mg = __expf(lr * dt), are = mg * c, aim = mg * s, nr = are - 1.f, den = lr * lr + li * li;
            const float fre = (nr * lr + aim * li) / den, fim = (aim * lr - nr * li) / den;
            const float br = F.in[IN_BRE][(size_t)gi * 1024 + i], bi = F.in[IN_BIM][(size_t)gi * 1024 + i];
            Bb[2 * i] = fre * br - fim * bi; Bb[2 * i + 1] = fre * bi + fim * br; }
        for (int i = F.tid; i < 16 * 64; i += NTHR) { Cc[2 * i] = F.in[IN_CRE][(size_t)gi * 1024 + i]; Cc[2 * i + 1] = F.in[IN_CIM][(size_t)gi * 1024 + i]; }
        __syncthreads();
        for (int i = F.tid; i < 32 * 256; i += NTHR) { const int d = i >> 8, c = (i >> 4) & 15, c2 = i & 15; float acc = 0.f;
            for (int p = 0; p < 64; ++p) { const float cr = Cc[2 * (c * 64 + p)], ci = Cc[2 * (c * 64 + p) + 1], pr = pw[2 * (d * 64 + p)], pi = pw[2 * (d * 64 + p) + 1];
                const float xr = cr * pr - ci * pi, xi = cr * pi + ci * pr; acc += xr * Bb[2 * (p * 16 + c2)] - xi * Bb[2 * (p * 16 + c2) + 1]; }
            Kd[i] = acc; }
        __syncthreads();
        for (int v = F.tid; v < 64 * 80; v += NTHR) { const int n = part * 64 + v / 80, k0 = (v % 80) * 8, t = n >> 4, c = n & 15; float o[8];
            if (k0 < 128) { const int im = k0 >= 64, p0 = k0 & 63;
#pragma unroll
                for (int j = 0; j < 8; ++j) { const int p = p0 + j; const float cr = Cc[2 * (c * 64 + p)], ci = Cc[2 * (c * 64 + p) + 1], pr = pw[2 * ((t + 1) * 64 + p)], pi = pw[2 * ((t + 1) * 64 + p) + 1];
                    o[j] = im ? -(cr * pi + ci * pr) : (cr * pr - ci * pi); }
            } else { const int s = (k0 - 128) >> 4, c0 = (k0 - 128) & 15;
#pragma unroll
                for (int j = 0; j < 8; ++j) { float x = 0.f; if (s <= t) { x = Kd[(t - s) * 256 + c * 16 + c0 + j]; if (s == t && c == c0 + j) x += F.in[IN_S5D][layer * 512 + g * 16 + c]; } o[j] = x; } }
            u32x4 q; q.x = pk2(o[0], o[1]); q.y = pk2(o[2], o[3]); q.z = pk2(o[4], o[5]); q.w = pk2(o[6], o[7]);
            *(u32x4*)(MG + ((size_t)(g * S5_N + n) * S5_K + k0)) = q; }
        for (int v = F.tid; v < 16 * 64; v += NTHR) { const int jr = part * 16 + v / 64, k0 = (v % 64) * 8, im = jr >= 64, p = jr & 63, s = k0 >> 4, c0 = k0 & 15; float o[8];
            const float pr = pw[2 * ((S5_TC - 1 - s) * 64 + p)], pi = pw[2 * ((S5_TC - 1 - s) * 64 + p) + 1];
#pragma unroll
            for (int j = 0; j < 8; ++j) { const float br = Bb[2 * (p * 16 + c0 + j)], bi = Bb[2 * (p * 16 + c0 + j) + 1]; o[j] = im ? (pr * bi + pi * br) : (pr * br - pi * bi); }
            u32x4 q; q.x = pk2(o[0], o[1]); q.y = pk2(o[2], o[3]); q.z = pk2(o[4], o[5]); q.w = pk2(o[6], o[7]);
            *(u32x4*)(EG + ((size_t)(g * 256 + jr) * 512 + k0)) = q; }
    }
    __syncthreads();
}
__device__ __forceinline__ void rms_row_to_bf16(const float* xrow, const float* gain, bf16_t* orow, int lane) {
    const f32x4* xr = (const f32x4*)xrow + lane; const f32x4* gr = (const f32x4*)gain + lane;
    f32x4 v[4]; float s = 0.f;
#pragma unroll
    for (int j = 0; j < 4; ++j) { v[j] = xr[64 * j]; s += (v[j].x * v[j].x + v[j].y * v[j].y) + (v[j].z * v[j].z + v[j].w * v[j].w); }
    const float rstd = 1.f / sqrtf(wave_sum(s) * (1.f / DM) + NORM_EPS);
    unsigned long long* o8 = (unsigned long long*)orow + lane;
#pragma unroll
    for (int j = 0; j < 4; ++j) { const f32x4 gv = gr[64 * j]; o8[64 * j] = (unsigned long long)pk2(v[j].x * rstd * gv.x, v[j].y * rstd * gv.y) | ((unsigned long long)pk2(v[j].z * rstd * gv.z, v[j].w * rstd * gv.w) << 32); }
}
__device__ __forceinline__ void rmsnorm_rows(Frame& F, const float* x, const float* gain, bf16_t* o) {
    const int gw = F.bid * NWAVES + F.wave, NGW = F.G * NWAVES;
    for (int m = gw; m < T; m += NGW) rms_row_to_bf16(x + (size_t)m * DM, gain, o + (size_t)m * DM, F.lane);
}

__device__ __forceinline__ void s5_scan(Frame& F, int layer) {
    const float* HL = (const float*)(F.ws + WS_HLOC); bf16_t* UH = (bf16_t*)(F.ws + WS_UH);
    for (int i = F.bid * NTHR + F.tid; i < BATCH * 32 * 64; i += F.G * NTHR) {
        const int p = i & 63, g = (i >> 6) & 31, b = i >> 11, gi = layer * 32 + g;
        const float dt = __expf(F.in[IN_LOGDT][gi]), lr = F.in[IN_LRE][gi * 64 + p], li = F.in[IN_LIM][gi * 64 + p];
        float s, c; sincos_red((float)S5_TC * li * dt, s, c); const float mg = __expf((float)S5_TC * lr * dt), ar = mg * c, ai = mg * s;
        float hr = 0.f, hi = 0.f;
        const int nch = SEQ / S5_TC;
#pragma unroll 8
        for (int ch = 0; ch < nch; ++ch) { const size_t r = (size_t)g * S5_ROWS + b * nch + ch;
            const float lr_ = HL[r * 128 + p], li_ = HL[r * 128 + 64 + p];
            UH[r * S5_K + p] = (bf16_t)f2bf(hr); UH[r * S5_K + 64 + p] = (bf16_t)f2bf(hi);
            const float nr = ar * hr - ai * hi + lr_, ni = ar * hi + ai * hr + li_; hr = nr; hi = ni; }
    }
}

__device__ __forceinline__ void ssd_stage_bc(Frame& F, int layer, int b, int ch, int grp, LAS float* Bs, LAS float* Cs, LAS float* dts, LAS float* das) {
    const bf16_t* P = (const bf16_t*)(F.ws + WS_P); const float* DT = (const float*)(F.ws + WS_DT);
    const float* cw = F.in[IN_CONVW] + layer * 4 * 1280; const float* cb = F.in[IN_CONVB] + layer * 1280;
    const int l0 = ch * 128; const size_t row0 = (size_t)b * SEQ + l0;
    for (int i = F.tid; i < 2 * 128 * 64; i += NTHR) { const int isC = i >> 13, t = (i >> 6) & 127, n = i & 63;
        const int col = (isC ? C_C : C_B) + grp * 64 + n, cc = 1024 + isC * 128 + grp * 64 + n; float a = cb[cc];
#pragma unroll
        for (int j = 0; j < 4; ++j) { const int l = l0 + t - 3 + j; if (l >= 0) a += cw[j * 1280 + cc] * bf2f(P[(row0 + t - 3 + j) * NINP + col]); }
        (isC ? Cs : Bs)[t * 64 + n] = siluf_(a); }
    for (int i = F.tid; i < 128 * 8; i += NTHR) { const int t = i >> 3, hh = i & 7, h = grp * 8 + hh;
        const float dt = softplusf_(DT[(row0 + t) * 16 + h] + F.in[IN_DTB][layer * 16 + h]); dts[i] = dt; das[i] = dt * (-__expf(F.in[IN_ALOG][layer * 16 + h])); }
}
template <bool OUT>
__device__ __forceinline__ void ssd_units(Frame& F, int layer) {
    LAS float* Bs = (LAS float*)F.lds; LAS float* Cs = Bs + 128 * 64; LAS float* dts = Cs + 128 * 64; LAS float* das = dts + 128 * 8; LAS float* ssq = das + 128 * 8;
    const bf16_t* P = (const bf16_t*)(F.ws + WS_P); float* SST = (float*)(F.ws + WS_SST); float* ASUM = (float*)(F.ws + WS_ASUM); bf16_t* YC = (bf16_t*)(F.ws + WS_YCAT);
    const float* cw = F.in[IN_CONVW] + layer * 4 * 1280; const float* cb = F.in[IN_CONVB] + layer * 1280;
    for (int u = F.bid; u < BATCH * SSD_NCH * 2; u += F.G) {
        const int grp = u & 1, ch = (u >> 1) & 31, b = u >> 6;
        __syncthreads();
        ssd_stage_bc(F, layer, b, ch, grp, Bs, Cs, dts, das);
        __syncthreads();
        const int hh = F.wave, h = grp * 8 + hh, p = F.lane, cx = h * 64 + p;
        const float w0 = cw[cx], w1 = cw[1280 + cx], w2 = cw[2560 + cx], w3 = cw[3840 + cx], bias = cb[cx], dsk = F.in[IN_SSDD][layer * 16 + h];
        const int l0 = ch * 128; const size_t row0 = (size_t)b * SEQ + l0;
        const bf16_t* xp = P + row0 * NINP + C_XS + cx;
        float x0 = 0.f, x1 = 0.f, x2 = 0.f;
        if (l0 > 0) { x0 = bf2f(xp[-3 * (ptrdiff_t)NINP]); x1 = bf2f(xp[-2 * (ptrdiff_t)NINP]); x2 = bf2f(xp[-1 * (ptrdiff_t)NINP]); }
        float st[64];
        float* sp = SST + ((((size_t)b * SSD_NCH + ch) * 16 + h) * 64 + p) * 64;
        if (OUT) {
#pragma unroll
            for (int n = 0; n < 64; n += 4) { const f32x4 v = *(const f32x4*)(sp + n); st[n] = v.x; st[n + 1] = v.y; st[n + 2] = v.z; st[n + 3] = v.w; }
        } else {
#pragma unroll
            for (int n = 0; n < 64; ++n) st[n] = 0.f;
        }
        float asum = 0.f;
#pragma unroll 4
        for (int t = 0; t < 128; ++t) {
            const float x3 = bf2f(xp[(size_t)t * NINP]);
            const float xs = siluf_(bias + w0 * x0 + w1 * x1 + w2 * x2 + w3 * x3);
            x0 = x1; x1 = x2; x2 = x3;
            const float dt = dts[t * 8 + hh], a = das[t * 8 + hh], da = __expf(a), xdt = xs * dt;
            asum += a;
            float y = 0.f;
#pragma unroll
            for (int n = 0; n < 64; n += 4) { const f32x4 bv = *(const LAS f32x4*)(Bs + t * 64 + n);
                st[n] = da * st[n] + bv.x * xdt; st[n + 1] = da * st[n + 1] + bv.y * xdt; st[n + 2] = da * st[n + 2] + bv.z * xdt; st[n + 3] = da * st[n + 3] + bv.w * xdt;
                if (OUT) { const f32x4 cv = *(const LAS f32x4*)(Cs + t * 64 + n); y += (cv.x * st[n] + cv.y * st[n + 1]) + (cv.z * st[n + 2] + cv.w * st[n + 3]); } }
            if (OUT) {
                const float z = bf2f(P[(row0 + t) * NINP + C_Z + cx]);
                const float yz = (y + dsk * xs) * siluf_(z);
                const float q = wave_sum(yz * yz);
                if (p == 0) ssq[t * 8 + hh] = q;
                YC[(row0 + t) * 2048 + 1024 + cx] = (bf16_t)f2bf(yz);
            }
        }
        if (!OUT) {
#pragma unroll
            for (int n = 0; n < 64; n += 4) *(f32x4*)(sp + n) = (f32x4){st[n], st[n + 1], st[n + 2], st[n + 3]};
            if (p == 0) ASUM[((size_t)b * SSD_NCH + ch) * 16 + h] = asum;
        } else {
            __syncthreads();
            const float ng = F.in[IN_SSDG][layer * 1024 + cx];
            for (int t = 0; t < 128; ++t) { float q = 0.f;
#pragma unroll
                for (int j = 0; j < 8; ++j) q += ssq[t * 8 + j];
                const float rs = 1.f / sqrtf(q * (1.f / 512.f) + NORM_EPS);
                bf16_t* yp = YC + (row0 + t) * 2048 + 1024 + cx; *yp = (bf16_t)f2bf(bf2f(*yp) * rs * ng); }
        }
    }
}
__device__ __forceinline__ void ssd_scan(Frame& F) {
    float* SST = (float*)(F.ws + WS_SST); const float* ASUM = (const float*)(F.ws + WS_ASUM);
    for (int i = F.bid * NTHR + F.tid; i < BATCH * 16 * 64 * 64; i += F.G * NTHR) {
        const int pn = i & 4095, h = (i >> 12) & 15, b = i >> 16; float s = 0.f;
#pragma unroll 8
        for (int ch = 0; ch < SSD_NCH; ++ch) { const size_t o = (((size_t)b * SSD_NCH + ch) * 16 + h) * 4096 + pn; const float loc = SST[o], dec = __expf(ASUM[((size_t)b * SSD_NCH + ch) * 16 + h]);
            SST[o] = s; s = s * dec + loc; }
    }
}

__device__ __forceinline__ void attn_units(Frame& F, int layer) {
    LAS float* Ks = (LAS float*)F.lds; LAS float* Vs = Ks + 256 * 64;
    const bf16_t* P = (const bf16_t*)(F.ws + WS_P); bf16_t* YC = (bf16_t*)(F.ws + WS_YCAT);
    const float* qg = F.in[IN_QG] + layer * 64; const float* kg = F.in[IN_KG] + layer * 64;
    for (int u = F.bid; u < BATCH * 32 * 2; u += F.G) {
        const int kvh = u & 1, qb = (u >> 1) & 31, b = u >> 6, q0 = qb * 128;
        int lane = F.lane; asm volatile("" : "+v"(lane));
        __syncthreads();
        for (int jr = F.wave; jr < 256; jr += NWAVES) { const int l = q0 - 128 + jr; float kv = 0.f, vv = 0.f;
            if (l >= 0) { const size_t row = (size_t)b * SEQ + l; const float x = bf2f(P[row * NINP + C_K + kvh * 64 + lane]); vv = bf2f(P[row * NINP + C_V + kvh * 64 + lane]);
                const float rs = 1.f / sqrtf(wave_sum(x * x) * (1.f / 64.f) + NORM_EPS); const float xn = x * rs * kg[lane];
                const float other = __shfl_xor(xn, 32); const int i = lane & 31; const float inv = exp2f(-(float)i * (13.287712379549449f / 32.f));
                float s, c; sincos_fast((float)l * inv, s, c);
                kv = (lane < 32) ? (xn * c - other * s) : (xn * c + other * s); }
            Ks[jr * 64 + lane] = kv; Vs[jr * 64 + lane] = vv; }
        __syncthreads();
        const int hh = F.wave >> 1, head = kvh * 4 + hh, qi = q0 + (F.wave & 1) * 64 + lane; const size_t row = (size_t)b * SEQ + qi;
        float q[64];
        { const u32x4* qp = (const u32x4*)(P + row * NINP + C_Q + head * 64); float ss = 0.f;
#pragma unroll
          for (int j = 0; j < 8; ++j) { const u32x4 w = qp[j];
#pragma unroll
              for (int e = 0; e < 4; ++e) { q[8 * j + 2 * e] = bflo(w[e]); q[8 * j + 2 * e + 1] = bfhi(w[e]); } }
#pragma unroll
          for (int d = 0; d < 64; ++d) ss += q[d] * q[d];
          const float rs = 1.f / sqrtf(ss * (1.f / 64.f) + NORM_EPS);
#pragma unroll
          for (int d = 0; d < 64; ++d) q[d] = q[d] * rs * qg[d];
#pragma unroll
          for (int i = 0; i < 32; ++i) { const float inv = exp2f(-(float)i * (13.287712379549449f / 32.f)); float s, c; sincos_fast((float)qi * inv, s, c);
              const float a = q[i], bq = q[i + 32]; q[i] = (a * c - bq * s) * 0.125f; q[i + 32] = (bq * c + a * s) * 0.125f; } }
        float o[64];
#pragma unroll
        for (int d = 0; d < 64; ++d) o[d] = 0.f;
        float mx = F.in[IN_SINK][layer * 8 + head], l = 1.f;
        const int qa = q0 + (F.wave & 1) * 64;
        int jlo = qa - 127 - (q0 - 128); if (q0 == 0 && jlo < 128) jlo = 128; const int jhi = qa + 63 - (q0 - 128);
        for (int jr = jlo; jr <= jhi; ++jr) { const int j = q0 - 128 + jr; const bool ok = (j <= qi) && (qi - j < 128);
            float s = 0.f;
#pragma unroll
            for (int d = 0; d < 64; d += 4) { const f32x4 kv = *(const LAS f32x4*)(Ks + jr * 64 + d); s += (q[d] * kv.x + q[d + 1] * kv.y) + (q[d + 2] * kv.z + q[d + 3] * kv.w); if ((d & 12) == 12) __builtin_amdgcn_sched_barrier(0); }
            if (ok) { const float mn = fmaxf(mx, s), al = __expf(mx - mn), pe = __expf(s - mn); l = l * al + pe; mx = mn;
#pragma unroll
                for (int d = 0; d < 64; d += 4) { const f32x4 vv = *(const LAS f32x4*)(Vs + jr * 64 + d); o[d] = o[d] * al + pe * vv.x; o[d + 1] = o[d + 1] * al + pe * vv.y; o[d + 2] = o[d + 2] * al + pe * vv.z; o[d + 3] = o[d + 3] * al + pe * vv.w; if ((d & 12) == 12) __builtin_amdgcn_sched_barrier(0); } } }
        const float il = 1.f / l; u32x4* op = (u32x4*)(YC + row * 2048 + 512 + head * 64);
#pragma unroll
        for (int j = 0; j < 8; ++j) { u32x4 w; w.x = pk2(o[8 * j] * il, o[8 * j + 1] * il); w.y = pk2(o[8 * j + 2] * il, o[8 * j + 3] * il); w.z = pk2(o[8 * j + 4] * il, o[8 * j + 5] * il); w.w = pk2(o[8 * j + 6] * il, o[8 * j + 7] * il); op[j] = w; }
    }
}

__device__ __forceinline__ void router_phase(Frame& F, int layer) {
    LAS float* Wt = (LAS float*)F.lds;
    const float* wrg = F.in[IN_WRG] + (size_t)layer * 1024 * 4; const float* wre = F.in[IN_WRE] + (size_t)layer * 1024 * 32;
    for (int i = F.tid; i < 1024 * 4; i += NTHR) Wt[(i & 3) * 1024 + (i >> 2)] = wrg[i];
    for (int i = F.tid; i < 1024 * 32; i += NTHR) Wt[(4 + (i & 31)) * 1024 + (i >> 5)] = wre[i];
    __syncthreads();
    const float* X = F.out; const float* gain = F.in[IN_NORM2] + layer * 1024; bf16_t* H2 = (bf16_t*)(F.ws + WS_XN);
    int* EID = (int*)(F.ws + WS_MOE); float* EW = (float*)(F.ws + WS_MOE + 128 * 1024); int* SLOT = (int*)(F.ws + WS_MOE + 256 * 1024);
    unsigned* cnt = F.ctl + CW_CNT + layer * 32;
    const int gw = F.bid * NWAVES + F.wave, NGW = F.G * NWAVES;
    for (int m = gw; m < T; m += NGW) {
        const f32x4* xr = (const f32x4*)(X + (size_t)m * DM) + F.lane; const f32x4* gr = (const f32x4*)gain + F.lane;
        f32x4 v[4]; float s = 0.f;
#pragma unroll
        for (int j = 0; j < 4; ++j) { v[j] = xr[64 * j]; s += (v[j].x * v[j].x + v[j].y * v[j].y) + (v[j].z * v[j].z + v[j].w * v[j].w); }
        const float rstd = 1.f / sqrtf(wave_sum(s) * (1.f / DM) + NORM_EPS);
        unsigned long long* o8 = (unsigned long long*)(H2 + (size_t)m * DM) + F.lane;
#pragma unroll
        for (int j = 0; j < 4; ++j) { const f32x4 gv = gr[64 * j]; v[j].x *= rstd * gv.x; v[j].y *= rstd * gv.y; v[j].z *= rstd * gv.z; v[j].w *= rstd * gv.w;
            o8[64 * j] = (unsigned long long)pk2(v[j].x, v[j].y) | ((unsigned long long)pk2(v[j].z, v[j].w) << 32); }
        float mylog = 0.f;
#pragma unroll 2
        for (int e = 0; e < 36; ++e) { float a = 0.f;
#pragma unroll
            for (int j = 0; j < 4; ++j) { const f32x4 w = *(const LAS f32x4*)(Wt + e * 1024 + 256 * j + 4 * F.lane); a += (v[j].x * w.x + v[j].y * w.y) + (v[j].z * w.z + v[j].w * w.w); }
            a = wave_sum(a); mylog = (F.lane == e) ? a : mylog; }
        float lg4[4];
#pragma unroll
        for (int k = 0; k < 4; ++k) lg4[k] = __shfl(mylog, k);
        float gl[4];
#pragma unroll
        for (int k = 0; k < 4; ++k) gl[k] = lg4[k] + F.in[IN_BRG][layer * 4 + k];
        int gs = 0; float gbest = gl[0];
#pragma unroll
        for (int k = 1; k < 4; ++k) if (gl[k] > gbest) { gbest = gl[k]; gs = k; }
        float elv[8];
#pragma unroll
        for (int k = 0; k < 8; ++k) elv[k] = __shfl(mylog, 4 + gs * 8 + k);
        if (F.lane == 0) {
            float den = 0.f;
#pragma unroll
            for (int k = 0; k < 4; ++k) den += __expf(gl[k] - gbest);
            const float pgrp = 1.f / den;
            float el[8];
#pragma unroll
            for (int k = 0; k < 8; ++k) el[k] = elv[k] + F.in[IN_BRE_][layer * 32 + gs * 8 + k];
            int i0 = 0; float v0 = el[0];
#pragma unroll
            for (int k = 1; k < 8; ++k) if (el[k] > v0) { v0 = el[k]; i0 = k; }
            int i1 = -1; float v1 = -3.0e38f;
#pragma unroll
            for (int k = 0; k < 8; ++k) if (k != i0 && el[k] > v1) { v1 = el[k]; i1 = k; }
            const float e1 = __expf(v1 - v0), w0 = pgrp / (1.f + e1), w1 = pgrp * e1 / (1.f + e1);
            const int ea = gs * 8 + i0, eb = gs * 8 + i1;
            EID[2 * m] = ea; EID[2 * m + 1] = eb; EW[2 * m] = w0; EW[2 * m + 1] = w1;
            SLOT[2 * m] = (int)__hip_atomic_fetch_add(cnt + ea, 1u, __ATOMIC_RELAXED, __HIP_MEMORY_SCOPE_AGENT);
            SLOT[2 * m + 1] = (int)__hip_atomic_fetch_add(cnt + eb, 1u, __ATOMIC_RELAXED, __HIP_MEMORY_SCOPE_AGENT);
        }
    }
}
__device__ __forceinline__ int moe_tables(Frame& F, int layer, volatile LAS int* offs, volatile LAS int* tile_e) {
    __syncthreads();
    if (F.tid < 64) {
        unsigned* cnt = F.ctl + CW_CNT + layer * 32;
        const int c = (F.tid < 32) ? (int)__hip_atomic_load(cnt + F.tid, __ATOMIC_RELAXED, __HIP_MEMORY_SCOPE_AGENT) : 0;
        const int tl = (c + 255) >> 8; int incl = tl;
#pragma unroll
        for (int o = 1; o < 32; o <<= 1) { const int v = __shfl_up(incl, o); if (F.tid >= o) incl += v; }
        const int excl = incl - tl;
        if (F.tid < 32) { offs[F.tid] = excl * 256; for (int k = 0; k < tl; ++k) tile_e[excl + k] = F.tid; }
        if (F.tid == 31) offs[32] = incl;
    }
    __syncthreads();
    return __builtin_amdgcn_readfirstlane(offs[32]);
}
__device__ __forceinline__ void gather_phase(Frame& F, int layer, volatile LAS int* offs) {
    const bf16_t* H2 = (const bf16_t*)(F.ws + WS_XN); bf16_t* XG = (bf16_t*)(F.ws + WS_XG);
    const int* EID = (const int*)(F.ws + WS_MOE); const int* SLOT = (const int*)(F.ws + WS_MOE + 256 * 1024); int* POS = (int*)(F.ws + WS_MOE + 384 * 1024);
    const int gw = F.bid * NWAVES + F.wave, NGW = F.G * NWAVES;
    for (int m = gw; m < T; m += NGW) {
        const u32x4* src = (const u32x4*)(H2 + (size_t)m * DM) + F.lane; const u32x4 a = src[0], b = src[64];
#pragma unroll
        for (int k = 0; k < 2; ++k) { const int pos = offs[EID[2 * m + k]] + SLOT[2 * m + k]; u32x4* dst = (u32x4*)(XG + (size_t)pos * DM) + F.lane; dst[0] = a; dst[64] = b; if (F.lane == 0) POS[2 * m + k] = pos; }
    }
}
__device__ __forceinline__ void combine_phase(Frame& F, const float* gain_next) {
    const bf16_t* Y = (const bf16_t*)(F.ws + WS_YEXP); const float* EW = (const float*)(F.ws + WS_MOE + 128 * 1024); const int* POS = (const int*)(F.ws + WS_MOE + 384 * 1024);
    bf16_t* XN = (bf16_t*)(F.ws + WS_XN);
    const int gw = F.bid * NWAVES + F.wave, NGW = F.G * NWAVES;
    for (int m = gw; m < T; m += NGW) {
        const float w0 = EW[2 * m], w1 = EW[2 * m + 1]; const int p0 = POS[2 * m], p1 = POS[2 * m + 1];
        f32x4* xr = (f32x4*)(F.out + (size_t)m * DM) + F.lane;
        const u32x2* y0 = (const u32x2*)(Y + (size_t)p0 * DM) + F.lane; const u32x2* y1 = (const u32x2*)(Y + (size_t)p1 * DM) + F.lane;
        f32x4 v[4]; float s = 0.f;
#pragma unroll
        for (int j = 0; j < 4; ++j) { v[j] = xr[64 * j]; const u32x2 a = y0[64 * j], b = y1[64 * j];
            v[j].x += w0 * bflo(a.x) + w1 * bflo(b.x); v[j].y += w0 * bfhi(a.x) + w1 * bfhi(b.x); v[j].z += w0 * bflo(a.y) + w1 * bflo(b.y); v[j].w += w0 * bfhi(a.y) + w1 * bfhi(b.y);
            xr[64 * j] = v[j]; s += (v[j].x * v[j].x + v[j].y * v[j].y) + (v[j].z * v[j].z + v[j].w * v[j].w); }
        if (gain_next) { const float rstd = 1.f / sqrtf(wave_sum(s) * (1.f / DM) + NORM_EPS); const f32x4* gr = (const f32x4*)gain_next + F.lane;
            unsigned long long* o8 = (unsigned long long*)(XN + (size_t)m * DM) + F.lane;
#pragma unroll
            for (int j = 0; j < 4; ++j) { const f32x4 gv = gr[64 * j]; o8[64 * j] = (unsigned long long)pk2(v[j].x * rstd * gv.x, v[j].y * rstd * gv.y) | ((unsigned long long)pk2(v[j].z * rstd * gv.z, v[j].w * rstd * gv.w) << 32); } }
    }
}

typedef float f32x16 __attribute__((ext_vector_type(16)));
typedef float f32x2_t __attribute__((ext_vector_type(2)));
typedef __bf16 bf16x2_t __attribute__((ext_vector_type(2)));
#define MFMA32(a, b, c) __builtin_amdgcn_mfma_f32_32x32x16_bf16((a), (b), (c), 0, 0, 0)
__device__ __forceinline__ unsigned cvtpk(float lo, float hi) { f32x2_t v = {lo, hi}; bf16x2_t b = __builtin_convertvector(v, bf16x2_t); return __builtin_bit_cast(unsigned, b); }
__device__ __forceinline__ bf16x8 pack8v(const float (&v)[8]) { u32x4 p; p.x = cvtpk(v[0], v[1]); p.y = cvtpk(v[2], v[3]); p.z = cvtpk(v[4], v[5]); p.w = cvtpk(v[6], v[7]); return __builtin_bit_cast(bf16x8, p); }
__device__ __forceinline__ int crow32(int reg, int hh) { return (reg & 3) + 8 * (reg >> 2) + 4 * hh; }
__device__ __forceinline__ float wave_incl_scan(float v, int lane) {
#pragma unroll
    for (int o = 1; o < 64; o <<= 1) { const float t = __shfl_up(v, o); if (lane >= o) v += t; }
    return v;
}
__device__ __forceinline__ void conv_frag(const LAS unsigned char* raw, int chan, int ks, int hh, float w0, float w1, float w2, float w3, float bias, float (&out)[8]) {
#pragma unroll
    for (int run = 0; run < 2; ++run) { const int lb = 16 * ks + 8 * run + 4 * hh; float x[7];
#pragma unroll
        for (int i = 0; i < 7; ++i) x[i] = bf2f(*(const LAS unsigned short*)(raw + (lb + i) * 128 + chan * 2));
#pragma unroll
        for (int j = 0; j < 4; ++j) out[4 * run + j] = siluf_(bias + w0 * x[j] + w1 * x[j + 1] + w2 * x[j + 2] + w3 * x[j + 3]); }
}
constexpr int RAWT = 131 * 128;
__device__ __forceinline__ void stage_raw(const bf16_t* P, size_t row0, int l0, int col, LAS unsigned char* dst, int idx0, int stride) {
    for (int idx = idx0; idx < 131 * 8; idx += stride) { const int r = idx >> 3, c8 = idx & 7; u32x4 v = (u32x4){0u, 0u, 0u, 0u};
        if (l0 - 3 + r >= 0) v = *(const u32x4*)(P + (row0 + r - 3) * NINP + col + c8 * 8);
        *(LAS u32x4*)(dst + r * 128 + c8 * 16) = v; }
}
__device__ __forceinline__ void ssdA_mfma(Frame& F, int layer) {
    const bf16_t* P = (const bf16_t*)(F.ws + WS_P); const float* DT = (const float*)(F.ws + WS_DT); float* SST = (float*)(F.ws + WS_SST); float* ASUM = (float*)(F.ws + WS_ASUM);
    const float* cw = F.in[IN_CONVW] + layer * 4 * 1280; const float* cb = F.in[IN_CONVB] + layer * 1280;
    LAS unsigned char* rawX = F.lds + F.wave * RAWT; LAS unsigned char* rawB = F.lds + 8 * RAWT; LAS float* ftab = (LAS float*)(F.lds + 9 * RAWT) + F.wave * 128;
    for (int u = F.bid; u < BATCH * SSD_NCH * 2; u += F.G) {
        const int grp = u & 1, ch = (u >> 1) & 31, b = u >> 6, h = grp * 8 + F.wave, l0 = ch * 128; const size_t row0 = (size_t)b * SEQ + l0;
        int lane = F.lane; asm volatile("" : "+v"(lane));
        const int r = lane & 31, hh = lane >> 5;
        __syncthreads();
        stage_raw(P, row0, l0, C_XS + h * 64, rawX, lane, 64);
        stage_raw(P, row0, l0, C_B + grp * 64, rawB, F.tid, NTHR);
        { const float dtb = F.in[IN_DTB][layer * 16 + h], A = -__expf(F.in[IN_ALOG][layer * 16 + h]);
          const float dt0 = softplusf_(DT[(row0 + lane) * 16 + h] + dtb), dt1 = softplusf_(DT[(row0 + 64 + lane) * 16 + h] + dtb);
          const float s0 = wave_incl_scan(dt0 * A, lane); const float tot0 = __builtin_bit_cast(float, __builtin_amdgcn_readlane(__builtin_bit_cast(int, s0), 63));
          const float s1 = wave_incl_scan(dt1 * A, lane) + tot0; const float tot = __builtin_bit_cast(float, __builtin_amdgcn_readlane(__builtin_bit_cast(int, s1), 63));
          ftab[lane] = dt0 * __expf(tot - s0); ftab[64 + lane] = dt1 * __expf(tot - s1);
          if (lane == 0) ASUM[((size_t)b * SSD_NCH + ch) * 16 + h] = tot; }
        __syncthreads();
        bf16x8 bfr[2];
#pragma unroll
        for (int q = 0; q < 2; ++q) { const int idx = F.wave * 2 + q, nt = idx >> 3, ks = idx & 7, cc = 1024 + grp * 64 + 32 * nt + r; float v[8];
            conv_frag(rawB, 32 * nt + r, ks, hh, cw[cc], cw[1280 + cc], cw[2560 + cc], cw[3840 + cc], cb[cc], v); bfr[q] = pack8v(v); }
        bf16x8 xw[2][8];
#pragma unroll
        for (int pt = 0; pt < 2; ++pt) { const int cx = h * 64 + 32 * pt + r; const float w0 = cw[cx], w1 = cw[1280 + cx], w2 = cw[2560 + cx], w3 = cw[3840 + cx], bias = cb[cx];
#pragma unroll
            for (int ks = 0; ks < 8; ++ks) { float v[8]; conv_frag(rawX, 32 * pt + r, ks, hh, w0, w1, w2, w3, bias, v);
                const f32x4 fa = *(const LAS f32x4*)(ftab + 16 * ks + 4 * hh), fb = *(const LAS f32x4*)(ftab + 16 * ks + 8 + 4 * hh);
                v[0] *= fa.x; v[1] *= fa.y; v[2] *= fa.z; v[3] *= fa.w; v[4] *= fb.x; v[5] *= fb.y; v[6] *= fb.z; v[7] *= fb.w; { u32x4 pq = __builtin_bit_cast(u32x4, pack8v(v)); asm volatile("" : "+v"(pq) :: "memory"); xw[pt][ks] = __builtin_bit_cast(bf16x8, pq); } } }
        __syncthreads();
#pragma unroll
        for (int q = 0; q < 2; ++q) *(LAS bf16x8*)(rawB + (F.wave * 2 + q) * 1024 + lane * 16) = bfr[q];
        __syncthreads();
        f32x16 acc[2][2];
#pragma unroll
        for (int pt = 0; pt < 2; ++pt)
#pragma unroll
            for (int nt = 0; nt < 2; ++nt)
#pragma unroll
                for (int i = 0; i < 16; ++i) acc[pt][nt][i] = 0.f;
#pragma unroll
        for (int ks = 0; ks < 8; ++ks)
#pragma unroll
            for (int nt = 0; nt < 2; ++nt) { const bf16x8 bq = *(const LAS bf16x8*)(rawB + (nt * 8 + ks) * 1024 + lane * 16);
#pragma unroll
                for (int pt = 0; pt < 2; ++pt) acc[pt][nt] = MFMA32(xw[pt][ks], bq, acc[pt][nt]); }
        float* sp = SST + (((size_t)b * SSD_NCH + ch) * 16 + h) * 4096;
#pragma unroll
        for (int pt = 0; pt < 2; ++pt)
#pragma unroll
            for (int nt = 0; nt < 2; ++nt)
#pragma unroll
                for (int i = 0; i < 16; ++i) sp[(32 * pt + crow32(i, hh)) * 64 + 32 * nt + r] = acc[pt][nt][i];
    }
}
__device__ __forceinline__ void ssdC_mfma(Frame& F, int layer) {
    const bf16_t* P = (const bf16_t*)(F.ws + WS_P); const float* DT = (const float*)(F.ws + WS_DT); const float* SST = (const float*)(F.ws + WS_SST); bf16_t* YC = (bf16_t*)(F.ws + WS_YCAT);
    const float* cw = F.in[IN_CONVW] + layer * 4 * 1280; const float* cb = F.in[IN_CONVB] + layer * 1280;
    LAS unsigned char* rawX = F.lds + F.wave * RAWT;
    LAS unsigned char* Bn = F.lds; LAS unsigned char* Cn = F.lds + 18432;
    LAS float* atab = (LAS float*)(F.lds + 36864) + F.wave * 128; LAS float* dtab = (LAS float*)(F.lds + 40960) + F.wave * 128;
    LAS float* ssqp = (LAS float*)(F.lds + 45056); LAS float* gtab = (LAS float*)(F.lds + 49152) + F.wave * 64;
    LAS unsigned char* zt = F.lds + 51200 + F.wave * 4608;
    for (int u = F.bid; u < BATCH * SSD_NCH * 2; u += F.G) {
        const int grp = u & 1, ch = (u >> 1) & 31, b = u >> 6, h = grp * 8 + F.wave, l0 = ch * 128; const size_t row0 = (size_t)b * SEQ + l0;
        int lane = F.lane; asm volatile("" : "+v"(lane));
        const int r = lane & 31, hh = lane >> 5;
        __syncthreads();
        stage_raw(P, row0, l0, C_XS + h * 64, rawX, lane, 64);
        __syncthreads();
        bf16x8 xsf[2][8];
#pragma unroll
        for (int pt = 0; pt < 2; ++pt) { const int cx = h * 64 + 32 * pt + r; const float w0 = cw[cx], w1 = cw[1280 + cx], w2 = cw[2560 + cx], w3 = cw[3840 + cx], bias = cb[cx];
#pragma unroll
            for (int ks = 0; ks < 8; ++ks) { float v[8]; conv_frag(rawX, 32 * pt + r, ks, hh, w0, w1, w2, w3, bias, v); { u32x4 pq = __builtin_bit_cast(u32x4, pack8v(v)); asm volatile("" : "+v"(pq) :: "memory"); xsf[pt][ks] = __builtin_bit_cast(bf16x8, pq); } } }
        __syncthreads();
        for (int it = F.tid; it < 128 * 16; it += NTHR) { const int l = it >> 4, c8 = it & 15, isC = c8 >> 3, col = (isC ? C_C : C_B) + grp * 64 + (c8 & 7) * 8, cc = 1024 + isC * 128 + grp * 64 + (c8 & 7) * 8;
            float a[8];
#pragma unroll
            for (int e = 0; e < 8; ++e) a[e] = cb[cc + e];
#pragma unroll
            for (int j = 0; j < 4; ++j) { if (l0 + l - 3 + j >= 0) { const u32x4 xv = *(const u32x4*)(P + (row0 + l - 3 + j) * NINP + col);
#pragma unroll
                for (int e = 0; e < 4; ++e) { a[2 * e] += cw[j * 1280 + cc + 2 * e] * bflo(xv[e]); a[2 * e + 1] += cw[j * 1280 + cc + 2 * e + 1] * bfhi(xv[e]); } } }
            u32x4 o; o.x = cvtpk(siluf_(a[0]), siluf_(a[1])); o.y = cvtpk(siluf_(a[2]), siluf_(a[3])); o.z = cvtpk(siluf_(a[4]), siluf_(a[5])); o.w = cvtpk(siluf_(a[6]), siluf_(a[7]));
            *(LAS u32x4*)((isC ? Cn : Bn) + l * 144 + (c8 & 7) * 16) = o; }
        { const float dtb = F.in[IN_DTB][layer * 16 + h], A = -__expf(F.in[IN_ALOG][layer * 16 + h]);
          const float dt0 = softplusf_(DT[(row0 + lane) * 16 + h] + dtb), dt1 = softplusf_(DT[(row0 + 64 + lane) * 16 + h] + dtb);
          const float s0 = wave_incl_scan(dt0 * A, lane); const float tot0 = __builtin_bit_cast(float, __builtin_amdgcn_readlane(__builtin_bit_cast(int, s0), 63));
          const float s1 = wave_incl_scan(dt1 * A, lane) + tot0;
          atab[lane] = s0; atab[64 + lane] = s1; dtab[lane] = dt0; dtab[64 + lane] = dt1; gtab[lane] = F.in[IN_SSDG][layer * 1024 + h * 64 + lane]; }
        const float* sp = SST + (((size_t)b * SSD_NCH + ch) * 16 + h) * 4096;
        const float dsk = F.in[IN_SSDD][layer * 16 + h];
        __syncthreads();
#pragma unroll 1
        for (int li = 0; li < 4; ++li) {
            bf16x8 Cf[4];
#pragma unroll
            for (int ks = 0; ks < 4; ++ks) Cf[ks] = *(const LAS bf16x8*)(Cn + (32 * li + r) * 144 + (16 * ks + 8 * hh) * 2);
            f32x16 acc[2];
#pragma unroll
            for (int pt = 0; pt < 2; ++pt)
#pragma unroll
                for (int i = 0; i < 16; ++i) acc[pt][i] = 0.f;
#pragma unroll
            for (int ks = 0; ks < 4; ++ks)
#pragma unroll
                for (int pt = 0; pt < 2; ++pt) { const f32x4 a0 = *(const f32x4*)(sp + (32 * pt + r) * 64 + 16 * ks + 8 * hh), a1 = *(const f32x4*)(sp + (32 * pt + r) * 64 + 16 * ks + 8 * hh + 4);
                    const float v[8] = {a0.x, a0.y, a0.z, a0.w, a1.x, a1.y, a1.z, a1.w}; acc[pt] = MFMA32(pack8v(v), Cf[ks], acc[pt]); }
            const float al = atab[32 * li + r], el = __expf(al); const int lrel = 32 * li + r;
#pragma unroll
            for (int pt = 0; pt < 2; ++pt)
#pragma unroll
                for (int i = 0; i < 16; ++i) acc[pt][i] *= el;
#pragma unroll
            for (int si = 0; si < 4; ++si) if (si <= li) {
                f32x16 X;
#pragma unroll
                for (int i = 0; i < 16; ++i) X[i] = 0.f;
#pragma unroll
                for (int ks = 0; ks < 4; ++ks) { const bf16x8 Bq = *(const LAS bf16x8*)(Bn + (32 * si + r) * 144 + (16 * ks + 8 * hh) * 2); X = MFMA32(Bq, Cf[ks], X); }
#pragma unroll
                for (int g4 = 0; g4 < 4; ++g4) { const int sb = 32 * si + 8 * g4 + 4 * hh; const f32x4 av = *(const LAS f32x4*)(atab + sb), dv = *(const LAS f32x4*)(dtab + sb);
#pragma unroll
                    for (int j = 0; j < 4; ++j) { const int s = sb + j; float arg = al - av[j]; if (si == li && s > lrel) arg = -100.f;
                        float x = X[4 * g4 + j] * (__expf(arg) * dv[j]); if (si == li && s > lrel) x = 0.f; if (si == li && s == lrel) x += dsk; X[4 * g4 + j] = x; } }
#pragma unroll
                for (int kq = 0; kq < 2; ++kq) { const float v[8] = {X[8 * kq], X[8 * kq + 1], X[8 * kq + 2], X[8 * kq + 3], X[8 * kq + 4], X[8 * kq + 5], X[8 * kq + 6], X[8 * kq + 7]}; const bf16x8 Xf = pack8v(v);
#pragma unroll
                    for (int pt = 0; pt < 2; ++pt) { bf16x8 a;
#pragma unroll
                        for (int q = 0; q < 4; ++q) a = (si == q) ? xsf[pt][2 * q + kq] : a;
                        acc[pt] = MFMA32(a, Xf, acc[pt]); } }
            }
            const size_t rowt = row0 + 32 * li;
#pragma unroll
            for (int q = 0; q < 4; ++q) { const int idx = lane + 64 * q, rr = idx >> 3, c8 = idx & 7; *(LAS u32x4*)(zt + rr * 144 + c8 * 16) = *(const u32x4*)(P + (rowt + rr) * NINP + C_Z + h * 64 + c8 * 8); }
            float qs = 0.f;
#pragma unroll
            for (int pt = 0; pt < 2; ++pt)
#pragma unroll
                for (int g4 = 0; g4 < 4; ++g4) { const u32x2 zz = *(const LAS u32x2*)(zt + r * 144 + (32 * pt + 8 * g4 + 4 * hh) * 2);
                    const float z0 = bflo(zz.x), z1 = bfhi(zz.x), z2 = bflo(zz.y), z3 = bfhi(zz.y);
                    float y0 = acc[pt][4 * g4] * siluf_(z0), y1 = acc[pt][4 * g4 + 1] * siluf_(z1), y2 = acc[pt][4 * g4 + 2] * siluf_(z2), y3 = acc[pt][4 * g4 + 3] * siluf_(z3);
                    acc[pt][4 * g4] = y0; acc[pt][4 * g4 + 1] = y1; acc[pt][4 * g4 + 2] = y2; acc[pt][4 * g4 + 3] = y3; qs += (y0 * y0 + y1 * y1) + (y2 * y2 + y3 * y3); }
            qs += __shfl_xor(qs, 32);
            if (hh == 0) ssqp[(32 * li + r) * 8 + F.wave] = qs;
            __syncthreads();
            { const f32x4 qa = *(const LAS f32x4*)(ssqp + (32 * li + r) * 8), qb = *(const LAS f32x4*)(ssqp + (32 * li + r) * 8 + 4);
              const float rs = 1.f / sqrtf(((qa.x + qa.y) + (qa.z + qa.w) + (qb.x + qb.y) + (qb.z + qb.w)) * (1.f / 512.f) + NORM_EPS);
#pragma unroll
              for (int pt = 0; pt < 2; ++pt)
#pragma unroll
                  for (int g4 = 0; g4 < 4; ++g4) { const int p0 = 32 * pt + 8 * g4 + 4 * hh; const f32x4 gv = *(const LAS f32x4*)(gtab + p0);
                      u32x2 o; o.x = cvtpk(acc[pt][4 * g4] * rs * gv.x, acc[pt][4 * g4 + 1] * rs * gv.y); o.y = cvtpk(acc[pt][4 * g4 + 2] * rs * gv.z, acc[pt][4 * g4 + 3] * rs * gv.w);
                      *(LAS u32x2*)(zt + r * 144 + p0 * 2) = o; } }
#pragma unroll
            for (int q = 0; q < 4; ++q) { const int idx = lane + 64 * q, rr = idx >> 3, c8 = idx & 7; *(u32x4*)(YC + (rowt + rr) * 2048 + 1024 + h * 64 + c8 * 8) = *(const LAS u32x4*)(zt + rr * 144 + c8 * 16); }
        }
    }
}

#ifndef MK_PER_PHASE
#define MK_PER_PHASE 0
#endif
constexpr int NPH = 13;
constexpr int TAB_OFF = 150 * 1024;
struct Args { const float* in[N_INPUTS]; float* out; unsigned char* ws; int gp_lo, gp_hi; };
static_assert(sizeof(Args) == (N_INPUTS + 2) * 8 + 8, "no padding in Args");

#ifndef PROBE_ID
#define PROBE_ID 0
#endif
#ifndef PROBE_N
#define PROBE_N 1
#endif
#define REP(id) for (int _r = 0; _r < ((id) == PROBE_ID ? 1 + PROBE_N : 1); ++_r)
#define LAUNDER() do { asm volatile("" : "+s"(F.in), "+s"(F.ws), "+s"(F.out), "+s"(F.ctl), "+s"(F.bid), "+s"(F.G)); asm volatile("" : "+v"(F.tid)); F.lane = F.tid & 63; F.wave = __builtin_amdgcn_readfirstlane(F.tid >> 6); } while (0)
template <int layer>
__device__ __forceinline__ void layer_body(Frame& F, const int lo, const int hi) {
    volatile LAS int* offs = (volatile LAS int*)(F.lds + TAB_OFF); volatile LAS int* tile_e = offs + 64;
    XcdBarrier bar; bar.bar = F.ctl + CW_BAR; bar.x = xb_xcc_id(); bar.st = F.MISC;
#define GP(k) (layer * NPH + (k))
#ifdef ONLY_PH
#define IN(k) (((k) == ONLY_PH) && lo <= GP(k) && GP(k) < hi)
#else
#define IN(k) (lo <= GP(k) && GP(k) < hi)
#endif
#define WSB ((const char*)F.ws)
#define SEAM(k) do { if (!MK_PER_PHASE && IN(k) && GP(k) + 1 < hi) xcd_barrier(bar); } while (0)
        if (IN(0) && layer == 0) { LAUNDER();
            REP(1) { convert_weights(F, 0); __syncthreads(); } REP(2) s5_build(F, 0);
            REP(3) rmsnorm_rows(F, F.in[IN_X], F.in[IN_NORM1], (bf16_t*)(F.ws + WS_XN));
            SEAM(0);
        }
        if (IN(1)) { LAUNDER();
            SchedDense<2048u, 2048u, T / 256, NINP / 256, 16> S{WSB + WS_XN, WSB + WS_WIN, F.G, F.bid};
            EpiProj E{F.ws, F.in[IN_BGATE] + layer * 3072};
            REP(4) pg8::gemm_phase<2048u, 2048u>(F.tid, F.lds, S, E);
            SEAM(1);
        }
        if (IN(2)) { LAUNDER();
            SchedS5P1 S{WSB + WS_UH, WSB + WS_EG, F.G, F.bid};
            EpiHloc E{(float*)(F.ws + WS_HLOC)};
            REP(5) pg8::gemm_phase<(unsigned)(S5_K * 2), 1024u>(F.tid, F.lds, S, E);
            REP(6) ssdA_mfma(F, layer);
            SEAM(2);
        }
        if (IN(3)) { LAUNDER();
            REP(7) s5_scan(F, layer);
            ssd_scan(F);
            REP(8) attn_units(F, layer);
            SEAM(3);
        }
        if (IN(4)) { LAUNDER();
            SchedS5Main S{WSB + WS_UH, WSB + WS_MG, F.G, F.bid};
            EpiS5Y E{(bf16_t*)(F.ws + WS_XN)};
            REP(9) pg8::gemm_phase<(unsigned)(S5_K * 2), (unsigned)(S5_K * 2)>(F.tid, F.lds, S, E);
            REP(10) ssdC_mfma(F, layer);
            SEAM(4);
        }
        if (IN(5)) { LAUNDER();
            SchedDense<1024u, 1024u, T / 256, 4, 8> S{WSB + WS_XN, WSB + WS_WGLU, F.G, F.bid};
            EpiGlu E{(bf16_t*)(F.ws + WS_YCAT)};
            REP(11) pg8::gemm_phase<1024u, 1024u>(F.tid, F.lds, S, E);
            SEAM(5);
        }
        if (IN(6)) { LAUNDER();
            SchedDense<4096u, 4096u, T / 256, 4, 32> S{WSB + WS_YCAT, WSB + WS_PCAT, F.G, F.bid};
            EpiMerged E{F.ws};
            REP(12) pg8::gemm_phase<4096u, 4096u>(F.tid, F.lds, S, E);
            SEAM(6);
        }
        if (IN(7)) { LAUNDER();
            SchedDense<2048u, 2048u, T / 256, 4, 16> S{WSB + WS_XN, WSB + WS_WOUT, F.G, F.bid};
            EpiResid E{layer == 0 ? F.in[IN_X] : (const float*)F.out, F.out};
            REP(layer == 0 ? 13 : -1) pg8::gemm_phase<2048u, 2048u>(F.tid, F.lds, S, E);
            SEAM(7);
        }
        if (IN(8)) { LAUNDER(); router_phase(F, layer); SEAM(8); }
        if (IN(9)) { LAUNDER(); (void)moe_tables(F, layer, offs, tile_e); REP(14) gather_phase(F, layer, offs); SEAM(9); }
        if (IN(10)) { LAUNDER();
            const int ntiles = moe_tables(F, layer, offs, tile_e);
            SchedMoe<2048u, (size_t)1024 * 1024 * 2, (size_t)256 * 2048, 16> S{WSB + WS_XG, WSB + WS_EGU, ntiles, F.G, F.bid, tile_e};
            EpiSwiGlu E{(bf16_t*)(F.ws + WS_HID)};
            REP(15) pg8::gemm_phase<2048u, 2048u>(F.tid, F.lds, S, E);
            SEAM(10);
        }
        if (IN(11)) { LAUNDER();
            const int ntiles = moe_tables(F, layer, offs, tile_e);
            SchedMoe<1024u, (size_t)1024 * 512 * 2, (size_t)256 * 1024, 8> S{WSB + WS_HID, WSB + WS_EDN, ntiles, F.G, F.bid, tile_e};
            EpiPlainBf16 E{(bf16_t*)(F.ws + WS_YEXP)};
            REP(16) pg8::gemm_phase<1024u, 1024u>(F.tid, F.lds, S, E);
            SEAM(11);
        }
        if (IN(12)) { LAUNDER();
            combine_phase(F, layer + 1 < DEPTH ? F.in[IN_NORM1] + (layer + 1) * 1024 : nullptr);
            if (layer + 1 < DEPTH) { __syncthreads(); convert_weights(F, layer + 1); __syncthreads(); s5_build(F, layer + 1); }
            SEAM(12);
        }
#undef GP
#undef IN
#undef SEAM
#undef WSB
}
__global__ void __launch_bounds__(NTHR, 2) fwd(Args args) {
    extern __shared__ __attribute__((aligned(16))) unsigned char lds_raw[];
    Frame F;
    F.lds = (LAS unsigned char*)lds_raw;
    F.MISC = (volatile LAS unsigned*)(F.lds + MISC_OFF);
    F.tid = threadIdx.x; F.lane = F.tid & 63; F.wave = __builtin_amdgcn_readfirstlane(F.tid >> 6);
    F.G = gridDim.x; F.bid = blockIdx.x;
    const __attribute__((address_space(4))) char* ka = (const __attribute__((address_space(4))) char*)__builtin_amdgcn_kernarg_segment_ptr();
    F.in = (const float* const __attribute__((address_space(4)))*)ka;
    F.out = *(float* const __attribute__((address_space(4)))*)(ka + N_INPUTS * 8); F.ws = *(unsigned char* const __attribute__((address_space(4)))*)(ka + N_INPUTS * 8 + 8); F.ctl = (unsigned*)(F.ws + WS_CTL);
    if (F.tid < 64) F.MISC[F.tid] = 0u;
    __syncthreads();
    XcdBarrier bar; bar.bar = F.ctl + CW_BAR; bar.x = 0; bar.st = nullptr;
    if (!MK_PER_PHASE) bar = xcd_barrier_post(F.ctl + CW_BAR, F.MISC);
    const int lo = *(const __attribute__((address_space(4))) int*)(ka + N_INPUTS * 8 + 16), hi = *(const __attribute__((address_space(4))) int*)(ka + N_INPUTS * 8 + 20);

    layer_body<0>(F, lo, hi);
    layer_body<1>(F, lo, hi);
}

extern "C" void kernel_launch(void* const* d_in, const int* in_sizes, int n_in, void* d_out, int out_size, void* d_ws, size_t ws_size, hipStream_t stream) {
    static int grid = 0;
    if (grid == 0) {
        if (n_in != N_INPUTS || out_size != T * DM || ws_size < WS_END) { fprintf(stderr, "kernel_launch: unexpected shapes (n_in %d out %d ws %zu need %zu)\n", n_in, out_size, ws_size, (size_t)WS_END); grid = -1; return; }
        int dev = 0, cus = 0, per_cu = 0;
        if (hipGetDevice(&dev) != hipSuccess || hipDeviceGetAttribute(&cus, hipDeviceAttributeMultiprocessorCount, dev) != hipSuccess) { grid = -1; return; }
        if (hipFuncSetAttribute((const void*)fwd, hipFuncAttributeMaxDynamicSharedMemorySize, LDS_BYTES) != hipSuccess) { fprintf(stderr, "kernel_launch: hipFuncSetAttribute failed\n"); grid = -1; return; }
        if (hipOccupancyMaxActiveBlocksPerMultiprocessor(&per_cu, (const void*)fwd, NTHR, LDS_BYTES) != hipSuccess || per_cu < 1) fprintf(stderr, "kernel_launch: occupancy query reports %d\n", per_cu);
        (void)hipGetLastError();
        grid = cus;
    }
    if (grid < 0) return;
    (void)hipMemsetAsync((char*)d_ws + WS_CTL, 0, CTL_ZERO_BYTES, stream);
    Args a{};
    for (int i = 0; i < N_INPUTS; ++i) a.in[i] = (const float*)d_in[i];
    a.out = (float*)d_out; a.ws = (unsigned char*)d_ws;
#if MK_PER_PHASE
    for (int gp = 0; gp < DEPTH * NPH; ++gp) {
        if (gp == NPH) continue;
        a.gp_lo = gp; a.gp_hi = gp + 1;
        hipLaunchKernelGGL(fwd, dim3(grid), dim3(NTHR), LDS_BYTES, stream, a);
    }
#else
    a.gp_lo = 0; a.gp_hi = DEPTH * NPH;
    hipLaunchKernelGGL(fwd, dim3(grid), dim3(NTHR), LDS_BYTES, stream, a);
#endif
}
```

```cpp
#include <hip/hip_runtime.h>
#include <cstdio>
#include <cstdint>

#define LAS __attribute__((address_space(3)))
#define GAS __attribute__((address_space(1)))
typedef unsigned short bf16_t;
typedef short bf16x8 __attribute__((ext_vector_type(8)));
typedef float f32x4 __attribute__((ext_vector_type(4)));
typedef float f32x2 __attribute__((ext_vector_type(2)));
typedef unsigned u32x4 __attribute__((ext_vector_type(4)));
typedef unsigned u32x2 __attribute__((ext_vector_type(2)));

constexpr int BATCH = 4, SEQ = 4096, DM = 1024, T = BATCH * SEQ, DEPTH = 2;
constexpr int NIN = 6672, NINP = 6912;
constexpr int C_U = 0, C_Q = 512, C_K = 1024, C_V = 1152, C_Z = 1280, C_XS = 2304, C_B = 3328, C_C = 3456, C_DT = 3584, C_G = 3840;
constexpr int S5_TC = 32, S5_ROWS = T / S5_TC  , S5_K = 128 + S5_TC * 16  , S5_N = S5_TC * 16  ;
constexpr int SSD_NCH = SEQ / 128;
constexpr int MOE_MAXROWS = 2 * T + 32 * 256;
constexpr float NORM_EPS = 1e-6f;

constexpr size_t MiB = 1u << 20;
constexpr size_t WS_CTL = 0, CTL_ZERO_BYTES = 1 * MiB;
constexpr size_t WS_WIN = 1 * MiB;
constexpr size_t WS_WGLU = WS_WIN + (size_t)NINP * DM * 2;
constexpr size_t WS_PCAT = WS_WGLU + 1 * MiB;
constexpr size_t WS_WOUT = WS_PCAT + 4 * MiB;
constexpr size_t WS_EGU = WS_WOUT + 2 * MiB;
constexpr size_t WS_EDN = WS_EGU + 64 * MiB;
constexpr size_t WS_MG = WS_EDN + 32 * MiB;
constexpr size_t WS_EG = WS_MG + 20 * MiB;
constexpr size_t WS_XN = WS_EG + 8 * MiB;
constexpr size_t WS_P = WS_XN + 32 * MiB;
constexpr size_t WS_XG = WS_P;
constexpr size_t WS_HID = WS_XG + (size_t)MOE_MAXROWS * 1024 * 2;
constexpr size_t WS_YEXP = WS_HID + (size_t)MOE_MAXROWS * 512 * 2;
constexpr size_t WS_DT = WS_P + 216 * MiB;
constexpr size_t WS_UH = WS_DT + 1 * MiB;
constexpr size_t WS_HLOC = WS_UH + 20 * MiB;
constexpr size_t WS_YCAT = WS_HLOC + 8 * MiB;
constexpr size_t WS_SST = WS_YCAT + 64 * MiB;
constexpr size_t WS_MOE = WS_SST + 32 * MiB;
constexpr size_t WS_ASUM = WS_MOE + 1 * MiB;
constexpr size_t WS_END = WS_ASUM + 64 * 1024;
static_assert(WS_YEXP + (size_t)MOE_MAXROWS * 1024 * 2 <= WS_DT, "MoE overlay fits in P");
constexpr int CW_BAR = 4096;
constexpr int CW_CNT = 16384;

constexpr int NWAVES = 8, NTHR = 512;
constexpr int LDS_BYTES = 163840;
constexpr int RING_BYTES = 131072;
constexpr int MISC_OFF = 160 * 1024 - 256;

__device__ __forceinline__ unsigned f2bf(float f) { unsigned u = __builtin_bit_cast(unsigned, f); return (u + 0x7fffu + ((u >> 16) & 1u)) >> 16; }
__device__ __forceinline__ unsigned pk2(float lo, float hi) { return f2bf(lo) | (f2bf(hi) << 16); }
__device__ __forceinline__ float bf2f(unsigned b) { return __builtin_bit_cast(float, b << 16); }
__device__ __forceinline__ float bflo(unsigned w) { return __builtin_bit_cast(float, w << 16); }
__device__ __forceinline__ float bfhi(unsigned w) { return __builtin_bit_cast(float, w & 0xffff0000u); }
#define WS_DPP(v, ctrl, rmask) __builtin_bit_cast(float, __builtin_amdgcn_update_dpp(0, __builtin_bit_cast(int, v), ctrl, rmask, 0xF, false))
__device__ __forceinline__ float wave_sum(float v) {
    v += WS_DPP(v, 0xB1, 0xF);
    v += WS_DPP(v, 0x4E, 0xF);
    v += WS_DPP(v, 0x141, 0xF);
    v += WS_DPP(v, 0x140, 0xF);
    v += WS_DPP(v, 0x142, 0xA);
    v += WS_DPP(v, 0x143, 0xC);
    return __builtin_bit_cast(float, __builtin_amdgcn_readlane(__builtin_bit_cast(int, v), 63));
}
__device__ __forceinline__ float frcp(float x) { return __builtin_amdgcn_rcpf(x); }
__device__ __forceinline__ float sigmoidf_(float x) { return frcp(1.0f + __expf(-x)); }
__device__ __forceinline__ float siluf_(float x) { return x * frcp(1.0f + __expf(-x)); }
__device__ __forceinline__ float gelu_tanh_(float x) { const float u = 0.7978845608f * (x + 0.044715f * x * x * x); return x * frcp(1.0f + __expf(-2.0f * u)); }
__device__ __forceinline__ float softplusf_(float x) { return x > 20.f ? x : log1pf(__expf(x)); }

#define XB_TMO      128
#define XB_XCNT(j)  (256  + 64 * (j))
#define XB_XSUB(j)  (1280 + 64 * (j))
#define XB_XGEN(j)  (2304 + 64 * (j))
#define XB_TOP      3328
#define XB_TOPGEN   3392
#define XCD_BAR_WORDS 3456
#define XB_SPIN_CAP (1u << 18)
__device__ __forceinline__ unsigned xb_ld(unsigned* p)              { return __hip_atomic_load(p, __ATOMIC_RELAXED, __HIP_MEMORY_SCOPE_AGENT); }
__device__ __forceinline__ unsigned xb_add(unsigned* p, unsigned v) { return __hip_atomic_fetch_add(p, v, __ATOMIC_RELAXED, __HIP_MEMORY_SCOPE_AGENT); }
__device__ __forceinline__ unsigned xb_xcc_id() { return (unsigned)__builtin_amdgcn_s_getreg((3 << 11) | 20) & 0xFu; }
#define XB_SPIN(cond, bar) do { unsigned _sp = 0; while (cond) { __builtin_amdgcn_s_sleep(1); \
    if ((++_sp & 255u) == 0u) { if (xb_ld(&(bar)[XB_TMO])) break; if (_sp > XB_SPIN_CAP) { atomicAdd(&(bar)[XB_TMO], 1u); break; } } } } while (0)
struct XcdBarrier { unsigned* bar; unsigned x; volatile LAS unsigned* st; };
__device__ __forceinline__ XcdBarrier xcd_barrier_post(unsigned* bar, volatile LAS unsigned* st) {
    XcdBarrier b; b.bar = bar; b.x = xb_xcc_id(); b.st = st;
    if (threadIdx.x == 0) (void)xb_add(&bar[XB_XCNT(b.x)], 1u);
    return b;
}
__device__ __forceinline__ void xcd_barrier_complete(unsigned* bar, unsigned x, unsigned& nloc, unsigned& nx) {
    const unsigned G = gridDim.x * gridDim.y * gridDim.z;
    unsigned sum, cnt, mine, sp = 0u;
    for (;;) {
        sum = 0u; cnt = 0u; mine = 0u;
#pragma unroll
        for (unsigned j = 0; j < 16; ++j) { const unsigned c = xb_ld(&bar[XB_XCNT(j)]); sum += c; cnt += (c > 0u) ? 1u : 0u; mine = (j == x) ? c : mine; }
        if (sum == G) break;
        __builtin_amdgcn_s_sleep(1);
        if ((++sp & 255u) == 0u) { if (xb_ld(&bar[XB_TMO])) break; if (sp > XB_SPIN_CAP) { atomicAdd(&bar[XB_TMO], 1u); break; } }
    }
    nloc = mine > 0u ? mine : 1u; nx = cnt > 0u ? cnt : 1u;
}
__device__ __forceinline__ void xcd_barrier(const XcdBarrier& b) {
    asm volatile("s_waitcnt vmcnt(0)" ::: "memory");
    __syncthreads();
    if (threadIdx.x == 0) {
        unsigned* bar = b.bar;
        __builtin_amdgcn_s_waitcnt(0);
        unsigned nloc = b.st[0], nx = b.st[1];
        if (nloc == 0u) { xcd_barrier_complete(bar, b.x, nloc, nx); b.st[0] = nloc; b.st[1] = nx; }
        const unsigned old = xb_add(&bar[XB_XSUB(b.x)], 1u);
        const unsigned gen = old / nloc;
        if (old + 1u == (gen + 1u) * nloc) {
            __builtin_amdgcn_fence(__ATOMIC_RELEASE, "agent");
            asm volatile("s_waitcnt vmcnt(0)" ::: "memory");
            const unsigned og = xb_add(&bar[XB_TOP], 1u);
            const unsigned tg = og / nx;
            if (og + 1u == (tg + 1u) * nx) xb_add(&bar[XB_TOPGEN], 1u);
            else XB_SPIN(xb_ld(&bar[XB_TOPGEN]) == tg, bar);
            __builtin_amdgcn_fence(__ATOMIC_ACQUIRE, "agent");
            xb_add(&bar[XB_XGEN(b.x)], 1u);
            asm volatile("s_waitcnt vmcnt(0)" ::: "memory");
        } else {
            XB_SPIN(xb_ld(&bar[XB_XGEN(b.x)]) == gen, bar);
            __builtin_amdgcn_fence(__ATOMIC_ACQUIRE, "agent");
            asm volatile("s_waitcnt vmcnt(0)" ::: "memory");
        }
    }
    __syncthreads();
}

namespace pg8 {
constexpr int BM = 256, BK = 64, HALF = 128, HTB = HALF * BK * 2, STAGE_BYTES = 8 * HTB, NXCD = 8, WGM = 8;
__host__ __device__ __forceinline__ int lds_byte(int r, int c) { const int st = (r >> 4) * 2 + (c >> 5), rr = r & 15, cc = c & 31, ob = rr * 64 + cc * 2; return st * 1024 + (ob ^ (((ob >> 9) & 1) << 5)); }
__host__ __device__ __forceinline__ void stage_rc(int b, int& R, int& C) { const int st = b / 1024, sb = b % 1024, swz = sb ^ (((sb >> 9) & 1) << 5); R = (st >> 1) * 16 + swz / 64; C = (st & 1) * 32 + (swz % 64) / 2; }
__host__ __device__ __forceinline__ int perm32(int rho) { const int n = rho >> 4, i = rho & 15; return 8 * (i >> 2) + 4 * n + (i & 3); }

struct Unit { const char* A; const char* B; int nt; int pm, pn, aux; };

__device__ __forceinline__ void tile_order(int L, int nM, int nN, int& pm, int& pn) {
    const int nwg = nM * nN; int wgid = L;
    { const int q = nwg / NXCD, r = nwg % NXCD, xcd = wgid % NXCD, off = wgid / NXCD; wgid = (xcd < r ? xcd * (q + 1) : r * (q + 1) + (xcd - r) * q) + off; }
    const int nig = WGM * nN, gid = wgid / nig, fm = gid * WGM, gsz = (nM - fm) < WGM ? (nM - fm) : WGM;
    pm = fm + ((wgid % nig) % gsz); pn = (wgid % nig) / gsz;
}
__device__ __forceinline__ unsigned cvt_pk_bf16(float lo, float hi) { unsigned r; asm volatile("v_cvt_pk_bf16_f32 %0, %1, %2" : "=v"(r) : "v"(lo), "v"(hi)); return r; }
__device__ __forceinline__ u32x4 pack8(const f32x4 v0, const f32x4 v1) { u32x4 w; w.x = cvt_pk_bf16(v0[0], v0[1]); w.y = cvt_pk_bf16(v0[2], v0[3]); w.z = cvt_pk_bf16(v1[0], v1[1]); w.w = cvt_pk_bf16(v1[2], v1[3]); return w; }

template <unsigned lda, unsigned ldb, class Epi, class Sched>
__device__ __forceinline__ void gemm_phase(const int tid, LAS unsigned char* lds, const Sched& S, const Epi& E) {
    const int wid = __builtin_amdgcn_readfirstlane(tid >> 6), lane = tid & 63, wr = wid >> 2, wc = wid & 3, fr = lane & 15, fq = lane >> 4;
    unsigned voffA[2], voffB[2];
#pragma unroll
    for (int i = 0; i < 2; ++i) { int R, C; stage_rc(tid * 16 + i * 8192, R, C); const int Rb = Epi::PERM ? ((R & ~31) + perm32(R & 31)) : R;
        voffA[i] = (unsigned)R * lda + (unsigned)C * 2u; voffB[i] = (unsigned)Rb * ldb + (unsigned)C * 2u; }
    const size_t kstep = (size_t)(BK * 2);
    const size_t hstepA = (size_t)HALF * lda, hstepB = (size_t)HALF * ldb;
    const unsigned ldsw = (unsigned)wid * 1024u;
    const int aoff = lds_byte(wr * 64 + fr, fq * 8), boff = lds_byte(wc * 32 + fr, fq * 8);
#define PG8_SA(b, h) (((b) * 2 + (h)) * HTB)
#define PG8_SB(b, h) ((4 + (b) * 2 + (h)) * HTB)
#define PG8_STAGE(bufoff, gbase, voff) do { const char* _gb = (const char*)(gbase); asm volatile("" : "+s"(_gb)); _Pragma("unroll") for (int _i = 0; _i < 2; ++_i) \
        __builtin_amdgcn_global_load_lds((const unsigned*)(_gb + (voff)[_i]), (LAS unsigned*)(lds + (bufoff) + ldsw + _i * 8192), 16, 0, 0); } while (0)
#define PG8_LDA(dst, b, h) do { _Pragma("unroll") for (int m = 0; m < 4; ++m) _Pragma("unroll") for (int k = 0; k < 2; ++k) dst[m][k] = *(const LAS bf16x8*)(lds + PG8_SA(b, h) + aoff + m * 2048 + k * 1024); } while (0)
#define PG8_LDB(dst, b, h) do { _Pragma("unroll") for (int n = 0; n < 2; ++n) _Pragma("unroll") for (int k = 0; k < 2; ++k) dst[n][k] = *(const LAS bf16x8*)(lds + PG8_SB(b, h) + boff + n * 2048 + k * 1024); } while (0)
#define PG8_MMA(ai, bj, At, Bt) do { __builtin_amdgcn_s_setprio(1); _Pragma("unroll") for (int m = 0; m < 4; ++m) _Pragma("unroll") for (int n = 0; n < 2; ++n) _Pragma("unroll") for (int k = 0; k < 2; ++k) \
        acc[ai][bj][m][n] = __builtin_amdgcn_mfma_f32_16x16x32_bf16(Bt[n][k], At[m][k], acc[ai][bj][m][n], 0, 0, 0); __builtin_amdgcn_s_setprio(0); } while (0)
#define PG8_WAIT_V(n) asm volatile("s_waitcnt vmcnt(" #n ")" ::: "memory")
#define PG8_WAIT_L(n) asm volatile("s_waitcnt lgkmcnt(" #n ")" ::: "memory")
#define PG8_BAR __builtin_amdgcn_s_barrier()
#define PG8_SCHED __builtin_amdgcn_sched_barrier(0)
    Unit cur, nxt; int ui = 0;
    if (!S.next(0, cur)) return;
    f32x4 acc[2][2][4][2];
#pragma unroll
    for (int a = 0; a < 2; ++a)
#pragma unroll
        for (int b = 0; b < 2; ++b)
#pragma unroll
            for (int m = 0; m < 4; ++m)
#pragma unroll
                for (int n = 0; n < 2; ++n) acc[a][b][m][n] = (f32x4){0.f, 0.f, 0.f, 0.f};
    bf16x8 At[4][2], B0[2][2], B1[2][2];
    const char* cA = cur.A; const char* cB = cur.B;
    PG8_STAGE(PG8_SB(0, 0), cB, voffB); PG8_STAGE(PG8_SB(0, 1), cB + hstepB, voffB); PG8_STAGE(PG8_SA(0, 0), cA, voffA); PG8_STAGE(PG8_SA(0, 1), cA + hstepA, voffA);
    if (wr == 1) PG8_BAR;
    PG8_WAIT_V(2); PG8_BAR;
    PG8_STAGE(PG8_SB(1, 0), cB + kstep, voffB); PG8_STAGE(PG8_SA(1, 0), cA + kstep, voffA); PG8_STAGE(PG8_SB(1, 1), cB + hstepB + kstep, voffB);
    PG8_WAIT_V(6); PG8_BAR;
    for (;;) {
        const bool has_next = S.next(ui + 1, nxt);
        const char* nA = has_next ? nxt.A : cA; const char* nB = has_next ? nxt.B : cB;
        const int nt = cur.nt;
        for (int t = 0; t < nt; t += 2) {
            const bool last = (t == nt - 2);
            const char* a1 = cA + (size_t)(t + 1) * kstep;
            const char* a2 = last ? nA : cA + (size_t)(t + 2) * kstep; const char* b2 = last ? nB : cB + (size_t)(t + 2) * kstep;
            const char* a3 = a2 + kstep; const char* b3 = b2 + kstep;
            PG8_LDB(B0, 0, 0); PG8_LDB(B1, 0, 1); PG8_SCHED; PG8_LDA(At, 0, 0); PG8_STAGE(PG8_SA(1, 1), a1 + hstepA, voffA);
            PG8_WAIT_V(8); PG8_WAIT_L(0); PG8_BAR; PG8_MMA(0, 0, At, B0); PG8_MMA(0, 1, At, B1); PG8_BAR; PG8_SCHED;
            PG8_LDA(At, 0, 1); PG8_STAGE(PG8_SB(0, 0), b2, voffB); PG8_STAGE(PG8_SB(0, 1), b2 + hstepB, voffB); PG8_STAGE(PG8_SA(0, 0), a2, voffA);
            PG8_WAIT_V(8); PG8_WAIT_L(0); PG8_BAR; PG8_MMA(1, 0, At, B0); PG8_MMA(1, 1, At, B1); PG8_BAR; PG8_SCHED;
            PG8_LDB(B0, 1, 0); PG8_LDB(B1, 1, 1); PG8_SCHED; PG8_LDA(At, 1, 0); PG8_STAGE(PG8_SA(0, 1), a2 + hstepA, voffA);
            PG8_WAIT_V(8); PG8_WAIT_L(0); PG8_BAR; PG8_MMA(0, 0, At, B0); PG8_MMA(0, 1, At, B1); PG8_BAR; PG8_SCHED;
            PG8_LDA(At, 1, 1); PG8_STAGE(PG8_SB(1, 0), b3, voffB); PG8_STAGE(PG8_SB(1, 1), b3 + hstepB, voffB); PG8_STAGE(PG8_SA(1, 0), a3, voffA);
            PG8_WAIT_V(8); PG8_WAIT_L(0); PG8_BAR; PG8_MMA(1, 0, At, B0); PG8_MMA(1, 1, At, B1); PG8_BAR; PG8_SCHED;
            if constexpr (Epi::HAS_MID) { if (t + 2 == 8 || t + 2 == 16) { E.mid(acc, cur, t + 2, wr, wc, fr, fq); PG8_SCHED; } }
        }
        if (wr == 0) PG8_BAR;
        E(acc, cur, wr, wc, fr, fq);
        if (!has_next) break;
#pragma unroll
        for (int a = 0; a < 2; ++a)
#pragma unroll
            for (int b = 0; b < 2; ++b)
#pragma unroll
                for (int m = 0; m < 4; ++m)
#pragma unroll
                    for (int n = 0; n < 2; ++n) acc[a][b][m][n] = (f32x4){0.f, 0.f, 0.f, 0.f};
        cur = nxt; cA = nA; cB = nB; ++ui;
        if (wr == 1) PG8_BAR;
    }
    PG8_WAIT_V(0);
    PG8_BAR;
#undef PG8_SA
#undef PG8_SB
#undef PG8_STAGE
#undef PG8_LDA
#undef PG8_LDB
#undef PG8_MMA
#undef PG8_WAIT_V
#undef PG8_WAIT_L
#undef PG8_BAR
#undef PG8_SCHED
}
}

struct Frame {
    LAS unsigned char* lds;
    volatile LAS unsigned* MISC;
    unsigned* ctl;
    int tid, lane, wave, G, bid;
    const float* const __attribute__((address_space(4)))* in;
    float* out; unsigned char* ws;
};
enum { IN_X = 0, IN_NORM1, IN_WIN, IN_BGATE, IN_LRE, IN_LIM, IN_BRE, IN_BIM, IN_CRE, IN_CIM, IN_S5D, IN_LOGDT, IN_GLU1, IN_GLU2, IN_QG, IN_KG, IN_SINK,
       IN_CONVW, IN_CONVB, IN_DTB, IN_ALOG, IN_SSDD, IN_SSDG, IN_PS5, IN_PATTN, IN_PSSD, IN_WOUT, IN_NORM2, IN_WRG, IN_BRG, IN_WRE, IN_BRE_, IN_EG, IN_EU, IN_ED, N_INPUTS };

#define LDS_WAIT() asm volatile("s_waitcnt lgkmcnt(0)" ::: "memory")
#define VM_WAIT() asm volatile("s_waitcnt vmcnt(0)" ::: "memory")

using pg8::Unit; using pg8::pack8;
struct EpiProj {
    static constexpr bool PERM = true, HAS_MID = false;
    unsigned char* ws; const float* bgate;
    __device__ __forceinline__ void operator()(const f32x4 (&acc)[2][2][4][2], const Unit& u, int wr, int wc, int fr, int fq) const {
        bf16_t* P = (bf16_t*)(ws + WS_P); bf16_t* UH = (bf16_t*)(ws + WS_UH); float* DT = (float*)(ws + WS_DT);
        const int row0 = u.pm * 256 + wr * 64 + fr;
        if (u.pn < 2) {
#pragma unroll
            for (int ai = 0; ai < 2; ++ai)
#pragma unroll
                for (int m = 0; m < 4; ++m) { const int row = row0 + ai * 128 + m * 16, r = row >> 5, s = row & 31;
#pragma unroll
                    for (int bj = 0; bj < 2; ++bj) { const int col = u.pn * 256 + bj * 128 + wc * 32 + 8 * fq, g = col >> 4, c0 = col & 15;
                        *(u32x4*)(UH + ((size_t)(g * S5_ROWS + r) * S5_K + 128 + s * 16 + c0)) = pack8(acc[ai][bj][m][0], acc[ai][bj][m][1]); } }
        } else {
            const int colb = u.pn * 256 + wc * 32 + 8 * fq;
            f32x4 bv[2][2];
#pragma unroll
            for (int bj = 0; bj < 2; ++bj)
#pragma unroll
                for (int n = 0; n < 2; ++n) bv[bj][n] = (u.pn >= 15) ? *(const f32x4*)(bgate + (colb - C_G) + bj * 128 + 4 * n) : (f32x4){0.f, 0.f, 0.f, 0.f};
#pragma unroll
            for (int ai = 0; ai < 2; ++ai)
#pragma unroll
                for (int m = 0; m < 4; ++m) { const int row = row0 + ai * 128 + m * 16;
#pragma unroll
                    for (int bj = 0; bj < 2; ++bj) *(u32x4*)(P + (size_t)row * NINP + colb + bj * 128) = pack8(acc[ai][bj][m][0] + bv[bj][0], acc[ai][bj][m][1] + bv[bj][1]);
                    if (u.pn == 14 && wc == 0 && fq < 2) { float* d = DT + (size_t)row * 16 + 8 * fq; *(f32x4*)d = acc[ai][0][m][0]; *(f32x4*)(d + 4) = acc[ai][0][m][1]; } }
        }
    }
};
struct EpiHloc {
    static constexpr bool PERM = false, HAS_MID = false;
    float* H;
    __device__ __forceinline__ void operator()(const f32x4 (&acc)[2][2][4][2], const Unit& u, int wr, int wc, int fr, int fq) const {
#pragma unroll
        for (int ai = 0; ai < 2; ++ai)
#pragma unroll
            for (int m = 0; m < 4; ++m) { const int r = u.pm * 256 + ai * 128 + wr * 64 + m * 16 + fr; float* rowp = H + ((size_t)(u.aux * S5_ROWS + r) * 128) + wc * 32 + 4 * fq;
#pragma unroll
                for (int n = 0; n < 2; ++n) *(f32x4*)(rowp + 16 * n) = acc[ai][0][m][n]; }
    }
};
struct EpiS5Y {
    static constexpr bool PERM = true, HAS_MID = false;
    bf16_t* Y;
    __device__ __forceinline__ void operator()(const f32x4 (&acc)[2][2][4][2], const Unit& u, int wr, int wc, int fr, int fq) const {
#pragma unroll
        for (int ai = 0; ai < 2; ++ai)
#pragma unroll
            for (int m = 0; m < 4; ++m) { const int r = u.pm * 256 + ai * 128 + wr * 64 + m * 16 + fr;
#pragma unroll
                for (int bj = 0; bj < 2; ++bj) { const int n0 = u.pn * 256 + bj * 128 + wc * 32 + 8 * fq, t = n0 >> 4, c0 = n0 & 15;
                    f32x4 v0 = acc[ai][bj][m][0], v1 = acc[ai][bj][m][1];
#pragma unroll
                    for (int j = 0; j < 4; ++j) { v0[j] = gelu_tanh_(v0[j]); v1[j] = gelu_tanh_(v1[j]); }
                    *(u32x4*)(Y + ((size_t)(r * S5_TC + t) * 512 + u.aux * 16 + c0)) = pack8(v0, v1); } }
    }
};
struct EpiGlu {
    static constexpr bool PERM = true, HAS_MID = false;
    bf16_t* Y;
    __device__ __forceinline__ void operator()(const f32x4 (&acc)[2][2][4][2], const Unit& u, int wr, int wc, int fr, int fq) const {
#pragma unroll
        for (int ai = 0; ai < 2; ++ai)
#pragma unroll
            for (int m = 0; m < 4; ++m) { const int row = u.pm * 256 + ai * 128 + wr * 64 + m * 16 + fr;
                f32x4 v0 = acc[ai][0][m][0], v1 = acc[ai][0][m][1]; const f32x4 g0 = acc[ai][1][m][0], g1 = acc[ai][1][m][1];
#pragma unroll
                for (int j = 0; j < 4; ++j) { v0[j] *= sigmoidf_(g0[j]); v1[j] *= sigmoidf_(g1[j]); }
                *(u32x4*)(Y + (size_t)row * 2048 + u.pn * 128 + wc * 32 + 8 * fq) = pack8(v0, v1); }
    }
};
struct EpiSwiGlu {
    static constexpr bool PERM = true, HAS_MID = false;
    bf16_t* Y;
    __device__ __forceinline__ void operator()(const f32x4 (&acc)[2][2][4][2], const Unit& u, int wr, int wc, int fr, int fq) const {
#pragma unroll
        for (int ai = 0; ai < 2; ++ai)
#pragma unroll
            for (int m = 0; m < 4; ++m) { const int row = u.pm * 256 + ai * 128 + wr * 64 + m * 16 + fr;
                f32x4 v0 = acc[ai][0][m][0], v1 = acc[ai][0][m][1]; const f32x4 g0 = acc[ai][1][m][0], g1 = acc[ai][1][m][1];
#pragma unroll
                for (int j = 0; j < 4; ++j) { v0[j] = siluf_(v0[j]) * g0[j]; v1[j] = siluf_(v1[j]) * g1[j]; }
                *(u32x4*)(Y + (size_t)row * 512 + u.pn * 128 + wc * 32 + 8 * fq) = pack8(v0, v1); }
    }
};
struct EpiPlainBf16 {
    static constexpr bool PERM = true, HAS_MID = false;
    bf16_t* O;
    __device__ __forceinline__ void operator()(const f32x4 (&acc)[2][2][4][2], const Unit& u, int wr, int wc, int fr, int fq) const {
#pragma unroll
        for (int ai = 0; ai < 2; ++ai)
#pragma unroll
            for (int m = 0; m < 4; ++m) { const int row = u.pm * 256 + ai * 128 + wr * 64 + m * 16 + fr;
#pragma unroll
                for (int bj = 0; bj < 2; ++bj) *(u32x4*)(O + (size_t)row * 1024 + u.pn * 256 + bj * 128 + wc * 32 + 8 * fq) = pack8(acc[ai][bj][m][0], acc[ai][bj][m][1]); }
    }
};
struct EpiMerged {
    static constexpr bool PERM = true, HAS_MID = true;
    unsigned char* ws;
    __device__ __forceinline__ static float lclamp(float l) { return fminf(fmaxf(l, -30.f), 30.f); }
    __device__ __forceinline__ void mid(f32x4 (&acc)[2][2][4][2], const Unit& u, int kt, int wr, int wc, int fr, int fq) const {
        const int br = (kt == 8) ? 0 : 1; const bf16_t* P = (const bf16_t*)(ws + WS_P);
#pragma unroll
        for (int ai = 0; ai < 2; ++ai)
#pragma unroll
            for (int m = 0; m < 4; ++m) { const int row = u.pm * 256 + ai * 128 + wr * 64 + m * 16 + fr;
#pragma unroll
                for (int bj = 0; bj < 2; ++bj) { const bf16_t* gp = P + (size_t)row * NINP + C_G + br * 1024 + u.pn * 256 + bj * 128 + wc * 32 + 8 * fq;
                    const u32x4 la = *(const u32x4*)gp, lb = *(const u32x4*)(gp + 1024);
#pragma unroll
                    for (int j = 0; j < 4; ++j) { const unsigned wa = la[j], wb = lb[j];
                        const float r0 = (1.f + __expf(-lclamp(bflo(wb)))) * frcp(1.f + __expf(-lclamp(bflo(wa)))), r1 = (1.f + __expf(-lclamp(bfhi(wb)))) * frcp(1.f + __expf(-lclamp(bfhi(wa))));
                        if (j < 2) { acc[ai][bj][m][0][2 * j] *= r0; acc[ai][bj][m][0][2 * j + 1] *= r1; } else { acc[ai][bj][m][1][2 * j - 4] *= r0; acc[ai][bj][m][1][2 * j - 3] *= r1; } } }
                if (m == 3) asm volatile("" ::: "memory"); }
    }
    __device__ __forceinline__ void operator()(const f32x4 (&acc)[2][2][4][2], const Unit& u, int wr, int wc, int fr, int fq) const {
        const bf16_t* P = (const bf16_t*)(ws + WS_P); bf16_t* O = (bf16_t*)(ws + WS_XN);
#pragma unroll
        for (int ai = 0; ai < 2; ++ai)
#pragma unroll
            for (int m = 0; m < 4; ++m) { const int row = u.pm * 256 + ai * 128 + wr * 64 + m * 16 + fr;
#pragma unroll
                for (int bj = 0; bj < 2; ++bj) { const int col = u.pn * 256 + bj * 128 + wc * 32 + 8 * fq;
                    const u32x4 lc = *(const u32x4*)(P + (size_t)row * NINP + C_G + 2048 + col);
                    f32x4 v0 = acc[ai][bj][m][0], v1 = acc[ai][bj][m][1];
                    v0[0] *= sigmoidf_(lclamp(bflo(lc[0]))); v0[1] *= sigmoidf_(lclamp(bfhi(lc[0]))); v0[2] *= sigmoidf_(lclamp(bflo(lc[1]))); v0[3] *= sigmoidf_(lclamp(bfhi(lc[1])));
                    v1[0] *= sigmoidf_(lclamp(bflo(lc[2]))); v1[1] *= sigmoidf_(lclamp(bfhi(lc[2]))); v1[2] *= sigmoidf_(lclamp(bflo(lc[3]))); v1[3] *= sigmoidf_(lclamp(bfhi(lc[3])));
                    *(u32x4*)(O + (size_t)row * 1024 + col) = pack8(v0, v1); }
                if (m == 3) asm volatile("" ::: "memory"); }
    }
};
struct EpiResid {
    static constexpr bool PERM = false, HAS_MID = false;
    const float* resid; float* out;
    __device__ __forceinline__ void operator()(const f32x4 (&acc)[2][2][4][2], const Unit& u, int wr, int wc, int fr, int fq) const {
#pragma unroll
        for (int ai = 0; ai < 2; ++ai)
#pragma unroll
            for (int m = 0; m < 4; ++m) { const size_t off = (size_t)(u.pm * 256 + ai * 128 + wr * 64 + m * 16 + fr) * 1024 + u.pn * 256 + wc * 32 + 4 * fq;
#pragma unroll
                for (int bj = 0; bj < 2; ++bj)
#pragma unroll
                    for (int n = 0; n < 2; ++n) { const f32x4 rv = *(const f32x4*)(resid + off + bj * 128 + n * 16); *(f32x4*)(out + off + bj * 128 + n * 16) = rv + acc[ai][bj][m][n]; } }
    }
};

template <unsigned lda, unsigned ldb, int nM, int nN, int NT>
struct SchedDense {
    const char* A; const char* B; int G, c;
    __device__ __forceinline__ bool next(int i, Unit& u) const {
        const int L = i * G + c; if (L >= nM * nN) return false;
        int pm, pn; pg8::tile_order(L, nM, nN, pm, pn);
        u.A = A + (size_t)pm * 256 * lda; u.B = B + (size_t)pn * 256 * ldb; u.nt = NT; u.pm = pm; u.pn = pn; u.aux = 0; return true;
    }
};
struct SchedS5P1 {
    const char* UH; const char* EG; int G, c;
    __device__ __forceinline__ bool next(int i, Unit& u) const {
        const int L = i * G + c; if (L >= 64) return false;
        const int g = L >> 1, pm = L & 1;
        u.A = UH + ((size_t)(g * S5_ROWS + pm * 256) * S5_K + 128) * 2; u.B = EG + (size_t)g * 256 * 512 * 2; u.nt = 8; u.pm = pm; u.pn = 0; u.aux = g; return true;
    }
};
struct SchedS5Main {
    const char* UH; const char* MG; int G, c;
    __device__ __forceinline__ bool next(int i, Unit& u) const {
        const int L = i * G + c; if (L >= 128) return false;
        const int g = L >> 2, pm = (L >> 1) & 1, pn = L & 1;
        u.A = UH + (size_t)(g * S5_ROWS + pm * 256) * S5_K * 2; u.B = MG + (size_t)(g * S5_N + pn * 256) * S5_K * 2; u.nt = 2 + 4 * (pn + 1); u.pm = pm; u.pn = pn; u.aux = g; return true;
    }
};
template <unsigned lda, size_t bexp  , size_t btile  , int NT>
struct SchedMoe {
    const char* A; const char* B; int ntiles, G, c; const volatile LAS int* tile_e;
    __device__ __forceinline__ bool next(int i, Unit& u) const {
        const int L = i * G + c; if (L >= ntiles * 4) return false;
        int pm, pn; pg8::tile_order(L, ntiles, 4, pm, pn);
        const int e = __builtin_amdgcn_readfirstlane(tile_e[pm]);
        u.A = A + (size_t)pm * 256 * lda; u.B = B + (size_t)e * bexp + (size_t)pn * btile; u.nt = NT; u.pm = pm; u.pn = pn; u.aux = e; return true;
    }
};

__device__ __forceinline__ void transpose_item(const float* W, int ldw, int ncols, bf16_t* WT, int ldt, int kofs, int mode, int p0, int p1, LAS float* scr, int k0, int n0, int lane) {
#pragma unroll 8
    for (int i = 0; i < 32; ++i) { const int kk = 2 * i + (lane >> 5), n = n0 + (lane & 31); scr[kk * 33 + (lane & 31)] = (n < ncols) ? W[(size_t)(k0 + kk) * ldw + n] : 0.f; }
    LDS_WAIT(); asm volatile("" ::: "memory");
    const int c = lane & 7;
#pragma unroll
    for (int j = 0; j < 4; ++j) { const int nn = (lane >> 3) + 8 * j, n = n0 + nn; const LAS float* s = scr + (8 * c) * 33 + nn;
        u32x4 o; o.x = pk2(s[0 * 33], s[1 * 33]); o.y = pk2(s[2 * 33], s[3 * 33]); o.z = pk2(s[4 * 33], s[5 * 33]); o.w = pk2(s[6 * 33], s[7 * 33]);
        const int drow = (mode == 0) ? n + (n >= p0 ? p1 : 0) : ((n >> 7) * 256 + (n & 127) + 128 * p0);
        if (n < ncols) *(u32x4*)(WT + (size_t)drow * ldt + kofs + k0 + 8 * c) = o; }
    LDS_WAIT(); asm volatile("" ::: "memory");
}
__device__ __forceinline__ void convert_weights(Frame& F, int layer) {
    LAS float* scr = (LAS float*)(F.lds + F.wave * 16384);
    const int gw = F.bid * NWAVES + F.wave, NGW = F.G * NWAVES;
    bf16_t* WIN = (bf16_t*)(F.ws + WS_WIN); bf16_t* WGLU = (bf16_t*)(F.ws + WS_WGLU); bf16_t* PCAT = (bf16_t*)(F.ws + WS_PCAT); bf16_t* WOUT = (bf16_t*)(F.ws + WS_WOUT);
    bf16_t* EGU = (bf16_t*)(F.ws + WS_EGU); bf16_t* EDN = (bf16_t*)(F.ws + WS_EDN);
    constexpr int I_WIN = 16 * 209, I_GLU = 8 * 16, I_P5 = 8 * 32, I_PS = 16 * 32, I_WO = 16 * 32, I_EG = 32 * 256, I_ED = 32 * 256;
    constexpr int NITEMS = I_WIN + 2 * I_GLU + 2 * I_P5 + I_PS + I_WO + 2 * I_EG + I_ED;
    for (int it = gw; it < NITEMS; it += NGW) {
        int r = it;
        if (r < I_WIN) { transpose_item(F.in[IN_WIN] + (size_t)layer * DM * NIN, NIN, NIN, WIN, DM, 0, 0, 3600, 240, scr, 64 * (r / 209), 32 * (r % 209), F.lane); continue; } r -= I_WIN;
        if (r < I_GLU) { transpose_item(F.in[IN_GLU1] + (size_t)layer * 512 * 512, 512, 512, WGLU, 512, 0, 1, 0, 0, scr, 64 * (r / 16), 32 * (r % 16), F.lane); continue; } r -= I_GLU;
        if (r < I_GLU) { transpose_item(F.in[IN_GLU2] + (size_t)layer * 512 * 512, 512, 512, WGLU, 512, 0, 1, 1, 0, scr, 64 * (r / 16), 32 * (r % 16), F.lane); continue; } r -= I_GLU;
        if (r < I_P5) { transpose_item(F.in[IN_PS5] + (size_t)layer * 512 * 1024, 1024, 1024, PCAT, 2048, 0, 0, 1 << 30, 0, scr, 64 * (r / 32), 32 * (r % 32), F.lane); continue; } r -= I_P5;
        if (r < I_P5) { transpose_item(F.in[IN_PATTN] + (size_t)layer * 512 * 1024, 1024, 1024, PCAT, 2048, 512, 0, 1 << 30, 0, scr, 64 * (r / 32), 32 * (r % 32), F.lane); continue; } r -= I_P5;
        if (r < I_PS) { transpose_item(F.in[IN_PSSD] + (size_t)layer * 1024 * 1024, 1024, 1024, PCAT, 2048, 1024, 0, 1 << 30, 0, scr, 64 * (r / 32), 32 * (r % 32), F.lane); continue; } r -= I_PS;
        if (r < I_WO) { transpose_item(F.in[IN_WOUT] + (size_t)layer * 1024 * 1024, 1024, 1024, WOUT, 1024, 0, 0, 1 << 30, 0, scr, 64 * (r / 32), 32 * (r % 32), F.lane); continue; } r -= I_WO;
        if (r < I_EG) { const int e = r >> 8, q = r & 255; transpose_item(F.in[IN_EG] + ((size_t)layer * 32 + e) * 1024 * 512, 512, 512, EGU + (size_t)e * 1024 * 1024, 1024, 0, 1, 0, 0, scr, 64 * (q / 16), 32 * (q % 16), F.lane); continue; } r -= I_EG;
        if (r < I_EG) { const int e = r >> 8, q = r & 255; transpose_item(F.in[IN_EU] + ((size_t)layer * 32 + e) * 1024 * 512, 512, 512, EGU + (size_t)e * 1024 * 1024, 1024, 0, 1, 1, 0, scr, 64 * (q / 16), 32 * (q % 16), F.lane); continue; } r -= I_EG;
        { const int e = r >> 8, q = r & 255; transpose_item(F.in[IN_ED] + ((size_t)layer * 32 + e) * 512 * 1024, 1024, 1024, EDN + (size_t)e * 1024 * 512, 512, 0, 0, 1 << 30, 0, scr, 64 * (q / 32), 32 * (q % 32), F.lane); }
    }
}
__device__ __forceinline__ void sincos_fast(float x, float& s, float& c) {
    const float k = rintf(x * 0.15915494309189535f);
    float r = fmaf(-k, 6.2831854820251465f, x); r = fmaf(-k, -1.7484555e-07f, r);
    s = __sinf(r); c = __cosf(r);
}
__device__ __forceinline__ void sincos_red(float x, float& s, float& c) {
    const float k = rintf(x * 0.15915494309189535f);
    float r = fmaf(-k, 6.2831854820251465f, x); r = fmaf(-k, -1.7484555e-07f, r);
    s = sinf(r); c = cosf(r);
}
__device__ __forceinline__ void s5_build(Frame& F, int layer) {
    LAS float* pw = (LAS float*)F.lds;
    LAS float* Bb = pw + 33 * 64 * 2;
    LAS float* Cc = Bb + 64 * 16 * 2;
    LAS float* Kd = Cc + 16 * 64 * 2;
    bf16_t* MG = (bf16_t*)(F.ws + WS_MG); bf16_t* EG = (bf16_t*)(F.ws + WS_EG);
    for (int w = F.bid; w < 256; w += F.G) {
        const int g = w >> 3, part = w & 7, gi = layer * 32 + g;
        __syncthreads();
        const float dt = __expf(F.in[IN_LOGDT][gi]);
        for (int i = F.tid; i < 33 * 64; i += NTHR) { const int d = i >> 6, p = i & 63; const float lr = F.in[IN_LRE][gi * 64 + p], li = F.in[IN_LIM][gi * 64 + p];
            float s, c; sincos_red((float)d * li * dt, s, c); const float mg = __expf((float)d * lr * dt); pw[2 * i] = mg * c; pw[2 * i + 1] = mg * s; }
        for (int i = F.tid; i < 64 * 16; i += NTHR) { const int p = i >> 4; const float lr = F.in[IN_LRE][gi * 64 + p], li = F.in[IN_LIM][gi * 64 + p];
            float s, c; sincos_red(li * dt, s, c); const float mg = __expf(lr * dt), are = mg * c, aim = mg * s, nr = are - 1.f, den = lr * lr + li * li;
            const float fre = (nr * lr + aim * li) / den, fim = (aim * lr - nr * li) / den;
            const float br = F.in[IN_BRE][(size_t)gi * 1024 + i], bi = F.in[IN_BIM][(size_t)gi * 1024 + i];
            Bb[2 * i] = fre * br - fim * bi; Bb[2 * i + 1] = fre * bi + fim * br; }
        for (int i = F.tid; i < 16 * 64; i += NTHR) { Cc[2 * i] = F.in[IN_CRE][(size_t)gi * 1024 + i]; Cc[2 * i + 1] = F.in[IN_CIM][(size_t)gi * 1024 + i]; }
        __syncthreads();
        { const int d = F.tid >> 4, c = F.tid & 15; float acc[16];
#pragma unroll
          for (int j = 0; j < 16; ++j) acc[j] = 0.f;
          for (int p = 0; p < 64; ++p) { const float cr = Cc[2 * (c * 64 + p)], ci = Cc[2 * (c * 64 + p) + 1], pr = pw[2 * (d * 64 + p)], pi = pw[2 * (d * 64 + p) + 1];
              const float xr = cr * pr - ci * pi, xi = cr * pi + ci * pr;
#pragma unroll
              for (int q = 0; q < 8; ++q) { const f32x4 bb = *(const LAS f32x4*)(Bb + 2 * (p * 16) + 4 * q); acc[2 * q] += xr * bb.x - xi * bb.y; acc[2 * q + 1] += xr * bb.z - xi * bb.w; } }
#pragma unroll
          for (int j = 0; j < 16; ++j) Kd[(d * 16 + c) * 16 + j] = acc[j]; }
        __syncthreads();
        for (int v = F.tid; v < 64 * 80; v += NTHR) { const int n = part * 64 + v / 80, k0 = (v % 80) * 8, t = n >> 4, c = n & 15; float o[8];
            if (k0 < 128) { const int im = k0 >= 64, p0 = k0 & 63;
#pragma unroll
                for (int j = 0; j < 8; ++j) { const int p = p0 + j; const float cr = Cc[2 * (c * 64 + p)], ci = Cc[2 * (c * 64 + p) + 1], pr = pw[2 * ((t + 1) * 64 + p)], pi = pw[2 * ((t + 1) * 64 + p) + 1];
                    o[j] = im ? -(cr * pi + ci * pr) : (cr * pr - ci * pi); }
            } else { const int s = (k0 - 128) >> 4, c0 = (k0 - 128) & 15;
#pragma unroll
                for (int j = 0; j < 8; ++j) { float x = 0.f; if (s <= t) { x = Kd[(t - s) * 256 + c * 16 + c0 + j]; if (s == t && c == c0 + j) x += F.in[IN_S5D][layer * 512 + g * 16 + c]; } o[j] = x; } }
            u32x4 q; q.x = pk2(o[0], o[1]); q.y = pk2(o[2], o[3]); q.z = pk2(o[4], o[5]); q.w = pk2(o[6], o[7]);
            *(u32x4*)(MG + ((size_t)(g * S5_N + n) * S5_K + k0)) = q; }
        for (int v = F.tid; v < 16 * 64; v += NTHR) { const int jr = part * 16 + v / 64, k0 = (v % 64) * 8, im = jr >= 64, p = jr & 63, s = k0 >> 4, c0 = k0 & 15; float o[8];
            const float pr = pw[2 * ((S5_TC - 1 - s) * 64 + p)], pi = pw[2 * ((S5_TC - 1 - s) * 64 + p) + 1];
#pragma unroll
            for (int j = 0; j < 8; ++j) { const float br = Bb[2 * (p * 16 + c0 + j)], bi = Bb[2 * (p * 16 + c0 + j) + 1]; o[j] = im ? (pr * bi + pi * br) : (pr * br - pi * bi); }
            u32x4 q; q.x = pk2(o[0], o[1]); q.y = pk2(o[2], o[3]); q.z = pk2(o[4], o[5]); q.w = pk2(o[6], o[7]);
            *(u32x4*)(EG + ((size_t)(g * 256 + jr) * 512 + k0)) = q; }
    }
    __syncthreads();
}
__device__ __forceinline__ void rms_row_to_bf16(const float* xrow, const float* gain, bf16_t* orow, int lane) {
    const f32x4* xr = (const f32x4*)xrow + lane; const f32x4* gr = (const f32x4*)gain + lane;
    f32x4 v[4]; float s = 0.f;
#pragma unroll
    for (int j = 0; j < 4; ++j) { v[j] = xr[64 * j]; s += (v[j].x * v[j].x + v[j].y * v[j].y) + (v[j].z * v[j].z + v[j].w * v[j].w); }
    const float rstd = __builtin_amdgcn_rsqf(wave_sum(s) * (1.f / DM) + NORM_EPS);
    unsigned long long* o8 = (unsigned long long*)orow + lane;
#pragma unroll
    for (int j = 0; j < 4; ++j) { const f32x4 gv = gr[64 * j]; o8[64 * j] = (unsigned long long)pk2(v[j].x * rstd * gv.x, v[j].y * rstd * gv.y) | ((unsigned long long)pk2(v[j].z * rstd * gv.z, v[j].w * rstd * gv.w) << 32); }
}
__device__ __forceinline__ void rmsnorm_rows(Frame& F, const float* x, const float* gain, bf16_t* o) {
    const int gw = F.bid * NWAVES + F.wave, NGW = F.G * NWAVES;
    for (int m = gw; m < T; m += NGW) rms_row_to_bf16(x + (size_t)m * DM, gain, o + (size_t)m * DM, F.lane);
}

__device__ __forceinline__ void s5_scan(Frame& F, int layer) {
    const float* HL = (const float*)(F.ws + WS_HLOC); bf16_t* UH = (bf16_t*)(F.ws + WS_UH);
    for (int i = (F.G - 1 - F.bid) * NTHR + F.tid; i < BATCH * 32 * 64; i += F.G * NTHR) {
        const int p = i & 63, g = (i >> 6) & 31, b = i >> 11, gi = layer * 32 + g;
        const float dt = __expf(F.in[IN_LOGDT][gi]), lr = F.in[IN_LRE][gi * 64 + p], li = F.in[IN_LIM][gi * 64 + p];
        float s, c; sincos_red((float)S5_TC * li * dt, s, c); const float mg = __expf((float)S5_TC * lr * dt), ar = mg * c, ai = mg * s;
        float hr = 0.f, hi = 0.f;
        const int nch = SEQ / S5_TC;
        for (int c0 = 0; c0 < nch; c0 += 32) { float lr_[32], li_[32];
#pragma unroll
            for (int k = 0; k < 32; ++k) { const size_t r = (size_t)g * S5_ROWS + b * nch + c0 + k; lr_[k] = HL[r * 128 + p]; li_[k] = HL[r * 128 + 64 + p]; }
#pragma unroll
            for (int k = 0; k < 32; ++k) { const size_t r = (size_t)g * S5_ROWS + b * nch + c0 + k;
                UH[r * S5_K + p] = (bf16_t)f2bf(hr); UH[r * S5_K + 64 + p] = (bf16_t)f2bf(hi);
                const float nr = ar * hr - ai * hi + lr_[k], ni = ar * hi + ai * hr + li_[k]; hr = nr; hi = ni; } }
    }
}

__device__ __forceinline__ void ssd_stage_bc(Frame& F, int layer, int b, int ch, int grp, LAS float* Bs, LAS float* Cs, LAS float* dts, LAS float* das) {
    const bf16_t* P = (const bf16_t*)(F.ws + WS_P); const float* DT = (const float*)(F.ws + WS_DT);
    const float* cw = F.in[IN_CONVW] + layer * 4 * 1280; const float* cb = F.in[IN_CONVB] + layer * 1280;
    const int l0 = ch * 128; const size_t row0 = (size_t)b * SEQ + l0;
    for (int i = F.tid; i < 2 * 128 * 64; i += NTHR) { const int isC = i >> 13, t = (i >> 6) & 127, n = i & 63;
        const int col = (isC ? C_C : C_B) + grp * 64 + n, cc = 1024 + isC * 128 + grp * 64 + n; float a = cb[cc];
#pragma unroll
        for (int j = 0; j < 4; ++j) { const int l = l0 + t - 3 + j; if (l >= 0) a += cw[j * 1280 + cc] * bf2f(P[(row0 + t - 3 + j) * NINP + col]); }
        (isC ? Cs : Bs)[t * 64 + n] = siluf_(a); }
    for (int i = F.tid; i < 128 * 8; i += NTHR) { const int t = i >> 3, hh = i & 7, h = grp * 8 + hh;
        const float dt = softplusf_(DT[(row0 + t) * 16 + h] + F.in[IN_DTB][layer * 16 + h]); dts[i] = dt; das[i] = dt * (-__expf(F.in[IN_ALOG][layer * 16 + h])); }
}
template <bool OUT>
__device__ __forceinline__ void ssd_units(Frame& F, int layer) {
    LAS float* Bs = (LAS float*)F.lds; LAS float* Cs = Bs + 128 * 64; LAS float* dts = Cs + 128 * 64; LAS float* das = dts + 128 * 8; LAS float* ssq = das + 128 * 8;
    const bf16_t* P = (const bf16_t*)(F.ws + WS_P); float* SST = (float*)(F.ws + WS_SST); float* ASUM = (float*)(F.ws + WS_ASUM); bf16_t* YC = (bf16_t*)(F.ws + WS_YCAT);
    const float* cw = F.in[IN_CONVW] + layer * 4 * 1280; const float* cb = F.in[IN_CONVB] + layer * 1280;
    for (int u = F.bid; u < BATCH * SSD_NCH * 2; u += F.G) {
        const int grp = u & 1, ch = (u >> 1) & 31, b = u >> 6;
        __syncthreads();
        ssd_stage_bc(F, layer, b, ch, grp, Bs, Cs, dts, das);
        __syncthreads();
        const int hh = F.wave, h = grp * 8 + hh, p = F.lane, cx = h * 64 + p;
        const float w0 = cw[cx], w1 = cw[1280 + cx], w2 = cw[2560 + cx], w3 = cw[3840 + cx], bias = cb[cx], dsk = F.in[IN_SSDD][layer * 16 + h];
        const int l0 = ch * 128; const size_t row0 = (size_t)b * SEQ + l0;
        const bf16_t* xp = P + row0 * NINP + C_XS + cx;
        float x0 = 0.f, x1 = 0.f, x2 = 0.f;
        if (l0 > 0) { x0 = bf2f(xp[-3 * (ptrdiff_t)NINP]); x1 = bf2f(xp[-2 * (ptrdiff_t)NINP]); x2 = bf2f(xp[-1 * (ptrdiff_t)NINP]); }
        float st[64];
        float* sp = SST + ((((size_t)b * SSD_NCH + ch) * 16 + h) * 64 + p) * 64;
        if (OUT) {
#pragma unroll
            for (int n = 0; n < 64; n += 4) { const f32x4 v = *(const f32x4*)(sp + n); st[n] = v.x; st[n + 1] = v.y; st[n + 2] = v.z; st[n + 3] = v.w; }
        } else {
#pragma unroll
            for (int n = 0; n < 64; ++n) st[n] = 0.f;
        }
        float asum = 0.f;
#pragma unroll 4
        for (int t = 0; t < 128; ++t) {
            const float x3 = bf2f(xp[(size_t)t * NINP]);
            const float xs = siluf_(bias + w0 * x0 + w1 * x1 + w2 * x2 + w3 * x3);
            x0 = x1; x1 = x2; x2 = x3;
            const float dt = dts[t * 8 + hh], a = das[t * 8 + hh], da = __expf(a), xdt = xs * dt;
            asum += a;
            float y = 0.f;
#pragma unroll
            for (int n = 0; n < 64; n += 4) { const f32x4 bv = *(const LAS f32x4*)(Bs + t * 64 + n);
                st[n] = da * st[n] + bv.x * xdt; st[n + 1] = da * st[n + 1] + bv.y * xdt; st[n + 2] = da * st[n + 2] + bv.z * xdt; st[n + 3] = da * st[n + 3] + bv.w * xdt;
                if (OUT) { const f32x4 cv = *(const LAS f32x4*)(Cs + t * 64 + n); y += (cv.x * st[n] + cv.y * st[n + 1]) + (cv.z * st[n + 2] + cv.w * st[n + 3]); } }
            if (OUT) {
                const float z = bf2f(P[(row0 + t) * NINP + C_Z + cx]);
                const float yz = (y + dsk * xs) * siluf_(z);
                const float q = wave_sum(yz * yz);
                if (p == 0) ssq[t * 8 + hh] = q;
                YC[(row0 + t) * 2048 + 1024 + cx] = (bf16_t)f2bf(yz);
            }
        }
        if (!OUT) {
#pragma unroll
            for (int n = 0; n < 64; n += 4) *(f32x4*)(sp + n) = (f32x4){st[n], st[n + 1], st[n + 2], st[n + 3]};
            if (p == 0) ASUM[((size_t)b * SSD_NCH + ch) * 16 + h] = asum;
        } else {
            __syncthreads();
            const float ng = F.in[IN_SSDG][layer * 1024 + cx];
            for (int t = 0; t < 128; ++t) { float q = 0.f;
#pragma unroll
                for (int j = 0; j < 8; ++j) q += ssq[t * 8 + j];
                const float rs = __builtin_amdgcn_rsqf(q * (1.f / 512.f) + NORM_EPS);
                bf16_t* yp = YC + (row0 + t) * 2048 + 1024 + cx; *yp = (bf16_t)f2bf(bf2f(*yp) * rs * ng); }
        }
    }
}
__device__ __forceinline__ void ssd_scan(Frame& F) {
    float* SST = (float*)(F.ws + WS_SST); const float* ASUM = (const float*)(F.ws + WS_ASUM);
    for (int i = F.bid * NTHR + F.tid; i < BATCH * 16 * 1024; i += F.G * NTHR) {
        const int pn = (i & 1023) * 4, h = (i >> 10) & 15, b = i >> 14; f32x4 s = {0.f, 0.f, 0.f, 0.f};
        f32x4 loc[SSD_NCH]; float dec[SSD_NCH];
#pragma unroll
        for (int ch = 0; ch < SSD_NCH; ++ch) { loc[ch] = *(const f32x4*)(SST + (((size_t)b * SSD_NCH + ch) * 16 + h) * 4096 + pn); dec[ch] = ASUM[((size_t)b * SSD_NCH + ch) * 16 + h]; }
#pragma unroll
        for (int ch = 0; ch < SSD_NCH; ++ch) { *(f32x4*)(SST + (((size_t)b * SSD_NCH + ch) * 16 + h) * 4096 + pn) = s; s = s * __expf(dec[ch]) + loc[ch]; }
    }
}

__device__ __forceinline__ void attn_units(Frame& F, int layer) {
    LAS float* Ks = (LAS float*)F.lds; LAS float* Vs = Ks + 256 * 64;
    const bf16_t* P = (const bf16_t*)(F.ws + WS_P); bf16_t* YC = (bf16_t*)(F.ws + WS_YCAT);
    const float* qg = F.in[IN_QG] + layer * 64; const float* kg = F.in[IN_KG] + layer * 64;
    for (int u = F.bid; u < BATCH * 32 * 2; u += F.G) {
        const int kvh = u & 1, qb = (u >> 1) & 31, b = u >> 6, q0 = qb * 128;
        int lane = F.lane; asm volatile("" : "+v"(lane));
        __syncthreads();
        for (int jr = F.wave; jr < 256; jr += NWAVES) { const int l = q0 - 128 + jr; float kv = 0.f, vv = 0.f;
            if (l >= 0) { const size_t row = (size_t)b * SEQ + l; const float x = bf2f(P[row * NINP + C_K + kvh * 64 + lane]); vv = bf2f(P[row * NINP + C_V + kvh * 64 + lane]);
                const float rs = __builtin_amdgcn_rsqf(wave_sum(x * x) * (1.f / 64.f) + NORM_EPS); const float xn = x * rs * kg[lane];
                const float other = __shfl_xor(xn, 32); const int i = lane & 31; const float inv = exp2f(-(float)i * (13.287712379549449f / 32.f));
                float s, c; sincos_fast((float)l * inv, s, c);
                kv = (lane < 32) ? (xn * c - other * s) : (xn * c + other * s); }
            Ks[jr * 64 + lane] = kv; Vs[jr * 64 + lane] = vv; }
        __syncthreads();
        const int hh = F.wave >> 1, head = kvh * 4 + hh, qi = q0 + (F.wave & 1) * 64 + lane; const size_t row = (size_t)b * SEQ + qi;
        float q[64];
        { const u32x4* qp = (const u32x4*)(P + row * NINP + C_Q + head * 64); float ss = 0.f;
#pragma unroll
          for (int j = 0; j < 8; ++j) { const u32x4 w = qp[j];
#pragma unroll
              for (int e = 0; e < 4; ++e) { q[8 * j + 2 * e] = bflo(w[e]); q[8 * j + 2 * e + 1] = bfhi(w[e]); } }
#pragma unroll
          for (int d = 0; d < 64; ++d) ss += q[d] * q[d];
          const float rs = __builtin_amdgcn_rsqf(ss * (1.f / 64.f) + NORM_EPS);
#pragma unroll
          for (int d = 0; d < 64; ++d) q[d] = q[d] * rs * qg[d];
#pragma unroll
          for (int i = 0; i < 32; ++i) { const float inv = exp2f(-(float)i * (13.287712379549449f / 32.f)); float s, c; sincos_fast((float)qi * inv, s, c);
              const float a = q[i], bq = q[i + 32]; q[i] = (a * c - bq * s) * 0.125f; q[i + 32] = (bq * c + a * s) * 0.125f; } }
        float o[64];
#pragma unroll
        for (int d = 0; d < 64; ++d) o[d] = 0.f;
        float mx = F.in[IN_SINK][layer * 8 + head], l = 1.f;
        const int qa = q0 + (F.wave & 1) * 64;
        int jlo = qa - 127 - (q0 - 128); if (q0 == 0 && jlo < 128) jlo = 128; const int jhi = qa + 63 - (q0 - 128);
        for (int jr = jlo; jr <= jhi; ++jr) { const int j = q0 - 128 + jr; const bool ok = (j <= qi) && (qi - j < 128);
            float s = 0.f;
#pragma unroll
            for (int d = 0; d < 64; d += 4) { const f32x4 kv = *(const LAS f32x4*)(Ks + jr * 64 + d); s += (q[d] * kv.x + q[d + 1] * kv.y) + (q[d + 2] * kv.z + q[d + 3] * kv.w); if ((d & 12) == 12) __builtin_amdgcn_sched_barrier(0); }
            if (ok) { const float mn = fmaxf(mx, s), al = __expf(mx - mn), pe = __expf(s - mn); l = l * al + pe; mx = mn;
#pragma unroll
                for (int d = 0; d < 64; d += 4) { const f32x4 vv = *(const LAS f32x4*)(Vs + jr * 64 + d); o[d] = o[d] * al + pe * vv.x; o[d + 1] = o[d + 1] * al + pe * vv.y; o[d + 2] = o[d + 2] * al + pe * vv.z; o[d + 3] = o[d + 3] * al + pe * vv.w; if ((d & 12) == 12) __builtin_amdgcn_sched_barrier(0); } } }
        const float il = 1.f / l; u32x4* op = (u32x4*)(YC + row * 2048 + 512 + head * 64);
#pragma unroll
        for (int j = 0; j < 8; ++j) { u32x4 w; w.x = pk2(o[8 * j] * il, o[8 * j + 1] * il); w.y = pk2(o[8 * j + 2] * il, o[8 * j + 3] * il); w.z = pk2(o[8 * j + 4] * il, o[8 * j + 5] * il); w.w = pk2(o[8 * j + 6] * il, o[8 * j + 7] * il); op[j] = w; }
    }
}

__device__ __forceinline__ void router_phase(Frame& F, int layer) {
    LAS float* Wt = (LAS float*)F.lds;
    const float* wrg = F.in[IN_WRG] + (size_t)layer * 1024 * 4; const float* wre = F.in[IN_WRE] + (size_t)layer * 1024 * 32;
    for (int i = F.tid; i < 1024 * 4; i += NTHR) Wt[(i & 3) * 1024 + (i >> 2)] = wrg[i];
    for (int i = F.tid; i < 1024 * 32; i += NTHR) Wt[(4 + (i & 31)) * 1024 + (i >> 5)] = wre[i];
    __syncthreads();
    const float* X = F.out; const float* gain = F.in[IN_NORM2] + layer * 1024; bf16_t* H2 = (bf16_t*)(F.ws + WS_XN);
    int* EID = (int*)(F.ws + WS_MOE); float* EW = (float*)(F.ws + WS_MOE + 128 * 1024); int* SLOT = (int*)(F.ws + WS_MOE + 256 * 1024);
    volatile LAS unsigned* lcnt = (volatile LAS unsigned*)(F.lds + 148 * 1024);
    if (F.tid < 32) lcnt[F.tid] = 0u;
    __syncthreads();
    const int TPB = T / F.G;
    for (int m0 = F.bid * TPB + 4 * F.wave; m0 < (F.bid + 1) * TPB; m0 += 4 * NWAVES) {
        f32x4 v[4][4]; float rstd[4];
#pragma unroll
        for (int q = 0; q < 4; ++q) { const f32x4* xr = (const f32x4*)(X + (size_t)(m0 + q) * DM) + F.lane;
#pragma unroll
            for (int j = 0; j < 4; ++j) v[q][j] = xr[64 * j]; }
        const f32x4* gr = (const f32x4*)gain + F.lane;
#pragma unroll
        for (int q = 0; q < 4; ++q) { float s = 0.f;
#pragma unroll
            for (int j = 0; j < 4; ++j) s += (v[q][j].x * v[q][j].x + v[q][j].y * v[q][j].y) + (v[q][j].z * v[q][j].z + v[q][j].w * v[q][j].w);
            rstd[q] = __builtin_amdgcn_rsqf(wave_sum(s) * (1.f / DM) + NORM_EPS); }
#pragma unroll
        for (int j = 0; j < 4; ++j) { const f32x4 gv = gr[64 * j];
#pragma unroll
            for (int q = 0; q < 4; ++q) { v[q][j].x *= rstd[q] * gv.x; v[q][j].y *= rstd[q] * gv.y; v[q][j].z *= rstd[q] * gv.z; v[q][j].w *= rstd[q] * gv.w;
                ((unsigned long long*)(H2 + (size_t)(m0 + q) * DM) + F.lane)[64 * j] = (unsigned long long)pk2(v[q][j].x, v[q][j].y) | ((unsigned long long)pk2(v[q][j].z, v[q][j].w) << 32); } }
        float mylog[4] = {0.f, 0.f, 0.f, 0.f};
#pragma unroll 2
        for (int e = 0; e < 36; ++e) { float a[4] = {0.f, 0.f, 0.f, 0.f};
#pragma unroll
            for (int j = 0; j < 4; ++j) { const f32x4 w = *(const LAS f32x4*)(Wt + e * 1024 + 256 * j + 4 * F.lane);
#pragma unroll
                for (int q = 0; q < 4; ++q) a[q] += (v[q][j].x * w.x + v[q][j].y * w.y) + (v[q][j].z * w.z + v[q][j].w * w.w); }
#pragma unroll
            for (int q = 0; q < 4; ++q) { const float t = wave_sum(a[q]); mylog[q] = (F.lane == e) ? t : mylog[q]; } }
#pragma unroll
        for (int q = 0; q < 4; ++q) { const int m = m0 + q;
        float lg4[4];
#pragma unroll
        for (int k = 0; k < 4; ++k) lg4[k] = __shfl(mylog[q], k);
        float gl[4];
#pragma unroll
        for (int k = 0; k < 4; ++k) gl[k] = lg4[k] + F.in[IN_BRG][layer * 4 + k];
        int gs = 0; float gbest = gl[0];
#pragma unroll
        for (int k = 1; k < 4; ++k) if (gl[k] > gbest) { gbest = gl[k]; gs = k; }
        float elv[8];
#pragma unroll
        for (int k = 0; k < 8; ++k) elv[k] = __shfl(mylog[q], 4 + gs * 8 + k);
        if (F.lane == 0) {
            float den = 0.f;
#pragma unroll
            for (int k = 0; k < 4; ++k) den += __expf(gl[k] - gbest);
            const float pgrp = 1.f / den;
            float el[8];
#pragma unroll
            for (int k = 0; k < 8; ++k) el[k] = elv[k] + F.in[IN_BRE_][layer * 32 + gs * 8 + k];
            int i0 = 0; float v0 = el[0];
#pragma unroll
            for (int k = 1; k < 8; ++k) if (el[k] > v0) { v0 = el[k]; i0 = k; }
            int i1 = -1; float v1 = -3.0e38f;
#pragma unroll
            for (int k = 0; k < 8; ++k) if (k != i0 && el[k] > v1) { v1 = el[k]; i1 = k; }
            const float e1 = __expf(v1 - v0), w0 = pgrp / (1.f + e1), w1 = pgrp * e1 / (1.f + e1);
            const int ea = gs * 8 + i0, eb = gs * 8 + i1;
            EID[2 * m] = ea; EID[2 * m + 1] = eb; EW[2 * m] = w0; EW[2 * m + 1] = w1;
            SLOT[2 * m] = (int)__hip_atomic_fetch_add((LAS unsigned*)lcnt + ea, 1u, __ATOMIC_RELAXED, __HIP_MEMORY_SCOPE_WORKGROUP);
            SLOT[2 * m + 1] = (int)__hip_atomic_fetch_add((LAS unsigned*)lcnt + eb, 1u, __ATOMIC_RELAXED, __HIP_MEMORY_SCOPE_WORKGROUP);
        } }
    }
    __syncthreads();
    if (F.tid < 32) ((unsigned*)(F.ws + WS_MOE + 512 * 1024))[(size_t)F.bid * 32 + F.tid] = lcnt[F.tid];
}
__device__ __forceinline__ int moe_tables(Frame& F, int layer, volatile LAS int* offs, volatile LAS int* tile_e) {
    volatile LAS int* psum = offs + 256;
    const unsigned* CNTB = (const unsigned*)(F.ws + WS_MOE + 512 * 1024);
    __syncthreads();
    { const int e = F.tid & 31, part = F.tid >> 5; int tot = 0, pre = 0; const int per = (F.G + 15) / 16;
      for (int bb = part * per; bb < (part + 1) * per && bb < F.G; ++bb) { const int c = (int)CNTB[(size_t)bb * 32 + e]; tot += c; pre += (bb < F.bid) ? c : 0; }
      psum[part * 32 + e] = tot; psum[512 + part * 32 + e] = pre; }
    __syncthreads();
    if (F.tid < 64) {
        int c = 0, pre = 0;
        if (F.tid < 32) for (int part = 0; part < 16; ++part) { c += psum[part * 32 + F.tid]; pre += psum[512 + part * 32 + F.tid]; }
        const int tl = (c + 255) >> 8; int incl = tl;
#pragma unroll
        for (int o = 1; o < 32; o <<= 1) { const int v = __shfl_up(incl, o); if (F.tid >= o) incl += v; }
        const int excl = incl - tl;
        if (F.tid < 32) { offs[F.tid] = excl * 256 + pre; for (int k = 0; k < tl; ++k) tile_e[excl + k] = F.tid; }
        if (F.tid == 31) offs[32] = incl;
    }
    __syncthreads();
    return __builtin_amdgcn_readfirstlane(offs[32]);
}
__device__ __forceinline__ void gather_phase(Frame& F, int layer, volatile LAS int* offs) {
    const bf16_t* H2 = (const bf16_t*)(F.ws + WS_XN); bf16_t* XG = (bf16_t*)(F.ws + WS_XG);
    const int* EID = (const int*)(F.ws + WS_MOE); const int* SLOT = (const int*)(F.ws + WS_MOE + 256 * 1024); int* POS = (int*)(F.ws + WS_MOE + 384 * 1024);
    const int TPB = T / F.G;
    for (int m = F.bid * TPB + F.wave; m < (F.bid + 1) * TPB; m += NWAVES) {
        const u32x4* src = (const u32x4*)(H2 + (size_t)m * DM) + F.lane; const u32x4 a = src[0], b = src[64];
#pragma unroll
        for (int k = 0; k < 2; ++k) { const int pos = offs[EID[2 * m + k]] + SLOT[2 * m + k]; u32x4* dst = (u32x4*)(XG + (size_t)pos * DM) + F.lane; dst[0] = a; dst[64] = b; if (F.lane == 0) POS[2 * m + k] = pos; }
    }
}
__device__ __forceinline__ void combine_phase(Frame& F, const float* gain_next, bool dry = false) {
    const bf16_t* Y = (const bf16_t*)(F.ws + WS_YEXP); const float* EW = (const float*)(F.ws + WS_MOE + 128 * 1024); const int* POS = (const int*)(F.ws + WS_MOE + 384 * 1024);
    bf16_t* XN = (bf16_t*)(F.ws + WS_XN);
    const int gw = F.bid * NWAVES + F.wave, NGW = F.G * NWAVES;
    for (int m = gw; m < T; m += NGW) {
        const float w0 = EW[2 * m], w1 = EW[2 * m + 1]; const int p0 = POS[2 * m], p1 = POS[2 * m + 1];
        f32x4* xr = (f32x4*)(F.out + (size_t)m * DM) + F.lane;
        const u32x2* y0 = (const u32x2*)(Y + (size_t)p0 * DM) + F.lane; const u32x2* y1 = (const u32x2*)(Y + (size_t)p1 * DM) + F.lane;
        f32x4 v[4]; float s = 0.f;
#pragma unroll
        for (int j = 0; j < 4; ++j) { v[j] = xr[64 * j]; const u32x2 a = y0[64 * j], b = y1[64 * j];
            v[j].x += w0 * bflo(a.x) + w1 * bflo(b.x); v[j].y += w0 * bfhi(a.x) + w1 * bfhi(b.x); v[j].z += w0 * bflo(a.y) + w1 * bflo(b.y); v[j].w += w0 * bfhi(a.y) + w1 * bfhi(b.y);
            if (!dry) xr[64 * j] = v[j]; s += (v[j].x * v[j].x + v[j].y * v[j].y) + (v[j].z * v[j].z + v[j].w * v[j].w); }
        if (gain_next) { const float rstd = __builtin_amdgcn_rsqf(wave_sum(s) * (1.f / DM) + NORM_EPS); const f32x4* gr = (const f32x4*)gain_next + F.lane;
            unsigned long long* o8 = (unsigned long long*)(XN + (size_t)m * DM) + F.lane;
#pragma unroll
            for (int j = 0; j < 4; ++j) { const f32x4 gv = gr[64 * j]; o8[64 * j] = (unsigned long long)pk2(v[j].x * rstd * gv.x, v[j].y * rstd * gv.y) | ((unsigned long long)pk2(v[j].z * rstd * gv.z, v[j].w * rstd * gv.w) << 32); } }
    }
}

typedef float f32x16 __attribute__((ext_vector_type(16)));
typedef float f32x2_t __attribute__((ext_vector_type(2)));
typedef __bf16 bf16x2_t __attribute__((ext_vector_type(2)));
#define MFMA32(a, b, c) __builtin_amdgcn_mfma_f32_32x32x16_bf16((a), (b), (c), 0, 0, 0)
__device__ __forceinline__ unsigned cvtpk(float lo, float hi) { f32x2_t v = {lo, hi}; bf16x2_t b = __builtin_convertvector(v, bf16x2_t); return __builtin_bit_cast(unsigned, b); }
__device__ __forceinline__ bf16x8 pack8v(const float (&v)[8]) { u32x4 p; p.x = cvtpk(v[0], v[1]); p.y = cvtpk(v[2], v[3]); p.z = cvtpk(v[4], v[5]); p.w = cvtpk(v[6], v[7]); return __builtin_bit_cast(bf16x8, p); }
__device__ __forceinline__ int crow32(int reg, int hh) { return (reg & 3) + 8 * (reg >> 2) + 4 * hh; }
__device__ __forceinline__ float wave_incl_scan(float v, int lane) {
#pragma unroll
    for (int o = 1; o < 64; o <<= 1) { const float t = __shfl_up(v, o); if (lane >= o) v += t; }
    return v;
}
__device__ __forceinline__ void conv_frag(const LAS unsigned char* raw, int chan, int ks, int hh, float w0, float w1, float w2, float w3, float bias, float (&out)[8]) {
#pragma unroll
    for (int run = 0; run < 2; ++run) { const int lb = 16 * ks + 8 * run + 4 * hh; float x[7];
#pragma unroll
        for (int i = 0; i < 7; ++i) x[i] = bf2f(*(const LAS unsigned short*)(raw + (lb + i) * 128 + chan * 2));
#pragma unroll
        for (int j = 0; j < 4; ++j) out[4 * run + j] = siluf_(bias + w0 * x[j] + w1 * x[j + 1] + w2 * x[j + 2] + w3 * x[j + 3]); }
}
constexpr int RAWT = 131 * 128;
__device__ __forceinline__ void stage_raw(const bf16_t* P, size_t row0, int l0, int col, LAS unsigned char* dst, int idx0, int stride) {
    for (int idx = idx0; idx < 131 * 8; idx += stride) { const int r = idx >> 3, c8 = idx & 7; u32x4 v = (u32x4){0u, 0u, 0u, 0u};
        if (l0 - 3 + r >= 0) v = *(const u32x4*)(P + (row0 + r - 3) * NINP + col + c8 * 8);
        *(LAS u32x4*)(dst + r * 128 + c8 * 16) = v; }
}
__device__ __forceinline__ void ssdA_mfma(Frame& F, int layer) {
    const bf16_t* P = (const bf16_t*)(F.ws + WS_P); const float* DT = (const float*)(F.ws + WS_DT); float* SST = (float*)(F.ws + WS_SST); float* ASUM = (float*)(F.ws + WS_ASUM);
    const float* cw = F.in[IN_CONVW] + layer * 4 * 1280; const float* cb = F.in[IN_CONVB] + layer * 1280;
    LAS unsigned char* rawX = F.lds + F.wave * RAWT; LAS unsigned char* rawB = F.lds + 8 * RAWT; LAS float* ftab = (LAS float*)(F.lds + 9 * RAWT) + F.wave * 128;
    for (int u = F.bid; u < BATCH * SSD_NCH * 2; u += F.G) {
        const int grp = u & 1, ch = (u >> 1) & 31, b = u >> 6, h = grp * 8 + F.wave, l0 = ch * 128; const size_t row0 = (size_t)b * SEQ + l0;
        int lane = F.lane; asm volatile("" : "+v"(lane));
        const int r = lane & 31, hh = lane >> 5;
        __syncthreads();
        stage_raw(P, row0, l0, C_XS + h * 64, rawX, lane, 64);
        stage_raw(P, row0, l0, C_B + grp * 64, rawB, F.tid, NTHR);
        { const float dtb = F.in[IN_DTB][layer * 16 + h], A = -__expf(F.in[IN_ALOG][layer * 16 + h]);
          const float dt0 = softplusf_(DT[(row0 + lane) * 16 + h] + dtb), dt1 = softplusf_(DT[(row0 + 64 + lane) * 16 + h] + dtb);
          const float s0 = wave_incl_scan(dt0 * A, lane); const float tot0 = __builtin_bit_cast(float, __builtin_amdgcn_readlane(__builtin_bit_cast(int, s0), 63));
          const float s1 = wave_incl_scan(dt1 * A, lane) + tot0; const float tot = __builtin_bit_cast(float, __builtin_amdgcn_readlane(__builtin_bit_cast(int, s1), 63));
          ftab[lane] = dt0 * __expf(tot - s0); ftab[64 + lane] = dt1 * __expf(tot - s1);
          if (lane == 0) ASUM[((size_t)b * SSD_NCH + ch) * 16 + h] = tot; }
        __syncthreads();
        bf16x8 bfr[2];
#pragma unroll
        for (int q = 0; q < 2; ++q) { const int idx = F.wave * 2 + q, nt = idx >> 3, ks = idx & 7, cc = 1024 + grp * 64 + 32 * nt + r; float v[8];
            conv_frag(rawB, 32 * nt + r, ks, hh, cw[cc], cw[1280 + cc], cw[2560 + cc], cw[3840 + cc], cb[cc], v); bfr[q] = pack8v(v); }
        bf16x8 xw[2][8];
#pragma unroll
        for (int pt = 0; pt < 2; ++pt) { const int cx = h * 64 + 32 * pt + r; const float w0 = cw[cx], w1 = cw[1280 + cx], w2 = cw[2560 + cx], w3 = cw[3840 + cx], bias = cb[cx];
#pragma unroll
            for (int ks = 0; ks < 8; ++ks) { float v[8]; conv_frag(rawX, 32 * pt + r, ks, hh, w0, w1, w2, w3, bias, v);
                const f32x4 fa = *(const LAS f32x4*)(ftab + 16 * ks + 4 * hh), fb = *(const LAS f32x4*)(ftab + 16 * ks + 8 + 4 * hh);
                v[0] *= fa.x; v[1] *= fa.y; v[2] *= fa.z; v[3] *= fa.w; v[4] *= fb.x; v[5] *= fb.y; v[6] *= fb.z; v[7] *= fb.w; { u32x4 pq = __builtin_bit_cast(u32x4, pack8v(v)); asm volatile("" : "+v"(pq) :: "memory"); xw[pt][ks] = __builtin_bit_cast(bf16x8, pq); } } }
        __syncthreads();
#pragma unroll
        for (int q = 0; q < 2; ++q) *(LAS bf16x8*)(rawB + (F.wave * 2 + q) * 1024 + lane * 16) = bfr[q];
        __syncthreads();
        f32x16 acc[2][2];
#pragma unroll
        for (int pt = 0; pt < 2; ++pt)
#pragma unroll
            for (int nt = 0; nt < 2; ++nt)
#pragma unroll
                for (int i = 0; i < 16; ++i) acc[pt][nt][i] = 0.f;
#pragma unroll
        for (int ks = 0; ks < 8; ++ks)
#pragma unroll
            for (int nt = 0; nt < 2; ++nt) { const bf16x8 bq = *(const LAS bf16x8*)(rawB + (nt * 8 + ks) * 1024 + lane * 16);
#pragma unroll
                for (int pt = 0; pt < 2; ++pt) acc[pt][nt] = MFMA32(xw[pt][ks], bq, acc[pt][nt]); }
        float* sp = SST + (((size_t)b * SSD_NCH + ch) * 16 + h) * 4096;
#pragma unroll
        for (int pt = 0; pt < 2; ++pt)
#pragma unroll
            for (int nt = 0; nt < 2; ++nt)
#pragma unroll
                for (int i = 0; i < 16; ++i) sp[(32 * pt + crow32(i, hh)) * 64 + 32 * nt + r] = acc[pt][nt][i];
    }
}
__device__ __forceinline__ void ssdC_mfma(Frame& F, int layer) {
    const bf16_t* P = (const bf16_t*)(F.ws + WS_P); const float* DT = (const float*)(F.ws + WS_DT); const float* SST = (const float*)(F.ws + WS_SST); bf16_t* YC = (bf16_t*)(F.ws + WS_YCAT);
    const float* cw = F.in[IN_CONVW] + layer * 4 * 1280; const float* cb = F.in[IN_CONVB] + layer * 1280;
    LAS unsigned char* rawX = F.lds + F.wave * RAWT;
    LAS unsigned char* Bn = F.lds; LAS unsigned char* Cn = F.lds + 18432;
    LAS float* atab = (LAS float*)(F.lds + 36864) + F.wave * 128; LAS float* dtab = (LAS float*)(F.lds + 40960) + F.wave * 128;
    LAS float* ssqp = (LAS float*)(F.lds + 45056); LAS float* gtab = (LAS float*)(F.lds + 49152) + F.wave * 64;
    LAS unsigned char* zt = F.lds + 51200 + F.wave * 4608;
    for (int u = F.bid; u < BATCH * SSD_NCH * 2; u += F.G) {
        const int grp = u & 1, ch = (u >> 1) & 31, b = u >> 6, h = grp * 8 + F.wave, l0 = ch * 128; const size_t row0 = (size_t)b * SEQ + l0;
        int lane = F.lane; asm volatile("" : "+v"(lane));
        const int r = lane & 31, hh = lane >> 5;
        __syncthreads();
        stage_raw(P, row0, l0, C_XS + h * 64, rawX, lane, 64);
        __syncthreads();
        bf16x8 xsf[2][8];
#pragma unroll
        for (int pt = 0; pt < 2; ++pt) { const int cx = h * 64 + 32 * pt + r; const float w0 = cw[cx], w1 = cw[1280 + cx], w2 = cw[2560 + cx], w3 = cw[3840 + cx], bias = cb[cx];
#pragma unroll
            for (int ks = 0; ks < 8; ++ks) { float v[8]; conv_frag(rawX, 32 * pt + r, ks, hh, w0, w1, w2, w3, bias, v); { u32x4 pq = __builtin_bit_cast(u32x4, pack8v(v)); asm volatile("" : "+v"(pq) :: "memory"); xsf[pt][ks] = __builtin_bit_cast(bf16x8, pq); } } }
        __syncthreads();
        for (int it = F.tid; it < 128 * 16; it += NTHR) { const int l = it >> 4, c8 = it & 15, isC = c8 >> 3, col = (isC ? C_C : C_B) + grp * 64 + (c8 & 7) * 8, cc = 1024 + isC * 128 + grp * 64 + (c8 & 7) * 8;
            float a[8];
#pragma unroll
            for (int e = 0; e < 8; ++e) a[e] = cb[cc + e];
#pragma unroll
            for (int j = 0; j < 4; ++j) { if (l0 + l - 3 + j >= 0) { const u32x4 xv = *(const u32x4*)(P + (row0 + l - 3 + j) * NINP + col);
#pragma unroll
                for (int e = 0; e < 4; ++e) { a[2 * e] += cw[j * 1280 + cc + 2 * e] * bflo(xv[e]); a[2 * e + 1] += cw[j * 1280 + cc + 2 * e + 1] * bfhi(xv[e]); } } }
            u32x4 o; o.x = cvtpk(siluf_(a[0]), siluf_(a[1])); o.y = cvtpk(siluf_(a[2]), siluf_(a[3])); o.z = cvtpk(siluf_(a[4]), siluf_(a[5])); o.w = cvtpk(siluf_(a[6]), siluf_(a[7]));
            *(LAS u32x4*)((isC ? Cn : Bn) + l * 144 + (c8 & 7) * 16) = o; }
        { const float dtb = F.in[IN_DTB][layer * 16 + h], A = -__expf(F.in[IN_ALOG][layer * 16 + h]);
          const float dt0 = softplusf_(DT[(row0 + lane) * 16 + h] + dtb), dt1 = softplusf_(DT[(row0 + 64 + lane) * 16 + h] + dtb);
          const float s0 = wave_incl_scan(dt0 * A, lane); const float tot0 = __builtin_bit_cast(float, __builtin_amdgcn_readlane(__builtin_bit_cast(int, s0), 63));
          const float s1 = wave_incl_scan(dt1 * A, lane) + tot0;
          atab[lane] = s0; atab[64 + lane] = s1; dtab[lane] = dt0; dtab[64 + lane] = dt1; gtab[lane] = F.in[IN_SSDG][layer * 1024 + h * 64 + lane]; }
        const float* sp = SST + (((size_t)b * SSD_NCH + ch) * 16 + h) * 4096;
        const float dsk = F.in[IN_SSDD][layer * 16 + h];
        __syncthreads();
#pragma unroll 1
        for (int li = 0; li < 4; ++li) {
            bf16x8 Cf[4];
#pragma unroll
            for (int ks = 0; ks < 4; ++ks) Cf[ks] = *(const LAS bf16x8*)(Cn + (32 * li + r) * 144 + (16 * ks + 8 * hh) * 2);
            f32x16 acc[2];
#pragma unroll
            for (int pt = 0; pt < 2; ++pt)
#pragma unroll
                for (int i = 0; i < 16; ++i) acc[pt][i] = 0.f;
#pragma unroll
            for (int ks = 0; ks < 4; ++ks)
#pragma unroll
                for (int pt = 0; pt < 2; ++pt) { const f32x4 a0 = *(const f32x4*)(sp + (32 * pt + r) * 64 + 16 * ks + 8 * hh), a1 = *(const f32x4*)(sp + (32 * pt + r) * 64 + 16 * ks + 8 * hh + 4);
                    const float v[8] = {a0.x, a0.y, a0.z, a0.w, a1.x, a1.y, a1.z, a1.w}; acc[pt] = MFMA32(pack8v(v), Cf[ks], acc[pt]); }
            const float al = atab[32 * li + r], el = __expf(al); const int lrel = 32 * li + r;
#pragma unroll
            for (int pt = 0; pt < 2; ++pt)
#pragma unroll
                for (int i = 0; i < 16; ++i) acc[pt][i] *= el;
#pragma unroll
            for (int si = 0; si < 4; ++si) if (si <= li) {
                f32x16 X;
#pragma unroll
                for (int i = 0; i < 16; ++i) X[i] = 0.f;
#pragma unroll
                for (int ks = 0; ks < 4; ++ks) { const bf16x8 Bq = *(const LAS bf16x8*)(Bn + (32 * si + r) * 144 + (16 * ks + 8 * hh) * 2); X = MFMA32(Bq, Cf[ks], X); }
#pragma unroll
                for (int g4 = 0; g4 < 4; ++g4) { const int sb = 32 * si + 8 * g4 + 4 * hh; const f32x4 av = *(const LAS f32x4*)(atab + sb), dv = *(const LAS f32x4*)(dtab + sb);
#pragma unroll
                    for (int j = 0; j < 4; ++j) { const int s = sb + j; float arg = al - av[j]; if (si == li && s > lrel) arg = -100.f;
                        float x = X[4 * g4 + j] * (__expf(arg) * dv[j]); if (si == li && s > lrel) x = 0.f; if (si == li && s == lrel) x += dsk; X[4 * g4 + j] = x; } }
#pragma unroll
                for (int kq = 0; kq < 2; ++kq) { const float v[8] = {X[8 * kq], X[8 * kq + 1], X[8 * kq + 2], X[8 * kq + 3], X[8 * kq + 4], X[8 * kq + 5], X[8 * kq + 6], X[8 * kq + 7]}; const bf16x8 Xf = pack8v(v);
#pragma unroll
                    for (int pt = 0; pt < 2; ++pt) { bf16x8 a;
#pragma unroll
                        for (int q = 0; q < 4; ++q) a = (si == q) ? xsf[pt][2 * q + kq] : a;
                        acc[pt] = MFMA32(a, Xf, acc[pt]); } }
            }
            const size_t rowt = row0 + 32 * li;
#pragma unroll
            for (int q = 0; q < 4; ++q) { const int idx = lane + 64 * q, rr = idx >> 3, c8 = idx & 7; *(LAS u32x4*)(zt + rr * 144 + c8 * 16) = *(const u32x4*)(P + (rowt + rr) * NINP + C_Z + h * 64 + c8 * 8); }
            float qs = 0.f;
#pragma unroll
            for (int pt = 0; pt < 2; ++pt)
#pragma unroll
                for (int g4 = 0; g4 < 4; ++g4) { const u32x2 zz = *(const LAS u32x2*)(zt + r * 144 + (32 * pt + 8 * g4 + 4 * hh) * 2);
                    const float z0 = bflo(zz.x), z1 = bfhi(zz.x), z2 = bflo(zz.y), z3 = bfhi(zz.y);
                    float y0 = acc[pt][4 * g4] * siluf_(z0), y1 = acc[pt][4 * g4 + 1] * siluf_(z1), y2 = acc[pt][4 * g4 + 2] * siluf_(z2), y3 = acc[pt][4 * g4 + 3] * siluf_(z3);
                    acc[pt][4 * g4] = y0; acc[pt][4 * g4 + 1] = y1; acc[pt][4 * g4 + 2] = y2; acc[pt][4 * g4 + 3] = y3; qs += (y0 * y0 + y1 * y1) + (y2 * y2 + y3 * y3); }
            qs += __shfl_xor(qs, 32);
            if (hh == 0) ssqp[(32 * li + r) * 8 + F.wave] = qs;
            __syncthreads();
            { const f32x4 qa = *(const LAS f32x4*)(ssqp + (32 * li + r) * 8), qb = *(const LAS f32x4*)(ssqp + (32 * li + r) * 8 + 4);
              const float rs = __builtin_amdgcn_rsqf(((qa.x + qa.y) + (qa.z + qa.w) + (qb.x + qb.y) + (qb.z + qb.w)) * (1.f / 512.f) + NORM_EPS);
#pragma unroll
              for (int pt = 0; pt < 2; ++pt)
#pragma unroll
                  for (int g4 = 0; g4 < 4; ++g4) { const int p0 = 32 * pt + 8 * g4 + 4 * hh; const f32x4 gv = *(const LAS f32x4*)(gtab + p0);
                      u32x2 o; o.x = cvtpk(acc[pt][4 * g4] * rs * gv.x, acc[pt][4 * g4 + 1] * rs * gv.y); o.y = cvtpk(acc[pt][4 * g4 + 2] * rs * gv.z, acc[pt][4 * g4 + 3] * rs * gv.w);
                      *(LAS u32x2*)(zt + r * 144 + p0 * 2) = o; } }
#pragma unroll
            for (int q = 0; q < 4; ++q) { const int idx = lane + 64 * q, rr = idx >> 3, c8 = idx & 7; *(u32x4*)(YC + (rowt + rr) * 2048 + 1024 + h * 64 + c8 * 8) = *(const LAS u32x4*)(zt + rr * 144 + c8 * 16); }
        }
    }
}

__device__ __forceinline__ void attn_mfma(Frame& F, int layer) {
    LAS unsigned char* Kn = F.lds; LAS unsigned char* VT = F.lds + 36864;
    const bf16_t* P = (const bf16_t*)(F.ws + WS_P); bf16_t* YC = (bf16_t*)(F.ws + WS_YCAT);
    const float* qg = F.in[IN_QG] + layer * 64; const float* kg = F.in[IN_KG] + layer * 64;
    for (int u = F.bid; u < BATCH * 32 * 2; u += F.G) {
        const int kvh = u & 1, qb = (u >> 1) & 31, b = u >> 6, q0 = qb * 128;
        int lane = F.lane; asm volatile("" : "+v"(lane));
        const int r = lane & 31, hh = lane >> 5;
        __syncthreads();
        for (int jr = F.wave; jr < 256; jr += NWAVES) { const int l = q0 - 128 + jr; float kv = 0.f;
            if (l >= 0) { const size_t row = (size_t)b * SEQ + l; const float x = bf2f(P[row * NINP + C_K + kvh * 64 + lane]);
                const float rs = __builtin_amdgcn_rsqf(wave_sum(x * x) * (1.f / 64.f) + NORM_EPS); const float xn = x * rs * kg[lane];
                const float other = __shfl_xor(xn, 32); const int i = lane & 31; const float inv = exp2f(-(float)i * (13.287712379549449f / 32.f));
                float s, c; sincos_fast((float)l * inv, s, c);
                kv = (lane < 32) ? (xn * c - other * s) : (xn * c + other * s); }
            *(LAS unsigned short*)(Kn + jr * 144 + lane * 2) = (unsigned short)f2bf(kv); }
#pragma unroll
        for (int q = 0; q < 4; ++q) { const int it = F.tid + NTHR * q, d = it & 63, ko = it >> 6; unsigned short v[8];
#pragma unroll
            for (int e = 0; e < 8; ++e) { const int l = q0 - 128 + 8 * ko + e; v[e] = (l >= 0) ? P[((size_t)b * SEQ + l) * NINP + C_V + kvh * 64 + d] : (unsigned short)0; }
            u32x4 o; o.x = v[0] | ((unsigned)v[1] << 16); o.y = v[2] | ((unsigned)v[3] << 16); o.z = v[4] | ((unsigned)v[5] << 16); o.w = v[6] | ((unsigned)v[7] << 16);
            *(LAS u32x4*)(VT + d * 528 + ko * 16) = o; }
        __syncthreads();
        const int hd = F.wave >> 1, head = kvh * 4 + hd, qhalf = F.wave & 1; const float sink = F.in[IN_SINK][layer * 8 + head];
#pragma unroll 1
        for (int jt = 0; jt < 2; ++jt) {
            const int qt = q0 + 64 * qhalf + 32 * jt, qi = qt + r, t0 = 2 * qhalf + jt; const size_t row = (size_t)b * SEQ + qi;
            bf16x8 Qf[4];
            { float qv[4][8]; float ss = 0.f;
#pragma unroll
              for (int ks = 0; ks < 4; ++ks) { const u32x4 w = *(const u32x4*)(P + row * NINP + C_Q + head * 64 + 16 * ks + 8 * hh);
#pragma unroll
                  for (int e = 0; e < 4; ++e) { qv[ks][2 * e] = bflo(w[e]); qv[ks][2 * e + 1] = bfhi(w[e]); ss += qv[ks][2 * e] * qv[ks][2 * e] + qv[ks][2 * e + 1] * qv[ks][2 * e + 1]; } }
              ss += __shfl_xor(ss, 32);
              const float rs = __builtin_amdgcn_rsqf(ss * (1.f / 64.f) + NORM_EPS);
#pragma unroll
              for (int ks = 0; ks < 4; ++ks)
#pragma unroll
                  for (int e = 0; e < 8; ++e) qv[ks][e] *= rs * qg[16 * ks + 8 * hh + e];
#pragma unroll
              for (int ks = 0; ks < 2; ++ks)
#pragma unroll
                  for (int e = 0; e < 8; ++e) { const int i = 16 * ks + 8 * hh + e; const float inv = exp2f(-(float)i * (13.287712379549449f / 32.f)); float s, c; sincos_fast((float)qi * inv, s, c);
                      const float a = qv[ks][e], bq = qv[ks + 2][e]; qv[ks][e] = (a * c - bq * s) * 0.125f; qv[ks + 2][e] = (bq * c + a * s) * 0.125f; }
#pragma unroll
              for (int ks = 0; ks < 4; ++ks) Qf[ks] = pack8v(qv[ks]); }
            f32x16 acc[2];
#pragma unroll
            for (int dt = 0; dt < 2; ++dt)
#pragma unroll
                for (int i = 0; i < 16; ++i) acc[dt][i] = 0.f;
            float m = sink, lsum = 1.f;
#pragma unroll
            for (int tt = 0; tt < 5; ++tt) { const int t = t0 + tt;
                if (q0 == 0 && t < 4) continue;
                f32x16 X;
#pragma unroll
                for (int i = 0; i < 16; ++i) X[i] = 0.f;
#pragma unroll
                for (int ks = 0; ks < 4; ++ks) { const bf16x8 Kq = *(const LAS bf16x8*)(Kn + (32 * t + r) * 144 + (16 * ks + 8 * hh) * 2); X = MFMA32(Kq, Qf[ks], X); }
                if (tt == 0) {
#pragma unroll
                    for (int i = 0; i < 16; ++i) if (!(r < crow32(i, hh))) X[i] = -INFINITY; }
                if (tt == 4) {
#pragma unroll
                    for (int i = 0; i < 16; ++i) if (!(crow32(i, hh) <= r)) X[i] = -INFINITY; }
                float mx = X[0];
#pragma unroll
                for (int i = 1; i < 16; ++i) mx = fmaxf(mx, X[i]);
                mx = fmaxf(mx, __shfl_xor(mx, 32));
                const float mn = fmaxf(m, mx), al = __expf(m - mn); m = mn;
                float ps = 0.f;
#pragma unroll
                for (int i = 0; i < 16; ++i) { X[i] = __expf(X[i] - mn); ps += X[i]; }
                ps += __shfl_xor(ps, 32);
                lsum = lsum * al + ps;
#pragma unroll
                for (int dt = 0; dt < 2; ++dt)
#pragma unroll
                    for (int i = 0; i < 16; ++i) acc[dt][i] *= al;
#pragma unroll
                for (int kq = 0; kq < 2; ++kq) { const float v[8] = {X[8 * kq], X[8 * kq + 1], X[8 * kq + 2], X[8 * kq + 3], X[8 * kq + 4], X[8 * kq + 5], X[8 * kq + 6], X[8 * kq + 7]}; const bf16x8 Pf = pack8v(v);
#pragma unroll
                    for (int dt = 0; dt < 2; ++dt) { const LAS unsigned char* vp = VT + (32 * dt + r) * 528 + (32 * t + 16 * kq + 4 * hh) * 2;
                        const u32x2 va = *(const LAS u32x2*)vp, vb = *(const LAS u32x2*)(vp + 16); const u32x4 vv = {va.x, va.y, vb.x, vb.y};
                        acc[dt] = MFMA32(__builtin_bit_cast(bf16x8, vv), Pf, acc[dt]); } }
            }
            const float il = 1.f / lsum;
#pragma unroll
            for (int dt = 0; dt < 2; ++dt)
#pragma unroll
                for (int g4 = 0; g4 < 4; ++g4) { u32x2 o; o.x = cvtpk(acc[dt][4 * g4] * il, acc[dt][4 * g4 + 1] * il); o.y = cvtpk(acc[dt][4 * g4 + 2] * il, acc[dt][4 * g4 + 3] * il);
                    *(u32x2*)(YC + row * 2048 + 512 + head * 64 + 32 * dt + 8 * g4 + 4 * hh) = o; }
        }
    }
}

#ifndef MK_PER_PHASE
#define MK_PER_PHASE 0
#endif
constexpr int NPH = 13;
constexpr int TAB_OFF = 150 * 1024;
struct Args { const float* in[N_INPUTS]; float* out; unsigned char* ws; int gp_lo, gp_hi; };
static_assert(sizeof(Args) == (N_INPUTS + 2) * 8 + 8, "no padding in Args");

#ifndef PROBE_ID
#define PROBE_ID 0
#endif
#ifndef PROBE_N
#define PROBE_N 1
#endif
#define REP(id) for (int _r = 0; _r < ((id) == PROBE_ID ? 1 + PROBE_N : 1); ++_r)
extern __shared__ __attribute__((aligned(16))) unsigned char lds_raw[];
__device__ __forceinline__ LAS unsigned char* lds_raw_base() { return (LAS unsigned char*)lds_raw; }
#define LAUNDER() do { asm volatile("" : "+s"(F.in), "+s"(F.ws), "+s"(F.out), "+s"(F.ctl), "+s"(F.bid), "+s"(F.G)); asm volatile("" : "+v"(F.tid)); F.lane = F.tid & 63; F.wave = __builtin_amdgcn_readfirstlane(F.tid >> 6); } while (0)
template <int layer>
__device__ __forceinline__ void layer_body(Frame& F, const int lo, const int hi, const bool rerun) {
    volatile LAS int* offs = (volatile LAS int*)(F.lds + TAB_OFF); volatile LAS int* tile_e = offs + 64;
    XcdBarrier bar; bar.bar = F.ctl + CW_BAR; bar.x = xb_xcc_id(); bar.st = F.MISC;
#define GP(k) (layer * NPH + (k))
#ifdef ONLY_PH
#define IN(k) (((k) == ONLY_PH) && lo <= GP(k) && GP(k) < hi)
#else
#define IN(k) (lo <= GP(k) && GP(k) < hi)
#endif
#define WSB ((const char*)F.ws)
#ifdef DIAG_GP
#define STAMP0(k) do { if (GP(k) == DIAG_GP) { const unsigned t_ = (unsigned)__builtin_amdgcn_s_memrealtime(); if (threadIdx.x == 0) *(volatile LAS unsigned*)((LAS unsigned char*)lds_raw_base() + MISC_OFF + 32) = t_; } } while (0)
#define STAMP1(k) do { if (GP(k) == DIAG_GP) { const unsigned t_ = (unsigned)__builtin_amdgcn_s_memrealtime(); if (threadIdx.x == 0) *(volatile LAS unsigned*)((LAS unsigned char*)lds_raw_base() + MISC_OFF + 40) = t_; } } while (0)
#else
#define STAMP0(k)
#define STAMP1(k)
#endif
#define SEAM(k) do { if (!MK_PER_PHASE && IN(k) && GP(k) + 1 < hi) { xcd_barrier(bar); if (PROBE_ID == 19) { xcd_barrier(bar); xcd_barrier(bar); } } STAMP1(k); } while (0)
        if (IN(0) && layer == 0) { LAUNDER(); STAMP0(0);
            REP(1) { convert_weights(F, 0); __syncthreads(); } REP(2) s5_build(F, 0);
            REP(3) rmsnorm_rows(F, F.in[IN_X], F.in[IN_NORM1], (bf16_t*)(F.ws + WS_XN));
            SEAM(0);
        }
        if (IN(1)) { LAUNDER(); STAMP0(1);
            SchedDense<2048u, 2048u, T / 256, NINP / 256, 16> S{WSB + WS_XN, WSB + WS_WIN, F.G, F.bid};
            EpiProj E{F.ws, F.in[IN_BGATE] + layer * 3072};
            REP(4) pg8::gemm_phase<2048u, 2048u>(F.tid, F.lds, S, E);
            SEAM(1);
        }
        if (IN(2)) { LAUNDER(); STAMP0(2);
            SchedS5P1 S{WSB + WS_UH, WSB + WS_EG, F.G, F.bid};
            EpiHloc E{(float*)(F.ws + WS_HLOC)};
            REP(5) pg8::gemm_phase<(unsigned)(S5_K * 2), 1024u>(F.tid, F.lds, S, E);
            REP(6) ssdA_mfma(F, layer);
            REP(8) attn_mfma(F, layer);
            SEAM(2);
        }
        if (IN(3)) { LAUNDER(); STAMP0(3);
            REP(7) s5_scan(F, layer);
            if (!rerun) ssd_scan(F);
            SEAM(3);
        }
        if (IN(4)) { LAUNDER(); STAMP0(4);
            SchedS5Main S{WSB + WS_UH, WSB + WS_MG, F.G, F.bid};
            EpiS5Y E{(bf16_t*)(F.ws + WS_XN)};
            REP(9) pg8::gemm_phase<(unsigned)(S5_K * 2), (unsigned)(S5_K * 2)>(F.tid, F.lds, S, E);
            REP(10) ssdC_mfma(F, layer);
            SEAM(4);
        }
        if (IN(5)) { LAUNDER(); STAMP0(5);
            SchedDense<1024u, 1024u, T / 256, 4, 8> S{WSB + WS_XN, WSB + WS_WGLU, F.G, F.bid};
            EpiGlu E{(bf16_t*)(F.ws + WS_YCAT)};
            REP(11) pg8::gemm_phase<1024u, 1024u>(F.tid, F.lds, S, E);
            SEAM(5);
        }
        if (IN(6)) { LAUNDER(); STAMP0(6);
            SchedDense<4096u, 4096u, T / 256, 4, 32> S{WSB + WS_YCAT, WSB + WS_PCAT, F.G, F.bid};
            EpiMerged E{F.ws};
            REP(12) pg8::gemm_phase<4096u, 4096u>(F.tid, F.lds, S, E);
            SEAM(6);
        }
        if (IN(7)) { LAUNDER(); STAMP0(7);
            SchedDense<2048u, 2048u, T / 256, 4, 16> S{WSB + WS_XN, WSB + WS_WOUT, F.G, F.bid};
            EpiResid E{layer == 0 ? F.in[IN_X] : (const float*)F.out, F.out};
            REP(layer == 0 ? 13 : -1) pg8::gemm_phase<2048u, 2048u>(F.tid, F.lds, S, E);
            SEAM(7);
        }
        if (IN(8)) { LAUNDER(); STAMP0(8); REP(17) router_phase(F, layer); SEAM(8); }
        if (IN(9)) { LAUNDER(); STAMP0(9); (void)moe_tables(F, layer, offs, tile_e); REP(14) gather_phase(F, layer, offs); SEAM(9); }
        if (IN(10)) { LAUNDER(); STAMP0(10);
            const int ntiles = moe_tables(F, layer, offs, tile_e);
            SchedMoe<2048u, (size_t)1024 * 1024 * 2, (size_t)256 * 2048, 16> S{WSB + WS_XG, WSB + WS_EGU, ntiles, F.G, F.bid, tile_e};
            EpiSwiGlu E{(bf16_t*)(F.ws + WS_HID)};
            REP(15) pg8::gemm_phase<2048u, 2048u>(F.tid, F.lds, S, E);
            SEAM(10);
        }
        if (IN(11)) { LAUNDER(); STAMP0(11);
            const int ntiles = moe_tables(F, layer, offs, tile_e);
            SchedMoe<1024u, (size_t)1024 * 512 * 2, (size_t)256 * 1024, 8> S{WSB + WS_HID, WSB + WS_EDN, ntiles, F.G, F.bid, tile_e};
            EpiPlainBf16 E{(bf16_t*)(F.ws + WS_YEXP)};
            REP(16) pg8::gemm_phase<1024u, 1024u>(F.tid, F.lds, S, E);
            SEAM(11);
        }
        if (IN(12)) { LAUNDER(); STAMP0(12);
            if (PROBE_ID == 18) combine_phase(F, F.in[IN_NORM1], true);
            combine_phase(F, layer + 1 < DEPTH ? F.in[IN_NORM1] + (layer + 1) * 1024 : nullptr);
            if (layer + 1 < DEPTH) { __syncthreads(); convert_weights(F, layer + 1); __syncthreads(); s5_build(F, layer + 1); }
            SEAM(12);
        }
#undef GP
#undef IN
#undef SEAM
#undef WSB
}
__global__ void __launch_bounds__(NTHR, 2) fwd(Args args) {
    Frame F;
    F.lds = (LAS unsigned char*)lds_raw;
    F.MISC = (volatile LAS unsigned*)(F.lds + MISC_OFF);
    F.tid = threadIdx.x; F.lane = F.tid & 63; F.wave = __builtin_amdgcn_readfirstlane(F.tid >> 6);
    F.G = gridDim.x; F.bid = blockIdx.x;
    const __attribute__((address_space(4))) char* ka = (const __attribute__((address_space(4))) char*)__builtin_amdgcn_kernarg_segment_ptr();
    F.in = (const float* const __attribute__((address_space(4)))*)ka;
    F.out = *(float* const __attribute__((address_space(4)))*)(ka + N_INPUTS * 8); F.ws = *(unsigned char* const __attribute__((address_space(4)))*)(ka + N_INPUTS * 8 + 8); F.ctl = (unsigned*)(F.ws + WS_CTL);
    if (F.tid < 64) F.MISC[F.tid] = 0u;
    __syncthreads();
    XcdBarrier bar; bar.bar = F.ctl + CW_BAR; bar.x = 0; bar.st = nullptr;
    if (!MK_PER_PHASE) bar = xcd_barrier_post(F.ctl + CW_BAR, F.MISC);
    const int lo = *(const __attribute__((address_space(4))) int*)(ka + N_INPUTS * 8 + 16), hi_raw = *(const __attribute__((address_space(4))) int*)(ka + N_INPUTS * 8 + 20), hi = hi_raw & 0xffff;

    layer_body<0>(F, lo, hi, (hi_raw >> 16) != 0);
    layer_body<1>(F, lo, hi, (hi_raw >> 16) != 0);
#ifdef DIAG_GP
    __syncthreads();
    if (blockIdx.x == 0 && threadIdx.x == 0) { const unsigned t0 = *(volatile LAS unsigned*)((LAS unsigned char*)lds_raw_base() + MISC_OFF + 32), t1 = *(volatile LAS unsigned*)((LAS unsigned char*)lds_raw_base() + MISC_OFF + 40); float* o_ = *(float* const __attribute__((address_space(4)))*)((const __attribute__((address_space(4))) char*)__builtin_amdgcn_kernarg_segment_ptr() + N_INPUTS * 8); asm volatile("s_waitcnt vmcnt(0)" ::: "memory"); o_[0] = (float)(t1 - t0); }
#endif
}

extern "C" void kernel_launch(void* const* d_in, const int* in_sizes, int n_in, void* d_out, int out_size, void* d_ws, size_t ws_size, hipStream_t stream) {
    static int grid = 0;
    if (grid == 0) {
        if (n_in != N_INPUTS || out_size != T * DM || ws_size < WS_END) { fprintf(stderr, "kernel_launch: unexpected shapes (n_in %d out %d ws %zu need %zu)\n", n_in, out_size, ws_size, (size_t)WS_END); grid = -1; return; }
        int dev = 0, cus = 0, per_cu = 0;
        if (hipGetDevice(&dev) != hipSuccess || hipDeviceGetAttribute(&cus, hipDeviceAttributeMultiprocessorCount, dev) != hipSuccess) { grid = -1; return; }
        if (hipFuncSetAttribute((const void*)fwd, hipFuncAttributeMaxDynamicSharedMemorySize, LDS_BYTES) != hipSuccess) { fprintf(stderr, "kernel_launch: hipFuncSetAttribute failed\n"); grid = -1; return; }
        if (hipOccupancyMaxActiveBlocksPerMultiprocessor(&per_cu, (const void*)fwd, NTHR, LDS_BYTES) != hipSuccess || per_cu < 1) fprintf(stderr, "kernel_launch: occupancy query reports %d\n", per_cu);
        (void)hipGetLastError();
        grid = cus;
    }
    if (grid < 0) return;
    (void)hipMemsetAsync((char*)d_ws + WS_CTL, 0, CTL_ZERO_BYTES, stream);
    Args a{};
    for (int i = 0; i < N_INPUTS; ++i) a.in[i] = (const float*)d_in[i];
    a.out = (float*)d_out; a.ws = (unsigned char*)d_ws;
#if MK_PER_PHASE
    for (int gp = 0; gp < DEPTH * NPH; ++gp) {
        if (gp == NPH) continue;
        a.gp_lo = gp; a.gp_hi = gp + 1;
        int nrep = 1;
#ifdef PP_REP_GP
        if (gp == PP_REP_GP) nrep = 1 + PP_REP_N;
#endif
        for (int rr = 0; rr < nrep; ++rr) { a.gp_hi = (gp + 1) | (rr > 0 ? 0x10000 : 0); hipLaunchKernelGGL(fwd, dim3(grid), dim3(NTHR), LDS_BYTES, stream, a); }
    }
#else
    a.gp_lo = 0; a.gp_hi = DEPTH * NPH;
    hipLaunchKernelGGL(fwd, dim3(grid), dim3(NTHR), LDS_BYTES, stream, a);
#endif
}
```

```cpp
#include <hip/hip_runtime.h>
#include <cstdio>
#include <cstdint>

#define LAS __attribute__((address_space(3)))
#define GAS __attribute__((address_space(1)))
typedef unsigned short bf16_t;
typedef short bf16x8 __attribute__((ext_vector_type(8)));
typedef float f32x4 __attribute__((ext_vector_type(4)));
typedef float f32x2 __attribute__((ext_vector_type(2)));
typedef unsigned u32x4 __attribute__((ext_vector_type(4)));
typedef unsigned u32x2 __attribute__((ext_vector_type(2)));

constexpr int BATCH = 4, SEQ = 4096, DM = 1024, T = BATCH * SEQ, DEPTH = 2;
constexpr int NIN = 6672, NINP = 6912;
constexpr int C_U = 0, C_Q = 512, C_K = 1024, C_V = 1152, C_Z = 1280, C_XS = 2304, C_B = 3328, C_C = 3456, C_DT = 3584, C_G = 3840;
constexpr int S5_TC = 32, S5_ROWS = T / S5_TC  , S5_K = 128 + S5_TC * 16  , S5_N = S5_TC * 16  ;
constexpr int SSD_NCH = SEQ / 128;
constexpr int MOE_MAXROWS = 2 * T + 32 * 256;
constexpr float NORM_EPS = 1e-6f;

constexpr size_t MiB = 1u << 20;
constexpr size_t WS_CTL = 0, CTL_ZERO_BYTES = 1 * MiB;
constexpr size_t WS_WIN = 1 * MiB;
constexpr size_t WS_WGLU = WS_WIN + (size_t)NINP * DM * 2;
constexpr size_t WS_PCAT = WS_WGLU + 1 * MiB;
constexpr size_t WS_WOUT = WS_PCAT + 4 * MiB;
constexpr size_t WS_EGU = WS_WOUT + 2 * MiB;
constexpr size_t WS_EDN = WS_EGU + 64 * MiB;
constexpr size_t WS_MG = WS_EDN + 32 * MiB;
constexpr size_t WS_EG = WS_MG + 20 * MiB;
constexpr size_t WS_XN = WS_EG + 8 * MiB;
constexpr size_t WS_P = WS_XN + 32 * MiB;
constexpr size_t WS_XG = WS_P;
constexpr size_t WS_HID = WS_XG + (size_t)MOE_MAXROWS * 1024 * 2;
constexpr size_t WS_YEXP = WS_HID + (size_t)MOE_MAXROWS * 512 * 2;
constexpr size_t WS_DT = WS_P + 216 * MiB;
constexpr size_t WS_UH = WS_DT + 1 * MiB;
constexpr size_t WS_HLOC = WS_UH + 20 * MiB;
constexpr size_t WS_YCAT = WS_HLOC + 8 * MiB;
constexpr size_t WS_SST = WS_YCAT + 64 * MiB;
constexpr size_t WS_MOE = WS_SST + 32 * MiB;
constexpr size_t WS_ASUM = WS_MOE + 1 * MiB;
constexpr size_t WS_END = WS_ASUM + 64 * 1024;
static_assert(WS_YEXP + (size_t)MOE_MAXROWS * 1024 * 2 <= WS_DT, "MoE overlay fits in P");
constexpr int CW_BAR = 4096;
constexpr int CW_CNT = 16384;

constexpr int NWAVES = 8, NTHR = 512;
constexpr int LDS_BYTES = 163840;
constexpr int RING_BYTES = 131072;
constexpr int MISC_OFF = 160 * 1024 - 256;

__device__ __forceinline__ unsigned f2bf(float f) { unsigned u = __builtin_bit_cast(unsigned, f); return (u + 0x7fffu + ((u >> 16) & 1u)) >> 16; }
__device__ __forceinline__ unsigned pk2(float lo, float hi) { return f2bf(lo) | (f2bf(hi) << 16); }
__device__ __forceinline__ float bf2f(unsigned b) { return __builtin_bit_cast(float, b << 16); }
__device__ __forceinline__ float bflo(unsigned w) { return __builtin_bit_cast(float, w << 16); }
__device__ __forceinline__ float bfhi(unsigned w) { return __builtin_bit_cast(float, w & 0xffff0000u); }
#define WS_DPP(v, ctrl, rmask) __builtin_bit_cast(float, __builtin_amdgcn_update_dpp(0, __builtin_bit_cast(int, v), ctrl, rmask, 0xF, false))
__device__ __forceinline__ float wave_sum(float v) {
    v += WS_DPP(v, 0xB1, 0xF);
    v += WS_DPP(v, 0x4E, 0xF);
    v += WS_DPP(v, 0x141, 0xF);
    v += WS_DPP(v, 0x140, 0xF);
    v += WS_DPP(v, 0x142, 0xA);
    v += WS_DPP(v, 0x143, 0xC);
    return __builtin_bit_cast(float, __builtin_amdgcn_readlane(__builtin_bit_cast(int, v), 63));
}
__device__ __forceinline__ float frcp(float x) { return __builtin_amdgcn_rcpf(x); }
__device__ __forceinline__ float sigmoidf_(float x) { return frcp(1.0f + __expf(-x)); }
__device__ __forceinline__ float siluf_(float x) { return x * frcp(1.0f + __expf(-x)); }
__device__ __forceinline__ float gelu_tanh_(float x) { const float u = 0.7978845608f * (x + 0.044715f * x * x * x); return x * frcp(1.0f + __expf(-2.0f * u)); }
__device__ __forceinline__ float softplusf_(float x) { return x > 20.f ? x : log1pf(__expf(x)); }

typedef float f32x16 __attribute__((ext_vector_type(16)));
typedef float f32x2_t __attribute__((ext_vector_type(2)));
typedef __bf16 bf16x2_t __attribute__((ext_vector_type(2)));
#define MFMA32(a, b, c) __builtin_amdgcn_mfma_f32_32x32x16_bf16((a), (b), (c), 0, 0, 0)
__device__ __forceinline__ unsigned cvtpk(float lo, float hi) { f32x2_t v = {lo, hi}; bf16x2_t b = __builtin_convertvector(v, bf16x2_t); return __builtin_bit_cast(unsigned, b); }
__device__ __forceinline__ bf16x8 pack8v(const float (&v)[8]) { u32x4 p; p.x = cvtpk(v[0], v[1]); p.y = cvtpk(v[2], v[3]); p.z = cvtpk(v[4], v[5]); p.w = cvtpk(v[6], v[7]); return __builtin_bit_cast(bf16x8, p); }

#define XB_TMO      128
#define XB_XCNT(j)  (256  + 64 * (j))
#define XB_XSUB(j)  (1280 + 64 * (j))
#define XB_XGEN(j)  (2304 + 64 * (j))
#define XB_TOP      3328
#define XB_TOPGEN   3392
#define XCD_BAR_WORDS 3456
#define XB_SPIN_CAP (1u << 18)
__device__ __forceinline__ unsigned xb_ld(unsigned* p)              { return __hip_atomic_load(p, __ATOMIC_RELAXED, __HIP_MEMORY_SCOPE_AGENT); }
__device__ __forceinline__ unsigned xb_add(unsigned* p, unsigned v) { return __hip_atomic_fetch_add(p, v, __ATOMIC_RELAXED, __HIP_MEMORY_SCOPE_AGENT); }
__device__ __forceinline__ unsigned xb_xcc_id() { return (unsigned)__builtin_amdgcn_s_getreg((3 << 11) | 20) & 0xFu; }
#define XB_SPIN(cond, bar) do { unsigned _sp = 0; while (cond) { __builtin_amdgcn_s_sleep(1); \
    if ((++_sp & 255u) == 0u) { if (xb_ld(&(bar)[XB_TMO])) break; if (_sp > XB_SPIN_CAP) { atomicAdd(&(bar)[XB_TMO], 1u); break; } } } } while (0)
struct XcdBarrier { unsigned* bar; unsigned x; volatile LAS unsigned* st; };
__device__ __forceinline__ XcdBarrier xcd_barrier_post(unsigned* bar, volatile LAS unsigned* st) {
    XcdBarrier b; b.bar = bar; b.x = xb_xcc_id(); b.st = st;
    if (threadIdx.x == 0) (void)xb_add(&bar[XB_XCNT(b.x)], 1u);
    return b;
}
__device__ __forceinline__ void xcd_barrier_complete(unsigned* bar, unsigned x, unsigned& nloc, unsigned& nx) {
    const unsigned G = gridDim.x * gridDim.y * gridDim.z;
    unsigned sum, cnt, mine, sp = 0u;
    for (;;) {
        sum = 0u; cnt = 0u; mine = 0u;
#pragma unroll
        for (unsigned j = 0; j < 16; ++j) { const unsigned c = xb_ld(&bar[XB_XCNT(j)]); sum += c; cnt += (c > 0u) ? 1u : 0u; mine = (j == x) ? c : mine; }
        if (sum == G) break;
        __builtin_amdgcn_s_sleep(1);
        if ((++sp & 255u) == 0u) { if (xb_ld(&bar[XB_TMO])) break; if (sp > XB_SPIN_CAP) { atomicAdd(&bar[XB_TMO], 1u); break; } }
    }
    nloc = mine > 0u ? mine : 1u; nx = cnt > 0u ? cnt : 1u;
}
__device__ __forceinline__ void xcd_barrier(const XcdBarrier& b) {
    asm volatile("s_waitcnt vmcnt(0)" ::: "memory");
    __syncthreads();
    if (threadIdx.x == 0) {
        unsigned* bar = b.bar;
        __builtin_amdgcn_s_waitcnt(0);
        unsigned nloc = b.st[0], nx = b.st[1];
        if (nloc == 0u) { xcd_barrier_complete(bar, b.x, nloc, nx); b.st[0] = nloc; b.st[1] = nx; }
        const unsigned old = xb_add(&bar[XB_XSUB(b.x)], 1u);
        const unsigned gen = old / nloc;
        if (old + 1u == (gen + 1u) * nloc) {
            __builtin_amdgcn_fence(__ATOMIC_RELEASE, "agent");
            asm volatile("s_waitcnt vmcnt(0)" ::: "memory");
            const unsigned og = xb_add(&bar[XB_TOP], 1u);
            const unsigned tg = og / nx;
            if (og + 1u == (tg + 1u) * nx) xb_add(&bar[XB_TOPGEN], 1u);
            else XB_SPIN(xb_ld(&bar[XB_TOPGEN]) == tg, bar);
            __builtin_amdgcn_fence(__ATOMIC_ACQUIRE, "agent");
            xb_add(&bar[XB_XGEN(b.x)], 1u);
            asm volatile("s_waitcnt vmcnt(0)" ::: "memory");
        } else {
            XB_SPIN(xb_ld(&bar[XB_XGEN(b.x)]) == gen, bar);
            __builtin_amdgcn_fence(__ATOMIC_ACQUIRE, "agent");
            asm volatile("s_waitcnt vmcnt(0)" ::: "memory");
        }
    }
    __syncthreads();
}

namespace pg8 {
constexpr int BM = 256, BK = 64, HALF = 128, HTB = HALF * BK * 2, STAGE_BYTES = 8 * HTB, NXCD = 8, WGM = 8;
__host__ __device__ __forceinline__ int lds_byte(int r, int c) { const int st = (r >> 4) * 2 + (c >> 5), rr = r & 15, cc = c & 31, ob = rr * 64 + cc * 2; return st * 1024 + (ob ^ (((ob >> 9) & 1) << 5)); }
__host__ __device__ __forceinline__ void stage_rc(int b, int& R, int& C) { const int st = b / 1024, sb = b % 1024, swz = sb ^ (((sb >> 9) & 1) << 5); R = (st >> 1) * 16 + swz / 64; C = (st & 1) * 32 + (swz % 64) / 2; }
__host__ __device__ __forceinline__ int perm32(int rho) { const int n = rho >> 4, i = rho & 15; return 8 * (i >> 2) + 4 * n + (i & 3); }

struct Unit { const char* A; const char* B; int nt; int pm, pn, aux; };

__device__ __forceinline__ void tile_order(int L, int nM, int nN, int& pm, int& pn) {
    const int nwg = nM * nN; int wgid = L;
    { const int q = nwg / NXCD, r = nwg % NXCD, xcd = wgid % NXCD, off = wgid / NXCD; wgid = (xcd < r ? xcd * (q + 1) : r * (q + 1) + (xcd - r) * q) + off; }
    const int nig = WGM * nN, gid = wgid / nig, fm = gid * WGM, gsz = (nM - fm) < WGM ? (nM - fm) : WGM;
    pm = fm + ((wgid % nig) % gsz); pn = (wgid % nig) / gsz;
}
__device__ __forceinline__ unsigned cvt_pk_bf16(float lo, float hi) { unsigned r; asm volatile("v_cvt_pk_bf16_f32 %0, %1, %2" : "=v"(r) : "v"(lo), "v"(hi)); return r; }
__device__ __forceinline__ u32x4 pack8(const f32x4 v0, const f32x4 v1) { u32x4 w; w.x = cvt_pk_bf16(v0[0], v0[1]); w.y = cvt_pk_bf16(v0[2], v0[3]); w.z = cvt_pk_bf16(v1[0], v1[1]); w.w = cvt_pk_bf16(v1[2], v1[3]); return w; }

template <unsigned lda, unsigned ldb, class Epi, class Sched>
__device__ __forceinline__ void gemm_phase(const int tid, LAS unsigned char* lds, const Sched& S, const Epi& E) {
    const int wid = __builtin_amdgcn_readfirstlane(tid >> 6), lane = tid & 63, wr = wid >> 2, wc = wid & 3, fr = lane & 15, fq = lane >> 4;
    unsigned voffA[2], voffB[2];
#pragma unroll
    for (int i = 0; i < 2; ++i) { int R, C; stage_rc(tid * 16 + i * 8192, R, C); const int Rb = Epi::PERM ? ((R & ~31) + perm32(R & 31)) : R;
        voffA[i] = (unsigned)R * lda + (unsigned)C * 2u; voffB[i] = (unsigned)Rb * ldb + (unsigned)C * 2u; }
    const size_t kstep = (size_t)(BK * 2);
    const size_t hstepA = (size_t)HALF * lda, hstepB = (size_t)HALF * ldb;
    const unsigned ldsw = (unsigned)wid * 1024u;
    const int aoff = lds_byte(wr * 64 + fr, fq * 8), boff = lds_byte(wc * 32 + fr, fq * 8);
#define PG8_SA(b, h) (((b) * 2 + (h)) * HTB)
#define PG8_SB(b, h) ((4 + (b) * 2 + (h)) * HTB)
#define PG8_STAGE(bufoff, gbase, voff) do { const char* _gb = (const char*)(gbase); asm volatile("" : "+s"(_gb)); _Pragma("unroll") for (int _i = 0; _i < 2; ++_i) \
        __builtin_amdgcn_global_load_lds((const unsigned*)(_gb + (voff)[_i]), (LAS unsigned*)(lds + (bufoff) + ldsw + _i * 8192), 16, 0, 0); } while (0)
#define PG8_LDA(dst, b, h) do { _Pragma("unroll") for (int m = 0; m < 4; ++m) _Pragma("unroll") for (int k = 0; k < 2; ++k) dst[m][k] = *(const LAS bf16x8*)(lds + PG8_SA(b, h) + aoff + m * 2048 + k * 1024); } while (0)
#define PG8_LDB(dst, b, h) do { _Pragma("unroll") for (int n = 0; n < 2; ++n) _Pragma("unroll") for (int k = 0; k < 2; ++k) dst[n][k] = *(const LAS bf16x8*)(lds + PG8_SB(b, h) + boff + n * 2048 + k * 1024); } while (0)
#define PG8_MMA(ai, bj, At, Bt) do { __builtin_amdgcn_s_setprio(1); _Pragma("unroll") for (int m = 0; m < 4; ++m) _Pragma("unroll") for (int n = 0; n < 2; ++n) _Pragma("unroll") for (int k = 0; k < 2; ++k) \
        acc[ai][bj][m][n] = __builtin_amdgcn_mfma_f32_16x16x32_bf16(Bt[n][k], At[m][k], acc[ai][bj][m][n], 0, 0, 0); __builtin_amdgcn_s_setprio(0); } while (0)
#define PG8_WAIT_V(n) asm volatile("s_waitcnt vmcnt(" #n ")" ::: "memory")
#define PG8_WAIT_L(n) asm volatile("s_waitcnt lgkmcnt(" #n ")" ::: "memory")
#define PG8_BAR __builtin_amdgcn_s_barrier()
#define PG8_SCHED __builtin_amdgcn_sched_barrier(0)
    Unit cur, nxt; int ui = 0;
    if (!S.next(0, cur)) return;
    f32x4 acc[2][2][4][2];
#pragma unroll
    for (int a = 0; a < 2; ++a)
#pragma unroll
        for (int b = 0; b < 2; ++b)
#pragma unroll
            for (int m = 0; m < 4; ++m)
#pragma unroll
                for (int n = 0; n < 2; ++n) acc[a][b][m][n] = (f32x4){0.f, 0.f, 0.f, 0.f};
    bf16x8 At[4][2], B0[2][2], B1[2][2];
    const char* cA = cur.A; const char* cB = cur.B;
    PG8_STAGE(PG8_SB(0, 0), cB, voffB); PG8_STAGE(PG8_SB(0, 1), cB + hstepB, voffB); PG8_STAGE(PG8_SA(0, 0), cA, voffA); PG8_STAGE(PG8_SA(0, 1), cA + hstepA, voffA);
    if (wr == 1) PG8_BAR;
    PG8_WAIT_V(2); PG8_BAR;
    PG8_STAGE(PG8_SB(1, 0), cB + kstep, voffB); PG8_STAGE(PG8_SA(1, 0), cA + kstep, voffA); PG8_STAGE(PG8_SB(1, 1), cB + hstepB + kstep, voffB);
    PG8_WAIT_V(6); PG8_BAR;
    for (;;) {
        const bool has_next = S.next(ui + 1, nxt);
        const char* nA = has_next ? nxt.A : cA; const char* nB = has_next ? nxt.B : cB;
        const int nt = cur.nt;
        for (int t = 0; t < nt; t += 2) {
            const bool last = (t == nt - 2);
            const char* a1 = cA + (size_t)(t + 1) * kstep;
            const char* a2 = last ? nA : cA + (size_t)(t + 2) * kstep; const char* b2 = last ? nB : cB + (size_t)(t + 2) * kstep;
            const char* a3 = a2 + kstep; const char* b3 = b2 + kstep;
            PG8_LDB(B0, 0, 0); PG8_LDB(B1, 0, 1); PG8_SCHED; PG8_LDA(At, 0, 0); PG8_STAGE(PG8_SA(1, 1), a1 + hstepA, voffA);
            PG8_WAIT_V(8); PG8_WAIT_L(0); PG8_BAR; PG8_MMA(0, 0, At, B0); PG8_MMA(0, 1, At, B1); PG8_BAR; PG8_SCHED;
            PG8_LDA(At, 0, 1); PG8_STAGE(PG8_SB(0, 0), b2, voffB); PG8_STAGE(PG8_SB(0, 1), b2 + hstepB, voffB); PG8_STAGE(PG8_SA(0, 0), a2, voffA);
            PG8_WAIT_V(8); PG8_WAIT_L(0); PG8_BAR; PG8_MMA(1, 0, At, B0); PG8_MMA(1, 1, At, B1); PG8_BAR; PG8_SCHED;
            PG8_LDB(B0, 1, 0); PG8_LDB(B1, 1, 1); PG8_SCHED; PG8_LDA(At, 1, 0); PG8_STAGE(PG8_SA(0, 1), a2 + hstepA, voffA);
            PG8_WAIT_V(8); PG8_WAIT_L(0); PG8_BAR; PG8_MMA(0, 0, At, B0); PG8_MMA(0, 1, At, B1); PG8_BAR; PG8_SCHED;
            PG8_LDA(At, 1, 1); PG8_STAGE(PG8_SB(1, 0), b3, voffB); PG8_STAGE(PG8_SB(1, 1), b3 + hstepB, voffB); PG8_STAGE(PG8_SA(1, 0), a3, voffA);
            PG8_WAIT_V(8); PG8_WAIT_L(0); PG8_BAR; PG8_MMA(1, 0, At, B0); PG8_MMA(1, 1, At, B1); PG8_BAR; PG8_SCHED;
            if constexpr (Epi::HAS_MID) { if (t + 2 == 8 || t + 2 == 16) { E.mid(acc, cur, t + 2, wr, wc, fr, fq); PG8_SCHED; } }
        }
        if (wr == 0) PG8_BAR;
        E(acc, cur, wr, wc, fr, fq);
        if (!has_next) break;
#pragma unroll
        for (int a = 0; a < 2; ++a)
#pragma unroll
            for (int b = 0; b < 2; ++b)
#pragma unroll
                for (int m = 0; m < 4; ++m)
#pragma unroll
                    for (int n = 0; n < 2; ++n) acc[a][b][m][n] = (f32x4){0.f, 0.f, 0.f, 0.f};
        cur = nxt; cA = nA; cB = nB; ++ui;
        if (wr == 1) PG8_BAR;
    }
    PG8_WAIT_V(0);
    PG8_BAR;
#undef PG8_SA
#undef PG8_SB
#undef PG8_STAGE
#undef PG8_LDA
#undef PG8_LDB
#undef PG8_MMA
#undef PG8_WAIT_V
#undef PG8_WAIT_L
#undef PG8_BAR
#undef PG8_SCHED
}
}

struct Frame {
    LAS unsigned char* lds;
    volatile LAS unsigned* MISC;
    unsigned* ctl;
    int tid, lane, wave, G, bid;
    const float* const __attribute__((address_space(4)))* in;
    float* out; unsigned char* ws;
};
enum { IN_X = 0, IN_NORM1, IN_WIN, IN_BGATE, IN_LRE, IN_LIM, IN_BRE, IN_BIM, IN_CRE, IN_CIM, IN_S5D, IN_LOGDT, IN_GLU1, IN_GLU2, IN_QG, IN_KG, IN_SINK,
       IN_CONVW, IN_CONVB, IN_DTB, IN_ALOG, IN_SSDD, IN_SSDG, IN_PS5, IN_PATTN, IN_PSSD, IN_WOUT, IN_NORM2, IN_WRG, IN_BRG, IN_WRE, IN_BRE_, IN_EG, IN_EU, IN_ED, N_INPUTS };

#define LDS_WAIT() asm volatile("s_waitcnt lgkmcnt(0)" ::: "memory")
#define VM_WAIT() asm volatile("s_waitcnt vmcnt(0)" ::: "memory")

using pg8::Unit; using pg8::pack8;
struct EpiProj {
    static constexpr bool PERM = true, HAS_MID = false;
    unsigned char* ws; const float* bgate;
    __device__ __forceinline__ void operator()(const f32x4 (&acc)[2][2][4][2], const Unit& u, int wr, int wc, int fr, int fq) const {
        bf16_t* P = (bf16_t*)(ws + WS_P); bf16_t* UH = (bf16_t*)(ws + WS_UH); float* DT = (float*)(ws + WS_DT);
        const int row0 = u.pm * 256 + wr * 64 + fr;
        if (u.pn < 2) {
#pragma unroll
            for (int ai = 0; ai < 2; ++ai)
#pragma unroll
                for (int m = 0; m < 4; ++m) { const int row = row0 + ai * 128 + m * 16, r = row >> 5, s = row & 31;
#pragma unroll
                    for (int bj = 0; bj < 2; ++bj) { const int col = u.pn * 256 + bj * 128 + wc * 32 + 8 * fq, g = col >> 4, c0 = col & 15;
                        *(u32x4*)(UH + ((size_t)(g * S5_ROWS + r) * S5_K + 128 + s * 16 + c0)) = pack8(acc[ai][bj][m][0], acc[ai][bj][m][1]); } }
        } else {
            const int colb = u.pn * 256 + wc * 32 + 8 * fq;
            f32x4 bv[2][2];
#pragma unroll
            for (int bj = 0; bj < 2; ++bj)
#pragma unroll
                for (int n = 0; n < 2; ++n) bv[bj][n] = (u.pn >= 15) ? *(const f32x4*)(bgate + (colb - C_G) + bj * 128 + 4 * n) : (f32x4){0.f, 0.f, 0.f, 0.f};
#pragma unroll
            for (int ai = 0; ai < 2; ++ai)
#pragma unroll
                for (int m = 0; m < 4; ++m) { const int row = row0 + ai * 128 + m * 16;
#pragma unroll
                    for (int bj = 0; bj < 2; ++bj) *(u32x4*)(P + (size_t)row * NINP + colb + bj * 128) = pack8(acc[ai][bj][m][0] + bv[bj][0], acc[ai][bj][m][1] + bv[bj][1]);
                    if (u.pn == 14 && wc == 0 && fq < 2) { float* d = DT + (size_t)row * 16 + 8 * fq; *(f32x4*)d = acc[ai][0][m][0]; *(f32x4*)(d + 4) = acc[ai][0][m][1]; } }
        }
    }
};
struct EpiHloc {
    static constexpr bool PERM = false, HAS_MID = false;
    float* H;
    __device__ __forceinline__ void operator()(const f32x4 (&acc)[2][2][4][2], const Unit& u, int wr, int wc, int fr, int fq) const {
#pragma unroll
        for (int ai = 0; ai < 2; ++ai)
#pragma unroll
            for (int m = 0; m < 4; ++m) { const int r = u.pm * 256 + ai * 128 + wr * 64 + m * 16 + fr; float* rowp = H + ((size_t)(u.aux * S5_ROWS + r) * 128) + wc * 32 + 4 * fq;
#pragma unroll
                for (int n = 0; n < 2; ++n) *(f32x4*)(rowp + 16 * n) = acc[ai][0][m][n]; }
    }
};
struct EpiS5Y {
    static constexpr bool PERM = true, HAS_MID = false;
    bf16_t* Y;
    __device__ __forceinline__ void operator()(const f32x4 (&acc)[2][2][4][2], const Unit& u, int wr, int wc, int fr, int fq) const {
#pragma unroll
        for (int ai = 0; ai < 2; ++ai)
#pragma unroll
            for (int m = 0; m < 4; ++m) { const int r = u.pm * 256 + ai * 128 + wr * 64 + m * 16 + fr;
#pragma unroll
                for (int bj = 0; bj < 2; ++bj) { const int n0 = u.pn * 256 + bj * 128 + wc * 32 + 8 * fq, t = n0 >> 4, c0 = n0 & 15;
                    f32x4 v0 = acc[ai][bj][m][0], v1 = acc[ai][bj][m][1];
#pragma unroll
                    for (int j = 0; j < 4; ++j) { v0[j] = gelu_tanh_(v0[j]); v1[j] = gelu_tanh_(v1[j]); }
                    *(u32x4*)(Y + ((size_t)(r * S5_TC + t) * 512 + u.aux * 16 + c0)) = pack8(v0, v1); } }
    }
};
struct EpiGlu {
    static constexpr bool PERM = true, HAS_MID = false;
    bf16_t* Y;
    __device__ __forceinline__ void operator()(const f32x4 (&acc)[2][2][4][2], const Unit& u, int wr, int wc, int fr, int fq) const {
#pragma unroll
        for (int ai = 0; ai < 2; ++ai)
#pragma unroll
            for (int m = 0; m < 4; ++m) { const int row = u.pm * 256 + ai * 128 + wr * 64 + m * 16 + fr;
                f32x4 v0 = acc[ai][0][m][0], v1 = acc[ai][0][m][1]; const f32x4 g0 = acc[ai][1][m][0], g1 = acc[ai][1][m][1];
#pragma unroll
                for (int j = 0; j < 4; ++j) { v0[j] *= sigmoidf_(g0[j]); v1[j] *= sigmoidf_(g1[j]); }
                *(u32x4*)(Y + (size_t)row * 2048 + u.pn * 128 + wc * 32 + 8 * fq) = pack8(v0, v1); }
    }
};
struct EpiSwiGlu {
    static constexpr bool PERM = true, HAS_MID = false;
    bf16_t* Y; const float* RSG;
    __device__ __forceinline__ void operator()(const f32x4 (&acc)[2][2][4][2], const Unit& u, int wr, int wc, int fr, int fq) const {
#pragma unroll
        for (int ai = 0; ai < 2; ++ai)
#pragma unroll
            for (int m = 0; m < 4; ++m) { const int row = u.pm * 256 + ai * 128 + wr * 64 + m * 16 + fr;
                f32x4 v0 = acc[ai][0][m][0], v1 = acc[ai][0][m][1]; const f32x4 g0 = acc[ai][1][m][0], g1 = acc[ai][1][m][1]; const float rr = 1.f;
#pragma unroll
                for (int j = 0; j < 4; ++j) { v0[j] = siluf_(v0[j] * rr) * (g0[j] * rr); v1[j] = siluf_(v1[j] * rr) * (g1[j] * rr); }
                *(u32x4*)(Y + (size_t)row * 512 + u.pn * 128 + wc * 32 + 8 * fq) = pack8(v0, v1); }
    }
};
struct EpiPlainBf16 {
    static constexpr bool PERM = true, HAS_MID = false;
    bf16_t* O;
    __device__ __forceinline__ void operator()(const f32x4 (&acc)[2][2][4][2], const Unit& u, int wr, int wc, int fr, int fq) const {
#pragma unroll
        for (int ai = 0; ai < 2; ++ai)
#pragma unroll
            for (int m = 0; m < 4; ++m) { const int row = u.pm * 256 + ai * 128 + wr * 64 + m * 16 + fr;
#pragma unroll
                for (int bj = 0; bj < 2; ++bj) *(u32x4*)(O + (size_t)row * 1024 + u.pn * 256 + bj * 128 + wc * 32 + 8 * fq) = pack8(acc[ai][bj][m][0], acc[ai][bj][m][1]); }
    }
};
struct EpiMerged {
    static constexpr bool PERM = true, HAS_MID = true;
    unsigned char* ws;
    __device__ __forceinline__ static float lclamp(float l) { return fminf(fmaxf(l, -30.f), 30.f); }
    __device__ __forceinline__ void mid(f32x4 (&acc)[2][2][4][2], const Unit& u, int kt, int wr, int wc, int fr, int fq) const {
        const int br = (kt == 8) ? 0 : 1; const bf16_t* P = (const bf16_t*)(ws + WS_P);
#pragma unroll
        for (int ai = 0; ai < 2; ++ai)
#pragma unroll
            for (int m = 0; m < 4; ++m) { const int row = u.pm * 256 + ai * 128 + wr * 64 + m * 16 + fr;
#pragma unroll
                for (int bj = 0; bj < 2; ++bj) { const bf16_t* gp = P + (size_t)row * NINP + C_G + br * 1024 + u.pn * 256 + bj * 128 + wc * 32 + 8 * fq;
                    const u32x4 la = *(const u32x4*)gp, lb = *(const u32x4*)(gp + 1024);
#pragma unroll
                    for (int j = 0; j < 4; ++j) { const unsigned wa = la[j], wb = lb[j];
                        const float r0 = (1.f + __expf(-lclamp(bflo(wb)))) * frcp(1.f + __expf(-lclamp(bflo(wa)))), r1 = (1.f + __expf(-lclamp(bfhi(wb)))) * frcp(1.f + __expf(-lclamp(bfhi(wa))));
                        if (j < 2) { acc[ai][bj][m][0][2 * j] *= r0; acc[ai][bj][m][0][2 * j + 1] *= r1; } else { acc[ai][bj][m][1][2 * j - 4] *= r0; acc[ai][bj][m][1][2 * j - 3] *= r1; } } }
                if (m == 3) asm volatile("" ::: "memory"); }
    }
    __device__ __forceinline__ void operator()(const f32x4 (&acc)[2][2][4][2], const Unit& u, int wr, int wc, int fr, int fq) const {
        const bf16_t* P = (const bf16_t*)(ws + WS_P); bf16_t* O = (bf16_t*)(ws + WS_XN);
#pragma unroll
        for (int ai = 0; ai < 2; ++ai)
#pragma unroll
            for (int m = 0; m < 4; ++m) { const int row = u.pm * 256 + ai * 128 + wr * 64 + m * 16 + fr;
#pragma unroll
                for (int bj = 0; bj < 2; ++bj) { const int col = u.pn * 256 + bj * 128 + wc * 32 + 8 * fq;
                    const u32x4 lc = *(const u32x4*)(P + (size_t)row * NINP + C_G + 2048 + col);
                    f32x4 v0 = acc[ai][bj][m][0], v1 = acc[ai][bj][m][1];
                    v0[0] *= sigmoidf_(lclamp(bflo(lc[0]))); v0[1] *= sigmoidf_(lclamp(bfhi(lc[0]))); v0[2] *= sigmoidf_(lclamp(bflo(lc[1]))); v0[3] *= sigmoidf_(lclamp(bfhi(lc[1])));
                    v1[0] *= sigmoidf_(lclamp(bflo(lc[2]))); v1[1] *= sigmoidf_(lclamp(bfhi(lc[2]))); v1[2] *= sigmoidf_(lclamp(bflo(lc[3]))); v1[3] *= sigmoidf_(lclamp(bfhi(lc[3])));
                    *(u32x4*)(O + (size_t)row * 1024 + col) = pack8(v0, v1); }
                if (m == 3) asm volatile("" ::: "memory"); }
    }
};
struct EpiResid {
    static constexpr bool PERM = false, HAS_MID = false;
    const float* resid; float* out;
    __device__ __forceinline__ void operator()(const f32x4 (&acc)[2][2][4][2], const Unit& u, int wr, int wc, int fr, int fq) const {
#pragma unroll
        for (int ai = 0; ai < 2; ++ai)
#pragma unroll
            for (int m = 0; m < 4; ++m) { const size_t off = (size_t)(u.pm * 256 + ai * 128 + wr * 64 + m * 16 + fr) * 1024 + u.pn * 256 + wc * 32 + 4 * fq;
#pragma unroll
                for (int bj = 0; bj < 2; ++bj)
#pragma unroll
                    for (int n = 0; n < 2; ++n) { const f32x4 rv = *(const f32x4*)(resid + off + bj * 128 + n * 16); *(f32x4*)(out + off + bj * 128 + n * 16) = rv + acc[ai][bj][m][n]; } }
    }
};

template <unsigned lda, unsigned ldb, int nM, int nN, int NT>
struct SchedDense {
    const char* A; const char* B; int G, c;
    __device__ __forceinline__ bool next(int i, Unit& u) const {
        const int L = i * G + c; if (L >= nM * nN) return false;
        int pm, pn; pg8::tile_order(L, nM, nN, pm, pn);
        u.A = A + (size_t)pm * 256 * lda; u.B = B + (size_t)pn * 256 * ldb; u.nt = NT; u.pm = pm; u.pn = pn; u.aux = 0; return true;
    }
};
struct SchedS5P1 {
    const char* UH; const char* EG; int G, c;
    __device__ __forceinline__ bool next(int i, Unit& u) const {
        const int L = i * G + c; if (L >= 64) return false;
        const int g = L >> 1, pm = L & 1;
        u.A = UH + ((size_t)(g * S5_ROWS + pm * 256) * S5_K + 128) * 2; u.B = EG + (size_t)g * 256 * 512 * 2; u.nt = 8; u.pm = pm; u.pn = 0; u.aux = g; return true;
    }
};
struct SchedS5Main {
    const char* UH; const char* MG; int G, c;
    __device__ __forceinline__ bool next(int i, Unit& u) const {
        const int L = i * G + c; if (L >= 128) return false;
        const int g = L >> 2, pm = (L >> 1) & 1, pn = L & 1;
        u.A = UH + (size_t)(g * S5_ROWS + pm * 256) * S5_K * 2; u.B = MG + (size_t)(g * S5_N + pn * 256) * S5_K * 2; u.nt = 2 + 4 * (pn + 1); u.pm = pm; u.pn = pn; u.aux = g; return true;
    }
};
template <unsigned lda, size_t bexp  , size_t btile  , int NT>
struct SchedMoe {
    const char* A; const char* B; int ntiles, G, c; const volatile LAS int* tile_e;
    __device__ __forceinline__ bool next(int i, Unit& u) const {
        const int L = i * G + c; if (L >= ntiles * 4) return false;
        int pm, pn; pg8::tile_order(L, ntiles, 4, pm, pn);
        const int e = __builtin_amdgcn_readfirstlane(tile_e[pm]);
        u.A = A + (size_t)pm * 256 * lda; u.B = B + (size_t)e * bexp + (size_t)pn * btile; u.nt = NT; u.pm = pm; u.pn = pn; u.aux = e; return true;
    }
};

__device__ __forceinline__ void transpose_item(const float* W, int ldw, int ncols, bf16_t* WT, int ldt, int kofs, int mode, int p0, int p1, LAS float* scr, int k0, int n0, int lane) {
    float wv[32];
#pragma unroll
    for (int i = 0; i < 32; ++i) { const int kk = 2 * i + (lane >> 5), n = n0 + (lane & 31); wv[i] = (n < ncols) ? W[(size_t)(k0 + kk) * ldw + n] : 0.f; }
#pragma unroll
    for (int i = 0; i < 32; ++i) { const int kk = 2 * i + (lane >> 5); scr[kk * 33 + (lane & 31)] = wv[i]; }
    LDS_WAIT(); asm volatile("" ::: "memory");
    const int c = lane & 7;
#pragma unroll
    for (int j = 0; j < 4; ++j) { const int nn = (lane >> 3) + 8 * j, n = n0 + nn; const LAS float* s = scr + (8 * c) * 33 + nn;
        u32x4 o; o.x = pk2(s[0 * 33], s[1 * 33]); o.y = pk2(s[2 * 33], s[3 * 33]); o.z = pk2(s[4 * 33], s[5 * 33]); o.w = pk2(s[6 * 33], s[7 * 33]);
        const int drow = (mode == 0) ? n + (n >= p0 ? p1 : 0) : ((n >> 7) * 256 + (n & 127) + 128 * p0);
        if (n < ncols) *(u32x4*)(WT + (size_t)drow * ldt + kofs + k0 + 8 * c) = o; }
    LDS_WAIT(); asm volatile("" ::: "memory");
}
__device__ __forceinline__ void convert_weights(Frame& F, int layer) {
    LAS float* scr = (LAS float*)(F.lds + F.wave * 16384);
    const int gw = F.bid * NWAVES + F.wave, NGW = F.G * NWAVES;
    bf16_t* WIN = (bf16_t*)(F.ws + WS_WIN); bf16_t* WGLU = (bf16_t*)(F.ws + WS_WGLU); bf16_t* PCAT = (bf16_t*)(F.ws + WS_PCAT); bf16_t* WOUT = (bf16_t*)(F.ws + WS_WOUT);
    bf16_t* EGU = (bf16_t*)(F.ws + WS_EGU); bf16_t* EDN = (bf16_t*)(F.ws + WS_EDN);
    constexpr int I_WIN = 16 * 209, I_GLU = 8 * 16, I_P5 = 8 * 32, I_PS = 16 * 32, I_WO = 16 * 32, I_EG = 32 * 256, I_ED = 32 * 256;
    constexpr int NITEMS = I_WIN + 2 * I_GLU + 2 * I_P5 + I_PS + I_WO + 2 * I_EG + I_ED;
    for (int it = gw; it < NITEMS; it += NGW) {
        int r = it;
        if (r < I_WIN) { transpose_item(F.in[IN_WIN] + (size_t)layer * DM * NIN, NIN, NIN, WIN, DM, 0, 0, 3600, 240, scr, 64 * (r / 209), 32 * (r % 209), F.lane); continue; } r -= I_WIN;
        if (r < I_GLU) { transpose_item(F.in[IN_GLU1] + (size_t)layer * 512 * 512, 512, 512, WGLU, 512, 0, 1, 0, 0, scr, 64 * (r / 16), 32 * (r % 16), F.lane); continue; } r -= I_GLU;
        if (r < I_GLU) { transpose_item(F.in[IN_GLU2] + (size_t)layer * 512 * 512, 512, 512, WGLU, 512, 0, 1, 1, 0, scr, 64 * (r / 16), 32 * (r % 16), F.lane); continue; } r -= I_GLU;
        if (r < I_P5) { transpose_item(F.in[IN_PS5] + (size_t)layer * 512 * 1024, 1024, 1024, PCAT, 2048, 0, 0, 1 << 30, 0, scr, 64 * (r / 32), 32 * (r % 32), F.lane); continue; } r -= I_P5;
        if (r < I_P5) { transpose_item(F.in[IN_PATTN] + (size_t)layer * 512 * 1024, 1024, 1024, PCAT, 2048, 512, 0, 1 << 30, 0, scr, 64 * (r / 32), 32 * (r % 32), F.lane); continue; } r -= I_P5;
        if (r < I_PS) { transpose_item(F.in[IN_PSSD] + (size_t)layer * 1024 * 1024, 1024, 1024, PCAT, 2048, 1024, 0, 1 << 30, 0, scr, 64 * (r / 32), 32 * (r % 32), F.lane); continue; } r -= I_PS;
        if (r < I_WO) { transpose_item(F.in[IN_WOUT] + (size_t)layer * 1024 * 1024, 1024, 1024, WOUT, 1024, 0, 0, 1 << 30, 0, scr, 64 * (r / 32), 32 * (r % 32), F.lane); continue; } r -= I_WO;
        if (r < I_EG) { const int e = r >> 8, q = r & 255; transpose_item(F.in[IN_EG] + ((size_t)layer * 32 + e) * 1024 * 512, 512, 512, EGU + (size_t)e * 1024 * 1024, 1024, 0, 1, 0, 0, scr, 64 * (q / 16), 32 * (q % 16), F.lane); continue; } r -= I_EG;
        if (r < I_EG) { const int e = r >> 8, q = r & 255; transpose_item(F.in[IN_EU] + ((size_t)layer * 32 + e) * 1024 * 512, 512, 512, EGU + (size_t)e * 1024 * 1024, 1024, 0, 1, 1, 0, scr, 64 * (q / 16), 32 * (q % 16), F.lane); continue; } r -= I_EG;
        { const int e = r >> 8, q = r & 255; transpose_item(F.in[IN_ED] + ((size_t)layer * 32 + e) * 512 * 1024, 1024, 1024, EDN + (size_t)e * 1024 * 512, 512, 0, 0, 1 << 30, 0, scr, 64 * (q / 32), 32 * (q % 32), F.lane); }
    }
}
__device__ __forceinline__ void sincos_fast(float x, float& s, float& c) {
    const float k = rintf(x * 0.15915494309189535f);
    float r = fmaf(-k, 6.2831854820251465f, x); r = fmaf(-k, -1.7484555e-07f, r);
    s = __sinf(r); c = __cosf(r);
}
__device__ __forceinline__ void sincos_red(float x, float& s, float& c) {
    const float k = rintf(x * 0.15915494309189535f);
    float r = fmaf(-k, 6.2831854820251465f, x); r = fmaf(-k, -1.7484555e-07f, r);
    s = sinf(r); c = cosf(r);
}
__device__ __forceinline__ void s5_build(Frame& F, int layer) {
    LAS float* pw = (LAS float*)F.lds;
    LAS float* Bb = pw + 33 * 64 * 2;
    LAS float* Cc = Bb + 64 * 16 * 2;
    LAS float* Kd = Cc + 16 * 64 * 2;
    bf16_t* MG = (bf16_t*)(F.ws + WS_MG); bf16_t* EG = (bf16_t*)(F.ws + WS_EG);
    for (int w = F.bid; w < 256; w += F.G) {
        const int g = w >> 3, part = w & 7, gi = layer * 32 + g;
        __syncthreads();
        const float dt = __expf(F.in[IN_LOGDT][gi]);
        for (int i = F.tid; i < 33 * 64; i += NTHR) { const int d = i >> 6, p = i & 63; const float lr = F.in[IN_LRE][gi * 64 + p], li = F.in[IN_LIM][gi * 64 + p];
            float s, c; sincos_red((float)d * li * dt, s, c); const float mg = __expf((float)d * lr * dt); pw[2 * i] = mg * c; pw[2 * i + 1] = mg * s; }
        for (int i = F.tid; i < 64 * 16; i += NTHR) { const int p = i >> 4; const float lr = F.in[IN_LRE][gi * 64 + p], li = F.in[IN_LIM][gi * 64 + p];
            float s, c; sincos_red(li * dt, s, c); const float mg = __expf(lr * dt), are = mg * c, aim = mg * s, nr = are - 1.f, den = lr * lr + li * li;
            const float fre = (nr * lr + aim * li) / den, fim = (aim * lr - nr * li) / den;
            const float br = F.in[IN_BRE][(size_t)gi * 1024 + i], bi = F.in[IN_BIM][(size_t)gi * 1024 + i];
            Bb[2 * i] = fre * br - fim * bi; Bb[2 * i + 1] = fre * bi + fim * br; }
        for (int i = F.tid; i < 16 * 64; i += NTHR) { Cc[2 * i] = F.in[IN_CRE][(size_t)gi * 1024 + i]; Cc[2 * i + 1] = F.in[IN_CIM][(size_t)gi * 1024 + i]; }
        __syncthreads();
        { const int d = F.tid >> 4, c = F.tid & 15; float acc[16];
#pragma unroll
          for (int j = 0; j < 16; ++j) acc[j] = 0.f;
          for (int p = 0; p < 64; ++p) { const float cr = Cc[2 * (c * 64 + p)], ci = Cc[2 * (c * 64 + p) + 1], pr = pw[2 * (d * 64 + p)], pi = pw[2 * (d * 64 + p) + 1];
              const float xr = cr * pr - ci * pi, xi = cr * pi + ci * pr;
#pragma unroll
              for (int q = 0; q < 8; ++q) { const f32x4 bb = *(const LAS f32x4*)(Bb + 2 * (p * 16) + 4 * q); acc[2 * q] += xr * bb.x - xi * bb.y; acc[2 * q + 1] += xr * bb.z - xi * bb.w; } }
#pragma unroll
          for (int j = 0; j < 16; ++j) Kd[(d * 16 + c) * 16 + j] = acc[j]; }
        __syncthreads();
        for (int v = F.tid; v < 64 * 80; v += NTHR) { const int n = part * 64 + v / 80, k0 = (v % 80) * 8, t = n >> 4, c = n & 15; float o[8];
            if (k0 < 128) { const int im = k0 >= 64, p0 = k0 & 63;
#pragma unroll
                for (int j = 0; j < 8; ++j) { const int p = p0 + j; const float cr = Cc[2 * (c * 64 + p)], ci = Cc[2 * (c * 64 + p) + 1], pr = pw[2 * ((t + 1) * 64 + p)], pi = pw[2 * ((t + 1) * 64 + p) + 1];
                    o[j] = im ? -(cr * pi + ci * pr) : (cr * pr - ci * pi); }
            } else { const int s = (k0 - 128) >> 4, c0 = (k0 - 128) & 15;
#pragma unroll
                for (int j = 0; j < 8; ++j) { float x = 0.f; if (s <= t) { x = Kd[(t - s) * 256 + c * 16 + c0 + j]; if (s == t && c == c0 + j) x += F.in[IN_S5D][layer * 512 + g * 16 + c]; } o[j] = x; } }
            u32x4 q; q.x = pk2(o[0], o[1]); q.y = pk2(o[2], o[3]); q.z = pk2(o[4], o[5]); q.w = pk2(o[6], o[7]);
            *(u32x4*)(MG + ((size_t)(g * S5_N + n) * S5_K + k0)) = q; }
        for (int v = F.tid; v < 16 * 64; v += NTHR) { const int jr = part * 16 + v / 64, k0 = (v % 64) * 8, im = jr >= 64, p = jr & 63, s = k0 >> 4, c0 = k0 & 15; float o[8];
            const float pr = pw[2 * ((S5_TC - 1 - s) * 64 + p)], pi = pw[2 * ((S5_TC - 1 - s) * 64 + p) + 1];
#pragma unroll
            for (int j = 0; j < 8; ++j) { const float br = Bb[2 * (p * 16 + c0 + j)], bi = Bb[2 * (p * 16 + c0 + j) + 1]; o[j] = im ? (pr * bi + pi * br) : (pr * br - pi * bi); }
            u32x4 q; q.x = pk2(o[0], o[1]); q.y = pk2(o[2], o[3]); q.z = pk2(o[4], o[5]); q.w = pk2(o[6], o[7]);
            *(u32x4*)(EG + ((size_t)(g * 256 + jr) * 512 + k0)) = q; }
    }
    __syncthreads();
}
__device__ __forceinline__ void rms_row_to_bf16(const float* xrow, const float* gain, bf16_t* orow, int lane) {
    const f32x4* xr = (const f32x4*)xrow + lane; const f32x4* gr = (const f32x4*)gain + lane;
    f32x4 v[4]; float s = 0.f;
#pragma unroll
    for (int j = 0; j < 4; ++j) { v[j] = xr[64 * j]; s += (v[j].x * v[j].x + v[j].y * v[j].y) + (v[j].z * v[j].z + v[j].w * v[j].w); }
    const float rstd = __builtin_amdgcn_rsqf(wave_sum(s) * (1.f / DM) + NORM_EPS);
    unsigned long long* o8 = (unsigned long long*)orow + lane;
#pragma unroll
    for (int j = 0; j < 4; ++j) { const f32x4 gv = gr[64 * j]; o8[64 * j] = (unsigned long long)pk2(v[j].x * rstd * gv.x, v[j].y * rstd * gv.y) | ((unsigned long long)pk2(v[j].z * rstd * gv.z, v[j].w * rstd * gv.w) << 32); }
}
__device__ __forceinline__ void rmsnorm_rows(Frame& F, const float* x, const float* gain, bf16_t* o) {
    const int gw = F.bid * NWAVES + F.wave, NGW = F.G * NWAVES;
    for (int m = gw; m < T; m += NGW) rms_row_to_bf16(x + (size_t)m * DM, gain, o + (size_t)m * DM, F.lane);
}

__device__ __forceinline__ void s5_scan(Frame& F, int layer) {
    const float* HL = (const float*)(F.ws + WS_HLOC); bf16_t* UH = (bf16_t*)(F.ws + WS_UH);
    for (int i = (F.G - 1 - F.bid) * NTHR + F.tid; i < BATCH * 32 * 64; i += F.G * NTHR) {
        const int p = i & 63, g = (i >> 6) & 31, b = i >> 11, gi = layer * 32 + g;
        const float dt = __expf(F.in[IN_LOGDT][gi]), lr = F.in[IN_LRE][gi * 64 + p], li = F.in[IN_LIM][gi * 64 + p];
        float s, c; sincos_red((float)S5_TC * li * dt, s, c); const float mg = __expf((float)S5_TC * lr * dt), ar = mg * c, ai = mg * s;
        float hr = 0.f, hi = 0.f;
        const int nch = SEQ / S5_TC;
        for (int c0 = 0; c0 < nch; c0 += 32) { float lr_[32], li_[32];
#pragma unroll
            for (int k = 0; k < 32; ++k) { const size_t r = (size_t)g * S5_ROWS + b * nch + c0 + k; lr_[k] = HL[r * 128 + p]; li_[k] = HL[r * 128 + 64 + p]; }
#pragma unroll
            for (int k = 0; k < 32; ++k) { const size_t r = (size_t)g * S5_ROWS + b * nch + c0 + k;
                UH[r * S5_K + p] = (bf16_t)f2bf(hr); UH[r * S5_K + 64 + p] = (bf16_t)f2bf(hi);
                const float nr = ar * hr - ai * hi + lr_[k], ni = ar * hi + ai * hr + li_[k]; hr = nr; hi = ni; } }
    }
}

__device__ __forceinline__ void ssd_stage_bc(Frame& F, int layer, int b, int ch, int grp, LAS float* Bs, LAS float* Cs, LAS float* dts, LAS float* das) {
    const bf16_t* P = (const bf16_t*)(F.ws + WS_P); const float* DT = (const float*)(F.ws + WS_DT);
    const float* cw = F.in[IN_CONVW] + layer * 4 * 1280; const float* cb = F.in[IN_CONVB] + layer * 1280;
    const int l0 = ch * 128; const size_t row0 = (size_t)b * SEQ + l0;
    for (int i = F.tid; i < 2 * 128 * 64; i += NTHR) { const int isC = i >> 13, t = (i >> 6) & 127, n = i & 63;
        const int col = (isC ? C_C : C_B) + grp * 64 + n, cc = 1024 + isC * 128 + grp * 64 + n; float a = cb[cc];
#pragma unroll
        for (int j = 0; j < 4; ++j) { const int l = l0 + t - 3 + j; if (l >= 0) a += cw[j * 1280 + cc] * bf2f(P[(row0 + t - 3 + j) * NINP + col]); }
        (isC ? Cs : Bs)[t * 64 + n] = siluf_(a); }
    for (int i = F.tid; i < 128 * 8; i += NTHR) { const int t = i >> 3, hh = i & 7, h = grp * 8 + hh;
        const float dt = softplusf_(DT[(row0 + t) * 16 + h] + F.in[IN_DTB][layer * 16 + h]); dts[i] = dt; das[i] = dt * (-__expf(F.in[IN_ALOG][layer * 16 + h])); }
}
template <bool OUT>
__device__ __forceinline__ void ssd_units(Frame& F, int layer) {
    LAS float* Bs = (LAS float*)F.lds; LAS float* Cs = Bs + 128 * 64; LAS float* dts = Cs + 128 * 64; LAS float* das = dts + 128 * 8; LAS float* ssq = das + 128 * 8;
    const bf16_t* P = (const bf16_t*)(F.ws + WS_P); float* SST = (float*)(F.ws + WS_SST); float* ASUM = (float*)(F.ws + WS_ASUM); bf16_t* YC = (bf16_t*)(F.ws + WS_YCAT);
    const float* cw = F.in[IN_CONVW] + layer * 4 * 1280; const float* cb = F.in[IN_CONVB] + layer * 1280;
    for (int u = F.bid; u < BATCH * SSD_NCH * 2; u += F.G) {
        const int grp = u & 1, ch = (u >> 1) & 31, b = u >> 6;
        __syncthreads();
        ssd_stage_bc(F, layer, b, ch, grp, Bs, Cs, dts, das);
        __syncthreads();
        const int hh = F.wave, h = grp * 8 + hh, p = F.lane, cx = h * 64 + p;
        const float w0 = cw[cx], w1 = cw[1280 + cx], w2 = cw[2560 + cx], w3 = cw[3840 + cx], bias = cb[cx], dsk = F.in[IN_SSDD][layer * 16 + h];
        const int l0 = ch * 128; const size_t row0 = (size_t)b * SEQ + l0;
        const bf16_t* xp = P + row0 * NINP + C_XS + cx;
        float x0 = 0.f, x1 = 0.f, x2 = 0.f;
        if (l0 > 0) { x0 = bf2f(xp[-3 * (ptrdiff_t)NINP]); x1 = bf2f(xp[-2 * (ptrdiff_t)NINP]); x2 = bf2f(xp[-1 * (ptrdiff_t)NINP]); }
        float st[64];
        float* sp = SST + ((((size_t)b * SSD_NCH + ch) * 16 + h) * 64 + p) * 64;
        if (OUT) {
#pragma unroll
            for (int n = 0; n < 64; n += 4) { const f32x4 v = *(const f32x4*)(sp + n); st[n] = v.x; st[n + 1] = v.y; st[n + 2] = v.z; st[n + 3] = v.w; }
        } else {
#pragma unroll
            for (int n = 0; n < 64; ++n) st[n] = 0.f;
        }
        float asum = 0.f;
#pragma unroll 4
        for (int t = 0; t < 128; ++t) {
            const float x3 = bf2f(xp[(size_t)t * NINP]);
            const float xs = siluf_(bias + w0 * x0 + w1 * x1 + w2 * x2 + w3 * x3);
            x0 = x1; x1 = x2; x2 = x3;
            const float dt = dts[t * 8 + hh], a = das[t * 8 + hh], da = __expf(a), xdt = xs * dt;
            asum += a;
            float y = 0.f;
#pragma unroll
            for (int n = 0; n < 64; n += 4) { const f32x4 bv = *(const LAS f32x4*)(Bs + t * 64 + n);
                st[n] = da * st[n] + bv.x * xdt; st[n + 1] = da * st[n + 1] + bv.y * xdt; st[n + 2] = da * st[n + 2] + bv.z * xdt; st[n + 3] = da * st[n + 3] + bv.w * xdt;
                if (OUT) { const f32x4 cv = *(const LAS f32x4*)(Cs + t * 64 + n); y += (cv.x * st[n] + cv.y * st[n + 1]) + (cv.z * st[n + 2] + cv.w * st[n + 3]); } }
            if (OUT) {
                const float z = bf2f(P[(row0 + t) * NINP + C_Z + cx]);
                const float yz = (y + dsk * xs) * siluf_(z);
                const float q = wave_sum(yz * yz);
                if (p == 0) ssq[t * 8 + hh] = q;
                YC[(row0 + t) * 2048 + 1024 + cx] = (bf16_t)f2bf(yz);
            }
        }
        if (!OUT) {
#pragma unroll
            for (int n = 0; n < 64; n += 4) *(f32x4*)(sp + n) = (f32x4){st[n], st[n + 1], st[n + 2], st[n + 3]};
            if (p == 0) ASUM[((size_t)b * SSD_NCH + ch) * 16 + h] = asum;
        } else {
            __syncthreads();
            const float ng = F.in[IN_SSDG][layer * 1024 + cx];
            for (int t = 0; t < 128; ++t) { float q = 0.f;
#pragma unroll
                for (int j = 0; j < 8; ++j) q += ssq[t * 8 + j];
                const float rs = __builtin_amdgcn_rsqf(q * (1.f / 512.f) + NORM_EPS);
                bf16_t* yp = YC + (row0 + t) * 2048 + 1024 + cx; *yp = (bf16_t)f2bf(bf2f(*yp) * rs * ng); }
        }
    }
}
__device__ __forceinline__ void ssd_scan(Frame& F) {
    float* SST = (float*)(F.ws + WS_SST); const float* ASUM = (const float*)(F.ws + WS_ASUM);
    for (int i = F.bid * NTHR + F.tid; i < BATCH * 16 * 1024; i += F.G * NTHR) {
        const int pn = (i & 1023) * 4, h = (i >> 10) & 15, b = i >> 14; f32x4 s = {0.f, 0.f, 0.f, 0.f};
        f32x4 loc[SSD_NCH]; float dec[SSD_NCH];
#pragma unroll
        for (int ch = 0; ch < SSD_NCH; ++ch) { loc[ch] = *(const f32x4*)(SST + (((size_t)b * SSD_NCH + ch) * 16 + h) * 4096 + pn); dec[ch] = ASUM[((size_t)b * SSD_NCH + ch) * 16 + h]; }
#pragma unroll
        for (int ch = 0; ch < SSD_NCH; ++ch) { *(f32x4*)(SST + (((size_t)b * SSD_NCH + ch) * 16 + h) * 4096 + pn) = s; s = s * __expf(dec[ch]) + loc[ch]; }
    }
}

__device__ __forceinline__ void attn_units(Frame& F, int layer) {
    LAS float* Ks = (LAS float*)F.lds; LAS float* Vs = Ks + 256 * 64;
    const bf16_t* P = (const bf16_t*)(F.ws + WS_P); bf16_t* YC = (bf16_t*)(F.ws + WS_YCAT);
    const float* qg = F.in[IN_QG] + layer * 64; const float* kg = F.in[IN_KG] + layer * 64;
    for (int u = F.bid; u < BATCH * 32 * 2; u += F.G) {
        const int kvh = u & 1, qb = (u >> 1) & 31, b = u >> 6, q0 = qb * 128;
        int lane = F.lane; asm volatile("" : "+v"(lane));
        __syncthreads();
        for (int jr = F.wave; jr < 256; jr += NWAVES) { const int l = q0 - 128 + jr; float kv = 0.f, vv = 0.f;
            if (l >= 0) { const size_t row = (size_t)b * SEQ + l; const float x = bf2f(P[row * NINP + C_K + kvh * 64 + lane]); vv = bf2f(P[row * NINP + C_V + kvh * 64 + lane]);
                const float rs = __builtin_amdgcn_rsqf(wave_sum(x * x) * (1.f / 64.f) + NORM_EPS); const float xn = x * rs * kg[lane];
                const float other = __shfl_xor(xn, 32); const int i = lane & 31; const float inv = exp2f(-(float)i * (13.287712379549449f / 32.f));
                float s, c; sincos_fast((float)l * inv, s, c);
                kv = (lane < 32) ? (xn * c - other * s) : (xn * c + other * s); }
            Ks[jr * 64 + lane] = kv; Vs[jr * 64 + lane] = vv; }
        __syncthreads();
        const int hh = F.wave >> 1, head = kvh * 4 + hh, qi = q0 + (F.wave & 1) * 64 + lane; const size_t row = (size_t)b * SEQ + qi;
        float q[64];
        { const u32x4* qp = (const u32x4*)(P + row * NINP + C_Q + head * 64); float ss = 0.f;
#pragma unroll
          for (int j = 0; j < 8; ++j) { const u32x4 w = qp[j];
#pragma unroll
              for (int e = 0; e < 4; ++e) { q[8 * j + 2 * e] = bflo(w[e]); q[8 * j + 2 * e + 1] = bfhi(w[e]); } }
#pragma unroll
          for (int d = 0; d < 64; ++d) ss += q[d] * q[d];
          const float rs = __builtin_amdgcn_rsqf(ss * (1.f / 64.f) + NORM_EPS);
#pragma unroll
          for (int d = 0; d < 64; ++d) q[d] = q[d] * rs * qg[d];
#pragma unroll
          for (int i = 0; i < 32; ++i) { const float inv = exp2f(-(float)i * (13.287712379549449f / 32.f)); float s, c; sincos_fast((float)qi * inv, s, c);
              const float a = q[i], bq = q[i + 32]; q[i] = (a * c - bq * s) * 0.125f; q[i + 32] = (bq * c + a * s) * 0.125f; } }
        float o[64];
#pragma unroll
        for (int d = 0; d < 64; ++d) o[d] = 0.f;
        float mx = F.in[IN_SINK][layer * 8 + head], l = 1.f;
        const int qa = q0 + (F.wave & 1) * 64;
        int jlo = qa - 127 - (q0 - 128); if (q0 == 0 && jlo < 128) jlo = 128; const int jhi = qa + 63 - (q0 - 128);
        for (int jr = jlo; jr <= jhi; ++jr) { const int j = q0 - 128 + jr; const bool ok = (j <= qi) && (qi - j < 128);
            float s = 0.f;
#pragma unroll
            for (int d = 0; d < 64; d += 4) { const f32x4 kv = *(const LAS f32x4*)(Ks + jr * 64 + d); s += (q[d] * kv.x + q[d + 1] * kv.y) + (q[d + 2] * kv.z + q[d + 3] * kv.w); if ((d & 12) == 12) __builtin_amdgcn_sched_barrier(0); }
            if (ok) { const float mn = fmaxf(mx, s), al = __expf(mx - mn), pe = __expf(s - mn); l = l * al + pe; mx = mn;
#pragma unroll
                for (int d = 0; d < 64; d += 4) { const f32x4 vv = *(const LAS f32x4*)(Vs + jr * 64 + d); o[d] = o[d] * al + pe * vv.x; o[d + 1] = o[d + 1] * al + pe * vv.y; o[d + 2] = o[d + 2] * al + pe * vv.z; o[d + 3] = o[d + 3] * al + pe * vv.w; if ((d & 12) == 12) __builtin_amdgcn_sched_barrier(0); } } }
        const float il = 1.f / l; u32x4* op = (u32x4*)(YC + row * 2048 + 512 + head * 64);
#pragma unroll
        for (int j = 0; j < 8; ++j) { u32x4 w; w.x = pk2(o[8 * j] * il, o[8 * j + 1] * il); w.y = pk2(o[8 * j + 2] * il, o[8 * j + 3] * il); w.z = pk2(o[8 * j + 4] * il, o[8 * j + 5] * il); w.w = pk2(o[8 * j + 6] * il, o[8 * j + 7] * il); op[j] = w; }
    }
}

typedef short bf16x8_t __attribute__((ext_vector_type(8)));
__device__ __forceinline__ void split_hi_lo(const f32x4 a, const f32x4 b, bf16x8& hi, bf16x8& lo) {
    u32x4 h; h.x = cvtpk(a.x, a.y); h.y = cvtpk(a.z, a.w); h.z = cvtpk(b.x, b.y); h.w = cvtpk(b.z, b.w);
    u32x4 l; l.x = cvtpk(a.x - bflo(h.x), a.y - bfhi(h.x)); l.y = cvtpk(a.z - bflo(h.y), a.w - bfhi(h.y)); l.z = cvtpk(b.x - bflo(h.z), b.y - bfhi(h.z)); l.w = cvtpk(b.z - bflo(h.w), b.w - bfhi(h.w));
    hi = __builtin_bit_cast(bf16x8, h); lo = __builtin_bit_cast(bf16x8, l);
}
__device__ __forceinline__ void router_phase(Frame& F, int layer) {
    constexpr int WROW = 2064;
    LAS unsigned char* Whi = F.lds; LAS unsigned char* Wlo = F.lds + 36 * WROW;
    LAS float* part = (LAS float*)F.lds;
    volatile LAS unsigned* lcnt = (volatile LAS unsigned*)(F.lds + 148 * 1024);
    const float* wrg = F.in[IN_WRG] + (size_t)layer * 1024 * 4; const float* wre = F.in[IN_WRE] + (size_t)layer * 1024 * 32; const float* gain = F.in[IN_NORM2] + layer * 1024;
    const float* X = F.out; bf16_t* H2 = (bf16_t*)(F.ws + WS_XN);
    int* EID = (int*)(F.ws + WS_MOE); float* EW = (float*)(F.ws + WS_MOE + 128 * 1024); int* SLOT = (int*)(F.ws + WS_MOE + 256 * 1024); float* RS = (float*)(F.ws + WS_MOE + 640 * 1024);
    __syncthreads();
    for (int k = F.tid; k < 1024; k += NTHR) { const float g = gain[k]; const f32x4 wg = *(const f32x4*)(wrg + k * 4);
        float w[36]; w[0] = wg.x; w[1] = wg.y; w[2] = wg.z; w[3] = wg.w;
#pragma unroll
        for (int q = 0; q < 8; ++q) { const f32x4 v = *(const f32x4*)(wre + k * 32 + 4 * q); w[4 + 4 * q] = v.x; w[5 + 4 * q] = v.y; w[6 + 4 * q] = v.z; w[7 + 4 * q] = v.w; }
#pragma unroll
        for (int e = 0; e < 36; ++e) { const float x = w[e] * g; const unsigned h = f2bf(x); const unsigned l = f2bf(x - bf2f(h));
            *(LAS unsigned short*)(Whi + e * WROW + k * 2) = (unsigned short)h; *(LAS unsigned short*)(Wlo + e * WROW + k * 2) = (unsigned short)l; } }
    if (F.tid < 32) lcnt[F.tid] = 0u;
    __syncthreads();
    const int TPB = T / F.G;
    int lane = F.lane; asm volatile("" : "+v"(lane));
    const int mt = F.wave & 3, kh = F.wave >> 2, row = lane & 15, kg = lane >> 4;
    const int m = F.bid * TPB + 16 * mt + row;
    f32x4 acc[3] = {{0.f, 0.f, 0.f, 0.f}, {0.f, 0.f, 0.f, 0.f}, {0.f, 0.f, 0.f, 0.f}}; float ss = 0.f;
    int er[3]; er[0] = row; er[1] = 16 + row; er[2] = (32 + row < 36) ? 32 + row : 35;
#pragma unroll 1
    for (int kb = 0; kb < 2; ++kb) {
        f32x4 xa[8][2];
#pragma unroll
        for (int ks = 0; ks < 8; ++ks) { const float* xp = X + (size_t)m * DM + 512 * kh + 256 * kb + 32 * ks + 8 * kg; xa[ks][0] = *(const f32x4*)xp; xa[ks][1] = *(const f32x4*)(xp + 4); }
#pragma unroll
        for (int ks = 0; ks < 8; ++ks) { const int k0 = 512 * kh + 256 * kb + 32 * ks + 8 * kg;
            const f32x4 a = xa[ks][0], b = xa[ks][1];
            ss += (a.x * a.x + a.y * a.y) + (a.z * a.z + a.w * a.w) + (b.x * b.x + b.y * b.y) + (b.z * b.z + b.w * b.w);
            bf16x8 ah, al; split_hi_lo(a, b, ah, al);
#pragma unroll
            for (int nt = 0; nt < 3; ++nt) { const bf16x8 bh = *(const LAS bf16x8*)(Whi + er[nt] * WROW + k0 * 2), bl = *(const LAS bf16x8*)(Wlo + er[nt] * WROW + k0 * 2);
                acc[nt] = __builtin_amdgcn_mfma_f32_16x16x32_bf16(ah, bh, acc[nt], 0, 0, 0);
                acc[nt] = __builtin_amdgcn_mfma_f32_16x16x32_bf16(ah, bl, acc[nt], 0, 0, 0);
                acc[nt] = __builtin_amdgcn_mfma_f32_16x16x32_bf16(al, bh, acc[nt], 0, 0, 0); } }
    }
    ss += __shfl_xor(ss, 16); ss += __shfl_xor(ss, 32);
    __syncthreads();
    LAS float* ssq = part + 4 * 3 * 64 * 4; LAS float* lg = ssq + 128; volatile LAS int* elist = (volatile LAS int*)(lg + 64 * 40);
    if (kh == 1) {
#pragma unroll
        for (int nt = 0; nt < 3; ++nt) *(LAS f32x4*)(part + ((mt * 3 + nt) * 64 + lane) * 4) = acc[nt];
        if (kg == 0) ssq[16 * mt + row] = ss; }
    __syncthreads();
    if (kh == 0) {
        const float rstd_row = __builtin_amdgcn_rsqf((ss + ssq[16 * mt + row]) * (1.f / DM) + NORM_EPS);
        if (kg == 0) { ssq[64 + 16 * mt + row] = rstd_row; RS[m] = rstd_row; }
#pragma unroll
        for (int nt = 0; nt < 3; ++nt) { const f32x4 o = *(const LAS f32x4*)(part + ((mt * 3 + nt) * 64 + lane) * 4); acc[nt] += o; }
    }
    __syncthreads();
    { const float rs = ssq[64 + 16 * mt + row];
#pragma unroll 4
      for (int ks = 0; ks < 16; ++ks) { const int k0 = 512 * kh + 32 * ks + 8 * kg; const float* xp = X + (size_t)m * DM + k0; const f32x4 a = *(const f32x4*)xp, b = *(const f32x4*)(xp + 4);
          const f32x4 g0 = *(const f32x4*)(gain + k0), g1 = *(const f32x4*)(gain + k0 + 4);
          u32x4 hw; hw.x = cvtpk(a.x * rs * g0.x, a.y * rs * g0.y); hw.y = cvtpk(a.z * rs * g0.z, a.w * rs * g0.w); hw.z = cvtpk(b.x * rs * g1.x, b.y * rs * g1.y); hw.w = cvtpk(b.z * rs * g1.z, b.w * rs * g1.w);
          *(u32x4*)(H2 + (size_t)m * DM + k0) = hw; } }
    if (kh == 0) {
#pragma unroll
        for (int nt = 0; nt < 3; ++nt)
#pragma unroll
            for (int rg = 0; rg < 4; ++rg) { const int e = row + 16 * nt, tk = 16 * mt + 4 * kg + rg; if (e < 36) lg[tk * 40 + e] = acc[nt][rg] * ssq[64 + tk]; }
    }
    __syncthreads();
    if (F.tid < TPB) { const int tk = F.tid, mm = F.bid * TPB + tk; const LAS float* L = lg + tk * 40;
        float gl[4];
#pragma unroll
        for (int k = 0; k < 4; ++k) gl[k] = L[k] + F.in[IN_BRG][layer * 4 + k];
        int gs = 0; float gbest = gl[0];
#pragma unroll
        for (int k = 1; k < 4; ++k) if (gl[k] > gbest) { gbest = gl[k]; gs = k; }
        float den = 0.f;
#pragma unroll
        for (int k = 0; k < 4; ++k) den += __expf(gl[k] - gbest);
        const float pgrp = 1.f / den;
        float el[8];
#pragma unroll
        for (int k = 0; k < 8; ++k) el[k] = L[4 + gs * 8 + k] + F.in[IN_BRE_][layer * 32 + gs * 8 + k];
        int i0 = 0; float v0 = el[0];
#pragma unroll
        for (int k = 1; k < 8; ++k) if (el[k] > v0) { v0 = el[k]; i0 = k; }
        int i1 = -1; float v1 = -3.0e38f;
#pragma unroll
        for (int k = 0; k < 8; ++k) if (k != i0 && el[k] > v1) { v1 = el[k]; i1 = k; }
        const float e1 = __expf(v1 - v0), w0 = pgrp / (1.f + e1), w1 = pgrp * e1 / (1.f + e1);
        const int ea = gs * 8 + i0, eb = gs * 8 + i1;
        EID[2 * mm] = ea; EID[2 * mm + 1] = eb; EW[2 * mm] = w0; EW[2 * mm + 1] = w1;
        elist[2 * tk] = ea; elist[2 * tk + 1] = eb;
    }
    __syncthreads();
    if (F.tid < 32) { const int e = F.tid; int c = 0;
        for (int i = 0; i < 2 * TPB; ++i) { if (elist[i] == e) { SLOT[2 * (F.bid * TPB) + i] = c; ++c; } }
        ((unsigned*)(F.ws + WS_MOE + 512 * 1024))[(size_t)F.bid * 32 + e] = (unsigned)c; }
    __syncthreads();
}
__device__ __forceinline__ int moe_tables(Frame& F, int layer, volatile LAS int* offs, volatile LAS int* tile_e) {
    volatile LAS int* psum = offs + 256;
    const unsigned* CNTB = (const unsigned*)(F.ws + WS_MOE + 512 * 1024);
    __syncthreads();
    { const int e = F.tid & 31, part = F.tid >> 5; int tot = 0, pre = 0; const int per = (F.G + 15) / 16;
      for (int bb = part * per; bb < (part + 1) * per && bb < F.G; ++bb) { const int c = (int)CNTB[(size_t)bb * 32 + e]; tot += c; pre += (bb < F.bid) ? c : 0; }
      psum[part * 32 + e] = tot; psum[512 + part * 32 + e] = pre; }
    __syncthreads();
    if (F.tid < 64) {
        int c = 0, pre = 0;
        if (F.tid < 32) for (int part = 0; part < 16; ++part) { c += psum[part * 32 + F.tid]; pre += psum[512 + part * 32 + F.tid]; }
        const int tl = (c + 255) >> 8; int incl = tl;
#pragma unroll
        for (int o = 1; o < 32; o <<= 1) { const int v = __shfl_up(incl, o); if (F.tid >= o) incl += v; }
        const int excl = incl - tl;
        if (F.tid < 32) { offs[F.tid] = excl * 256 + pre; for (int k = 0; k < tl; ++k) tile_e[excl + k] = F.tid; }
        if (F.tid == 31) offs[32] = incl;
    }
    __syncthreads();
    return __builtin_amdgcn_readfirstlane(offs[32]);
}
__device__ __forceinline__ void gather_phase(Frame& F, int layer, volatile LAS int* offs) {
    const bf16_t* H2 = (const bf16_t*)(F.ws + WS_XN); bf16_t* XG = (bf16_t*)(F.ws + WS_XG);
    const int* EID = (const int*)(F.ws + WS_MOE); const int* SLOT = (const int*)(F.ws + WS_MOE + 256 * 1024); int* POS = (int*)(F.ws + WS_MOE + 384 * 1024);
    const float* RS = (const float*)(F.ws + WS_MOE + 640 * 1024); float* RSG = (float*)(F.ws + WS_MOE + 704 * 1024);
    const int TPB = T / F.G;
    for (int m = F.bid * TPB + F.wave; m < (F.bid + 1) * TPB; m += NWAVES) {
        const u32x4* src = (const u32x4*)(H2 + (size_t)m * DM) + F.lane; const u32x4 a = src[0], b = src[64];
#pragma unroll
        for (int k = 0; k < 2; ++k) { const int pos = offs[EID[2 * m + k]] + SLOT[2 * m + k]; u32x4* dst = (u32x4*)(XG + (size_t)pos * DM) + F.lane; dst[0] = a; dst[64] = b; if (F.lane == 0) POS[2 * m + k] = pos; }
    }
}
__device__ __forceinline__ void combine_phase(Frame& F, const float* gain_next, bool dry = false) {
    const bf16_t* Y = (const bf16_t*)(F.ws + WS_YEXP); const float* EW = (const float*)(F.ws + WS_MOE + 128 * 1024); const int* POS = (const int*)(F.ws + WS_MOE + 384 * 1024);
    bf16_t* XN = (bf16_t*)(F.ws + WS_XN);
    const int gw = F.bid * NWAVES + F.wave, NGW = F.G * NWAVES;
    for (int m = gw; m < T; m += NGW) {
        const float w0 = EW[2 * m], w1 = EW[2 * m + 1]; const int p0 = POS[2 * m], p1 = POS[2 * m + 1];
        f32x4* xr = (f32x4*)(F.out + (size_t)m * DM) + F.lane;
        const u32x2* y0 = (const u32x2*)(Y + (size_t)p0 * DM) + F.lane; const u32x2* y1 = (const u32x2*)(Y + (size_t)p1 * DM) + F.lane;
        f32x4 v[4]; float s = 0.f;
#pragma unroll
        for (int j = 0; j < 4; ++j) { v[j] = xr[64 * j]; const u32x2 a = y0[64 * j], b = y1[64 * j];
            v[j].x += w0 * bflo(a.x) + w1 * bflo(b.x); v[j].y += w0 * bfhi(a.x) + w1 * bfhi(b.x); v[j].z += w0 * bflo(a.y) + w1 * bflo(b.y); v[j].w += w0 * bfhi(a.y) + w1 * bfhi(b.y);
            if (!dry) xr[64 * j] = v[j]; s += (v[j].x * v[j].x + v[j].y * v[j].y) + (v[j].z * v[j].z + v[j].w * v[j].w); }
        if (gain_next) { const float rstd = __builtin_amdgcn_rsqf(wave_sum(s) * (1.f / DM) + NORM_EPS); const f32x4* gr = (const f32x4*)gain_next + F.lane;
            unsigned long long* o8 = (unsigned long long*)(XN + (size_t)m * DM) + F.lane;
#pragma unroll
            for (int j = 0; j < 4; ++j) { const f32x4 gv = gr[64 * j]; o8[64 * j] = (unsigned long long)pk2(v[j].x * rstd * gv.x, v[j].y * rstd * gv.y) | ((unsigned long long)pk2(v[j].z * rstd * gv.z, v[j].w * rstd * gv.w) << 32); } }
    }
}

__device__ __forceinline__ int crow32(int reg, int hh) { return (reg & 3) + 8 * (reg >> 2) + 4 * hh; }
__device__ __forceinline__ float wave_incl_scan(float v, int lane) {
#pragma unroll
    for (int o = 1; o < 64; o <<= 1) { const float t = __shfl_up(v, o); if (lane >= o) v += t; }
    return v;
}
__device__ __forceinline__ void conv_frag(const LAS unsigned char* raw, int chan, int ks, int hh, float w0, float w1, float w2, float w3, float bias, float (&out)[8]) {
#pragma unroll
    for (int run = 0; run < 2; ++run) { const int lb = 16 * ks + 8 * run + 4 * hh; float x[7];
#pragma unroll
        for (int i = 0; i < 7; ++i) x[i] = bf2f(*(const LAS unsigned short*)(raw + (lb + i) * 128 + chan * 2));
#pragma unroll
        for (int j = 0; j < 4; ++j) out[4 * run + j] = siluf_(bias + w0 * x[j] + w1 * x[j + 1] + w2 * x[j + 2] + w3 * x[j + 3]); }
}
constexpr int RAWT = 131 * 128;
__device__ __forceinline__ void stage_raw(const bf16_t* P, size_t row0, int l0, int col, LAS unsigned char* dst, int idx0, int stride) {
    for (int idx = idx0; idx < 131 * 8; idx += stride) { const int r = idx >> 3, c8 = idx & 7; u32x4 v = (u32x4){0u, 0u, 0u, 0u};
        if (l0 - 3 + r >= 0) v = *(const u32x4*)(P + (row0 + r - 3) * NINP + col + c8 * 8);
        *(LAS u32x4*)(dst + r * 128 + c8 * 16) = v; }
}
__device__ __forceinline__ void ssdA_mfma(Frame& F, int layer) {
    const bf16_t* P = (const bf16_t*)(F.ws + WS_P); const float* DT = (const float*)(F.ws + WS_DT); float* SST = (float*)(F.ws + WS_SST); float* ASUM = (float*)(F.ws + WS_ASUM);
    const float* cw = F.in[IN_CONVW] + layer * 4 * 1280; const float* cb = F.in[IN_CONVB] + layer * 1280;
    LAS unsigned char* rawX = F.lds + F.wave * RAWT; LAS unsigned char* rawB = F.lds + 8 * RAWT; LAS float* ftab = (LAS float*)(F.lds + 9 * RAWT) + F.wave * 128;
    for (int u = F.bid; u < BATCH * SSD_NCH * 2; u += F.G) {
        const int grp = u & 1, ch = (u >> 1) & 31, b = u >> 6, h = grp * 8 + F.wave, l0 = ch * 128; const size_t row0 = (size_t)b * SEQ + l0;
        int lane = F.lane; asm volatile("" : "+v"(lane));
        const int r = lane & 31, hh = lane >> 5;
        __syncthreads();
        stage_raw(P, row0, l0, C_XS + h * 64, rawX, lane, 64);
        stage_raw(P, row0, l0, C_B + grp * 64, rawB, F.tid, NTHR);
        { const float dtb = F.in[IN_DTB][layer * 16 + h], A = -__expf(F.in[IN_ALOG][layer * 16 + h]);
          const float dt0 = softplusf_(DT[(row0 + lane) * 16 + h] + dtb), dt1 = softplusf_(DT[(row0 + 64 + lane) * 16 + h] + dtb);
          const float s0 = wave_incl_scan(dt0 * A, lane); const float tot0 = __builtin_bit_cast(float, __builtin_amdgcn_readlane(__builtin_bit_cast(int, s0), 63));
          const float s1 = wave_incl_scan(dt1 * A, lane) + tot0; const float tot = __builtin_bit_cast(float, __builtin_amdgcn_readlane(__builtin_bit_cast(int, s1), 63));
          ftab[lane] = dt0 * __expf(tot - s0); ftab[64 + lane] = dt1 * __expf(tot - s1);
          if (lane == 0) ASUM[((size_t)b * SSD_NCH + ch) * 16 + h] = tot; }
        __syncthreads();
        bf16x8 bfr[2];
#pragma unroll
        for (int q = 0; q < 2; ++q) { const int idx = F.wave * 2 + q, nt = idx >> 3, ks = idx & 7, cc = 1024 + grp * 64 + 32 * nt + r; float v[8];
            conv_frag(rawB, 32 * nt + r, ks, hh, cw[cc], cw[1280 + cc], cw[2560 + cc], cw[3840 + cc], cb[cc], v); bfr[q] = pack8v(v); }
        bf16x8 xw[2][8];
#pragma unroll
        for (int pt = 0; pt < 2; ++pt) { const int cx = h * 64 + 32 * pt + r; const float w0 = cw[cx], w1 = cw[1280 + cx], w2 = cw[2560 + cx], w3 = cw[3840 + cx], bias = cb[cx];
#pragma unroll
            for (int ks = 0; ks < 8; ++ks) { float v[8]; conv_frag(rawX, 32 * pt + r, ks, hh, w0, w1, w2, w3, bias, v);
                const f32x4 fa = *(const LAS f32x4*)(ftab + 16 * ks + 4 * hh), fb = *(const LAS f32x4*)(ftab + 16 * ks + 8 + 4 * hh);
                v[0] *= fa.x; v[1] *= fa.y; v[2] *= fa.z; v[3] *= fa.w; v[4] *= fb.x; v[5] *= fb.y; v[6] *= fb.z; v[7] *= fb.w; { u32x4 pq = __builtin_bit_cast(u32x4, pack8v(v)); asm volatile("" : "+v"(pq) :: "memory"); xw[pt][ks] = __builtin_bit_cast(bf16x8, pq); } } }
        __syncthreads();
#pragma unroll
        for (int q = 0; q < 2; ++q) *(LAS bf16x8*)(rawB + (F.wave * 2 + q) * 1024 + lane * 16) = bfr[q];
        __syncthreads();
        f32x16 acc[2][2];
#pragma unroll
        for (int pt = 0; pt < 2; ++pt)
#pragma unroll
            for (int nt = 0; nt < 2; ++nt)
#pragma unroll
                for (int i = 0; i < 16; ++i) acc[pt][nt][i] = 0.f;
#pragma unroll
        for (int ks = 0; ks < 8; ++ks)
#pragma unroll
            for (int nt = 0; nt < 2; ++nt) { const bf16x8 bq = *(const LAS bf16x8*)(rawB + (nt * 8 + ks) * 1024 + lane * 16);
#pragma unroll
                for (int pt = 0; pt < 2; ++pt) acc[pt][nt] = MFMA32(xw[pt][ks], bq, acc[pt][nt]); }
        float* sp = SST + (((size_t)b * SSD_NCH + ch) * 16 + h) * 4096;
#pragma unroll
        for (int pt = 0; pt < 2; ++pt)
#pragma unroll
            for (int nt = 0; nt < 2; ++nt)
#pragma unroll
                for (int i = 0; i < 16; ++i) sp[(32 * pt + crow32(i, hh)) * 64 + 32 * nt + r] = acc[pt][nt][i];
    }
}
__device__ __forceinline__ void ssdC_mfma(Frame& F, int layer) {
    const bf16_t* P = (const bf16_t*)(F.ws + WS_P); const float* DT = (const float*)(F.ws + WS_DT); const float* SST = (const float*)(F.ws + WS_SST); bf16_t* YC = (bf16_t*)(F.ws + WS_YCAT);
    const float* cw = F.in[IN_CONVW] + layer * 4 * 1280; const float* cb = F.in[IN_CONVB] + layer * 1280;
    LAS unsigned char* rawX = F.lds + F.wave * RAWT;
    LAS unsigned char* Bn = F.lds; LAS unsigned char* Cn = F.lds + 18432;
    LAS float* atab = (LAS float*)(F.lds + 36864) + F.wave * 128; LAS float* dtab = (LAS float*)(F.lds + 40960) + F.wave * 128;
    LAS float* ssqp = (LAS float*)(F.lds + 45056); LAS float* gtab = (LAS float*)(F.lds + 49152) + F.wave * 64;
    LAS unsigned char* zt = F.lds + 51200 + F.wave * 4608;
    for (int u = F.bid; u < BATCH * SSD_NCH * 2; u += F.G) {
        const int grp = u & 1, ch = (u >> 1) & 31, b = u >> 6, h = grp * 8 + F.wave, l0 = ch * 128; const size_t row0 = (size_t)b * SEQ + l0;
        int lane = F.lane; asm volatile("" : "+v"(lane));
        const int r = lane & 31, hh = lane >> 5;
        __syncthreads();
        stage_raw(P, row0, l0, C_XS + h * 64, rawX, lane, 64);
        __syncthreads();
        bf16x8 xsf[2][8];
#pragma unroll
        for (int pt = 0; pt < 2; ++pt) { const int cx = h * 64 + 32 * pt + r; const float w0 = cw[cx], w1 = cw[1280 + cx], w2 = cw[2560 + cx], w3 = cw[3840 + cx], bias = cb[cx];
#pragma unroll
            for (int ks = 0; ks < 8; ++ks) { float v[8]; conv_frag(rawX, 32 * pt + r, ks, hh, w0, w1, w2, w3, bias, v); { u32x4 pq = __builtin_bit_cast(u32x4, pack8v(v)); asm volatile("" : "+v"(pq) :: "memory"); xsf[pt][ks] = __builtin_bit_cast(bf16x8, pq); } } }
        __syncthreads();
        for (int it = F.tid; it < 128 * 16; it += NTHR) { const int l = it >> 4, c8 = it & 15, isC = c8 >> 3, col = (isC ? C_C : C_B) + grp * 64 + (c8 & 7) * 8, cc = 1024 + isC * 128 + grp * 64 + (c8 & 7) * 8;
            float a[8];
#pragma unroll
            for (int e = 0; e < 8; ++e) a[e] = cb[cc + e];
#pragma unroll
            for (int j = 0; j < 4; ++j) { if (l0 + l - 3 + j >= 0) { const u32x4 xv = *(const u32x4*)(P + (row0 + l - 3 + j) * NINP + col);
#pragma unroll
                for (int e = 0; e < 4; ++e) { a[2 * e] += cw[j * 1280 + cc + 2 * e] * bflo(xv[e]); a[2 * e + 1] += cw[j * 1280 + cc + 2 * e + 1] * bfhi(xv[e]); } } }
            u32x4 o; o.x = cvtpk(siluf_(a[0]), siluf_(a[1])); o.y = cvtpk(siluf_(a[2]), siluf_(a[3])); o.z = cvtpk(siluf_(a[4]), siluf_(a[5])); o.w = cvtpk(siluf_(a[6]), siluf_(a[7]));
            *(LAS u32x4*)((isC ? Cn : Bn) + l * 144 + (c8 & 7) * 16) = o; }
        { const float dtb = F.in[IN_DTB][layer * 16 + h], A = -__expf(F.in[IN_ALOG][layer * 16 + h]);
          const float dt0 = softplusf_(DT[(row0 + lane) * 16 + h] + dtb), dt1 = softplusf_(DT[(row0 + 64 + lane) * 16 + h] + dtb);
          const float s0 = wave_incl_scan(dt0 * A, lane); const float tot0 = __builtin_bit_cast(float, __builtin_amdgcn_readlane(__builtin_bit_cast(int, s0), 63));
          const float s1 = wave_incl_scan(dt1 * A, lane) + tot0;
          atab[lane] = s0; atab[64 + lane] = s1; dtab[lane] = dt0; dtab[64 + lane] = dt1; gtab[lane] = F.in[IN_SSDG][layer * 1024 + h * 64 + lane]; }
        const float* sp = SST + (((size_t)b * SSD_NCH + ch) * 16 + h) * 4096;
        const float dsk = F.in[IN_SSDD][layer * 16 + h];
        __syncthreads();
#pragma unroll 1
        for (int li = 0; li < 4; ++li) {
            bf16x8 Cf[4];
#pragma unroll
            for (int ks = 0; ks < 4; ++ks) Cf[ks] = *(const LAS bf16x8*)(Cn + (32 * li + r) * 144 + (16 * ks + 8 * hh) * 2);
            f32x16 acc[2];
#pragma unroll
            for (int pt = 0; pt < 2; ++pt)
#pragma unroll
                for (int i = 0; i < 16; ++i) acc[pt][i] = 0.f;
#pragma unroll
            for (int ks = 0; ks < 4; ++ks)
#pragma unroll
                for (int pt = 0; pt < 2; ++pt) { const f32x4 a0 = *(const f32x4*)(sp + (32 * pt + r) * 64 + 16 * ks + 8 * hh), a1 = *(const f32x4*)(sp + (32 * pt + r) * 64 + 16 * ks + 8 * hh + 4);
                    const float v[8] = {a0.x, a0.y, a0.z, a0.w, a1.x, a1.y, a1.z, a1.w}; acc[pt] = MFMA32(pack8v(v), Cf[ks], acc[pt]); }
            const float al = atab[32 * li + r], el = __expf(al); const int lrel = 32 * li + r;
#pragma unroll
            for (int pt = 0; pt < 2; ++pt)
#pragma unroll
                for (int i = 0; i < 16; ++i) acc[pt][i] *= el;
#pragma unroll
            for (int si = 0; si < 4; ++si) if (si <= li) {
                f32x16 X;
#pragma unroll
                for (int i = 0; i < 16; ++i) X[i] = 0.f;
#pragma unroll
                for (int ks = 0; ks < 4; ++ks) { const bf16x8 Bq = *(const LAS bf16x8*)(Bn + (32 * si + r) * 144 + (16 * ks + 8 * hh) * 2); X = MFMA32(Bq, Cf[ks], X); }
#pragma unroll
                for (int g4 = 0; g4 < 4; ++g4) { const int sb = 32 * si + 8 * g4 + 4 * hh; const f32x4 av = *(const LAS f32x4*)(atab + sb), dv = *(const LAS f32x4*)(dtab + sb);
#pragma unroll
                    for (int j = 0; j < 4; ++j) { const int s = sb + j; float arg = al - av[j]; if (si == li && s > lrel) arg = -100.f;
                        float x = X[4 * g4 + j] * (__expf(arg) * dv[j]); if (si == li && s > lrel) x = 0.f; if (si == li && s == lrel) x += dsk; X[4 * g4 + j] = x; } }
#pragma unroll
                for (int kq = 0; kq < 2; ++kq) { const float v[8] = {X[8 * kq], X[8 * kq + 1], X[8 * kq + 2], X[8 * kq + 3], X[8 * kq + 4], X[8 * kq + 5], X[8 * kq + 6], X[8 * kq + 7]}; const bf16x8 Xf = pack8v(v);
#pragma unroll
                    for (int pt = 0; pt < 2; ++pt) { bf16x8 a;
#pragma unroll
                        for (int q = 0; q < 4; ++q) a = (si == q) ? xsf[pt][2 * q + kq] : a;
                        acc[pt] = MFMA32(a, Xf, acc[pt]); } }
            }
            const size_t rowt = row0 + 32 * li;
#pragma unroll
            for (int q = 0; q < 4; ++q) { const int idx = lane + 64 * q, rr = idx >> 3, c8 = idx & 7; *(LAS u32x4*)(zt + rr * 144 + c8 * 16) = *(const u32x4*)(P + (rowt + rr) * NINP + C_Z + h * 64 + c8 * 8); }
            float qs = 0.f;
#pragma unroll
            for (int pt = 0; pt < 2; ++pt)
#pragma unroll
                for (int g4 = 0; g4 < 4; ++g4) { const u32x2 zz = *(const LAS u32x2*)(zt + r * 144 + (32 * pt + 8 * g4 + 4 * hh) * 2);
                    const float z0 = bflo(zz.x), z1 = bfhi(zz.x), z2 = bflo(zz.y), z3 = bfhi(zz.y);
                    float y0 = acc[pt][4 * g4] * siluf_(z0), y1 = acc[pt][4 * g4 + 1] * siluf_(z1), y2 = acc[pt][4 * g4 + 2] * siluf_(z2), y3 = acc[pt][4 * g4 + 3] * siluf_(z3);
                    acc[pt][4 * g4] = y0; acc[pt][4 * g4 + 1] = y1; acc[pt][4 * g4 + 2] = y2; acc[pt][4 * g4 + 3] = y3; qs += (y0 * y0 + y1 * y1) + (y2 * y2 + y3 * y3); }
            qs += __shfl_xor(qs, 32);
            if (hh == 0) ssqp[(32 * li + r) * 8 + F.wave] = qs;
            __syncthreads();
            { const f32x4 qa = *(const LAS f32x4*)(ssqp + (32 * li + r) * 8), qb = *(const LAS f32x4*)(ssqp + (32 * li + r) * 8 + 4);
              const float rs = __builtin_amdgcn_rsqf(((qa.x + qa.y) + (qa.z + qa.w) + (qb.x + qb.y) + (qb.z + qb.w)) * (1.f / 512.f) + NORM_EPS);
#pragma unroll
              for (int pt = 0; pt < 2; ++pt)
#pragma unroll
                  for (int g4 = 0; g4 < 4; ++g4) { const int p0 = 32 * pt + 8 * g4 + 4 * hh; const f32x4 gv = *(const LAS f32x4*)(gtab + p0);
                      u32x2 o; o.x = cvtpk(acc[pt][4 * g4] * rs * gv.x, acc[pt][4 * g4 + 1] * rs * gv.y); o.y = cvtpk(acc[pt][4 * g4 + 2] * rs * gv.z, acc[pt][4 * g4 + 3] * rs * gv.w);
                      *(LAS u32x2*)(zt + r * 144 + p0 * 2) = o; } }
#pragma unroll
            for (int q = 0; q < 4; ++q) { const int idx = lane + 64 * q, rr = idx >> 3, c8 = idx & 7; *(u32x4*)(YC + (rowt + rr) * 2048 + 1024 + h * 64 + c8 * 8) = *(const LAS u32x4*)(zt + rr * 144 + c8 * 16); }
        }
    }
}

__device__ __forceinline__ void attn_mfma(Frame& F, int layer) {
    LAS unsigned char* Kn = F.lds; LAS unsigned char* VT = F.lds + 36864;
    const bf16_t* P = (const bf16_t*)(F.ws + WS_P); bf16_t* YC = (bf16_t*)(F.ws + WS_YCAT);
    const float* qg = F.in[IN_QG] + layer * 64; const float* kg = F.in[IN_KG] + layer * 64;
    for (int u = F.bid; u < BATCH * 32 * 2; u += F.G) {
        const int kvh = u & 1, qb = (u >> 1) & 31, b = u >> 6, q0 = qb * 128;
        int lane = F.lane; asm volatile("" : "+v"(lane));
        const int r = lane & 31, hh = lane >> 5;
        __syncthreads();
        for (int jr = F.wave; jr < 256; jr += NWAVES) { const int l = q0 - 128 + jr; float kv = 0.f;
            if (l >= 0) { const size_t row = (size_t)b * SEQ + l; const float x = bf2f(P[row * NINP + C_K + kvh * 64 + lane]);
                const float rs = __builtin_amdgcn_rsqf(wave_sum(x * x) * (1.f / 64.f) + NORM_EPS); const float xn = x * rs * kg[lane];
                const float other = __shfl_xor(xn, 32); const int i = lane & 31; const float inv = exp2f(-(float)i * (13.287712379549449f / 32.f));
                float s, c; sincos_fast((float)l * inv, s, c);
                kv = (lane < 32) ? (xn * c - other * s) : (xn * c + other * s); }
            *(LAS unsigned short*)(Kn + jr * 144 + lane * 2) = (unsigned short)f2bf(kv); }
#pragma unroll
        for (int q = 0; q < 4; ++q) { const int it = F.tid + NTHR * q, d = it & 63, ko = it >> 6; unsigned short v[8];
#pragma unroll
            for (int e = 0; e < 8; ++e) { const int l = q0 - 128 + 8 * ko + e; v[e] = (l >= 0) ? P[((size_t)b * SEQ + l) * NINP + C_V + kvh * 64 + d] : (unsigned short)0; }
            u32x4 o; o.x = v[0] | ((unsigned)v[1] << 16); o.y = v[2] | ((unsigned)v[3] << 16); o.z = v[4] | ((unsigned)v[5] << 16); o.w = v[6] | ((unsigned)v[7] << 16);
            *(LAS u32x4*)(VT + d * 528 + ko * 16) = o; }
        __syncthreads();
        const int hd = F.wave >> 1, head = kvh * 4 + hd, qhalf = F.wave & 1; const float sink = F.in[IN_SINK][layer * 8 + head];
#pragma unroll 1
        for (int jt = 0; jt < 2; ++jt) {
            const int qt = q0 + 64 * qhalf + 32 * jt, qi = qt + r, t0 = 2 * qhalf + jt; const size_t row = (size_t)b * SEQ + qi;
            bf16x8 Qf[4];
            { float qv[4][8]; float ss = 0.f;
#pragma unroll
              for (int ks = 0; ks < 4; ++ks) { const u32x4 w = *(const u32x4*)(P + row * NINP + C_Q + head * 64 + 16 * ks + 8 * hh);
#pragma unroll
                  for (int e = 0; e < 4; ++e) { qv[ks][2 * e] = bflo(w[e]); qv[ks][2 * e + 1] = bfhi(w[e]); ss += qv[ks][2 * e] * qv[ks][2 * e] + qv[ks][2 * e + 1] * qv[ks][2 * e + 1]; } }
              ss += __shfl_xor(ss, 32);
              const float rs = __builtin_amdgcn_rsqf(ss * (1.f / 64.f) + NORM_EPS);
#pragma unroll
              for (int ks = 0; ks < 4; ++ks)
#pragma unroll
                  for (int e = 0; e < 8; ++e) qv[ks][e] *= rs * qg[16 * ks + 8 * hh + e];
#pragma unroll
              for (int ks = 0; ks < 2; ++ks)
#pragma unroll
                  for (int e = 0; e < 8; ++e) { const int i = 16 * ks + 8 * hh + e; const float inv = exp2f(-(float)i * (13.287712379549449f / 32.f)); float s, c; sincos_fast((float)qi * inv, s, c);
                      const float a = qv[ks][e], bq = qv[ks + 2][e]; qv[ks][e] = (a * c - bq * s) * 0.125f; qv[ks + 2][e] = (bq * c + a * s) * 0.125f; }
#pragma unroll
              for (int ks = 0; ks < 4; ++ks) Qf[ks] = pack8v(qv[ks]); }
            f32x16 acc[2];
#pragma unroll
            for (int dt = 0; dt < 2; ++dt)
#pragma unroll
                for (int i = 0; i < 16; ++i) acc[dt][i] = 0.f;
            float m = sink, lsum = 1.f;
#pragma unroll
            for (int tt = 0; tt < 5; ++tt) { const int t = t0 + tt;
                if (q0 == 0 && t < 4) continue;
                f32x16 X;
#pragma unroll
                for (int i = 0; i < 16; ++i) X[i] = 0.f;
#pragma unroll
                for (int ks = 0; ks < 4; ++ks) { const bf16x8 Kq = *(const LAS bf16x8*)(Kn + (32 * t + r) * 144 + (16 * ks + 8 * hh) * 2); X = MFMA32(Kq, Qf[ks], X); }
                if (tt == 0) {
#pragma unroll
                    for (int i = 0; i < 16; ++i) if (!(r < crow32(i, hh))) X[i] = -INFINITY; }
                if (tt == 4) {
#pragma unroll
                    for (int i = 0; i < 16; ++i) if (!(crow32(i, hh) <= r)) X[i] = -INFINITY; }
                float mx = X[0];
#pragma unroll
                for (int i = 1; i < 16; ++i) mx = fmaxf(mx, X[i]);
                mx = fmaxf(mx, __shfl_xor(mx, 32));
                const float mn = fmaxf(m, mx), al = __expf(m - mn); m = mn;
                float ps = 0.f;
#pragma unroll
                for (int i = 0; i < 16; ++i) { X[i] = __expf(X[i] - mn); ps += X[i]; }
                ps += __shfl_xor(ps, 32);
                lsum = lsum * al + ps;
#pragma unroll
                for (int dt = 0; dt < 2; ++dt)
#pragma unroll
                    for (int i = 0; i < 16; ++i) acc[dt][i] *= al;
#pragma unroll
                for (int kq = 0; kq < 2; ++kq) { const float v[8] = {X[8 * kq], X[8 * kq + 1], X[8 * kq + 2], X[8 * kq + 3], X[8 * kq + 4], X[8 * kq + 5], X[8 * kq + 6], X[8 * kq + 7]}; const bf16x8 Pf = pack8v(v);
#pragma unroll
                    for (int dt = 0; dt < 2; ++dt) { const LAS unsigned char* vp = VT + (32 * dt + r) * 528 + (32 * t + 16 * kq + 4 * hh) * 2;
                        const u32x2 va = *(const LAS u32x2*)vp, vb = *(const LAS u32x2*)(vp + 16); const u32x4 vv = {va.x, va.y, vb.x, vb.y};
                        acc[dt] = MFMA32(__builtin_bit_cast(bf16x8, vv), Pf, acc[dt]); } }
            }
            const float il = 1.f / lsum;
#pragma unroll
            for (int dt = 0; dt < 2; ++dt)
#pragma unroll
                for (int g4 = 0; g4 < 4; ++g4) { u32x2 o; o.x = cvtpk(acc[dt][4 * g4] * il, acc[dt][4 * g4 + 1] * il); o.y = cvtpk(acc[dt][4 * g4 + 2] * il, acc[dt][4 * g4 + 3] * il);
                    *(u32x2*)(YC + row * 2048 + 512 + head * 64 + 32 * dt + 8 * g4 + 4 * hh) = o; }
        }
    }
}

#ifndef MK_PER_PHASE
#define MK_PER_PHASE 0
#endif
constexpr int NPH = 13;
constexpr int TAB_OFF = 150 * 1024;
struct Args { const float* in[N_INPUTS]; float* out; unsigned char* ws; int gp_lo, gp_hi; };
static_assert(sizeof(Args) == (N_INPUTS + 2) * 8 + 8, "no padding in Args");

#ifndef PROBE_ID
#define PROBE_ID 0
#endif
#ifndef PROBE_N
#define PROBE_N 1
#endif
#define REP(id) for (int _r = 0; _r < ((id) == PROBE_ID ? 1 + PROBE_N : 1); ++_r)
extern __shared__ __attribute__((aligned(16))) unsigned char lds_raw[];
__device__ __forceinline__ LAS unsigned char* lds_raw_base() { return (LAS unsigned char*)lds_raw; }
#define LAUNDER() do { asm volatile("" : "+s"(F.in), "+s"(F.ws), "+s"(F.out), "+s"(F.ctl), "+s"(F.bid), "+s"(F.G)); asm volatile("" : "+v"(F.tid)); F.lane = F.tid & 63; F.wave = __builtin_amdgcn_readfirstlane(F.tid >> 6); } while (0)
template <int layer>
__device__ __forceinline__ void layer_body(Frame& F, const int lo, const int hi, const bool rerun) {
    volatile LAS int* offs = (volatile LAS int*)(F.lds + TAB_OFF); volatile LAS int* tile_e = offs + 64;
    XcdBarrier bar; bar.bar = F.ctl + CW_BAR; bar.x = xb_xcc_id(); bar.st = F.MISC;
#define GP(k) (layer * NPH + (k))
#ifdef ONLY_PH
#define IN(k) (((k) == ONLY_PH) && lo <= GP(k) && GP(k) < hi)
#else
#define IN(k) (lo <= GP(k) && GP(k) < hi)
#endif
#define WSB ((const char*)F.ws)
#ifdef DIAG_GP
#define STAMP0(k) do { if (GP(k) == DIAG_GP) { const unsigned t_ = (unsigned)__builtin_amdgcn_s_memrealtime(); if (threadIdx.x == 0) *(volatile LAS unsigned*)((LAS unsigned char*)lds_raw_base() + MISC_OFF + 32) = t_; } } while (0)
#define STAMP1(k) do { if (GP(k) == DIAG_GP) { const unsigned t_ = (unsigned)__builtin_amdgcn_s_memrealtime(); if (threadIdx.x == 0) *(volatile LAS unsigned*)((LAS unsigned char*)lds_raw_base() + MISC_OFF + 40) = t_; } } while (0)
#else
#define STAMP0(k)
#define STAMP1(k)
#endif
#define SEAM(k) do { if (!MK_PER_PHASE && IN(k) && GP(k) + 1 < hi) { xcd_barrier(bar); if (PROBE_ID == 19) { xcd_barrier(bar); xcd_barrier(bar); } } STAMP1(k); } while (0)
        if (IN(0) && layer == 0) { LAUNDER(); STAMP0(0);
            REP(1) { convert_weights(F, 0); __syncthreads(); } REP(2) s5_build(F, 0);
            REP(3) rmsnorm_rows(F, F.in[IN_X], F.in[IN_NORM1], (bf16_t*)(F.ws + WS_XN));
            SEAM(0);
        }
        if (IN(1)) { LAUNDER(); STAMP0(1);
            SchedDense<2048u, 2048u, T / 256, NINP / 256, 16> S{WSB + WS_XN, WSB + WS_WIN, F.G, F.bid};
            EpiProj E{F.ws, F.in[IN_BGATE] + layer * 3072};
            REP(4) pg8::gemm_phase<2048u, 2048u>(F.tid, F.lds, S, E);
            SEAM(1);
        }
        if (IN(2)) { LAUNDER(); STAMP0(2);
            SchedS5P1 S{WSB + WS_UH, WSB + WS_EG, F.G, F.bid};
            EpiHloc E{(float*)(F.ws + WS_HLOC)};
            REP(5) pg8::gemm_phase<(unsigned)(S5_K * 2), 1024u>(F.tid, F.lds, S, E);
            REP(6) ssdA_mfma(F, layer);
            REP(8) attn_mfma(F, layer);
            SEAM(2);
        }
        if (IN(3)) { LAUNDER(); STAMP0(3);
            REP(7) s5_scan(F, layer);
            if (!rerun) ssd_scan(F);
            SEAM(3);
        }
        if (IN(4)) { LAUNDER(); STAMP0(4);
            SchedS5Main S{WSB + WS_UH, WSB + WS_MG, F.G, F.bid};
            EpiS5Y E{(bf16_t*)(F.ws + WS_XN)};
            REP(9) pg8::gemm_phase<(unsigned)(S5_K * 2), (unsigned)(S5_K * 2)>(F.tid, F.lds, S, E);
            REP(10) ssdC_mfma(F, layer);
            SEAM(4);
        }
        if (IN(5)) { LAUNDER(); STAMP0(5);
            SchedDense<1024u, 1024u, T / 256, 4, 8> S{WSB + WS_XN, WSB + WS_WGLU, F.G, F.bid};
            EpiGlu E{(bf16_t*)(F.ws + WS_YCAT)};
            REP(11) pg8::gemm_phase<1024u, 1024u>(F.tid, F.lds, S, E);
            SEAM(5);
        }
        if (IN(6)) { LAUNDER(); STAMP0(6);
            SchedDense<4096u, 4096u, T / 256, 4, 32> S{WSB + WS_YCAT, WSB + WS_PCAT, F.G, F.bid};
            EpiMerged E{F.ws};
            REP(12) pg8::gemm_phase<4096u, 4096u>(F.tid, F.lds, S, E);
            SEAM(6);
        }
        if (IN(7)) { LAUNDER(); STAMP0(7);
            SchedDense<2048u, 2048u, T / 256, 4, 16> S{WSB + WS_XN, WSB + WS_WOUT, F.G, F.bid};
            EpiResid E{layer == 0 ? F.in[IN_X] : (const float*)F.out, F.out};
            REP(layer == 0 ? 13 : -1) pg8::gemm_phase<2048u, 2048u>(F.tid, F.lds, S, E);
            SEAM(7);
        }
        if (IN(8)) { LAUNDER(); STAMP0(8); REP(17) router_phase(F, layer); SEAM(8); }
        if (IN(9)) { LAUNDER(); STAMP0(9); (void)moe_tables(F, layer, offs, tile_e); REP(14) gather_phase(F, layer, offs); SEAM(9); }
        if (IN(10)) { LAUNDER(); STAMP0(10);
            const int ntiles = moe_tables(F, layer, offs, tile_e);
            SchedMoe<2048u, (size_t)1024 * 1024 * 2, (size_t)256 * 2048, 16> S{WSB + WS_XG, WSB + WS_EGU, ntiles, F.G, F.bid, tile_e};
            EpiSwiGlu E{(bf16_t*)(F.ws + WS_HID), (const float*)(F.ws + WS_MOE + 704 * 1024)};
            REP(15) pg8::gemm_phase<2048u, 2048u>(F.tid, F.lds, S, E);
            SEAM(10);
        }
        if (IN(11)) { LAUNDER(); STAMP0(11);
            const int ntiles = moe_tables(F, layer, offs, tile_e);
            SchedMoe<1024u, (size_t)1024 * 512 * 2, (size_t)256 * 1024, 8> S{WSB + WS_HID, WSB + WS_EDN, ntiles, F.G, F.bid, tile_e};
            EpiPlainBf16 E{(bf16_t*)(F.ws + WS_YEXP)};
            REP(16) pg8::gemm_phase<1024u, 1024u>(F.tid, F.lds, S, E);
            SEAM(11);
        }
        if (IN(12)) { LAUNDER(); STAMP0(12);
            if (PROBE_ID == 18) combine_phase(F, F.in[IN_NORM1], true);
            combine_phase(F, layer + 1 < DEPTH ? F.in[IN_NORM1] + (layer + 1) * 1024 : nullptr);
            if (layer + 1 < DEPTH) { __syncthreads(); convert_weights(F, layer + 1); __syncthreads(); s5_build(F, layer + 1); }
            SEAM(12);
        }
#undef GP
#undef IN
#undef SEAM
#undef WSB
}
__global__ void __launch_bounds__(NTHR, 2) fwd(Args args) {
    Frame F;
    F.lds = (LAS unsigned char*)lds_raw;
    F.MISC = (volatile LAS unsigned*)(F.lds + MISC_OFF);
    F.tid = threadIdx.x; F.lane = F.tid & 63; F.wave = __builtin_amdgcn_readfirstlane(F.tid >> 6);
    F.G = gridDim.x; F.bid = blockIdx.x;
    const __attribute__((address_space(4))) char* ka = (const __attribute__((address_space(4))) char*)__builtin_amdgcn_kernarg_segment_ptr();
    F.in = (const float* const __attribute__((address_space(4)))*)ka;
    F.out = *(float* const __attribute__((address_space(4)))*)(ka + N_INPUTS * 8); F.ws = *(unsigned char* const __attribute__((address_space(4)))*)(ka + N_INPUTS * 8 + 8); F.ctl = (unsigned*)(F.ws + WS_CTL);
    if (F.tid < 64) F.MISC[F.tid] = 0u;
    __syncthreads();
    XcdBarrier bar; bar.bar = F.ctl + CW_BAR; bar.x = 0; bar.st = nullptr;
    if (!MK_PER_PHASE) bar = xcd_barrier_post(F.ctl + CW_BAR, F.MISC);
    const int lo = *(const __attribute__((address_space(4))) int*)(ka + N_INPUTS * 8 + 16), hi_raw = *(const __attribute__((address_space(4))) int*)(ka + N_INPUTS * 8 + 20), hi = hi_raw & 0xffff;

    layer_body<0>(F, lo, hi, (hi_raw >> 16) != 0);
    layer_body<1>(F, lo, hi, (hi_raw >> 16) != 0);
#ifdef DIAG_GP
    __syncthreads();
    if (blockIdx.x == 0 && threadIdx.x == 0) { const unsigned t0 = *(volatile LAS unsigned*)((LAS unsigned char*)lds_raw_base() + MISC_OFF + 32), t1 = *(volatile LAS unsigned*)((LAS unsigned char*)lds_raw_base() + MISC_OFF + 40); float* o_ = *(float* const __attribute__((address_space(4)))*)((const __attribute__((address_space(4))) char*)__builtin_amdgcn_kernarg_segment_ptr() + N_INPUTS * 8); asm volatile("s_waitcnt vmcnt(0)" ::: "memory"); o_[0] = (float)(t1 - t0); }
#endif
}

extern "C" void kernel_launch(void* const* d_in, const int* in_sizes, int n_in, void* d_out, int out_size, void* d_ws, size_t ws_size, hipStream_t stream) {
    static int grid = 0;
    if (grid == 0) {
        if (n_in != N_INPUTS || out_size != T * DM || ws_size < WS_END) { fprintf(stderr, "kernel_launch: unexpected shapes (n_in %d out %d ws %zu need %zu)\n", n_in, out_size, ws_size, (size_t)WS_END); grid = -1; return; }
        int dev = 0, cus = 0, per_cu = 0;
        if (hipGetDevice(&dev) != hipSuccess || hipDeviceGetAttribute(&cus, hipDeviceAttributeMultiprocessorCount, dev) != hipSuccess) { grid = -1; return; }
        if (hipFuncSetAttribute((const void*)fwd, hipFuncAttributeMaxDynamicSharedMemorySize, LDS_BYTES) != hipSuccess) { fprintf(stderr, "kernel_launch: hipFuncSetAttribute failed\n"); grid = -1; return; }
        if (hipOccupancyMaxActiveBlocksPerMultiprocessor(&per_cu, (const void*)fwd, NTHR, LDS_BYTES) != hipSuccess || per_cu < 1) fprintf(stderr, "kernel_launch: occupancy query reports %d\n", per_cu);
        (void)hipGetLastError();
        grid = cus;
    }
    if (grid < 0) return;
    (void)hipMemsetAsync((char*)d_ws + WS_CTL, 0, CTL_ZERO_BYTES, stream);
    Args a{};
    for (int i = 0; i < N_INPUTS; ++i) a.in[i] = (const float*)d_in[i];
    a.out = (float*)d_out; a.ws = (unsigned char*)d_ws;
#if MK_PER_PHASE
    for (int gp = 0; gp < DEPTH * NPH; ++gp) {
        if (gp == NPH) continue;
        a.gp_lo = gp; a.gp_hi = gp + 1;
        int nrep = 1;
#ifdef PP_REP_GP
        if (gp == PP_REP_GP) nrep = 1 + PP_REP_N;
#endif
        for (int rr = 0; rr < nrep; ++rr) { a.gp_hi = (gp + 1) | (rr > 0 ? 0x10000 : 0); hipLaunchKernelGGL(fwd, dim3(grid), dim3(NTHR), LDS_BYTES, stream, a); }
    }
#else
    a.gp_lo = 0; a.gp_hi = DEPTH * NPH;
    hipLaunchKernelGGL(fwd, dim3(grid), dim3(NTHR), LDS_BYTES, stream, a);
#endif
}
```

```cpp
#include <hip/hip_runtime.h>
#include <cstdio>
#include <cstdint>

#define LAS __attribute__((address_space(3)))
#define GAS __attribute__((address_space(1)))
typedef unsigned short bf16_t;
typedef short bf16x8 __attribute__((ext_vector_type(8)));
typedef float f32x4 __attribute__((ext_vector_type(4)));
typedef float f32x2 __attribute__((ext_vector_type(2)));
typedef unsigned u32x4 __attribute__((ext_vector_type(4)));
typedef unsigned u32x2 __attribute__((ext_vector_type(2)));

constexpr int BATCH = 4, SEQ = 4096, DM = 1024, T = BATCH * SEQ, DEPTH = 2;
constexpr int NIN = 6672, NINP = 6912;
constexpr int C_U = 0, C_Q = 512, C_K = 1024, C_V = 1152, C_Z = 1280, C_XS = 2304, C_B = 3328, C_C = 3456, C_DT = 3584, C_G = 3840;
constexpr int S5_TC = 32, S5_ROWS = T / S5_TC  , S5_K = 128 + S5_TC * 16  , S5_N = S5_TC * 16  ;
constexpr int SSD_NCH = SEQ / 128;
constexpr int MOE_MAXROWS = 2 * T + 32 * 256;
constexpr float NORM_EPS = 1e-6f;

constexpr size_t MiB = 1u << 20;
constexpr size_t WS_CTL = 0, CTL_ZERO_BYTES = 1 * MiB;
constexpr size_t WS_WIN = 1 * MiB;
constexpr size_t WS_WGLU = WS_WIN + (size_t)NINP * DM * 2;
constexpr size_t WS_PCAT = WS_WGLU + 1 * MiB;
constexpr size_t WS_WOUT = WS_PCAT + 4 * MiB;
constexpr size_t WS_EGU = WS_WOUT + 2 * MiB;
constexpr size_t WS_EDN = WS_EGU + 64 * MiB;
constexpr size_t WS_MG = WS_EDN + 32 * MiB;
constexpr size_t WS_EG = WS_MG + 20 * MiB;
constexpr size_t WS_XN = WS_EG + 8 * MiB;
constexpr size_t WS_P = WS_XN + 32 * MiB;
constexpr size_t WS_XG = WS_P;
constexpr size_t WS_HID = WS_XG + (size_t)MOE_MAXROWS * 1024 * 2;
constexpr size_t WS_YEXP = WS_HID + (size_t)MOE_MAXROWS * 512 * 2;
constexpr size_t WS_DT = WS_P + 216 * MiB;
constexpr size_t WS_UH = WS_DT + 1 * MiB;
constexpr size_t WS_HLOC = WS_UH + 20 * MiB;
constexpr size_t WS_YCAT = WS_HLOC + 8 * MiB;
constexpr size_t WS_SST = WS_YCAT + 64 * MiB;
constexpr size_t WS_MOE = WS_SST + 32 * MiB;
constexpr size_t WS_ASUM = WS_MOE + 1 * MiB;
constexpr size_t WS_END = WS_ASUM + 64 * 1024;
static_assert(WS_YEXP + (size_t)MOE_MAXROWS * 1024 * 2 <= WS_DT, "MoE overlay fits in P");
constexpr int CW_BAR = 4096;
constexpr int CW_CNT = 16384;

constexpr int NWAVES = 8, NTHR = 512;
constexpr int LDS_BYTES = 163840;
constexpr int RING_BYTES = 131072;
constexpr int MISC_OFF = 160 * 1024 - 256;

__device__ __forceinline__ unsigned f2bf(float f) { unsigned u = __builtin_bit_cast(unsigned, f); return (u + 0x7fffu + ((u >> 16) & 1u)) >> 16; }
__device__ __forceinline__ unsigned pk2(float lo, float hi) { return f2bf(lo) | (f2bf(hi) << 16); }
__device__ __forceinline__ float bf2f(unsigned b) { return __builtin_bit_cast(float, b << 16); }
__device__ __forceinline__ float bflo(unsigned w) { return __builtin_bit_cast(float, w << 16); }
__device__ __forceinline__ float bfhi(unsigned w) { return __builtin_bit_cast(float, w & 0xffff0000u); }
#define WS_DPP(v, ctrl, rmask) __builtin_bit_cast(float, __builtin_amdgcn_update_dpp(0, __builtin_bit_cast(int, v), ctrl, rmask, 0xF, false))
__device__ __forceinline__ float wave_sum(float v) {
    v += WS_DPP(v, 0xB1, 0xF);
    v += WS_DPP(v, 0x4E, 0xF);
    v += WS_DPP(v, 0x141, 0xF);
    v += WS_DPP(v, 0x140, 0xF);
    v += WS_DPP(v, 0x142, 0xA);
    v += WS_DPP(v, 0x143, 0xC);
    return __builtin_bit_cast(float, __builtin_amdgcn_readlane(__builtin_bit_cast(int, v), 63));
}
__device__ __forceinline__ float frcp(float x) { return __builtin_amdgcn_rcpf(x); }
__device__ __forceinline__ float sigmoidf_(float x) { return frcp(1.0f + __expf(-x)); }
__device__ __forceinline__ float siluf_(float x) { return x * frcp(1.0f + __expf(-x)); }
__device__ __forceinline__ float gelu_tanh_(float x) { const float u = 0.7978845608f * (x + 0.044715f * x * x * x); return x * frcp(1.0f + __expf(-2.0f * u)); }
__device__ __forceinline__ float softplusf_(float x) { return x > 20.f ? x : log1pf(__expf(x)); }

typedef float f32x16 __attribute__((ext_vector_type(16)));
typedef float f32x2_t __attribute__((ext_vector_type(2)));
typedef __bf16 bf16x2_t __attribute__((ext_vector_type(2)));
#define MFMA32(a, b, c) __builtin_amdgcn_mfma_f32_32x32x16_bf16((a), (b), (c), 0, 0, 0)
__device__ __forceinline__ unsigned cvtpk(float lo, float hi) { f32x2_t v = {lo, hi}; bf16x2_t b = __builtin_convertvector(v, bf16x2_t); return __builtin_bit_cast(unsigned, b); }
__device__ __forceinline__ bf16x8 pack8v(const float (&v)[8]) { u32x4 p; p.x = cvtpk(v[0], v[1]); p.y = cvtpk(v[2], v[3]); p.z = cvtpk(v[4], v[5]); p.w = cvtpk(v[6], v[7]); return __builtin_bit_cast(bf16x8, p); }

#define XB_TMO      128
#define XB_XCNT(j)  (256  + 64 * (j))
#define XB_XSUB(j)  (1280 + 64 * (j))
#define XB_XGEN(j)  (2304 + 64 * (j))
#define XB_TOP      3328
#define XB_TOPGEN   3392
#define XCD_BAR_WORDS 3456
#define XB_SPIN_CAP (1u << 18)
__device__ __forceinline__ unsigned xb_ld(unsigned* p)              { return __hip_atomic_load(p, __ATOMIC_RELAXED, __HIP_MEMORY_SCOPE_AGENT); }
__device__ __forceinline__ unsigned xb_add(unsigned* p, unsigned v) { return __hip_atomic_fetch_add(p, v, __ATOMIC_RELAXED, __HIP_MEMORY_SCOPE_AGENT); }
__device__ __forceinline__ unsigned xb_xcc_id() { return (unsigned)__builtin_amdgcn_s_getreg((3 << 11) | 20) & 0xFu; }
#define XB_SPIN(cond, bar) do { unsigned _sp = 0; while (cond) { __builtin_amdgcn_s_sleep(1); \
    if ((++_sp & 255u) == 0u) { if (xb_ld(&(bar)[XB_TMO])) break; if (_sp > XB_SPIN_CAP) { atomicAdd(&(bar)[XB_TMO], 1u); break; } } } } while (0)
struct XcdBarrier { unsigned* bar; unsigned x; volatile LAS unsigned* st; };
__device__ __forceinline__ XcdBarrier xcd_barrier_post(unsigned* bar, volatile LAS unsigned* st) {
    XcdBarrier b; b.bar = bar; b.x = xb_xcc_id(); b.st = st;
    if (threadIdx.x == 0) (void)xb_add(&bar[XB_XCNT(b.x)], 1u);
    return b;
}
__device__ __forceinline__ void xcd_barrier_complete(unsigned* bar, unsigned x, unsigned& nloc, unsigned& nx) {
    const unsigned G = gridDim.x * gridDim.y * gridDim.z;
    unsigned sum, cnt, mine, sp = 0u;
    for (;;) {
        sum = 0u; cnt = 0u; mine = 0u;
#pragma unroll
        for (unsigned j = 0; j < 16; ++j) { const unsigned c = xb_ld(&bar[XB_XCNT(j)]); sum += c; cnt += (c > 0u) ? 1u : 0u; mine = (j == x) ? c : mine; }
        if (sum == G) break;
        __builtin_amdgcn_s_sleep(1);
        if ((++sp & 255u) == 0u) { if (xb_ld(&bar[XB_TMO])) break; if (sp > XB_SPIN_CAP) { atomicAdd(&bar[XB_TMO], 1u); break; } }
    }
    nloc = mine > 0u ? mine : 1u; nx = cnt > 0u ? cnt : 1u;
}
__device__ __forceinline__ void xcd_barrier(const XcdBarrier& b) {
    asm volatile("s_waitcnt vmcnt(0)" ::: "memory");
    __syncthreads();
    if (threadIdx.x == 0) {
        unsigned* bar = b.bar;
        __builtin_amdgcn_s_waitcnt(0);
        unsigned nloc = b.st[0], nx = b.st[1];
        if (nloc == 0u) { xcd_barrier_complete(bar, b.x, nloc, nx); b.st[0] = nloc; b.st[1] = nx; }
        const unsigned old = xb_add(&bar[XB_XSUB(b.x)], 1u);
        const unsigned gen = old / nloc;
        if (old + 1u == (gen + 1u) * nloc) {
            __builtin_amdgcn_fence(__ATOMIC_RELEASE, "agent");
            asm volatile("s_waitcnt vmcnt(0)" ::: "memory");
            const unsigned og = xb_add(&bar[XB_TOP], 1u);
            const unsigned tg = og / nx;
            if (og + 1u == (tg + 1u) * nx) xb_add(&bar[XB_TOPGEN], 1u);
            else XB_SPIN(xb_ld(&bar[XB_TOPGEN]) == tg, bar);
            __builtin_amdgcn_fence(__ATOMIC_ACQUIRE, "agent");
            xb_add(&bar[XB_XGEN(b.x)], 1u);
            asm volatile("s_waitcnt vmcnt(0)" ::: "memory");
        } else {
            XB_SPIN(xb_ld(&bar[XB_XGEN(b.x)]) == gen, bar);
            __builtin_amdgcn_fence(__ATOMIC_ACQUIRE, "agent");
            asm volatile("s_waitcnt vmcnt(0)" ::: "memory");
        }
    }
    __syncthreads();
}

namespace pg8 {
constexpr int BM = 256, BK = 64, HALF = 128, HTB = HALF * BK * 2, STAGE_BYTES = 8 * HTB, NXCD = 8, WGM = 8;
__host__ __device__ __forceinline__ int lds_byte(int r, int c) { const int st = (r >> 4) * 2 + (c >> 5), rr = r & 15, cc = c & 31, ob = rr * 64 + cc * 2; return st * 1024 + (ob ^ (((ob >> 9) & 1) << 5)); }
__host__ __device__ __forceinline__ void stage_rc(int b, int& R, int& C) { const int st = b / 1024, sb = b % 1024, swz = sb ^ (((sb >> 9) & 1) << 5); R = (st >> 1) * 16 + swz / 64; C = (st & 1) * 32 + (swz % 64) / 2; }
__host__ __device__ __forceinline__ int perm32(int rho) { const int n = rho >> 4, i = rho & 15; return 8 * (i >> 2) + 4 * n + (i & 3); }

struct Unit { const char* A; const char* B; int nt; int pm, pn, aux; };

__device__ __forceinline__ void tile_order(int L, int nM, int nN, int& pm, int& pn) {
    const int nwg = nM * nN; int wgid = L;
    { const int q = nwg / NXCD, r = nwg % NXCD, xcd = wgid % NXCD, off = wgid / NXCD; wgid = (xcd < r ? xcd * (q + 1) : r * (q + 1) + (xcd - r) * q) + off; }
    const int nig = WGM * nN, gid = wgid / nig, fm = gid * WGM, gsz = (nM - fm) < WGM ? (nM - fm) : WGM;
    pm = fm + ((wgid % nig) % gsz); pn = (wgid % nig) / gsz;
}
__device__ __forceinline__ unsigned cvt_pk_bf16(float lo, float hi) { unsigned r; asm volatile("v_cvt_pk_bf16_f32 %0, %1, %2" : "=v"(r) : "v"(lo), "v"(hi)); return r; }
__device__ __forceinline__ u32x4 pack8(const f32x4 v0, const f32x4 v1) { u32x4 w; w.x = cvt_pk_bf16(v0[0], v0[1]); w.y = cvt_pk_bf16(v0[2], v0[3]); w.z = cvt_pk_bf16(v1[0], v1[1]); w.w = cvt_pk_bf16(v1[2], v1[3]); return w; }

template <unsigned lda, unsigned ldb, class Epi, class Sched>
__device__ __forceinline__ void gemm_phase(const int tid, LAS unsigned char* lds, const Sched& S, const Epi& E) {
    const int wid = __builtin_amdgcn_readfirstlane(tid >> 6), lane = tid & 63, wr = wid >> 2, wc = wid & 3, fr = lane & 15, fq = lane >> 4;
    unsigned voffA[2], voffB[2];
#pragma unroll
    for (int i = 0; i < 2; ++i) { int R, C; stage_rc(tid * 16 + i * 8192, R, C); const int Rb = Epi::PERM ? ((R & ~31) + perm32(R & 31)) : R;
        voffA[i] = (unsigned)R * lda + (unsigned)C * 2u; voffB[i] = (unsigned)Rb * ldb + (unsigned)C * 2u; }
    const size_t kstep = (size_t)(BK * 2);
    const size_t hstepA = (size_t)HALF * lda, hstepB = (size_t)HALF * ldb;
    const unsigned ldsw = (unsigned)wid * 1024u;
    const int aoff = lds_byte(wr * 64 + fr, fq * 8), boff = lds_byte(wc * 32 + fr, fq * 8);
#define PG8_SA(b, h) (((b) * 2 + (h)) * HTB)
#define PG8_SB(b, h) ((4 + (b) * 2 + (h)) * HTB)
#define PG8_STAGE(bufoff, gbase, voff) do { const char* _gb = (const char*)(gbase); asm volatile("" : "+s"(_gb)); _Pragma("unroll") for (int _i = 0; _i < 2; ++_i) \
        __builtin_amdgcn_global_load_lds((const unsigned*)(_gb + (voff)[_i]), (LAS unsigned*)(lds + (bufoff) + ldsw + _i * 8192), 16, 0, 0); } while (0)
#define PG8_LDA(dst, b, h) do { _Pragma("unroll") for (int m = 0; m < 4; ++m) _Pragma("unroll") for (int k = 0; k < 2; ++k) dst[m][k] = *(const LAS bf16x8*)(lds + PG8_SA(b, h) + aoff + m * 2048 + k * 1024); } while (0)
#define PG8_LDB(dst, b, h) do { _Pragma("unroll") for (int n = 0; n < 2; ++n) _Pragma("unroll") for (int k = 0; k < 2; ++k) dst[n][k] = *(const LAS bf16x8*)(lds + PG8_SB(b, h) + boff + n * 2048 + k * 1024); } while (0)
#define PG8_MMA(ai, bj, At, Bt) do { __builtin_amdgcn_s_setprio(1); _Pragma("unroll") for (int m = 0; m < 4; ++m) _Pragma("unroll") for (int n = 0; n < 2; ++n) _Pragma("unroll") for (int k = 0; k < 2; ++k) \
        acc[ai][bj][m][n] = __builtin_amdgcn_mfma_f32_16x16x32_bf16(Bt[n][k], At[m][k], acc[ai][bj][m][n], 0, 0, 0); __builtin_amdgcn_s_setprio(0); } while (0)
#define PG8_WAIT_V(n) asm volatile("s_waitcnt vmcnt(" #n ")" ::: "memory")
#define PG8_WAIT_L(n) asm volatile("s_waitcnt lgkmcnt(" #n ")" ::: "memory")
#define PG8_BAR __builtin_amdgcn_s_barrier()
#define PG8_SCHED __builtin_amdgcn_sched_barrier(0)
    Unit cur, nxt; int ui = 0;
    if (!S.next(0, cur)) return;
    f32x4 acc[2][2][4][2];
#pragma unroll
    for (int a = 0; a < 2; ++a)
#pragma unroll
        for (int b = 0; b < 2; ++b)
#pragma unroll
            for (int m = 0; m < 4; ++m)
#pragma unroll
                for (int n = 0; n < 2; ++n) acc[a][b][m][n] = (f32x4){0.f, 0.f, 0.f, 0.f};
    bf16x8 At[4][2], B0[2][2], B1[2][2];
    const char* cA = cur.A; const char* cB = cur.B;
    PG8_STAGE(PG8_SB(0, 0), cB, voffB); PG8_STAGE(PG8_SB(0, 1), cB + hstepB, voffB); PG8_STAGE(PG8_SA(0, 0), cA, voffA); PG8_STAGE(PG8_SA(0, 1), cA + hstepA, voffA);
    if (wr == 1) PG8_BAR;
    PG8_WAIT_V(2); PG8_BAR;
    PG8_STAGE(PG8_SB(1, 0), cB + kstep, voffB); PG8_STAGE(PG8_SA(1, 0), cA + kstep, voffA); PG8_STAGE(PG8_SB(1, 1), cB + hstepB + kstep, voffB);
    PG8_WAIT_V(6); PG8_BAR;
    for (;;) {
        const bool has_next = S.next(ui + 1, nxt);
        const char* nA = has_next ? nxt.A : cA; const char* nB = has_next ? nxt.B : cB;
        const int nt = cur.nt;
        for (int t = 0; t < nt; t += 2) {
            const bool last = (t == nt - 2);
            const char* a1 = cA + (size_t)(t + 1) * kstep;
            const char* a2 = last ? nA : cA + (size_t)(t + 2) * kstep; const char* b2 = last ? nB : cB + (size_t)(t + 2) * kstep;
            const char* a3 = a2 + kstep; const char* b3 = b2 + kstep;
            PG8_LDB(B0, 0, 0); PG8_LDB(B1, 0, 1); PG8_SCHED; PG8_LDA(At, 0, 0); PG8_STAGE(PG8_SA(1, 1), a1 + hstepA, voffA);
            PG8_WAIT_V(8); PG8_WAIT_L(0); PG8_BAR; PG8_MMA(0, 0, At, B0); PG8_MMA(0, 1, At, B1); PG8_BAR; PG8_SCHED;
            PG8_LDA(At, 0, 1); PG8_STAGE(PG8_SB(0, 0), b2, voffB); PG8_STAGE(PG8_SB(0, 1), b2 + hstepB, voffB); PG8_STAGE(PG8_SA(0, 0), a2, voffA);
            PG8_WAIT_V(8); PG8_WAIT_L(0); PG8_BAR; PG8_MMA(1, 0, At, B0); PG8_MMA(1, 1, At, B1); PG8_BAR; PG8_SCHED;
            PG8_LDB(B0, 1, 0); PG8_LDB(B1, 1, 1); PG8_SCHED; PG8_LDA(At, 1, 0); PG8_STAGE(PG8_SA(0, 1), a2 + hstepA, voffA);
            PG8_WAIT_V(8); PG8_WAIT_L(0); PG8_BAR; PG8_MMA(0, 0, At, B0); PG8_MMA(0, 1, At, B1); PG8_BAR; PG8_SCHED;
            PG8_LDA(At, 1, 1); PG8_STAGE(PG8_SB(1, 0), b3, voffB); PG8_STAGE(PG8_SB(1, 1), b3 + hstepB, voffB); PG8_STAGE(PG8_SA(1, 0), a3, voffA);
            PG8_WAIT_V(8); PG8_WAIT_L(0); PG8_BAR; PG8_MMA(1, 0, At, B0); PG8_MMA(1, 1, At, B1); PG8_BAR; PG8_SCHED;
            if constexpr (Epi::HAS_MID) { if (t + 2 == 8 || t + 2 == 16) { E.mid(acc, cur, t + 2, wr, wc, fr, fq); PG8_SCHED; } }
        }
        if (wr == 0) PG8_BAR;
        E(acc, cur, wr, wc, fr, fq);
        if (!has_next) break;
#pragma unroll
        for (int a = 0; a < 2; ++a)
#pragma unroll
            for (int b = 0; b < 2; ++b)
#pragma unroll
                for (int m = 0; m < 4; ++m)
#pragma unroll
                    for (int n = 0; n < 2; ++n) acc[a][b][m][n] = (f32x4){0.f, 0.f, 0.f, 0.f};
        cur = nxt; cA = nA; cB = nB; ++ui;
        if (wr == 1) PG8_BAR;
    }
    PG8_WAIT_V(0);
    PG8_BAR;
#undef PG8_SA
#undef PG8_SB
#undef PG8_STAGE
#undef PG8_LDA
#undef PG8_LDB
#undef PG8_MMA
#undef PG8_WAIT_V
#undef PG8_WAIT_L
#undef PG8_BAR
#undef PG8_SCHED
}
}

struct Frame {
    LAS unsigned char* lds;
    volatile LAS unsigned* MISC;
    unsigned* ctl;
    int tid, lane, wave, G, bid;
    const float* const __attribute__((address_space(4)))* in;
    float* out; unsigned char* ws;
};
enum { IN_X = 0, IN_NORM1, IN_WIN, IN_BGATE, IN_LRE, IN_LIM, IN_BRE, IN_BIM, IN_CRE, IN_CIM, IN_S5D, IN_LOGDT, IN_GLU1, IN_GLU2, IN_QG, IN_KG, IN_SINK,
       IN_CONVW, IN_CONVB, IN_DTB, IN_ALOG, IN_SSDD, IN_SSDG, IN_PS5, IN_PATTN, IN_PSSD, IN_WOUT, IN_NORM2, IN_WRG, IN_BRG, IN_WRE, IN_BRE_, IN_EG, IN_EU, IN_ED, N_INPUTS };

#define LDS_WAIT() asm volatile("s_waitcnt lgkmcnt(0)" ::: "memory")
#define VM_WAIT() asm volatile("s_waitcnt vmcnt(0)" ::: "memory")

using pg8::Unit; using pg8::pack8;
struct EpiProj {
    static constexpr bool PERM = true, HAS_MID = false;
    unsigned char* ws; const float* bgate;
    __device__ __forceinline__ void operator()(const f32x4 (&acc)[2][2][4][2], const Unit& u, int wr, int wc, int fr, int fq) const {
        bf16_t* P = (bf16_t*)(ws + WS_P); bf16_t* UH = (bf16_t*)(ws + WS_UH); float* DT = (float*)(ws + WS_DT);
        const int row0 = u.pm * 256 + wr * 64 + fr;
        if (u.pn < 2) {
#pragma unroll
            for (int ai = 0; ai < 2; ++ai)
#pragma unroll
                for (int m = 0; m < 4; ++m) { const int row = row0 + ai * 128 + m * 16, r = row >> 5, s = row & 31;
#pragma unroll
                    for (int bj = 0; bj < 2; ++bj) { const int col = u.pn * 256 + bj * 128 + wc * 32 + 8 * fq, g = col >> 4, c0 = col & 15;
                        *(u32x4*)(UH + ((size_t)(g * S5_ROWS + r) * S5_K + 128 + s * 16 + c0)) = pack8(acc[ai][bj][m][0], acc[ai][bj][m][1]); } }
        } else {
            const int colb = u.pn * 256 + wc * 32 + 8 * fq;
            f32x4 bv[2][2];
#pragma unroll
            for (int bj = 0; bj < 2; ++bj)
#pragma unroll
                for (int n = 0; n < 2; ++n) bv[bj][n] = (u.pn >= 15) ? *(const f32x4*)(bgate + (colb - C_G) + bj * 128 + 4 * n) : (f32x4){0.f, 0.f, 0.f, 0.f};
#pragma unroll
            for (int ai = 0; ai < 2; ++ai)
#pragma unroll
                for (int m = 0; m < 4; ++m) { const int row = row0 + ai * 128 + m * 16;
#pragma unroll
                    for (int bj = 0; bj < 2; ++bj) { f32x4 v0 = acc[ai][bj][m][0] + bv[bj][0], v1 = acc[ai][bj][m][1] + bv[bj][1];
                        if (u.pn >= 15) {
#pragma unroll
                            for (int j = 0; j < 4; ++j) { v0[j] = fmaxf(sigmoidf_(v0[j]), 1e-30f); v1[j] = fmaxf(sigmoidf_(v1[j]), 1e-30f); } }
                        *(u32x4*)(P + (size_t)row * NINP + colb + bj * 128) = pack8(v0, v1); }
                    if (u.pn == 14 && wc == 0 && fq < 2) { float* d = DT + (size_t)row * 16 + 8 * fq; *(f32x4*)d = acc[ai][0][m][0]; *(f32x4*)(d + 4) = acc[ai][0][m][1]; } }
        }
    }
};
struct EpiHloc {
    static constexpr bool PERM = false, HAS_MID = false;
    float* H;
    __device__ __forceinline__ void operator()(const f32x4 (&acc)[2][2][4][2], const Unit& u, int wr, int wc, int fr, int fq) const {
#pragma unroll
        for (int ai = 0; ai < 2; ++ai)
#pragma unroll
            for (int m = 0; m < 4; ++m) { const int r = u.pm * 256 + ai * 128 + wr * 64 + m * 16 + fr; float* rowp = H + ((size_t)(u.aux * S5_ROWS + r) * 128) + wc * 32 + 4 * fq;
#pragma unroll
                for (int n = 0; n < 2; ++n) *(f32x4*)(rowp + 16 * n) = acc[ai][0][m][n]; }
    }
};
struct EpiS5Y {
    static constexpr bool PERM = true, HAS_MID = false;
    bf16_t* Y;
    __device__ __forceinline__ void operator()(const f32x4 (&acc)[2][2][4][2], const Unit& u, int wr, int wc, int fr, int fq) const {
#pragma unroll
        for (int ai = 0; ai < 2; ++ai)
#pragma unroll
            for (int m = 0; m < 4; ++m) { const int r = u.pm * 256 + ai * 128 + wr * 64 + m * 16 + fr;
#pragma unroll
                for (int bj = 0; bj < 2; ++bj) { const int n0 = u.pn * 256 + bj * 128 + wc * 32 + 8 * fq, t = n0 >> 4, c0 = n0 & 15;
                    f32x4 v0 = acc[ai][bj][m][0], v1 = acc[ai][bj][m][1];
#pragma unroll
                    for (int j = 0; j < 4; ++j) { v0[j] = gelu_tanh_(v0[j]); v1[j] = gelu_tanh_(v1[j]); }
                    *(u32x4*)(Y + ((size_t)(r * S5_TC + t) * 512 + u.aux * 16 + c0)) = pack8(v0, v1); } }
    }
};
struct EpiGlu {
    static constexpr bool PERM = true, HAS_MID = false;
    bf16_t* Y;
    __device__ __forceinline__ void operator()(const f32x4 (&acc)[2][2][4][2], const Unit& u, int wr, int wc, int fr, int fq) const {
#pragma unroll
        for (int ai = 0; ai < 2; ++ai)
#pragma unroll
            for (int m = 0; m < 4; ++m) { const int row = u.pm * 256 + ai * 128 + wr * 64 + m * 16 + fr;
                f32x4 v0 = acc[ai][0][m][0], v1 = acc[ai][0][m][1]; const f32x4 g0 = acc[ai][1][m][0], g1 = acc[ai][1][m][1];
#pragma unroll
                for (int j = 0; j < 4; ++j) { v0[j] *= sigmoidf_(g0[j]); v1[j] *= sigmoidf_(g1[j]); }
                *(u32x4*)(Y + (size_t)row * 2048 + u.pn * 128 + wc * 32 + 8 * fq) = pack8(v0, v1); }
    }
};
struct EpiSwiGlu {
    static constexpr bool PERM = true, HAS_MID = false;
    bf16_t* Y; const float* RSG;
    __device__ __forceinline__ void operator()(const f32x4 (&acc)[2][2][4][2], const Unit& u, int wr, int wc, int fr, int fq) const {
#pragma unroll
        for (int ai = 0; ai < 2; ++ai)
#pragma unroll
            for (int m = 0; m < 4; ++m) { const int row = u.pm * 256 + ai * 128 + wr * 64 + m * 16 + fr;
                f32x4 v0 = acc[ai][0][m][0], v1 = acc[ai][0][m][1]; const f32x4 g0 = acc[ai][1][m][0], g1 = acc[ai][1][m][1]; const float rr = 1.f;
#pragma unroll
                for (int j = 0; j < 4; ++j) { v0[j] = siluf_(v0[j] * rr) * (g0[j] * rr); v1[j] = siluf_(v1[j] * rr) * (g1[j] * rr); }
                *(u32x4*)(Y + (size_t)row * 512 + u.pn * 128 + wc * 32 + 8 * fq) = pack8(v0, v1); }
    }
};
struct EpiPlainBf16 {
    static constexpr bool PERM = true, HAS_MID = false;
    bf16_t* O;
    __device__ __forceinline__ void operator()(const f32x4 (&acc)[2][2][4][2], const Unit& u, int wr, int wc, int fr, int fq) const {
#pragma unroll
        for (int ai = 0; ai < 2; ++ai)
#pragma unroll
            for (int m = 0; m < 4; ++m) { const int row = u.pm * 256 + ai * 128 + wr * 64 + m * 16 + fr;
#pragma unroll
                for (int bj = 0; bj < 2; ++bj) *(u32x4*)(O + (size_t)row * 1024 + u.pn * 256 + bj * 128 + wc * 32 + 8 * fq) = pack8(acc[ai][bj][m][0], acc[ai][bj][m][1]); }
    }
};
struct EpiMerged {
    static constexpr bool PERM = true, HAS_MID = true;
    unsigned char* ws;
    __device__ __forceinline__ static float lclamp(float l) { return fminf(fmaxf(l, -30.f), 30.f); }
    __device__ __forceinline__ void mid(f32x4 (&acc)[2][2][4][2], const Unit& u, int kt, int wr, int wc, int fr, int fq) const {
        const int br = (kt == 8) ? 0 : 1; const bf16_t* P = (const bf16_t*)(ws + WS_P);
#pragma unroll
        for (int ai = 0; ai < 2; ++ai)
#pragma unroll
            for (int m = 0; m < 4; ++m) { const int row = u.pm * 256 + ai * 128 + wr * 64 + m * 16 + fr;
#pragma unroll
                for (int bj = 0; bj < 2; ++bj) { const bf16_t* gp = P + (size_t)row * NINP + C_G + br * 1024 + u.pn * 256 + bj * 128 + wc * 32 + 8 * fq;
                    const u32x4 la = *(const u32x4*)gp, lb = *(const u32x4*)(gp + 1024);
#pragma unroll
                    for (int j = 0; j < 4; ++j) { const unsigned wa = la[j], wb = lb[j];
                        const float r0 = bflo(wa) * frcp(bflo(wb)), r1 = bfhi(wa) * frcp(bfhi(wb));
                        if (j < 2) { acc[ai][bj][m][0][2 * j] *= r0; acc[ai][bj][m][0][2 * j + 1] *= r1; } else { acc[ai][bj][m][1][2 * j - 4] *= r0; acc[ai][bj][m][1][2 * j - 3] *= r1; } } }
                if (m == 3) asm volatile("" ::: "memory"); }
    }
    __device__ __forceinline__ void operator()(const f32x4 (&acc)[2][2][4][2], const Unit& u, int wr, int wc, int fr, int fq) const {
        const bf16_t* P = (const bf16_t*)(ws + WS_P); bf16_t* O = (bf16_t*)(ws + WS_XN);
#pragma unroll
        for (int ai = 0; ai < 2; ++ai)
#pragma unroll
            for (int m = 0; m < 4; ++m) { const int row = u.pm * 256 + ai * 128 + wr * 64 + m * 16 + fr;
#pragma unroll
                for (int bj = 0; bj < 2; ++bj) { const int col = u.pn * 256 + bj * 128 + wc * 32 + 8 * fq;
                    const u32x4 lc = *(const u32x4*)(P + (size_t)row * NINP + C_G + 2048 + col);
                    f32x4 v0 = acc[ai][bj][m][0], v1 = acc[ai][bj][m][1];
                    v0[0] *= bflo(lc[0]); v0[1] *= bfhi(lc[0]); v0[2] *= bflo(lc[1]); v0[3] *= bfhi(lc[1]);
                    v1[0] *= bflo(lc[2]); v1[1] *= bfhi(lc[2]); v1[2] *= bflo(lc[3]); v1[3] *= bfhi(lc[3]);
                    *(u32x4*)(O + (size_t)row * 1024 + col) = pack8(v0, v1); }
                if (m == 3) asm volatile("" ::: "memory"); }
    }
};
struct EpiResid {
    static constexpr bool PERM = false, HAS_MID = false;
    const float* resid; float* out;
    __device__ __forceinline__ void operator()(const f32x4 (&acc)[2][2][4][2], const Unit& u, int wr, int wc, int fr, int fq) const {
#pragma unroll
        for (int ai = 0; ai < 2; ++ai)
#pragma unroll
            for (int m = 0; m < 4; ++m) { const size_t off = (size_t)(u.pm * 256 + ai * 128 + wr * 64 + m * 16 + fr) * 1024 + u.pn * 256 + wc * 32 + 4 * fq;
#pragma unroll
                for (int bj = 0; bj < 2; ++bj)
#pragma unroll
                    for (int n = 0; n < 2; ++n) { const f32x4 rv = *(const f32x4*)(resid + off + bj * 128 + n * 16); *(f32x4*)(out + off + bj * 128 + n * 16) = rv + acc[ai][bj][m][n]; } }
    }
};

template <unsigned lda, unsigned ldb, int nM, int nN, int NT>
struct SchedDense {
    const char* A; const char* B; int G, c;
    __device__ __forceinline__ bool next(int i, Unit& u) const {
        const int L = i * G + c; if (L >= nM * nN) return false;
        int pm, pn; pg8::tile_order(L, nM, nN, pm, pn);
        u.A = A + (size_t)pm * 256 * lda; u.B = B + (size_t)pn * 256 * ldb; u.nt = NT; u.pm = pm; u.pn = pn; u.aux = 0; return true;
    }
};
struct SchedS5P1 {
    const char* UH; const char* EG; int G, c;
    __device__ __forceinline__ bool next(int i, Unit& u) const {
        const int L = i * G + c; if (L >= 64) return false;
        const int g = L >> 1, pm = L & 1;
        u.A = UH + ((size_t)(g * S5_ROWS + pm * 256) * S5_K + 128) * 2; u.B = EG + (size_t)g * 256 * 512 * 2; u.nt = 8; u.pm = pm; u.pn = 0; u.aux = g; return true;
    }
};
struct SchedS5Main {
    const char* UH; const char* MG; int G, c;
    __device__ __forceinline__ bool next(int i, Unit& u) const {
        const int L = i * G + c; if (L >= 128) return false;
        const int g = L >> 2, pm = (L >> 1) & 1, pn = L & 1;
        u.A = UH + (size_t)(g * S5_ROWS + pm * 256) * S5_K * 2; u.B = MG + (size_t)(g * S5_N + pn * 256) * S5_K * 2; u.nt = 2 + 4 * (pn + 1); u.pm = pm; u.pn = pn; u.aux = g; return true;
    }
};
template <unsigned lda, size_t bexp  , size_t btile  , int NT>
struct SchedMoe {
    const char* A; const char* B; int ntiles, G, c; const volatile LAS int* tile_e;
    __device__ __forceinline__ bool next(int i, Unit& u) const {
        const int L = i * G + c; if (L >= ntiles * 4) return false;
        int pm, pn; pg8::tile_order(L, ntiles, 4, pm, pn);
        const int e = __builtin_amdgcn_readfirstlane(tile_e[pm]);
        u.A = A + (size_t)pm * 256 * lda; u.B = B + (size_t)e * bexp + (size_t)pn * btile; u.nt = NT; u.pm = pm; u.pn = pn; u.aux = e; return true;
    }
};

__device__ __forceinline__ void transpose_item(const float* W, int ldw, int ncols, bf16_t* WT, int ldt, int kofs, int mode, int p0, int p1, LAS float* scr, int k0, int n0, int lane) {
    float wv[32];
#pragma unroll
    for (int i = 0; i < 32; ++i) { const int kk = 2 * i + (lane >> 5), n = n0 + (lane & 31); wv[i] = (n < ncols) ? W[(size_t)(k0 + kk) * ldw + n] : 0.f; }
#pragma unroll
    for (int i = 0; i < 32; ++i) { const int kk = 2 * i + (lane >> 5); scr[kk * 33 + (lane & 31)] = wv[i]; }
    LDS_WAIT(); asm volatile("" ::: "memory");
    const int c = lane & 7;
#pragma unroll
    for (int j = 0; j < 4; ++j) { const int nn = (lane >> 3) + 8 * j, n = n0 + nn; const LAS float* s = scr + (8 * c) * 33 + nn;
        u32x4 o; o.x = pk2(s[0 * 33], s[1 * 33]); o.y = pk2(s[2 * 33], s[3 * 33]); o.z = pk2(s[4 * 33], s[5 * 33]); o.w = pk2(s[6 * 33], s[7 * 33]);
        const int drow = (mode == 0) ? n + (n >= p0 ? p1 : 0) : ((n >> 7) * 256 + (n & 127) + 128 * p0);
        if (n < ncols) *(u32x4*)(WT + (size_t)drow * ldt + kofs + k0 + 8 * c) = o; }
    LDS_WAIT(); asm volatile("" ::: "memory");
}
__device__ __forceinline__ void convert_weights(Frame& F, int layer) {
    LAS float* scr = (LAS float*)(F.lds + F.wave * 16384);
    const int gw = F.bid * NWAVES + F.wave, NGW = F.G * NWAVES;
    bf16_t* WIN = (bf16_t*)(F.ws + WS_WIN); bf16_t* WGLU = (bf16_t*)(F.ws + WS_WGLU); bf16_t* PCAT = (bf16_t*)(F.ws + WS_PCAT); bf16_t* WOUT = (bf16_t*)(F.ws + WS_WOUT);
    bf16_t* EGU = (bf16_t*)(F.ws + WS_EGU); bf16_t* EDN = (bf16_t*)(F.ws + WS_EDN);
    constexpr int I_WIN = 16 * 209, I_GLU = 8 * 16, I_P5 = 8 * 32, I_PS = 16 * 32, I_WO = 16 * 32, I_EG = 32 * 256, I_ED = 32 * 256;
    constexpr int NITEMS = I_WIN + 2 * I_GLU + 2 * I_P5 + I_PS + I_WO + 2 * I_EG + I_ED;
    for (int it = gw; it < NITEMS; it += NGW) {
        int r = it;
        if (r < I_WIN) { transpose_item(F.in[IN_WIN] + (size_t)layer * DM * NIN, NIN, NIN, WIN, DM, 0, 0, 3600, 240, scr, 64 * (r / 209), 32 * (r % 209), F.lane); continue; } r -= I_WIN;
        if (r < I_GLU) { transpose_item(F.in[IN_GLU1] + (size_t)layer * 512 * 512, 512, 512, WGLU, 512, 0, 1, 0, 0, scr, 64 * (r / 16), 32 * (r % 16), F.lane); continue; } r -= I_GLU;
        if (r < I_GLU) { transpose_item(F.in[IN_GLU2] + (size_t)layer * 512 * 512, 512, 512, WGLU, 512, 0, 1, 1, 0, scr, 64 * (r / 16), 32 * (r % 16), F.lane); continue; } r -= I_GLU;
        if (r < I_P5) { transpose_item(F.in[IN_PS5] + (size_t)layer * 512 * 1024, 1024, 1024, PCAT, 2048, 0, 0, 1 << 30, 0, scr, 64 * (r / 32), 32 * (r % 32), F.lane); continue; } r -= I_P5;
        if (r < I_P5) { transpose_item(F.in[IN_PATTN] + (size_t)layer * 512 * 1024, 1024, 1024, PCAT, 2048, 512, 0, 1 << 30, 0, scr, 64 * (r / 32), 32 * (r % 32), F.lane); continue; } r -= I_P5;
        if (r < I_PS) { transpose_item(F.in[IN_PSSD] + (size_t)layer * 1024 * 1024, 1024, 1024, PCAT, 2048, 1024, 0, 1 << 30, 0, scr, 64 * (r / 32), 32 * (r % 32), F.lane); continue; } r -= I_PS;
        if (r < I_WO) { transpose_item(F.in[IN_WOUT] + (size_t)layer * 1024 * 1024, 1024, 1024, WOUT, 1024, 0, 0, 1 << 30, 0, scr, 64 * (r / 32), 32 * (r % 32), F.lane); continue; } r -= I_WO;
        if (r < I_EG) { const int e = r >> 8, q = r & 255; transpose_item(F.in[IN_EG] + ((size_t)layer * 32 + e) * 1024 * 512, 512, 512, EGU + (size_t)e * 1024 * 1024, 1024, 0, 1, 0, 0, scr, 64 * (q / 16), 32 * (q % 16), F.lane); continue; } r -= I_EG;
        if (r < I_EG) { const int e = r >> 8, q = r & 255; transpose_item(F.in[IN_EU] + ((size_t)layer * 32 + e) * 1024 * 512, 512, 512, EGU + (size_t)e * 1024 * 1024, 1024, 0, 1, 1, 0, scr, 64 * (q / 16), 32 * (q % 16), F.lane); continue; } r -= I_EG;
        { const int e = r >> 8, q = r & 255; transpose_item(F.in[IN_ED] + ((size_t)layer * 32 + e) * 512 * 1024, 1024, 1024, EDN + (size_t)e * 1024 * 512, 512, 0, 0, 1 << 30, 0, scr, 64 * (q / 32), 32 * (q % 32), F.lane); }
    }
}
__device__ __forceinline__ void sincos_fast(float x, float& s, float& c) {
    const float k = rintf(x * 0.15915494309189535f);
    float r = fmaf(-k, 6.2831854820251465f, x); r = fmaf(-k, -1.7484555e-07f, r);
    s = __sinf(r); c = __cosf(r);
}
__device__ __forceinline__ void sincos_red(float x, float& s, float& c) {
    const float k = rintf(x * 0.15915494309189535f);
    float r = fmaf(-k, 6.2831854820251465f, x); r = fmaf(-k, -1.7484555e-07f, r);
    s = sinf(r); c = cosf(r);
}
__device__ __forceinline__ void s5_build(Frame& F, int layer) {
    LAS float* pw = (LAS float*)F.lds;
    LAS float* Bb = pw + 33 * 64 * 2;
    LAS float* Cc = Bb + 64 * 16 * 2;
    LAS float* Kd = Cc + 16 * 64 * 2;
    bf16_t* MG = (bf16_t*)(F.ws + WS_MG); bf16_t* EG = (bf16_t*)(F.ws + WS_EG);
    for (int w = F.bid; w < 256; w += F.G) {
        const int g = w >> 3, part = w & 7, gi = layer * 32 + g;
        __syncthreads();
        const float dt = __expf(F.in[IN_LOGDT][gi]);
        for (int i = F.tid; i < 33 * 64; i += NTHR) { const int d = i >> 6, p = i & 63; const float lr = F.in[IN_LRE][gi * 64 + p], li = F.in[IN_LIM][gi * 64 + p];
            float s, c; sincos_red((float)d * li * dt, s, c); const float mg = __expf((float)d * lr * dt); pw[2 * i] = mg * c; pw[2 * i + 1] = mg * s; }
        for (int i = F.tid; i < 64 * 16; i += NTHR) { const int p = i >> 4; const float lr = F.in[IN_LRE][gi * 64 + p], li = F.in[IN_LIM][gi * 64 + p];
            float s, c; sincos_red(li * dt, s, c); const float mg = __expf(lr * dt), are = mg * c, aim = mg * s, nr = are - 1.f, den = lr * lr + li * li;
            const float fre = (nr * lr + aim * li) / den, fim = (aim * lr - nr * li) / den;
            const float br = F.in[IN_BRE][(size_t)gi * 1024 + i], bi = F.in[IN_BIM][(size_t)gi * 1024 + i];
            Bb[2 * i] = fre * br - fim * bi; Bb[2 * i + 1] = fre * bi + fim * br; }
        for (int i = F.tid; i < 16 * 64; i += NTHR) { Cc[2 * i] = F.in[IN_CRE][(size_t)gi * 1024 + i]; Cc[2 * i + 1] = F.in[IN_CIM][(size_t)gi * 1024 + i]; }
        __syncthreads();
        { const int d = F.tid >> 4, c = F.tid & 15; float acc[16];
#pragma unroll
          for (int j = 0; j < 16; ++j) acc[j] = 0.f;
          for (int p = 0; p < 64; ++p) { const float cr = Cc[2 * (c * 64 + p)], ci = Cc[2 * (c * 64 + p) + 1], pr = pw[2 * (d * 64 + p)], pi = pw[2 * (d * 64 + p) + 1];
              const float xr = cr * pr - ci * pi, xi = cr * pi + ci * pr;
#pragma unroll
              for (int q = 0; q < 8; ++q) { const f32x4 bb = *(const LAS f32x4*)(Bb + 2 * (p * 16) + 4 * q); acc[2 * q] += xr * bb.x - xi * bb.y; acc[2 * q + 1] += xr * bb.z - xi * bb.w; } }
#pragma unroll
          for (int j = 0; j < 16; ++j) Kd[(d * 16 + c) * 16 + j] = acc[j]; }
        __syncthreads();
        for (int v = F.tid; v < 64 * 80; v += NTHR) { const int n = part * 64 + v / 80, k0 = (v % 80) * 8, t = n >> 4, c = n & 15; float o[8];
            if (k0 < 128) { const int im = k0 >= 64, p0 = k0 & 63;
#pragma unroll
                for (int j = 0; j < 8; ++j) { const int p = p0 + j; const float cr = Cc[2 * (c * 64 + p)], ci = Cc[2 * (c * 64 + p) + 1], pr = pw[2 * ((t + 1) * 64 + p)], pi = pw[2 * ((t + 1) * 64 + p) + 1];
                    o[j] = im ? -(cr * pi + ci * pr) : (cr * pr - ci * pi); }
            } else { const int s = (k0 - 128) >> 4, c0 = (k0 - 128) & 15;
#pragma unroll
                for (int j = 0; j < 8; ++j) { float x = 0.f; if (s <= t) { x = Kd[(t - s) * 256 + c * 16 + c0 + j]; if (s == t && c == c0 + j) x += F.in[IN_S5D][layer * 512 + g * 16 + c]; } o[j] = x; } }
            u32x4 q; q.x = pk2(o[0], o[1]); q.y = pk2(o[2], o[3]); q.z = pk2(o[4], o[5]); q.w = pk2(o[6], o[7]);
            *(u32x4*)(MG + ((size_t)(g * S5_N + n) * S5_K + k0)) = q; }
        for (int v = F.tid; v < 16 * 64; v += NTHR) { const int jr = part * 16 + v / 64, k0 = (v % 64) * 8, im = jr >= 64, p = jr & 63, s = k0 >> 4, c0 = k0 & 15; float o[8];
            const float pr = pw[2 * ((S5_TC - 1 - s) * 64 + p)], pi = pw[2 * ((S5_TC - 1 - s) * 64 + p) + 1];
#pragma unroll
            for (int j = 0; j < 8; ++j) { const float br = Bb[2 * (p * 16 + c0 + j)], bi = Bb[2 * (p * 16 + c0 + j) + 1]; o[j] = im ? (pr * bi + pi * br) : (pr * br - pi * bi); }
            u32x4 q; q.x = pk2(o[0], o[1]); q.y = pk2(o[2], o[3]); q.z = pk2(o[4], o[5]); q.w = pk2(o[6], o[7]);
            *(u32x4*)(EG + ((size_t)(g * 256 + jr) * 512 + k0)) = q; }
    }
    __syncthreads();
}
__device__ __forceinline__ void rms_row_to_bf16(const float* xrow, const float* gain, bf16_t* orow, int lane) {
    const f32x4* xr = (const f32x4*)xrow + lane; const f32x4* gr = (const f32x4*)gain + lane;
    f32x4 v[4]; float s = 0.f;
#pragma unroll
    for (int j = 0; j < 4; ++j) { v[j] = xr[64 * j]; s += (v[j].x * v[j].x + v[j].y * v[j].y) + (v[j].z * v[j].z + v[j].w * v[j].w); }
    const float rstd = __builtin_amdgcn_rsqf(wave_sum(s) * (1.f / DM) + NORM_EPS);
    unsigned long long* o8 = (unsigned long long*)orow + lane;
#pragma unroll
    for (int j = 0; j < 4; ++j) { const f32x4 gv = gr[64 * j]; o8[64 * j] = (unsigned long long)pk2(v[j].x * rstd * gv.x, v[j].y * rstd * gv.y) | ((unsigned long long)pk2(v[j].z * rstd * gv.z, v[j].w * rstd * gv.w) << 32); }
}
__device__ __forceinline__ void rmsnorm_rows(Frame& F, const float* x, const float* gain, bf16_t* o) {
    const int gw = F.bid * NWAVES + F.wave, NGW = F.G * NWAVES;
    for (int m = gw; m < T; m += NGW) rms_row_to_bf16(x + (size_t)m * DM, gain, o + (size_t)m * DM, F.lane);
}

__device__ __forceinline__ void s5_scan(Frame& F, int layer) {
    const float* HL = (const float*)(F.ws + WS_HLOC); bf16_t* UH = (bf16_t*)(F.ws + WS_UH);
    for (int i = (F.G - 1 - F.bid) * NTHR + F.tid; i < BATCH * 32 * 64; i += F.G * NTHR) {
        const int p = i & 63, g = (i >> 6) & 31, b = i >> 11, gi = layer * 32 + g;
        const float dt = __expf(F.in[IN_LOGDT][gi]), lr = F.in[IN_LRE][gi * 64 + p], li = F.in[IN_LIM][gi * 64 + p];
        float s, c; sincos_red((float)S5_TC * li * dt, s, c); const float mg = __expf((float)S5_TC * lr * dt), ar = mg * c, ai = mg * s;
        float hr = 0.f, hi = 0.f;
        const int nch = SEQ / S5_TC;
        for (int c0 = 0; c0 < nch; c0 += 32) { float lr_[32], li_[32];
#pragma unroll
            for (int k = 0; k < 32; ++k) { const size_t r = (size_t)g * S5_ROWS + b * nch + c0 + k; lr_[k] = HL[r * 128 + p]; li_[k] = HL[r * 128 + 64 + p]; }
#pragma unroll
            for (int k = 0; k < 32; ++k) { const size_t r = (size_t)g * S5_ROWS + b * nch + c0 + k;
                UH[r * S5_K + p] = (bf16_t)f2bf(hr); UH[r * S5_K + 64 + p] = (bf16_t)f2bf(hi);
                const float nr = ar * hr - ai * hi + lr_[k], ni = ar * hi + ai * hr + li_[k]; hr = nr; hi = ni; } }
    }
}

__device__ __forceinline__ void ssd_stage_bc(Frame& F, int layer, int b, int ch, int grp, LAS float* Bs, LAS float* Cs, LAS float* dts, LAS float* das) {
    const bf16_t* P = (const bf16_t*)(F.ws + WS_P); const float* DT = (const float*)(F.ws + WS_DT);
    const float* cw = F.in[IN_CONVW] + layer * 4 * 1280; const float* cb = F.in[IN_CONVB] + layer * 1280;
    const int l0 = ch * 128; const size_t row0 = (size_t)b * SEQ + l0;
    for (int i = F.tid; i < 2 * 128 * 64; i += NTHR) { const int isC = i >> 13, t = (i >> 6) & 127, n = i & 63;
        const int col = (isC ? C_C : C_B) + grp * 64 + n, cc = 1024 + isC * 128 + grp * 64 + n; float a = cb[cc];
#pragma unroll
        for (int j = 0; j < 4; ++j) { const int l = l0 + t - 3 + j; if (l >= 0) a += cw[j * 1280 + cc] * bf2f(P[(row0 + t - 3 + j) * NINP + col]); }
        (isC ? Cs : Bs)[t * 64 + n] = siluf_(a); }
    for (int i = F.tid; i < 128 * 8; i += NTHR) { const int t = i >> 3, hh = i & 7, h = grp * 8 + hh;
        const float dt = softplusf_(DT[(row0 + t) * 16 + h] + F.in[IN_DTB][layer * 16 + h]); dts[i] = dt; das[i] = dt * (-__expf(F.in[IN_ALOG][layer * 16 + h])); }
}
template <bool OUT>
__device__ __forceinline__ void ssd_units(Frame& F, int layer) {
    LAS float* Bs = (LAS float*)F.lds; LAS float* Cs = Bs + 128 * 64; LAS float* dts = Cs + 128 * 64; LAS float* das = dts + 128 * 8; LAS float* ssq = das + 128 * 8;
    const bf16_t* P = (const bf16_t*)(F.ws + WS_P); float* SST = (float*)(F.ws + WS_SST); float* ASUM = (float*)(F.ws + WS_ASUM); bf16_t* YC = (bf16_t*)(F.ws + WS_YCAT);
    const float* cw = F.in[IN_CONVW] + layer * 4 * 1280; const float* cb = F.in[IN_CONVB] + layer * 1280;
    for (int u = F.bid; u < BATCH * SSD_NCH * 2; u += F.G) {
        const int grp = u & 1, ch = (u >> 1) & 31, b = u >> 6;
        __syncthreads();
        ssd_stage_bc(F, layer, b, ch, grp, Bs, Cs, dts, das);
        __syncthreads();
        const int hh = F.wave, h = grp * 8 + hh, p = F.lane, cx = h * 64 + p;
        const float w0 = cw[cx], w1 = cw[1280 + cx], w2 = cw[2560 + cx], w3 = cw[3840 + cx], bias = cb[cx], dsk = F.in[IN_SSDD][layer * 16 + h];
        const int l0 = ch * 128; const size_t row0 = (size_t)b * SEQ + l0;
        const bf16_t* xp = P + row0 * NINP + C_XS + cx;
        float x0 = 0.f, x1 = 0.f, x2 = 0.f;
        if (l0 > 0) { x0 = bf2f(xp[-3 * (ptrdiff_t)NINP]); x1 = bf2f(xp[-2 * (ptrdiff_t)NINP]); x2 = bf2f(xp[-1 * (ptrdiff_t)NINP]); }
        float st[64];
        float* sp = SST + ((((size_t)b * SSD_NCH + ch) * 16 + h) * 64 + p) * 64;
        if (OUT) {
#pragma unroll
            for (int n = 0; n < 64; n += 4) { const f32x4 v = *(const f32x4*)(sp + n); st[n] = v.x; st[n + 1] = v.y; st[n + 2] = v.z; st[n + 3] = v.w; }
        } else {
#pragma unroll
            for (int n = 0; n < 64; ++n) st[n] = 0.f;
        }
        float asum = 0.f;
#pragma unroll 4
        for (int t = 0; t < 128; ++t) {
            const float x3 = bf2f(xp[(size_t)t * NINP]);
            const float xs = siluf_(bias + w0 * x0 + w1 * x1 + w2 * x2 + w3 * x3);
            x0 = x1; x1 = x2; x2 = x3;
            const float dt = dts[t * 8 + hh], a = das[t * 8 + hh], da = __expf(a), xdt = xs * dt;
            asum += a;
            float y = 0.f;
#pragma unroll
            for (int n = 0; n < 64; n += 4) { const f32x4 bv = *(const LAS f32x4*)(Bs + t * 64 + n);
                st[n] = da * st[n] + bv.x * xdt; st[n + 1] = da * st[n + 1] + bv.y * xdt; st[n + 2] = da * st[n + 2] + bv.z * xdt; st[n + 3] = da * st[n + 3] + bv.w * xdt;
                if (OUT) { const f32x4 cv = *(const LAS f32x4*)(Cs + t * 64 + n); y += (cv.x * st[n] + cv.y * st[n + 1]) + (cv.z * st[n + 2] + cv.w * st[n + 3]); } }
            if (OUT) {
                const float z = bf2f(P[(row0 + t) * NINP + C_Z + cx]);
                const float yz = (y + dsk * xs) * siluf_(z);
                const float q = wave_sum(yz * yz);
                if (p == 0) ssq[t * 8 + hh] = q;
                YC[(row0 + t) * 2048 + 1024 + cx] = (bf16_t)f2bf(yz);
            }
        }
        if (!OUT) {
#pragma unroll
            for (int n = 0; n < 64; n += 4) *(f32x4*)(sp + n) = (f32x4){st[n], st[n + 1], st[n + 2], st[n + 3]};
            if (p == 0) ASUM[((size_t)b * SSD_NCH + ch) * 16 + h] = asum;
        } else {
            __syncthreads();
            const float ng = F.in[IN_SSDG][layer * 1024 + cx];
            for (int t = 0; t < 128; ++t) { float q = 0.f;
#pragma unroll
                for (int j = 0; j < 8; ++j) q += ssq[t * 8 + j];
                const float rs = __builtin_amdgcn_rsqf(q * (1.f / 512.f) + NORM_EPS);
                bf16_t* yp = YC + (row0 + t) * 2048 + 1024 + cx; *yp = (bf16_t)f2bf(bf2f(*yp) * rs * ng); }
        }
    }
}
__device__ __forceinline__ void ssd_scan(Frame& F) {
    float* SST = (float*)(F.ws + WS_SST); const float* ASUM = (const float*)(F.ws + WS_ASUM);
    for (int i = F.bid * NTHR + F.tid; i < BATCH * 16 * 1024; i += F.G * NTHR) {
        const int pn = (i & 1023) * 4, h = (i >> 10) & 15, b = i >> 14; f32x4 s = {0.f, 0.f, 0.f, 0.f};
        f32x4 loc[SSD_NCH]; float dec[SSD_NCH];
#pragma unroll
        for (int ch = 0; ch < SSD_NCH; ++ch) { loc[ch] = *(const f32x4*)(SST + (((size_t)b * SSD_NCH + ch) * 16 + h) * 4096 + pn); dec[ch] = ASUM[((size_t)b * SSD_NCH + ch) * 16 + h]; }
#pragma unroll
        for (int ch = 0; ch < SSD_NCH; ++ch) { *(f32x4*)(SST + (((size_t)b * SSD_NCH + ch) * 16 + h) * 4096 + pn) = s; s = s * __expf(dec[ch]) + loc[ch]; }
    }
}

__device__ __forceinline__ void attn_units(Frame& F, int layer) {
    LAS float* Ks = (LAS float*)F.lds; LAS float* Vs = Ks + 256 * 64;
    const bf16_t* P = (const bf16_t*)(F.ws + WS_P); bf16_t* YC = (bf16_t*)(F.ws + WS_YCAT);
    const float* qg = F.in[IN_QG] + layer * 64; const float* kg = F.in[IN_KG] + layer * 64;
    for (int u = F.bid; u < BATCH * 32 * 2; u += F.G) {
        const int kvh = u & 1, qb = (u >> 1) & 31, b = u >> 6, q0 = qb * 128;
        int lane = F.lane; asm volatile("" : "+v"(lane));
        __syncthreads();
        for (int jr = F.wave; jr < 256; jr += NWAVES) { const int l = q0 - 128 + jr; float kv = 0.f, vv = 0.f;
            if (l >= 0) { const size_t row = (size_t)b * SEQ + l; const float x = bf2f(P[row * NINP + C_K + kvh * 64 + lane]); vv = bf2f(P[row * NINP + C_V + kvh * 64 + lane]);
                const float rs = __builtin_amdgcn_rsqf(wave_sum(x * x) * (1.f / 64.f) + NORM_EPS); const float xn = x * rs * kg[lane];
                const float other = __shfl_xor(xn, 32); const int i = lane & 31; const float inv = exp2f(-(float)i * (13.287712379549449f / 32.f));
                float s, c; sincos_fast((float)l * inv, s, c);
                kv = (lane < 32) ? (xn * c - other * s) : (xn * c + other * s); }
            Ks[jr * 64 + lane] = kv; Vs[jr * 64 + lane] = vv; }
        __syncthreads();
        const int hh = F.wave >> 1, head = kvh * 4 + hh, qi = q0 + (F.wave & 1) * 64 + lane; const size_t row = (size_t)b * SEQ + qi;
        float q[64];
        { const u32x4* qp = (const u32x4*)(P + row * NINP + C_Q + head * 64); float ss = 0.f;
#pragma unroll
          for (int j = 0; j < 8; ++j) { const u32x4 w = qp[j];
#pragma unroll
              for (int e = 0; e < 4; ++e) { q[8 * j + 2 * e] = bflo(w[e]); q[8 * j + 2 * e + 1] = bfhi(w[e]); } }
#pragma unroll
          for (int d = 0; d < 64; ++d) ss += q[d] * q[d];
          const float rs = __builtin_amdgcn_rsqf(ss * (1.f / 64.f) + NORM_EPS);
#pragma unroll
          for (int d = 0; d < 64; ++d) q[d] = q[d] * rs * qg[d];
#pragma unroll
          for (int i = 0; i < 32; ++i) { const float inv = exp2f(-(float)i * (13.287712379549449f / 32.f)); float s, c; sincos_fast((float)qi * inv, s, c);
              const float a = q[i], bq = q[i + 32]; q[i] = (a * c - bq * s) * 0.125f; q[i + 32] = (bq * c + a * s) * 0.125f; } }
        float o[64];
#pragma unroll
        for (int d = 0; d < 64; ++d) o[d] = 0.f;
        float mx = F.in[IN_SINK][layer * 8 + head], l = 1.f;
        const int qa = q0 + (F.wave & 1) * 64;
        int jlo = qa - 127 - (q0 - 128); if (q0 == 0 && jlo < 128) jlo = 128; const int jhi = qa + 63 - (q0 - 128);
        for (int jr = jlo; jr <= jhi; ++jr) { const int j = q0 - 128 + jr; const bool ok = (j <= qi) && (qi - j < 128);
            float s = 0.f;
#pragma unroll
            for (int d = 0; d < 64; d += 4) { const f32x4 kv = *(const LAS f32x4*)(Ks + jr * 64 + d); s += (q[d] * kv.x + q[d + 1] * kv.y) + (q[d + 2] * kv.z + q[d + 3] * kv.w); if ((d & 12) == 12) __builtin_amdgcn_sched_barrier(0); }
            if (ok) { const float mn = fmaxf(mx, s), al = __expf(mx - mn), pe = __expf(s - mn); l = l * al + pe; mx = mn;
#pragma unroll
                for (int d = 0; d < 64; d += 4) { const f32x4 vv = *(const LAS f32x4*)(Vs + jr * 64 + d); o[d] = o[d] * al + pe * vv.x; o[d + 1] = o[d + 1] * al + pe * vv.y; o[d + 2] = o[d + 2] * al + pe * vv.z; o[d + 3] = o[d + 3] * al + pe * vv.w; if ((d & 12) == 12) __builtin_amdgcn_sched_barrier(0); } } }
        const float il = 1.f / l; u32x4* op = (u32x4*)(YC + row * 2048 + 512 + head * 64);
#pragma unroll
        for (int j = 0; j < 8; ++j) { u32x4 w; w.x = pk2(o[8 * j] * il, o[8 * j + 1] * il); w.y = pk2(o[8 * j + 2] * il, o[8 * j + 3] * il); w.z = pk2(o[8 * j + 4] * il, o[8 * j + 5] * il); w.w = pk2(o[8 * j + 6] * il, o[8 * j + 7] * il); op[j] = w; }
    }
}

typedef short bf16x8_t __attribute__((ext_vector_type(8)));
__device__ __forceinline__ void split_hi_lo(const f32x4 a, const f32x4 b, bf16x8& hi, bf16x8& lo) {
    u32x4 h; h.x = cvtpk(a.x, a.y); h.y = cvtpk(a.z, a.w); h.z = cvtpk(b.x, b.y); h.w = cvtpk(b.z, b.w);
    u32x4 l; l.x = cvtpk(a.x - bflo(h.x), a.y - bfhi(h.x)); l.y = cvtpk(a.z - bflo(h.y), a.w - bfhi(h.y)); l.z = cvtpk(b.x - bflo(h.z), b.y - bfhi(h.z)); l.w = cvtpk(b.z - bflo(h.w), b.w - bfhi(h.w));
    hi = __builtin_bit_cast(bf16x8, h); lo = __builtin_bit_cast(bf16x8, l);
}
__device__ __forceinline__ void router_phase(Frame& F, int layer) {
    constexpr int WROW = 2064;
    LAS unsigned char* Whi = F.lds; LAS unsigned char* Wlo = F.lds + 36 * WROW;
    LAS float* part = (LAS float*)F.lds;
    volatile LAS unsigned* lcnt = (volatile LAS unsigned*)(F.lds + 148 * 1024);
    const float* wrg = F.in[IN_WRG] + (size_t)layer * 1024 * 4; const float* wre = F.in[IN_WRE] + (size_t)layer * 1024 * 32; const float* gain = F.in[IN_NORM2] + layer * 1024;
    const float* X = F.out; bf16_t* H2 = (bf16_t*)(F.ws + WS_XN);
    int* EID = (int*)(F.ws + WS_MOE); float* EW = (float*)(F.ws + WS_MOE + 128 * 1024); int* SLOT = (int*)(F.ws + WS_MOE + 256 * 1024); float* RS = (float*)(F.ws + WS_MOE + 640 * 1024);
    __syncthreads();
    for (int k = F.tid; k < 1024; k += NTHR) { const float g = gain[k]; const f32x4 wg = *(const f32x4*)(wrg + k * 4);
        float w[36]; w[0] = wg.x; w[1] = wg.y; w[2] = wg.z; w[3] = wg.w;
#pragma unroll
        for (int q = 0; q < 8; ++q) { const f32x4 v = *(const f32x4*)(wre + k * 32 + 4 * q); w[4 + 4 * q] = v.x; w[5 + 4 * q] = v.y; w[6 + 4 * q] = v.z; w[7 + 4 * q] = v.w; }
#pragma unroll
        for (int e = 0; e < 36; ++e) { const float x = w[e] * g; const unsigned h = f2bf(x); const unsigned l = f2bf(x - bf2f(h));
            *(LAS unsigned short*)(Whi + e * WROW + k * 2) = (unsigned short)h; *(LAS unsigned short*)(Wlo + e * WROW + k * 2) = (unsigned short)l; } }
    if (F.tid < 32) lcnt[F.tid] = 0u;
    __syncthreads();
    const int TPB = T / F.G;
    int lane = F.lane; asm volatile("" : "+v"(lane));
    const int mt = F.wave & 3, kh = F.wave >> 2, row = lane & 15, kg = lane >> 4;
    const int m = F.bid * TPB + 16 * mt + row;
    f32x4 acc[3] = {{0.f, 0.f, 0.f, 0.f}, {0.f, 0.f, 0.f, 0.f}, {0.f, 0.f, 0.f, 0.f}}; float ss = 0.f;
    int er[3]; er[0] = row; er[1] = 16 + row; er[2] = (32 + row < 36) ? 32 + row : 35;
    if (kh == 0)
#pragma unroll 1
    for (int kb = 0; kb < 4; ++kb) {
        f32x4 xa[8][2];
#pragma unroll
        for (int ks = 0; ks < 8; ++ks) { const float* xp = X + (size_t)m * DM + 256 * kb + 32 * ks + 8 * kg; xa[ks][0] = *(const f32x4*)xp; xa[ks][1] = *(const f32x4*)(xp + 4); }
#pragma unroll
        for (int ks = 0; ks < 8; ++ks) { const int k0 = 256 * kb + 32 * ks + 8 * kg;
            const f32x4 a = xa[ks][0], b = xa[ks][1];
            ss += (a.x * a.x + a.y * a.y) + (a.z * a.z + a.w * a.w) + (b.x * b.x + b.y * b.y) + (b.z * b.z + b.w * b.w);
            bf16x8 ah, al; split_hi_lo(a, b, ah, al);
#pragma unroll
            for (int nt = 0; nt < 3; ++nt) { const bf16x8 bh = *(const LAS bf16x8*)(Whi + er[nt] * WROW + k0 * 2), bl = *(const LAS bf16x8*)(Wlo + er[nt] * WROW + k0 * 2);
                acc[nt] = __builtin_amdgcn_mfma_f32_16x16x32_bf16(ah, bh, acc[nt], 0, 0, 0);
                acc[nt] = __builtin_amdgcn_mfma_f32_16x16x32_bf16(ah, bl, acc[nt], 0, 0, 0);
                acc[nt] = __builtin_amdgcn_mfma_f32_16x16x32_bf16(al, bh, acc[nt], 0, 0, 0); } }
    }
    ss += __shfl_xor(ss, 16); ss += __shfl_xor(ss, 32);
    __syncthreads();
    LAS float* ssq = part + 4 * 3 * 64 * 4; LAS float* lg = ssq + 128; volatile LAS int* elist = (volatile LAS int*)(lg + 64 * 40);
    if (kh == 0) {
        const float rstd_row = __builtin_amdgcn_rsqf(ss * (1.f / DM) + NORM_EPS);
        if (kg == 0) { ssq[64 + 16 * mt + row] = rstd_row; RS[m] = rstd_row; }
    }
    __syncthreads();
    { const float rs = ssq[64 + 16 * mt + row];
#pragma unroll 4
      for (int ks = 0; ks < 16; ++ks) { const int k0 = 512 * kh + 32 * ks + 8 * kg; const float* xp = X + (size_t)m * DM + k0; const f32x4 a = *(const f32x4*)xp, b = *(const f32x4*)(xp + 4);
          const f32x4 g0 = *(const f32x4*)(gain + k0), g1 = *(const f32x4*)(gain + k0 + 4);
          u32x4 hw; hw.x = cvtpk(a.x * rs * g0.x, a.y * rs * g0.y); hw.y = cvtpk(a.z * rs * g0.z, a.w * rs * g0.w); hw.z = cvtpk(b.x * rs * g1.x, b.y * rs * g1.y); hw.w = cvtpk(b.z * rs * g1.z, b.w * rs * g1.w);
          *(u32x4*)(H2 + (size_t)m * DM + k0) = hw; } }
    if (kh == 0) {
#pragma unroll
        for (int nt = 0; nt < 3; ++nt)
#pragma unroll
            for (int rg = 0; rg < 4; ++rg) { const int e = row + 16 * nt, tk = 16 * mt + 4 * kg + rg; if (e < 36) lg[tk * 40 + e] = acc[nt][rg] * ssq[64 + tk]; }
    }
    __syncthreads();
    if (F.tid < TPB) { const int tk = F.tid, mm = F.bid * TPB + tk; const LAS float* L = lg + tk * 40;
        float gl[4];
#pragma unroll
        for (int k = 0; k < 4; ++k) gl[k] = L[k] + F.in[IN_BRG][layer * 4 + k];
        int gs = 0; float gbest = gl[0];
#pragma unroll
        for (int k = 1; k < 4; ++k) if (gl[k] > gbest) { gbest = gl[k]; gs = k; }
        float den = 0.f;
#pragma unroll
        for (int k = 0; k < 4; ++k) den += __expf(gl[k] - gbest);
        const float pgrp = 1.f / den;
        float el[8];
#pragma unroll
        for (int k = 0; k < 8; ++k) el[k] = L[4 + gs * 8 + k] + F.in[IN_BRE_][layer * 32 + gs * 8 + k];
        int i0 = 0; float v0 = el[0];
#pragma unroll
        for (int k = 1; k < 8; ++k) if (el[k] > v0) { v0 = el[k]; i0 = k; }
        int i1 = -1; float v1 = -3.0e38f;
#pragma unroll
        for (int k = 0; k < 8; ++k) if (k != i0 && el[k] > v1) { v1 = el[k]; i1 = k; }
        const float e1 = __expf(v1 - v0), w0 = pgrp / (1.f + e1), w1 = pgrp * e1 / (1.f + e1);
        const int ea = gs * 8 + i0, eb = gs * 8 + i1;
        EID[2 * mm] = ea; EID[2 * mm + 1] = eb; EW[2 * mm] = w0; EW[2 * mm + 1] = w1;
        elist[2 * tk] = ea; elist[2 * tk + 1] = eb;
    }
    __syncthreads();
    if (F.tid < 32) { const int e = F.tid; int c = 0;
        for (int i = 0; i < 2 * TPB; ++i) { if (elist[i] == e) { SLOT[2 * (F.bid * TPB) + i] = c; ++c; } }
        ((unsigned*)(F.ws + WS_MOE + 512 * 1024))[(size_t)F.bid * 32 + e] = (unsigned)c; }
    __syncthreads();
}
__device__ __forceinline__ int moe_tables(Frame& F, int layer, volatile LAS int* offs, volatile LAS int* tile_e) {
    volatile LAS int* psum = offs + 256;
    const unsigned* CNTB = (const unsigned*)(F.ws + WS_MOE + 512 * 1024);
    __syncthreads();
    { const int e = F.tid & 31, part = F.tid >> 5; int tot = 0, pre = 0; const int per = (F.G + 15) / 16;
      for (int bb = part * per; bb < (part + 1) * per && bb < F.G; ++bb) { const int c = (int)CNTB[(size_t)bb * 32 + e]; tot += c; pre += (bb < F.bid) ? c : 0; }
      psum[part * 32 + e] = tot; psum[512 + part * 32 + e] = pre; }
    __syncthreads();
    if (F.tid < 64) {
        int c = 0, pre = 0;
        if (F.tid < 32) for (int part = 0; part < 16; ++part) { c += psum[part * 32 + F.tid]; pre += psum[512 + part * 32 + F.tid]; }
        const int tl = (c + 255) >> 8; int incl = tl;
#pragma unroll
        for (int o = 1; o < 32; o <<= 1) { const int v = __shfl_up(incl, o); if (F.tid >= o) incl += v; }
        const int excl = incl - tl;
        if (F.tid < 32) { offs[F.tid] = excl * 256 + pre; for (int k = 0; k < tl; ++k) tile_e[excl + k] = F.tid; }
        if (F.tid == 31) offs[32] = incl;
    }
    __syncthreads();
    return __builtin_amdgcn_readfirstlane(offs[32]);
}
__device__ __forceinline__ void gather_phase(Frame& F, int layer, volatile LAS int* offs) {
    const bf16_t* H2 = (const bf16_t*)(F.ws + WS_XN); bf16_t* XG = (bf16_t*)(F.ws + WS_XG);
    const int* EID = (const int*)(F.ws + WS_MOE); const int* SLOT = (const int*)(F.ws + WS_MOE + 256 * 1024); int* POS = (int*)(F.ws + WS_MOE + 384 * 1024);
    const float* RS = (const float*)(F.ws + WS_MOE + 640 * 1024); float* RSG = (float*)(F.ws + WS_MOE + 704 * 1024);
    const int TPB = T / F.G;
    for (int m = F.bid * TPB + F.wave; m < (F.bid + 1) * TPB; m += NWAVES) {
        const u32x4* src = (const u32x4*)(H2 + (size_t)m * DM) + F.lane; const u32x4 a = src[0], b = src[64];
#pragma unroll
        for (int k = 0; k < 2; ++k) { const int pos = offs[EID[2 * m + k]] + SLOT[2 * m + k]; u32x4* dst = (u32x4*)(XG + (size_t)pos * DM) + F.lane; dst[0] = a; dst[64] = b; if (F.lane == 0) POS[2 * m + k] = pos; }
    }
}
__device__ __forceinline__ void combine_phase(Frame& F, const float* gain_next, bool dry = false) {
    const bf16_t* Y = (const bf16_t*)(F.ws + WS_YEXP); const float* EW = (const float*)(F.ws + WS_MOE + 128 * 1024); const int* POS = (const int*)(F.ws + WS_MOE + 384 * 1024);
    bf16_t* XN = (bf16_t*)(F.ws + WS_XN);
    const int gw = F.bid * NWAVES + F.wave, NGW = F.G * NWAVES;
    for (int m = gw; m < T; m += NGW) {
        const float w0 = EW[2 * m], w1 = EW[2 * m + 1]; const int p0 = POS[2 * m], p1 = POS[2 * m + 1];
        f32x4* xr = (f32x4*)(F.out + (size_t)m * DM) + F.lane;
        const u32x2* y0 = (const u32x2*)(Y + (size_t)p0 * DM) + F.lane; const u32x2* y1 = (const u32x2*)(Y + (size_t)p1 * DM) + F.lane;
        f32x4 v[4]; float s = 0.f;
#pragma unroll
        for (int j = 0; j < 4; ++j) { v[j] = xr[64 * j]; const u32x2 a = y0[64 * j], b = y1[64 * j];
            v[j].x += w0 * bflo(a.x) + w1 * bflo(b.x); v[j].y += w0 * bfhi(a.x) + w1 * bfhi(b.x); v[j].z += w0 * bflo(a.y) + w1 * bflo(b.y); v[j].w += w0 * bfhi(a.y) + w1 * bfhi(b.y);
            if (!dry) xr[64 * j] = v[j]; s += (v[j].x * v[j].x + v[j].y * v[j].y) + (v[j].z * v[j].z + v[j].w * v[j].w); }
        if (gain_next) { const float rstd = __builtin_amdgcn_rsqf(wave_sum(s) * (1.f / DM) + NORM_EPS); const f32x4* gr = (const f32x4*)gain_next + F.lane;
            unsigned long long* o8 = (unsigned long long*)(XN + (size_t)m * DM) + F.lane;
#pragma unroll
            for (int j = 0; j < 4; ++j) { const f32x4 gv = gr[64 * j]; o8[64 * j] = (unsigned long long)pk2(v[j].x * rstd * gv.x, v[j].y * rstd * gv.y) | ((unsigned long long)pk2(v[j].z * rstd * gv.z, v[j].w * rstd * gv.w) << 32); } }
    }
}

__device__ __forceinline__ int crow32(int reg, int hh) { return (reg & 3) + 8 * (reg >> 2) + 4 * hh; }
__device__ __forceinline__ float wave_incl_scan(float v, int lane) {
#pragma unroll
    for (int o = 1; o < 64; o <<= 1) { const float t = __shfl_up(v, o); if (lane >= o) v += t; }
    return v;
}
__device__ __forceinline__ void conv_frag(const LAS unsigned char* raw, int chan, int ks, int hh, float w0, float w1, float w2, float w3, float bias, float (&out)[8]) {
#pragma unroll
    for (int run = 0; run < 2; ++run) { const int lb = 16 * ks + 8 * run + 4 * hh; float x[7];
#pragma unroll
        for (int i = 0; i < 7; ++i) x[i] = bf2f(*(const LAS unsigned short*)(raw + (lb + i) * 128 + chan * 2));
#pragma unroll
        for (int j = 0; j < 4; ++j) out[4 * run + j] = siluf_(bias + w0 * x[j] + w1 * x[j + 1] + w2 * x[j + 2] + w3 * x[j + 3]); }
}
constexpr int RAWT = 131 * 128;
__device__ __forceinline__ void stage_raw(const bf16_t* P, size_t row0, int l0, int col, LAS unsigned char* dst, int idx0, int stride) {
    for (int idx = idx0; idx < 131 * 8; idx += stride) { const int r = idx >> 3, c8 = idx & 7; u32x4 v = (u32x4){0u, 0u, 0u, 0u};
        if (l0 - 3 + r >= 0) v = *(const u32x4*)(P + (row0 + r - 3) * NINP + col + c8 * 8);
        *(LAS u32x4*)(dst + r * 128 + c8 * 16) = v; }
}
__device__ __forceinline__ void ssdA_mfma(Frame& F, int layer) {
    const bf16_t* P = (const bf16_t*)(F.ws + WS_P); const float* DT = (const float*)(F.ws + WS_DT); float* SST = (float*)(F.ws + WS_SST); float* ASUM = (float*)(F.ws + WS_ASUM);
    const float* cw = F.in[IN_CONVW] + layer * 4 * 1280; const float* cb = F.in[IN_CONVB] + layer * 1280;
    LAS unsigned char* rawX = F.lds + F.wave * RAWT; LAS unsigned char* rawB = F.lds + 8 * RAWT; LAS float* ftab = (LAS float*)(F.lds + 9 * RAWT) + F.wave * 128;
    for (int u = F.bid; u < BATCH * SSD_NCH * 2; u += F.G) {
        const int grp = u & 1, ch = (u >> 1) & 31, b = u >> 6, h = grp * 8 + F.wave, l0 = ch * 128; const size_t row0 = (size_t)b * SEQ + l0;
        int lane = F.lane; asm volatile("" : "+v"(lane));
        const int r = lane & 31, hh = lane >> 5;
        __syncthreads();
        stage_raw(P, row0, l0, C_XS + h * 64, rawX, lane, 64);
        stage_raw(P, row0, l0, C_B + grp * 64, rawB, F.tid, NTHR);
        { const float dtb = F.in[IN_DTB][layer * 16 + h], A = -__expf(F.in[IN_ALOG][layer * 16 + h]);
          const float dt0 = softplusf_(DT[(row0 + lane) * 16 + h] + dtb), dt1 = softplusf_(DT[(row0 + 64 + lane) * 16 + h] + dtb);
          const float s0 = wave_incl_scan(dt0 * A, lane); const float tot0 = __builtin_bit_cast(float, __builtin_amdgcn_readlane(__builtin_bit_cast(int, s0), 63));
          const float s1 = wave_incl_scan(dt1 * A, lane) + tot0; const float tot = __builtin_bit_cast(float, __builtin_amdgcn_readlane(__builtin_bit_cast(int, s1), 63));
          ftab[lane] = dt0 * __expf(tot - s0); ftab[64 + lane] = dt1 * __expf(tot - s1);
          if (lane == 0) ASUM[((size_t)b * SSD_NCH + ch) * 16 + h] = tot; }
        __syncthreads();
        bf16x8 bfr[2];
#pragma unroll
        for (int q = 0; q < 2; ++q) { const int idx = F.wave * 2 + q, nt = idx >> 3, ks = idx & 7, cc = 1024 + grp * 64 + 32 * nt + r; float v[8];
            conv_frag(rawB, 32 * nt + r, ks, hh, cw[cc], cw[1280 + cc], cw[2560 + cc], cw[3840 + cc], cb[cc], v); bfr[q] = pack8v(v); }
        bf16x8 xw[2][8];
#pragma unroll
        for (int pt = 0; pt < 2; ++pt) { const int cx = h * 64 + 32 * pt + r; const float w0 = cw[cx], w1 = cw[1280 + cx], w2 = cw[2560 + cx], w3 = cw[3840 + cx], bias = cb[cx];
#pragma unroll
            for (int ks = 0; ks < 8; ++ks) { float v[8]; conv_frag(rawX, 32 * pt + r, ks, hh, w0, w1, w2, w3, bias, v);
                const f32x4 fa = *(const LAS f32x4*)(ftab + 16 * ks + 4 * hh), fb = *(const LAS f32x4*)(ftab + 16 * ks + 8 + 4 * hh);
                v[0] *= fa.x; v[1] *= fa.y; v[2] *= fa.z; v[3] *= fa.w; v[4] *= fb.x; v[5] *= fb.y; v[6] *= fb.z; v[7] *= fb.w; { u32x4 pq = __builtin_bit_cast(u32x4, pack8v(v)); asm volatile("" : "+v"(pq) :: "memory"); xw[pt][ks] = __builtin_bit_cast(bf16x8, pq); } } }
        __syncthreads();
#pragma unroll
        for (int q = 0; q < 2; ++q) *(LAS bf16x8*)(rawB + (F.wave * 2 + q) * 1024 + lane * 16) = bfr[q];
        __syncthreads();
        f32x16 acc[2][2];
#pragma unroll
        for (int pt = 0; pt < 2; ++pt)
#pragma unroll
            for (int nt = 0; nt < 2; ++nt)
#pragma unroll
                for (int i = 0; i < 16; ++i) acc[pt][nt][i] = 0.f;
#pragma unroll
        for (int ks = 0; ks < 8; ++ks)
#pragma unroll
            for (int nt = 0; nt < 2; ++nt) { const bf16x8 bq = *(const LAS bf16x8*)(rawB + (nt * 8 + ks) * 1024 + lane * 16);
#pragma unroll
                for (int pt = 0; pt < 2; ++pt) acc[pt][nt] = MFMA32(xw[pt][ks], bq, acc[pt][nt]); }
        float* sp = SST + (((size_t)b * SSD_NCH + ch) * 16 + h) * 4096;
#pragma unroll
        for (int pt = 0; pt < 2; ++pt)
#pragma unroll
            for (int nt = 0; nt < 2; ++nt)
#pragma unroll
                for (int i = 0; i < 16; ++i) sp[(32 * pt + crow32(i, hh)) * 64 + 32 * nt + r] = acc[pt][nt][i];
    }
}
__device__ __forceinline__ void ssdC_mfma(Frame& F, int layer) {
    const bf16_t* P = (const bf16_t*)(F.ws + WS_P); const float* DT = (const float*)(F.ws + WS_DT); const float* SST = (const float*)(F.ws + WS_SST); bf16_t* YC = (bf16_t*)(F.ws + WS_YCAT);
    const float* cw = F.in[IN_CONVW] + layer * 4 * 1280; const float* cb = F.in[IN_CONVB] + layer * 1280;
    LAS unsigned char* rawX = F.lds + F.wave * RAWT;
    LAS unsigned char* Bn = F.lds; LAS unsigned char* Cn = F.lds + 18432;
    LAS float* atab = (LAS float*)(F.lds + 36864) + F.wave * 128; LAS float* dtab = (LAS float*)(F.lds + 40960) + F.wave * 128;
    LAS float* ssqp = (LAS float*)(F.lds + 45056); LAS float* gtab = (LAS float*)(F.lds + 49152) + F.wave * 64;
    LAS unsigned char* zt = F.lds + 51200 + F.wave * 4608;
    for (int u = F.bid; u < BATCH * SSD_NCH * 2; u += F.G) {
        const int grp = u & 1, ch = (u >> 1) & 31, b = u >> 6, h = grp * 8 + F.wave, l0 = ch * 128; const size_t row0 = (size_t)b * SEQ + l0;
        int lane = F.lane; asm volatile("" : "+v"(lane));
        const int r = lane & 31, hh = lane >> 5;
        __syncthreads();
        stage_raw(P, row0, l0, C_XS + h * 64, rawX, lane, 64);
        __syncthreads();
        bf16x8 xsf[2][8];
#pragma unroll
        for (int pt = 0; pt < 2; ++pt) { const int cx = h * 64 + 32 * pt + r; const float w0 = cw[cx], w1 = cw[1280 + cx], w2 = cw[2560 + cx], w3 = cw[3840 + cx], bias = cb[cx];
#pragma unroll
            for (int ks = 0; ks < 8; ++ks) { float v[8]; conv_frag(rawX, 32 * pt + r, ks, hh, w0, w1, w2, w3, bias, v); { u32x4 pq = __builtin_bit_cast(u32x4, pack8v(v)); asm volatile("" : "+v"(pq) :: "memory"); xsf[pt][ks] = __builtin_bit_cast(bf16x8, pq); } } }
        __syncthreads();
        for (int it = F.tid; it < 128 * 16; it += NTHR) { const int l = it >> 4, c8 = it & 15, isC = c8 >> 3, col = (isC ? C_C : C_B) + grp * 64 + (c8 & 7) * 8, cc = 1024 + isC * 128 + grp * 64 + (c8 & 7) * 8;
            float a[8];
#pragma unroll
            for (int e = 0; e < 8; ++e) a[e] = cb[cc + e];
#pragma unroll
            for (int j = 0; j < 4; ++j) { if (l0 + l - 3 + j >= 0) { const u32x4 xv = *(const u32x4*)(P + (row0 + l - 3 + j) * NINP + col);
#pragma unroll
                for (int e = 0; e < 4; ++e) { a[2 * e] += cw[j * 1280 + cc + 2 * e] * bflo(xv[e]); a[2 * e + 1] += cw[j * 1280 + cc + 2 * e + 1] * bfhi(xv[e]); } } }
            u32x4 o; o.x = cvtpk(siluf_(a[0]), siluf_(a[1])); o.y = cvtpk(siluf_(a[2]), siluf_(a[3])); o.z = cvtpk(siluf_(a[4]), siluf_(a[5])); o.w = cvtpk(siluf_(a[6]), siluf_(a[7]));
            *(LAS u32x4*)((isC ? Cn : Bn) + l * 144 + (c8 & 7) * 16) = o; }
        { const float dtb = F.in[IN_DTB][layer * 16 + h], A = -__expf(F.in[IN_ALOG][layer * 16 + h]);
          const float dt0 = softplusf_(DT[(row0 + lane) * 16 + h] + dtb), dt1 = softplusf_(DT[(row0 + 64 + lane) * 16 + h] + dtb);
          const float s0 = wave_incl_scan(dt0 * A, lane); const float tot0 = __builtin_bit_cast(float, __builtin_amdgcn_readlane(__builtin_bit_cast(int, s0), 63));
          const float s1 = wave_incl_scan(dt1 * A, lane) + tot0;
          atab[lane] = s0; atab[64 + lane] = s1; dtab[lane] = dt0; dtab[64 + lane] = dt1; gtab[lane] = F.in[IN_SSDG][layer * 1024 + h * 64 + lane]; }
        const float* sp = SST + (((size_t)b * SSD_NCH + ch) * 16 + h) * 4096;
        const float dsk = F.in[IN_SSDD][layer * 16 + h];
        __syncthreads();
#pragma unroll 1
        for (int li = 0; li < 4; ++li) {
            bf16x8 Cf[4];
#pragma unroll
            for (int ks = 0; ks < 4; ++ks) Cf[ks] = *(const LAS bf16x8*)(Cn + (32 * li + r) * 144 + (16 * ks + 8 * hh) * 2);
            f32x16 acc[2];
#pragma unroll
            for (int pt = 0; pt < 2; ++pt)
#pragma unroll
                for (int i = 0; i < 16; ++i) acc[pt][i] = 0.f;
#pragma unroll
            for (int ks = 0; ks < 4; ++ks)
#pragma unroll
                for (int pt = 0; pt < 2; ++pt) { const f32x4 a0 = *(const f32x4*)(sp + (32 * pt + r) * 64 + 16 * ks + 8 * hh), a1 = *(const f32x4*)(sp + (32 * pt + r) * 64 + 16 * ks + 8 * hh + 4);
                    const float v[8] = {a0.x, a0.y, a0.z, a0.w, a1.x, a1.y, a1.z, a1.w}; acc[pt] = MFMA32(pack8v(v), Cf[ks], acc[pt]); }
            const float al = atab[32 * li + r], el = __expf(al); const int lrel = 32 * li + r;
#pragma unroll
            for (int pt = 0; pt < 2; ++pt)
#pragma unroll
                for (int i = 0; i < 16; ++i) acc[pt][i] *= el;
#pragma unroll
            for (int si = 0; si < 4; ++si) if (si <= li) {
                f32x16 X;
#pragma unroll
                for (int i = 0; i < 16; ++i) X[i] = 0.f;
#pragma unroll
                for (int ks = 0; ks < 4; ++ks) { const bf16x8 Bq = *(const LAS bf16x8*)(Bn + (32 * si + r) * 144 + (16 * ks + 8 * hh) * 2); X = MFMA32(Bq, Cf[ks], X); }
#pragma unroll
                for (int g4 = 0; g4 < 4; ++g4) { const int sb = 32 * si + 8 * g4 + 4 * hh; const f32x4 av = *(const LAS f32x4*)(atab + sb), dv = *(const LAS f32x4*)(dtab + sb);
#pragma unroll
                    for (int j = 0; j < 4; ++j) { const int s = sb + j; float arg = al - av[j]; if (si == li && s > lrel) arg = -100.f;
                        float x = X[4 * g4 + j] * (__expf(arg) * dv[j]); if (si == li && s > lrel) x = 0.f; if (si == li && s == lrel) x += dsk; X[4 * g4 + j] = x; } }
#pragma unroll
                for (int kq = 0; kq < 2; ++kq) { const float v[8] = {X[8 * kq], X[8 * kq + 1], X[8 * kq + 2], X[8 * kq + 3], X[8 * kq + 4], X[8 * kq + 5], X[8 * kq + 6], X[8 * kq + 7]}; const bf16x8 Xf = pack8v(v);
#pragma unroll
                    for (int pt = 0; pt < 2; ++pt) { bf16x8 a;
#pragma unroll
                        for (int q = 0; q < 4; ++q) a = (si == q) ? xsf[pt][2 * q + kq] : a;
                        acc[pt] = MFMA32(a, Xf, acc[pt]); } }
            }
            const size_t rowt = row0 + 32 * li;
#pragma unroll
            for (int q = 0; q < 4; ++q) { const int idx = lane + 64 * q, rr = idx >> 3, c8 = idx & 7; *(LAS u32x4*)(zt + rr * 144 + c8 * 16) = *(const u32x4*)(P + (rowt + rr) * NINP + C_Z + h * 64 + c8 * 8); }
            float qs = 0.f;
#pragma unroll
            for (int pt = 0; pt < 2; ++pt)
#pragma unroll
                for (int g4 = 0; g4 < 4; ++g4) { const u32x2 zz = *(const LAS u32x2*)(zt + r * 144 + (32 * pt + 8 * g4 + 4 * hh) * 2);
                    const float z0 = bflo(zz.x), z1 = bfhi(zz.x), z2 = bflo(zz.y), z3 = bfhi(zz.y);
                    float y0 = acc[pt][4 * g4] * siluf_(z0), y1 = acc[pt][4 * g4 + 1] * siluf_(z1), y2 = acc[pt][4 * g4 + 2] * siluf_(z2), y3 = acc[pt][4 * g4 + 3] * siluf_(z3);
                    acc[pt][4 * g4] = y0; acc[pt][4 * g4 + 1] = y1; acc[pt][4 * g4 + 2] = y2; acc[pt][4 * g4 + 3] = y3; qs += (y0 * y0 + y1 * y1) + (y2 * y2 + y3 * y3); }
            qs += __shfl_xor(qs, 32);
            if (hh == 0) ssqp[(32 * li + r) * 8 + F.wave] = qs;
            __syncthreads();
            { const f32x4 qa = *(const LAS f32x4*)(ssqp + (32 * li + r) * 8), qb = *(const LAS f32x4*)(ssqp + (32 * li + r) * 8 + 4);
              const float rs = __builtin_amdgcn_rsqf(((qa.x + qa.y) + (qa.z + qa.w) + (qb.x + qb.y) + (qb.z + qb.w)) * (1.f / 512.f) + NORM_EPS);
#pragma unroll
              for (int pt = 0; pt < 2; ++pt)
#pragma unroll
                  for (int g4 = 0; g4 < 4; ++g4) { const int p0 = 32 * pt + 8 * g4 + 4 * hh; const f32x4 gv = *(const LAS f32x4*)(gtab + p0);
                      u32x2 o; o.x = cvtpk(acc[pt][4 * g4] * rs * gv.x, acc[pt][4 * g4 + 1] * rs * gv.y); o.y = cvtpk(acc[pt][4 * g4 + 2] * rs * gv.z, acc[pt][4 * g4 + 3] * rs * gv.w);
                      *(LAS u32x2*)(zt + r * 144 + p0 * 2) = o; } }
#pragma unroll
            for (int q = 0; q < 4; ++q) { const int idx = lane + 64 * q, rr = idx >> 3, c8 = idx & 7; *(u32x4*)(YC + (rowt + rr) * 2048 + 1024 + h * 64 + c8 * 8) = *(const LAS u32x4*)(zt + rr * 144 + c8 * 16); }
        }
    }
}

__device__ __forceinline__ void attn_mfma(Frame& F, int layer) {
    LAS unsigned char* Kn = F.lds; LAS unsigned char* VT = F.lds + 36864;
    const bf16_t* P = (const bf16_t*)(F.ws + WS_P); bf16_t* YC = (bf16_t*)(F.ws + WS_YCAT);
    const float* qg = F.in[IN_QG] + layer * 64; const float* kg = F.in[IN_KG] + layer * 64;
    for (int u = F.bid; u < BATCH * 32 * 2; u += F.G) {
        const int kvh = u & 1, qb = (u >> 1) & 31, b = u >> 6, q0 = qb * 128;
        int lane = F.lane; asm volatile("" : "+v"(lane));
        const int r = lane & 31, hh = lane >> 5;
        __syncthreads();
        for (int jr = F.wave; jr < 256; jr += NWAVES) { const int l = q0 - 128 + jr; float kv = 0.f;
            if (l >= 0) { const size_t row = (size_t)b * SEQ + l; const float x = bf2f(P[row * NINP + C_K + kvh * 64 + lane]);
                const float rs = __builtin_amdgcn_rsqf(wave_sum(x * x) * (1.f / 64.f) + NORM_EPS); const float xn = x * rs * kg[lane];
                const float other = __shfl_xor(xn, 32); const int i = lane & 31; const float inv = exp2f(-(float)i * (13.287712379549449f / 32.f));
                float s, c; sincos_fast((float)l * inv, s, c);
                kv = (lane < 32) ? (xn * c - other * s) : (xn * c + other * s); }
            *(LAS unsigned short*)(Kn + jr * 144 + lane * 2) = (unsigned short)f2bf(kv); }
#pragma unroll
        for (int q = 0; q < 4; ++q) { const int it = F.tid + NTHR * q, d = it & 63, ko = it >> 6; unsigned short v[8];
#pragma unroll
            for (int e = 0; e < 8; ++e) { const int l = q0 - 128 + 8 * ko + e; v[e] = (l >= 0) ? P[((size_t)b * SEQ + l) * NINP + C_V + kvh * 64 + d] : (unsigned short)0; }
            u32x4 o; o.x = v[0] | ((unsigned)v[1] << 16); o.y = v[2] | ((unsigned)v[3] << 16); o.z = v[4] | ((unsigned)v[5] << 16); o.w = v[6] | ((unsigned)v[7] << 16);
            *(LAS u32x4*)(VT + d * 528 + ko * 16) = o; }
        __syncthreads();
        const int hd = F.wave >> 1, head = kvh * 4 + hd, qhalf = F.wave & 1; const float sink = F.in[IN_SINK][layer * 8 + head];
#pragma unroll 1
        for (int jt = 0; jt < 2; ++jt) {
            const int qt = q0 + 64 * qhalf + 32 * jt, qi = qt + r, t0 = 2 * qhalf + jt; const size_t row = (size_t)b * SEQ + qi;
            bf16x8 Qf[4];
            { float qv[4][8]; float ss = 0.f;
#pragma unroll
              for (int ks = 0; ks < 4; ++ks) { const u32x4 w = *(const u32x4*)(P + row * NINP + C_Q + head * 64 + 16 * ks + 8 * hh);
#pragma unroll
                  for (int e = 0; e < 4; ++e) { qv[ks][2 * e] = bflo(w[e]); qv[ks][2 * e + 1] = bfhi(w[e]); ss += qv[ks][2 * e] * qv[ks][2 * e] + qv[ks][2 * e + 1] * qv[ks][2 * e + 1]; } }
              ss += __shfl_xor(ss, 32);
              const float rs = __builtin_amdgcn_rsqf(ss * (1.f / 64.f) + NORM_EPS);
#pragma unroll
              for (int ks = 0; ks < 4; ++ks)
#pragma unroll
                  for (int e = 0; e < 8; ++e) qv[ks][e] *= rs * qg[16 * ks + 8 * hh + e];
#pragma unroll
              for (int ks = 0; ks < 2; ++ks)
#pragma unroll
                  for (int e = 0; e < 8; ++e) { const int i = 16 * ks + 8 * hh + e; const float inv = exp2f(-(float)i * (13.287712379549449f / 32.f)); float s, c; sincos_fast((float)qi * inv, s, c);
                      const float a = qv[ks][e], bq = qv[ks + 2][e]; qv[ks][e] = (a * c - bq * s) * 0.125f; qv[ks + 2][e] = (bq * c + a * s) * 0.125f; }
#pragma unroll
              for (int ks = 0; ks < 4; ++ks) Qf[ks] = pack8v(qv[ks]); }
            f32x16 acc[2];
#pragma unroll
            for (int dt = 0; dt < 2; ++dt)
#pragma unroll
                for (int i = 0; i < 16; ++i) acc[dt][i] = 0.f;
            float m = sink, lsum = 1.f;
#pragma unroll
            for (int tt = 0; tt < 5; ++tt) { const int t = t0 + tt;
                if (q0 == 0 && t < 4) continue;
                f32x16 X;
#pragma unroll
                for (int i = 0; i < 16; ++i) X[i] = 0.f;
#pragma unroll
                for (int ks = 0; ks < 4; ++ks) { const bf16x8 Kq = *(const LAS bf16x8*)(Kn + (32 * t + r) * 144 + (16 * ks + 8 * hh) * 2); X = MFMA32(Kq, Qf[ks], X); }
                if (tt == 0) {
#pragma unroll
                    for (int i = 0; i < 16; ++i) if (!(r < crow32(i, hh))) X[i] = -INFINITY; }
                if (tt == 4) {
#pragma unroll
                    for (int i = 0; i < 16; ++i) if (!(crow32(i, hh) <= r)) X[i] = -INFINITY; }
                float mx = X[0];
#pragma unroll
                for (int i = 1; i < 16; ++i) mx = fmaxf(mx, X[i]);
                mx = fmaxf(mx, __shfl_xor(mx, 32));
                const float mn = fmaxf(m, mx), al = __expf(m - mn); m = mn;
                float ps = 0.f;
#pragma unroll
                for (int i = 0; i < 16; ++i) { X[i] = __expf(X[i] - mn); ps += X[i]; }
                ps += __shfl_xor(ps, 32);
                lsum = lsum * al + ps;
#pragma unroll
                for (int dt = 0; dt < 2; ++dt)
#pragma unroll
                    for (int i = 0; i < 16; ++i) acc[dt][i] *= al;
#pragma unroll
                for (int kq = 0; kq < 2; ++kq) { const float v[8] = {X[8 * kq], X[8 * kq + 1], X[8 * kq + 2], X[8 * kq + 3], X[8 * kq + 4], X[8 * kq + 5], X[8 * kq + 6], X[8 * kq + 7]}; const bf16x8 Pf = pack8v(v);
#pragma unroll
                    for (int dt = 0; dt < 2; ++dt) { const LAS unsigned char* vp = VT + (32 * dt + r) * 528 + (32 * t + 16 * kq + 4 * hh) * 2;
                        const u32x2 va = *(const LAS u32x2*)vp, vb = *(const LAS u32x2*)(vp + 16); const u32x4 vv = {va.x, va.y, vb.x, vb.y};
                        acc[dt] = MFMA32(__builtin_bit_cast(bf16x8, vv), Pf, acc[dt]); } }
            }
            const float il = 1.f / lsum;
#pragma unroll
            for (int dt = 0; dt < 2; ++dt)
#pragma unroll
                for (int g4 = 0; g4 < 4; ++g4) { u32x2 o; o.x = cvtpk(acc[dt][4 * g4] * il, acc[dt][4 * g4 + 1] * il); o.y = cvtpk(acc[dt][4 * g4 + 2] * il, acc[dt][4 * g4 + 3] * il);
                    *(u32x2*)(YC + row * 2048 + 512 + head * 64 + 32 * dt + 8 * g4 + 4 * hh) = o; }
        }
    }
}

#ifndef MK_PER_PHASE
#define MK_PER_PHASE 0
#endif
constexpr int NPH = 13;
constexpr int TAB_OFF = 150 * 1024;
struct Args { const float* in[N_INPUTS]; float* out; unsigned char* ws; int gp_lo, gp_hi; };
static_assert(sizeof(Args) == (N_INPUTS + 2) * 8 + 8, "no padding in Args");

#ifndef PROBE_ID
#define PROBE_ID 0
#endif
#ifndef PROBE_N
#define PROBE_N 1
#endif
#define REP(id) for (int _r = 0; _r < ((id) == PROBE_ID ? 1 + PROBE_N : 1); ++_r)
extern __shared__ __attribute__((aligned(16))) unsigned char lds_raw[];
__device__ __forceinline__ LAS unsigned char* lds_raw_base() { return (LAS unsigned char*)lds_raw; }
#define LAUNDER() do { asm volatile("" : "+s"(F.in), "+s"(F.ws), "+s"(F.out), "+s"(F.ctl), "+s"(F.bid), "+s"(F.G)); asm volatile("" : "+v"(F.tid)); F.lane = F.tid & 63; F.wave = __builtin_amdgcn_readfirstlane(F.tid >> 6); } while (0)
template <int layer>
__device__ __forceinline__ void layer_body(Frame& F, const int lo, const int hi, const bool rerun) {
    volatile LAS int* offs = (volatile LAS int*)(F.lds + TAB_OFF); volatile LAS int* tile_e = offs + 64;
    XcdBarrier bar; bar.bar = F.ctl + CW_BAR; bar.x = xb_xcc_id(); bar.st = F.MISC;
#define GP(k) (layer * NPH + (k))
#ifdef ONLY_PH
#define IN(k) (((k) == ONLY_PH) && lo <= GP(k) && GP(k) < hi)
#else
#define IN(k) (lo <= GP(k) && GP(k) < hi)
#endif
#define WSB ((const char*)F.ws)
#ifdef DIAG_GP
#define STAMP0(k) do { if (GP(k) == DIAG_GP) { const unsigned t_ = (unsigned)__builtin_amdgcn_s_memrealtime(); if (threadIdx.x == 0) *(volatile LAS unsigned*)((LAS unsigned char*)lds_raw_base() + MISC_OFF + 32) = t_; } } while (0)
#define STAMP1(k) do { if (GP(k) == DIAG_GP) { const unsigned t_ = (unsigned)__builtin_amdgcn_s_memrealtime(); if (threadIdx.x == 0) *(volatile LAS unsigned*)((LAS unsigned char*)lds_raw_base() + MISC_OFF + 40) = t_; } } while (0)
#else
#define STAMP0(k)
#define STAMP1(k)
#endif
#define SEAM(k) do { if (!MK_PER_PHASE && IN(k) && GP(k) + 1 < hi) { xcd_barrier(bar); if (PROBE_ID == 19) { xcd_barrier(bar); xcd_barrier(bar); } } STAMP1(k); } while (0)
        if (IN(0) && layer == 0) { LAUNDER(); STAMP0(0);
            REP(1) { convert_weights(F, 0); __syncthreads(); } REP(2) s5_build(F, 0);
            REP(3) rmsnorm_rows(F, F.in[IN_X], F.in[IN_NORM1], (bf16_t*)(F.ws + WS_XN));
            SEAM(0);
        }
        if (IN(1)) { LAUNDER(); STAMP0(1);
            SchedDense<2048u, 2048u, T / 256, NINP / 256, 16> S{WSB + WS_XN, WSB + WS_WIN, F.G, F.bid};
            EpiProj E{F.ws, F.in[IN_BGATE] + layer * 3072};
            REP(4) pg8::gemm_phase<2048u, 2048u>(F.tid, F.lds, S, E);
            SEAM(1);
        }
        if (IN(2)) { LAUNDER(); STAMP0(2);
            SchedS5P1 S{WSB + WS_UH, WSB + WS_EG, F.G, F.bid};
            EpiHloc E{(float*)(F.ws + WS_HLOC)};
            REP(5) pg8::gemm_phase<(unsigned)(S5_K * 2), 1024u>(F.tid, F.lds, S, E);
            REP(6) ssdA_mfma(F, layer);
            REP(8) attn_mfma(F, layer);
            SEAM(2);
        }
        if (IN(3)) { LAUNDER(); STAMP0(3);
            REP(7) s5_scan(F, layer);
            if (!rerun) ssd_scan(F);
            SEAM(3);
        }
        if (IN(4)) { LAUNDER(); STAMP0(4);
            SchedS5Main S{WSB + WS_UH, WSB + WS_MG, F.G, F.bid};
            EpiS5Y E{(bf16_t*)(F.ws + WS_XN)};
            REP(9) pg8::gemm_phase<(unsigned)(S5_K * 2), (unsigned)(S5_K * 2)>(F.tid, F.lds, S, E);
            REP(10) ssdC_mfma(F, layer);
            SEAM(4);
        }
        if (IN(5)) { LAUNDER(); STAMP0(5);
            SchedDense<1024u, 1024u, T / 256, 4, 8> S{WSB + WS_XN, WSB + WS_WGLU, F.G, F.bid};
            EpiGlu E{(bf16_t*)(F.ws + WS_YCAT)};
            REP(11) pg8::gemm_phase<1024u, 1024u>(F.tid, F.lds, S, E);
            SEAM(5);
        }
        if (IN(6)) { LAUNDER(); STAMP0(6);
            SchedDense<4096u, 4096u, T / 256, 4, 32> S{WSB + WS_YCAT, WSB + WS_PCAT, F.G, F.bid};
            EpiMerged E{F.ws};
            REP(12) pg8::gemm_phase<4096u, 4096u>(F.tid, F.lds, S, E);
            SEAM(6);
        }
        if (IN(7)) { LAUNDER(); STAMP0(7);
            SchedDense<2048u, 2048u, T / 256, 4, 16> S{WSB + WS_XN, WSB + WS_WOUT, F.G, F.bid};
            EpiResid E{layer == 0 ? F.in[IN_X] : (const float*)F.out, F.out};
            REP(layer == 0 ? 13 : -1) pg8::gemm_phase<2048u, 2048u>(F.tid, F.lds, S, E);
            SEAM(7);
        }
        if (IN(8)) { LAUNDER(); STAMP0(8); REP(17) router_phase(F, layer); SEAM(8); }
        if (IN(9)) { LAUNDER(); STAMP0(9); (void)moe_tables(F, layer, offs, tile_e); REP(14) gather_phase(F, layer, offs); SEAM(9); }
        if (IN(10)) { LAUNDER(); STAMP0(10);
            const int ntiles = moe_tables(F, layer, offs, tile_e);
            SchedMoe<2048u, (size_t)1024 * 1024 * 2, (size_t)256 * 2048, 16> S{WSB + WS_XG, WSB + WS_EGU, ntiles, F.G, F.bid, tile_e};
            EpiSwiGlu E{(bf16_t*)(F.ws + WS_HID), (const float*)(F.ws + WS_MOE + 704 * 1024)};
            REP(15) pg8::gemm_phase<2048u, 2048u>(F.tid, F.lds, S, E);
            SEAM(10);
        }
        if (IN(11)) { LAUNDER(); STAMP0(11);
            const int ntiles = moe_tables(F, layer, offs, tile_e);
            SchedMoe<1024u, (size_t)1024 * 512 * 2, (size_t)256 * 1024, 8> S{WSB + WS_HID, WSB + WS_EDN, ntiles, F.G, F.bid, tile_e};
            EpiPlainBf16 E{(bf16_t*)(F.ws + WS_YEXP)};
            REP(16) pg8::gemm_phase<1024u, 1024u>(F.tid, F.lds, S, E);
            SEAM(11);
        }
        if (IN(12)) { LAUNDER(); STAMP0(12);
            if (PROBE_ID == 18) combine_phase(F, F.in[IN_NORM1], true);
            combine_phase(F, layer + 1 < DEPTH ? F.in[IN_NORM1] + (layer + 1) * 1024 : nullptr);
            if (layer + 1 < DEPTH) { __syncthreads(); convert_weights(F, layer + 1); __syncthreads(); s5_build(F, layer + 1); }
            SEAM(12);
        }
#undef GP
#undef IN
#undef SEAM
#undef WSB
}
__global__ void __launch_bounds__(NTHR, 2) fwd(Args args) {
    Frame F;
    F.lds = (LAS unsigned char*)lds_raw;
    F.MISC = (volatile LAS unsigned*)(F.lds + MISC_OFF);
    F.tid = threadIdx.x; F.lane = F.tid & 63; F.wave = __builtin_amdgcn_readfirstlane(F.tid >> 6);
    F.G = gridDim.x; F.bid = blockIdx.x;
    const __attribute__((address_space(4))) char* ka = (const __attribute__((address_space(4))) char*)__builtin_amdgcn_kernarg_segment_ptr();
    F.in = (const float* const __attribute__((address_space(4)))*)ka;
    F.out = *(float* const __attribute__((address_space(4)))*)(ka + N_INPUTS * 8); F.ws = *(unsigned char* const __attribute__((address_space(4)))*)(ka + N_INPUTS * 8 + 8); F.ctl = (unsigned*)(F.ws + WS_CTL);
    if (F.tid < 64) F.MISC[F.tid] = 0u;
    __syncthreads();
    XcdBarrier bar; bar.bar = F.ctl + CW_BAR; bar.x = 0; bar.st = nullptr;
    if (!MK_PER_PHASE) bar = xcd_barrier_post(F.ctl + CW_BAR, F.MISC);
    const int lo = *(const __attribute__((address_space(4))) int*)(ka + N_INPUTS * 8 + 16), hi_raw = *(const __attribute__((address_space(4))) int*)(ka + N_INPUTS * 8 + 20), hi = hi_raw & 0xffff;

    layer_body<0>(F, lo, hi, (hi_raw >> 16) != 0);
    layer_body<1>(F, lo, hi, (hi_raw >> 16) != 0);
#ifdef DIAG_GP
    __syncthreads();
    if (blockIdx.x == 0 && threadIdx.x == 0) { const unsigned t0 = *(volatile LAS unsigned*)((LAS unsigned char*)lds_raw_base() + MISC_OFF + 32), t1 = *(volatile LAS unsigned*)((LAS unsigned char*)lds_raw_base() + MISC_OFF + 40); float* o_ = *(float* const __attribute__((address_space(4)))*)((const __attribute__((address_space(4))) char*)__builtin_amdgcn_kernarg_segment_ptr() + N_INPUTS * 8); asm volatile("s_waitcnt vmcnt(0)" ::: "memory"); o_[0] = (float)(t1 - t0); }
#endif
}

extern "C" void kernel_launch(void* const* d_in, const int* in_sizes, int n_in, void* d_out, int out_size, void* d_ws, size_t ws_size, hipStream_t stream) {
    static int grid = 0;
    if (grid == 0) {
        if (n_in != N_INPUTS || out_size != T * DM || ws_size < WS_END) { fprintf(stderr, "kernel_launch: unexpected shapes (n_in %d out %d ws %zu need %zu)\n", n_in, out_size, ws_size, (size_t)WS_END); grid = -1; return; }
        int dev = 0, cus = 0, per_cu = 0;
        if (hipGetDevice(&dev) != hipSuccess || hipDeviceGetAttribute(&cus, hipDeviceAttributeMultiprocessorCount, dev) != hipSuccess) { grid = -1; return; }
        if (hipFuncSetAttribute((const void*)fwd, hipFuncAttributeMaxDynamicSharedMemorySize, LDS_BYTES) != hipSuccess) { fprintf(stderr, "kernel_launch: hipFuncSetAttribute failed\n"); grid = -1; return; }
        if (hipOccupancyMaxActiveBlocksPerMultiprocessor(&per_cu, (const void*)fwd, NTHR, LDS_BYTES) != hipSuccess || per_cu < 1) fprintf(stderr, "kernel_launch: occupancy query reports %d\n", per_cu);
        (void)hipGetLastError();
        grid = cus;
    }
    if (grid < 0) return;
    (void)hipMemsetAsync((char*)d_ws + WS_CTL, 0, CTL_ZERO_BYTES, stream);
    Args a{};
    for (int i = 0; i < N_INPUTS; ++i) a.in[i] = (const float*)d_in[i];
    a.out = (float*)d_out; a.ws = (unsigned char*)d_ws;
#if MK_PER_PHASE
    for (int gp = 0; gp < DEPTH * NPH; ++gp) {
        if (gp == NPH) continue;
        a.gp_lo = gp; a.gp_hi = gp + 1;
        int nrep = 1;
#ifdef PP_REP_GP
        if (gp == PP_REP_GP) nrep = 1 + PP_REP_N;
#endif
        for (int rr = 0; rr < nrep; ++rr) { a.gp_hi = (gp + 1) | (rr > 0 ? 0x10000 : 0); hipLaunchKernelGGL(fwd, dim3(grid), dim3(NTHR), LDS_BYTES, stream, a); }
    }
#else
    a.gp_lo = 0; a.gp_hi = DEPTH * NPH;
    hipLaunchKernelGGL(fwd, dim3(grid), dim3(NTHR), LDS_BYTES, stream, a);
#endif
}
```

```cpp
#include <hip/hip_runtime.h>
#include <cstdio>
#include <cstdint>

#define LAS __attribute__((address_space(3)))
#define GAS __attribute__((address_space(1)))
typedef unsigned short bf16_t;
typedef short bf16x8 __attribute__((ext_vector_type(8)));
typedef float f32x4 __attribute__((ext_vector_type(4)));
typedef float f32x2 __attribute__((ext_vector_type(2)));
typedef unsigned u32x4 __attribute__((ext_vector_type(4)));
typedef unsigned u32x2 __attribute__((ext_vector_type(2)));

constexpr int BATCH = 4, SEQ = 4096, DM = 1024, T = BATCH * SEQ, DEPTH = 2;
constexpr int NIN = 6672, NINP = 6912;
constexpr int C_U = 0, C_Q = 512, C_K = 1024, C_V = 1152, C_Z = 1280, C_XS = 2304, C_B = 3328, C_C = 3456, C_DT = 3584, C_G = 3840;
constexpr int S5_TC = 32, S5_ROWS = T / S5_TC  , S5_K = 128 + S5_TC * 16  , S5_N = S5_TC * 16  ;
constexpr int SSD_NCH = SEQ / 128;
constexpr int MOE_MAXROWS = 2 * T + 32 * 256;
constexpr float NORM_EPS = 1e-6f;

constexpr size_t MiB = 1u << 20;
constexpr size_t WS_CTL = 0, CTL_ZERO_BYTES = 1 * MiB;
constexpr size_t WS_WIN = 1 * MiB;
constexpr size_t WS_WGLU = WS_WIN + (size_t)NINP * DM * 2;
constexpr size_t WS_PCAT = WS_WGLU + 1 * MiB;
constexpr size_t WS_WOUT = WS_PCAT + 4 * MiB;
constexpr size_t WS_EGU = WS_WOUT + 2 * MiB;
constexpr size_t WS_EDN = WS_EGU + 64 * MiB;
constexpr size_t WS_MG = WS_EDN + 32 * MiB;
constexpr size_t WS_EG = WS_MG + 20 * MiB;
constexpr size_t WS_XN = WS_EG + 8 * MiB;
constexpr size_t WS_P = WS_XN + 32 * MiB;
constexpr size_t WS_XG = WS_P;
constexpr size_t WS_HID = WS_XG + (size_t)MOE_MAXROWS * 1024 * 2;
constexpr size_t WS_YEXP = WS_HID + (size_t)MOE_MAXROWS * 512 * 2;
constexpr size_t WS_DT = WS_P + 216 * MiB;
constexpr size_t WS_UH = WS_DT + 1 * MiB;
constexpr size_t WS_HLOC = WS_UH + 20 * MiB;
constexpr size_t WS_YCAT = WS_HLOC + 8 * MiB;
constexpr size_t WS_SST = WS_YCAT + 64 * MiB;
constexpr size_t WS_MOE = WS_SST + 32 * MiB;
constexpr size_t WS_ASUM = WS_MOE + 1 * MiB;
constexpr size_t WS_END = WS_ASUM + 64 * 1024;
static_assert(WS_YEXP + (size_t)MOE_MAXROWS * 1024 * 2 <= WS_DT, "MoE overlay fits in P");
constexpr int CW_BAR = 4096;
constexpr int CW_CNT = 16384;

constexpr int NWAVES = 8, NTHR = 512;
constexpr int LDS_BYTES = 163840;
constexpr int RING_BYTES = 131072;
constexpr int MISC_OFF = 160 * 1024 - 256;

__device__ __forceinline__ unsigned f2bf(float f) { unsigned u = __builtin_bit_cast(unsigned, f); return (u + 0x7fffu + ((u >> 16) & 1u)) >> 16; }
typedef float f32x2_t __attribute__((ext_vector_type(2)));
typedef __bf16 bf16x2_t __attribute__((ext_vector_type(2)));
__device__ __forceinline__ unsigned pk2(float lo, float hi) { f32x2_t v = {lo, hi}; bf16x2_t b = __builtin_convertvector(v, bf16x2_t); return __builtin_bit_cast(unsigned, b); }
__device__ __forceinline__ float bf2f(unsigned b) { return __builtin_bit_cast(float, b << 16); }
__device__ __forceinline__ float bflo(unsigned w) { return __builtin_bit_cast(float, w << 16); }
__device__ __forceinline__ float bfhi(unsigned w) { return __builtin_bit_cast(float, w & 0xffff0000u); }
#define WS_DPP(v, ctrl, rmask) __builtin_bit_cast(float, __builtin_amdgcn_update_dpp(0, __builtin_bit_cast(int, v), ctrl, rmask, 0xF, false))
__device__ __forceinline__ float wave_sum(float v) {
    v += WS_DPP(v, 0xB1, 0xF);
    v += WS_DPP(v, 0x4E, 0xF);
    v += WS_DPP(v, 0x141, 0xF);
    v += WS_DPP(v, 0x140, 0xF);
    v += WS_DPP(v, 0x142, 0xA);
    v += WS_DPP(v, 0x143, 0xC);
    return __builtin_bit_cast(float, __builtin_amdgcn_readlane(__builtin_bit_cast(int, v), 63));
}
__device__ __forceinline__ float frcp(float x) { return __builtin_amdgcn_rcpf(x); }
__device__ __forceinline__ float sigmoidf_(float x) { return frcp(1.0f + __expf(-x)); }
__device__ __forceinline__ float siluf_(float x) { return x * frcp(1.0f + __expf(-x)); }
__device__ __forceinline__ float gelu_tanh_(float x) { const float u = 0.7978845608f * (x + 0.044715f * x * x * x); return x * frcp(1.0f + __expf(-2.0f * u)); }
__device__ __forceinline__ float softplusf_(float x) { return x > 20.f ? x : log1pf(__expf(x)); }

typedef float f32x16 __attribute__((ext_vector_type(16)));
#define MFMA32(a, b, c) __builtin_amdgcn_mfma_f32_32x32x16_bf16((a), (b), (c), 0, 0, 0)
__device__ __forceinline__ unsigned cvtpk(float lo, float hi) { f32x2_t v = {lo, hi}; bf16x2_t b = __builtin_convertvector(v, bf16x2_t); return __builtin_bit_cast(unsigned, b); }
__device__ __forceinline__ bf16x8 pack8v(const float (&v)[8]) { u32x4 p; p.x = cvtpk(v[0], v[1]); p.y = cvtpk(v[2], v[3]); p.z = cvtpk(v[4], v[5]); p.w = cvtpk(v[6], v[7]); return __builtin_bit_cast(bf16x8, p); }

#define XB_TMO      128
#define XB_XCNT(j)  (256  + 64 * (j))
#define XB_XSUB(j)  (1280 + 64 * (j))
#define XB_XGEN(j)  (2304 + 64 * (j))
#define XB_TOP      3328
#define XB_TOPGEN   3392
#define XCD_BAR_WORDS 3456
#define XB_SPIN_CAP (1u << 18)
__device__ __forceinline__ unsigned xb_ld(unsigned* p)              { return __hip_atomic_load(p, __ATOMIC_RELAXED, __HIP_MEMORY_SCOPE_AGENT); }
__device__ __forceinline__ unsigned xb_add(unsigned* p, unsigned v) { return __hip_atomic_fetch_add(p, v, __ATOMIC_RELAXED, __HIP_MEMORY_SCOPE_AGENT); }
__device__ __forceinline__ unsigned xb_xcc_id() { return (unsigned)__builtin_amdgcn_s_getreg((3 << 11) | 20) & 0xFu; }
#define XB_SPIN(cond, bar) do { unsigned _sp = 0; while (cond) { __builtin_amdgcn_s_sleep(1); \
    if ((++_sp & 255u) == 0u) { if (xb_ld(&(bar)[XB_TMO])) break; if (_sp > XB_SPIN_CAP) { atomicAdd(&(bar)[XB_TMO], 1u); break; } } } } while (0)
struct XcdBarrier { unsigned* bar; unsigned x; volatile LAS unsigned* st; };
__device__ __forceinline__ XcdBarrier xcd_barrier_post(unsigned* bar, volatile LAS unsigned* st) {
    XcdBarrier b; b.bar = bar; b.x = xb_xcc_id(); b.st = st;
    if (threadIdx.x == 0) (void)xb_add(&bar[XB_XCNT(b.x)], 1u);
    return b;
}
__device__ __forceinline__ void xcd_barrier_complete(unsigned* bar, unsigned x, unsigned& nloc, unsigned& nx) {
    const unsigned G = gridDim.x * gridDim.y * gridDim.z;
    unsigned sum, cnt, mine, sp = 0u;
    for (;;) {
        sum = 0u; cnt = 0u; mine = 0u;
#pragma unroll
        for (unsigned j = 0; j < 16; ++j) { const unsigned c = xb_ld(&bar[XB_XCNT(j)]); sum += c; cnt += (c > 0u) ? 1u : 0u; mine = (j == x) ? c : mine; }
        if (sum == G) break;
        __builtin_amdgcn_s_sleep(1);
        if ((++sp & 255u) == 0u) { if (xb_ld(&bar[XB_TMO])) break; if (sp > XB_SPIN_CAP) { atomicAdd(&bar[XB_TMO], 1u); break; } }
    }
    nloc = mine > 0u ? mine : 1u; nx = cnt > 0u ? cnt : 1u;
}
__device__ __forceinline__ void xcd_barrier(const XcdBarrier& b) {
    asm volatile("s_waitcnt vmcnt(0)" ::: "memory");
    __syncthreads();
    if (threadIdx.x == 0) {
        unsigned* bar = b.bar;
        __builtin_amdgcn_s_waitcnt(0);
        unsigned nloc = b.st[0], nx = b.st[1];
        if (nloc == 0u) { xcd_barrier_complete(bar, b.x, nloc, nx); b.st[0] = nloc; b.st[1] = nx; }
        const unsigned old = xb_add(&bar[XB_XSUB(b.x)], 1u);
        const unsigned gen = old / nloc;
        if (old + 1u == (gen + 1u) * nloc) {
            __builtin_amdgcn_fence(__ATOMIC_RELEASE, "agent");
            asm volatile("s_waitcnt vmcnt(0)" ::: "memory");
            const unsigned og = xb_add(&bar[XB_TOP], 1u);
            const unsigned tg = og / nx;
            if (og + 1u == (tg + 1u) * nx) xb_add(&bar[XB_TOPGEN], 1u);
            else XB_SPIN(xb_ld(&bar[XB_TOPGEN]) == tg, bar);
            __builtin_amdgcn_fence(__ATOMIC_ACQUIRE, "agent");
            xb_add(&bar[XB_XGEN(b.x)], 1u);
            asm volatile("s_waitcnt vmcnt(0)" ::: "memory");
        } else {
            XB_SPIN(xb_ld(&bar[XB_XGEN(b.x)]) == gen, bar);
            __builtin_amdgcn_fence(__ATOMIC_ACQUIRE, "agent");
            asm volatile("s_waitcnt vmcnt(0)" ::: "memory");
        }
    }
    __syncthreads();
}

namespace pg8 {
constexpr int BM = 256, BK = 64, HALF = 128, HTB = HALF * BK * 2, STAGE_BYTES = 8 * HTB, NXCD = 8, WGM = 8;
__host__ __device__ __forceinline__ int lds_byte(int r, int c) { const int st = (r >> 4) * 2 + (c >> 5), rr = r & 15, cc = c & 31, ob = rr * 64 + cc * 2; return st * 1024 + (ob ^ (((ob >> 9) & 1) << 5)); }
__host__ __device__ __forceinline__ void stage_rc(int b, int& R, int& C) { const int st = b / 1024, sb = b % 1024, swz = sb ^ (((sb >> 9) & 1) << 5); R = (st >> 1) * 16 + swz / 64; C = (st & 1) * 32 + (swz % 64) / 2; }
__host__ __device__ __forceinline__ int perm32(int rho) { const int n = rho >> 4, i = rho & 15; return 8 * (i >> 2) + 4 * n + (i & 3); }

struct Unit { const char* A; const char* B; int nt; int pm, pn, aux; };

__device__ __forceinline__ void tile_order(int L, int nM, int nN, int& pm, int& pn) {
    const int nwg = nM * nN; int wgid = L;
    { const int q = nwg / NXCD, r = nwg % NXCD, xcd = wgid % NXCD, off = wgid / NXCD; wgid = (xcd < r ? xcd * (q + 1) : r * (q + 1) + (xcd - r) * q) + off; }
    const int nig = WGM * nN, gid = wgid / nig, fm = gid * WGM, gsz = (nM - fm) < WGM ? (nM - fm) : WGM;
    pm = fm + ((wgid % nig) % gsz); pn = (wgid % nig) / gsz;
}
__device__ __forceinline__ unsigned cvt_pk_bf16(float lo, float hi) { unsigned r; asm volatile("v_cvt_pk_bf16_f32 %0, %1, %2" : "=v"(r) : "v"(lo), "v"(hi)); return r; }
__device__ __forceinline__ u32x4 pack8(const f32x4 v0, const f32x4 v1) { u32x4 w; w.x = cvt_pk_bf16(v0[0], v0[1]); w.y = cvt_pk_bf16(v0[2], v0[3]); w.z = cvt_pk_bf16(v1[0], v1[1]); w.w = cvt_pk_bf16(v1[2], v1[3]); return w; }

template <unsigned lda, unsigned ldb, class Epi, class Sched>
__device__ __forceinline__ void gemm_phase(const int tid, LAS unsigned char* lds, const Sched& S, const Epi& E) {
    const int wid = __builtin_amdgcn_readfirstlane(tid >> 6), lane = tid & 63, wr = wid >> 2, wc = wid & 3, fr = lane & 15, fq = lane >> 4;
    unsigned voffA[2], voffB[2];
#pragma unroll
    for (int i = 0; i < 2; ++i) { int R, C; stage_rc(tid * 16 + i * 8192, R, C); const int Rb = Epi::PERM ? ((R & ~31) + perm32(R & 31)) : R;
        voffA[i] = (unsigned)R * lda + (unsigned)C * 2u; voffB[i] = (unsigned)Rb * ldb + (unsigned)C * 2u; }
    const size_t kstep = (size_t)(BK * 2);
    const size_t hstepA = (size_t)HALF * lda, hstepB = (size_t)HALF * ldb;
    const unsigned ldsw = (unsigned)wid * 1024u;
    const int aoff = lds_byte(wr * 64 + fr, fq * 8), boff = lds_byte(wc * 32 + fr, fq * 8);
#define PG8_SA(b, h) (((b) * 2 + (h)) * HTB)
#define PG8_SB(b, h) ((4 + (b) * 2 + (h)) * HTB)
#define PG8_STAGE(bufoff, gbase, voff) do { const char* _gb = (const char*)(gbase); asm volatile("" : "+s"(_gb)); _Pragma("unroll") for (int _i = 0; _i < 2; ++_i) \
        __builtin_amdgcn_global_load_lds((const unsigned*)(_gb + (voff)[_i]), (LAS unsigned*)(lds + (bufoff) + ldsw + _i * 8192), 16, 0, 0); } while (0)
#define PG8_LDA(dst, b, h) do { _Pragma("unroll") for (int m = 0; m < 4; ++m) _Pragma("unroll") for (int k = 0; k < 2; ++k) dst[m][k] = *(const LAS bf16x8*)(lds + PG8_SA(b, h) + aoff + m * 2048 + k * 1024); } while (0)
#define PG8_LDB(dst, b, h) do { _Pragma("unroll") for (int n = 0; n < 2; ++n) _Pragma("unroll") for (int k = 0; k < 2; ++k) dst[n][k] = *(const LAS bf16x8*)(lds + PG8_SB(b, h) + boff + n * 2048 + k * 1024); } while (0)
#define PG8_MMA(ai, bj, At, Bt) do { __builtin_amdgcn_s_setprio(1); _Pragma("unroll") for (int m = 0; m < 4; ++m) _Pragma("unroll") for (int n = 0; n < 2; ++n) _Pragma("unroll") for (int k = 0; k < 2; ++k) \
        acc[ai][bj][m][n] = __builtin_amdgcn_mfma_f32_16x16x32_bf16(Bt[n][k], At[m][k], acc[ai][bj][m][n], 0, 0, 0); __builtin_amdgcn_s_setprio(0); } while (0)
#define PG8_WAIT_V(n) asm volatile("s_waitcnt vmcnt(" #n ")" ::: "memory")
#define PG8_WAIT_L(n) asm volatile("s_waitcnt lgkmcnt(" #n ")" ::: "memory")
#define PG8_BAR __builtin_amdgcn_s_barrier()
#define PG8_SCHED __builtin_amdgcn_sched_barrier(0)
    Unit cur, nxt; int ui = 0;
    if (!S.next(0, cur)) return;
    f32x4 acc[2][2][4][2];
#pragma unroll
    for (int a = 0; a < 2; ++a)
#pragma unroll
        for (int b = 0; b < 2; ++b)
#pragma unroll
            for (int m = 0; m < 4; ++m)
#pragma unroll
                for (int n = 0; n < 2; ++n) acc[a][b][m][n] = (f32x4){0.f, 0.f, 0.f, 0.f};
    bf16x8 At[4][2], B0[2][2], B1[2][2];
    const char* cA = cur.A; const char* cB = cur.B;
    PG8_STAGE(PG8_SB(0, 0), cB, voffB); PG8_STAGE(PG8_SB(0, 1), cB + hstepB, voffB); PG8_STAGE(PG8_SA(0, 0), cA, voffA); PG8_STAGE(PG8_SA(0, 1), cA + hstepA, voffA);
    if (wr == 1) PG8_BAR;
    PG8_WAIT_V(2); PG8_BAR;
    PG8_STAGE(PG8_SB(1, 0), cB + kstep, voffB); PG8_STAGE(PG8_SA(1, 0), cA + kstep, voffA); PG8_STAGE(PG8_SB(1, 1), cB + hstepB + kstep, voffB);
    PG8_WAIT_V(6); PG8_BAR;
    for (;;) {
        const bool has_next = S.next(ui + 1, nxt);
        const char* nA = has_next ? nxt.A : cA; const char* nB = has_next ? nxt.B : cB;
        const int nt = cur.nt;
        for (int t = 0; t < nt; t += 2) {
            const bool last = (t == nt - 2);
            const char* a1 = cA + (size_t)(t + 1) * kstep;
            const char* a2 = last ? nA : cA + (size_t)(t + 2) * kstep; const char* b2 = last ? nB : cB + (size_t)(t + 2) * kstep;
            const char* a3 = a2 + kstep; const char* b3 = b2 + kstep;
            PG8_LDB(B0, 0, 0); PG8_LDB(B1, 0, 1); PG8_SCHED; PG8_LDA(At, 0, 0); PG8_STAGE(PG8_SA(1, 1), a1 + hstepA, voffA);
            PG8_WAIT_V(8); PG8_WAIT_L(0); PG8_BAR; PG8_MMA(0, 0, At, B0); PG8_MMA(0, 1, At, B1); PG8_BAR; PG8_SCHED;
            PG8_LDA(At, 0, 1); PG8_STAGE(PG8_SB(0, 0), b2, voffB); PG8_STAGE(PG8_SB(0, 1), b2 + hstepB, voffB); PG8_STAGE(PG8_SA(0, 0), a2, voffA);
            PG8_WAIT_V(8); PG8_WAIT_L(0); PG8_BAR; PG8_MMA(1, 0, At, B0); PG8_MMA(1, 1, At, B1); PG8_BAR; PG8_SCHED;
            PG8_LDB(B0, 1, 0); PG8_LDB(B1, 1, 1); PG8_SCHED; PG8_LDA(At, 1, 0); PG8_STAGE(PG8_SA(0, 1), a2 + hstepA, voffA);
            PG8_WAIT_V(8); PG8_WAIT_L(0); PG8_BAR; PG8_MMA(0, 0, At, B0); PG8_MMA(0, 1, At, B1); PG8_BAR; PG8_SCHED;
            PG8_LDA(At, 1, 1); PG8_STAGE(PG8_SB(1, 0), b3, voffB); PG8_STAGE(PG8_SB(1, 1), b3 + hstepB, voffB); PG8_STAGE(PG8_SA(1, 0), a3, voffA);
            PG8_WAIT_V(8); PG8_WAIT_L(0); PG8_BAR; PG8_MMA(1, 0, At, B0); PG8_MMA(1, 1, At, B1); PG8_BAR; PG8_SCHED;
            if constexpr (Epi::HAS_MID) { if (t + 2 == 8 || t + 2 == 16) { E.mid(acc, cur, t + 2, wr, wc, fr, fq); PG8_SCHED; } }
        }
        if (wr == 0) PG8_BAR;
        E(acc, cur, wr, wc, fr, fq);
        if (!has_next) break;
#pragma unroll
        for (int a = 0; a < 2; ++a)
#pragma unroll
            for (int b = 0; b < 2; ++b)
#pragma unroll
                for (int m = 0; m < 4; ++m)
#pragma unroll
                    for (int n = 0; n < 2; ++n) acc[a][b][m][n] = (f32x4){0.f, 0.f, 0.f, 0.f};
        cur = nxt; cA = nA; cB = nB; ++ui;
        if (wr == 1) PG8_BAR;
    }
    PG8_WAIT_V(0);
    PG8_BAR;
#undef PG8_SA
#undef PG8_SB
#undef PG8_STAGE
#undef PG8_LDA
#undef PG8_LDB
#undef PG8_MMA
#undef PG8_WAIT_V
#undef PG8_WAIT_L
#undef PG8_BAR
#undef PG8_SCHED
}
}

struct Frame {
    LAS unsigned char* lds;
    volatile LAS unsigned* MISC;
    unsigned* ctl;
    int tid, lane, wave, G, bid;
    const float* const __attribute__((address_space(4)))* in;
    float* out; unsigned char* ws;
};
enum { IN_X = 0, IN_NORM1, IN_WIN, IN_BGATE, IN_LRE, IN_LIM, IN_BRE, IN_BIM, IN_CRE, IN_CIM, IN_S5D, IN_LOGDT, IN_GLU1, IN_GLU2, IN_QG, IN_KG, IN_SINK,
       IN_CONVW, IN_CONVB, IN_DTB, IN_ALOG, IN_SSDD, IN_SSDG, IN_PS5, IN_PATTN, IN_PSSD, IN_WOUT, IN_NORM2, IN_WRG, IN_BRG, IN_WRE, IN_BRE_, IN_EG, IN_EU, IN_ED, N_INPUTS };

#define LDS_WAIT() asm volatile("s_waitcnt lgkmcnt(0)" ::: "memory")
#define VM_WAIT() asm volatile("s_waitcnt vmcnt(0)" ::: "memory")

using pg8::Unit; using pg8::pack8;
struct EpiProj {
    static constexpr bool PERM = true, HAS_MID = false;
    unsigned char* ws; const float* bgate;
    __device__ __forceinline__ void operator()(const f32x4 (&acc)[2][2][4][2], const Unit& u, int wr, int wc, int fr, int fq) const {
        bf16_t* P = (bf16_t*)(ws + WS_P); bf16_t* UH = (bf16_t*)(ws + WS_UH); float* DT = (float*)(ws + WS_DT);
        const int row0 = u.pm * 256 + wr * 64 + fr;
        if (u.pn < 2) {
#pragma unroll
            for (int ai = 0; ai < 2; ++ai)
#pragma unroll
                for (int m = 0; m < 4; ++m) { const int row = row0 + ai * 128 + m * 16, r = row >> 5, s = row & 31;
#pragma unroll
                    for (int bj = 0; bj < 2; ++bj) { const int col = u.pn * 256 + bj * 128 + wc * 32 + 8 * fq, g = col >> 4, c0 = col & 15;
                        *(u32x4*)(UH + ((size_t)(g * S5_ROWS + r) * S5_K + 128 + s * 16 + c0)) = pack8(acc[ai][bj][m][0], acc[ai][bj][m][1]); } }
        } else {
            const int colb = u.pn * 256 + wc * 32 + 8 * fq;
            f32x4 bv[2][2];
#pragma unroll
            for (int bj = 0; bj < 2; ++bj)
#pragma unroll
                for (int n = 0; n < 2; ++n) bv[bj][n] = (u.pn >= 15) ? *(const f32x4*)(bgate + (colb - C_G) + bj * 128 + 4 * n) : (f32x4){0.f, 0.f, 0.f, 0.f};
#pragma unroll
            for (int ai = 0; ai < 2; ++ai)
#pragma unroll
                for (int m = 0; m < 4; ++m) { const int row = row0 + ai * 128 + m * 16;
#pragma unroll
                    for (int bj = 0; bj < 2; ++bj) { f32x4 v0 = acc[ai][bj][m][0] + bv[bj][0], v1 = acc[ai][bj][m][1] + bv[bj][1];
                        if (u.pn >= 15) {
#pragma unroll
                            for (int j = 0; j < 4; ++j) { v0[j] = fmaxf(sigmoidf_(v0[j]), 1e-30f); v1[j] = fmaxf(sigmoidf_(v1[j]), 1e-30f); } }
                        *(u32x4*)(P + (size_t)row * NINP + colb + bj * 128) = pack8(v0, v1); }
                    if (u.pn == 14 && wc == 0 && fq < 2) { float* d = DT + (size_t)row * 16 + 8 * fq; *(f32x4*)d = acc[ai][0][m][0]; *(f32x4*)(d + 4) = acc[ai][0][m][1]; } }
        }
    }
};
struct EpiHloc {
    static constexpr bool PERM = false, HAS_MID = false;
    float* H;
    __device__ __forceinline__ void operator()(const f32x4 (&acc)[2][2][4][2], const Unit& u, int wr, int wc, int fr, int fq) const {
#pragma unroll
        for (int ai = 0; ai < 2; ++ai)
#pragma unroll
            for (int m = 0; m < 4; ++m) { const int r = u.pm * 256 + ai * 128 + wr * 64 + m * 16 + fr; float* rowp = H + ((size_t)(u.aux * S5_ROWS + r) * 128) + wc * 32 + 4 * fq;
#pragma unroll
                for (int n = 0; n < 2; ++n) *(f32x4*)(rowp + 16 * n) = acc[ai][0][m][n]; }
    }
};
struct EpiS5Y {
    static constexpr bool PERM = true, HAS_MID = false;
    bf16_t* Y;
    __device__ __forceinline__ void operator()(const f32x4 (&acc)[2][2][4][2], const Unit& u, int wr, int wc, int fr, int fq) const {
#pragma unroll
        for (int ai = 0; ai < 2; ++ai)
#pragma unroll
            for (int m = 0; m < 4; ++m) { const int r = u.pm * 256 + ai * 128 + wr * 64 + m * 16 + fr;
#pragma unroll
                for (int bj = 0; bj < 2; ++bj) { const int n0 = u.pn * 256 + bj * 128 + wc * 32 + 8 * fq, t = n0 >> 4, c0 = n0 & 15;
                    f32x4 v0 = acc[ai][bj][m][0], v1 = acc[ai][bj][m][1];
#pragma unroll
                    for (int j = 0; j < 4; ++j) { v0[j] = gelu_tanh_(v0[j]); v1[j] = gelu_tanh_(v1[j]); }
                    *(u32x4*)(Y + ((size_t)(r * S5_TC + t) * 512 + u.aux * 16 + c0)) = pack8(v0, v1); } }
    }
};
struct EpiGlu {
    static constexpr bool PERM = true, HAS_MID = false;
    bf16_t* Y;
    __device__ __forceinline__ void operator()(const f32x4 (&acc)[2][2][4][2], const Unit& u, int wr, int wc, int fr, int fq) const {
#pragma unroll
        for (int ai = 0; ai < 2; ++ai)
#pragma unroll
            for (int m = 0; m < 4; ++m) { const int row = u.pm * 256 + ai * 128 + wr * 64 + m * 16 + fr;
                f32x4 v0 = acc[ai][0][m][0], v1 = acc[ai][0][m][1]; const f32x4 g0 = acc[ai][1][m][0], g1 = acc[ai][1][m][1];
#pragma unroll
                for (int j = 0; j < 4; ++j) { v0[j] *= sigmoidf_(g0[j]); v1[j] *= sigmoidf_(g1[j]); }
                *(u32x4*)(Y + (size_t)row * 2048 + u.pn * 128 + wc * 32 + 8 * fq) = pack8(v0, v1); }
    }
};
struct EpiSwiGlu {
    static constexpr bool PERM = true, HAS_MID = false;
    bf16_t* Y; const float* RSG;
    __device__ __forceinline__ void operator()(const f32x4 (&acc)[2][2][4][2], const Unit& u, int wr, int wc, int fr, int fq) const {
#pragma unroll
        for (int ai = 0; ai < 2; ++ai)
#pragma unroll
            for (int m = 0; m < 4; ++m) { const int row = u.pm * 256 + ai * 128 + wr * 64 + m * 16 + fr;
                f32x4 v0 = acc[ai][0][m][0], v1 = acc[ai][0][m][1]; const f32x4 g0 = acc[ai][1][m][0], g1 = acc[ai][1][m][1]; const float rr = 1.f;
#pragma unroll
                for (int j = 0; j < 4; ++j) { v0[j] = siluf_(v0[j] * rr) * (g0[j] * rr); v1[j] = siluf_(v1[j] * rr) * (g1[j] * rr); }
                *(u32x4*)(Y + (size_t)row * 512 + u.pn * 128 + wc * 32 + 8 * fq) = pack8(v0, v1); }
    }
};
struct EpiPlainBf16 {
    static constexpr bool PERM = true, HAS_MID = false;
    bf16_t* O;
    __device__ __forceinline__ void operator()(const f32x4 (&acc)[2][2][4][2], const Unit& u, int wr, int wc, int fr, int fq) const {
#pragma unroll
        for (int ai = 0; ai < 2; ++ai)
#pragma unroll
            for (int m = 0; m < 4; ++m) { const int row = u.pm * 256 + ai * 128 + wr * 64 + m * 16 + fr;
#pragma unroll
                for (int bj = 0; bj < 2; ++bj) *(u32x4*)(O + (size_t)row * 1024 + u.pn * 256 + bj * 128 + wc * 32 + 8 * fq) = pack8(acc[ai][bj][m][0], acc[ai][bj][m][1]); }
    }
};
struct EpiMerged {
    static constexpr bool PERM = true, HAS_MID = true;
    unsigned char* ws;
    __device__ __forceinline__ static float lclamp(float l) { return fminf(fmaxf(l, -30.f), 30.f); }
    __device__ __forceinline__ void mid(f32x4 (&acc)[2][2][4][2], const Unit& u, int kt, int wr, int wc, int fr, int fq) const {
        const int br = (kt == 8) ? 0 : 1; const bf16_t* P = (const bf16_t*)(ws + WS_P);
#pragma unroll
        for (int ai = 0; ai < 2; ++ai)
#pragma unroll
            for (int m = 0; m < 4; ++m) { const int row = u.pm * 256 + ai * 128 + wr * 64 + m * 16 + fr;
#pragma unroll
                for (int bj = 0; bj < 2; ++bj) { const bf16_t* gp = P + (size_t)row * NINP + C_G + br * 1024 + u.pn * 256 + bj * 128 + wc * 32 + 8 * fq;
                    const u32x4 la = *(const u32x4*)gp, lb = *(const u32x4*)(gp + 1024);
#pragma unroll
                    for (int j = 0; j < 4; ++j) { const unsigned wa = la[j], wb = lb[j];
                        const float r0 = bflo(wa) * frcp(bflo(wb)), r1 = bfhi(wa) * frcp(bfhi(wb));
                        if (j < 2) { acc[ai][bj][m][0][2 * j] *= r0; acc[ai][bj][m][0][2 * j + 1] *= r1; } else { acc[ai][bj][m][1][2 * j - 4] *= r0; acc[ai][bj][m][1][2 * j - 3] *= r1; } } }
                if (m == 3) asm volatile("" ::: "memory"); }
    }
    __device__ __forceinline__ void operator()(const f32x4 (&acc)[2][2][4][2], const Unit& u, int wr, int wc, int fr, int fq) const {
        const bf16_t* P = (const bf16_t*)(ws + WS_P); bf16_t* O = (bf16_t*)(ws + WS_XN);
#pragma unroll
        for (int ai = 0; ai < 2; ++ai)
#pragma unroll
            for (int m = 0; m < 4; ++m) { const int row = u.pm * 256 + ai * 128 + wr * 64 + m * 16 + fr;
#pragma unroll
                for (int bj = 0; bj < 2; ++bj) { const int col = u.pn * 256 + bj * 128 + wc * 32 + 8 * fq;
                    const u32x4 lc = *(const u32x4*)(P + (size_t)row * NINP + C_G + 2048 + col);
                    f32x4 v0 = acc[ai][bj][m][0], v1 = acc[ai][bj][m][1];
                    v0[0] *= bflo(lc[0]); v0[1] *= bfhi(lc[0]); v0[2] *= bflo(lc[1]); v0[3] *= bfhi(lc[1]);
                    v1[0] *= bflo(lc[2]); v1[1] *= bfhi(lc[2]); v1[2] *= bflo(lc[3]); v1[3] *= bfhi(lc[3]);
                    *(u32x4*)(O + (size_t)row * 1024 + col) = pack8(v0, v1); }
                if (m == 3) asm volatile("" ::: "memory"); }
    }
};
struct EpiResid {
    static constexpr bool PERM = false, HAS_MID = false;
    const float* resid; float* out;
    __device__ __forceinline__ void operator()(const f32x4 (&acc)[2][2][4][2], const Unit& u, int wr, int wc, int fr, int fq) const {
#pragma unroll
        for (int ai = 0; ai < 2; ++ai)
#pragma unroll
            for (int m = 0; m < 4; ++m) { const size_t off = (size_t)(u.pm * 256 + ai * 128 + wr * 64 + m * 16 + fr) * 1024 + u.pn * 256 + wc * 32 + 4 * fq;
#pragma unroll
                for (int bj = 0; bj < 2; ++bj)
#pragma unroll
                    for (int n = 0; n < 2; ++n) { const f32x4 rv = *(const f32x4*)(resid + off + bj * 128 + n * 16); *(f32x4*)(out + off + bj * 128 + n * 16) = rv + acc[ai][bj][m][n]; } }
    }
};

template <unsigned lda, unsigned ldb, int nM, int nN, int NT>
struct SchedDense {
    const char* A; const char* B; int G, c;
    __device__ __forceinline__ bool next(int i, Unit& u) const {
        const int L = i * G + c; if (L >= nM * nN) return false;
        int pm, pn; pg8::tile_order(L, nM, nN, pm, pn);
        u.A = A + (size_t)pm * 256 * lda; u.B = B + (size_t)pn * 256 * ldb; u.nt = NT; u.pm = pm; u.pn = pn; u.aux = 0; return true;
    }
};
struct SchedS5P1 {
    const char* UH; const char* EG; int G, c;
    __device__ __forceinline__ bool next(int i, Unit& u) const {
        const int L = i * G + c; if (L >= 64) return false;
        const int g = L >> 1, pm = L & 1;
        u.A = UH + ((size_t)(g * S5_ROWS + pm * 256) * S5_K + 128) * 2; u.B = EG + (size_t)g * 256 * 512 * 2; u.nt = 8; u.pm = pm; u.pn = 0; u.aux = g; return true;
    }
};
struct SchedS5Main {
    const char* UH; const char* MG; int G, c;
    __device__ __forceinline__ bool next(int i, Unit& u) const {
        const int L = i * G + c; if (L >= 128) return false;
        const int g = L >> 2, pm = (L >> 1) & 1, pn = L & 1;
        u.A = UH + (size_t)(g * S5_ROWS + pm * 256) * S5_K * 2; u.B = MG + (size_t)(g * S5_N + pn * 256) * S5_K * 2; u.nt = 2 + 4 * (pn + 1); u.pm = pm; u.pn = pn; u.aux = g; return true;
    }
};
template <unsigned lda, size_t bexp  , size_t btile  , int NT>
struct SchedMoe {
    const char* A; const char* B; int ntiles, G, c; const volatile LAS int* tile_e;
    __device__ __forceinline__ bool next(int i, Unit& u) const {
        const int L = i * G + c; if (L >= ntiles * 4) return false;
        int pm, pn; pg8::tile_order(L, ntiles, 4, pm, pn);
        const int e = __builtin_amdgcn_readfirstlane(tile_e[pm]);
        u.A = A + (size_t)pm * 256 * lda; u.B = B + (size_t)e * bexp + (size_t)pn * btile; u.nt = NT; u.pm = pm; u.pn = pn; u.aux = e; return true;
    }
};

__device__ __forceinline__ void transpose_item(const float* W, int ldw, int ncols, bf16_t* WT, int ldt, int kofs, int mode, int p0, int p1, LAS float* scr, int k0, int n0, int lane) {
    float wv[32];
#pragma unroll
    for (int i = 0; i < 32; ++i) { const int kk = 2 * i + (lane >> 5), n = n0 + (lane & 31); wv[i] = (n < ncols) ? W[(size_t)(k0 + kk) * ldw + n] : 0.f; }
#pragma unroll
    for (int i = 0; i < 32; ++i) { const int kk = 2 * i + (lane >> 5); scr[kk * 33 + (lane & 31)] = wv[i]; }
    LDS_WAIT(); asm volatile("" ::: "memory");
    const int c = lane & 7;
#pragma unroll
    for (int j = 0; j < 4; ++j) { const int nn = (lane >> 3) + 8 * j, n = n0 + nn; const LAS float* s = scr + (8 * c) * 33 + nn;
        u32x4 o; o.x = pk2(s[0 * 33], s[1 * 33]); o.y = pk2(s[2 * 33], s[3 * 33]); o.z = pk2(s[4 * 33], s[5 * 33]); o.w = pk2(s[6 * 33], s[7 * 33]);
        const int drow = (mode == 0) ? n + (n >= p0 ? p1 : 0) : ((n >> 7) * 256 + (n & 127) + 128 * p0);
        if (n < ncols) *(u32x4*)(WT + (size_t)drow * ldt + kofs + k0 + 8 * c) = o; }
    LDS_WAIT(); asm volatile("" ::: "memory");
}
__device__ __forceinline__ void convert_weights(Frame& F, int layer) {
    LAS float* scr = (LAS float*)(F.lds + F.wave * 16384);
    const int gw = F.bid * NWAVES + F.wave, NGW = F.G * NWAVES;
    bf16_t* WIN = (bf16_t*)(F.ws + WS_WIN); bf16_t* WGLU = (bf16_t*)(F.ws + WS_WGLU); bf16_t* PCAT = (bf16_t*)(F.ws + WS_PCAT); bf16_t* WOUT = (bf16_t*)(F.ws + WS_WOUT);
    bf16_t* EGU = (bf16_t*)(F.ws + WS_EGU); bf16_t* EDN = (bf16_t*)(F.ws + WS_EDN);
    constexpr int I_WIN = 16 * 209, I_GLU = 8 * 16, I_P5 = 8 * 32, I_PS = 16 * 32, I_WO = 16 * 32, I_EG = 32 * 256, I_ED = 32 * 256;
    constexpr int NITEMS = I_WIN + 2 * I_GLU + 2 * I_P5 + I_PS + I_WO + 2 * I_EG + I_ED;
    for (int it = gw; it < NITEMS; it += NGW) {
        int r = it;
        if (r < I_WIN) { transpose_item(F.in[IN_WIN] + (size_t)layer * DM * NIN, NIN, NIN, WIN, DM, 0, 0, 3600, 240, scr, 64 * (r / 209), 32 * (r % 209), F.lane); continue; } r -= I_WIN;
        if (r < I_GLU) { transpose_item(F.in[IN_GLU1] + (size_t)layer * 512 * 512, 512, 512, WGLU, 512, 0, 1, 0, 0, scr, 64 * (r / 16), 32 * (r % 16), F.lane); continue; } r -= I_GLU;
        if (r < I_GLU) { transpose_item(F.in[IN_GLU2] + (size_t)layer * 512 * 512, 512, 512, WGLU, 512, 0, 1, 1, 0, scr, 64 * (r / 16), 32 * (r % 16), F.lane); continue; } r -= I_GLU;
        if (r < I_P5) { transpose_item(F.in[IN_PS5] + (size_t)layer * 512 * 1024, 1024, 1024, PCAT, 2048, 0, 0, 1 << 30, 0, scr, 64 * (r / 32), 32 * (r % 32), F.lane); continue; } r -= I_P5;
        if (r < I_P5) { transpose_item(F.in[IN_PATTN] + (size_t)layer * 512 * 1024, 1024, 1024, PCAT, 2048, 512, 0, 1 << 30, 0, scr, 64 * (r / 32), 32 * (r % 32), F.lane); continue; } r -= I_P5;
        if (r < I_PS) { transpose_item(F.in[IN_PSSD] + (size_t)layer * 1024 * 1024, 1024, 1024, PCAT, 2048, 1024, 0, 1 << 30, 0, scr, 64 * (r / 32), 32 * (r % 32), F.lane); continue; } r -= I_PS;
        if (r < I_WO) { transpose_item(F.in[IN_WOUT] + (size_t)layer * 1024 * 1024, 1024, 1024, WOUT, 1024, 0, 0, 1 << 30, 0, scr, 64 * (r / 32), 32 * (r % 32), F.lane); continue; } r -= I_WO;
        if (r < I_EG) { const int e = r >> 8, q = r & 255; transpose_item(F.in[IN_EG] + ((size_t)layer * 32 + e) * 1024 * 512, 512, 512, EGU + (size_t)e * 1024 * 1024, 1024, 0, 1, 0, 0, scr, 64 * (q / 16), 32 * (q % 16), F.lane); continue; } r -= I_EG;
        if (r < I_EG) { const int e = r >> 8, q = r & 255; transpose_item(F.in[IN_EU] + ((size_t)layer * 32 + e) * 1024 * 512, 512, 512, EGU + (size_t)e * 1024 * 1024, 1024, 0, 1, 1, 0, scr, 64 * (q / 16), 32 * (q % 16), F.lane); continue; } r -= I_EG;
        { const int e = r >> 8, q = r & 255; transpose_item(F.in[IN_ED] + ((size_t)layer * 32 + e) * 512 * 1024, 1024, 1024, EDN + (size_t)e * 1024 * 512, 512, 0, 0, 1 << 30, 0, scr, 64 * (q / 32), 32 * (q % 32), F.lane); }
    }
}
__device__ __forceinline__ void sincos_fast(float x, float& s, float& c) {
    const float k = rintf(x * 0.15915494309189535f);
    float r = fmaf(-k, 6.2831854820251465f, x); r = fmaf(-k, -1.7484555e-07f, r);
    s = __sinf(r); c = __cosf(r);
}
__device__ __forceinline__ void sincos_red(float x, float& s, float& c) {
    const float k = rintf(x * 0.15915494309189535f);
    float r = fmaf(-k, 6.2831854820251465f, x); r = fmaf(-k, -1.7484555e-07f, r);
    s = sinf(r); c = cosf(r);
}
__device__ __forceinline__ void s5_build(Frame& F, int layer) {
    LAS float* pw = (LAS float*)F.lds;
    LAS float* Bb = pw + 33 * 64 * 2;
    LAS float* Cc = Bb + 64 * 16 * 2;
    LAS float* Kd = Cc + 16 * 64 * 2;
    bf16_t* MG = (bf16_t*)(F.ws + WS_MG); bf16_t* EG = (bf16_t*)(F.ws + WS_EG);
    for (int w = F.bid; w < 256; w += F.G) {
        const int g = w >> 3, part = w & 7, gi = layer * 32 + g;
        __syncthreads();
        const float dt = __expf(F.in[IN_LOGDT][gi]);
        for (int i = F.tid; i < 33 * 64; i += NTHR) { const int d = i >> 6, p = i & 63; const float lr = F.in[IN_LRE][gi * 64 + p], li = F.in[IN_LIM][gi * 64 + p];
            float s, c; sincos_red((float)d * li * dt, s, c); const float mg = __expf((float)d * lr * dt); pw[2 * i] = mg * c; pw[2 * i + 1] = mg * s; }
        for (int i = F.tid; i < 64 * 16; i += NTHR) { const int p = i >> 4; const float lr = F.in[IN_LRE][gi * 64 + p], li = F.in[IN_LIM][gi * 64 + p];
            float s, c; sincos_red(li * dt, s, c); const float mg = __expf(lr * dt), are = mg * c, aim = mg * s, nr = are - 1.f, den = lr * lr + li * li;
            const float fre = (nr * lr + aim * li) / den, fim = (aim * lr - nr * li) / den;
            const float br = F.in[IN_BRE][(size_t)gi * 1024 + i], bi = F.in[IN_BIM][(size_t)gi * 1024 + i];
            Bb[2 * i] = fre * br - fim * bi; Bb[2 * i + 1] = fre * bi + fim * br; }
        for (int i = F.tid; i < 16 * 64; i += NTHR) { Cc[2 * i] = F.in[IN_CRE][(size_t)gi * 1024 + i]; Cc[2 * i + 1] = F.in[IN_CIM][(size_t)gi * 1024 + i]; }
        __syncthreads();
        { const int d = F.tid >> 4, c = F.tid & 15; float acc[16];
#pragma unroll
          for (int j = 0; j < 16; ++j) acc[j] = 0.f;
          for (int p = 0; p < 64; ++p) { const float cr = Cc[2 * (c * 64 + p)], ci = Cc[2 * (c * 64 + p) + 1], pr = pw[2 * (d * 64 + p)], pi = pw[2 * (d * 64 + p) + 1];
              const float xr = cr * pr - ci * pi, xi = cr * pi + ci * pr;
#pragma unroll
              for (int q = 0; q < 8; ++q) { const f32x4 bb = *(const LAS f32x4*)(Bb + 2 * (p * 16) + 4 * q); acc[2 * q] += xr * bb.x - xi * bb.y; acc[2 * q + 1] += xr * bb.z - xi * bb.w; } }
#pragma unroll
          for (int j = 0; j < 16; ++j) Kd[(d * 16 + c) * 16 + j] = acc[j]; }
        __syncthreads();
        for (int v = F.tid; v < 64 * 80; v += NTHR) { const int n = part * 64 + v / 80, k0 = (v % 80) * 8, t = n >> 4, c = n & 15; float o[8];
            if (k0 < 128) { const int im = k0 >= 64, p0 = k0 & 63;
#pragma unroll
                for (int j = 0; j < 8; ++j) { const int p = p0 + j; const float cr = Cc[2 * (c * 64 + p)], ci = Cc[2 * (c * 64 + p) + 1], pr = pw[2 * ((t + 1) * 64 + p)], pi = pw[2 * ((t + 1) * 64 + p) + 1];
                    o[j] = im ? -(cr * pi + ci * pr) : (cr * pr - ci * pi); }
            } else { const int s = (k0 - 128) >> 4, c0 = (k0 - 128) & 15;
#pragma unroll
                for (int j = 0; j < 8; ++j) { float x = 0.f; if (s <= t) { x = Kd[(t - s) * 256 + c * 16 + c0 + j]; if (s == t && c == c0 + j) x += F.in[IN_S5D][layer * 512 + g * 16 + c]; } o[j] = x; } }
            u32x4 q; q.x = pk2(o[0], o[1]); q.y = pk2(o[2], o[3]); q.z = pk2(o[4], o[5]); q.w = pk2(o[6], o[7]);
            *(u32x4*)(MG + ((size_t)(g * S5_N + n) * S5_K + k0)) = q; }
        for (int v = F.tid; v < 16 * 64; v += NTHR) { const int jr = part * 16 + v / 64, k0 = (v % 64) * 8, im = jr >= 64, p = jr & 63, s = k0 >> 4, c0 = k0 & 15; float o[8];
            const float pr = pw[2 * ((S5_TC - 1 - s) * 64 + p)], pi = pw[2 * ((S5_TC - 1 - s) * 64 + p) + 1];
#pragma unroll
            for (int j = 0; j < 8; ++j) { const float br = Bb[2 * (p * 16 + c0 + j)], bi = Bb[2 * (p * 16 + c0 + j) + 1]; o[j] = im ? (pr * bi + pi * br) : (pr * br - pi * bi); }
            u32x4 q; q.x = pk2(o[0], o[1]); q.y = pk2(o[2], o[3]); q.z = pk2(o[4], o[5]); q.w = pk2(o[6], o[7]);
            *(u32x4*)(EG + ((size_t)(g * 256 + jr) * 512 + k0)) = q; }
    }
    __syncthreads();
}
__device__ __forceinline__ void rms_row_to_bf16(const float* xrow, const float* gain, bf16_t* orow, int lane) {
    const f32x4* xr = (const f32x4*)xrow + lane; const f32x4* gr = (const f32x4*)gain + lane;
    f32x4 v[4]; float s = 0.f;
#pragma unroll
    for (int j = 0; j < 4; ++j) { v[j] = xr[64 * j]; s += (v[j].x * v[j].x + v[j].y * v[j].y) + (v[j].z * v[j].z + v[j].w * v[j].w); }
    const float rstd = __builtin_amdgcn_rsqf(wave_sum(s) * (1.f / DM) + NORM_EPS);
    unsigned long long* o8 = (unsigned long long*)orow + lane;
#pragma unroll
    for (int j = 0; j < 4; ++j) { const f32x4 gv = gr[64 * j]; o8[64 * j] = (unsigned long long)pk2(v[j].x * rstd * gv.x, v[j].y * rstd * gv.y) | ((unsigned long long)pk2(v[j].z * rstd * gv.z, v[j].w * rstd * gv.w) << 32); }
}
__device__ __forceinline__ void rmsnorm_rows(Frame& F, const float* x, const float* gain, bf16_t* o) {
    const int gw = F.bid * NWAVES + F.wave, NGW = F.G * NWAVES;
    for (int m = gw; m < T; m += NGW) rms_row_to_bf16(x + (size_t)m * DM, gain, o + (size_t)m * DM, F.lane);
}

__device__ __forceinline__ void s5_scan(Frame& F, int layer) {
    const float* HL = (const float*)(F.ws + WS_HLOC); bf16_t* UH = (bf16_t*)(F.ws + WS_UH);
    for (int i = (F.G - 1 - F.bid) * NTHR + F.tid; i < BATCH * 32 * 64; i += F.G * NTHR) {
        const int p = i & 63, g = (i >> 6) & 31, b = i >> 11, gi = layer * 32 + g;
        const float dt = __expf(F.in[IN_LOGDT][gi]), lr = F.in[IN_LRE][gi * 64 + p], li = F.in[IN_LIM][gi * 64 + p];
        float s, c; sincos_red((float)S5_TC * li * dt, s, c); const float mg = __expf((float)S5_TC * lr * dt), ar = mg * c, ai = mg * s;
        float hr = 0.f, hi = 0.f;
        const int nch = SEQ / S5_TC;
        for (int c0 = 0; c0 < nch; c0 += 32) { float lr_[32], li_[32];
#pragma unroll
            for (int k = 0; k < 32; ++k) { const size_t r = (size_t)g * S5_ROWS + b * nch + c0 + k; lr_[k] = HL[r * 128 + p]; li_[k] = HL[r * 128 + 64 + p]; }
#pragma unroll
            for (int k = 0; k < 32; ++k) { const size_t r = (size_t)g * S5_ROWS + b * nch + c0 + k;
                UH[r * S5_K + p] = (bf16_t)f2bf(hr); UH[r * S5_K + 64 + p] = (bf16_t)f2bf(hi);
                const float nr = ar * hr - ai * hi + lr_[k], ni = ar * hi + ai * hr + li_[k]; hr = nr; hi = ni; } }
    }
}

__device__ __forceinline__ void ssd_stage_bc(Frame& F, int layer, int b, int ch, int grp, LAS float* Bs, LAS float* Cs, LAS float* dts, LAS float* das) {
    const bf16_t* P = (const bf16_t*)(F.ws + WS_P); const float* DT = (const float*)(F.ws + WS_DT);
    const float* cw = F.in[IN_CONVW] + layer * 4 * 1280; const float* cb = F.in[IN_CONVB] + layer * 1280;
    const int l0 = ch * 128; const size_t row0 = (size_t)b * SEQ + l0;
    for (int i = F.tid; i < 2 * 128 * 64; i += NTHR) { const int isC = i >> 13, t = (i >> 6) & 127, n = i & 63;
        const int col = (isC ? C_C : C_B) + grp * 64 + n, cc = 1024 + isC * 128 + grp * 64 + n; float a = cb[cc];
#pragma unroll
        for (int j = 0; j < 4; ++j) { const int l = l0 + t - 3 + j; if (l >= 0) a += cw[j * 1280 + cc] * bf2f(P[(row0 + t - 3 + j) * NINP + col]); }
        (isC ? Cs : Bs)[t * 64 + n] = siluf_(a); }
    for (int i = F.tid; i < 128 * 8; i += NTHR) { const int t = i >> 3, hh = i & 7, h = grp * 8 + hh;
        const float dt = softplusf_(DT[(row0 + t) * 16 + h] + F.in[IN_DTB][layer * 16 + h]); dts[i] = dt; das[i] = dt * (-__expf(F.in[IN_ALOG][layer * 16 + h])); }
}
template <bool OUT>
__device__ __forceinline__ void ssd_units(Frame& F, int layer) {
    LAS float* Bs = (LAS float*)F.lds; LAS float* Cs = Bs + 128 * 64; LAS float* dts = Cs + 128 * 64; LAS float* das = dts + 128 * 8; LAS float* ssq = das + 128 * 8;
    const bf16_t* P = (const bf16_t*)(F.ws + WS_P); float* SST = (float*)(F.ws + WS_SST); float* ASUM = (float*)(F.ws + WS_ASUM); bf16_t* YC = (bf16_t*)(F.ws + WS_YCAT);
    const float* cw = F.in[IN_CONVW] + layer * 4 * 1280; const float* cb = F.in[IN_CONVB] + layer * 1280;
    for (int u = F.bid; u < BATCH * SSD_NCH * 2; u += F.G) {
        const int grp = u & 1, ch = (u >> 1) & 31, b = u >> 6;
        __syncthreads();
        ssd_stage_bc(F, layer, b, ch, grp, Bs, Cs, dts, das);
        __syncthreads();
        const int hh = F.wave, h = grp * 8 + hh, p = F.lane, cx = h * 64 + p;
        const float w0 = cw[cx], w1 = cw[1280 + cx], w2 = cw[2560 + cx], w3 = cw[3840 + cx], bias = cb[cx], dsk = F.in[IN_SSDD][layer * 16 + h];
        const int l0 = ch * 128; const size_t row0 = (size_t)b * SEQ + l0;
        const bf16_t* xp = P + row0 * NINP + C_XS + cx;
        float x0 = 0.f, x1 = 0.f, x2 = 0.f;
        if (l0 > 0) { x0 = bf2f(xp[-3 * (ptrdiff_t)NINP]); x1 = bf2f(xp[-2 * (ptrdiff_t)NINP]); x2 = bf2f(xp[-1 * (ptrdiff_t)NINP]); }
        float st[64];
        float* sp = SST + ((((size_t)b * SSD_NCH + ch) * 16 + h) * 64 + p) * 64;
        if (OUT) {
#pragma unroll
            for (int n = 0; n < 64; n += 4) { const f32x4 v = *(const f32x4*)(sp + n); st[n] = v.x; st[n + 1] = v.y; st[n + 2] = v.z; st[n + 3] = v.w; }
        } else {
#pragma unroll
            for (int n = 0; n < 64; ++n) st[n] = 0.f;
        }
        float asum = 0.f;
#pragma unroll 4
        for (int t = 0; t < 128; ++t) {
            const float x3 = bf2f(xp[(size_t)t * NINP]);
            const float xs = siluf_(bias + w0 * x0 + w1 * x1 + w2 * x2 + w3 * x3);
            x0 = x1; x1 = x2; x2 = x3;
            const float dt = dts[t * 8 + hh], a = das[t * 8 + hh], da = __expf(a), xdt = xs * dt;
            asum += a;
            float y = 0.f;
#pragma unroll
            for (int n = 0; n < 64; n += 4) { const f32x4 bv = *(const LAS f32x4*)(Bs + t * 64 + n);
                st[n] = da * st[n] + bv.x * xdt; st[n + 1] = da * st[n + 1] + bv.y * xdt; st[n + 2] = da * st[n + 2] + bv.z * xdt; st[n + 3] = da * st[n + 3] + bv.w * xdt;
                if (OUT) { const f32x4 cv = *(const LAS f32x4*)(Cs + t * 64 + n); y += (cv.x * st[n] + cv.y * st[n + 1]) + (cv.z * st[n + 2] + cv.w * st[n + 3]); } }
            if (OUT) {
                const float z = bf2f(P[(row0 + t) * NINP + C_Z + cx]);
                const float yz = (y + dsk * xs) * siluf_(z);
                const float q = wave_sum(yz * yz);
                if (p == 0) ssq[t * 8 + hh] = q;
                YC[(row0 + t) * 2048 + 1024 + cx] = (bf16_t)f2bf(yz);
            }
        }
        if (!OUT) {
#pragma unroll
            for (int n = 0; n < 64; n += 4) *(f32x4*)(sp + n) = (f32x4){st[n], st[n + 1], st[n + 2], st[n + 3]};
            if (p == 0) ASUM[((size_t)b * SSD_NCH + ch) * 16 + h] = asum;
        } else {
            __syncthreads();
            const float ng = F.in[IN_SSDG][layer * 1024 + cx];
            for (int t = 0; t < 128; ++t) { float q = 0.f;
#pragma unroll
                for (int j = 0; j < 8; ++j) q += ssq[t * 8 + j];
                const float rs = __builtin_amdgcn_rsqf(q * (1.f / 512.f) + NORM_EPS);
                bf16_t* yp = YC + (row0 + t) * 2048 + 1024 + cx; *yp = (bf16_t)f2bf(bf2f(*yp) * rs * ng); }
        }
    }
}
__device__ __forceinline__ void ssd_scan(Frame& F) {
    float* SST = (float*)(F.ws + WS_SST); const float* ASUM = (const float*)(F.ws + WS_ASUM);
    for (int i = F.bid * NTHR + F.tid; i < BATCH * 16 * 1024; i += F.G * NTHR) {
        const int pn = (i & 1023) * 4, h = (i >> 10) & 15, b = i >> 14; f32x4 s = {0.f, 0.f, 0.f, 0.f};
        f32x4 loc[SSD_NCH]; float dec[SSD_NCH];
#pragma unroll
        for (int ch = 0; ch < SSD_NCH; ++ch) { loc[ch] = *(const f32x4*)(SST + (((size_t)b * SSD_NCH + ch) * 16 + h) * 4096 + pn); dec[ch] = ASUM[((size_t)b * SSD_NCH + ch) * 16 + h]; }
#pragma unroll
        for (int ch = 0; ch < SSD_NCH; ++ch) { *(f32x4*)(SST + (((size_t)b * SSD_NCH + ch) * 16 + h) * 4096 + pn) = s; s = s * __expf(dec[ch]) + loc[ch]; }
    }
}

__device__ __forceinline__ void attn_units(Frame& F, int layer) {
    LAS float* Ks = (LAS float*)F.lds; LAS float* Vs = Ks + 256 * 64;
    const bf16_t* P = (const bf16_t*)(F.ws + WS_P); bf16_t* YC = (bf16_t*)(F.ws + WS_YCAT);
    const float* qg = F.in[IN_QG] + layer * 64; const float* kg = F.in[IN_KG] + layer * 64;
    for (int u = F.bid; u < BATCH * 32 * 2; u += F.G) {
        const int kvh = u & 1, qb = (u >> 1) & 31, b = u >> 6, q0 = qb * 128;
        int lane = F.lane; asm volatile("" : "+v"(lane));
        __syncthreads();
        for (int jr = F.wave; jr < 256; jr += NWAVES) { const int l = q0 - 128 + jr; float kv = 0.f, vv = 0.f;
            if (l >= 0) { const size_t row = (size_t)b * SEQ + l; const float x = bf2f(P[row * NINP + C_K + kvh * 64 + lane]); vv = bf2f(P[row * NINP + C_V + kvh * 64 + lane]);
                const float rs = __builtin_amdgcn_rsqf(wave_sum(x * x) * (1.f / 64.f) + NORM_EPS); const float xn = x * rs * kg[lane];
                const float other = __shfl_xor(xn, 32); const int i = lane & 31; const float inv = exp2f(-(float)i * (13.287712379549449f / 32.f));
                float s, c; sincos_fast((float)l * inv, s, c);
                kv = (lane < 32) ? (xn * c - other * s) : (xn * c + other * s); }
            Ks[jr * 64 + lane] = kv; Vs[jr * 64 + lane] = vv; }
        __syncthreads();
        const int hh = F.wave >> 1, head = kvh * 4 + hh, qi = q0 + (F.wave & 1) * 64 + lane; const size_t row = (size_t)b * SEQ + qi;
        float q[64];
        { const u32x4* qp = (const u32x4*)(P + row * NINP + C_Q + head * 64); float ss = 0.f;
#pragma unroll
          for (int j = 0; j < 8; ++j) { const u32x4 w = qp[j];
#pragma unroll
              for (int e = 0; e < 4; ++e) { q[8 * j + 2 * e] = bflo(w[e]); q[8 * j + 2 * e + 1] = bfhi(w[e]); } }
#pragma unroll
          for (int d = 0; d < 64; ++d) ss += q[d] * q[d];
          const float rs = __builtin_amdgcn_rsqf(ss * (1.f / 64.f) + NORM_EPS);
#pragma unroll
          for (int d = 0; d < 64; ++d) q[d] = q[d] * rs * qg[d];
#pragma unroll
          for (int i = 0; i < 32; ++i) { const float inv = exp2f(-(float)i * (13.287712379549449f / 32.f)); float s, c; sincos_fast((float)qi * inv, s, c);
              const float a = q[i], bq = q[i + 32]; q[i] = (a * c - bq * s) * 0.125f; q[i + 32] = (bq * c + a * s) * 0.125f; } }
        float o[64];
#pragma unroll
        for (int d = 0; d < 64; ++d) o[d] = 0.f;
        float mx = F.in[IN_SINK][layer * 8 + head], l = 1.f;
        const int qa = q0 + (F.wave & 1) * 64;
        int jlo = qa - 127 - (q0 - 128); if (q0 == 0 && jlo < 128) jlo = 128; const int jhi = qa + 63 - (q0 - 128);
        for (int jr = jlo; jr <= jhi; ++jr) { const int j = q0 - 128 + jr; const bool ok = (j <= qi) && (qi - j < 128);
            float s = 0.f;
#pragma unroll
            for (int d = 0; d < 64; d += 4) { const f32x4 kv = *(const LAS f32x4*)(Ks + jr * 64 + d); s += (q[d] * kv.x + q[d + 1] * kv.y) + (q[d + 2] * kv.z + q[d + 3] * kv.w); if ((d & 12) == 12) __builtin_amdgcn_sched_barrier(0); }
            if (ok) { const float mn = fmaxf(mx, s), al = __expf(mx - mn), pe = __expf(s - mn); l = l * al + pe; mx = mn;
#pragma unroll
                for (int d = 0; d < 64; d += 4) { const f32x4 vv = *(const LAS f32x4*)(Vs + jr * 64 + d); o[d] = o[d] * al + pe * vv.x; o[d + 1] = o[d + 1] * al + pe * vv.y; o[d + 2] = o[d + 2] * al + pe * vv.z; o[d + 3] = o[d + 3] * al + pe * vv.w; if ((d & 12) == 12) __builtin_amdgcn_sched_barrier(0); } } }
        const float il = 1.f / l; u32x4* op = (u32x4*)(YC + row * 2048 + 512 + head * 64);
#pragma unroll
        for (int j = 0; j < 8; ++j) { u32x4 w; w.x = pk2(o[8 * j] * il, o[8 * j + 1] * il); w.y = pk2(o[8 * j + 2] * il, o[8 * j + 3] * il); w.z = pk2(o[8 * j + 4] * il, o[8 * j + 5] * il); w.w = pk2(o[8 * j + 6] * il, o[8 * j + 7] * il); op[j] = w; }
    }
}

typedef short bf16x8_t __attribute__((ext_vector_type(8)));
__device__ __forceinline__ void split_hi_lo(const f32x4 a, const f32x4 b, bf16x8& hi, bf16x8& lo) {
    u32x4 h; h.x = cvtpk(a.x, a.y); h.y = cvtpk(a.z, a.w); h.z = cvtpk(b.x, b.y); h.w = cvtpk(b.z, b.w);
    u32x4 l; l.x = cvtpk(a.x - bflo(h.x), a.y - bfhi(h.x)); l.y = cvtpk(a.z - bflo(h.y), a.w - bfhi(h.y)); l.z = cvtpk(b.x - bflo(h.z), b.y - bfhi(h.z)); l.w = cvtpk(b.z - bflo(h.w), b.w - bfhi(h.w));
    hi = __builtin_bit_cast(bf16x8, h); lo = __builtin_bit_cast(bf16x8, l);
}
__device__ __forceinline__ void router_phase(Frame& F, int layer) {
    constexpr int WROW = 2064;
    LAS unsigned char* Whi = F.lds; LAS unsigned char* Wlo = F.lds + 36 * WROW;
    LAS float* part = (LAS float*)F.lds;
    volatile LAS unsigned* lcnt = (volatile LAS unsigned*)(F.lds + 148 * 1024);
    const float* wrg = F.in[IN_WRG] + (size_t)layer * 1024 * 4; const float* wre = F.in[IN_WRE] + (size_t)layer * 1024 * 32; const float* gain = F.in[IN_NORM2] + layer * 1024;
    const float* X = F.out; bf16_t* H2 = (bf16_t*)(F.ws + WS_XN);
    int* EID = (int*)(F.ws + WS_MOE); float* EW = (float*)(F.ws + WS_MOE + 128 * 1024); int* SLOT = (int*)(F.ws + WS_MOE + 256 * 1024); float* RS = (float*)(F.ws + WS_MOE + 640 * 1024);
    __syncthreads();
    for (int k = F.tid; k < 1024; k += NTHR) { const float g = gain[k]; const f32x4 wg = *(const f32x4*)(wrg + k * 4);
        float w[36]; w[0] = wg.x; w[1] = wg.y; w[2] = wg.z; w[3] = wg.w;
#pragma unroll
        for (int q = 0; q < 8; ++q) { const f32x4 v = *(const f32x4*)(wre + k * 32 + 4 * q); w[4 + 4 * q] = v.x; w[5 + 4 * q] = v.y; w[6 + 4 * q] = v.z; w[7 + 4 * q] = v.w; }
#pragma unroll
        for (int e = 0; e < 36; ++e) { const float x = w[e] * g; const unsigned h = f2bf(x); const unsigned l = f2bf(x - bf2f(h));
            *(LAS unsigned short*)(Whi + e * WROW + k * 2) = (unsigned short)h; *(LAS unsigned short*)(Wlo + e * WROW + k * 2) = (unsigned short)l; } }
    if (F.tid < 32) lcnt[F.tid] = 0u;
    __syncthreads();
    const int TPB = T / F.G;
    int lane = F.lane; asm volatile("" : "+v"(lane));
    const int mt = F.wave & 3, kh = F.wave >> 2, row = lane & 15, kg = lane >> 4;
    const int m = F.bid * TPB + 16 * mt + row;
    f32x4 acc[3] = {{0.f, 0.f, 0.f, 0.f}, {0.f, 0.f, 0.f, 0.f}, {0.f, 0.f, 0.f, 0.f}}; float ss = 0.f;
    int er[3]; er[0] = row; er[1] = 16 + row; er[2] = (32 + row < 36) ? 32 + row : 35;
    if (kh == 0)
#pragma unroll 1
    for (int kb = 0; kb < 4; ++kb) {
        f32x4 xa[8][2];
#pragma unroll
        for (int ks = 0; ks < 8; ++ks) { const float* xp = X + (size_t)m * DM + 256 * kb + 32 * ks + 8 * kg; xa[ks][0] = *(const f32x4*)xp; xa[ks][1] = *(const f32x4*)(xp + 4); }
#pragma unroll
        for (int ks = 0; ks < 8; ++ks) { const int k0 = 256 * kb + 32 * ks + 8 * kg;
            const f32x4 a = xa[ks][0], b = xa[ks][1];
            ss += (a.x * a.x + a.y * a.y) + (a.z * a.z + a.w * a.w) + (b.x * b.x + b.y * b.y) + (b.z * b.z + b.w * b.w);
            bf16x8 ah, al; split_hi_lo(a, b, ah, al);
#pragma unroll
            for (int nt = 0; nt < 3; ++nt) { const bf16x8 bh = *(const LAS bf16x8*)(Whi + er[nt] * WROW + k0 * 2), bl = *(const LAS bf16x8*)(Wlo + er[nt] * WROW + k0 * 2);
                acc[nt] = __builtin_amdgcn_mfma_f32_16x16x32_bf16(ah, bh, acc[nt], 0, 0, 0);
                acc[nt] = __builtin_amdgcn_mfma_f32_16x16x32_bf16(ah, bl, acc[nt], 0, 0, 0);
                acc[nt] = __builtin_amdgcn_mfma_f32_16x16x32_bf16(al, bh, acc[nt], 0, 0, 0); } }
    }
    ss += __shfl_xor(ss, 16); ss += __shfl_xor(ss, 32);
    __syncthreads();
    LAS float* ssq = part + 4 * 3 * 64 * 4; LAS float* lg = ssq + 128; volatile LAS int* elist = (volatile LAS int*)(lg + 64 * 40);
    if (kh == 0) {
        const float rstd_row = __builtin_amdgcn_rsqf(ss * (1.f / DM) + NORM_EPS);
        if (kg == 0) { ssq[64 + 16 * mt + row] = rstd_row; RS[m] = rstd_row; }
    }
    __syncthreads();
    { const float rs = ssq[64 + 16 * mt + row];
#pragma unroll 4
      for (int ks = 0; ks < 16; ++ks) { const int k0 = 512 * kh + 32 * ks + 8 * kg; const float* xp = X + (size_t)m * DM + k0; const f32x4 a = *(const f32x4*)xp, b = *(const f32x4*)(xp + 4);
          const f32x4 g0 = *(const f32x4*)(gain + k0), g1 = *(const f32x4*)(gain + k0 + 4);
          u32x4 hw; hw.x = cvtpk(a.x * rs * g0.x, a.y * rs * g0.y); hw.y = cvtpk(a.z * rs * g0.z, a.w * rs * g0.w); hw.z = cvtpk(b.x * rs * g1.x, b.y * rs * g1.y); hw.w = cvtpk(b.z * rs * g1.z, b.w * rs * g1.w);
          *(u32x4*)(H2 + (size_t)m * DM + k0) = hw; } }
    if (kh == 0) {
#pragma unroll
        for (int nt = 0; nt < 3; ++nt)
#pragma unroll
            for (int rg = 0; rg < 4; ++rg) { const int e = row + 16 * nt, tk = 16 * mt + 4 * kg + rg; if (e < 36) lg[tk * 40 + e] = acc[nt][rg] * ssq[64 + tk]; }
    }
    __syncthreads();
    if (F.tid < TPB) { const int tk = F.tid, mm = F.bid * TPB + tk; const LAS float* L = lg + tk * 40;
        float gl[4];
#pragma unroll
        for (int k = 0; k < 4; ++k) gl[k] = L[k] + F.in[IN_BRG][layer * 4 + k];
        int gs = 0; float gbest = gl[0];
#pragma unroll
        for (int k = 1; k < 4; ++k) if (gl[k] > gbest) { gbest = gl[k]; gs = k; }
        float den = 0.f;
#pragma unroll
        for (int k = 0; k < 4; ++k) den += __expf(gl[k] - gbest);
        const float pgrp = 1.f / den;
        float el[8];
#pragma unroll
        for (int k = 0; k < 8; ++k) el[k] = L[4 + gs * 8 + k] + F.in[IN_BRE_][layer * 32 + gs * 8 + k];
        int i0 = 0; float v0 = el[0];
#pragma unroll
        for (int k = 1; k < 8; ++k) if (el[k] > v0) { v0 = el[k]; i0 = k; }
        int i1 = -1; float v1 = -3.0e38f;
#pragma unroll
        for (int k = 0; k < 8; ++k) if (k != i0 && el[k] > v1) { v1 = el[k]; i1 = k; }
        const float e1 = __expf(v1 - v0), w0 = pgrp / (1.f + e1), w1 = pgrp * e1 / (1.f + e1);
        const int ea = gs * 8 + i0, eb = gs * 8 + i1;
        EID[2 * mm] = ea; EID[2 * mm + 1] = eb; EW[2 * mm] = w0; EW[2 * mm + 1] = w1;
        elist[2 * tk] = ea; elist[2 * tk + 1] = eb;
    }
    __syncthreads();
    if (F.tid < 32) { const int e = F.tid; int c = 0;
        for (int i = 0; i < 2 * TPB; ++i) { if (elist[i] == e) { SLOT[2 * (F.bid * TPB) + i] = c; ++c; } }
        ((unsigned*)(F.ws + WS_MOE + 512 * 1024))[(size_t)F.bid * 32 + e] = (unsigned)c; }
    __syncthreads();
}
__device__ __forceinline__ int moe_tables(Frame& F, int layer, volatile LAS int* offs, volatile LAS int* tile_e) {
    volatile LAS int* psum = offs + 256;
    const unsigned* CNTB = (const unsigned*)(F.ws + WS_MOE + 512 * 1024);
    __syncthreads();
    { const int e = F.tid & 31, part = F.tid >> 5; int tot = 0, pre = 0; const int per = (F.G + 15) / 16;
      for (int bb = part * per; bb < (part + 1) * per && bb < F.G; ++bb) { const int c = (int)CNTB[(size_t)bb * 32 + e]; tot += c; pre += (bb < F.bid) ? c : 0; }
      psum[part * 32 + e] = tot; psum[512 + part * 32 + e] = pre; }
    __syncthreads();
    if (F.tid < 64) {
        int c = 0, pre = 0;
        if (F.tid < 32) for (int part = 0; part < 16; ++part) { c += psum[part * 32 + F.tid]; pre += psum[512 + part * 32 + F.tid]; }
        const int tl = (c + 255) >> 8; int incl = tl;
#pragma unroll
        for (int o = 1; o < 32; o <<= 1) { const int v = __shfl_up(incl, o); if (F.tid >= o) incl += v; }
        const int excl = incl - tl;
        if (F.tid < 32) { offs[F.tid] = excl * 256 + pre; for (int k = 0; k < tl; ++k) tile_e[excl + k] = F.tid; }
        if (F.tid == 31) offs[32] = incl;
    }
    __syncthreads();
    return __builtin_amdgcn_readfirstlane(offs[32]);
}
__device__ __forceinline__ void gather_phase(Frame& F, int layer, volatile LAS int* offs) {
    const bf16_t* H2 = (const bf16_t*)(F.ws + WS_XN); bf16_t* XG = (bf16_t*)(F.ws + WS_XG);
    const int* EID = (const int*)(F.ws + WS_MOE); const int* SLOT = (const int*)(F.ws + WS_MOE + 256 * 1024); int* POS = (int*)(F.ws + WS_MOE + 384 * 1024);
    const float* RS = (const float*)(F.ws + WS_MOE + 640 * 1024); float* RSG = (float*)(F.ws + WS_MOE + 704 * 1024);
    const int TPB = T / F.G;
    for (int m = F.bid * TPB + F.wave; m < (F.bid + 1) * TPB; m += NWAVES) {
        const u32x4* src = (const u32x4*)(H2 + (size_t)m * DM) + F.lane; const u32x4 a = src[0], b = src[64];
#pragma unroll
        for (int k = 0; k < 2; ++k) { const int pos = offs[EID[2 * m + k]] + SLOT[2 * m + k]; u32x4* dst = (u32x4*)(XG + (size_t)pos * DM) + F.lane; dst[0] = a; dst[64] = b; if (F.lane == 0) POS[2 * m + k] = pos; }
    }
}
__device__ __forceinline__ void combine_phase(Frame& F, const float* gain_next, bool dry = false) {
    const bf16_t* Y = (const bf16_t*)(F.ws + WS_YEXP); const float* EW = (const float*)(F.ws + WS_MOE + 128 * 1024); const int* POS = (const int*)(F.ws + WS_MOE + 384 * 1024);
    bf16_t* XN = (bf16_t*)(F.ws + WS_XN);
    const int gw = F.bid * NWAVES + F.wave, NGW = F.G * NWAVES;
    for (int m = gw; m < T; m += NGW) {
        const float w0 = EW[2 * m], w1 = EW[2 * m + 1]; const int p0 = POS[2 * m], p1 = POS[2 * m + 1];
        f32x4* xr = (f32x4*)(F.out + (size_t)m * DM) + F.lane;
        const u32x2* y0 = (const u32x2*)(Y + (size_t)p0 * DM) + F.lane; const u32x2* y1 = (const u32x2*)(Y + (size_t)p1 * DM) + F.lane;
        f32x4 v[4]; float s = 0.f;
#pragma unroll
        for (int j = 0; j < 4; ++j) { v[j] = xr[64 * j]; const u32x2 a = y0[64 * j], b = y1[64 * j];
            v[j].x += w0 * bflo(a.x) + w1 * bflo(b.x); v[j].y += w0 * bfhi(a.x) + w1 * bfhi(b.x); v[j].z += w0 * bflo(a.y) + w1 * bflo(b.y); v[j].w += w0 * bfhi(a.y) + w1 * bfhi(b.y);
            if (!dry) xr[64 * j] = v[j]; s += (v[j].x * v[j].x + v[j].y * v[j].y) + (v[j].z * v[j].z + v[j].w * v[j].w); }
        if (gain_next) { const float rstd = __builtin_amdgcn_rsqf(wave_sum(s) * (1.f / DM) + NORM_EPS); const f32x4* gr = (const f32x4*)gain_next + F.lane;
            unsigned long long* o8 = (unsigned long long*)(XN + (size_t)m * DM) + F.lane;
#pragma unroll
            for (int j = 0; j < 4; ++j) { const f32x4 gv = gr[64 * j]; o8[64 * j] = (unsigned long long)pk2(v[j].x * rstd * gv.x, v[j].y * rstd * gv.y) | ((unsigned long long)pk2(v[j].z * rstd * gv.z, v[j].w * rstd * gv.w) << 32); } }
    }
}

__device__ __forceinline__ int crow32(int reg, int hh) { return (reg & 3) + 8 * (reg >> 2) + 4 * hh; }
__device__ __forceinline__ float wave_incl_scan(float v, int lane) {
#pragma unroll
    for (int o = 1; o < 64; o <<= 1) { const float t = __shfl_up(v, o); if (lane >= o) v += t; }
    return v;
}
__device__ __forceinline__ void conv_frag(const LAS unsigned char* raw, int chan, int ks, int hh, float w0, float w1, float w2, float w3, float bias, float (&out)[8]) {
#pragma unroll
    for (int run = 0; run < 2; ++run) { const int lb = 16 * ks + 8 * run + 4 * hh; float x[7];
#pragma unroll
        for (int i = 0; i < 7; ++i) x[i] = bf2f(*(const LAS unsigned short*)(raw + (lb + i) * 128 + chan * 2));
#pragma unroll
        for (int j = 0; j < 4; ++j) out[4 * run + j] = siluf_(bias + w0 * x[j] + w1 * x[j + 1] + w2 * x[j + 2] + w3 * x[j + 3]); }
}
constexpr int RAWT = 131 * 128;
__device__ __forceinline__ void stage_raw(const bf16_t* P, size_t row0, int l0, int col, LAS unsigned char* dst, int idx0, int stride) {
    for (int idx = idx0; idx < 131 * 8; idx += stride) { const int r = idx >> 3, c8 = idx & 7; u32x4 v = (u32x4){0u, 0u, 0u, 0u};
        if (l0 - 3 + r >= 0) v = *(const u32x4*)(P + (row0 + r - 3) * NINP + col + c8 * 8);
        *(LAS u32x4*)(dst + r * 128 + c8 * 16) = v; }
}
__device__ __forceinline__ void ssdA_mfma(Frame& F, int layer) {
    const bf16_t* P = (const bf16_t*)(F.ws + WS_P); const float* DT = (const float*)(F.ws + WS_DT); float* SST = (float*)(F.ws + WS_SST); float* ASUM = (float*)(F.ws + WS_ASUM);
    const float* cw = F.in[IN_CONVW] + layer * 4 * 1280; const float* cb = F.in[IN_CONVB] + layer * 1280;
    LAS unsigned char* rawX = F.lds + F.wave * RAWT; LAS unsigned char* rawB = F.lds + 8 * RAWT; LAS float* ftab = (LAS float*)(F.lds + 9 * RAWT) + F.wave * 128;
    for (int u = F.bid; u < BATCH * SSD_NCH * 2; u += F.G) {
        const int grp = u & 1, ch = (u >> 1) & 31, b = u >> 6, h = grp * 8 + F.wave, l0 = ch * 128; const size_t row0 = (size_t)b * SEQ + l0;
        int lane = F.lane; asm volatile("" : "+v"(lane));
        const int r = lane & 31, hh = lane >> 5;
        __syncthreads();
        stage_raw(P, row0, l0, C_XS + h * 64, rawX, lane, 64);
        stage_raw(P, row0, l0, C_B + grp * 64, rawB, F.tid, NTHR);
        { const float dtb = F.in[IN_DTB][layer * 16 + h], A = -__expf(F.in[IN_ALOG][layer * 16 + h]);
          const float dt0 = softplusf_(DT[(row0 + lane) * 16 + h] + dtb), dt1 = softplusf_(DT[(row0 + 64 + lane) * 16 + h] + dtb);
          const float s0 = wave_incl_scan(dt0 * A, lane); const float tot0 = __builtin_bit_cast(float, __builtin_amdgcn_readlane(__builtin_bit_cast(int, s0), 63));
          const float s1 = wave_incl_scan(dt1 * A, lane) + tot0; const float tot = __builtin_bit_cast(float, __builtin_amdgcn_readlane(__builtin_bit_cast(int, s1), 63));
          ftab[lane] = dt0 * __expf(tot - s0); ftab[64 + lane] = dt1 * __expf(tot - s1);
          if (lane == 0) ASUM[((size_t)b * SSD_NCH + ch) * 16 + h] = tot; }
        __syncthreads();
        bf16x8 bfr[2];
#pragma unroll
        for (int q = 0; q < 2; ++q) { const int idx = F.wave * 2 + q, nt = idx >> 3, ks = idx & 7, cc = 1024 + grp * 64 + 32 * nt + r; float v[8];
            conv_frag(rawB, 32 * nt + r, ks, hh, cw[cc], cw[1280 + cc], cw[2560 + cc], cw[3840 + cc], cb[cc], v); bfr[q] = pack8v(v); }
        bf16x8 xw[2][8];
#pragma unroll
        for (int pt = 0; pt < 2; ++pt) { const int cx = h * 64 + 32 * pt + r; const float w0 = cw[cx], w1 = cw[1280 + cx], w2 = cw[2560 + cx], w3 = cw[3840 + cx], bias = cb[cx];
#pragma unroll
            for (int ks = 0; ks < 8; ++ks) { float v[8]; conv_frag(rawX, 32 * pt + r, ks, hh, w0, w1, w2, w3, bias, v);
                const f32x4 fa = *(const LAS f32x4*)(ftab + 16 * ks + 4 * hh), fb = *(const LAS f32x4*)(ftab + 16 * ks + 8 + 4 * hh);
                v[0] *= fa.x; v[1] *= fa.y; v[2] *= fa.z; v[3] *= fa.w; v[4] *= fb.x; v[5] *= fb.y; v[6] *= fb.z; v[7] *= fb.w; { u32x4 pq = __builtin_bit_cast(u32x4, pack8v(v)); asm volatile("" : "+v"(pq) :: "memory"); xw[pt][ks] = __builtin_bit_cast(bf16x8, pq); } } }
        __syncthreads();
#pragma unroll
        for (int q = 0; q < 2; ++q) *(LAS bf16x8*)(rawB + (F.wave * 2 + q) * 1024 + lane * 16) = bfr[q];
        __syncthreads();
        f32x16 acc[2][2];
#pragma unroll
        for (int pt = 0; pt < 2; ++pt)
#pragma unroll
            for (int nt = 0; nt < 2; ++nt)
#pragma unroll
                for (int i = 0; i < 16; ++i) acc[pt][nt][i] = 0.f;
#pragma unroll
        for (int ks = 0; ks < 8; ++ks)
#pragma unroll
            for (int nt = 0; nt < 2; ++nt) { const bf16x8 bq = *(const LAS bf16x8*)(rawB + (nt * 8 + ks) * 1024 + lane * 16);
#pragma unroll
                for (int pt = 0; pt < 2; ++pt) acc[pt][nt] = MFMA32(xw[pt][ks], bq, acc[pt][nt]); }
        float* sp = SST + (((size_t)b * SSD_NCH + ch) * 16 + h) * 4096;
#pragma unroll
        for (int pt = 0; pt < 2; ++pt)
#pragma unroll
            for (int nt = 0; nt < 2; ++nt)
#pragma unroll
                for (int i = 0; i < 16; ++i) sp[(32 * pt + crow32(i, hh)) * 64 + 32 * nt + r] = acc[pt][nt][i];
    }
}
__device__ __forceinline__ void ssdC_mfma(Frame& F, int layer) {
    const bf16_t* P = (const bf16_t*)(F.ws + WS_P); const float* DT = (const float*)(F.ws + WS_DT); const float* SST = (const float*)(F.ws + WS_SST); bf16_t* YC = (bf16_t*)(F.ws + WS_YCAT);
    const float* cw = F.in[IN_CONVW] + layer * 4 * 1280; const float* cb = F.in[IN_CONVB] + layer * 1280;
    LAS unsigned char* rawX = F.lds + F.wave * RAWT;
    LAS unsigned char* Bn = F.lds; LAS unsigned char* Cn = F.lds + 18432;
    LAS float* atab = (LAS float*)(F.lds + 36864) + F.wave * 128; LAS float* dtab = (LAS float*)(F.lds + 40960) + F.wave * 128;
    LAS float* ssqp = (LAS float*)(F.lds + 45056); LAS float* gtab = (LAS float*)(F.lds + 49152) + F.wave * 64;
    LAS unsigned char* zt = F.lds + 51200 + F.wave * 4608;
    for (int u = F.bid; u < BATCH * SSD_NCH * 2; u += F.G) {
        const int grp = u & 1, ch = (u >> 1) & 31, b = u >> 6, h = grp * 8 + F.wave, l0 = ch * 128; const size_t row0 = (size_t)b * SEQ + l0;
        int lane = F.lane; asm volatile("" : "+v"(lane));
        const int r = lane & 31, hh = lane >> 5;
        __syncthreads();
        stage_raw(P, row0, l0, C_XS + h * 64, rawX, lane, 64);
        __syncthreads();
        bf16x8 xsf[2][8];
#pragma unroll
        for (int pt = 0; pt < 2; ++pt) { const int cx = h * 64 + 32 * pt + r; const float w0 = cw[cx], w1 = cw[1280 + cx], w2 = cw[2560 + cx], w3 = cw[3840 + cx], bias = cb[cx];
#pragma unroll
            for (int ks = 0; ks < 8; ++ks) { float v[8]; conv_frag(rawX, 32 * pt + r, ks, hh, w0, w1, w2, w3, bias, v); { u32x4 pq = __builtin_bit_cast(u32x4, pack8v(v)); asm volatile("" : "+v"(pq) :: "memory"); xsf[pt][ks] = __builtin_bit_cast(bf16x8, pq); } } }
        __syncthreads();
        for (int it = F.tid; it < 128 * 16; it += NTHR) { const int l = it >> 4, c8 = it & 15, isC = c8 >> 3, col = (isC ? C_C : C_B) + grp * 64 + (c8 & 7) * 8, cc = 1024 + isC * 128 + grp * 64 + (c8 & 7) * 8;
            float a[8];
#pragma unroll
            for (int e = 0; e < 8; ++e) a[e] = cb[cc + e];
#pragma unroll
            for (int j = 0; j < 4; ++j) { if (l0 + l - 3 + j >= 0) { const u32x4 xv = *(const u32x4*)(P + (row0 + l - 3 + j) * NINP + col);
#pragma unroll
                for (int e = 0; e < 4; ++e) { a[2 * e] += cw[j * 1280 + cc + 2 * e] * bflo(xv[e]); a[2 * e + 1] += cw[j * 1280 + cc + 2 * e + 1] * bfhi(xv[e]); } } }
            u32x4 o; o.x = cvtpk(siluf_(a[0]), siluf_(a[1])); o.y = cvtpk(siluf_(a[2]), siluf_(a[3])); o.z = cvtpk(siluf_(a[4]), siluf_(a[5])); o.w = cvtpk(siluf_(a[6]), siluf_(a[7]));
            *(LAS u32x4*)((isC ? Cn : Bn) + l * 144 + (c8 & 7) * 16) = o; }
        { const float dtb = F.in[IN_DTB][layer * 16 + h], A = -__expf(F.in[IN_ALOG][layer * 16 + h]);
          const float dt0 = softplusf_(DT[(row0 + lane) * 16 + h] + dtb), dt1 = softplusf_(DT[(row0 + 64 + lane) * 16 + h] + dtb);
          const float s0 = wave_incl_scan(dt0 * A, lane); const float tot0 = __builtin_bit_cast(float, __builtin_amdgcn_readlane(__builtin_bit_cast(int, s0), 63));
          const float s1 = wave_incl_scan(dt1 * A, lane) + tot0;
          atab[lane] = s0; atab[64 + lane] = s1; dtab[lane] = dt0; dtab[64 + lane] = dt1; gtab[lane] = F.in[IN_SSDG][layer * 1024 + h * 64 + lane]; }
        const float* sp = SST + (((size_t)b * SSD_NCH + ch) * 16 + h) * 4096;
        const float dsk = F.in[IN_SSDD][layer * 16 + h];
        __syncthreads();
#pragma unroll 1
        for (int li = 0; li < 4; ++li) {
            bf16x8 Cf[4];
#pragma unroll
            for (int ks = 0; ks < 4; ++ks) Cf[ks] = *(const LAS bf16x8*)(Cn + (32 * li + r) * 144 + (16 * ks + 8 * hh) * 2);
            f32x16 acc[2];
#pragma unroll
            for (int pt = 0; pt < 2; ++pt)
#pragma unroll
                for (int i = 0; i < 16; ++i) acc[pt][i] = 0.f;
#pragma unroll
            for (int ks = 0; ks < 4; ++ks)
#pragma unroll
                for (int pt = 0; pt < 2; ++pt) { const f32x4 a0 = *(const f32x4*)(sp + (32 * pt + r) * 64 + 16 * ks + 8 * hh), a1 = *(const f32x4*)(sp + (32 * pt + r) * 64 + 16 * ks + 8 * hh + 4);
                    const float v[8] = {a0.x, a0.y, a0.z, a0.w, a1.x, a1.y, a1.z, a1.w}; acc[pt] = MFMA32(pack8v(v), Cf[ks], acc[pt]); }
            const float al = atab[32 * li + r], el = __expf(al); const int lrel = 32 * li + r;
#pragma unroll
            for (int pt = 0; pt < 2; ++pt)
#pragma unroll
                for (int i = 0; i < 16; ++i) acc[pt][i] *= el;
#pragma unroll
            for (int si = 0; si < 4; ++si) if (si <= li) {
                f32x16 X;
#pragma unroll
                for (int i = 0; i < 16; ++i) X[i] = 0.f;
#pragma unroll
                for (int ks = 0; ks < 4; ++ks) { const bf16x8 Bq = *(const LAS bf16x8*)(Bn + (32 * si + r) * 144 + (16 * ks + 8 * hh) * 2); X = MFMA32(Bq, Cf[ks], X); }
#pragma unroll
                for (int g4 = 0; g4 < 4; ++g4) { const int sb = 32 * si + 8 * g4 + 4 * hh; const f32x4 av = *(const LAS f32x4*)(atab + sb), dv = *(const LAS f32x4*)(dtab + sb);
#pragma unroll
                    for (int j = 0; j < 4; ++j) { const int s = sb + j; float arg = al - av[j]; if (si == li && s > lrel) arg = -100.f;
                        float x = X[4 * g4 + j] * (__expf(arg) * dv[j]); if (si == li && s > lrel) x = 0.f; if (si == li && s == lrel) x += dsk; X[4 * g4 + j] = x; } }
#pragma unroll
                for (int kq = 0; kq < 2; ++kq) { const float v[8] = {X[8 * kq], X[8 * kq + 1], X[8 * kq + 2], X[8 * kq + 3], X[8 * kq + 4], X[8 * kq + 5], X[8 * kq + 6], X[8 * kq + 7]}; const bf16x8 Xf = pack8v(v);
#pragma unroll
                    for (int pt = 0; pt < 2; ++pt) { bf16x8 a;
#pragma unroll
                        for (int q = 0; q < 4; ++q) a = (si == q) ? xsf[pt][2 * q + kq] : a;
                        acc[pt] = MFMA32(a, Xf, acc[pt]); } }
            }
            const size_t rowt = row0 + 32 * li;
#pragma unroll
            for (int q = 0; q < 4; ++q) { const int idx = lane + 64 * q, rr = idx >> 3, c8 = idx & 7; *(LAS u32x4*)(zt + rr * 144 + c8 * 16) = *(const u32x4*)(P + (rowt + rr) * NINP + C_Z + h * 64 + c8 * 8); }
            float qs = 0.f;
#pragma unroll
            for (int pt = 0; pt < 2; ++pt)
#pragma unroll
                for (int g4 = 0; g4 < 4; ++g4) { const u32x2 zz = *(const LAS u32x2*)(zt + r * 144 + (32 * pt + 8 * g4 + 4 * hh) * 2);
                    const float z0 = bflo(zz.x), z1 = bfhi(zz.x), z2 = bflo(zz.y), z3 = bfhi(zz.y);
                    float y0 = acc[pt][4 * g4] * siluf_(z0), y1 = acc[pt][4 * g4 + 1] * siluf_(z1), y2 = acc[pt][4 * g4 + 2] * siluf_(z2), y3 = acc[pt][4 * g4 + 3] * siluf_(z3);
                    acc[pt][4 * g4] = y0; acc[pt][4 * g4 + 1] = y1; acc[pt][4 * g4 + 2] = y2; acc[pt][4 * g4 + 3] = y3; qs += (y0 * y0 + y1 * y1) + (y2 * y2 + y3 * y3); }
            qs += __shfl_xor(qs, 32);
            if (hh == 0) ssqp[(32 * li + r) * 8 + F.wave] = qs;
            __syncthreads();
            { const f32x4 qa = *(const LAS f32x4*)(ssqp + (32 * li + r) * 8), qb = *(const LAS f32x4*)(ssqp + (32 * li + r) * 8 + 4);
              const float rs = __builtin_amdgcn_rsqf(((qa.x + qa.y) + (qa.z + qa.w) + (qb.x + qb.y) + (qb.z + qb.w)) * (1.f / 512.f) + NORM_EPS);
#pragma unroll
              for (int pt = 0; pt < 2; ++pt)
#pragma unroll
                  for (int g4 = 0; g4 < 4; ++g4) { const int p0 = 32 * pt + 8 * g4 + 4 * hh; const f32x4 gv = *(const LAS f32x4*)(gtab + p0);
                      u32x2 o; o.x = cvtpk(acc[pt][4 * g4] * rs * gv.x, acc[pt][4 * g4 + 1] * rs * gv.y); o.y = cvtpk(acc[pt][4 * g4 + 2] * rs * gv.z, acc[pt][4 * g4 + 3] * rs * gv.w);
                      *(LAS u32x2*)(zt + r * 144 + p0 * 2) = o; } }
#pragma unroll
            for (int q = 0; q < 4; ++q) { const int idx = lane + 64 * q, rr = idx >> 3, c8 = idx & 7; *(u32x4*)(YC + (rowt + rr) * 2048 + 1024 + h * 64 + c8 * 8) = *(const LAS u32x4*)(zt + rr * 144 + c8 * 16); }
        }
    }
}

__device__ __forceinline__ void attn_mfma(Frame& F, int layer) {
    LAS unsigned char* Kn = F.lds; LAS unsigned char* VT = F.lds + 36864;
    const bf16_t* P = (const bf16_t*)(F.ws + WS_P); bf16_t* YC = (bf16_t*)(F.ws + WS_YCAT);
    const float* qg = F.in[IN_QG] + layer * 64; const float* kg = F.in[IN_KG] + layer * 64;
    for (int u = F.bid; u < BATCH * 32 * 2; u += F.G) {
        const int kvh = u & 1, qb = (u >> 1) & 31, b = u >> 6, q0 = qb * 128;
        int lane = F.lane; asm volatile("" : "+v"(lane));
        const int r = lane & 31, hh = lane >> 5;
        __syncthreads();
        for (int jr = F.wave; jr < 256; jr += NWAVES) { const int l = q0 - 128 + jr; float kv = 0.f;
            if (l >= 0) { const size_t row = (size_t)b * SEQ + l; const float x = bf2f(P[row * NINP + C_K + kvh * 64 + lane]);
                const float rs = __builtin_amdgcn_rsqf(wave_sum(x * x) * (1.f / 64.f) + NORM_EPS); const float xn = x * rs * kg[lane];
                const float other = __shfl_xor(xn, 32); const int i = lane & 31; const float inv = exp2f(-(float)i * (13.287712379549449f / 32.f));
                float s, c; sincos_fast((float)l * inv, s, c);
                kv = (lane < 32) ? (xn * c - other * s) : (xn * c + other * s); }
            *(LAS unsigned short*)(Kn + jr * 144 + lane * 2) = (unsigned short)f2bf(kv); }
#pragma unroll
        for (int q = 0; q < 4; ++q) { const int it = F.tid + NTHR * q, d = it & 63, ko = it >> 6; unsigned short v[8];
#pragma unroll
            for (int e = 0; e < 8; ++e) { const int l = q0 - 128 + 8 * ko + e; v[e] = (l >= 0) ? P[((size_t)b * SEQ + l) * NINP + C_V + kvh * 64 + d] : (unsigned short)0; }
            u32x4 o; o.x = v[0] | ((unsigned)v[1] << 16); o.y = v[2] | ((unsigned)v[3] << 16); o.z = v[4] | ((unsigned)v[5] << 16); o.w = v[6] | ((unsigned)v[7] << 16);
            *(LAS u32x4*)(VT + d * 528 + ko * 16) = o; }
        __syncthreads();
        const int hd = F.wave >> 1, head = kvh * 4 + hd, qhalf = F.wave & 1; const float sink = F.in[IN_SINK][layer * 8 + head];
#pragma unroll 1
        for (int jt = 0; jt < 2; ++jt) {
            const int qt = q0 + 64 * qhalf + 32 * jt, qi = qt + r, t0 = 2 * qhalf + jt; const size_t row = (size_t)b * SEQ + qi;
            bf16x8 Qf[4];
            { float qv[4][8]; float ss = 0.f;
#pragma unroll
              for (int ks = 0; ks < 4; ++ks) { const u32x4 w = *(const u32x4*)(P + row * NINP + C_Q + head * 64 + 16 * ks + 8 * hh);
#pragma unroll
                  for (int e = 0; e < 4; ++e) { qv[ks][2 * e] = bflo(w[e]); qv[ks][2 * e + 1] = bfhi(w[e]); ss += qv[ks][2 * e] * qv[ks][2 * e] + qv[ks][2 * e + 1] * qv[ks][2 * e + 1]; } }
              ss += __shfl_xor(ss, 32);
              const float rs = __builtin_amdgcn_rsqf(ss * (1.f / 64.f) + NORM_EPS);
#pragma unroll
              for (int ks = 0; ks < 4; ++ks)
#pragma unroll
                  for (int e = 0; e < 8; ++e) qv[ks][e] *= rs * qg[16 * ks + 8 * hh + e];
#pragma unroll
              for (int ks = 0; ks < 2; ++ks)
#pragma unroll
                  for (int e = 0; e < 8; ++e) { const int i = 16 * ks + 8 * hh + e; const float inv = exp2f(-(float)i * (13.287712379549449f / 32.f)); float s, c; sincos_fast((float)qi * inv, s, c);
                      const float a = qv[ks][e], bq = qv[ks + 2][e]; qv[ks][e] = (a * c - bq * s) * 0.125f; qv[ks + 2][e] = (bq * c + a * s) * 0.125f; }
#pragma unroll
              for (int ks = 0; ks < 4; ++ks) Qf[ks] = pack8v(qv[ks]); }
            f32x16 acc[2];
#pragma unroll
            for (int dt = 0; dt < 2; ++dt)
#pragma unroll
                for (int i = 0; i < 16; ++i) acc[dt][i] = 0.f;
            float m = sink, lsum = 1.f;
#pragma unroll
            for (int tt = 0; tt < 5; ++tt) { const int t = t0 + tt;
                if (q0 == 0 && t < 4) continue;
                f32x16 X;
#pragma unroll
                for (int i = 0; i < 16; ++i) X[i] = 0.f;
#pragma unroll
                for (int ks = 0; ks < 4; ++ks) { const bf16x8 Kq = *(const LAS bf16x8*)(Kn + (32 * t + r) * 144 + (16 * ks + 8 * hh) * 2); X = MFMA32(Kq, Qf[ks], X); }
                if (tt == 0) {
#pragma unroll
                    for (int i = 0; i < 16; ++i) if (!(r < crow32(i, hh))) X[i] = -INFINITY; }
                if (tt == 4) {
#pragma unroll
                    for (int i = 0; i < 16; ++i) if (!(crow32(i, hh) <= r)) X[i] = -INFINITY; }
                float mx = X[0];
#pragma unroll
                for (int i = 1; i < 16; ++i) mx = fmaxf(mx, X[i]);
                mx = fmaxf(mx, __shfl_xor(mx, 32));
                const float mn = fmaxf(m, mx), al = __expf(m - mn); m = mn;
                float ps = 0.f;
#pragma unroll
                for (int i = 0; i < 16; ++i) { X[i] = __expf(X[i] - mn); ps += X[i]; }
                ps += __shfl_xor(ps, 32);
                lsum = lsum * al + ps;
#pragma unroll
                for (int dt = 0; dt < 2; ++dt)
#pragma unroll
                    for (int i = 0; i < 16; ++i) acc[dt][i] *= al;
#pragma unroll
                for (int kq = 0; kq < 2; ++kq) { const float v[8] = {X[8 * kq], X[8 * kq + 1], X[8 * kq + 2], X[8 * kq + 3], X[8 * kq + 4], X[8 * kq + 5], X[8 * kq + 6], X[8 * kq + 7]}; const bf16x8 Pf = pack8v(v);
#pragma unroll
                    for (int dt = 0; dt < 2; ++dt) { const LAS unsigned char* vp = VT + (32 * dt + r) * 528 + (32 * t + 16 * kq + 4 * hh) * 2;
                        const u32x2 va = *(const LAS u32x2*)vp, vb = *(const LAS u32x2*)(vp + 16); const u32x4 vv = {va.x, va.y, vb.x, vb.y};
                        acc[dt] = MFMA32(__builtin_bit_cast(bf16x8, vv), Pf, acc[dt]); } }
            }
            const float il = 1.f / lsum;
#pragma unroll
            for (int dt = 0; dt < 2; ++dt)
#pragma unroll
                for (int g4 = 0; g4 < 4; ++g4) { u32x2 o; o.x = cvtpk(acc[dt][4 * g4] * il, acc[dt][4 * g4 + 1] * il); o.y = cvtpk(acc[dt][4 * g4 + 2] * il, acc[dt][4 * g4 + 3] * il);
                    *(u32x2*)(YC + row * 2048 + 512 + head * 64 + 32 * dt + 8 * g4 + 4 * hh) = o; }
        }
    }
}

#ifndef MK_PER_PHASE
#define MK_PER_PHASE 0
#endif
constexpr int NPH = 13;
constexpr int TAB_OFF = 150 * 1024;
struct Args { const float* in[N_INPUTS]; float* out; unsigned char* ws; int gp_lo, gp_hi; };
static_assert(sizeof(Args) == (N_INPUTS + 2) * 8 + 8, "no padding in Args");

#ifndef PROBE_ID
#define PROBE_ID 0
#endif
#ifndef PROBE_N
#define PROBE_N 1
#endif
#define REP(id) for (int _r = 0; _r < ((id) == PROBE_ID ? 1 + PROBE_N : 1); ++_r)
extern __shared__ __attribute__((aligned(16))) unsigned char lds_raw[];
__device__ __forceinline__ LAS unsigned char* lds_raw_base() { return (LAS unsigned char*)lds_raw; }
#define LAUNDER() do { asm volatile("" : "+s"(F.in), "+s"(F.ws), "+s"(F.out), "+s"(F.ctl), "+s"(F.bid), "+s"(F.G)); asm volatile("" : "+v"(F.tid)); F.lane = F.tid & 63; F.wave = __builtin_amdgcn_readfirstlane(F.tid >> 6); } while (0)
template <int layer>
__device__ __forceinline__ void layer_body(Frame& F, const int lo, const int hi, const bool rerun) {
    volatile LAS int* offs = (volatile LAS int*)(F.lds + TAB_OFF); volatile LAS int* tile_e = offs + 64;
    XcdBarrier bar; bar.bar = F.ctl + CW_BAR; bar.x = xb_xcc_id(); bar.st = F.MISC;
#define GP(k) (layer * NPH + (k))
#ifdef ONLY_PH
#define IN(k) (((k) == ONLY_PH) && lo <= GP(k) && GP(k) < hi)
#else
#define IN(k) (lo <= GP(k) && GP(k) < hi)
#endif
#define WSB ((const char*)F.ws)
#ifdef DIAG_GP
#define STAMP0(k) do { if (GP(k) == DIAG_GP) { const unsigned t_ = (unsigned)__builtin_amdgcn_s_memrealtime(); if (threadIdx.x == 0) *(volatile LAS unsigned*)((LAS unsigned char*)lds_raw_base() + MISC_OFF + 32) = t_; } } while (0)
#define STAMP1(k) do { if (GP(k) == DIAG_GP) { const unsigned t_ = (unsigned)__builtin_amdgcn_s_memrealtime(); if (threadIdx.x == 0) *(volatile LAS unsigned*)((LAS unsigned char*)lds_raw_base() + MISC_OFF + 40) = t_; } } while (0)
#else
#define STAMP0(k)
#define STAMP1(k)
#endif
#define SEAM(k) do { if (!MK_PER_PHASE && IN(k) && GP(k) + 1 < hi) { xcd_barrier(bar); if (PROBE_ID == 19) { xcd_barrier(bar); xcd_barrier(bar); } } STAMP1(k); } while (0)
        if (IN(0) && layer == 0) { LAUNDER(); STAMP0(0);
            REP(1) { convert_weights(F, 0); __syncthreads(); } REP(2) s5_build(F, 0);
            REP(3) rmsnorm_rows(F, F.in[IN_X], F.in[IN_NORM1], (bf16_t*)(F.ws + WS_XN));
            SEAM(0);
        }
        if (IN(1)) { LAUNDER(); STAMP0(1);
            SchedDense<2048u, 2048u, T / 256, NINP / 256, 16> S{WSB + WS_XN, WSB + WS_WIN, F.G, F.bid};
            EpiProj E{F.ws, F.in[IN_BGATE] + layer * 3072};
            REP(4) pg8::gemm_phase<2048u, 2048u>(F.tid, F.lds, S, E);
            SEAM(1);
        }
        if (IN(2)) { LAUNDER(); STAMP0(2);
            SchedS5P1 S{WSB + WS_UH, WSB + WS_EG, F.G, F.bid};
            EpiHloc E{(float*)(F.ws + WS_HLOC)};
            REP(5) pg8::gemm_phase<(unsigned)(S5_K * 2), 1024u>(F.tid, F.lds, S, E);
            REP(6) ssdA_mfma(F, layer);
            REP(8) attn_mfma(F, layer);
            SEAM(2);
        }
        if (IN(3)) { LAUNDER(); STAMP0(3);
            REP(7) s5_scan(F, layer);
            if (!rerun) ssd_scan(F);
            SEAM(3);
        }
        if (IN(4)) { LAUNDER(); STAMP0(4);
            SchedS5Main S{WSB + WS_UH, WSB + WS_MG, F.G, F.bid};
            EpiS5Y E{(bf16_t*)(F.ws + WS_XN)};
            REP(9) pg8::gemm_phase<(unsigned)(S5_K * 2), (unsigned)(S5_K * 2)>(F.tid, F.lds, S, E);
            REP(10) ssdC_mfma(F, layer);
            SEAM(4);
        }
        if (IN(5)) { LAUNDER(); STAMP0(5);
            SchedDense<1024u, 1024u, T / 256, 4, 8> S{WSB + WS_XN, WSB + WS_WGLU, F.G, F.bid};
            EpiGlu E{(bf16_t*)(F.ws + WS_YCAT)};
            REP(11) pg8::gemm_phase<1024u, 1024u>(F.tid, F.lds, S, E);
            SEAM(5);
        }
        if (IN(6)) { LAUNDER(); STAMP0(6);
            SchedDense<4096u, 4096u, T / 256, 4, 32> S{WSB + WS_YCAT, WSB + WS_PCAT, F.G, F.bid};
            EpiMerged E{F.ws};
            REP(12) pg8::gemm_phase<4096u, 4096u>(F.tid, F.lds, S, E);
            SEAM(6);
        }
        if (IN(7)) { LAUNDER(); STAMP0(7);
            SchedDense<2048u, 2048u, T / 256, 4, 16> S{WSB + WS_XN, WSB + WS_WOUT, F.G, F.bid};
            EpiResid E{layer == 0 ? F.in[IN_X] : (const float*)F.out, F.out};
            REP(layer == 0 ? 13 : -1) pg8::gemm_phase<2048u, 2048u>(F.tid, F.lds, S, E);
            SEAM(7);
        }
        if (IN(8)) { LAUNDER(); STAMP0(8); REP(17) router_phase(F, layer); SEAM(8); }
        if (IN(9)) { LAUNDER(); STAMP0(9); (void)moe_tables(F, layer, offs, tile_e); REP(14) gather_phase(F, layer, offs); SEAM(9); }
        if (IN(10)) { LAUNDER(); STAMP0(10);
            const int ntiles = moe_tables(F, layer, offs, tile_e);
            SchedMoe<2048u, (size_t)1024 * 1024 * 2, (size_t)256 * 2048, 16> S{WSB + WS_XG, WSB + WS_EGU, ntiles, F.G, F.bid, tile_e};
            EpiSwiGlu E{(bf16_t*)(F.ws + WS_HID), (const float*)(F.ws + WS_MOE + 704 * 1024)};
            REP(15) pg8::gemm_phase<2048u, 2048u>(F.tid, F.lds, S, E);
            SEAM(10);
        }
        if (IN(11)) { LAUNDER(); STAMP0(11);
            const int ntiles = moe_tables(F, layer, offs, tile_e);
            SchedMoe<1024u, (size_t)1024 * 512 * 2, (size_t)256 * 1024, 8> S{WSB + WS_HID, WSB + WS_EDN, ntiles, F.G, F.bid, tile_e};
            EpiPlainBf16 E{(bf16_t*)(F.ws + WS_YEXP)};
            REP(16) pg8::gemm_phase<1024u, 1024u>(F.tid, F.lds, S, E);
            SEAM(11);
        }
        if (IN(12)) { LAUNDER(); STAMP0(12);
            if (PROBE_ID == 18) combine_phase(F, F.in[IN_NORM1], true);
            combine_phase(F, layer + 1 < DEPTH ? F.in[IN_NORM1] + (layer + 1) * 1024 : nullptr);
            if (layer + 1 < DEPTH) { __syncthreads(); convert_weights(F, layer + 1); __syncthreads(); s5_build(F, layer + 1); }
            SEAM(12);
        }
#undef GP
#undef IN
#undef SEAM
#undef WSB
}
__global__ void __launch_bounds__(NTHR, 2) fwd(Args args) {
    Frame F;
    F.lds = (LAS unsigned char*)lds_raw;
    F.MISC = (volatile LAS unsigned*)(F.lds + MISC_OFF);
    F.tid = threadIdx.x; F.lane = F.tid & 63; F.wave = __builtin_amdgcn_readfirstlane(F.tid >> 6);
    F.G = gridDim.x; F.bid = blockIdx.x;
    const __attribute__((address_space(4))) char* ka = (const __attribute__((address_space(4))) char*)__builtin_amdgcn_kernarg_segment_ptr();
    F.in = (const float* const __attribute__((address_space(4)))*)ka;
    F.out = *(float* const __attribute__((address_space(4)))*)(ka + N_INPUTS * 8); F.ws = *(unsigned char* const __attribute__((address_space(4)))*)(ka + N_INPUTS * 8 + 8); F.ctl = (unsigned*)(F.ws + WS_CTL);
    if (F.tid < 64) F.MISC[F.tid] = 0u;
    __syncthreads();
    XcdBarrier bar; bar.bar = F.ctl + CW_BAR; bar.x = 0; bar.st = nullptr;
    if (!MK_PER_PHASE) bar = xcd_barrier_post(F.ctl + CW_BAR, F.MISC);
    const int lo = *(const __attribute__((address_space(4))) int*)(ka + N_INPUTS * 8 + 16), hi_raw = *(const __attribute__((address_space(4))) int*)(ka + N_INPUTS * 8 + 20), hi = hi_raw & 0xffff;

    layer_body<0>(F, lo, hi, (hi_raw >> 16) != 0);
    layer_body<1>(F, lo, hi, (hi_raw >> 16) != 0);
#ifdef DIAG_GP
    __syncthreads();
    if (blockIdx.x == 0 && threadIdx.x == 0) { const unsigned t0 = *(volatile LAS unsigned*)((LAS unsigned char*)lds_raw_base() + MISC_OFF + 32), t1 = *(volatile LAS unsigned*)((LAS unsigned char*)lds_raw_base() + MISC_OFF + 40); float* o_ = *(float* const __attribute__((address_space(4)))*)((const __attribute__((address_space(4))) char*)__builtin_amdgcn_kernarg_segment_ptr() + N_INPUTS * 8); asm volatile("s_waitcnt vmcnt(0)" ::: "memory"); o_[0] = (float)(t1 - t0); }
#endif
}

extern "C" void kernel_launch(void* const* d_in, const int* in_sizes, int n_in, void* d_out, int out_size, void* d_ws, size_t ws_size, hipStream_t stream) {
    static int grid = 0;
    if (grid == 0) {
        if (n_in != N_INPUTS || out_size != T * DM || ws_size < WS_END) { fprintf(stderr, "kernel_launch: unexpected shapes (n_in %d out %d ws %zu need %zu)\n", n_in, out_size, ws_size, (size_t)WS_END); grid = -1; return; }
        int dev = 0, cus = 0, per_cu = 0;
        if (hipGetDevice(&dev) != hipSuccess || hipDeviceGetAttribute(&cus, hipDeviceAttributeMultiprocessorCount, dev) != hipSuccess) { grid = -1; return; }
        if (hipFuncSetAttribute((const void*)fwd, hipFuncAttributeMaxDynamicSharedMemorySize, LDS_BYTES) != hipSuccess) { fprintf(stderr, "kernel_launch: hipFuncSetAttribute failed\n"); grid = -1; return; }
        if (hipOccupancyMaxActiveBlocksPerMultiprocessor(&per_cu, (const void*)fwd, NTHR, LDS_BYTES) != hipSuccess || per_cu < 1) fprintf(stderr, "kernel_launch: occupancy query reports %d\n", per_cu);
        (void)hipGetLastError();
        grid = cus;
    }
    if (grid < 0) return;
    (void)hipMemsetAsync((char*)d_ws + WS_CTL, 0, CTL_ZERO_BYTES, stream);
    Args a{};
    for (int i = 0; i < N_INPUTS; ++i) a.in[i] = (const float*)d_in[i];
    a.out = (float*)d_out; a.ws = (unsigned char*)d_ws;
#if MK_PER_PHASE
    for (int gp = 0; gp < DEPTH * NPH; ++gp) {
        if (gp == NPH) continue;
        a.gp_lo = gp; a.gp_hi = gp + 1;
        int nrep = 1;
#ifdef PP_REP_GP
        if (gp == PP_REP_GP) nrep = 1 + PP_REP_N;
#endif
        for (int rr = 0; rr < nrep; ++rr) { a.gp_hi = (gp + 1) | (rr > 0 ? 0x10000 : 0); hipLaunchKernelGGL(fwd, dim3(grid), dim3(NTHR), LDS_BYTES, stream, a); }
    }
#else
    a.gp_lo = 0; a.gp_hi = DEPTH * NPH;
    hipLaunchKernelGGL(fwd, dim3(grid), dim3(NTHR), LDS_BYTES, stream, a);
#endif
}
```

```cpp
#include <hip/hip_runtime.h>
#include <cstdio>
#include <cstdint>

#define LAS __attribute__((address_space(3)))
#define GAS __attribute__((address_space(1)))
typedef unsigned short bf16_t;
typedef short bf16x8 __attribute__((ext_vector_type(8)));
typedef float f32x4 __attribute__((ext_vector_type(4)));
typedef float f32x2 __attribute__((ext_vector_type(2)));
typedef unsigned u32x4 __attribute__((ext_vector_type(4)));
typedef unsigned u32x2 __attribute__((ext_vector_type(2)));

constexpr int BATCH = 4, SEQ = 4096, DM = 1024, T = BATCH * SEQ, DEPTH = 2;
constexpr int NIN = 6672, NINP = 6912;
constexpr int C_U = 0, C_Q = 512, C_K = 1024, C_V = 1152, C_Z = 1280, C_XS = 2304, C_B = 3328, C_C = 3456, C_DT = 3584, C_G = 3840;
constexpr int S5_TC = 32, S5_ROWS = T / S5_TC  , S5_K = 128 + S5_TC * 16  , S5_N = S5_TC * 16  ;
constexpr int SSD_NCH = SEQ / 128;
constexpr int MOE_MAXROWS = 2 * T + 32 * 256;
constexpr float NORM_EPS = 1e-6f;

constexpr size_t MiB = 1u << 20;
constexpr size_t WS_CTL = 0, CTL_ZERO_BYTES = 1 * MiB;
constexpr size_t WS_WIN = 1 * MiB;
constexpr size_t WS_WGLU = WS_WIN + (size_t)NINP * DM * 2;
constexpr size_t WS_PCAT = WS_WGLU + 1 * MiB;
constexpr size_t WS_WOUT = WS_PCAT + 4 * MiB;
constexpr size_t WS_EGU = WS_WOUT + 2 * MiB;
constexpr size_t WS_EDN = WS_EGU + 64 * MiB;
constexpr size_t WS_MG = WS_EDN + 32 * MiB;
constexpr size_t WS_EG = WS_MG + 20 * MiB;
constexpr size_t WS_XN = WS_EG + 8 * MiB;
constexpr size_t WS_P = WS_XN + 32 * MiB;
constexpr size_t WS_XG = WS_P;
constexpr size_t WS_HID = WS_XG + (size_t)MOE_MAXROWS * 1024 * 2;
constexpr size_t WS_YEXP = WS_HID + (size_t)MOE_MAXROWS * 512 * 2;
constexpr size_t WS_DT = WS_P + 216 * MiB;
constexpr size_t WS_UH = WS_DT + 1 * MiB;
constexpr size_t WS_HLOC = WS_UH + 20 * MiB;
constexpr size_t WS_YCAT = WS_HLOC + 8 * MiB;
constexpr size_t WS_SST = WS_YCAT + 64 * MiB;
constexpr size_t WS_MOE = WS_SST + 32 * MiB;
constexpr size_t WS_ASUM = WS_MOE + 1 * MiB;
constexpr size_t WS_END = WS_ASUM + 64 * 1024;
static_assert(WS_YEXP + (size_t)MOE_MAXROWS * 1024 * 2 <= WS_DT, "MoE overlay fits in P");
constexpr int CW_BAR = 4096;
constexpr int CW_CNT = 16384;

constexpr int NWAVES = 8, NTHR = 512;
constexpr int LDS_BYTES = 163840;
constexpr int RING_BYTES = 131072;
constexpr int MISC_OFF = 160 * 1024 - 256;

__device__ __forceinline__ unsigned f2bf(float f) { unsigned u = __builtin_bit_cast(unsigned, f); return (u + 0x7fffu + ((u >> 16) & 1u)) >> 16; }
typedef float f32x2_t __attribute__((ext_vector_type(2)));
typedef __bf16 bf16x2_t __attribute__((ext_vector_type(2)));
__device__ __forceinline__ unsigned pk2(float lo, float hi) { f32x2_t v = {lo, hi}; bf16x2_t b = __builtin_convertvector(v, bf16x2_t); return __builtin_bit_cast(unsigned, b); }
__device__ __forceinline__ float bf2f(unsigned b) { return __builtin_bit_cast(float, b << 16); }
__device__ __forceinline__ float bflo(unsigned w) { return __builtin_bit_cast(float, w << 16); }
__device__ __forceinline__ float bfhi(unsigned w) { return __builtin_bit_cast(float, w & 0xffff0000u); }
#define WS_DPP(v, ctrl, rmask) __builtin_bit_cast(float, __builtin_amdgcn_update_dpp(0, __builtin_bit_cast(int, v), ctrl, rmask, 0xF, false))
__device__ __forceinline__ float wave_sum(float v) {
    v += WS_DPP(v, 0xB1, 0xF);
    v += WS_DPP(v, 0x4E, 0xF);
    v += WS_DPP(v, 0x141, 0xF);
    v += WS_DPP(v, 0x140, 0xF);
    v += WS_DPP(v, 0x142, 0xA);
    v += WS_DPP(v, 0x143, 0xC);
    return __builtin_bit_cast(float, __builtin_amdgcn_readlane(__builtin_bit_cast(int, v), 63));
}
__device__ __forceinline__ float frcp(float x) { return __builtin_amdgcn_rcpf(x); }
__device__ __forceinline__ float sigmoidf_(float x) { return frcp(1.0f + __expf(-x)); }
__device__ __forceinline__ float siluf_(float x) { return x * frcp(1.0f + __expf(-x)); }
__device__ __forceinline__ float gelu_tanh_(float x) { const float u = 0.7978845608f * (x + 0.044715f * x * x * x); return x * frcp(1.0f + __expf(-2.0f * u)); }
__device__ __forceinline__ float softplusf_(float x) { return x > 20.f ? x : log1pf(__expf(x)); }

typedef float f32x16 __attribute__((ext_vector_type(16)));
#define MFMA32(a, b, c) __builtin_amdgcn_mfma_f32_32x32x16_bf16((a), (b), (c), 0, 0, 0)
__device__ __forceinline__ unsigned cvtpk(float lo, float hi) { f32x2_t v = {lo, hi}; bf16x2_t b = __builtin_convertvector(v, bf16x2_t); return __builtin_bit_cast(unsigned, b); }
__device__ __forceinline__ bf16x8 pack8v(const float (&v)[8]) { u32x4 p; p.x = cvtpk(v[0], v[1]); p.y = cvtpk(v[2], v[3]); p.z = cvtpk(v[4], v[5]); p.w = cvtpk(v[6], v[7]); return __builtin_bit_cast(bf16x8, p); }

#define XB_TMO      128
#define XB_XCNT(j)  (256  + 64 * (j))
#define XB_XSUB(j)  (1280 + 64 * (j))
#define XB_XGEN(j)  (2304 + 64 * (j))
#define XB_TOP      3328
#define XB_TOPGEN   3392
#define XCD_BAR_WORDS 3456
#define XB_SPIN_CAP (1u << 18)
__device__ __forceinline__ unsigned xb_ld(unsigned* p)              { return __hip_atomic_load(p, __ATOMIC_RELAXED, __HIP_MEMORY_SCOPE_AGENT); }
__device__ __forceinline__ unsigned xb_add(unsigned* p, unsigned v) { return __hip_atomic_fetch_add(p, v, __ATOMIC_RELAXED, __HIP_MEMORY_SCOPE_AGENT); }
__device__ __forceinline__ unsigned xb_xcc_id() { return (unsigned)__builtin_amdgcn_s_getreg((3 << 11) | 20) & 0xFu; }
#define XB_SPIN(cond, bar) do { unsigned _sp = 0; while (cond) { __builtin_amdgcn_s_sleep(1); \
    if ((++_sp & 255u) == 0u) { if (xb_ld(&(bar)[XB_TMO])) break; if (_sp > XB_SPIN_CAP) { atomicAdd(&(bar)[XB_TMO], 1u); break; } } } } while (0)
struct XcdBarrier { unsigned* bar; unsigned x; volatile LAS unsigned* st; };
__device__ __forceinline__ XcdBarrier xcd_barrier_post(unsigned* bar, volatile LAS unsigned* st) {
    XcdBarrier b; b.bar = bar; b.x = xb_xcc_id(); b.st = st;
    if (threadIdx.x == 0) (void)xb_add(&bar[XB_XCNT(b.x)], 1u);
    return b;
}
__device__ __forceinline__ void xcd_barrier_complete(unsigned* bar, unsigned x, unsigned& nloc, unsigned& nx) {
    const unsigned G = gridDim.x * gridDim.y * gridDim.z;
    unsigned sum, cnt, mine, sp = 0u;
    for (;;) {
        sum = 0u; cnt = 0u; mine = 0u;
#pragma unroll
        for (unsigned j = 0; j < 16; ++j) { const unsigned c = xb_ld(&bar[XB_XCNT(j)]); sum += c; cnt += (c > 0u) ? 1u : 0u; mine = (j == x) ? c : mine; }
        if (sum == G) break;
        __builtin_amdgcn_s_sleep(1);
        if ((++sp & 255u) == 0u) { if (xb_ld(&bar[XB_TMO])) break; if (sp > XB_SPIN_CAP) { atomicAdd(&bar[XB_TMO], 1u); break; } }
    }
    nloc = mine > 0u ? mine : 1u; nx = cnt > 0u ? cnt : 1u;
}
__device__ __forceinline__ void xcd_barrier(const XcdBarrier& b) {
    asm volatile("s_waitcnt vmcnt(0)" ::: "memory");
    __syncthreads();
    if (threadIdx.x == 0) {
        unsigned* bar = b.bar;
        __builtin_amdgcn_s_waitcnt(0);
        unsigned nloc = b.st[0], nx = b.st[1];
        if (nloc == 0u) { xcd_barrier_complete(bar, b.x, nloc, nx); b.st[0] = nloc; b.st[1] = nx; }
        const unsigned old = xb_add(&bar[XB_XSUB(b.x)], 1u);
        const unsigned gen = old / nloc;
        if (old + 1u == (gen + 1u) * nloc) {
            __builtin_amdgcn_fence(__ATOMIC_RELEASE, "agent");
            asm volatile("s_waitcnt vmcnt(0)" ::: "memory");
            const unsigned og = xb_add(&bar[XB_TOP], 1u);
            const unsigned tg = og / nx;
            if (og + 1u == (tg + 1u) * nx) xb_add(&bar[XB_TOPGEN], 1u);
            else XB_SPIN(xb_ld(&bar[XB_TOPGEN]) == tg, bar);
            __builtin_amdgcn_fence(__ATOMIC_ACQUIRE, "agent");
            xb_add(&bar[XB_XGEN(b.x)], 1u);
            asm volatile("s_waitcnt vmcnt(0)" ::: "memory");
        } else {
            XB_SPIN(xb_ld(&bar[XB_XGEN(b.x)]) == gen, bar);
            __builtin_amdgcn_fence(__ATOMIC_ACQUIRE, "agent");
            asm volatile("s_waitcnt vmcnt(0)" ::: "memory");
        }
    }
    __syncthreads();
}

namespace pg8 {
constexpr int BM = 256, BK = 64, HALF = 128, HTB = HALF * BK * 2, STAGE_BYTES = 8 * HTB, NXCD = 8, WGM = 8;
__host__ __device__ __forceinline__ int lds_byte(int r, int c) { const int st = (r >> 4) * 2 + (c >> 5), rr = r & 15, cc = c & 31, ob = rr * 64 + cc * 2; return st * 1024 + (ob ^ (((ob >> 9) & 1) << 5)); }
__host__ __device__ __forceinline__ void stage_rc(int b, int& R, int& C) { const int st = b / 1024, sb = b % 1024, swz = sb ^ (((sb >> 9) & 1) << 5); R = (st >> 1) * 16 + swz / 64; C = (st & 1) * 32 + (swz % 64) / 2; }
__host__ __device__ __forceinline__ int perm32(int rho) { const int n = rho >> 4, i = rho & 15; return 8 * (i >> 2) + 4 * n + (i & 3); }

struct Unit { const char* A; const char* B; int nt; int pm, pn, aux; };

__device__ __forceinline__ void tile_order(int L, int nM, int nN, int& pm, int& pn) {
    const int nwg = nM * nN; int wgid = L;
    { const int q = nwg / NXCD, r = nwg % NXCD, xcd = wgid % NXCD, off = wgid / NXCD; wgid = (xcd < r ? xcd * (q + 1) : r * (q + 1) + (xcd - r) * q) + off; }
    const int nig = WGM * nN, gid = wgid / nig, fm = gid * WGM, gsz = (nM - fm) < WGM ? (nM - fm) : WGM;
    pm = fm + ((wgid % nig) % gsz); pn = (wgid % nig) / gsz;
}
__device__ __forceinline__ unsigned cvt_pk_bf16(float lo, float hi) { unsigned r; asm volatile("v_cvt_pk_bf16_f32 %0, %1, %2" : "=v"(r) : "v"(lo), "v"(hi)); return r; }
__device__ __forceinline__ u32x4 pack8(const f32x4 v0, const f32x4 v1) { u32x4 w; w.x = cvt_pk_bf16(v0[0], v0[1]); w.y = cvt_pk_bf16(v0[2], v0[3]); w.z = cvt_pk_bf16(v1[0], v1[1]); w.w = cvt_pk_bf16(v1[2], v1[3]); return w; }

template <unsigned lda, unsigned ldb, class Epi, class Sched>
__device__ __forceinline__ void gemm_phase(const int tid, LAS unsigned char* lds, const Sched& S, const Epi& E) {
    const int wid = __builtin_amdgcn_readfirstlane(tid >> 6), lane = tid & 63, wr = wid >> 2, wc = wid & 3, fr = lane & 15, fq = lane >> 4;
    unsigned voffA[2], voffB[2];
#pragma unroll
    for (int i = 0; i < 2; ++i) { int R, C; stage_rc(tid * 16 + i * 8192, R, C); const int Rb = Epi::PERM ? ((R & ~31) + perm32(R & 31)) : R;
        voffA[i] = (unsigned)R * lda + (unsigned)C * 2u; voffB[i] = (unsigned)Rb * ldb + (unsigned)C * 2u; }
    const size_t kstep = (size_t)(BK * 2);
    const size_t hstepA = (size_t)HALF * lda, hstepB = (size_t)HALF * ldb;
    const unsigned ldsw = (unsigned)wid * 1024u;
    const int aoff = lds_byte(wr * 64 + fr, fq * 8), boff = lds_byte(wc * 32 + fr, fq * 8);
#define PG8_SA(b, h) (((b) * 2 + (h)) * HTB)
#define PG8_SB(b, h) ((4 + (b) * 2 + (h)) * HTB)
#define PG8_STAGE(bufoff, gbase, voff) do { const char* _gb = (const char*)(gbase); asm volatile("" : "+s"(_gb)); _Pragma("unroll") for (int _i = 0; _i < 2; ++_i) \
        __builtin_amdgcn_global_load_lds((const unsigned*)(_gb + (voff)[_i]), (LAS unsigned*)(lds + (bufoff) + ldsw + _i * 8192), 16, 0, 0); } while (0)
#define PG8_LDA(dst, b, h) do { _Pragma("unroll") for (int m = 0; m < 4; ++m) _Pragma("unroll") for (int k = 0; k < 2; ++k) dst[m][k] = *(const LAS bf16x8*)(lds + PG8_SA(b, h) + aoff + m * 2048 + k * 1024); } while (0)
#define PG8_LDB(dst, b, h) do { _Pragma("unroll") for (int n = 0; n < 2; ++n) _Pragma("unroll") for (int k = 0; k < 2; ++k) dst[n][k] = *(const LAS bf16x8*)(lds + PG8_SB(b, h) + boff + n * 2048 + k * 1024); } while (0)
#define PG8_MMA(ai, bj, At, Bt) do { __builtin_amdgcn_s_setprio(1); _Pragma("unroll") for (int m = 0; m < 4; ++m) _Pragma("unroll") for (int n = 0; n < 2; ++n) _Pragma("unroll") for (int k = 0; k < 2; ++k) \
        acc[ai][bj][m][n] = __builtin_amdgcn_mfma_f32_16x16x32_bf16(Bt[n][k], At[m][k], acc[ai][bj][m][n], 0, 0, 0); __builtin_amdgcn_s_setprio(0); } while (0)
#define PG8_WAIT_V(n) asm volatile("s_waitcnt vmcnt(" #n ")" ::: "memory")
#define PG8_WAIT_L(n) asm volatile("s_waitcnt lgkmcnt(" #n ")" ::: "memory")
#define PG8_BAR __builtin_amdgcn_s_barrier()
#define PG8_SCHED __builtin_amdgcn_sched_barrier(0)
    Unit cur, nxt; int ui = 0;
    if (!S.next(0, cur)) return;
    f32x4 acc[2][2][4][2];
#pragma unroll
    for (int a = 0; a < 2; ++a)
#pragma unroll
        for (int b = 0; b < 2; ++b)
#pragma unroll
            for (int m = 0; m < 4; ++m)
#pragma unroll
                for (int n = 0; n < 2; ++n) acc[a][b][m][n] = (f32x4){0.f, 0.f, 0.f, 0.f};
    bf16x8 At[4][2], B0[2][2], B1[2][2];
    const char* cA = cur.A; const char* cB = cur.B;
    PG8_STAGE(PG8_SB(0, 0), cB, voffB); PG8_STAGE(PG8_SB(0, 1), cB + hstepB, voffB); PG8_STAGE(PG8_SA(0, 0), cA, voffA); PG8_STAGE(PG8_SA(0, 1), cA + hstepA, voffA);
    if (wr == 1) PG8_BAR;
    PG8_WAIT_V(2); PG8_BAR;
    PG8_STAGE(PG8_SB(1, 0), cB + kstep, voffB); PG8_STAGE(PG8_SA(1, 0), cA + kstep, voffA); PG8_STAGE(PG8_SB(1, 1), cB + hstepB + kstep, voffB);
    PG8_WAIT_V(6); PG8_BAR;
    for (;;) {
        const bool has_next = S.next(ui + 1, nxt);
        const char* nA = has_next ? nxt.A : cA; const char* nB = has_next ? nxt.B : cB;
        const int nt = cur.nt;
        for (int t = 0; t < nt; t += 2) {
            const bool last = (t == nt - 2);
            const char* a1 = cA + (size_t)(t + 1) * kstep;
            const char* a2 = last ? nA : cA + (size_t)(t + 2) * kstep; const char* b2 = last ? nB : cB + (size_t)(t + 2) * kstep;
            const char* a3 = a2 + kstep; const char* b3 = b2 + kstep;
            PG8_LDB(B0, 0, 0); PG8_LDB(B1, 0, 1); PG8_SCHED; PG8_LDA(At, 0, 0); PG8_STAGE(PG8_SA(1, 1), a1 + hstepA, voffA);
            PG8_WAIT_V(8); PG8_WAIT_L(0); PG8_BAR; PG8_MMA(0, 0, At, B0); PG8_MMA(0, 1, At, B1); PG8_BAR; PG8_SCHED;
            PG8_LDA(At, 0, 1); PG8_STAGE(PG8_SB(0, 0), b2, voffB); PG8_STAGE(PG8_SB(0, 1), b2 + hstepB, voffB); PG8_STAGE(PG8_SA(0, 0), a2, voffA);
            PG8_WAIT_V(8); PG8_WAIT_L(0); PG8_BAR; PG8_MMA(1, 0, At, B0); PG8_MMA(1, 1, At, B1); PG8_BAR; PG8_SCHED;
            PG8_LDB(B0, 1, 0); PG8_LDB(B1, 1, 1); PG8_SCHED; PG8_LDA(At, 1, 0); PG8_STAGE(PG8_SA(0, 1), a2 + hstepA, voffA);
            PG8_WAIT_V(8); PG8_WAIT_L(0); PG8_BAR; PG8_MMA(0, 0, At, B0); PG8_MMA(0, 1, At, B1); PG8_BAR; PG8_SCHED;
            PG8_LDA(At, 1, 1); PG8_STAGE(PG8_SB(1, 0), b3, voffB); PG8_STAGE(PG8_SB(1, 1), b3 + hstepB, voffB); PG8_STAGE(PG8_SA(1, 0), a3, voffA);
            PG8_WAIT_V(8); PG8_WAIT_L(0); PG8_BAR; PG8_MMA(1, 0, At, B0); PG8_MMA(1, 1, At, B1); PG8_BAR; PG8_SCHED;
            if constexpr (Epi::HAS_MID) { if (t + 2 == 8 || t + 2 == 16) { E.mid(acc, cur, t + 2, wr, wc, fr, fq); PG8_SCHED; } }
        }
        if (wr == 0) PG8_BAR;
        E(acc, cur, wr, wc, fr, fq);
        if (!has_next) break;
#pragma unroll
        for (int a = 0; a < 2; ++a)
#pragma unroll
            for (int b = 0; b < 2; ++b)
#pragma unroll
                for (int m = 0; m < 4; ++m)
#pragma unroll
                    for (int n = 0; n < 2; ++n) acc[a][b][m][n] = (f32x4){0.f, 0.f, 0.f, 0.f};
        cur = nxt; cA = nA; cB = nB; ++ui;
        if (wr == 1) PG8_BAR;
    }
    PG8_WAIT_V(0);
    PG8_BAR;
#undef PG8_SA
#undef PG8_SB
#undef PG8_STAGE
#undef PG8_LDA
#undef PG8_LDB
#undef PG8_MMA
#undef PG8_WAIT_V
#undef PG8_WAIT_L
#undef PG8_BAR
#undef PG8_SCHED
}
}

struct Frame {
    LAS unsigned char* lds;
    volatile LAS unsigned* MISC;
    unsigned* ctl;
    int tid, lane, wave, G, bid;
    const float* const __attribute__((address_space(4)))* in;
    float* out; unsigned char* ws;
};
enum { IN_X = 0, IN_NORM1, IN_WIN, IN_BGATE, IN_LRE, IN_LIM, IN_BRE, IN_BIM, IN_CRE, IN_CIM, IN_S5D, IN_LOGDT, IN_GLU1, IN_GLU2, IN_QG, IN_KG, IN_SINK,
       IN_CONVW, IN_CONVB, IN_DTB, IN_ALOG, IN_SSDD, IN_SSDG, IN_PS5, IN_PATTN, IN_PSSD, IN_WOUT, IN_NORM2, IN_WRG, IN_BRG, IN_WRE, IN_BRE_, IN_EG, IN_EU, IN_ED, N_INPUTS };

#define LDS_WAIT() asm volatile("s_waitcnt lgkmcnt(0)" ::: "memory")
#define VM_WAIT() asm volatile("s_waitcnt vmcnt(0)" ::: "memory")

using pg8::Unit; using pg8::pack8;
struct EpiProj {
    static constexpr bool PERM = true, HAS_MID = false;
    unsigned char* ws; const float* bgate;
    __device__ __forceinline__ void operator()(const f32x4 (&acc)[2][2][4][2], const Unit& u, int wr, int wc, int fr, int fq) const {
        bf16_t* P = (bf16_t*)(ws + WS_P); bf16_t* UH = (bf16_t*)(ws + WS_UH); float* DT = (float*)(ws + WS_DT);
        const int row0 = u.pm * 256 + wr * 64 + fr;
        if (u.pn < 2) {
#pragma unroll
            for (int ai = 0; ai < 2; ++ai)
#pragma unroll
                for (int m = 0; m < 4; ++m) { const int row = row0 + ai * 128 + m * 16, r = row >> 5, s = row & 31;
#pragma unroll
                    for (int bj = 0; bj < 2; ++bj) { const int col = u.pn * 256 + bj * 128 + wc * 32 + 8 * fq, g = col >> 4, c0 = col & 15;
                        *(u32x4*)(UH + ((size_t)(g * S5_ROWS + r) * S5_K + 128 + s * 16 + c0)) = pack8(acc[ai][bj][m][0], acc[ai][bj][m][1]); } }
        } else {
            const int colb = u.pn * 256 + wc * 32 + 8 * fq;
            f32x4 bv[2][2];
#pragma unroll
            for (int bj = 0; bj < 2; ++bj)
#pragma unroll
                for (int n = 0; n < 2; ++n) bv[bj][n] = (u.pn >= 15) ? *(const f32x4*)(bgate + (colb - C_G) + bj * 128 + 4 * n) : (f32x4){0.f, 0.f, 0.f, 0.f};
#pragma unroll
            for (int ai = 0; ai < 2; ++ai)
#pragma unroll
                for (int m = 0; m < 4; ++m) { const int row = row0 + ai * 128 + m * 16;
#pragma unroll
                    for (int bj = 0; bj < 2; ++bj) { f32x4 v0 = acc[ai][bj][m][0] + bv[bj][0], v1 = acc[ai][bj][m][1] + bv[bj][1];
                        if (u.pn >= 15) {
#pragma unroll
                            for (int j = 0; j < 4; ++j) { v0[j] = fmaxf(sigmoidf_(v0[j]), 1e-30f); v1[j] = fmaxf(sigmoidf_(v1[j]), 1e-30f); } }
                        *(u32x4*)(P + (size_t)row * NINP + colb + bj * 128) = pack8(v0, v1); }
                    if (u.pn == 14 && wc == 0 && fq < 2) { float* d = DT + (size_t)row * 16 + 8 * fq; *(f32x4*)d = acc[ai][0][m][0]; *(f32x4*)(d + 4) = acc[ai][0][m][1]; } }
        }
    }
};
struct EpiHloc {
    static constexpr bool PERM = false, HAS_MID = false;
    float* H;
    __device__ __forceinline__ void operator()(const f32x4 (&acc)[2][2][4][2], const Unit& u, int wr, int wc, int fr, int fq) const {
#pragma unroll
        for (int ai = 0; ai < 2; ++ai)
#pragma unroll
            for (int m = 0; m < 4; ++m) { const int r = u.pm * 256 + ai * 128 + wr * 64 + m * 16 + fr; float* rowp = H + ((size_t)(u.aux * S5_ROWS + r) * 128) + wc * 32 + 4 * fq;
#pragma unroll
                for (int n = 0; n < 2; ++n) *(f32x4*)(rowp + 16 * n) = acc[ai][0][m][n]; }
    }
};
struct EpiS5Y {
    static constexpr bool PERM = true, HAS_MID = false;
    bf16_t* Y;
    __device__ __forceinline__ void operator()(const f32x4 (&acc)[2][2][4][2], const Unit& u, int wr, int wc, int fr, int fq) const {
#pragma unroll
        for (int ai = 0; ai < 2; ++ai)
#pragma unroll
            for (int m = 0; m < 4; ++m) { const int r = u.pm * 256 + ai * 128 + wr * 64 + m * 16 + fr;
#pragma unroll
                for (int bj = 0; bj < 2; ++bj) { const int n0 = u.pn * 256 + bj * 128 + wc * 32 + 8 * fq, t = n0 >> 4, c0 = n0 & 15;
                    f32x4 v0 = acc[ai][bj][m][0], v1 = acc[ai][bj][m][1];
#pragma unroll
                    for (int j = 0; j < 4; ++j) { v0[j] = gelu_tanh_(v0[j]); v1[j] = gelu_tanh_(v1[j]); }
                    *(u32x4*)(Y + ((size_t)(r * S5_TC + t) * 512 + u.aux * 16 + c0)) = pack8(v0, v1); } }
    }
};
struct EpiGlu {
    static constexpr bool PERM = true, HAS_MID = false;
    bf16_t* Y;
    __device__ __forceinline__ void operator()(const f32x4 (&acc)[2][2][4][2], const Unit& u, int wr, int wc, int fr, int fq) const {
#pragma unroll
        for (int ai = 0; ai < 2; ++ai)
#pragma unroll
            for (int m = 0; m < 4; ++m) { const int row = u.pm * 256 + ai * 128 + wr * 64 + m * 16 + fr;
                f32x4 v0 = acc[ai][0][m][0], v1 = acc[ai][0][m][1]; const f32x4 g0 = acc[ai][1][m][0], g1 = acc[ai][1][m][1];
#pragma unroll
                for (int j = 0; j < 4; ++j) { v0[j] *= sigmoidf_(g0[j]); v1[j] *= sigmoidf_(g1[j]); }
                *(u32x4*)(Y + (size_t)row * 2048 + u.pn * 128 + wc * 32 + 8 * fq) = pack8(v0, v1); }
    }
};
struct EpiSwiGlu {
    static constexpr bool PERM = true, HAS_MID = false;
    bf16_t* Y; const float* RSG;
    __device__ __forceinline__ void operator()(const f32x4 (&acc)[2][2][4][2], const Unit& u, int wr, int wc, int fr, int fq) const {
#pragma unroll
        for (int ai = 0; ai < 2; ++ai)
#pragma unroll
            for (int m = 0; m < 4; ++m) { const int row = u.pm * 256 + ai * 128 + wr * 64 + m * 16 + fr;
                f32x4 v0 = acc[ai][0][m][0], v1 = acc[ai][0][m][1]; const f32x4 g0 = acc[ai][1][m][0], g1 = acc[ai][1][m][1]; const float rr = 1.f;
#pragma unroll
                for (int j = 0; j < 4; ++j) { v0[j] = siluf_(v0[j] * rr) * (g0[j] * rr); v1[j] = siluf_(v1[j] * rr) * (g1[j] * rr); }
                *(u32x4*)(Y + (size_t)row * 512 + u.pn * 128 + wc * 32 + 8 * fq) = pack8(v0, v1); }
    }
};
struct EpiPlainBf16 {
    static constexpr bool PERM = true, HAS_MID = false;
    bf16_t* O;
    __device__ __forceinline__ void operator()(const f32x4 (&acc)[2][2][4][2], const Unit& u, int wr, int wc, int fr, int fq) const {
#pragma unroll
        for (int ai = 0; ai < 2; ++ai)
#pragma unroll
            for (int m = 0; m < 4; ++m) { const int row = u.pm * 256 + ai * 128 + wr * 64 + m * 16 + fr;
#pragma unroll
                for (int bj = 0; bj < 2; ++bj) *(u32x4*)(O + (size_t)row * 1024 + u.pn * 256 + bj * 128 + wc * 32 + 8 * fq) = pack8(acc[ai][bj][m][0], acc[ai][bj][m][1]); }
    }
};
struct EpiMerged {
    static constexpr bool PERM = true, HAS_MID = true;
    unsigned char* ws;
    __device__ __forceinline__ static float lclamp(float l) { return fminf(fmaxf(l, -30.f), 30.f); }
    __device__ __forceinline__ void mid(f32x4 (&acc)[2][2][4][2], const Unit& u, int kt, int wr, int wc, int fr, int fq) const {
        const int br = (kt == 8) ? 0 : 1; const bf16_t* P = (const bf16_t*)(ws + WS_P);
#pragma unroll
        for (int ai = 0; ai < 2; ++ai)
#pragma unroll
            for (int m = 0; m < 4; ++m) { const int row = u.pm * 256 + ai * 128 + wr * 64 + m * 16 + fr;
#pragma unroll
                for (int bj = 0; bj < 2; ++bj) { const bf16_t* gp = P + (size_t)row * NINP + C_G + br * 1024 + u.pn * 256 + bj * 128 + wc * 32 + 8 * fq;
                    const u32x4 la = *(const u32x4*)gp, lb = *(const u32x4*)(gp + 1024);
#pragma unroll
                    for (int j = 0; j < 4; ++j) { const unsigned wa = la[j], wb = lb[j];
                        const float r0 = bflo(wa) * frcp(bflo(wb)), r1 = bfhi(wa) * frcp(bfhi(wb));
                        if (j < 2) { acc[ai][bj][m][0][2 * j] *= r0; acc[ai][bj][m][0][2 * j + 1] *= r1; } else { acc[ai][bj][m][1][2 * j - 4] *= r0; acc[ai][bj][m][1][2 * j - 3] *= r1; } } }
                if (m == 3) asm volatile("" ::: "memory"); }
    }
    __device__ __forceinline__ void operator()(const f32x4 (&acc)[2][2][4][2], const Unit& u, int wr, int wc, int fr, int fq) const {
        const bf16_t* P = (const bf16_t*)(ws + WS_P); bf16_t* O = (bf16_t*)(ws + WS_XN);
#pragma unroll
        for (int ai = 0; ai < 2; ++ai)
#pragma unroll
            for (int m = 0; m < 4; ++m) { const int row = u.pm * 256 + ai * 128 + wr * 64 + m * 16 + fr;
#pragma unroll
                for (int bj = 0; bj < 2; ++bj) { const int col = u.pn * 256 + bj * 128 + wc * 32 + 8 * fq;
                    const u32x4 lc = *(const u32x4*)(P + (size_t)row * NINP + C_G + 2048 + col);
                    f32x4 v0 = acc[ai][bj][m][0], v1 = acc[ai][bj][m][1];
                    v0[0] *= bflo(lc[0]); v0[1] *= bfhi(lc[0]); v0[2] *= bflo(lc[1]); v0[3] *= bfhi(lc[1]);
                    v1[0] *= bflo(lc[2]); v1[1] *= bfhi(lc[2]); v1[2] *= bflo(lc[3]); v1[3] *= bfhi(lc[3]);
                    *(u32x4*)(O + (size_t)row * 1024 + col) = pack8(v0, v1); }
                if (m == 3) asm volatile("" ::: "memory"); }
    }
};
struct EpiResid {
    static constexpr bool PERM = false, HAS_MID = false;
    const float* resid; float* out;
    __device__ __forceinline__ void operator()(const f32x4 (&acc)[2][2][4][2], const Unit& u, int wr, int wc, int fr, int fq) const {
#pragma unroll
        for (int ai = 0; ai < 2; ++ai)
#pragma unroll
            for (int m = 0; m < 4; ++m) { const size_t off = (size_t)(u.pm * 256 + ai * 128 + wr * 64 + m * 16 + fr) * 1024 + u.pn * 256 + wc * 32 + 4 * fq;
#pragma unroll
                for (int bj = 0; bj < 2; ++bj)
#pragma unroll
                    for (int n = 0; n < 2; ++n) { const f32x4 rv = *(const f32x4*)(resid + off + bj * 128 + n * 16); *(f32x4*)(out + off + bj * 128 + n * 16) = rv + acc[ai][bj][m][n]; } }
    }
};

template <unsigned lda, unsigned ldb, int nM, int nN, int NT>
struct SchedDense {
    const char* A; const char* B; int G, c;
    __device__ __forceinline__ bool next(int i, Unit& u) const {
        const int L = i * G + c; if (L >= nM * nN) return false;
        int pm, pn; pg8::tile_order(L, nM, nN, pm, pn);
        u.A = A + (size_t)pm * 256 * lda; u.B = B + (size_t)pn * 256 * ldb; u.nt = NT; u.pm = pm; u.pn = pn; u.aux = 0; return true;
    }
};
struct SchedS5P1 {
    const char* UH; const char* EG; int G, c;
    __device__ __forceinline__ bool next(int i, Unit& u) const {
        const int L = i * G + c; if (L >= 64) return false;
        const int g = L >> 1, pm = L & 1;
        u.A = UH + ((size_t)(g * S5_ROWS + pm * 256) * S5_K + 128) * 2; u.B = EG + (size_t)g * 256 * 512 * 2; u.nt = 8; u.pm = pm; u.pn = 0; u.aux = g; return true;
    }
};
struct SchedS5Main {
    const char* UH; const char* MG; int G, c;
    __device__ __forceinline__ bool next(int i, Unit& u) const {
        const int L = i * G + c; if (L >= 128) return false;
        const int g = L >> 2, pm = (L >> 1) & 1, pn = L & 1;
        u.A = UH + (size_t)(g * S5_ROWS + pm * 256) * S5_K * 2; u.B = MG + (size_t)(g * S5_N + pn * 256) * S5_K * 2; u.nt = 2 + 4 * (pn + 1); u.pm = pm; u.pn = pn; u.aux = g; return true;
    }
};
template <unsigned lda, size_t bexp  , size_t btile  , int NT>
struct SchedMoe {
    const char* A; const char* B; int ntiles, G, c; const volatile LAS int* tile_e;
    __device__ __forceinline__ bool next(int i, Unit& u) const {
        const int L = i * G + c; if (L >= ntiles * 4) return false;
        int pm, pn; pg8::tile_order(L, ntiles, 4, pm, pn);
        const int e = __builtin_amdgcn_readfirstlane(tile_e[pm]);
        u.A = A + (size_t)pm * 256 * lda; u.B = B + (size_t)e * bexp + (size_t)pn * btile; u.nt = NT; u.pm = pm; u.pn = pn; u.aux = e; return true;
    }
};

__device__ __forceinline__ void transpose_item(const float* W, int ldw, int ncols, bf16_t* WT, int ldt, int kofs, int mode, int p0, int p1, LAS float* scr, int k0, int n0, int lane) {
    float wv[32];
#pragma unroll
    for (int i = 0; i < 32; ++i) { const int kk = 2 * i + (lane >> 5), n = n0 + (lane & 31); wv[i] = (n < ncols) ? W[(size_t)(k0 + kk) * ldw + n] : 0.f; }
#pragma unroll
    for (int i = 0; i < 32; ++i) { const int kk = 2 * i + (lane >> 5); scr[kk * 33 + (lane & 31)] = wv[i]; }
    LDS_WAIT(); asm volatile("" ::: "memory");
    const int c = lane & 7;
#pragma unroll
    for (int j = 0; j < 4; ++j) { const int nn = (lane >> 3) + 8 * j, n = n0 + nn; const LAS float* s = scr + (8 * c) * 33 + nn;
        u32x4 o; o.x = pk2(s[0 * 33], s[1 * 33]); o.y = pk2(s[2 * 33], s[3 * 33]); o.z = pk2(s[4 * 33], s[5 * 33]); o.w = pk2(s[6 * 33], s[7 * 33]);
        const int drow = (mode == 0) ? n + (n >= p0 ? p1 : 0) : ((n >> 7) * 256 + (n & 127) + 128 * p0);
        if (n < ncols) *(u32x4*)(WT + (size_t)drow * ldt + kofs + k0 + 8 * c) = o; }
    LDS_WAIT(); asm volatile("" ::: "memory");
}
__device__ __forceinline__ void convert_weights(Frame& F, int layer) {
    LAS float* scr = (LAS float*)(F.lds + F.wave * 16384);
    const int gw = F.bid * NWAVES + F.wave, NGW = F.G * NWAVES;
    bf16_t* WIN = (bf16_t*)(F.ws + WS_WIN); bf16_t* WGLU = (bf16_t*)(F.ws + WS_WGLU); bf16_t* PCAT = (bf16_t*)(F.ws + WS_PCAT); bf16_t* WOUT = (bf16_t*)(F.ws + WS_WOUT);
    bf16_t* EGU = (bf16_t*)(F.ws + WS_EGU); bf16_t* EDN = (bf16_t*)(F.ws + WS_EDN);
    constexpr int I_WIN = 16 * 209, I_GLU = 8 * 16, I_P5 = 8 * 32, I_PS = 16 * 32, I_WO = 16 * 32, I_EG = 32 * 256, I_ED = 32 * 256;
    constexpr int NITEMS = I_WIN + 2 * I_GLU + 2 * I_P5 + I_PS + I_WO + 2 * I_EG + I_ED;
    for (int it = gw; it < NITEMS; it += NGW) {
        int r = it;
        if (r < I_WIN) { transpose_item(F.in[IN_WIN] + (size_t)layer * DM * NIN, NIN, NIN, WIN, DM, 0, 0, 3600, 240, scr, 64 * (r / 209), 32 * (r % 209), F.lane); continue; } r -= I_WIN;
        if (r < I_GLU) { transpose_item(F.in[IN_GLU1] + (size_t)layer * 512 * 512, 512, 512, WGLU, 512, 0, 1, 0, 0, scr, 64 * (r / 16), 32 * (r % 16), F.lane); continue; } r -= I_GLU;
        if (r < I_GLU) { transpose_item(F.in[IN_GLU2] + (size_t)layer * 512 * 512, 512, 512, WGLU, 512, 0, 1, 1, 0, scr, 64 * (r / 16), 32 * (r % 16), F.lane); continue; } r -= I_GLU;
        if (r < I_P5) { transpose_item(F.in[IN_PS5] + (size_t)layer * 512 * 1024, 1024, 1024, PCAT, 2048, 0, 0, 1 << 30, 0, scr, 64 * (r / 32), 32 * (r % 32), F.lane); continue; } r -= I_P5;
        if (r < I_P5) { transpose_item(F.in[IN_PATTN] + (size_t)layer * 512 * 1024, 1024, 1024, PCAT, 2048, 512, 0, 1 << 30, 0, scr, 64 * (r / 32), 32 * (r % 32), F.lane); continue; } r -= I_P5;
        if (r < I_PS) { transpose_item(F.in[IN_PSSD] + (size_t)layer * 1024 * 1024, 1024, 1024, PCAT, 2048, 1024, 0, 1 << 30, 0, scr, 64 * (r / 32), 32 * (r % 32), F.lane); continue; } r -= I_PS;
        if (r < I_WO) { transpose_item(F.in[IN_WOUT] + (size_t)layer * 1024 * 1024, 1024, 1024, WOUT, 1024, 0, 0, 1 << 30, 0, scr, 64 * (r / 32), 32 * (r % 32), F.lane); continue; } r -= I_WO;
        if (r < I_EG) { const int e = r >> 8, q = r & 255; transpose_item(F.in[IN_EG] + ((size_t)layer * 32 + e) * 1024 * 512, 512, 512, EGU + (size_t)e * 1024 * 1024, 1024, 0, 1, 0, 0, scr, 64 * (q / 16), 32 * (q % 16), F.lane); continue; } r -= I_EG;
        if (r < I_EG) { const int e = r >> 8, q = r & 255; transpose_item(F.in[IN_EU] + ((size_t)layer * 32 + e) * 1024 * 512, 512, 512, EGU + (size_t)e * 1024 * 1024, 1024, 0, 1, 1, 0, scr, 64 * (q / 16), 32 * (q % 16), F.lane); continue; } r -= I_EG;
        { const int e = r >> 8, q = r & 255; transpose_item(F.in[IN_ED] + ((size_t)layer * 32 + e) * 512 * 1024, 1024, 1024, EDN + (size_t)e * 1024 * 512, 512, 0, 0, 1 << 30, 0, scr, 64 * (q / 32), 32 * (q % 32), F.lane); }
    }
}
__device__ __forceinline__ void sincos_fast(float x, float& s, float& c) {
    const float k = rintf(x * 0.15915494309189535f);
    float r = fmaf(-k, 6.2831854820251465f, x); r = fmaf(-k, -1.7484555e-07f, r);
    s = __sinf(r); c = __cosf(r);
}
__device__ __forceinline__ void sincos_red(float x, float& s, float& c) {
    const float k = rintf(x * 0.15915494309189535f);
    float r = fmaf(-k, 6.2831854820251465f, x); r = fmaf(-k, -1.7484555e-07f, r);
    s = sinf(r); c = cosf(r);
}
__device__ __forceinline__ void s5_build(Frame& F, int layer) {
    LAS float* pw = (LAS float*)F.lds;
    LAS float* Bb = pw + 33 * 64 * 2;
    LAS float* Cc = Bb + 64 * 16 * 2;
    LAS float* Kd = Cc + 16 * 64 * 2;
    bf16_t* MG = (bf16_t*)(F.ws + WS_MG); bf16_t* EG = (bf16_t*)(F.ws + WS_EG);
    for (int w = F.bid; w < 256; w += F.G) {
        const int g = w >> 3, part = w & 7, gi = layer * 32 + g;
        __syncthreads();
        const float dt = __expf(F.in[IN_LOGDT][gi]);
        for (int i = F.tid; i < 33 * 64; i += NTHR) { const int d = i >> 6, p = i & 63; const float lr = F.in[IN_LRE][gi * 64 + p], li = F.in[IN_LIM][gi * 64 + p];
            float s, c; sincos_red((float)d * li * dt, s, c); const float mg = __expf((float)d * lr * dt); pw[2 * i] = mg * c; pw[2 * i + 1] = mg * s; }
        for (int i = F.tid; i < 64 * 16; i += NTHR) { const int p = i >> 4; const float lr = F.in[IN_LRE][gi * 64 + p], li = F.in[IN_LIM][gi * 64 + p];
            float s, c; sincos_red(li * dt, s, c); const float mg = __expf(lr * dt), are = mg * c, aim = mg * s, nr = are - 1.f, den = lr * lr + li * li;
            const float fre = (nr * lr + aim * li) / den, fim = (aim * lr - nr * li) / den;
            const float br = F.in[IN_BRE][(size_t)gi * 1024 + i], bi = F.in[IN_BIM][(size_t)gi * 1024 + i];
            Bb[2 * i] = fre * br - fim * bi; Bb[2 * i + 1] = fre * bi + fim * br; }
        for (int i = F.tid; i < 16 * 64; i += NTHR) { Cc[2 * i] = F.in[IN_CRE][(size_t)gi * 1024 + i]; Cc[2 * i + 1] = F.in[IN_CIM][(size_t)gi * 1024 + i]; }
        __syncthreads();
        { const int d = F.tid >> 4, c = F.tid & 15; float acc[16];
#pragma unroll
          for (int j = 0; j < 16; ++j) acc[j] = 0.f;
          for (int p = 0; p < 64; ++p) { const float cr = Cc[2 * (c * 64 + p)], ci = Cc[2 * (c * 64 + p) + 1], pr = pw[2 * (d * 64 + p)], pi = pw[2 * (d * 64 + p) + 1];
              const float xr = cr * pr - ci * pi, xi = cr * pi + ci * pr;
#pragma unroll
              for (int q = 0; q < 8; ++q) { const f32x4 bb = *(const LAS f32x4*)(Bb + 2 * (p * 16) + 4 * q); acc[2 * q] += xr * bb.x - xi * bb.y; acc[2 * q + 1] += xr * bb.z - xi * bb.w; } }
#pragma unroll
          for (int j = 0; j < 16; ++j) Kd[(d * 16 + c) * 16 + j] = acc[j]; }
        __syncthreads();
        for (int v = F.tid; v < 64 * 80; v += NTHR) { const int n = part * 64 + v / 80, k0 = (v % 80) * 8, t = n >> 4, c = n & 15; float o[8];
            if (k0 < 128) { const int im = k0 >= 64, p0 = k0 & 63;
#pragma unroll
                for (int j = 0; j < 8; ++j) { const int p = p0 + j; const float cr = Cc[2 * (c * 64 + p)], ci = Cc[2 * (c * 64 + p) + 1], pr = pw[2 * ((t + 1) * 64 + p)], pi = pw[2 * ((t + 1) * 64 + p) + 1];
                    o[j] = im ? -(cr * pi + ci * pr) : (cr * pr - ci * pi); }
            } else { const int s = (k0 - 128) >> 4, c0 = (k0 - 128) & 15;
#pragma unroll
                for (int j = 0; j < 8; ++j) { float x = 0.f; if (s <= t) { x = Kd[(t - s) * 256 + c * 16 + c0 + j]; if (s == t && c == c0 + j) x += F.in[IN_S5D][layer * 512 + g * 16 + c]; } o[j] = x; } }
            u32x4 q; q.x = pk2(o[0], o[1]); q.y = pk2(o[2], o[3]); q.z = pk2(o[4], o[5]); q.w = pk2(o[6], o[7]);
            *(u32x4*)(MG + ((size_t)(g * S5_N + n) * S5_K + k0)) = q; }
        for (int v = F.tid; v < 16 * 64; v += NTHR) { const int jr = part * 16 + v / 64, k0 = (v % 64) * 8, im = jr >= 64, p = jr & 63, s = k0 >> 4, c0 = k0 & 15; float o[8];
            const float pr = pw[2 * ((S5_TC - 1 - s) * 64 + p)], pi = pw[2 * ((S5_TC - 1 - s) * 64 + p) + 1];
#pragma unroll
            for (int j = 0; j < 8; ++j) { const float br = Bb[2 * (p * 16 + c0 + j)], bi = Bb[2 * (p * 16 + c0 + j) + 1]; o[j] = im ? (pr * bi + pi * br) : (pr * br - pi * bi); }
            u32x4 q; q.x = pk2(o[0], o[1]); q.y = pk2(o[2], o[3]); q.z = pk2(o[4], o[5]); q.w = pk2(o[6], o[7]);
            *(u32x4*)(EG + ((size_t)(g * 256 + jr) * 512 + k0)) = q; }
    }
    __syncthreads();
}
__device__ __forceinline__ void rms_row_to_bf16(const float* xrow, const float* gain, bf16_t* orow, int lane) {
    const f32x4* xr = (const f32x4*)xrow + lane; const f32x4* gr = (const f32x4*)gain + lane;
    f32x4 v[4]; float s = 0.f;
#pragma unroll
    for (int j = 0; j < 4; ++j) { v[j] = xr[64 * j]; s += (v[j].x * v[j].x + v[j].y * v[j].y) + (v[j].z * v[j].z + v[j].w * v[j].w); }
    const float rstd = __builtin_amdgcn_rsqf(wave_sum(s) * (1.f / DM) + NORM_EPS);
    unsigned long long* o8 = (unsigned long long*)orow + lane;
#pragma unroll
    for (int j = 0; j < 4; ++j) { const f32x4 gv = gr[64 * j]; o8[64 * j] = (unsigned long long)pk2(v[j].x * rstd * gv.x, v[j].y * rstd * gv.y) | ((unsigned long long)pk2(v[j].z * rstd * gv.z, v[j].w * rstd * gv.w) << 32); }
}
__device__ __forceinline__ void rmsnorm_rows(Frame& F, const float* x, const float* gain, bf16_t* o) {
    const int gw = F.bid * NWAVES + F.wave, NGW = F.G * NWAVES;
    for (int m = gw; m < T; m += NGW) rms_row_to_bf16(x + (size_t)m * DM, gain, o + (size_t)m * DM, F.lane);
}

__device__ __forceinline__ void s5_scan(Frame& F, int layer) {
    const float* HL = (const float*)(F.ws + WS_HLOC); bf16_t* UH = (bf16_t*)(F.ws + WS_UH);
    for (int i = (F.G - 1 - F.bid) * NTHR + F.tid; i < BATCH * 32 * 64; i += F.G * NTHR) {
        const int p = i & 63, g = (i >> 6) & 31, b = i >> 11, gi = layer * 32 + g;
        const float dt = __expf(F.in[IN_LOGDT][gi]), lr = F.in[IN_LRE][gi * 64 + p], li = F.in[IN_LIM][gi * 64 + p];
        float s, c; sincos_red((float)S5_TC * li * dt, s, c); const float mg = __expf((float)S5_TC * lr * dt), ar = mg * c, ai = mg * s;
        float hr = 0.f, hi = 0.f;
        const int nch = SEQ / S5_TC;
        for (int c0 = 0; c0 < nch; c0 += 32) { float lr_[32], li_[32];
#pragma unroll
            for (int k = 0; k < 32; ++k) { const size_t r = (size_t)g * S5_ROWS + b * nch + c0 + k; lr_[k] = HL[r * 128 + p]; li_[k] = HL[r * 128 + 64 + p]; }
#pragma unroll
            for (int k = 0; k < 32; ++k) { const size_t r = (size_t)g * S5_ROWS + b * nch + c0 + k;
                UH[r * S5_K + p] = (bf16_t)f2bf(hr); UH[r * S5_K + 64 + p] = (bf16_t)f2bf(hi);
                const float nr = ar * hr - ai * hi + lr_[k], ni = ar * hi + ai * hr + li_[k]; hr = nr; hi = ni; } }
    }
}

__device__ __forceinline__ void ssd_stage_bc(Frame& F, int layer, int b, int ch, int grp, LAS float* Bs, LAS float* Cs, LAS float* dts, LAS float* das) {
    const bf16_t* P = (const bf16_t*)(F.ws + WS_P); const float* DT = (const float*)(F.ws + WS_DT);
    const float* cw = F.in[IN_CONVW] + layer * 4 * 1280; const float* cb = F.in[IN_CONVB] + layer * 1280;
    const int l0 = ch * 128; const size_t row0 = (size_t)b * SEQ + l0;
    for (int i = F.tid; i < 2 * 128 * 64; i += NTHR) { const int isC = i >> 13, t = (i >> 6) & 127, n = i & 63;
        const int col = (isC ? C_C : C_B) + grp * 64 + n, cc = 1024 + isC * 128 + grp * 64 + n; float a = cb[cc];
#pragma unroll
        for (int j = 0; j < 4; ++j) { const int l = l0 + t - 3 + j; if (l >= 0) a += cw[j * 1280 + cc] * bf2f(P[(row0 + t - 3 + j) * NINP + col]); }
        (isC ? Cs : Bs)[t * 64 + n] = siluf_(a); }
    for (int i = F.tid; i < 128 * 8; i += NTHR) { const int t = i >> 3, hh = i & 7, h = grp * 8 + hh;
        const float dt = softplusf_(DT[(row0 + t) * 16 + h] + F.in[IN_DTB][layer * 16 + h]); dts[i] = dt; das[i] = dt * (-__expf(F.in[IN_ALOG][layer * 16 + h])); }
}
template <bool OUT>
__device__ __forceinline__ void ssd_units(Frame& F, int layer) {
    LAS float* Bs = (LAS float*)F.lds; LAS float* Cs = Bs + 128 * 64; LAS float* dts = Cs + 128 * 64; LAS float* das = dts + 128 * 8; LAS float* ssq = das + 128 * 8;
    const bf16_t* P = (const bf16_t*)(F.ws + WS_P); float* SST = (float*)(F.ws + WS_SST); float* ASUM = (float*)(F.ws + WS_ASUM); bf16_t* YC = (bf16_t*)(F.ws + WS_YCAT);
    const float* cw = F.in[IN_CONVW] + layer * 4 * 1280; const float* cb = F.in[IN_CONVB] + layer * 1280;
    for (int u = F.bid; u < BATCH * SSD_NCH * 2; u += F.G) {
        const int grp = u & 1, ch = (u >> 1) & 31, b = u >> 6;
        __syncthreads();
        ssd_stage_bc(F, layer, b, ch, grp, Bs, Cs, dts, das);
        __syncthreads();
        const int hh = F.wave, h = grp * 8 + hh, p = F.lane, cx = h * 64 + p;
        const float w0 = cw[cx], w1 = cw[1280 + cx], w2 = cw[2560 + cx], w3 = cw[3840 + cx], bias = cb[cx], dsk = F.in[IN_SSDD][layer * 16 + h];
        const int l0 = ch * 128; const size_t row0 = (size_t)b * SEQ + l0;
        const bf16_t* xp = P + row0 * NINP + C_XS + cx;
        float x0 = 0.f, x1 = 0.f, x2 = 0.f;
        if (l0 > 0) { x0 = bf2f(xp[-3 * (ptrdiff_t)NINP]); x1 = bf2f(xp[-2 * (ptrdiff_t)NINP]); x2 = bf2f(xp[-1 * (ptrdiff_t)NINP]); }
        float st[64];
        float* sp = SST + ((((size_t)b * SSD_NCH + ch) * 16 + h) * 64 + p) * 64;
        if (OUT) {
#pragma unroll
            for (int n = 0; n < 64; n += 4) { const f32x4 v = *(const f32x4*)(sp + n); st[n] = v.x; st[n + 1] = v.y; st[n + 2] = v.z; st[n + 3] = v.w; }
        } else {
#pragma unroll
            for (int n = 0; n < 64; ++n) st[n] = 0.f;
        }
        float asum = 0.f;
#pragma unroll 4
        for (int t = 0; t < 128; ++t) {
            const float x3 = bf2f(xp[(size_t)t * NINP]);
            const float xs = siluf_(bias + w0 * x0 + w1 * x1 + w2 * x2 + w3 * x3);
            x0 = x1; x1 = x2; x2 = x3;
            const float dt = dts[t * 8 + hh], a = das[t * 8 + hh], da = __expf(a), xdt = xs * dt;
            asum += a;
            float y = 0.f;
#pragma unroll
            for (int n = 0; n < 64; n += 4) { const f32x4 bv = *(const LAS f32x4*)(Bs + t * 64 + n);
                st[n] = da * st[n] + bv.x * xdt; st[n + 1] = da * st[n + 1] + bv.y * xdt; st[n + 2] = da * st[n + 2] + bv.z * xdt; st[n + 3] = da * st[n + 3] + bv.w * xdt;
                if (OUT) { const f32x4 cv = *(const LAS f32x4*)(Cs + t * 64 + n); y += (cv.x * st[n] + cv.y * st[n + 1]) + (cv.z * st[n + 2] + cv.w * st[n + 3]); } }
            if (OUT) {
                const float z = bf2f(P[(row0 + t) * NINP + C_Z + cx]);
                const float yz = (y + dsk * xs) * siluf_(z);
                const float q = wave_sum(yz * yz);
                if (p == 0) ssq[t * 8 + hh] = q;
                YC[(row0 + t) * 2048 + 1024 + cx] = (bf16_t)f2bf(yz);
            }
        }
        if (!OUT) {
#pragma unroll
            for (int n = 0; n < 64; n += 4) *(f32x4*)(sp + n) = (f32x4){st[n], st[n + 1], st[n + 2], st[n + 3]};
            if (p == 0) ASUM[((size_t)b * SSD_NCH + ch) * 16 + h] = asum;
        } else {
            __syncthreads();
            const float ng = F.in[IN_SSDG][layer * 1024 + cx];
            for (int t = 0; t < 128; ++t) { float q = 0.f;
#pragma unroll
                for (int j = 0; j < 8; ++j) q += ssq[t * 8 + j];
                const float rs = __builtin_amdgcn_rsqf(q * (1.f / 512.f) + NORM_EPS);
                bf16_t* yp = YC + (row0 + t) * 2048 + 1024 + cx; *yp = (bf16_t)f2bf(bf2f(*yp) * rs * ng); }
        }
    }
}
__device__ __forceinline__ void ssd_scan(Frame& F) {
    bf16_t* SST = (bf16_t*)(F.ws + WS_SST); const float* ASUM = (const float*)(F.ws + WS_ASUM);
    for (int i = F.bid * NTHR + F.tid; i < BATCH * 16 * 512; i += F.G * NTHR) {
        const int pn = (i & 511) * 8, h = (i >> 9) & 15, b = i >> 13; float s[8];
#pragma unroll
        for (int j = 0; j < 8; ++j) s[j] = 0.f;
        u32x4 loc[SSD_NCH]; float dec[SSD_NCH];
#pragma unroll
        for (int ch = 0; ch < SSD_NCH; ++ch) { loc[ch] = *(const u32x4*)(SST + (((size_t)b * SSD_NCH + ch) * 16 + h) * 4096 + pn); dec[ch] = ASUM[((size_t)b * SSD_NCH + ch) * 16 + h]; }
#pragma unroll
        for (int ch = 0; ch < SSD_NCH; ++ch) { u32x4 o; o.x = pk2(s[0], s[1]); o.y = pk2(s[2], s[3]); o.z = pk2(s[4], s[5]); o.w = pk2(s[6], s[7]);
            *(u32x4*)(SST + (((size_t)b * SSD_NCH + ch) * 16 + h) * 4096 + pn) = o; const float d = __expf(dec[ch]);
#pragma unroll
            for (int j = 0; j < 4; ++j) { s[2 * j] = s[2 * j] * d + bflo(loc[ch][j]); s[2 * j + 1] = s[2 * j + 1] * d + bfhi(loc[ch][j]); } }
    }
}

__device__ __forceinline__ void attn_units(Frame& F, int layer) {
    LAS float* Ks = (LAS float*)F.lds; LAS float* Vs = Ks + 256 * 64;
    const bf16_t* P = (const bf16_t*)(F.ws + WS_P); bf16_t* YC = (bf16_t*)(F.ws + WS_YCAT);
    const float* qg = F.in[IN_QG] + layer * 64; const float* kg = F.in[IN_KG] + layer * 64;
    for (int u = F.bid; u < BATCH * 32 * 2; u += F.G) {
        const int kvh = u & 1, qb = (u >> 1) & 31, b = u >> 6, q0 = qb * 128;
        int lane = F.lane; asm volatile("" : "+v"(lane));
        __syncthreads();
        for (int jr = F.wave; jr < 256; jr += NWAVES) { const int l = q0 - 128 + jr; float kv = 0.f, vv = 0.f;
            if (l >= 0) { const size_t row = (size_t)b * SEQ + l; const float x = bf2f(P[row * NINP + C_K + kvh * 64 + lane]); vv = bf2f(P[row * NINP + C_V + kvh * 64 + lane]);
                const float rs = __builtin_amdgcn_rsqf(wave_sum(x * x) * (1.f / 64.f) + NORM_EPS); const float xn = x * rs * kg[lane];
                const float other = __shfl_xor(xn, 32); const int i = lane & 31; const float inv = exp2f(-(float)i * (13.287712379549449f / 32.f));
                float s, c; sincos_fast((float)l * inv, s, c);
                kv = (lane < 32) ? (xn * c - other * s) : (xn * c + other * s); }
            Ks[jr * 64 + lane] = kv; Vs[jr * 64 + lane] = vv; }
        __syncthreads();
        const int hh = F.wave >> 1, head = kvh * 4 + hh, qi = q0 + (F.wave & 1) * 64 + lane; const size_t row = (size_t)b * SEQ + qi;
        float q[64];
        { const u32x4* qp = (const u32x4*)(P + row * NINP + C_Q + head * 64); float ss = 0.f;
#pragma unroll
          for (int j = 0; j < 8; ++j) { const u32x4 w = qp[j];
#pragma unroll
              for (int e = 0; e < 4; ++e) { q[8 * j + 2 * e] = bflo(w[e]); q[8 * j + 2 * e + 1] = bfhi(w[e]); } }
#pragma unroll
          for (int d = 0; d < 64; ++d) ss += q[d] * q[d];
          const float rs = __builtin_amdgcn_rsqf(ss * (1.f / 64.f) + NORM_EPS);
#pragma unroll
          for (int d = 0; d < 64; ++d) q[d] = q[d] * rs * qg[d];
#pragma unroll
          for (int i = 0; i < 32; ++i) { const float inv = exp2f(-(float)i * (13.287712379549449f / 32.f)); float s, c; sincos_fast((float)qi * inv, s, c);
              const float a = q[i], bq = q[i + 32]; q[i] = (a * c - bq * s) * 0.125f; q[i + 32] = (bq * c + a * s) * 0.125f; } }
        float o[64];
#pragma unroll
        for (int d = 0; d < 64; ++d) o[d] = 0.f;
        float mx = F.in[IN_SINK][layer * 8 + head], l = 1.f;
        const int qa = q0 + (F.wave & 1) * 64;
        int jlo = qa - 127 - (q0 - 128); if (q0 == 0 && jlo < 128) jlo = 128; const int jhi = qa + 63 - (q0 - 128);
        for (int jr = jlo; jr <= jhi; ++jr) { const int j = q0 - 128 + jr; const bool ok = (j <= qi) && (qi - j < 128);
            float s = 0.f;
#pragma unroll
            for (int d = 0; d < 64; d += 4) { const f32x4 kv = *(const LAS f32x4*)(Ks + jr * 64 + d); s += (q[d] * kv.x + q[d + 1] * kv.y) + (q[d + 2] * kv.z + q[d + 3] * kv.w); if ((d & 12) == 12) __builtin_amdgcn_sched_barrier(0); }
            if (ok) { const float mn = fmaxf(mx, s), al = __expf(mx - mn), pe = __expf(s - mn); l = l * al + pe; mx = mn;
#pragma unroll
                for (int d = 0; d < 64; d += 4) { const f32x4 vv = *(const LAS f32x4*)(Vs + jr * 64 + d); o[d] = o[d] * al + pe * vv.x; o[d + 1] = o[d + 1] * al + pe * vv.y; o[d + 2] = o[d + 2] * al + pe * vv.z; o[d + 3] = o[d + 3] * al + pe * vv.w; if ((d & 12) == 12) __builtin_amdgcn_sched_barrier(0); } } }
        const float il = 1.f / l; u32x4* op = (u32x4*)(YC + row * 2048 + 512 + head * 64);
#pragma unroll
        for (int j = 0; j < 8; ++j) { u32x4 w; w.x = pk2(o[8 * j] * il, o[8 * j + 1] * il); w.y = pk2(o[8 * j + 2] * il, o[8 * j + 3] * il); w.z = pk2(o[8 * j + 4] * il, o[8 * j + 5] * il); w.w = pk2(o[8 * j + 6] * il, o[8 * j + 7] * il); op[j] = w; }
    }
}

typedef short bf16x8_t __attribute__((ext_vector_type(8)));
__device__ __forceinline__ void split_hi_lo(const f32x4 a, const f32x4 b, bf16x8& hi, bf16x8& lo) {
    u32x4 h; h.x = cvtpk(a.x, a.y); h.y = cvtpk(a.z, a.w); h.z = cvtpk(b.x, b.y); h.w = cvtpk(b.z, b.w);
    u32x4 l; l.x = cvtpk(a.x - bflo(h.x), a.y - bfhi(h.x)); l.y = cvtpk(a.z - bflo(h.y), a.w - bfhi(h.y)); l.z = cvtpk(b.x - bflo(h.z), b.y - bfhi(h.z)); l.w = cvtpk(b.z - bflo(h.w), b.w - bfhi(h.w));
    hi = __builtin_bit_cast(bf16x8, h); lo = __builtin_bit_cast(bf16x8, l);
}
__device__ __forceinline__ void router_phase(Frame& F, int layer) {
    constexpr int WROW = 2064;
    LAS unsigned char* Whi = F.lds; LAS unsigned char* Wlo = F.lds + 36 * WROW;
    LAS float* part = (LAS float*)F.lds;
    volatile LAS unsigned* lcnt = (volatile LAS unsigned*)(F.lds + 148 * 1024);
    const float* wrg = F.in[IN_WRG] + (size_t)layer * 1024 * 4; const float* wre = F.in[IN_WRE] + (size_t)layer * 1024 * 32; const float* gain = F.in[IN_NORM2] + layer * 1024;
    const float* X = F.out; bf16_t* H2 = (bf16_t*)(F.ws + WS_XN);
    int* EID = (int*)(F.ws + WS_MOE); float* EW = (float*)(F.ws + WS_MOE + 128 * 1024); int* SLOT = (int*)(F.ws + WS_MOE + 256 * 1024); float* RS = (float*)(F.ws + WS_MOE + 640 * 1024);
    __syncthreads();
    for (int k = F.tid; k < 1024; k += NTHR) { const float g = gain[k]; const f32x4 wg = *(const f32x4*)(wrg + k * 4);
        float w[36]; w[0] = wg.x; w[1] = wg.y; w[2] = wg.z; w[3] = wg.w;
#pragma unroll
        for (int q = 0; q < 8; ++q) { const f32x4 v = *(const f32x4*)(wre + k * 32 + 4 * q); w[4 + 4 * q] = v.x; w[5 + 4 * q] = v.y; w[6 + 4 * q] = v.z; w[7 + 4 * q] = v.w; }
#pragma unroll
        for (int e = 0; e < 36; ++e) { const float x = w[e] * g; const unsigned h = f2bf(x); const unsigned l = f2bf(x - bf2f(h));
            *(LAS unsigned short*)(Whi + e * WROW + k * 2) = (unsigned short)h; *(LAS unsigned short*)(Wlo + e * WROW + k * 2) = (unsigned short)l; } }
    if (F.tid < 32) lcnt[F.tid] = 0u;
    __syncthreads();
    const int TPB = T / F.G;
    int lane = F.lane; asm volatile("" : "+v"(lane));
    const int mt = F.wave & 3, kh = F.wave >> 2, row = lane & 15, kg = lane >> 4;
    const int m = F.bid * TPB + 16 * mt + row;
    f32x4 acc[3] = {{0.f, 0.f, 0.f, 0.f}, {0.f, 0.f, 0.f, 0.f}, {0.f, 0.f, 0.f, 0.f}}; float ss = 0.f;
    int er[3]; er[0] = row; er[1] = 16 + row; er[2] = (32 + row < 36) ? 32 + row : 35;
    if (kh == 0)
#pragma unroll 1
    for (int kb = 0; kb < 4; ++kb) {
        f32x4 xa[8][2];
#pragma unroll
        for (int ks = 0; ks < 8; ++ks) { const float* xp = X + (size_t)m * DM + 256 * kb + 32 * ks + 8 * kg; xa[ks][0] = *(const f32x4*)xp; xa[ks][1] = *(const f32x4*)(xp + 4); }
#pragma unroll
        for (int ks = 0; ks < 8; ++ks) { const int k0 = 256 * kb + 32 * ks + 8 * kg;
            const f32x4 a = xa[ks][0], b = xa[ks][1];
            ss += (a.x * a.x + a.y * a.y) + (a.z * a.z + a.w * a.w) + (b.x * b.x + b.y * b.y) + (b.z * b.z + b.w * b.w);
            bf16x8 ah, al; split_hi_lo(a, b, ah, al);
#pragma unroll
            for (int nt = 0; nt < 3; ++nt) { const bf16x8 bh = *(const LAS bf16x8*)(Whi + er[nt] * WROW + k0 * 2), bl = *(const LAS bf16x8*)(Wlo + er[nt] * WROW + k0 * 2);
                acc[nt] = __builtin_amdgcn_mfma_f32_16x16x32_bf16(ah, bh, acc[nt], 0, 0, 0);
                acc[nt] = __builtin_amdgcn_mfma_f32_16x16x32_bf16(ah, bl, acc[nt], 0, 0, 0);
                acc[nt] = __builtin_amdgcn_mfma_f32_16x16x32_bf16(al, bh, acc[nt], 0, 0, 0); } }
    }
    ss += __shfl_xor(ss, 16); ss += __shfl_xor(ss, 32);
    __syncthreads();
    LAS float* ssq = part + 4 * 3 * 64 * 4; LAS float* lg = ssq + 128; volatile LAS int* elist = (volatile LAS int*)(lg + 64 * 40);
    if (kh == 0) {
        const float rstd_row = __builtin_amdgcn_rsqf(ss * (1.f / DM) + NORM_EPS);
        if (kg == 0) { ssq[64 + 16 * mt + row] = rstd_row; RS[m] = rstd_row; }
    }
    __syncthreads();
    if (kh == 0) {
#pragma unroll
        for (int nt = 0; nt < 3; ++nt)
#pragma unroll
            for (int rg = 0; rg < 4; ++rg) { const int e = row + 16 * nt, tk = 16 * mt + 4 * kg + rg; if (e < 36) lg[tk * 40 + e] = acc[nt][rg] * ssq[64 + tk]; }
    }
    __syncthreads();
    if (F.tid < TPB) { const int tk = F.tid, mm = F.bid * TPB + tk; const LAS float* L = lg + tk * 40;
        float gl[4];
#pragma unroll
        for (int k = 0; k < 4; ++k) gl[k] = L[k] + F.in[IN_BRG][layer * 4 + k];
        int gs = 0; float gbest = gl[0];
#pragma unroll
        for (int k = 1; k < 4; ++k) if (gl[k] > gbest) { gbest = gl[k]; gs = k; }
        float den = 0.f;
#pragma unroll
        for (int k = 0; k < 4; ++k) den += __expf(gl[k] - gbest);
        const float pgrp = 1.f / den;
        float el[8];
#pragma unroll
        for (int k = 0; k < 8; ++k) el[k] = L[4 + gs * 8 + k] + F.in[IN_BRE_][layer * 32 + gs * 8 + k];
        int i0 = 0; float v0 = el[0];
#pragma unroll
        for (int k = 1; k < 8; ++k) if (el[k] > v0) { v0 = el[k]; i0 = k; }
        int i1 = -1; float v1 = -3.0e38f;
#pragma unroll
        for (int k = 0; k < 8; ++k) if (k != i0 && el[k] > v1) { v1 = el[k]; i1 = k; }
        const float e1 = __expf(v1 - v0), w0 = pgrp / (1.f + e1), w1 = pgrp * e1 / (1.f + e1);
        const int ea = gs * 8 + i0, eb = gs * 8 + i1;
        EID[2 * mm] = ea; EID[2 * mm + 1] = eb; EW[2 * mm] = w0; EW[2 * mm + 1] = w1;
        elist[2 * tk] = ea; elist[2 * tk + 1] = eb;
    }
    __syncthreads();
    if (F.tid < 32) { const int e = F.tid; int c = 0;
        for (int i = 0; i < 2 * TPB; ++i) { if (elist[i] == e) { SLOT[2 * (F.bid * TPB) + i] = c; ++c; } }
        ((unsigned*)(F.ws + WS_MOE + 512 * 1024))[(size_t)F.bid * 32 + e] = (unsigned)c; }
    __syncthreads();
}
__device__ __forceinline__ int moe_tables(Frame& F, int layer, volatile LAS int* offs, volatile LAS int* tile_e) {
    volatile LAS int* psum = offs + 256;
    const unsigned* CNTB = (const unsigned*)(F.ws + WS_MOE + 512 * 1024);
    __syncthreads();
    { const int e = F.tid & 31, part = F.tid >> 5; int tot = 0, pre = 0; const int per = (F.G + 15) / 16;
      for (int bb = part * per; bb < (part + 1) * per && bb < F.G; ++bb) { const int c = (int)CNTB[(size_t)bb * 32 + e]; tot += c; pre += (bb < F.bid) ? c : 0; }
      psum[part * 32 + e] = tot; psum[512 + part * 32 + e] = pre; }
    __syncthreads();
    if (F.tid < 64) {
        int c = 0, pre = 0;
        if (F.tid < 32) for (int part = 0; part < 16; ++part) { c += psum[part * 32 + F.tid]; pre += psum[512 + part * 32 + F.tid]; }
        const int tl = (c + 255) >> 8; int incl = tl;
#pragma unroll
        for (int o = 1; o < 32; o <<= 1) { const int v = __shfl_up(incl, o); if (F.tid >= o) incl += v; }
        const int excl = incl - tl;
        if (F.tid < 32) { offs[F.tid] = excl * 256 + pre; for (int k = 0; k < tl; ++k) tile_e[excl + k] = F.tid; }
        if (F.tid == 31) offs[32] = incl;
    }
    __syncthreads();
    return __builtin_amdgcn_readfirstlane(offs[32]);
}
__device__ __forceinline__ void gather_phase(Frame& F, int layer, volatile LAS int* offs) {
    const float* X = F.out; const float* gain = F.in[IN_NORM2] + layer * 1024; const float* RS = (const float*)(F.ws + WS_MOE + 640 * 1024); bf16_t* XG = (bf16_t*)(F.ws + WS_XG);
    const int* EID = (const int*)(F.ws + WS_MOE); const int* SLOT = (const int*)(F.ws + WS_MOE + 256 * 1024); int* POS = (int*)(F.ws + WS_MOE + 384 * 1024);
    const int TPB = T / F.G;
    for (int m = F.bid * TPB + F.wave; m < (F.bid + 1) * TPB; m += NWAVES) {
        const f32x4* xr = (const f32x4*)(X + (size_t)m * DM) + F.lane; const f32x4* gr = (const f32x4*)gain + F.lane; const float rs = RS[m];
        u32x2 o[4];
#pragma unroll
        for (int j = 0; j < 4; ++j) { const f32x4 v = xr[64 * j], g = gr[64 * j]; o[j].x = pk2(v.x * rs * g.x, v.y * rs * g.y); o[j].y = pk2(v.z * rs * g.z, v.w * rs * g.w); }
#pragma unroll
        for (int k = 0; k < 2; ++k) { const int pos = offs[EID[2 * m + k]] + SLOT[2 * m + k]; u32x2* dst = (u32x2*)(XG + (size_t)pos * DM) + F.lane;
#pragma unroll
            for (int j = 0; j < 4; ++j) dst[64 * j] = o[j];
            if (F.lane == 0) POS[2 * m + k] = pos; }
    }
}
__device__ __forceinline__ void combine_phase(Frame& F, const float* gain_next, bool dry = false) {
    const bf16_t* Y = (const bf16_t*)(F.ws + WS_YEXP); const float* EW = (const float*)(F.ws + WS_MOE + 128 * 1024); const int* POS = (const int*)(F.ws + WS_MOE + 384 * 1024);
    bf16_t* XN = (bf16_t*)(F.ws + WS_XN);
    const int gw = F.bid * NWAVES + F.wave, NGW = F.G * NWAVES;
    for (int m = gw; m < T; m += NGW) {
        const float w0 = EW[2 * m], w1 = EW[2 * m + 1]; const int p0 = POS[2 * m], p1 = POS[2 * m + 1];
        f32x4* xr = (f32x4*)(F.out + (size_t)m * DM) + F.lane;
        const u32x2* y0 = (const u32x2*)(Y + (size_t)p0 * DM) + F.lane; const u32x2* y1 = (const u32x2*)(Y + (size_t)p1 * DM) + F.lane;
        f32x4 v[4]; float s = 0.f;
#pragma unroll
        for (int j = 0; j < 4; ++j) { v[j] = xr[64 * j]; const u32x2 a = y0[64 * j], b = y1[64 * j];
            v[j].x += w0 * bflo(a.x) + w1 * bflo(b.x); v[j].y += w0 * bfhi(a.x) + w1 * bfhi(b.x); v[j].z += w0 * bflo(a.y) + w1 * bflo(b.y); v[j].w += w0 * bfhi(a.y) + w1 * bfhi(b.y);
            if (!dry) xr[64 * j] = v[j]; s += (v[j].x * v[j].x + v[j].y * v[j].y) + (v[j].z * v[j].z + v[j].w * v[j].w); }
        if (gain_next) { const float rstd = __builtin_amdgcn_rsqf(wave_sum(s) * (1.f / DM) + NORM_EPS); const f32x4* gr = (const f32x4*)gain_next + F.lane;
            unsigned long long* o8 = (unsigned long long*)(XN + (size_t)m * DM) + F.lane;
#pragma unroll
            for (int j = 0; j < 4; ++j) { const f32x4 gv = gr[64 * j]; o8[64 * j] = (unsigned long long)pk2(v[j].x * rstd * gv.x, v[j].y * rstd * gv.y) | ((unsigned long long)pk2(v[j].z * rstd * gv.z, v[j].w * rstd * gv.w) << 32); } }
    }
}

__device__ __forceinline__ int crow32(int reg, int hh) { return (reg & 3) + 8 * (reg >> 2) + 4 * hh; }
__device__ __forceinline__ float wave_incl_scan(float v, int lane) {
#pragma unroll
    for (int o = 1; o < 64; o <<= 1) { const float t = __shfl_up(v, o); if (lane >= o) v += t; }
    return v;
}
__device__ __forceinline__ void conv_frag(const LAS unsigned char* raw, int chan, int ks, int hh, float w0, float w1, float w2, float w3, float bias, float (&out)[8]) {
#pragma unroll
    for (int run = 0; run < 2; ++run) { const int lb = 16 * ks + 8 * run + 4 * hh; float x[7];
#pragma unroll
        for (int i = 0; i < 7; ++i) x[i] = bf2f(*(const LAS unsigned short*)(raw + (lb + i) * 128 + chan * 2));
#pragma unroll
        for (int j = 0; j < 4; ++j) out[4 * run + j] = siluf_(bias + w0 * x[j] + w1 * x[j + 1] + w2 * x[j + 2] + w3 * x[j + 3]); }
}
constexpr int RAWT = 131 * 128;
__device__ __forceinline__ void stage_raw(const bf16_t* P, size_t row0, int l0, int col, LAS unsigned char* dst, int idx0, int stride) {
    for (int idx = idx0; idx < 131 * 8; idx += stride) { const int r = idx >> 3, c8 = idx & 7; u32x4 v = (u32x4){0u, 0u, 0u, 0u};
        if (l0 - 3 + r >= 0) v = *(const u32x4*)(P + (row0 + r - 3) * NINP + col + c8 * 8);
        *(LAS u32x4*)(dst + r * 128 + c8 * 16) = v; }
}
__device__ __forceinline__ bf16_t* xf_base(unsigned char* ws, int b, int ch, int h) { return (bf16_t*)(ws + ((b < 2) ? WS_XN : WS_SST) + 16 * MiB) + ((size_t)(((b & 1) * SSD_NCH + ch) * 16 + h)) * 8192; }
__device__ __forceinline__ void ssdA_mfma(Frame& F, int layer) {
    const bf16_t* P = (const bf16_t*)(F.ws + WS_P); const float* DT = (const float*)(F.ws + WS_DT); bf16_t* SST = (bf16_t*)(F.ws + WS_SST); float* ASUM = (float*)(F.ws + WS_ASUM);
    const float* cw = F.in[IN_CONVW] + layer * 4 * 1280; const float* cb = F.in[IN_CONVB] + layer * 1280;
    LAS unsigned char* rawX = F.lds + F.wave * RAWT; LAS unsigned char* rawB = F.lds + 8 * RAWT; LAS float* ftab = (LAS float*)(F.lds + 9 * RAWT) + F.wave * 128;
    for (int u = F.bid; u < BATCH * SSD_NCH * 2; u += F.G) {
        const int grp = u & 1, ch = (u >> 1) & 31, b = u >> 6, h = grp * 8 + F.wave, l0 = ch * 128; const size_t row0 = (size_t)b * SEQ + l0;
        int lane = F.lane; asm volatile("" : "+v"(lane));
        const int r = lane & 31, hh = lane >> 5;
        __syncthreads();
        stage_raw(P, row0, l0, C_XS + h * 64, rawX, lane, 64);
        stage_raw(P, row0, l0, C_B + grp * 64, rawB, F.tid, NTHR);
        { const float dtb = F.in[IN_DTB][layer * 16 + h], A = -__expf(F.in[IN_ALOG][layer * 16 + h]);
          const float dt0 = softplusf_(DT[(row0 + lane) * 16 + h] + dtb), dt1 = softplusf_(DT[(row0 + 64 + lane) * 16 + h] + dtb);
          const float s0 = wave_incl_scan(dt0 * A, lane); const float tot0 = __builtin_bit_cast(float, __builtin_amdgcn_readlane(__builtin_bit_cast(int, s0), 63));
          const float s1 = wave_incl_scan(dt1 * A, lane) + tot0; const float tot = __builtin_bit_cast(float, __builtin_amdgcn_readlane(__builtin_bit_cast(int, s1), 63));
          ftab[lane] = dt0 * __expf(tot - s0); ftab[64 + lane] = dt1 * __expf(tot - s1);
          if (lane == 0) ASUM[((size_t)b * SSD_NCH + ch) * 16 + h] = tot; }
        __syncthreads();
        bf16x8 bfr[2];
#pragma unroll
        for (int q = 0; q < 2; ++q) { const int idx = F.wave * 2 + q, nt = idx >> 3, ks = idx & 7, cc = 1024 + grp * 64 + 32 * nt + r; float v[8];
            conv_frag(rawB, 32 * nt + r, ks, hh, cw[cc], cw[1280 + cc], cw[2560 + cc], cw[3840 + cc], cb[cc], v); bfr[q] = pack8v(v); }
        bf16x8 xw[2][8];
        bf16_t* xf = xf_base(F.ws, b, ch, h);
#pragma unroll
        for (int pt = 0; pt < 2; ++pt) { const int cx = h * 64 + 32 * pt + r; const float w0 = cw[cx], w1 = cw[1280 + cx], w2 = cw[2560 + cx], w3 = cw[3840 + cx], bias = cb[cx];
#pragma unroll
            for (int ks = 0; ks < 8; ++ks) { float v[8]; conv_frag(rawX, 32 * pt + r, ks, hh, w0, w1, w2, w3, bias, v);
                *(bf16x8*)(xf + ((pt * 8 + ks) * 64 + lane) * 8) = pack8v(v);
                const f32x4 fa = *(const LAS f32x4*)(ftab + 16 * ks + 4 * hh), fb = *(const LAS f32x4*)(ftab + 16 * ks + 8 + 4 * hh);
                v[0] *= fa.x; v[1] *= fa.y; v[2] *= fa.z; v[3] *= fa.w; v[4] *= fb.x; v[5] *= fb.y; v[6] *= fb.z; v[7] *= fb.w; { u32x4 pq = __builtin_bit_cast(u32x4, pack8v(v)); asm volatile("" : "+v"(pq) :: "memory"); xw[pt][ks] = __builtin_bit_cast(bf16x8, pq); } } }
        __syncthreads();
#pragma unroll
        for (int q = 0; q < 2; ++q) *(LAS bf16x8*)(rawB + (F.wave * 2 + q) * 1024 + lane * 16) = bfr[q];
        __syncthreads();
        f32x16 acc[2][2];
#pragma unroll
        for (int pt = 0; pt < 2; ++pt)
#pragma unroll
            for (int nt = 0; nt < 2; ++nt)
#pragma unroll
                for (int i = 0; i < 16; ++i) acc[pt][nt][i] = 0.f;
#pragma unroll
        for (int ks = 0; ks < 8; ++ks)
#pragma unroll
            for (int nt = 0; nt < 2; ++nt) { const bf16x8 bq = *(const LAS bf16x8*)(rawB + (nt * 8 + ks) * 1024 + lane * 16);
#pragma unroll
                for (int pt = 0; pt < 2; ++pt) acc[pt][nt] = MFMA32(xw[pt][ks], bq, acc[pt][nt]); }
        bf16_t* sp = SST + (((size_t)b * SSD_NCH + ch) * 16 + h) * 4096;
#pragma unroll
        for (int pt = 0; pt < 2; ++pt)
#pragma unroll
            for (int nt = 0; nt < 2; ++nt)
#pragma unroll
                for (int i = 0; i < 16; ++i) sp[(32 * pt + crow32(i, hh)) * 64 + 32 * nt + r] = (bf16_t)f2bf(acc[pt][nt][i]);
    }
}
__device__ __forceinline__ void ssdC_mfma(Frame& F, int layer) {
    const bf16_t* P = (const bf16_t*)(F.ws + WS_P); const float* DT = (const float*)(F.ws + WS_DT); const bf16_t* SST = (const bf16_t*)(F.ws + WS_SST); bf16_t* YC = (bf16_t*)(F.ws + WS_YCAT);
    const float* cw = F.in[IN_CONVW] + layer * 4 * 1280; const float* cb = F.in[IN_CONVB] + layer * 1280;
    LAS unsigned char* rawX = F.lds + F.wave * RAWT;
    LAS unsigned char* Bn = F.lds; LAS unsigned char* Cn = F.lds + 18432;
    LAS float* atab = (LAS float*)(F.lds + 36864) + F.wave * 128; LAS float* dtab = (LAS float*)(F.lds + 40960) + F.wave * 128;
    LAS float* ssqp = (LAS float*)(F.lds + 45056); LAS float* gtab = (LAS float*)(F.lds + 49152) + F.wave * 64;
    LAS unsigned char* zt = F.lds + 51200 + F.wave * 4608;
    for (int u = F.bid; u < BATCH * SSD_NCH * 2; u += F.G) {
        const int grp = u & 1, ch = (u >> 1) & 31, b = u >> 6, h = grp * 8 + F.wave, l0 = ch * 128; const size_t row0 = (size_t)b * SEQ + l0;
        int lane = F.lane; asm volatile("" : "+v"(lane));
        const int r = lane & 31, hh = lane >> 5;
        bf16x8 xsf[2][8];
        { const bf16_t* xf = xf_base(F.ws, b, ch, h);
#pragma unroll
          for (int pt = 0; pt < 2; ++pt)
#pragma unroll
              for (int ks = 0; ks < 8; ++ks) xsf[pt][ks] = *(const bf16x8*)(xf + ((pt * 8 + ks) * 64 + lane) * 8); }
        __syncthreads();
        for (int it = F.tid; it < 128 * 16; it += NTHR) { const int l = it >> 4, c8 = it & 15, isC = c8 >> 3, col = (isC ? C_C : C_B) + grp * 64 + (c8 & 7) * 8, cc = 1024 + isC * 128 + grp * 64 + (c8 & 7) * 8;
            float a[8];
#pragma unroll
            for (int e = 0; e < 8; ++e) a[e] = cb[cc + e];
#pragma unroll
            for (int j = 0; j < 4; ++j) { if (l0 + l - 3 + j >= 0) { const u32x4 xv = *(const u32x4*)(P + (row0 + l - 3 + j) * NINP + col);
#pragma unroll
                for (int e = 0; e < 4; ++e) { a[2 * e] += cw[j * 1280 + cc + 2 * e] * bflo(xv[e]); a[2 * e + 1] += cw[j * 1280 + cc + 2 * e + 1] * bfhi(xv[e]); } } }
            u32x4 o; o.x = cvtpk(siluf_(a[0]), siluf_(a[1])); o.y = cvtpk(siluf_(a[2]), siluf_(a[3])); o.z = cvtpk(siluf_(a[4]), siluf_(a[5])); o.w = cvtpk(siluf_(a[6]), siluf_(a[7]));
            *(LAS u32x4*)((isC ? Cn : Bn) + l * 144 + (c8 & 7) * 16) = o; }
        { const float dtb = F.in[IN_DTB][layer * 16 + h], A = -__expf(F.in[IN_ALOG][layer * 16 + h]);
          const float dt0 = softplusf_(DT[(row0 + lane) * 16 + h] + dtb), dt1 = softplusf_(DT[(row0 + 64 + lane) * 16 + h] + dtb);
          const float s0 = wave_incl_scan(dt0 * A, lane); const float tot0 = __builtin_bit_cast(float, __builtin_amdgcn_readlane(__builtin_bit_cast(int, s0), 63));
          const float s1 = wave_incl_scan(dt1 * A, lane) + tot0;
          atab[lane] = s0; atab[64 + lane] = s1; dtab[lane] = dt0; dtab[64 + lane] = dt1; gtab[lane] = F.in[IN_SSDG][layer * 1024 + h * 64 + lane]; }
        const bf16_t* sp = SST + (((size_t)b * SSD_NCH + ch) * 16 + h) * 4096;
        const float dsk = F.in[IN_SSDD][layer * 16 + h];
        __syncthreads();
#pragma unroll 1
        for (int li = 0; li < 4; ++li) {
            const size_t rowt = row0 + 32 * li;
            u32x4 zreg[4];
#pragma unroll
            for (int q = 0; q < 4; ++q) { const int idx = lane + 64 * q, rr = idx >> 3, c8 = idx & 7; zreg[q] = *(const u32x4*)(P + (rowt + rr) * NINP + C_Z + h * 64 + c8 * 8); }
            bf16x8 Cf[4];
#pragma unroll
            for (int ks = 0; ks < 4; ++ks) Cf[ks] = *(const LAS bf16x8*)(Cn + (32 * li + r) * 144 + (16 * ks + 8 * hh) * 2);
            f32x16 acc[2];
#pragma unroll
            for (int pt = 0; pt < 2; ++pt)
#pragma unroll
                for (int i = 0; i < 16; ++i) acc[pt][i] = 0.f;
#pragma unroll
            for (int ks = 0; ks < 4; ++ks)
#pragma unroll
                for (int pt = 0; pt < 2; ++pt) acc[pt] = MFMA32(*(const bf16x8*)(sp + (32 * pt + r) * 64 + 16 * ks + 8 * hh), Cf[ks], acc[pt]);
            const float al = atab[32 * li + r], el = __expf(al); const int lrel = 32 * li + r;
#pragma unroll
            for (int pt = 0; pt < 2; ++pt)
#pragma unroll
                for (int i = 0; i < 16; ++i) acc[pt][i] *= el;
#pragma unroll
            for (int si = 0; si < 4; ++si) if (si <= li) {
                f32x16 X;
#pragma unroll
                for (int i = 0; i < 16; ++i) X[i] = 0.f;
#pragma unroll
                for (int ks = 0; ks < 4; ++ks) { const bf16x8 Bq = *(const LAS bf16x8*)(Bn + (32 * si + r) * 144 + (16 * ks + 8 * hh) * 2); X = MFMA32(Bq, Cf[ks], X); }
#pragma unroll
                for (int g4 = 0; g4 < 4; ++g4) { const int sb = 32 * si + 8 * g4 + 4 * hh; const f32x4 av = *(const LAS f32x4*)(atab + sb), dv = *(const LAS f32x4*)(dtab + sb);
#pragma unroll
                    for (int j = 0; j < 4; ++j) { const int s = sb + j; float arg = al - av[j]; if (si == li && s > lrel) arg = -100.f;
                        float x = X[4 * g4 + j] * (__expf(arg) * dv[j]); if (si == li && s > lrel) x = 0.f; if (si == li && s == lrel) x += dsk; X[4 * g4 + j] = x; } }
#pragma unroll
                for (int kq = 0; kq < 2; ++kq) { const float v[8] = {X[8 * kq], X[8 * kq + 1], X[8 * kq + 2], X[8 * kq + 3], X[8 * kq + 4], X[8 * kq + 5], X[8 * kq + 6], X[8 * kq + 7]}; const bf16x8 Xf = pack8v(v);
#pragma unroll
                    for (int pt = 0; pt < 2; ++pt) { bf16x8 a;
#pragma unroll
                        for (int q = 0; q < 4; ++q) a = (si == q) ? xsf[pt][2 * q + kq] : a;
                        acc[pt] = MFMA32(a, Xf, acc[pt]); } }
            }
#pragma unroll
            for (int q = 0; q < 4; ++q) { const int idx = lane + 64 * q, rr = idx >> 3, c8 = idx & 7; *(LAS u32x4*)(zt + rr * 144 + c8 * 16) = zreg[q]; }
            float qs = 0.f;
#pragma unroll
            for (int pt = 0; pt < 2; ++pt)
#pragma unroll
                for (int g4 = 0; g4 < 4; ++g4) { const u32x2 zz = *(const LAS u32x2*)(zt + r * 144 + (32 * pt + 8 * g4 + 4 * hh) * 2);
                    const float z0 = bflo(zz.x), z1 = bfhi(zz.x), z2 = bflo(zz.y), z3 = bfhi(zz.y);
                    float y0 = acc[pt][4 * g4] * siluf_(z0), y1 = acc[pt][4 * g4 + 1] * siluf_(z1), y2 = acc[pt][4 * g4 + 2] * siluf_(z2), y3 = acc[pt][4 * g4 + 3] * siluf_(z3);
                    acc[pt][4 * g4] = y0; acc[pt][4 * g4 + 1] = y1; acc[pt][4 * g4 + 2] = y2; acc[pt][4 * g4 + 3] = y3; qs += (y0 * y0 + y1 * y1) + (y2 * y2 + y3 * y3); }
            qs += __shfl_xor(qs, 32);
            if (hh == 0) ssqp[(32 * li + r) * 8 + F.wave] = qs;
            __syncthreads();
            { const f32x4 qa = *(const LAS f32x4*)(ssqp + (32 * li + r) * 8), qb = *(const LAS f32x4*)(ssqp + (32 * li + r) * 8 + 4);
              const float rs = __builtin_amdgcn_rsqf(((qa.x + qa.y) + (qa.z + qa.w) + (qb.x + qb.y) + (qb.z + qb.w)) * (1.f / 512.f) + NORM_EPS);
#pragma unroll
              for (int pt = 0; pt < 2; ++pt)
#pragma unroll
                  for (int g4 = 0; g4 < 4; ++g4) { const int p0 = 32 * pt + 8 * g4 + 4 * hh; const f32x4 gv = *(const LAS f32x4*)(gtab + p0);
                      u32x2 o; o.x = cvtpk(acc[pt][4 * g4] * rs * gv.x, acc[pt][4 * g4 + 1] * rs * gv.y); o.y = cvtpk(acc[pt][4 * g4 + 2] * rs * gv.z, acc[pt][4 * g4 + 3] * rs * gv.w);
                      *(LAS u32x2*)(zt + r * 144 + p0 * 2) = o; } }
#pragma unroll
            for (int q = 0; q < 4; ++q) { const int idx = lane + 64 * q, rr = idx >> 3, c8 = idx & 7; *(u32x4*)(YC + (rowt + rr) * 2048 + 1024 + h * 64 + c8 * 8) = *(const LAS u32x4*)(zt + rr * 144 + c8 * 16); }
        }
    }
}

__device__ __forceinline__ void attn_mfma(Frame& F, int layer) {
    LAS unsigned char* Kn = F.lds; LAS unsigned char* VT = F.lds + 36864;
    const bf16_t* P = (const bf16_t*)(F.ws + WS_P); bf16_t* YC = (bf16_t*)(F.ws + WS_YCAT);
    const float* qg = F.in[IN_QG] + layer * 64; const float* kg = F.in[IN_KG] + layer * 64;
    for (int u = F.bid; u < BATCH * 32 * 2; u += F.G) {
        const int kvh = u & 1, qb = (u >> 1) & 31, b = u >> 6, q0 = qb * 128;
        int lane = F.lane; asm volatile("" : "+v"(lane));
        const int r = lane & 31, hh = lane >> 5;
        __syncthreads();
        for (int jr = F.wave; jr < 256; jr += NWAVES) { const int l = q0 - 128 + jr; float kv = 0.f;
            if (l >= 0) { const size_t row = (size_t)b * SEQ + l; const float x = bf2f(P[row * NINP + C_K + kvh * 64 + lane]);
                const float rs = __builtin_amdgcn_rsqf(wave_sum(x * x) * (1.f / 64.f) + NORM_EPS); const float xn = x * rs * kg[lane];
                const float other = __shfl_xor(xn, 32); const int i = lane & 31; const float inv = exp2f(-(float)i * (13.287712379549449f / 32.f));
                float s, c; sincos_fast((float)l * inv, s, c);
                kv = (lane < 32) ? (xn * c - other * s) : (xn * c + other * s); }
            *(LAS unsigned short*)(Kn + jr * 144 + lane * 2) = (unsigned short)f2bf(kv); }
#pragma unroll
        for (int q = 0; q < 4; ++q) { const int it = F.tid + NTHR * q, d = it & 63, ko = it >> 6; unsigned short v[8];
#pragma unroll
            for (int e = 0; e < 8; ++e) { const int l = q0 - 128 + 8 * ko + e; v[e] = (l >= 0) ? P[((size_t)b * SEQ + l) * NINP + C_V + kvh * 64 + d] : (unsigned short)0; }
            u32x4 o; o.x = v[0] | ((unsigned)v[1] << 16); o.y = v[2] | ((unsigned)v[3] << 16); o.z = v[4] | ((unsigned)v[5] << 16); o.w = v[6] | ((unsigned)v[7] << 16);
            *(LAS u32x4*)(VT + d * 528 + ko * 16) = o; }
        __syncthreads();
        const int hd = F.wave >> 1, head = kvh * 4 + hd, qhalf = F.wave & 1; const float sink = F.in[IN_SINK][layer * 8 + head];
#pragma unroll 1
        for (int jt = 0; jt < 2; ++jt) {
            const int qt = q0 + 64 * qhalf + 32 * jt, qi = qt + r, t0 = 2 * qhalf + jt; const size_t row = (size_t)b * SEQ + qi;
            bf16x8 Qf[4];
            { float qv[4][8]; float ss = 0.f;
#pragma unroll
              for (int ks = 0; ks < 4; ++ks) { const u32x4 w = *(const u32x4*)(P + row * NINP + C_Q + head * 64 + 16 * ks + 8 * hh);
#pragma unroll
                  for (int e = 0; e < 4; ++e) { qv[ks][2 * e] = bflo(w[e]); qv[ks][2 * e + 1] = bfhi(w[e]); ss += qv[ks][2 * e] * qv[ks][2 * e] + qv[ks][2 * e + 1] * qv[ks][2 * e + 1]; } }
              ss += __shfl_xor(ss, 32);
              const float rs = __builtin_amdgcn_rsqf(ss * (1.f / 64.f) + NORM_EPS);
#pragma unroll
              for (int ks = 0; ks < 4; ++ks)
#pragma unroll
                  for (int e = 0; e < 8; ++e) qv[ks][e] *= rs * qg[16 * ks + 8 * hh + e];
#pragma unroll
              for (int ks = 0; ks < 2; ++ks)
#pragma unroll
                  for (int e = 0; e < 8; ++e) { const int i = 16 * ks + 8 * hh + e; const float inv = exp2f(-(float)i * (13.287712379549449f / 32.f)); float s, c; sincos_fast((float)qi * inv, s, c);
                      const float a = qv[ks][e], bq = qv[ks + 2][e]; qv[ks][e] = (a * c - bq * s) * 0.125f; qv[ks + 2][e] = (bq * c + a * s) * 0.125f; }
#pragma unroll
              for (int ks = 0; ks < 4; ++ks) Qf[ks] = pack8v(qv[ks]); }
            f32x16 acc[2];
#pragma unroll
            for (int dt = 0; dt < 2; ++dt)
#pragma unroll
                for (int i = 0; i < 16; ++i) acc[dt][i] = 0.f;
            float m = sink, lsum = 1.f;
#pragma unroll
            for (int tt = 0; tt < 5; ++tt) { const int t = t0 + tt;
                if (q0 == 0 && t < 4) continue;
                f32x16 X;
#pragma unroll
                for (int i = 0; i < 16; ++i) X[i] = 0.f;
#pragma unroll
                for (int ks = 0; ks < 4; ++ks) { const bf16x8 Kq = *(const LAS bf16x8*)(Kn + (32 * t + r) * 144 + (16 * ks + 8 * hh) * 2); X = MFMA32(Kq, Qf[ks], X); }
                if (tt == 0) {
#pragma unroll
                    for (int i = 0; i < 16; ++i) if (!(r < crow32(i, hh))) X[i] = -INFINITY; }
                if (tt == 4) {
#pragma unroll
                    for (int i = 0; i < 16; ++i) if (!(crow32(i, hh) <= r)) X[i] = -INFINITY; }
                float mx = X[0];
#pragma unroll
                for (int i = 1; i < 16; ++i) mx = fmaxf(mx, X[i]);
                mx = fmaxf(mx, __shfl_xor(mx, 32));
                const float mn = fmaxf(m, mx), al = __expf(m - mn); m = mn;
                float ps = 0.f;
#pragma unroll
                for (int i = 0; i < 16; ++i) { X[i] = __expf(X[i] - mn); ps += X[i]; }
                ps += __shfl_xor(ps, 32);
                lsum = lsum * al + ps;
#pragma unroll
                for (int dt = 0; dt < 2; ++dt)
#pragma unroll
                    for (int i = 0; i < 16; ++i) acc[dt][i] *= al;
#pragma unroll
                for (int kq = 0; kq < 2; ++kq) { const float v[8] = {X[8 * kq], X[8 * kq + 1], X[8 * kq + 2], X[8 * kq + 3], X[8 * kq + 4], X[8 * kq + 5], X[8 * kq + 6], X[8 * kq + 7]}; const bf16x8 Pf = pack8v(v);
#pragma unroll
                    for (int dt = 0; dt < 2; ++dt) { const LAS unsigned char* vp = VT + (32 * dt + r) * 528 + (32 * t + 16 * kq + 4 * hh) * 2;
                        const u32x2 va = *(const LAS u32x2*)vp, vb = *(const LAS u32x2*)(vp + 16); const u32x4 vv = {va.x, va.y, vb.x, vb.y};
                        acc[dt] = MFMA32(__builtin_bit_cast(bf16x8, vv), Pf, acc[dt]); } }
            }
            const float il = 1.f / lsum;
#pragma unroll
            for (int dt = 0; dt < 2; ++dt)
#pragma unroll
                for (int g4 = 0; g4 < 4; ++g4) { u32x2 o; o.x = cvtpk(acc[dt][4 * g4] * il, acc[dt][4 * g4 + 1] * il); o.y = cvtpk(acc[dt][4 * g4 + 2] * il, acc[dt][4 * g4 + 3] * il);
                    *(u32x2*)(YC + row * 2048 + 512 + head * 64 + 32 * dt + 8 * g4 + 4 * hh) = o; }
        }
    }
}

#ifndef MK_PER_PHASE
#define MK_PER_PHASE 0
#endif
constexpr int NPH = 13;
constexpr int TAB_OFF = 150 * 1024;
struct Args { const float* in[N_INPUTS]; float* out; unsigned char* ws; int gp_lo, gp_hi; };
static_assert(sizeof(Args) == (N_INPUTS + 2) * 8 + 8, "no padding in Args");

#ifndef PROBE_ID
#define PROBE_ID 0
#endif
#ifndef PROBE_N
#define PROBE_N 1
#endif
#define REP(id) for (int _r = 0; _r < ((id) == PROBE_ID ? 1 + PROBE_N : 1); ++_r)
extern __shared__ __attribute__((aligned(16))) unsigned char lds_raw[];
__device__ __forceinline__ LAS unsigned char* lds_raw_base() { return (LAS unsigned char*)lds_raw; }
#define LAUNDER() do { asm volatile("" : "+s"(F.in), "+s"(F.ws), "+s"(F.out), "+s"(F.ctl), "+s"(F.bid), "+s"(F.G)); asm volatile("" : "+v"(F.tid)); F.lane = F.tid & 63; F.wave = __builtin_amdgcn_readfirstlane(F.tid >> 6); } while (0)
template <int layer>
__device__ __forceinline__ void layer_body(Frame& F, const int lo, const int hi, const bool rerun) {
    volatile LAS int* offs = (volatile LAS int*)(F.lds + TAB_OFF); volatile LAS int* tile_e = offs + 64;
    XcdBarrier bar; bar.bar = F.ctl + CW_BAR; bar.x = xb_xcc_id(); bar.st = F.MISC;
#define GP(k) (layer * NPH + (k))
#ifdef ONLY_PH
#define IN(k) (((k) == ONLY_PH) && lo <= GP(k) && GP(k) < hi)
#else
#define IN(k) (lo <= GP(k) && GP(k) < hi)
#endif
#define WSB ((const char*)F.ws)
#ifdef DIAG_GP
#define STAMP0(k) do { if (GP(k) == DIAG_GP) { const unsigned t_ = (unsigned)__builtin_amdgcn_s_memrealtime(); if (threadIdx.x == 0) *(volatile LAS unsigned*)((LAS unsigned char*)lds_raw_base() + MISC_OFF + 32) = t_; } } while (0)
#define STAMP1(k) do { if (GP(k) == DIAG_GP) { const unsigned t_ = (unsigned)__builtin_amdgcn_s_memrealtime(); if (threadIdx.x == 0) *(volatile LAS unsigned*)((LAS unsigned char*)lds_raw_base() + MISC_OFF + 40) = t_; } } while (0)
#else
#define STAMP0(k)
#define STAMP1(k)
#endif
#define SEAM(k) do { if (!MK_PER_PHASE && IN(k) && GP(k) + 1 < hi) { xcd_barrier(bar); if (PROBE_ID == 19) { xcd_barrier(bar); xcd_barrier(bar); } } STAMP1(k); } while (0)
        if (IN(0) && layer == 0) { LAUNDER(); STAMP0(0);
            REP(1) { convert_weights(F, 0); __syncthreads(); } REP(2) s5_build(F, 0);
            REP(3) rmsnorm_rows(F, F.in[IN_X], F.in[IN_NORM1], (bf16_t*)(F.ws + WS_XN));
            SEAM(0);
        }
        if (IN(1)) { LAUNDER(); STAMP0(1);
            SchedDense<2048u, 2048u, T / 256, NINP / 256, 16> S{WSB + WS_XN, WSB + WS_WIN, F.G, F.bid};
            EpiProj E{F.ws, F.in[IN_BGATE] + layer * 3072};
            REP(4) pg8::gemm_phase<2048u, 2048u>(F.tid, F.lds, S, E);
            SEAM(1);
        }
        if (IN(2)) { LAUNDER(); STAMP0(2);
            SchedS5P1 S{WSB + WS_UH, WSB + WS_EG, F.G, F.bid};
            EpiHloc E{(float*)(F.ws + WS_HLOC)};
            REP(5) pg8::gemm_phase<(unsigned)(S5_K * 2), 1024u>(F.tid, F.lds, S, E);
            REP(6) ssdA_mfma(F, layer);
            REP(8) attn_mfma(F, layer);
            SEAM(2);
        }
        if (IN(3)) { LAUNDER(); STAMP0(3);
            REP(7) s5_scan(F, layer);
            if (!rerun) ssd_scan(F);
            SEAM(3);
        }
        if (IN(4)) { LAUNDER(); STAMP0(4);
            SchedS5Main S{WSB + WS_UH, WSB + WS_MG, F.G, F.bid};
            EpiS5Y E{(bf16_t*)(F.ws + WS_XN)};
            REP(9) pg8::gemm_phase<(unsigned)(S5_K * 2), (unsigned)(S5_K * 2)>(F.tid, F.lds, S, E);
            REP(10) ssdC_mfma(F, layer);
            SEAM(4);
        }
        if (IN(5)) { LAUNDER(); STAMP0(5);
            SchedDense<1024u, 1024u, T / 256, 4, 8> S{WSB + WS_XN, WSB + WS_WGLU, F.G, F.bid};
            EpiGlu E{(bf16_t*)(F.ws + WS_YCAT)};
            REP(11) pg8::gemm_phase<1024u, 1024u>(F.tid, F.lds, S, E);
            SEAM(5);
        }
        if (IN(6)) { LAUNDER(); STAMP0(6);
            SchedDense<4096u, 4096u, T / 256, 4, 32> S{WSB + WS_YCAT, WSB + WS_PCAT, F.G, F.bid};
            EpiMerged E{F.ws};
            REP(12) pg8::gemm_phase<4096u, 4096u>(F.tid, F.lds, S, E);
            SEAM(6);
        }
        if (IN(7)) { LAUNDER(); STAMP0(7);
            SchedDense<2048u, 2048u, T / 256, 4, 16> S{WSB + WS_XN, WSB + WS_WOUT, F.G, F.bid};
            EpiResid E{layer == 0 ? F.in[IN_X] : (const float*)F.out, F.out};
            REP(layer == 0 ? 13 : -1) pg8::gemm_phase<2048u, 2048u>(F.tid, F.lds, S, E);
            SEAM(7);
        }
        if (IN(8)) { LAUNDER(); STAMP0(8); REP(17) router_phase(F, layer); SEAM(8); }
        if (IN(9)) { LAUNDER(); STAMP0(9); (void)moe_tables(F, layer, offs, tile_e); REP(14) gather_phase(F, layer, offs); SEAM(9); }
        if (IN(10)) { LAUNDER(); STAMP0(10);
            const int ntiles = moe_tables(F, layer, offs, tile_e);
            SchedMoe<2048u, (size_t)1024 * 1024 * 2, (size_t)256 * 2048, 16> S{WSB + WS_XG, WSB + WS_EGU, ntiles, F.G, F.bid, tile_e};
            EpiSwiGlu E{(bf16_t*)(F.ws + WS_HID), (const float*)(F.ws + WS_MOE + 704 * 1024)};
            REP(15) pg8::gemm_phase<2048u, 2048u>(F.tid, F.lds, S, E);
            SEAM(10);
        }
        if (IN(11)) { LAUNDER(); STAMP0(11);
            const int ntiles = moe_tables(F, layer, offs, tile_e);
            SchedMoe<1024u, (size_t)1024 * 512 * 2, (size_t)256 * 1024, 8> S{WSB + WS_HID, WSB + WS_EDN, ntiles, F.G, F.bid, tile_e};
            EpiPlainBf16 E{(bf16_t*)(F.ws + WS_YEXP)};
            REP(16) pg8::gemm_phase<1024u, 1024u>(F.tid, F.lds, S, E);
            SEAM(11);
        }
        if (IN(12)) { LAUNDER(); STAMP0(12);
            if (PROBE_ID == 18) combine_phase(F, F.in[IN_NORM1], true);
            combine_phase(F, layer + 1 < DEPTH ? F.in[IN_NORM1] + (layer + 1) * 1024 : nullptr);
            if (layer + 1 < DEPTH) { __syncthreads(); convert_weights(F, layer + 1); __syncthreads(); s5_build(F, layer + 1); }
            SEAM(12);
        }
#undef GP
#undef IN
#undef SEAM
#undef WSB
}
__global__ void __launch_bounds__(NTHR, 2) fwd(Args args) {
    Frame F;
    F.lds = (LAS unsigned char*)lds_raw;
    F.MISC = (volatile LAS unsigned*)(F.lds + MISC_OFF);
    F.tid = threadIdx.x; F.lane = F.tid & 63; F.wave = __builtin_amdgcn_readfirstlane(F.tid >> 6);
    F.G = gridDim.x; F.bid = blockIdx.x;
    const __attribute__((address_space(4))) char* ka = (const __attribute__((address_space(4))) char*)__builtin_amdgcn_kernarg_segment_ptr();
    F.in = (const float* const __attribute__((address_space(4)))*)ka;
    F.out = *(float* const __attribute__((address_space(4)))*)(ka + N_INPUTS * 8); F.ws = *(unsigned char* const __attribute__((address_space(4)))*)(ka + N_INPUTS * 8 + 8); F.ctl = (unsigned*)(F.ws + WS_CTL);
    if (F.tid < 64) F.MISC[F.tid] = 0u;
    __syncthreads();
    XcdBarrier bar; bar.bar = F.ctl + CW_BAR; bar.x = 0; bar.st = nullptr;
    if (!MK_PER_PHASE) bar = xcd_barrier_post(F.ctl + CW_BAR, F.MISC);
    const int lo = *(const __attribute__((address_space(4))) int*)(ka + N_INPUTS * 8 + 16), hi_raw = *(const __attribute__((address_space(4))) int*)(ka + N_INPUTS * 8 + 20), hi = hi_raw & 0xffff;

    layer_body<0>(F, lo, hi, (hi_raw >> 16) != 0);
    layer_body<1>(F, lo, hi, (hi_raw >> 16) != 0);
#ifdef DIAG_GP
    __syncthreads();
    if (blockIdx.x == 0 && threadIdx.x == 0) { const unsigned t0 = *(volatile LAS unsigned*)((LAS unsigned char*)lds_raw_base() + MISC_OFF + 32), t1 = *(volatile LAS unsigned*)((LAS unsigned char*)lds_raw_base() + MISC_OFF + 40); float* o_ = *(float* const __attribute__((address_space(4)))*)((const __attribute__((address_space(4))) char*)__builtin_amdgcn_kernarg_segment_ptr() + N_INPUTS * 8); asm volatile("s_waitcnt vmcnt(0)" ::: "memory"); o_[0] = (float)(t1 - t0); }
#endif
}

extern "C" void kernel_launch(void* const* d_in, const int* in_sizes, int n_in, void* d_out, int out_size, void* d_ws, size_t ws_size, hipStream_t stream) {
    static int grid = 0;
    if (grid == 0) {
        if (n_in != N_INPUTS || out_size != T * DM || ws_size < WS_END) { fprintf(stderr, "kernel_launch: unexpected shapes (n_in %d out %d ws %zu need %zu)\n", n_in, out_size, ws_size, (size_t)WS_END); grid = -1; return; }
        int dev = 0, cus = 0, per_cu = 0;
        if (hipGetDevice(&dev) != hipSuccess || hipDeviceGetAttribute(&cus, hipDeviceAttributeMultiprocessorCount, dev) != hipSuccess) { grid = -1; return; }
        if (hipFuncSetAttribute((const void*)fwd, hipFuncAttributeMaxDynamicSharedMemorySize, LDS_BYTES) != hipSuccess) { fprintf(stderr, "kernel_launch: hipFuncSetAttribute failed\n"); grid = -1; return; }
        if (hipOccupancyMaxActiveBlocksPerMultiprocessor(&per_cu, (const void*)fwd, NTHR, LDS_BYTES) != hipSuccess || per_cu < 1) fprintf(stderr, "kernel_launch: occupancy query reports %d\n", per_cu);
        (void)hipGetLastError();
        grid = cus;
    }
    if (grid < 0) return;
    (void)hipMemsetAsync((char*)d_ws + WS_CTL, 0, CTL_ZERO_BYTES, stream);
    Args a{};
    for (int i = 0; i < N_INPUTS; ++i) a.in[i] = (const float*)d_in[i];
    a.out = (float*)d_out; a.ws = (unsigned char*)d_ws;
#if MK_PER_PHASE
    for (int gp = 0; gp < DEPTH * NPH; ++gp) {
        if (gp == NPH) continue;
        a.gp_lo = gp; a.gp_hi = gp + 1;
        int nrep = 1;
#ifdef PP_REP_GP
        if (gp == PP_REP_GP) nrep = 1 + PP_REP_N;
#endif
        for (int rr = 0; rr < nrep; ++rr) { a.gp_hi = (gp + 1) | (rr > 0 ? 0x10000 : 0); hipLaunchKernelGGL(fwd, dim3(grid), dim3(NTHR), LDS_BYTES, stream, a); }
    }
#else
    a.gp_lo = 0; a.gp_hi = DEPTH * NPH;
    hipLaunchKernelGGL(fwd, dim3(grid), dim3(NTHR), LDS_BYTES, stream, a);
#endif
}
```

```cpp
#include <hip/hip_runtime.h>
#include <cstdio>
#include <cstdint>

#define LAS __attribute__((address_space(3)))
#define GAS __attribute__((address_space(1)))
typedef unsigned short bf16_t;
typedef short bf16x8 __attribute__((ext_vector_type(8)));
typedef float f32x4 __attribute__((ext_vector_type(4)));
typedef float f32x2 __attribute__((ext_vector_type(2)));
typedef unsigned u32x4 __attribute__((ext_vector_type(4)));
typedef unsigned u32x2 __attribute__((ext_vector_type(2)));

constexpr int BATCH = 4, SEQ = 4096, DM = 1024, T = BATCH * SEQ, DEPTH = 2;
constexpr int NIN = 6672, NINP = 6912;
constexpr int C_U = 0, C_Q = 512, C_K = 1024, C_V = 1152, C_Z = 1280, C_XS = 2304, C_B = 3328, C_C = 3456, C_DT = 3584, C_G = 3840;
constexpr int S5_TC = 32, S5_ROWS = T / S5_TC  , S5_K = 128 + S5_TC * 16  , S5_N = S5_TC * 16  ;
constexpr int SSD_NCH = SEQ / 128;
constexpr int MOE_MAXROWS = 2 * T + 32 * 256;
constexpr float NORM_EPS = 1e-6f;

constexpr size_t MiB = 1u << 20;
constexpr size_t WS_CTL = 0, CTL_ZERO_BYTES = 1 * MiB;
constexpr size_t WS_WIN = 1 * MiB;
constexpr size_t WS_WGLU = WS_WIN + (size_t)NINP * DM * 2;
constexpr size_t WS_PCAT = WS_WGLU + 1 * MiB;
constexpr size_t WS_WOUT = WS_PCAT + 4 * MiB;
constexpr size_t WS_EGU = WS_WOUT + 2 * MiB;
constexpr size_t WS_EDN = WS_EGU + 64 * MiB;
constexpr size_t WS_MG = WS_EDN + 32 * MiB;
constexpr size_t WS_EG = WS_MG + 20 * MiB;
constexpr size_t WS_XN = WS_EG + 8 * MiB;
constexpr size_t WS_P = WS_XN + 32 * MiB;
constexpr size_t WS_XG = WS_P;
constexpr size_t WS_HID = WS_XG + (size_t)MOE_MAXROWS * 1024 * 2;
constexpr size_t WS_YEXP = WS_HID + (size_t)MOE_MAXROWS * 512 * 2;
constexpr size_t WS_DT = WS_P + 216 * MiB;
constexpr size_t WS_UH = WS_DT + 1 * MiB;
constexpr size_t WS_HLOC = WS_UH + 20 * MiB;
constexpr size_t WS_YCAT = WS_HLOC + 8 * MiB;
constexpr size_t WS_SST = WS_YCAT + 64 * MiB;
constexpr size_t WS_MOE = WS_SST + 32 * MiB;
constexpr size_t WS_ASUM = WS_MOE + 1 * MiB;
constexpr size_t WS_END = WS_ASUM + 64 * 1024;
static_assert(WS_YEXP + (size_t)MOE_MAXROWS * 1024 * 2 <= WS_DT, "MoE overlay fits in P");
constexpr int CW_BAR = 4096;
constexpr int CW_CNT = 16384;

constexpr int NWAVES = 8, NTHR = 512;
constexpr int LDS_BYTES = 163840;
constexpr int RING_BYTES = 131072;
constexpr int MISC_OFF = 160 * 1024 - 256;

__device__ __forceinline__ unsigned f2bf(float f) { unsigned u = __builtin_bit_cast(unsigned, f); return (u + 0x7fffu + ((u >> 16) & 1u)) >> 16; }
typedef float f32x2_t __attribute__((ext_vector_type(2)));
typedef __bf16 bf16x2_t __attribute__((ext_vector_type(2)));
__device__ __forceinline__ unsigned pk2(float lo, float hi) { f32x2_t v = {lo, hi}; bf16x2_t b = __builtin_convertvector(v, bf16x2_t); return __builtin_bit_cast(unsigned, b); }
__device__ __forceinline__ float bf2f(unsigned b) { return __builtin_bit_cast(float, b << 16); }
__device__ __forceinline__ float bflo(unsigned w) { return __builtin_bit_cast(float, w << 16); }
__device__ __forceinline__ float bfhi(unsigned w) { return __builtin_bit_cast(float, w & 0xffff0000u); }
#define WS_DPP(v, ctrl, rmask) __builtin_bit_cast(float, __builtin_amdgcn_update_dpp(0, __builtin_bit_cast(int, v), ctrl, rmask, 0xF, false))
__device__ __forceinline__ float wave_sum(float v) {
    v += WS_DPP(v, 0xB1, 0xF);
    v += WS_DPP(v, 0x4E, 0xF);
    v += WS_DPP(v, 0x141, 0xF);
    v += WS_DPP(v, 0x140, 0xF);
    v += WS_DPP(v, 0x142, 0xA);
    v += WS_DPP(v, 0x143, 0xC);
    return __builtin_bit_cast(float, __builtin_amdgcn_readlane(__builtin_bit_cast(int, v), 63));
}
__device__ __forceinline__ float frcp(float x) { return __builtin_amdgcn_rcpf(x); }
__device__ __forceinline__ float sigmoidf_(float x) { return frcp(1.0f + __expf(-x)); }
__device__ __forceinline__ float siluf_(float x) { return x * frcp(1.0f + __expf(-x)); }
__device__ __forceinline__ float gelu_tanh_(float x) { const float u = 0.7978845608f * (x + 0.044715f * x * x * x); return x * frcp(1.0f + __expf(-2.0f * u)); }
__device__ __forceinline__ float softplusf_(float x) { return x > 20.f ? x : log1pf(__expf(x)); }

typedef float f32x16 __attribute__((ext_vector_type(16)));
#define MFMA32(a, b, c) __builtin_amdgcn_mfma_f32_32x32x16_bf16((a), (b), (c), 0, 0, 0)
__device__ __forceinline__ unsigned cvtpk(float lo, float hi) { f32x2_t v = {lo, hi}; bf16x2_t b = __builtin_convertvector(v, bf16x2_t); return __builtin_bit_cast(unsigned, b); }
__device__ __forceinline__ bf16x8 pack8v(const float (&v)[8]) { u32x4 p; p.x = cvtpk(v[0], v[1]); p.y = cvtpk(v[2], v[3]); p.z = cvtpk(v[4], v[5]); p.w = cvtpk(v[6], v[7]); return __builtin_bit_cast(bf16x8, p); }

#define XB_TMO      128
#define XB_XCNT(j)  (256  + 64 * (j))
#define XB_XSUB(j)  (1280 + 64 * (j))
#define XB_XGEN(j)  (2304 + 64 * (j))
#define XB_TOP      3328
#define XB_TOPGEN   3392
#define XCD_BAR_WORDS 3456
#define XB_SPIN_CAP (1u << 18)
__device__ __forceinline__ unsigned xb_ld(unsigned* p)              { return __hip_atomic_load(p, __ATOMIC_RELAXED, __HIP_MEMORY_SCOPE_AGENT); }
__device__ __forceinline__ unsigned xb_add(unsigned* p, unsigned v) { return __hip_atomic_fetch_add(p, v, __ATOMIC_RELAXED, __HIP_MEMORY_SCOPE_AGENT); }
__device__ __forceinline__ unsigned xb_xcc_id() { return (unsigned)__builtin_amdgcn_s_getreg((3 << 11) | 20) & 0xFu; }
#define XB_SPIN(cond, bar) do { unsigned _sp = 0; while (cond) { __builtin_amdgcn_s_sleep(1); \
    if ((++_sp & 255u) == 0u) { if (xb_ld(&(bar)[XB_TMO])) break; if (_sp > XB_SPIN_CAP) { atomicAdd(&(bar)[XB_TMO], 1u); break; } } } } while (0)
struct XcdBarrier { unsigned* bar; unsigned x; volatile LAS unsigned* st; };
__device__ __forceinline__ XcdBarrier xcd_barrier_post(unsigned* bar, volatile LAS unsigned* st) {
    XcdBarrier b; b.bar = bar; b.x = xb_xcc_id(); b.st = st;
    if (threadIdx.x == 0) (void)xb_add(&bar[XB_XCNT(b.x)], 1u);
    return b;
}
__device__ __forceinline__ void xcd_barrier_complete(unsigned* bar, unsigned x, unsigned& nloc, unsigned& nx) {
    const unsigned G = gridDim.x * gridDim.y * gridDim.z;
    unsigned sum, cnt, mine, sp = 0u;
    for (;;) {
        sum = 0u; cnt = 0u; mine = 0u;
#pragma unroll
        for (unsigned j = 0; j < 16; ++j) { const unsigned c = xb_ld(&bar[XB_XCNT(j)]); sum += c; cnt += (c > 0u) ? 1u : 0u; mine = (j == x) ? c : mine; }
        if (sum == G) break;
        __builtin_amdgcn_s_sleep(1);
        if ((++sp & 255u) == 0u) { if (xb_ld(&bar[XB_TMO])) break; if (sp > XB_SPIN_CAP) { atomicAdd(&bar[XB_TMO], 1u); break; } }
    }
    nloc = mine > 0u ? mine : 1u; nx = cnt > 0u ? cnt : 1u;
}
__device__ __forceinline__ void xcd_barrier(const XcdBarrier& b) {
    asm volatile("s_waitcnt vmcnt(0)" ::: "memory");
    __syncthreads();
    if (threadIdx.x == 0) {
        unsigned* bar = b.bar;
        __builtin_amdgcn_s_waitcnt(0);
        unsigned nloc = b.st[0], nx = b.st[1];
        if (nloc == 0u) { xcd_barrier_complete(bar, b.x, nloc, nx); b.st[0] = nloc; b.st[1] = nx; }
        const unsigned old = xb_add(&bar[XB_XSUB(b.x)], 1u);
        const unsigned gen = old / nloc;
        if (old + 1u == (gen + 1u) * nloc) {
            __builtin_amdgcn_fence(__ATOMIC_RELEASE, "agent");
            asm volatile("s_waitcnt vmcnt(0)" ::: "memory");
            const unsigned og = xb_add(&bar[XB_TOP], 1u);
            const unsigned tg = og / nx;
            if (og + 1u == (tg + 1u) * nx) xb_add(&bar[XB_TOPGEN], 1u);
            else XB_SPIN(xb_ld(&bar[XB_TOPGEN]) == tg, bar);
            __builtin_amdgcn_fence(__ATOMIC_ACQUIRE, "agent");
            xb_add(&bar[XB_XGEN(b.x)], 1u);
            asm volatile("s_waitcnt vmcnt(0)" ::: "memory");
        } else {
            XB_SPIN(xb_ld(&bar[XB_XGEN(b.x)]) == gen, bar);
            __builtin_amdgcn_fence(__ATOMIC_ACQUIRE, "agent");
            asm volatile("s_waitcnt vmcnt(0)" ::: "memory");
        }
    }
    __syncthreads();
}

namespace pg8 {
constexpr int BM = 256, BK = 64, HALF = 128, HTB = HALF * BK * 2, STAGE_BYTES = 8 * HTB, NXCD = 8, WGM = 8;
__host__ __device__ __forceinline__ int lds_byte(int r, int c) { const int st = (r >> 4) * 2 + (c >> 5), rr = r & 15, cc = c & 31, ob = rr * 64 + cc * 2; return st * 1024 + (ob ^ (((ob >> 9) & 1) << 5)); }
__host__ __device__ __forceinline__ void stage_rc(int b, int& R, int& C) { const int st = b / 1024, sb = b % 1024, swz = sb ^ (((sb >> 9) & 1) << 5); R = (st >> 1) * 16 + swz / 64; C = (st & 1) * 32 + (swz % 64) / 2; }
__host__ __device__ __forceinline__ int perm32(int rho) { const int n = rho >> 4, i = rho & 15; return 8 * (i >> 2) + 4 * n + (i & 3); }

struct Unit { const char* A; const char* B; int nt; int pm, pn, aux; };

__device__ __forceinline__ void tile_order(int L, int nM, int nN, int& pm, int& pn) {
    const int nwg = nM * nN; int wgid = L;
    { const int q = nwg / NXCD, r = nwg % NXCD, xcd = wgid % NXCD, off = wgid / NXCD; wgid = (xcd < r ? xcd * (q + 1) : r * (q + 1) + (xcd - r) * q) + off; }
    const int nig = WGM * nN, gid = wgid / nig, fm = gid * WGM, gsz = (nM - fm) < WGM ? (nM - fm) : WGM;
    pm = fm + ((wgid % nig) % gsz); pn = (wgid % nig) / gsz;
}
__device__ __forceinline__ unsigned cvt_pk_bf16(float lo, float hi) { unsigned r; asm volatile("v_cvt_pk_bf16_f32 %0, %1, %2" : "=v"(r) : "v"(lo), "v"(hi)); return r; }
__device__ __forceinline__ u32x4 pack8(const f32x4 v0, const f32x4 v1) { u32x4 w; w.x = cvt_pk_bf16(v0[0], v0[1]); w.y = cvt_pk_bf16(v0[2], v0[3]); w.z = cvt_pk_bf16(v1[0], v1[1]); w.w = cvt_pk_bf16(v1[2], v1[3]); return w; }

template <unsigned lda, unsigned ldb, class Epi, class Sched>
__device__ __forceinline__ void gemm_phase(const int tid, LAS unsigned char* lds, const Sched& S, const Epi& E) {
    const int wid = __builtin_amdgcn_readfirstlane(tid >> 6), lane = tid & 63, wr = wid >> 2, wc = wid & 3, fr = lane & 15, fq = lane >> 4;
    unsigned voffA[2], voffB[2];
#pragma unroll
    for (int i = 0; i < 2; ++i) { int R, C; stage_rc(tid * 16 + i * 8192, R, C); const int Rb = Epi::PERM ? ((R & ~31) + perm32(R & 31)) : R;
        voffA[i] = (unsigned)R * lda + (unsigned)C * 2u; voffB[i] = (unsigned)Rb * ldb + (unsigned)C * 2u; }
    const size_t kstep = (size_t)(BK * 2);
    const size_t hstepA = (size_t)HALF * lda, hstepB = (size_t)HALF * ldb;
    const unsigned ldsw = (unsigned)wid * 1024u;
    const int aoff = lds_byte(wr * 64 + fr, fq * 8), boff = lds_byte(wc * 32 + fr, fq * 8);
#define PG8_SA(b, h) (((b) * 2 + (h)) * HTB)
#define PG8_SB(b, h) ((4 + (b) * 2 + (h)) * HTB)
#define PG8_STAGE(bufoff, gbase, voff) do { const char* _gb = (const char*)(gbase); asm volatile("" : "+s"(_gb)); _Pragma("unroll") for (int _i = 0; _i < 2; ++_i) \
        __builtin_amdgcn_global_load_lds((const unsigned*)(_gb + (voff)[_i]), (LAS unsigned*)(lds + (bufoff) + ldsw + _i * 8192), 16, 0, 0); } while (0)
#define PG8_LDA(dst, b, h) do { _Pragma("unroll") for (int m = 0; m < 4; ++m) _Pragma("unroll") for (int k = 0; k < 2; ++k) dst[m][k] = *(const LAS bf16x8*)(lds + PG8_SA(b, h) + aoff + m * 2048 + k * 1024); } while (0)
#define PG8_LDB(dst, b, h) do { _Pragma("unroll") for (int n = 0; n < 2; ++n) _Pragma("unroll") for (int k = 0; k < 2; ++k) dst[n][k] = *(const LAS bf16x8*)(lds + PG8_SB(b, h) + boff + n * 2048 + k * 1024); } while (0)
#define PG8_MMA(ai, bj, At, Bt) do { __builtin_amdgcn_s_setprio(1); _Pragma("unroll") for (int m = 0; m < 4; ++m) _Pragma("unroll") for (int n = 0; n < 2; ++n) _Pragma("unroll") for (int k = 0; k < 2; ++k) \
        acc[ai][bj][m][n] = __builtin_amdgcn_mfma_f32_16x16x32_bf16(Bt[n][k], At[m][k], acc[ai][bj][m][n], 0, 0, 0); __builtin_amdgcn_s_setprio(0); } while (0)
#define PG8_WAIT_V(n) asm volatile("s_waitcnt vmcnt(" #n ")" ::: "memory")
#define PG8_WAIT_L(n) asm volatile("s_waitcnt lgkmcnt(" #n ")" ::: "memory")
#define PG8_BAR __builtin_amdgcn_s_barrier()
#define PG8_SCHED __builtin_amdgcn_sched_barrier(0)
    Unit cur, nxt; int ui = 0;
    if (!S.next(0, cur)) return;
    f32x4 acc[2][2][4][2];
#pragma unroll
    for (int a = 0; a < 2; ++a)
#pragma unroll
        for (int b = 0; b < 2; ++b)
#pragma unroll
            for (int m = 0; m < 4; ++m)
#pragma unroll
                for (int n = 0; n < 2; ++n) acc[a][b][m][n] = (f32x4){0.f, 0.f, 0.f, 0.f};
    bf16x8 At[4][2], B0[2][2], B1[2][2];
    const char* cA = cur.A; const char* cB = cur.B;
    PG8_STAGE(PG8_SB(0, 0), cB, voffB); PG8_STAGE(PG8_SB(0, 1), cB + hstepB, voffB); PG8_STAGE(PG8_SA(0, 0), cA, voffA); PG8_STAGE(PG8_SA(0, 1), cA + hstepA, voffA);
    if (wr == 1) PG8_BAR;
    PG8_WAIT_V(2); PG8_BAR;
    PG8_STAGE(PG8_SB(1, 0), cB + kstep, voffB); PG8_STAGE(PG8_SA(1, 0), cA + kstep, voffA); PG8_STAGE(PG8_SB(1, 1), cB + hstepB + kstep, voffB);
    PG8_WAIT_V(6); PG8_BAR;
    for (;;) {
        const bool has_next = S.next(ui + 1, nxt);
        const char* nA = has_next ? nxt.A : cA; const char* nB = has_next ? nxt.B : cB;
        const int nt = cur.nt;
        for (int t = 0; t < nt; t += 2) {
            const bool last = (t == nt - 2);
            const char* a1 = cA + (size_t)(t + 1) * kstep;
            const char* a2 = last ? nA : cA + (size_t)(t + 2) * kstep; const char* b2 = last ? nB : cB + (size_t)(t + 2) * kstep;
            const char* a3 = a2 + kstep; const char* b3 = b2 + kstep;
            PG8_LDB(B0, 0, 0); PG8_LDB(B1, 0, 1); PG8_SCHED; PG8_LDA(At, 0, 0); PG8_STAGE(PG8_SA(1, 1), a1 + hstepA, voffA);
            PG8_WAIT_V(8); PG8_WAIT_L(0); PG8_BAR; PG8_MMA(0, 0, At, B0); PG8_MMA(0, 1, At, B1); PG8_BAR; PG8_SCHED;
            PG8_LDA(At, 0, 1); PG8_STAGE(PG8_SB(0, 0), b2, voffB); PG8_STAGE(PG8_SB(0, 1), b2 + hstepB, voffB); PG8_STAGE(PG8_SA(0, 0), a2, voffA);
            PG8_WAIT_V(8); PG8_WAIT_L(0); PG8_BAR; PG8_MMA(1, 0, At, B0); PG8_MMA(1, 1, At, B1); PG8_BAR; PG8_SCHED;
            PG8_LDB(B0, 1, 0); PG8_LDB(B1, 1, 1); PG8_SCHED; PG8_LDA(At, 1, 0); PG8_STAGE(PG8_SA(0, 1), a2 + hstepA, voffA);
            PG8_WAIT_V(8); PG8_WAIT_L(0); PG8_BAR; PG8_MMA(0, 0, At, B0); PG8_MMA(0, 1, At, B1); PG8_BAR; PG8_SCHED;
            PG8_LDA(At, 1, 1); PG8_STAGE(PG8_SB(1, 0), b3, voffB); PG8_STAGE(PG8_SB(1, 1), b3 + hstepB, voffB); PG8_STAGE(PG8_SA(1, 0), a3, voffA);
            PG8_WAIT_V(8); PG8_WAIT_L(0); PG8_BAR; PG8_MMA(1, 0, At, B0); PG8_MMA(1, 1, At, B1); PG8_BAR; PG8_SCHED;
            if constexpr (Epi::HAS_MID) { if (t + 2 == 8 || t + 2 == 16) { E.mid(acc, cur, t + 2, wr, wc, fr, fq); PG8_SCHED; } }
        }
        if (wr == 0) PG8_BAR;
        E(acc, cur, wr, wc, fr, fq);
        if (!has_next) break;
#pragma unroll
        for (int a = 0; a < 2; ++a)
#pragma unroll
            for (int b = 0; b < 2; ++b)
#pragma unroll
                for (int m = 0; m < 4; ++m)
#pragma unroll
                    for (int n = 0; n < 2; ++n) acc[a][b][m][n] = (f32x4){0.f, 0.f, 0.f, 0.f};
        cur = nxt; cA = nA; cB = nB; ++ui;
        if (wr == 1) PG8_BAR;
    }
    PG8_WAIT_V(0);
    PG8_BAR;
#undef PG8_SA
#undef PG8_SB
#undef PG8_STAGE
#undef PG8_LDA
#undef PG8_LDB
#undef PG8_MMA
#undef PG8_WAIT_V
#undef PG8_WAIT_L
#undef PG8_BAR
#undef PG8_SCHED
}
}

struct Frame {
    LAS unsigned char* lds;
    volatile LAS unsigned* MISC;
    unsigned* ctl;
    int tid, lane, wave, G, bid;
    const float* const __attribute__((address_space(4)))* in;
    float* out; unsigned char* ws;
};
enum { IN_X = 0, IN_NORM1, IN_WIN, IN_BGATE, IN_LRE, IN_LIM, IN_BRE, IN_BIM, IN_CRE, IN_CIM, IN_S5D, IN_LOGDT, IN_GLU1, IN_GLU2, IN_QG, IN_KG, IN_SINK,
       IN_CONVW, IN_CONVB, IN_DTB, IN_ALOG, IN_SSDD, IN_SSDG, IN_PS5, IN_PATTN, IN_PSSD, IN_WOUT, IN_NORM2, IN_WRG, IN_BRG, IN_WRE, IN_BRE_, IN_EG, IN_EU, IN_ED, N_INPUTS };

#define LDS_WAIT() asm volatile("s_waitcnt lgkmcnt(0)" ::: "memory")
#define VM_WAIT() asm volatile("s_waitcnt vmcnt(0)" ::: "memory")

using pg8::Unit; using pg8::pack8;
struct EpiProj {
    static constexpr bool PERM = true, HAS_MID = false;
    unsigned char* ws; const float* bgate;
    __device__ __forceinline__ void operator()(const f32x4 (&acc)[2][2][4][2], const Unit& u, int wr, int wc, int fr, int fq) const {
        bf16_t* P = (bf16_t*)(ws + WS_P); bf16_t* UH = (bf16_t*)(ws + WS_UH); float* DT = (float*)(ws + WS_DT);
        const int row0 = u.pm * 256 + wr * 64 + fr;
        if (u.pn < 2) {
#pragma unroll
            for (int ai = 0; ai < 2; ++ai)
#pragma unroll
                for (int m = 0; m < 4; ++m) { const int row = row0 + ai * 128 + m * 16, r = row >> 5, s = row & 31;
#pragma unroll
                    for (int bj = 0; bj < 2; ++bj) { const int col = u.pn * 256 + bj * 128 + wc * 32 + 8 * fq, g = col >> 4, c0 = col & 15;
                        *(u32x4*)(UH + ((size_t)(g * S5_ROWS + r) * S5_K + 128 + s * 16 + c0)) = pack8(acc[ai][bj][m][0], acc[ai][bj][m][1]); } }
        } else {
            const int colb = u.pn * 256 + wc * 32 + 8 * fq;
            f32x4 bv[2][2];
#pragma unroll
            for (int bj = 0; bj < 2; ++bj)
#pragma unroll
                for (int n = 0; n < 2; ++n) bv[bj][n] = (u.pn >= 15) ? *(const f32x4*)(bgate + (colb - C_G) + bj * 128 + 4 * n) : (f32x4){0.f, 0.f, 0.f, 0.f};
#pragma unroll
            for (int ai = 0; ai < 2; ++ai)
#pragma unroll
                for (int m = 0; m < 4; ++m) { const int row = row0 + ai * 128 + m * 16;
#pragma unroll
                    for (int bj = 0; bj < 2; ++bj) { f32x4 v0 = acc[ai][bj][m][0] + bv[bj][0], v1 = acc[ai][bj][m][1] + bv[bj][1];
                        if (u.pn >= 15) {
#pragma unroll
                            for (int j = 0; j < 4; ++j) { v0[j] = fmaxf(sigmoidf_(v0[j]), 1e-30f); v1[j] = fmaxf(sigmoidf_(v1[j]), 1e-30f); } }
                        *(u32x4*)(P + (size_t)row * NINP + colb + bj * 128) = pack8(v0, v1); }
                    if (u.pn == 14 && wc == 0 && fq < 2) { float* d = DT + (size_t)row * 16 + 8 * fq; *(f32x4*)d = acc[ai][0][m][0]; *(f32x4*)(d + 4) = acc[ai][0][m][1]; } }
        }
    }
};
struct EpiHloc {
    static constexpr bool PERM = false, HAS_MID = false;
    float* H;
    __device__ __forceinline__ void operator()(const f32x4 (&acc)[2][2][4][2], const Unit& u, int wr, int wc, int fr, int fq) const {
#pragma unroll
        for (int ai = 0; ai < 2; ++ai)
#pragma unroll
            for (int m = 0; m < 4; ++m) { const int r = u.pm * 256 + ai * 128 + wr * 64 + m * 16 + fr; float* rowp = H + ((size_t)(u.aux * S5_ROWS + r) * 128) + wc * 32 + 4 * fq;
#pragma unroll
                for (int n = 0; n < 2; ++n) *(f32x4*)(rowp + 16 * n) = acc[ai][0][m][n]; }
    }
};
struct EpiS5Y {
    static constexpr bool PERM = true, HAS_MID = false;
    bf16_t* Y;
    __device__ __forceinline__ void operator()(const f32x4 (&acc)[2][2][4][2], const Unit& u, int wr, int wc, int fr, int fq) const {
#pragma unroll
        for (int ai = 0; ai < 2; ++ai)
#pragma unroll
            for (int m = 0; m < 4; ++m) { const int r = u.pm * 256 + ai * 128 + wr * 64 + m * 16 + fr;
#pragma unroll
                for (int bj = 0; bj < 2; ++bj) { const int n0 = u.pn * 256 + bj * 128 + wc * 32 + 8 * fq, t = n0 >> 4, c0 = n0 & 15;
                    f32x4 v0 = acc[ai][bj][m][0], v1 = acc[ai][bj][m][1];
#pragma unroll
                    for (int j = 0; j < 4; ++j) { v0[j] = gelu_tanh_(v0[j]); v1[j] = gelu_tanh_(v1[j]); }
                    *(u32x4*)(Y + ((size_t)(r * S5_TC + t) * 512 + u.aux * 16 + c0)) = pack8(v0, v1); } }
    }
};
struct EpiGlu {
    static constexpr bool PERM = true, HAS_MID = false;
    bf16_t* Y;
    __device__ __forceinline__ void operator()(const f32x4 (&acc)[2][2][4][2], const Unit& u, int wr, int wc, int fr, int fq) const {
#pragma unroll
        for (int ai = 0; ai < 2; ++ai)
#pragma unroll
            for (int m = 0; m < 4; ++m) { const int row = u.pm * 256 + ai * 128 + wr * 64 + m * 16 + fr;
                f32x4 v0 = acc[ai][0][m][0], v1 = acc[ai][0][m][1]; const f32x4 g0 = acc[ai][1][m][0], g1 = acc[ai][1][m][1];
#pragma unroll
                for (int j = 0; j < 4; ++j) { v0[j] *= sigmoidf_(g0[j]); v1[j] *= sigmoidf_(g1[j]); }
                *(u32x4*)(Y + (size_t)row * 2048 + u.pn * 128 + wc * 32 + 8 * fq) = pack8(v0, v1); }
    }
};
struct EpiSwiGlu {
    static constexpr bool PERM = true, HAS_MID = false;
    bf16_t* Y; const float* RSG;
    __device__ __forceinline__ void operator()(const f32x4 (&acc)[2][2][4][2], const Unit& u, int wr, int wc, int fr, int fq) const {
#pragma unroll
        for (int ai = 0; ai < 2; ++ai)
#pragma unroll
            for (int m = 0; m < 4; ++m) { const int row = u.pm * 256 + ai * 128 + wr * 64 + m * 16 + fr;
                f32x4 v0 = acc[ai][0][m][0], v1 = acc[ai][0][m][1]; const f32x4 g0 = acc[ai][1][m][0], g1 = acc[ai][1][m][1]; const float rr = 1.f;
#pragma unroll
                for (int j = 0; j < 4; ++j) { v0[j] = siluf_(v0[j] * rr) * (g0[j] * rr); v1[j] = siluf_(v1[j] * rr) * (g1[j] * rr); }
                *(u32x4*)(Y + (size_t)row * 512 + u.pn * 128 + wc * 32 + 8 * fq) = pack8(v0, v1); }
    }
};
struct EpiPlainBf16 {
    static constexpr bool PERM = true, HAS_MID = false;
    bf16_t* O;
    __device__ __forceinline__ void operator()(const f32x4 (&acc)[2][2][4][2], const Unit& u, int wr, int wc, int fr, int fq) const {
#pragma unroll
        for (int ai = 0; ai < 2; ++ai)
#pragma unroll
            for (int m = 0; m < 4; ++m) { const int row = u.pm * 256 + ai * 128 + wr * 64 + m * 16 + fr;
#pragma unroll
                for (int bj = 0; bj < 2; ++bj) *(u32x4*)(O + (size_t)row * 1024 + u.pn * 256 + bj * 128 + wc * 32 + 8 * fq) = pack8(acc[ai][bj][m][0], acc[ai][bj][m][1]); }
    }
};
struct EpiMerged {
    static constexpr bool PERM = true, HAS_MID = true;
    unsigned char* ws;
    __device__ __forceinline__ static float lclamp(float l) { return fminf(fmaxf(l, -30.f), 30.f); }
    __device__ __forceinline__ void mid(f32x4 (&acc)[2][2][4][2], const Unit& u, int kt, int wr, int wc, int fr, int fq) const {
        const int br = (kt == 8) ? 0 : 1; const bf16_t* P = (const bf16_t*)(ws + WS_P);
#pragma unroll
        for (int ai = 0; ai < 2; ++ai)
#pragma unroll
            for (int m = 0; m < 4; ++m) { const int row = u.pm * 256 + ai * 128 + wr * 64 + m * 16 + fr;
#pragma unroll
                for (int bj = 0; bj < 2; ++bj) { const bf16_t* gp = P + (size_t)row * NINP + C_G + br * 1024 + u.pn * 256 + bj * 128 + wc * 32 + 8 * fq;
                    const u32x4 la = *(const u32x4*)gp, lb = *(const u32x4*)(gp + 1024);
#pragma unroll
                    for (int j = 0; j < 4; ++j) { const unsigned wa = la[j], wb = lb[j];
                        const float r0 = bflo(wa) * frcp(bflo(wb)), r1 = bfhi(wa) * frcp(bfhi(wb));
                        if (j < 2) { acc[ai][bj][m][0][2 * j] *= r0; acc[ai][bj][m][0][2 * j + 1] *= r1; } else { acc[ai][bj][m][1][2 * j - 4] *= r0; acc[ai][bj][m][1][2 * j - 3] *= r1; } } }
                if (m == 3) asm volatile("" ::: "memory"); }
    }
    __device__ __forceinline__ void operator()(const f32x4 (&acc)[2][2][4][2], const Unit& u, int wr, int wc, int fr, int fq) const {
        const bf16_t* P = (const bf16_t*)(ws + WS_P); bf16_t* O = (bf16_t*)(ws + WS_XN);
#pragma unroll
        for (int ai = 0; ai < 2; ++ai)
#pragma unroll
            for (int m = 0; m < 4; ++m) { const int row = u.pm * 256 + ai * 128 + wr * 64 + m * 16 + fr;
#pragma unroll
                for (int bj = 0; bj < 2; ++bj) { const int col = u.pn * 256 + bj * 128 + wc * 32 + 8 * fq;
                    const u32x4 lc = *(const u32x4*)(P + (size_t)row * NINP + C_G + 2048 + col);
                    f32x4 v0 = acc[ai][bj][m][0], v1 = acc[ai][bj][m][1];
                    v0[0] *= bflo(lc[0]); v0[1] *= bfhi(lc[0]); v0[2] *= bflo(lc[1]); v0[3] *= bfhi(lc[1]);
                    v1[0] *= bflo(lc[2]); v1[1] *= bfhi(lc[2]); v1[2] *= bflo(lc[3]); v1[3] *= bfhi(lc[3]);
                    *(u32x4*)(O + (size_t)row * 1024 + col) = pack8(v0, v1); }
                if (m == 3) asm volatile("" ::: "memory"); }
    }
};
struct EpiResid {
    static constexpr bool PERM = false, HAS_MID = false;
    const float* resid; float* out;
    __device__ __forceinline__ void operator()(const f32x4 (&acc)[2][2][4][2], const Unit& u, int wr, int wc, int fr, int fq) const {
#pragma unroll
        for (int ai = 0; ai < 2; ++ai)
#pragma unroll
            for (int m = 0; m < 4; ++m) { const size_t off = (size_t)(u.pm * 256 + ai * 128 + wr * 64 + m * 16 + fr) * 1024 + u.pn * 256 + wc * 32 + 4 * fq;
#pragma unroll
                for (int bj = 0; bj < 2; ++bj)
#pragma unroll
                    for (int n = 0; n < 2; ++n) { const f32x4 rv = *(const f32x4*)(resid + off + bj * 128 + n * 16); *(f32x4*)(out + off + bj * 128 + n * 16) = rv + acc[ai][bj][m][n]; } }
    }
};

template <unsigned lda, unsigned ldb, int nM, int nN, int NT>
struct SchedDense {
    const char* A; const char* B; int G, c;
    __device__ __forceinline__ bool next(int i, Unit& u) const {
        const int L = i * G + c; if (L >= nM * nN) return false;
        int pm, pn; pg8::tile_order(L, nM, nN, pm, pn);
        u.A = A + (size_t)pm * 256 * lda; u.B = B + (size_t)pn * 256 * ldb; u.nt = NT; u.pm = pm; u.pn = pn; u.aux = 0; return true;
    }
};
struct SchedS5P1 {
    const char* UH; const char* EG; int G, c;
    __device__ __forceinline__ bool next(int i, Unit& u) const {
        const int L = i * G + c; if (L >= 64) return false;
        const int g = L >> 1, pm = L & 1;
        u.A = UH + ((size_t)(g * S5_ROWS + pm * 256) * S5_K + 128) * 2; u.B = EG + (size_t)g * 256 * 512 * 2; u.nt = 8; u.pm = pm; u.pn = 0; u.aux = g; return true;
    }
};
struct SchedS5Main {
    const char* UH; const char* MG; int G, c;
    __device__ __forceinline__ bool next(int i, Unit& u) const {
        const int L = i * G + c; if (L >= 128) return false;
        const int g = L >> 2, pm = (L >> 1) & 1, pn = L & 1;
        u.A = UH + (size_t)(g * S5_ROWS + pm * 256) * S5_K * 2; u.B = MG + (size_t)(g * S5_N + pn * 256) * S5_K * 2; u.nt = 2 + 4 * (pn + 1); u.pm = pm; u.pn = pn; u.aux = g; return true;
    }
};
template <unsigned lda, size_t bexp  , size_t btile  , int NT>
struct SchedMoe {
    const char* A; const char* B; int ntiles, G, c; const volatile LAS int* tile_e;
    __device__ __forceinline__ bool next(int i, Unit& u) const {
        const int L = i * G + c; if (L >= ntiles * 4) return false;
        int pm, pn; pg8::tile_order(L, ntiles, 4, pm, pn);
        const int e = __builtin_amdgcn_readfirstlane(tile_e[pm]);
        u.A = A + (size_t)pm * 256 * lda; u.B = B + (size_t)e * bexp + (size_t)pn * btile; u.nt = NT; u.pm = pm; u.pn = pn; u.aux = e; return true;
    }
};

__device__ __forceinline__ void transpose_item(const float* W, int ldw, int ncols, bf16_t* WT, int ldt, int kofs, int mode, int p0, int p1, LAS float* scr, int k0, int n0, int lane) {
    float wv[32];
#pragma unroll
    for (int i = 0; i < 32; ++i) { const int kk = 2 * i + (lane >> 5), n = n0 + (lane & 31); wv[i] = (n < ncols) ? W[(size_t)(k0 + kk) * ldw + n] : 0.f; }
#pragma unroll
    for (int i = 0; i < 32; ++i) { const int kk = 2 * i + (lane >> 5); scr[kk * 33 + (lane & 31)] = wv[i]; }
    LDS_WAIT(); asm volatile("" ::: "memory");
    const int c = lane & 7;
#pragma unroll
    for (int j = 0; j < 4; ++j) { const int nn = (lane >> 3) + 8 * j, n = n0 + nn; const LAS float* s = scr + (8 * c) * 33 + nn;
        u32x4 o; o.x = pk2(s[0 * 33], s[1 * 33]); o.y = pk2(s[2 * 33], s[3 * 33]); o.z = pk2(s[4 * 33], s[5 * 33]); o.w = pk2(s[6 * 33], s[7 * 33]);
        const int drow = (mode == 0) ? n + (n >= p0 ? p1 : 0) : ((n >> 7) * 256 + (n & 127) + 128 * p0);
        if (n < ncols) *(u32x4*)(WT + (size_t)drow * ldt + kofs + k0 + 8 * c) = o; }
    LDS_WAIT(); asm volatile("" ::: "memory");
}
__device__ __forceinline__ void convert_weights(Frame& F, int layer) {
    LAS float* scr = (LAS float*)(F.lds + F.wave * 16384);
    const int gw = F.bid * NWAVES + F.wave, NGW = F.G * NWAVES;
    bf16_t* WIN = (bf16_t*)(F.ws + WS_WIN); bf16_t* WGLU = (bf16_t*)(F.ws + WS_WGLU); bf16_t* PCAT = (bf16_t*)(F.ws + WS_PCAT); bf16_t* WOUT = (bf16_t*)(F.ws + WS_WOUT);
    bf16_t* EGU = (bf16_t*)(F.ws + WS_EGU); bf16_t* EDN = (bf16_t*)(F.ws + WS_EDN);
    constexpr int I_WIN = 16 * 209, I_GLU = 8 * 16, I_P5 = 8 * 32, I_PS = 16 * 32, I_WO = 16 * 32, I_EG = 32 * 256, I_ED = 32 * 256;
    constexpr int NITEMS = I_WIN + 2 * I_GLU + 2 * I_P5 + I_PS + I_WO + 2 * I_EG + I_ED;
    for (int it = gw; it < NITEMS; it += NGW) {
        int r = it;
        if (r < I_WIN) { transpose_item(F.in[IN_WIN] + (size_t)layer * DM * NIN, NIN, NIN, WIN, DM, 0, 0, 3600, 240, scr, 64 * (r / 209), 32 * (r % 209), F.lane); continue; } r -= I_WIN;
        if (r < I_GLU) { transpose_item(F.in[IN_GLU1] + (size_t)layer * 512 * 512, 512, 512, WGLU, 512, 0, 1, 0, 0, scr, 64 * (r / 16), 32 * (r % 16), F.lane); continue; } r -= I_GLU;
        if (r < I_GLU) { transpose_item(F.in[IN_GLU2] + (size_t)layer * 512 * 512, 512, 512, WGLU, 512, 0, 1, 1, 0, scr, 64 * (r / 16), 32 * (r % 16), F.lane); continue; } r -= I_GLU;
        if (r < I_P5) { transpose_item(F.in[IN_PS5] + (size_t)layer * 512 * 1024, 1024, 1024, PCAT, 2048, 0, 0, 1 << 30, 0, scr, 64 * (r / 32), 32 * (r % 32), F.lane); continue; } r -= I_P5;
        if (r < I_P5) { transpose_item(F.in[IN_PATTN] + (size_t)layer * 512 * 1024, 1024, 1024, PCAT, 2048, 512, 0, 1 << 30, 0, scr, 64 * (r / 32), 32 * (r % 32), F.lane); continue; } r -= I_P5;
        if (r < I_PS) { transpose_item(F.in[IN_PSSD] + (size_t)layer * 1024 * 1024, 1024, 1024, PCAT, 2048, 1024, 0, 1 << 30, 0, scr, 64 * (r / 32), 32 * (r % 32), F.lane); continue; } r -= I_PS;
        if (r < I_WO) { transpose_item(F.in[IN_WOUT] + (size_t)layer * 1024 * 1024, 1024, 1024, WOUT, 1024, 0, 0, 1 << 30, 0, scr, 64 * (r / 32), 32 * (r % 32), F.lane); continue; } r -= I_WO;
        if (r < I_EG) { const int e = r >> 8, q = r & 255; transpose_item(F.in[IN_EG] + ((size_t)layer * 32 + e) * 1024 * 512, 512, 512, EGU + (size_t)e * 1024 * 1024, 1024, 0, 1, 0, 0, scr, 64 * (q / 16), 32 * (q % 16), F.lane); continue; } r -= I_EG;
        if (r < I_EG) { const int e = r >> 8, q = r & 255; transpose_item(F.in[IN_EU] + ((size_t)layer * 32 + e) * 1024 * 512, 512, 512, EGU + (size_t)e * 1024 * 1024, 1024, 0, 1, 1, 0, scr, 64 * (q / 16), 32 * (q % 16), F.lane); continue; } r -= I_EG;
        { const int e = r >> 8, q = r & 255; transpose_item(F.in[IN_ED] + ((size_t)layer * 32 + e) * 512 * 1024, 1024, 1024, EDN + (size_t)e * 1024 * 512, 512, 0, 0, 1 << 30, 0, scr, 64 * (q / 32), 32 * (q % 32), F.lane); }
    }
}
__device__ __forceinline__ void sincos_fast(float x, float& s, float& c) {
    const float k = rintf(x * 0.15915494309189535f);
    float r = fmaf(-k, 6.2831854820251465f, x); r = fmaf(-k, -1.7484555e-07f, r);
    s = __sinf(r); c = __cosf(r);
}
__device__ __forceinline__ void sincos_red(float x, float& s, float& c) {
    const float k = rintf(x * 0.15915494309189535f);
    float r = fmaf(-k, 6.2831854820251465f, x); r = fmaf(-k, -1.7484555e-07f, r);
    s = sinf(r); c = cosf(r);
}
__device__ __forceinline__ void s5_build(Frame& F, int layer) {
    LAS float* pw = (LAS float*)F.lds;
    LAS float* Bb = pw + 33 * 64 * 2;
    LAS float* Cc = Bb + 64 * 16 * 2;
    LAS float* Kd = Cc + 16 * 64 * 2;
    bf16_t* MG = (bf16_t*)(F.ws + WS_MG); bf16_t* EG = (bf16_t*)(F.ws + WS_EG);
    for (int w = F.bid; w < 256; w += F.G) {
        const int g = w >> 3, part = w & 7, gi = layer * 32 + g;
        __syncthreads();
        const float dt = __expf(F.in[IN_LOGDT][gi]);
        for (int i = F.tid; i < 33 * 64; i += NTHR) { const int d = i >> 6, p = i & 63; const float lr = F.in[IN_LRE][gi * 64 + p], li = F.in[IN_LIM][gi * 64 + p];
            float s, c; sincos_red((float)d * li * dt, s, c); const float mg = __expf((float)d * lr * dt); pw[2 * i] = mg * c; pw[2 * i + 1] = mg * s; }
        for (int i = F.tid; i < 64 * 16; i += NTHR) { const int p = i >> 4; const float lr = F.in[IN_LRE][gi * 64 + p], li = F.in[IN_LIM][gi * 64 + p];
            float s, c; sincos_red(li * dt, s, c); const float mg = __expf(lr * dt), are = mg * c, aim = mg * s, nr = are - 1.f, den = lr * lr + li * li;
            const float fre = (nr * lr + aim * li) / den, fim = (aim * lr - nr * li) / den;
            const float br = F.in[IN_BRE][(size_t)gi * 1024 + i], bi = F.in[IN_BIM][(size_t)gi * 1024 + i];
            Bb[2 * i] = fre * br - fim * bi; Bb[2 * i + 1] = fre * bi + fim * br; }
        for (int i = F.tid; i < 16 * 64; i += NTHR) { Cc[2 * i] = F.in[IN_CRE][(size_t)gi * 1024 + i]; Cc[2 * i + 1] = F.in[IN_CIM][(size_t)gi * 1024 + i]; }
        __syncthreads();
        { const int d = F.tid >> 4, c = F.tid & 15; float acc[16];
#pragma unroll
          for (int j = 0; j < 16; ++j) acc[j] = 0.f;
          for (int p = 0; p < 64; ++p) { const float cr = Cc[2 * (c * 64 + p)], ci = Cc[2 * (c * 64 + p) + 1], pr = pw[2 * (d * 64 + p)], pi = pw[2 * (d * 64 + p) + 1];
              const float xr = cr * pr - ci * pi, xi = cr * pi + ci * pr;
#pragma unroll
              for (int q = 0; q < 8; ++q) { const f32x4 bb = *(const LAS f32x4*)(Bb + 2 * (p * 16) + 4 * q); acc[2 * q] += xr * bb.x - xi * bb.y; acc[2 * q + 1] += xr * bb.z - xi * bb.w; } }
#pragma unroll
          for (int j = 0; j < 16; ++j) Kd[(d * 16 + c) * 16 + j] = acc[j]; }
        __syncthreads();
        for (int v = F.tid; v < 64 * 80; v += NTHR) { const int n = part * 64 + v / 80, k0 = (v % 80) * 8, t = n >> 4, c = n & 15; float o[8];
            if (k0 < 128) { const int im = k0 >= 64, p0 = k0 & 63;
#pragma unroll
                for (int j = 0; j < 8; ++j) { const int p = p0 + j; const float cr = Cc[2 * (c * 64 + p)], ci = Cc[2 * (c * 64 + p) + 1], pr = pw[2 * ((t + 1) * 64 + p)], pi = pw[2 * ((t + 1) * 64 + p) + 1];
                    o[j] = im ? -(cr * pi + ci * pr) : (cr * pr - ci * pi); }
            } else { const int s = (k0 - 128) >> 4, c0 = (k0 - 128) & 15;
#pragma unroll
                for (int j = 0; j < 8; ++j) { float x = 0.f; if (s <= t) { x = Kd[(t - s) * 256 + c * 16 + c0 + j]; if (s == t && c == c0 + j) x += F.in[IN_S5D][layer * 512 + g * 16 + c]; } o[j] = x; } }
            u32x4 q; q.x = pk2(o[0], o[1]); q.y = pk2(o[2], o[3]); q.z = pk2(o[4], o[5]); q.w = pk2(o[6], o[7]);
            *(u32x4*)(MG + ((size_t)(g * S5_N + n) * S5_K + k0)) = q; }
        for (int v = F.tid; v < 16 * 64; v += NTHR) { const int jr = part * 16 + v / 64, k0 = (v % 64) * 8, im = jr >= 64, p = jr & 63, s = k0 >> 4, c0 = k0 & 15; float o[8];
            const float pr = pw[2 * ((S5_TC - 1 - s) * 64 + p)], pi = pw[2 * ((S5_TC - 1 - s) * 64 + p) + 1];
#pragma unroll
            for (int j = 0; j < 8; ++j) { const float br = Bb[2 * (p * 16 + c0 + j)], bi = Bb[2 * (p * 16 + c0 + j) + 1]; o[j] = im ? (pr * bi + pi * br) : (pr * br - pi * bi); }
            u32x4 q; q.x = pk2(o[0], o[1]); q.y = pk2(o[2], o[3]); q.z = pk2(o[4], o[5]); q.w = pk2(o[6], o[7]);
            *(u32x4*)(EG + ((size_t)(g * 256 + jr) * 512 + k0)) = q; }
    }
    __syncthreads();
}
__device__ __forceinline__ void rms_row_to_bf16(const float* xrow, const float* gain, bf16_t* orow, int lane) {
    const f32x4* xr = (const f32x4*)xrow + lane; const f32x4* gr = (const f32x4*)gain + lane;
    f32x4 v[4]; float s = 0.f;
#pragma unroll
    for (int j = 0; j < 4; ++j) { v[j] = xr[64 * j]; s += (v[j].x * v[j].x + v[j].y * v[j].y) + (v[j].z * v[j].z + v[j].w * v[j].w); }
    const float rstd = __builtin_amdgcn_rsqf(wave_sum(s) * (1.f / DM) + NORM_EPS);
    unsigned long long* o8 = (unsigned long long*)orow + lane;
#pragma unroll
    for (int j = 0; j < 4; ++j) { const f32x4 gv = gr[64 * j]; o8[64 * j] = (unsigned long long)pk2(v[j].x * rstd * gv.x, v[j].y * rstd * gv.y) | ((unsigned long long)pk2(v[j].z * rstd * gv.z, v[j].w * rstd * gv.w) << 32); }
}
__device__ __forceinline__ void rmsnorm_rows(Frame& F, const float* x, const float* gain, bf16_t* o) {
    const int gw = F.bid * NWAVES + F.wave, NGW = F.G * NWAVES;
    for (int m = gw; m < T; m += NGW) rms_row_to_bf16(x + (size_t)m * DM, gain, o + (size_t)m * DM, F.lane);
}

__device__ __forceinline__ void s5_scan(Frame& F, int layer) {
    const float* HL = (const float*)(F.ws + WS_HLOC); bf16_t* UH = (bf16_t*)(F.ws + WS_UH);
    for (int i = (F.G - 1 - F.bid) * NTHR + F.tid; i < BATCH * 32 * 64; i += F.G * NTHR) {
        const int p = i & 63, g = (i >> 6) & 31, b = i >> 11, gi = layer * 32 + g;
        const float dt = __expf(F.in[IN_LOGDT][gi]), lr = F.in[IN_LRE][gi * 64 + p], li = F.in[IN_LIM][gi * 64 + p];
        float s, c; sincos_red((float)S5_TC * li * dt, s, c); const float mg = __expf((float)S5_TC * lr * dt), ar = mg * c, ai = mg * s;
        float hr = 0.f, hi = 0.f;
        const int nch = SEQ / S5_TC;
        for (int c0 = 0; c0 < nch; c0 += 32) { float lr_[32], li_[32];
#pragma unroll
            for (int k = 0; k < 32; ++k) { const size_t r = (size_t)g * S5_ROWS + b * nch + c0 + k; lr_[k] = HL[r * 128 + p]; li_[k] = HL[r * 128 + 64 + p]; }
#pragma unroll
            for (int k = 0; k < 32; ++k) { const size_t r = (size_t)g * S5_ROWS + b * nch + c0 + k;
                UH[r * S5_K + p] = (bf16_t)f2bf(hr); UH[r * S5_K + 64 + p] = (bf16_t)f2bf(hi);
                const float nr = ar * hr - ai * hi + lr_[k], ni = ar * hi + ai * hr + li_[k]; hr = nr; hi = ni; } }
    }
}

__device__ __forceinline__ void ssd_stage_bc(Frame& F, int layer, int b, int ch, int grp, LAS float* Bs, LAS float* Cs, LAS float* dts, LAS float* das) {
    const bf16_t* P = (const bf16_t*)(F.ws + WS_P); const float* DT = (const float*)(F.ws + WS_DT);
    const float* cw = F.in[IN_CONVW] + layer * 4 * 1280; const float* cb = F.in[IN_CONVB] + layer * 1280;
    const int l0 = ch * 128; const size_t row0 = (size_t)b * SEQ + l0;
    for (int i = F.tid; i < 2 * 128 * 64; i += NTHR) { const int isC = i >> 13, t = (i >> 6) & 127, n = i & 63;
        const int col = (isC ? C_C : C_B) + grp * 64 + n, cc = 1024 + isC * 128 + grp * 64 + n; float a = cb[cc];
#pragma unroll
        for (int j = 0; j < 4; ++j) { const int l = l0 + t - 3 + j; if (l >= 0) a += cw[j * 1280 + cc] * bf2f(P[(row0 + t - 3 + j) * NINP + col]); }
        (isC ? Cs : Bs)[t * 64 + n] = siluf_(a); }
    for (int i = F.tid; i < 128 * 8; i += NTHR) { const int t = i >> 3, hh = i & 7, h = grp * 8 + hh;
        const float dt = softplusf_(DT[(row0 + t) * 16 + h] + F.in[IN_DTB][layer * 16 + h]); dts[i] = dt; das[i] = dt * (-__expf(F.in[IN_ALOG][layer * 16 + h])); }
}
template <bool OUT>
__device__ __forceinline__ void ssd_units(Frame& F, int layer) {
    LAS float* Bs = (LAS float*)F.lds; LAS float* Cs = Bs + 128 * 64; LAS float* dts = Cs + 128 * 64; LAS float* das = dts + 128 * 8; LAS float* ssq = das + 128 * 8;
    const bf16_t* P = (const bf16_t*)(F.ws + WS_P); float* SST = (float*)(F.ws + WS_SST); float* ASUM = (float*)(F.ws + WS_ASUM); bf16_t* YC = (bf16_t*)(F.ws + WS_YCAT);
    const float* cw = F.in[IN_CONVW] + layer * 4 * 1280; const float* cb = F.in[IN_CONVB] + layer * 1280;
    for (int u = F.bid; u < BATCH * SSD_NCH * 2; u += F.G) {
        const int grp = u & 1, ch = (u >> 1) & 31, b = u >> 6;
        __syncthreads();
        ssd_stage_bc(F, layer, b, ch, grp, Bs, Cs, dts, das);
        __syncthreads();
        const int hh = F.wave, h = grp * 8 + hh, p = F.lane, cx = h * 64 + p;
        const float w0 = cw[cx], w1 = cw[1280 + cx], w2 = cw[2560 + cx], w3 = cw[3840 + cx], bias = cb[cx], dsk = F.in[IN_SSDD][layer * 16 + h];
        const int l0 = ch * 128; const size_t row0 = (size_t)b * SEQ + l0;
        const bf16_t* xp = P + row0 * NINP + C_XS + cx;
        float x0 = 0.f, x1 = 0.f, x2 = 0.f;
        if (l0 > 0) { x0 = bf2f(xp[-3 * (ptrdiff_t)NINP]); x1 = bf2f(xp[-2 * (ptrdiff_t)NINP]); x2 = bf2f(xp[-1 * (ptrdiff_t)NINP]); }
        float st[64];
        float* sp = SST + ((((size_t)b * SSD_NCH + ch) * 16 + h) * 64 + p) * 64;
        if (OUT) {
#pragma unroll
            for (int n = 0; n < 64; n += 4) { const f32x4 v = *(const f32x4*)(sp + n); st[n] = v.x; st[n + 1] = v.y; st[n + 2] = v.z; st[n + 3] = v.w; }
        } else {
#pragma unroll
            for (int n = 0; n < 64; ++n) st[n] = 0.f;
        }
        float asum = 0.f;
#pragma unroll 4
        for (int t = 0; t < 128; ++t) {
            const float x3 = bf2f(xp[(size_t)t * NINP]);
            const float xs = siluf_(bias + w0 * x0 + w1 * x1 + w2 * x2 + w3 * x3);
            x0 = x1; x1 = x2; x2 = x3;
            const float dt = dts[t * 8 + hh], a = das[t * 8 + hh], da = __expf(a), xdt = xs * dt;
            asum += a;
            float y = 0.f;
#pragma unroll
            for (int n = 0; n < 64; n += 4) { const f32x4 bv = *(const LAS f32x4*)(Bs + t * 64 + n);
                st[n] = da * st[n] + bv.x * xdt; st[n + 1] = da * st[n + 1] + bv.y * xdt; st[n + 2] = da * st[n + 2] + bv.z * xdt; st[n + 3] = da * st[n + 3] + bv.w * xdt;
                if (OUT) { const f32x4 cv = *(const LAS f32x4*)(Cs + t * 64 + n); y += (cv.x * st[n] + cv.y * st[n + 1]) + (cv.z * st[n + 2] + cv.w * st[n + 3]); } }
            if (OUT) {
                const float z = bf2f(P[(row0 + t) * NINP + C_Z + cx]);
                const float yz = (y + dsk * xs) * siluf_(z);
                const float q = wave_sum(yz * yz);
                if (p == 0) ssq[t * 8 + hh] = q;
                YC[(row0 + t) * 2048 + 1024 + cx] = (bf16_t)f2bf(yz);
            }
        }
        if (!OUT) {
#pragma unroll
            for (int n = 0; n < 64; n += 4) *(f32x4*)(sp + n) = (f32x4){st[n], st[n + 1], st[n + 2], st[n + 3]};
            if (p == 0) ASUM[((size_t)b * SSD_NCH + ch) * 16 + h] = asum;
        } else {
            __syncthreads();
            const float ng = F.in[IN_SSDG][layer * 1024 + cx];
            for (int t = 0; t < 128; ++t) { float q = 0.f;
#pragma unroll
                for (int j = 0; j < 8; ++j) q += ssq[t * 8 + j];
                const float rs = __builtin_amdgcn_rsqf(q * (1.f / 512.f) + NORM_EPS);
                bf16_t* yp = YC + (row0 + t) * 2048 + 1024 + cx; *yp = (bf16_t)f2bf(bf2f(*yp) * rs * ng); }
        }
    }
}
__device__ __forceinline__ void ssd_scan(Frame& F) {
    bf16_t* SST = (bf16_t*)(F.ws + WS_SST); const float* ASUM = (const float*)(F.ws + WS_ASUM);
    for (int i = F.bid * NTHR + F.tid; i < BATCH * 16 * 512; i += F.G * NTHR) {
        const int pn = (i & 511) * 8, h = (i >> 9) & 15, b = i >> 13; float s[8];
#pragma unroll
        for (int j = 0; j < 8; ++j) s[j] = 0.f;
        u32x4 loc[SSD_NCH]; float dec[SSD_NCH];
#pragma unroll
        for (int ch = 0; ch < SSD_NCH; ++ch) { loc[ch] = *(const u32x4*)(SST + (((size_t)b * SSD_NCH + ch) * 16 + h) * 4096 + pn); dec[ch] = ASUM[((size_t)b * SSD_NCH + ch) * 16 + h]; }
#pragma unroll
        for (int ch = 0; ch < SSD_NCH; ++ch) { u32x4 o; o.x = pk2(s[0], s[1]); o.y = pk2(s[2], s[3]); o.z = pk2(s[4], s[5]); o.w = pk2(s[6], s[7]);
            *(u32x4*)(SST + (((size_t)b * SSD_NCH + ch) * 16 + h) * 4096 + pn) = o; const float d = __expf(dec[ch]);
#pragma unroll
            for (int j = 0; j < 4; ++j) { s[2 * j] = s[2 * j] * d + bflo(loc[ch][j]); s[2 * j + 1] = s[2 * j + 1] * d + bfhi(loc[ch][j]); } }
    }
}

__device__ __forceinline__ void attn_units(Frame& F, int layer) {
    LAS float* Ks = (LAS float*)F.lds; LAS float* Vs = Ks + 256 * 64;
    const bf16_t* P = (const bf16_t*)(F.ws + WS_P); bf16_t* YC = (bf16_t*)(F.ws + WS_YCAT);
    const float* qg = F.in[IN_QG] + layer * 64; const float* kg = F.in[IN_KG] + layer * 64;
    for (int u = F.bid; u < BATCH * 32 * 2; u += F.G) {
        const int kvh = u & 1, qb = (u >> 1) & 31, b = u >> 6, q0 = qb * 128;
        int lane = F.lane; asm volatile("" : "+v"(lane));
        __syncthreads();
        for (int jr = F.wave; jr < 256; jr += NWAVES) { const int l = q0 - 128 + jr; float kv = 0.f, vv = 0.f;
            if (l >= 0) { const size_t row = (size_t)b * SEQ + l; const float x = bf2f(P[row * NINP + C_K + kvh * 64 + lane]); vv = bf2f(P[row * NINP + C_V + kvh * 64 + lane]);
                const float rs = __builtin_amdgcn_rsqf(wave_sum(x * x) * (1.f / 64.f) + NORM_EPS); const float xn = x * rs * kg[lane];
                const float other = __shfl_xor(xn, 32); const int i = lane & 31; const float inv = exp2f(-(float)i * (13.287712379549449f / 32.f));
                float s, c; sincos_fast((float)l * inv, s, c);
                kv = (lane < 32) ? (xn * c - other * s) : (xn * c + other * s); }
            Ks[jr * 64 + lane] = kv; Vs[jr * 64 + lane] = vv; }
        __syncthreads();
        const int hh = F.wave >> 1, head = kvh * 4 + hh, qi = q0 + (F.wave & 1) * 64 + lane; const size_t row = (size_t)b * SEQ + qi;
        float q[64];
        { const u32x4* qp = (const u32x4*)(P + row * NINP + C_Q + head * 64); float ss = 0.f;
#pragma unroll
          for (int j = 0; j < 8; ++j) { const u32x4 w = qp[j];
#pragma unroll
              for (int e = 0; e < 4; ++e) { q[8 * j + 2 * e] = bflo(w[e]); q[8 * j + 2 * e + 1] = bfhi(w[e]); } }
#pragma unroll
          for (int d = 0; d < 64; ++d) ss += q[d] * q[d];
          const float rs = __builtin_amdgcn_rsqf(ss * (1.f / 64.f) + NORM_EPS);
#pragma unroll
          for (int d = 0; d < 64; ++d) q[d] = q[d] * rs * qg[d];
#pragma unroll
          for (int i = 0; i < 32; ++i) { const float inv = exp2f(-(float)i * (13.287712379549449f / 32.f)); float s, c; sincos_fast((float)qi * inv, s, c);
              const float a = q[i], bq = q[i + 32]; q[i] = (a * c - bq * s) * 0.125f; q[i + 32] = (bq * c + a * s) * 0.125f; } }
        float o[64];
#pragma unroll
        for (int d = 0; d < 64; ++d) o[d] = 0.f;
        float mx = F.in[IN_SINK][layer * 8 + head], l = 1.f;
        const int qa = q0 + (F.wave & 1) * 64;
        int jlo = qa - 127 - (q0 - 128); if (q0 == 0 && jlo < 128) jlo = 128; const int jhi = qa + 63 - (q0 - 128);
        for (int jr = jlo; jr <= jhi; ++jr) { const int j = q0 - 128 + jr; const bool ok = (j <= qi) && (qi - j < 128);
            float s = 0.f;
#pragma unroll
            for (int d = 0; d < 64; d += 4) { const f32x4 kv = *(const LAS f32x4*)(Ks + jr * 64 + d); s += (q[d] * kv.x + q[d + 1] * kv.y) + (q[d + 2] * kv.z + q[d + 3] * kv.w); if ((d & 12) == 12) __builtin_amdgcn_sched_barrier(0); }
            if (ok) { const float mn = fmaxf(mx, s), al = __expf(mx - mn), pe = __expf(s - mn); l = l * al + pe; mx = mn;
#pragma unroll
                for (int d = 0; d < 64; d += 4) { const f32x4 vv = *(const LAS f32x4*)(Vs + jr * 64 + d); o[d] = o[d] * al + pe * vv.x; o[d + 1] = o[d + 1] * al + pe * vv.y; o[d + 2] = o[d + 2] * al + pe * vv.z; o[d + 3] = o[d + 3] * al + pe * vv.w; if ((d & 12) == 12) __builtin_amdgcn_sched_barrier(0); } } }
        const float il = 1.f / l; u32x4* op = (u32x4*)(YC + row * 2048 + 512 + head * 64);
#pragma unroll
        for (int j = 0; j < 8; ++j) { u32x4 w; w.x = pk2(o[8 * j] * il, o[8 * j + 1] * il); w.y = pk2(o[8 * j + 2] * il, o[8 * j + 3] * il); w.z = pk2(o[8 * j + 4] * il, o[8 * j + 5] * il); w.w = pk2(o[8 * j + 6] * il, o[8 * j + 7] * il); op[j] = w; }
    }
}

typedef short bf16x8_t __attribute__((ext_vector_type(8)));
__device__ __forceinline__ void split_hi_lo(const f32x4 a, const f32x4 b, bf16x8& hi, bf16x8& lo) {
    u32x4 h; h.x = cvtpk(a.x, a.y); h.y = cvtpk(a.z, a.w); h.z = cvtpk(b.x, b.y); h.w = cvtpk(b.z, b.w);
    u32x4 l; l.x = cvtpk(a.x - bflo(h.x), a.y - bfhi(h.x)); l.y = cvtpk(a.z - bflo(h.y), a.w - bfhi(h.y)); l.z = cvtpk(b.x - bflo(h.z), b.y - bfhi(h.z)); l.w = cvtpk(b.z - bflo(h.w), b.w - bfhi(h.w));
    hi = __builtin_bit_cast(bf16x8, h); lo = __builtin_bit_cast(bf16x8, l);
}
__device__ __forceinline__ void router_phase(Frame& F, int layer) {
    constexpr int WROW = 2064;
    LAS unsigned char* Whi = F.lds; LAS unsigned char* Wlo = F.lds + 36 * WROW;
    LAS float* part = (LAS float*)F.lds;
    volatile LAS unsigned* lcnt = (volatile LAS unsigned*)(F.lds + 148 * 1024);
    const float* wrg = F.in[IN_WRG] + (size_t)layer * 1024 * 4; const float* wre = F.in[IN_WRE] + (size_t)layer * 1024 * 32; const float* gain = F.in[IN_NORM2] + layer * 1024;
    const float* X = F.out; bf16_t* H2 = (bf16_t*)(F.ws + WS_XN);
    int* EID = (int*)(F.ws + WS_MOE); float* EW = (float*)(F.ws + WS_MOE + 128 * 1024); int* SLOT = (int*)(F.ws + WS_MOE + 256 * 1024); float* RS = (float*)(F.ws + WS_MOE + 640 * 1024);
    __syncthreads();
    for (int k = F.tid; k < 1024; k += NTHR) { const float g = gain[k]; const f32x4 wg = *(const f32x4*)(wrg + k * 4);
        float w[36]; w[0] = wg.x; w[1] = wg.y; w[2] = wg.z; w[3] = wg.w;
#pragma unroll
        for (int q = 0; q < 8; ++q) { const f32x4 v = *(const f32x4*)(wre + k * 32 + 4 * q); w[4 + 4 * q] = v.x; w[5 + 4 * q] = v.y; w[6 + 4 * q] = v.z; w[7 + 4 * q] = v.w; }
#pragma unroll
        for (int e = 0; e < 36; ++e) { const float x = w[e] * g; const unsigned h = f2bf(x); const unsigned l = f2bf(x - bf2f(h));
            *(LAS unsigned short*)(Whi + e * WROW + k * 2) = (unsigned short)h; *(LAS unsigned short*)(Wlo + e * WROW + k * 2) = (unsigned short)l; } }
    if (F.tid < 32) lcnt[F.tid] = 0u;
    __syncthreads();
    const int TPB = T / F.G;
    int lane = F.lane; asm volatile("" : "+v"(lane));
    const int mt = F.wave & 3, kh = F.wave >> 2, row = lane & 15, kg = lane >> 4;
    const int m = F.bid * TPB + 16 * mt + row;
    f32x4 acc[3] = {{0.f, 0.f, 0.f, 0.f}, {0.f, 0.f, 0.f, 0.f}, {0.f, 0.f, 0.f, 0.f}}; float ss = 0.f;
    int er[3]; er[0] = row; er[1] = 16 + row; er[2] = (32 + row < 36) ? 32 + row : 35;
    if (kh == 0)
#pragma unroll 1
    for (int kb = 0; kb < 4; ++kb) {
        f32x4 xa[8][2];
#pragma unroll
        for (int ks = 0; ks < 8; ++ks) { const float* xp = X + (size_t)m * DM + 256 * kb + 32 * ks + 8 * kg; xa[ks][0] = *(const f32x4*)xp; xa[ks][1] = *(const f32x4*)(xp + 4); }
#pragma unroll
        for (int ks = 0; ks < 8; ++ks) { const int k0 = 256 * kb + 32 * ks + 8 * kg;
            const f32x4 a = xa[ks][0], b = xa[ks][1];
            ss += (a.x * a.x + a.y * a.y) + (a.z * a.z + a.w * a.w) + (b.x * b.x + b.y * b.y) + (b.z * b.z + b.w * b.w);
            bf16x8 ah, al; split_hi_lo(a, b, ah, al);
#pragma unroll
            for (int nt = 0; nt < 3; ++nt) { const bf16x8 bh = *(const LAS bf16x8*)(Whi + er[nt] * WROW + k0 * 2), bl = *(const LAS bf16x8*)(Wlo + er[nt] * WROW + k0 * 2);
                acc[nt] = __builtin_amdgcn_mfma_f32_16x16x32_bf16(ah, bh, acc[nt], 0, 0, 0);
                acc[nt] = __builtin_amdgcn_mfma_f32_16x16x32_bf16(ah, bl, acc[nt], 0, 0, 0);
                acc[nt] = __builtin_amdgcn_mfma_f32_16x16x32_bf16(al, bh, acc[nt], 0, 0, 0); } }
    }
    ss += __shfl_xor(ss, 16); ss += __shfl_xor(ss, 32);
    __syncthreads();
    LAS float* ssq = part + 4 * 3 * 64 * 4; LAS float* lg = ssq + 128; volatile LAS int* elist = (volatile LAS int*)(lg + 64 * 40);
    if (kh == 0) {
        const float rstd_row = __builtin_amdgcn_rsqf(ss * (1.f / DM) + NORM_EPS);
        if (kg == 0) { ssq[64 + 16 * mt + row] = rstd_row; RS[m] = rstd_row; }
    }
    __syncthreads();
    if (kh == 0) {
#pragma unroll
        for (int nt = 0; nt < 3; ++nt)
#pragma unroll
            for (int rg = 0; rg < 4; ++rg) { const int e = row + 16 * nt, tk = 16 * mt + 4 * kg + rg; if (e < 36) lg[tk * 40 + e] = acc[nt][rg] * ssq[64 + tk]; }
    }
    __syncthreads();
    if (F.tid < TPB) { const int tk = F.tid, mm = F.bid * TPB + tk; const LAS float* L = lg + tk * 40;
        float gl[4];
#pragma unroll
        for (int k = 0; k < 4; ++k) gl[k] = L[k] + F.in[IN_BRG][layer * 4 + k];
        int gs = 0; float gbest = gl[0];
#pragma unroll
        for (int k = 1; k < 4; ++k) if (gl[k] > gbest) { gbest = gl[k]; gs = k; }
        float den = 0.f;
#pragma unroll
        for (int k = 0; k < 4; ++k) den += __expf(gl[k] - gbest);
        const float pgrp = 1.f / den;
        float el[8];
#pragma unroll
        for (int k = 0; k < 8; ++k) el[k] = L[4 + gs * 8 + k] + F.in[IN_BRE_][layer * 32 + gs * 8 + k];
        int i0 = 0; float v0 = el[0];
#pragma unroll
        for (int k = 1; k < 8; ++k) if (el[k] > v0) { v0 = el[k]; i0 = k; }
        int i1 = -1; float v1 = -3.0e38f;
#pragma unroll
        for (int k = 0; k < 8; ++k) if (k != i0 && el[k] > v1) { v1 = el[k]; i1 = k; }
        const float e1 = __expf(v1 - v0), w0 = pgrp / (1.f + e1), w1 = pgrp * e1 / (1.f + e1);
        const int ea = gs * 8 + i0, eb = gs * 8 + i1;
        EID[2 * mm] = ea; EID[2 * mm + 1] = eb; EW[2 * mm] = w0; EW[2 * mm + 1] = w1;
        elist[2 * tk] = ea; elist[2 * tk + 1] = eb;
    }
    __syncthreads();
    if (F.tid < 32) { const int e = F.tid; int c = 0;
        for (int i = 0; i < 2 * TPB; ++i) { if (elist[i] == e) { SLOT[2 * (F.bid * TPB) + i] = c; ++c; } }
        ((unsigned*)(F.ws + WS_MOE + 512 * 1024))[(size_t)F.bid * 32 + e] = (unsigned)c; }
    __syncthreads();
}
__device__ __forceinline__ int moe_tables(Frame& F, int layer, volatile LAS int* offs, volatile LAS int* tile_e) {
    volatile LAS int* psum = offs + 256;
    const unsigned* CNTB = (const unsigned*)(F.ws + WS_MOE + 512 * 1024);
    __syncthreads();
    { const int e = F.tid & 31, part = F.tid >> 5; int tot = 0, pre = 0; const int per = (F.G + 15) / 16;
      for (int bb = part * per; bb < (part + 1) * per && bb < F.G; ++bb) { const int c = (int)CNTB[(size_t)bb * 32 + e]; tot += c; pre += (bb < F.bid) ? c : 0; }
      psum[part * 32 + e] = tot; psum[512 + part * 32 + e] = pre; }
    __syncthreads();
    if (F.tid < 64) {
        int c = 0, pre = 0;
        if (F.tid < 32) for (int part = 0; part < 16; ++part) { c += psum[part * 32 + F.tid]; pre += psum[512 + part * 32 + F.tid]; }
        const int tl = (c + 255) >> 8; int incl = tl;
#pragma unroll
        for (int o = 1; o < 32; o <<= 1) { const int v = __shfl_up(incl, o); if (F.tid >= o) incl += v; }
        const int excl = incl - tl;
        if (F.tid < 32) { offs[F.tid] = excl * 256 + pre; for (int k = 0; k < tl; ++k) tile_e[excl + k] = F.tid; }
        if (F.tid == 31) offs[32] = incl;
    }
    __syncthreads();
    return __builtin_amdgcn_readfirstlane(offs[32]);
}
__device__ __forceinline__ void gather_phase(Frame& F, int layer, volatile LAS int* offs) {
    const float* X = F.out; const float* gain = F.in[IN_NORM2] + layer * 1024; const float* RS = (const float*)(F.ws + WS_MOE + 640 * 1024); bf16_t* XG = (bf16_t*)(F.ws + WS_XG);
    const int* EID = (const int*)(F.ws + WS_MOE); const int* SLOT = (const int*)(F.ws + WS_MOE + 256 * 1024); int* POS = (int*)(F.ws + WS_MOE + 384 * 1024);
    const int TPB = T / F.G;
    for (int m = F.bid * TPB + F.wave; m < (F.bid + 1) * TPB; m += NWAVES) {
        const f32x4* xr = (const f32x4*)(X + (size_t)m * DM) + F.lane; const f32x4* gr = (const f32x4*)gain + F.lane; const float rs = RS[m];
        u32x2 o[4];
#pragma unroll
        for (int j = 0; j < 4; ++j) { const f32x4 v = xr[64 * j], g = gr[64 * j]; o[j].x = pk2(v.x * rs * g.x, v.y * rs * g.y); o[j].y = pk2(v.z * rs * g.z, v.w * rs * g.w); }
#pragma unroll
        for (int k = 0; k < 2; ++k) { const int pos = offs[EID[2 * m + k]] + SLOT[2 * m + k]; u32x2* dst = (u32x2*)(XG + (size_t)pos * DM) + F.lane;
#pragma unroll
            for (int j = 0; j < 4; ++j) dst[64 * j] = o[j];
            if (F.lane == 0) POS[2 * m + k] = pos; }
    }
}
__device__ __forceinline__ void combine_phase(Frame& F, const float* gain_next, bool dry = false) {
    const bf16_t* Y = (const bf16_t*)(F.ws + WS_YEXP); const float* EW = (const float*)(F.ws + WS_MOE + 128 * 1024); const int* POS = (const int*)(F.ws + WS_MOE + 384 * 1024);
    bf16_t* XN = (bf16_t*)(F.ws + WS_XN);
    const int gw = F.bid * NWAVES + F.wave, NGW = F.G * NWAVES;
    for (int m = gw; m < T; m += NGW) {
        const float w0 = EW[2 * m], w1 = EW[2 * m + 1]; const int p0 = POS[2 * m], p1 = POS[2 * m + 1];
        f32x4* xr = (f32x4*)(F.out + (size_t)m * DM) + F.lane;
        const u32x2* y0 = (const u32x2*)(Y + (size_t)p0 * DM) + F.lane; const u32x2* y1 = (const u32x2*)(Y + (size_t)p1 * DM) + F.lane;
        f32x4 v[4]; float s = 0.f;
#pragma unroll
        for (int j = 0; j < 4; ++j) { v[j] = xr[64 * j]; const u32x2 a = y0[64 * j], b = y1[64 * j];
            v[j].x += w0 * bflo(a.x) + w1 * bflo(b.x); v[j].y += w0 * bfhi(a.x) + w1 * bfhi(b.x); v[j].z += w0 * bflo(a.y) + w1 * bflo(b.y); v[j].w += w0 * bfhi(a.y) + w1 * bfhi(b.y);
            if (!dry) xr[64 * j] = v[j]; s += (v[j].x * v[j].x + v[j].y * v[j].y) + (v[j].z * v[j].z + v[j].w * v[j].w); }
        if (gain_next) { const float rstd = __builtin_amdgcn_rsqf(wave_sum(s) * (1.f / DM) + NORM_EPS); const f32x4* gr = (const f32x4*)gain_next + F.lane;
            unsigned long long* o8 = (unsigned long long*)(XN + (size_t)m * DM) + F.lane;
#pragma unroll
            for (int j = 0; j < 4; ++j) { const f32x4 gv = gr[64 * j]; o8[64 * j] = (unsigned long long)pk2(v[j].x * rstd * gv.x, v[j].y * rstd * gv.y) | ((unsigned long long)pk2(v[j].z * rstd * gv.z, v[j].w * rstd * gv.w) << 32); } }
    }
}

__device__ __forceinline__ int crow32(int reg, int hh) { return (reg & 3) + 8 * (reg >> 2) + 4 * hh; }
__device__ __forceinline__ float wave_incl_scan(float v, int lane) {
#pragma unroll
    for (int o = 1; o < 64; o <<= 1) { const float t = __shfl_up(v, o); if (lane >= o) v += t; }
    return v;
}
__device__ __forceinline__ void conv_frag(const LAS unsigned char* raw, int chan, int ks, int hh, float w0, float w1, float w2, float w3, float bias, float (&out)[8]) {
#pragma unroll
    for (int run = 0; run < 2; ++run) { const int lb = 16 * ks + 8 * run + 4 * hh; float x[7];
#pragma unroll
        for (int i = 0; i < 7; ++i) x[i] = bf2f(*(const LAS unsigned short*)(raw + (lb + i) * 128 + chan * 2));
#pragma unroll
        for (int j = 0; j < 4; ++j) out[4 * run + j] = siluf_(bias + w0 * x[j] + w1 * x[j + 1] + w2 * x[j + 2] + w3 * x[j + 3]); }
}
constexpr int RAWT = 131 * 128;
__device__ __forceinline__ void stage_raw(const bf16_t* P, size_t row0, int l0, int col, LAS unsigned char* dst, int idx0, int stride) {
    for (int idx = idx0; idx < 131 * 8; idx += stride) { const int r = idx >> 3, c8 = idx & 7; u32x4 v = (u32x4){0u, 0u, 0u, 0u};
        if (l0 - 3 + r >= 0) v = *(const u32x4*)(P + (row0 + r - 3) * NINP + col + c8 * 8);
        *(LAS u32x4*)(dst + r * 128 + c8 * 16) = v; }
}
__device__ __forceinline__ bf16_t* xf_base(unsigned char* ws, int b, int ch, int h) { return (bf16_t*)(ws + ((b < 2) ? WS_XN : WS_SST) + 16 * MiB) + ((size_t)(((b & 1) * SSD_NCH + ch) * 16 + h)) * 8192; }
__device__ __forceinline__ void ssdA_mfma(Frame& F, int layer) {
    const bf16_t* P = (const bf16_t*)(F.ws + WS_P); const float* DT = (const float*)(F.ws + WS_DT); bf16_t* SST = (bf16_t*)(F.ws + WS_SST); float* ASUM = (float*)(F.ws + WS_ASUM);
    const float* cw = F.in[IN_CONVW] + layer * 4 * 1280; const float* cb = F.in[IN_CONVB] + layer * 1280;
    LAS unsigned char* rawX = F.lds + F.wave * RAWT; LAS unsigned char* rawB = F.lds + 8 * RAWT; LAS float* ftab = (LAS float*)(F.lds + 9 * RAWT) + F.wave * 128;
    for (int u = F.bid; u < BATCH * SSD_NCH * 2; u += F.G) {
        const int grp = u & 1, ch = (u >> 1) & 31, b = u >> 6, h = grp * 8 + F.wave, l0 = ch * 128; const size_t row0 = (size_t)b * SEQ + l0;
        int lane = F.lane; asm volatile("" : "+v"(lane));
        const int r = lane & 31, hh = lane >> 5;
        __syncthreads();
        stage_raw(P, row0, l0, C_XS + h * 64, rawX, lane, 64);
        stage_raw(P, row0, l0, C_B + grp * 64, rawB, F.tid, NTHR);
        { const float dtb = F.in[IN_DTB][layer * 16 + h], A = -__expf(F.in[IN_ALOG][layer * 16 + h]);
          const float dt0 = softplusf_(DT[(row0 + lane) * 16 + h] + dtb), dt1 = softplusf_(DT[(row0 + 64 + lane) * 16 + h] + dtb);
          const float s0 = wave_incl_scan(dt0 * A, lane); const float tot0 = __builtin_bit_cast(float, __builtin_amdgcn_readlane(__builtin_bit_cast(int, s0), 63));
          const float s1 = wave_incl_scan(dt1 * A, lane) + tot0; const float tot = __builtin_bit_cast(float, __builtin_amdgcn_readlane(__builtin_bit_cast(int, s1), 63));
          ftab[lane] = dt0 * __expf(tot - s0); ftab[64 + lane] = dt1 * __expf(tot - s1);
          if (lane == 0) ASUM[((size_t)b * SSD_NCH + ch) * 16 + h] = tot; }
        __syncthreads();
        bf16x8 bfr[2];
#pragma unroll
        for (int q = 0; q < 2; ++q) { const int idx = F.wave * 2 + q, nt = idx >> 3, ks = idx & 7, cc = 1024 + grp * 64 + 32 * nt + r; float v[8];
            conv_frag(rawB, 32 * nt + r, ks, hh, cw[cc], cw[1280 + cc], cw[2560 + cc], cw[3840 + cc], cb[cc], v); bfr[q] = pack8v(v); }
        bf16x8 xw[2][8];
        bf16_t* xf = xf_base(F.ws, b, ch, h);
#pragma unroll
        for (int pt = 0; pt < 2; ++pt) { const int cx = h * 64 + 32 * pt + r; const float w0 = cw[cx], w1 = cw[1280 + cx], w2 = cw[2560 + cx], w3 = cw[3840 + cx], bias = cb[cx];
#pragma unroll
            for (int ks = 0; ks < 8; ++ks) { float v[8]; conv_frag(rawX, 32 * pt + r, ks, hh, w0, w1, w2, w3, bias, v);
                *(bf16x8*)(xf + ((pt * 8 + ks) * 64 + lane) * 8) = pack8v(v);
                const f32x4 fa = *(const LAS f32x4*)(ftab + 16 * ks + 4 * hh), fb = *(const LAS f32x4*)(ftab + 16 * ks + 8 + 4 * hh);
                v[0] *= fa.x; v[1] *= fa.y; v[2] *= fa.z; v[3] *= fa.w; v[4] *= fb.x; v[5] *= fb.y; v[6] *= fb.z; v[7] *= fb.w; { u32x4 pq = __builtin_bit_cast(u32x4, pack8v(v)); asm volatile("" : "+v"(pq) :: "memory"); xw[pt][ks] = __builtin_bit_cast(bf16x8, pq); } } }
        __syncthreads();
#pragma unroll
        for (int q = 0; q < 2; ++q) *(LAS bf16x8*)(rawB + (F.wave * 2 + q) * 1024 + lane * 16) = bfr[q];
        __syncthreads();
        f32x16 acc[2][2];
#pragma unroll
        for (int pt = 0; pt < 2; ++pt)
#pragma unroll
            for (int nt = 0; nt < 2; ++nt)
#pragma unroll
                for (int i = 0; i < 16; ++i) acc[pt][nt][i] = 0.f;
#pragma unroll
        for (int ks = 0; ks < 8; ++ks)
#pragma unroll
            for (int nt = 0; nt < 2; ++nt) { const bf16x8 bq = *(const LAS bf16x8*)(rawB + (nt * 8 + ks) * 1024 + lane * 16);
#pragma unroll
                for (int pt = 0; pt < 2; ++pt) acc[pt][nt] = MFMA32(xw[pt][ks], bq, acc[pt][nt]); }
        bf16_t* sp = SST + (((size_t)b * SSD_NCH + ch) * 16 + h) * 4096;
#pragma unroll
        for (int pt = 0; pt < 2; ++pt)
#pragma unroll
            for (int nt = 0; nt < 2; ++nt)
#pragma unroll
                for (int i = 0; i < 16; ++i) sp[(32 * pt + crow32(i, hh)) * 64 + 32 * nt + r] = (bf16_t)f2bf(acc[pt][nt][i]);
    }
}
__device__ __forceinline__ void ssdC_mfma(Frame& F, int layer) {
    const bf16_t* P = (const bf16_t*)(F.ws + WS_P); const float* DT = (const float*)(F.ws + WS_DT); const bf16_t* SST = (const bf16_t*)(F.ws + WS_SST); bf16_t* YC = (bf16_t*)(F.ws + WS_YCAT);
    const float* cw = F.in[IN_CONVW] + layer * 4 * 1280; const float* cb = F.in[IN_CONVB] + layer * 1280;
    LAS unsigned char* rawX = F.lds + F.wave * RAWT;
    LAS unsigned char* Bn = F.lds; LAS unsigned char* Cn = F.lds + 18432;
    LAS float* atab = (LAS float*)(F.lds + 36864) + F.wave * 128; LAS float* dtab = (LAS float*)(F.lds + 40960) + F.wave * 128;
    LAS float* ssqp = (LAS float*)(F.lds + 45056); LAS float* gtab = (LAS float*)(F.lds + 49152) + F.wave * 64;
    LAS unsigned char* zt = F.lds + 51200 + F.wave * 4608;
    for (int u = F.bid; u < BATCH * SSD_NCH * 2; u += F.G) {
        const int grp = u & 1, ch = (u >> 1) & 31, b = u >> 6, h = grp * 8 + F.wave, l0 = ch * 128; const size_t row0 = (size_t)b * SEQ + l0;
        int lane = F.lane; asm volatile("" : "+v"(lane));
        const int r = lane & 31, hh = lane >> 5;
        bf16x8 xsf[2][8];
        { const bf16_t* xf = xf_base(F.ws, b, ch, h);
#pragma unroll
          for (int pt = 0; pt < 2; ++pt)
#pragma unroll
              for (int ks = 0; ks < 8; ++ks) xsf[pt][ks] = *(const bf16x8*)(xf + ((pt * 8 + ks) * 64 + lane) * 8); }
        __syncthreads();
        for (int it = F.tid; it < 128 * 16; it += NTHR) { const int l = it >> 4, c8 = it & 15, isC = c8 >> 3, col = (isC ? C_C : C_B) + grp * 64 + (c8 & 7) * 8, cc = 1024 + isC * 128 + grp * 64 + (c8 & 7) * 8;
            float a[8];
#pragma unroll
            for (int e = 0; e < 8; ++e) a[e] = cb[cc + e];
#pragma unroll
            for (int j = 0; j < 4; ++j) { if (l0 + l - 3 + j >= 0) { const u32x4 xv = *(const u32x4*)(P + (row0 + l - 3 + j) * NINP + col);
#pragma unroll
                for (int e = 0; e < 4; ++e) { a[2 * e] += cw[j * 1280 + cc + 2 * e] * bflo(xv[e]); a[2 * e + 1] += cw[j * 1280 + cc + 2 * e + 1] * bfhi(xv[e]); } } }
            u32x4 o; o.x = cvtpk(siluf_(a[0]), siluf_(a[1])); o.y = cvtpk(siluf_(a[2]), siluf_(a[3])); o.z = cvtpk(siluf_(a[4]), siluf_(a[5])); o.w = cvtpk(siluf_(a[6]), siluf_(a[7]));
            *(LAS u32x4*)((isC ? Cn : Bn) + l * 144 + (c8 & 7) * 16) = o; }
        { const float dtb = F.in[IN_DTB][layer * 16 + h], A = -__expf(F.in[IN_ALOG][layer * 16 + h]);
          const float dt0 = softplusf_(DT[(row0 + lane) * 16 + h] + dtb), dt1 = softplusf_(DT[(row0 + 64 + lane) * 16 + h] + dtb);
          const float s0 = wave_incl_scan(dt0 * A, lane); const float tot0 = __builtin_bit_cast(float, __builtin_amdgcn_readlane(__builtin_bit_cast(int, s0), 63));
          const float s1 = wave_incl_scan(dt1 * A, lane) + tot0;
          atab[lane] = s0; atab[64 + lane] = s1; dtab[lane] = dt0; dtab[64 + lane] = dt1; gtab[lane] = F.in[IN_SSDG][layer * 1024 + h * 64 + lane]; }
        const bf16_t* sp = SST + (((size_t)b * SSD_NCH + ch) * 16 + h) * 4096;
        const float dsk = F.in[IN_SSDD][layer * 16 + h];
        LAS unsigned char* pf = F.lds + 90112 + F.wave * 8192;
#pragma unroll
        for (int pt = 0; pt < 2; ++pt)
#pragma unroll
            for (int ks = 0; ks < 4; ++ks) *(LAS bf16x8*)(pf + ((pt * 4 + ks) * 64 + lane) * 16) = *(const bf16x8*)(sp + (32 * pt + r) * 64 + 16 * ks + 8 * hh);
        __syncthreads();
#pragma unroll 1
        for (int li = 0; li < 4; ++li) {
            const size_t rowt = row0 + 32 * li;
            u32x4 zreg[4];
#pragma unroll
            for (int q = 0; q < 4; ++q) { const int idx = lane + 64 * q, rr = idx >> 3, c8 = idx & 7; zreg[q] = *(const u32x4*)(P + (rowt + rr) * NINP + C_Z + h * 64 + c8 * 8); }
            bf16x8 Cf[4];
#pragma unroll
            for (int ks = 0; ks < 4; ++ks) Cf[ks] = *(const LAS bf16x8*)(Cn + (32 * li + r) * 144 + (16 * ks + 8 * hh) * 2);
            f32x16 acc[2];
#pragma unroll
            for (int pt = 0; pt < 2; ++pt)
#pragma unroll
                for (int i = 0; i < 16; ++i) acc[pt][i] = 0.f;
#pragma unroll
            for (int ks = 0; ks < 4; ++ks)
#pragma unroll
                for (int pt = 0; pt < 2; ++pt) acc[pt] = MFMA32(*(const LAS bf16x8*)(pf + ((pt * 4 + ks) * 64 + lane) * 16), Cf[ks], acc[pt]);
            const float al = atab[32 * li + r], el = __expf(al); const int lrel = 32 * li + r;
#pragma unroll
            for (int pt = 0; pt < 2; ++pt)
#pragma unroll
                for (int i = 0; i < 16; ++i) acc[pt][i] *= el;
#pragma unroll
            for (int si = 0; si < 4; ++si) if (si <= li) {
                f32x16 X;
#pragma unroll
                for (int i = 0; i < 16; ++i) X[i] = 0.f;
#pragma unroll
                for (int ks = 0; ks < 4; ++ks) { const bf16x8 Bq = *(const LAS bf16x8*)(Bn + (32 * si + r) * 144 + (16 * ks + 8 * hh) * 2); X = MFMA32(Bq, Cf[ks], X); }
#pragma unroll
                for (int g4 = 0; g4 < 4; ++g4) { const int sb = 32 * si + 8 * g4 + 4 * hh; const f32x4 av = *(const LAS f32x4*)(atab + sb), dv = *(const LAS f32x4*)(dtab + sb);
#pragma unroll
                    for (int j = 0; j < 4; ++j) { const int s = sb + j; float arg = al - av[j]; if (si == li && s > lrel) arg = -100.f;
                        float x = X[4 * g4 + j] * (__expf(arg) * dv[j]); if (si == li && s > lrel) x = 0.f; if (si == li && s == lrel) x += dsk; X[4 * g4 + j] = x; } }
#pragma unroll
                for (int kq = 0; kq < 2; ++kq) { const float v[8] = {X[8 * kq], X[8 * kq + 1], X[8 * kq + 2], X[8 * kq + 3], X[8 * kq + 4], X[8 * kq + 5], X[8 * kq + 6], X[8 * kq + 7]}; const bf16x8 Xf = pack8v(v);
#pragma unroll
                    for (int pt = 0; pt < 2; ++pt) { bf16x8 a;
#pragma unroll
                        for (int q = 0; q < 4; ++q) a = (si == q) ? xsf[pt][2 * q + kq] : a;
                        acc[pt] = MFMA32(a, Xf, acc[pt]); } }
            }
#pragma unroll
            for (int q = 0; q < 4; ++q) { const int idx = lane + 64 * q, rr = idx >> 3, c8 = idx & 7; *(LAS u32x4*)(zt + rr * 144 + c8 * 16) = zreg[q]; }
            float qs = 0.f;
#pragma unroll
            for (int pt = 0; pt < 2; ++pt)
#pragma unroll
                for (int g4 = 0; g4 < 4; ++g4) { const u32x2 zz = *(const LAS u32x2*)(zt + r * 144 + (32 * pt + 8 * g4 + 4 * hh) * 2);
                    const float z0 = bflo(zz.x), z1 = bfhi(zz.x), z2 = bflo(zz.y), z3 = bfhi(zz.y);
                    float y0 = acc[pt][4 * g4] * siluf_(z0), y1 = acc[pt][4 * g4 + 1] * siluf_(z1), y2 = acc[pt][4 * g4 + 2] * siluf_(z2), y3 = acc[pt][4 * g4 + 3] * siluf_(z3);
                    acc[pt][4 * g4] = y0; acc[pt][4 * g4 + 1] = y1; acc[pt][4 * g4 + 2] = y2; acc[pt][4 * g4 + 3] = y3; qs += (y0 * y0 + y1 * y1) + (y2 * y2 + y3 * y3); }
            qs += __shfl_xor(qs, 32);
            if (hh == 0) ssqp[(32 * li + r) * 8 + F.wave] = qs;
            __syncthreads();
            { const f32x4 qa = *(const LAS f32x4*)(ssqp + (32 * li + r) * 8), qb = *(const LAS f32x4*)(ssqp + (32 * li + r) * 8 + 4);
              const float rs = __builtin_amdgcn_rsqf(((qa.x + qa.y) + (qa.z + qa.w) + (qb.x + qb.y) + (qb.z + qb.w)) * (1.f / 512.f) + NORM_EPS);
#pragma unroll
              for (int pt = 0; pt < 2; ++pt)
#pragma unroll
                  for (int g4 = 0; g4 < 4; ++g4) { const int p0 = 32 * pt + 8 * g4 + 4 * hh; const f32x4 gv = *(const LAS f32x4*)(gtab + p0);
                      u32x2 o; o.x = cvtpk(acc[pt][4 * g4] * rs * gv.x, acc[pt][4 * g4 + 1] * rs * gv.y); o.y = cvtpk(acc[pt][4 * g4 + 2] * rs * gv.z, acc[pt][4 * g4 + 3] * rs * gv.w);
                      *(LAS u32x2*)(zt + r * 144 + p0 * 2) = o; } }
#pragma unroll
            for (int q = 0; q < 4; ++q) { const int idx = lane + 64 * q, rr = idx >> 3, c8 = idx & 7; *(u32x4*)(YC + (rowt + rr) * 2048 + 1024 + h * 64 + c8 * 8) = *(const LAS u32x4*)(zt + rr * 144 + c8 * 16); }
        }
    }
}

__device__ __forceinline__ void attn_mfma(Frame& F, int layer) {
    LAS unsigned char* Kn = F.lds; LAS unsigned char* VT = F.lds + 36864;
    const bf16_t* P = (const bf16_t*)(F.ws + WS_P); bf16_t* YC = (bf16_t*)(F.ws + WS_YCAT);
    const float* qg = F.in[IN_QG] + layer * 64; const float* kg = F.in[IN_KG] + layer * 64;
    for (int u = F.bid; u < BATCH * 32 * 2; u += F.G) {
        const int kvh = u & 1, qb = (u >> 1) & 31, b = u >> 6, q0 = qb * 128;
        int lane = F.lane; asm volatile("" : "+v"(lane));
        const int r = lane & 31, hh = lane >> 5;
        __syncthreads();
        for (int jr = F.wave; jr < 256; jr += NWAVES) { const int l = q0 - 128 + jr; float kv = 0.f;
            if (l >= 0) { const size_t row = (size_t)b * SEQ + l; const float x = bf2f(P[row * NINP + C_K + kvh * 64 + lane]);
                const float rs = __builtin_amdgcn_rsqf(wave_sum(x * x) * (1.f / 64.f) + NORM_EPS); const float xn = x * rs * kg[lane];
                const float other = __shfl_xor(xn, 32); const int i = lane & 31; const float inv = exp2f(-(float)i * (13.287712379549449f / 32.f));
                float s, c; sincos_fast((float)l * inv, s, c);
                kv = (lane < 32) ? (xn * c - other * s) : (xn * c + other * s); }
            *(LAS unsigned short*)(Kn + jr * 144 + lane * 2) = (unsigned short)f2bf(kv); }
#pragma unroll
        for (int q = 0; q < 4; ++q) { const int it = F.tid + NTHR * q, d = it & 63, ko = it >> 6; unsigned short v[8];
#pragma unroll
            for (int e = 0; e < 8; ++e) { const int l = q0 - 128 + 8 * ko + e; v[e] = (l >= 0) ? P[((size_t)b * SEQ + l) * NINP + C_V + kvh * 64 + d] : (unsigned short)0; }
            u32x4 o; o.x = v[0] | ((unsigned)v[1] << 16); o.y = v[2] | ((unsigned)v[3] << 16); o.z = v[4] | ((unsigned)v[5] << 16); o.w = v[6] | ((unsigned)v[7] << 16);
            *(LAS u32x4*)(VT + d * 528 + ko * 16) = o; }
        __syncthreads();
        const int hd = F.wave >> 1, head = kvh * 4 + hd, qhalf = F.wave & 1; const float sink = F.in[IN_SINK][layer * 8 + head];
#pragma unroll 1
        for (int jt = 0; jt < 2; ++jt) {
            const int qt = q0 + 64 * qhalf + 32 * jt, qi = qt + r, t0 = 2 * qhalf + jt; const size_t row = (size_t)b * SEQ + qi;
            bf16x8 Qf[4];
            { float qv[4][8]; float ss = 0.f;
#pragma unroll
              for (int ks = 0; ks < 4; ++ks) { const u32x4 w = *(const u32x4*)(P + row * NINP + C_Q + head * 64 + 16 * ks + 8 * hh);
#pragma unroll
                  for (int e = 0; e < 4; ++e) { qv[ks][2 * e] = bflo(w[e]); qv[ks][2 * e + 1] = bfhi(w[e]); ss += qv[ks][2 * e] * qv[ks][2 * e] + qv[ks][2 * e + 1] * qv[ks][2 * e + 1]; } }
              ss += __shfl_xor(ss, 32);
              const float rs = __builtin_amdgcn_rsqf(ss * (1.f / 64.f) + NORM_EPS);
#pragma unroll
              for (int ks = 0; ks < 4; ++ks)
#pragma unroll
                  for (int e = 0; e < 8; ++e) qv[ks][e] *= rs * qg[16 * ks + 8 * hh + e];
#pragma unroll
              for (int ks = 0; ks < 2; ++ks)
#pragma unroll
                  for (int e = 0; e < 8; ++e) { const int i = 16 * ks + 8 * hh + e; const float inv = exp2f(-(float)i * (13.287712379549449f / 32.f)); float s, c; sincos_fast((float)qi * inv, s, c);
                      const float a = qv[ks][e], bq = qv[ks + 2][e]; qv[ks][e] = (a * c - bq * s) * 0.125f; qv[ks + 2][e] = (bq * c + a * s) * 0.125f; }
#pragma unroll
              for (int ks = 0; ks < 4; ++ks) Qf[ks] = pack8v(qv[ks]); }
            f32x16 acc[2];
#pragma unroll
            for (int dt = 0; dt < 2; ++dt)
#pragma unroll
                for (int i = 0; i < 16; ++i) acc[dt][i] = 0.f;
            float m = sink, lsum = 1.f;
#pragma unroll
            for (int tt = 0; tt < 5; ++tt) { const int t = t0 + tt;
                if (q0 == 0 && t < 4) continue;
                f32x16 X;
#pragma unroll
                for (int i = 0; i < 16; ++i) X[i] = 0.f;
#pragma unroll
                for (int ks = 0; ks < 4; ++ks) { const bf16x8 Kq = *(const LAS bf16x8*)(Kn + (32 * t + r) * 144 + (16 * ks + 8 * hh) * 2); X = MFMA32(Kq, Qf[ks], X); }
                if (tt == 0) {
#pragma unroll
                    for (int i = 0; i < 16; ++i) if (!(r < crow32(i, hh))) X[i] = -INFINITY; }
                if (tt == 4) {
#pragma unroll
                    for (int i = 0; i < 16; ++i) if (!(crow32(i, hh) <= r)) X[i] = -INFINITY; }
                float mx = X[0];
#pragma unroll
                for (int i = 1; i < 16; ++i) mx = fmaxf(mx, X[i]);
                mx = fmaxf(mx, __shfl_xor(mx, 32));
                const float mn = fmaxf(m, mx), al = __expf(m - mn); m = mn;
                float ps = 0.f;
#pragma unroll
                for (int i = 0; i < 16; ++i) { X[i] = __expf(X[i] - mn); ps += X[i]; }
                ps += __shfl_xor(ps, 32);
                lsum = lsum * al + ps;
#pragma unroll
                for (int dt = 0; dt < 2; ++dt)
#pragma unroll
                    for (int i = 0; i < 16; ++i) acc[dt][i] *= al;
#pragma unroll
                for (int kq = 0; kq < 2; ++kq) { const float v[8] = {X[8 * kq], X[8 * kq + 1], X[8 * kq + 2], X[8 * kq + 3], X[8 * kq + 4], X[8 * kq + 5], X[8 * kq + 6], X[8 * kq + 7]}; const bf16x8 Pf = pack8v(v);
#pragma unroll
                    for (int dt = 0; dt < 2; ++dt) { const LAS unsigned char* vp = VT + (32 * dt + r) * 528 + (32 * t + 16 * kq + 4 * hh) * 2;
                        const u32x2 va = *(const LAS u32x2*)vp, vb = *(const LAS u32x2*)(vp + 16); const u32x4 vv = {va.x, va.y, vb.x, vb.y};
                        acc[dt] = MFMA32(__builtin_bit_cast(bf16x8, vv), Pf, acc[dt]); } }
            }
            const float il = 1.f / lsum;
#pragma unroll
            for (int dt = 0; dt < 2; ++dt)
#pragma unroll
                for (int g4 = 0; g4 < 4; ++g4) { u32x2 o; o.x = cvtpk(acc[dt][4 * g4] * il, acc[dt][4 * g4 + 1] * il); o.y = cvtpk(acc[dt][4 * g4 + 2] * il, acc[dt][4 * g4 + 3] * il);
                    *(u32x2*)(YC + row * 2048 + 512 + head * 64 + 32 * dt + 8 * g4 + 4 * hh) = o; }
        }
    }
}

#ifndef MK_PER_PHASE
#define MK_PER_PHASE 0
#endif
constexpr int NPH = 13;
constexpr int TAB_OFF = 150 * 1024;
struct Args { const float* in[N_INPUTS]; float* out; unsigned char* ws; int gp_lo, gp_hi; };
static_assert(sizeof(Args) == (N_INPUTS + 2) * 8 + 8, "no padding in Args");

#ifndef PROBE_ID
#define PROBE_ID 0
#endif
#ifndef PROBE_N
#define PROBE_N 1
#endif
#define REP(id) for (int _r = 0; _r < ((id) == PROBE_ID ? 1 + PROBE_N : 1); ++_r)
extern __shared__ __attribute__((aligned(16))) unsigned char lds_raw[];
__device__ __forceinline__ LAS unsigned char* lds_raw_base() { return (LAS unsigned char*)lds_raw; }
#define LAUNDER() do { asm volatile("" : "+s"(F.in), "+s"(F.ws), "+s"(F.out), "+s"(F.ctl), "+s"(F.bid), "+s"(F.G)); asm volatile("" : "+v"(F.tid)); F.lane = F.tid & 63; F.wave = __builtin_amdgcn_readfirstlane(F.tid >> 6); } while (0)
template <int layer>
__device__ __forceinline__ void layer_body(Frame& F, const int lo, const int hi, const bool rerun) {
    volatile LAS int* offs = (volatile LAS int*)(F.lds + TAB_OFF); volatile LAS int* tile_e = offs + 64;
    XcdBarrier bar; bar.bar = F.ctl + CW_BAR; bar.x = xb_xcc_id(); bar.st = F.MISC;
#define GP(k) (layer * NPH + (k))
#ifdef ONLY_PH
#define IN(k) (((k) == ONLY_PH) && lo <= GP(k) && GP(k) < hi)
#else
#define IN(k) (lo <= GP(k) && GP(k) < hi)
#endif
#define WSB ((const char*)F.ws)
#ifdef DIAG_GP
#define STAMP0(k) do { if (GP(k) == DIAG_GP) { const unsigned t_ = (unsigned)__builtin_amdgcn_s_memrealtime(); if (threadIdx.x == 0) *(volatile LAS unsigned*)((LAS unsigned char*)lds_raw_base() + MISC_OFF + 32) = t_; } } while (0)
#define STAMP1(k) do { if (GP(k) == DIAG_GP) { const unsigned t_ = (unsigned)__builtin_amdgcn_s_memrealtime(); if (threadIdx.x == 0) *(volatile LAS unsigned*)((LAS unsigned char*)lds_raw_base() + MISC_OFF + 40) = t_; } } while (0)
#else
#define STAMP0(k)
#define STAMP1(k)
#endif
#define SEAM(k) do { if (!MK_PER_PHASE && IN(k) && GP(k) + 1 < hi) { xcd_barrier(bar); if (PROBE_ID == 19) { xcd_barrier(bar); xcd_barrier(bar); } } STAMP1(k); } while (0)
        if (IN(0) && layer == 0) { LAUNDER(); STAMP0(0);
            REP(1) { convert_weights(F, 0); __syncthreads(); } REP(2) s5_build(F, 0);
            REP(3) rmsnorm_rows(F, F.in[IN_X], F.in[IN_NORM1], (bf16_t*)(F.ws + WS_XN));
            SEAM(0);
        }
        if (IN(1)) { LAUNDER(); STAMP0(1);
            SchedDense<2048u, 2048u, T / 256, NINP / 256, 16> S{WSB + WS_XN, WSB + WS_WIN, F.G, F.bid};
            EpiProj E{F.ws, F.in[IN_BGATE] + layer * 3072};
            REP(4) pg8::gemm_phase<2048u, 2048u>(F.tid, F.lds, S, E);
            SEAM(1);
        }
        if (IN(2)) { LAUNDER(); STAMP0(2);
            SchedS5P1 S{WSB + WS_UH, WSB + WS_EG, F.G, F.bid};
            EpiHloc E{(float*)(F.ws + WS_HLOC)};
            REP(5) pg8::gemm_phase<(unsigned)(S5_K * 2), 1024u>(F.tid, F.lds, S, E);
            REP(6) ssdA_mfma(F, layer);
            REP(8) attn_mfma(F, layer);
            SEAM(2);
        }
        if (IN(3)) { LAUNDER(); STAMP0(3);
            REP(7) s5_scan(F, layer);
            if (!rerun) ssd_scan(F);
            SEAM(3);
        }
        if (IN(4)) { LAUNDER(); STAMP0(4);
            SchedS5Main S{WSB + WS_UH, WSB + WS_MG, F.G, F.bid};
            EpiS5Y E{(bf16_t*)(F.ws + WS_XN)};
            REP(9) pg8::gemm_phase<(unsigned)(S5_K * 2), (unsigned)(S5_K * 2)>(F.tid, F.lds, S, E);
            REP(10) ssdC_mfma(F, layer);
            SEAM(4);
        }
        if (IN(5)) { LAUNDER(); STAMP0(5);
            SchedDense<1024u, 1024u, T / 256, 4, 8> S{WSB + WS_XN, WSB + WS_WGLU, F.G, F.bid};
            EpiGlu E{(bf16_t*)(F.ws + WS_YCAT)};
            REP(11) pg8::gemm_phase<1024u, 1024u>(F.tid, F.lds, S, E);
            SEAM(5);
        }
        if (IN(6)) { LAUNDER(); STAMP0(6);
            SchedDense<4096u, 4096u, T / 256, 4, 32> S{WSB + WS_YCAT, WSB + WS_PCAT, F.G, F.bid};
            EpiMerged E{F.ws};
            REP(12) pg8::gemm_phase<4096u, 4096u>(F.tid, F.lds, S, E);
            SEAM(6);
        }
        if (IN(7)) { LAUNDER(); STAMP0(7);
            SchedDense<2048u, 2048u, T / 256, 4, 16> S{WSB + WS_XN, WSB + WS_WOUT, F.G, F.bid};
            EpiResid E{layer == 0 ? F.in[IN_X] : (const float*)F.out, F.out};
            REP(layer == 0 ? 13 : -1) pg8::gemm_phase<2048u, 2048u>(F.tid, F.lds, S, E);
            SEAM(7);
        }
        if (IN(8)) { LAUNDER(); STAMP0(8); REP(17) router_phase(F, layer); SEAM(8); }
        if (IN(9)) { LAUNDER(); STAMP0(9); (void)moe_tables(F, layer, offs, tile_e); REP(14) gather_phase(F, layer, offs); SEAM(9); }
        if (IN(10)) { LAUNDER(); STAMP0(10);
            const int ntiles = moe_tables(F, layer, offs, tile_e);
            SchedMoe<2048u, (size_t)1024 * 1024 * 2, (size_t)256 * 2048, 16> S{WSB + WS_XG, WSB + WS_EGU, ntiles, F.G, F.bid, tile_e};
            EpiSwiGlu E{(bf16_t*)(F.ws + WS_HID), (const float*)(F.ws + WS_MOE + 704 * 1024)};
            REP(15) pg8::gemm_phase<2048u, 2048u>(F.tid, F.lds, S, E);
            SEAM(10);
        }
        if (IN(11)) { LAUNDER(); STAMP0(11);
            const int ntiles = moe_tables(F, layer, offs, tile_e);
            SchedMoe<1024u, (size_t)1024 * 512 * 2, (size_t)256 * 1024, 8> S{WSB + WS_HID, WSB + WS_EDN, ntiles, F.G, F.bid, tile_e};
            EpiPlainBf16 E{(bf16_t*)(F.ws + WS_YEXP)};
            REP(16) pg8::gemm_phase<1024u, 1024u>(F.tid, F.lds, S, E);
            SEAM(11);
        }
        if (IN(12)) { LAUNDER(); STAMP0(12);
            if (PROBE_ID == 18) combine_phase(F, F.in[IN_NORM1], true);
            combine_phase(F, layer + 1 < DEPTH ? F.in[IN_NORM1] + (layer + 1) * 1024 : nullptr);
            if (layer + 1 < DEPTH) { __syncthreads(); convert_weights(F, layer + 1); __syncthreads(); s5_build(F, layer + 1); }
            SEAM(12);
        }
#undef GP
#undef IN
#undef SEAM
#undef WSB
}
__global__ void __launch_bounds__(NTHR, 2) fwd(Args args) {
    Frame F;
    F.lds = (LAS unsigned char*)lds_raw;
    F.MISC = (volatile LAS unsigned*)(F.lds + MISC_OFF);
    F.tid = threadIdx.x; F.lane = F.tid & 63; F.wave = __builtin_amdgcn_readfirstlane(F.tid >> 6);
    F.G = gridDim.x; F.bid = blockIdx.x;
    const __attribute__((address_space(4))) char* ka = (const __attribute__((address_space(4))) char*)__builtin_amdgcn_kernarg_segment_ptr();
    F.in = (const float* const __attribute__((address_space(4)))*)ka;
    F.out = *(float* const __attribute__((address_space(4)))*)(ka + N_INPUTS * 8); F.ws = *(unsigned char* const __attribute__((address_space(4)))*)(ka + N_INPUTS * 8 + 8); F.ctl = (unsigned*)(F.ws + WS_CTL);
    if (F.tid < 64) F.MISC[F.tid] = 0u;
    __syncthreads();
    XcdBarrier bar; bar.bar = F.ctl + CW_BAR; bar.x = 0; bar.st = nullptr;
    if (!MK_PER_PHASE) bar = xcd_barrier_post(F.ctl + CW_BAR, F.MISC);
    const int lo = *(const __attribute__((address_space(4))) int*)(ka + N_INPUTS * 8 + 16), hi_raw = *(const __attribute__((address_space(4))) int*)(ka + N_INPUTS * 8 + 20), hi = hi_raw & 0xffff;

    layer_body<0>(F, lo, hi, (hi_raw >> 16) != 0);
    layer_body<1>(F, lo, hi, (hi_raw >> 16) != 0);
#ifdef DIAG_GP
    __syncthreads();
    if (blockIdx.x == 0 && threadIdx.x == 0) { const unsigned t0 = *(volatile LAS unsigned*)((LAS unsigned char*)lds_raw_base() + MISC_OFF + 32), t1 = *(volatile LAS unsigned*)((LAS unsigned char*)lds_raw_base() + MISC_OFF + 40); float* o_ = *(float* const __attribute__((address_space(4)))*)((const __attribute__((address_space(4))) char*)__builtin_amdgcn_kernarg_segment_ptr() + N_INPUTS * 8); asm volatile("s_waitcnt vmcnt(0)" ::: "memory"); o_[0] = (float)(t1 - t0); }
#endif
}

extern "C" void kernel_launch(void* const* d_in, const int* in_sizes, int n_in, void* d_out, int out_size, void* d_ws, size_t ws_size, hipStream_t stream) {
    static int grid = 0;
    if (grid == 0) {
        if (n_in != N_INPUTS || out_size != T * DM || ws_size < WS_END) { fprintf(stderr, "kernel_launch: unexpected shapes (n_in %d out %d ws %zu need %zu)\n", n_in, out_size, ws_size, (size_t)WS_END); grid = -1; return; }
        int dev = 0, cus = 0, per_cu = 0;
        if (hipGetDevice(&dev) != hipSuccess || hipDeviceGetAttribute(&cus, hipDeviceAttributeMultiprocessorCount, dev) != hipSuccess) { grid = -1; return; }
        if (hipFuncSetAttribute((const void*)fwd, hipFuncAttributeMaxDynamicSharedMemorySize, LDS_BYTES) != hipSuccess) { fprintf(stderr, "kernel_launch: hipFuncSetAttribute failed\n"); grid = -1; return; }
        if (hipOccupancyMaxActiveBlocksPerMultiprocessor(&per_cu, (const void*)fwd, NTHR, LDS_BYTES) != hipSuccess || per_cu < 1) fprintf(stderr, "kernel_launch: occupancy query reports %d\n", per_cu);
        (void)hipGetLastError();
        grid = cus;
    }
    if (grid < 0) return;
    (void)hipMemsetAsync((char*)d_ws + WS_CTL, 0, CTL_ZERO_BYTES, stream);
    Args a{};
    for (int i = 0; i < N_INPUTS; ++i) a.in[i] = (const float*)d_in[i];
    a.out = (float*)d_out; a.ws = (unsigned char*)d_ws;
#if MK_PER_PHASE
    for (int gp = 0; gp < DEPTH * NPH; ++gp) {
        if (gp == NPH) continue;
        a.gp_lo = gp; a.gp_hi = gp + 1;
        int nrep = 1;
#ifdef PP_REP_GP
        if (gp == PP_REP_GP) nrep = 1 + PP_REP_N;
#endif
        for (int rr = 0; rr < nrep; ++rr) { a.gp_hi = (gp + 1) | (rr > 0 ? 0x10000 : 0); hipLaunchKernelGGL(fwd, dim3(grid), dim3(NTHR), LDS_BYTES, stream, a); }
    }
#else
    a.gp_lo = 0; a.gp_hi = DEPTH * NPH;
    hipLaunchKernelGGL(fwd, dim3(grid), dim3(NTHR), LDS_BYTES, stream, a);
#endif
}
```

```cpp
#include <hip/hip_runtime.h>
#include <cstdio>
#include <cstdint>

#define LAS __attribute__((address_space(3)))
#define GAS __attribute__((address_space(1)))
typedef unsigned short bf16_t;
typedef short bf16x8 __attribute__((ext_vector_type(8)));
typedef float f32x4 __attribute__((ext_vector_type(4)));
typedef float f32x2 __attribute__((ext_vector_type(2)));
typedef unsigned u32x4 __attribute__((ext_vector_type(4)));
typedef unsigned u32x2 __attribute__((ext_vector_type(2)));

constexpr int BATCH = 4, SEQ = 4096, DM = 1024, T = BATCH * SEQ, DEPTH = 2;
constexpr int NIN = 6672, NINP = 6912;
constexpr int C_U = 0, C_Q = 512, C_K = 1024, C_V = 1152, C_Z = 1280, C_XS = 2304, C_B = 3328, C_C = 3456, C_DT = 3584, C_G = 3840;
constexpr int S5_TC = 32, S5_ROWS = T / S5_TC  , S5_K = 128 + S5_TC * 16  , S5_N = S5_TC * 16  ;
constexpr int SSD_NCH = SEQ / 128;
constexpr int MOE_MAXROWS = 2 * T + 32 * 256;
constexpr float NORM_EPS = 1e-6f;

constexpr size_t MiB = 1u << 20;
constexpr size_t WS_CTL = 0, CTL_ZERO_BYTES = 1 * MiB;
constexpr size_t WS_WIN = 1 * MiB;
constexpr size_t WS_WGLU = WS_WIN + (size_t)NINP * DM * 2;
constexpr size_t WS_PCAT = WS_WGLU + 1 * MiB;
constexpr size_t WS_WOUT = WS_PCAT + 4 * MiB;
constexpr size_t WS_EGU = WS_WOUT + 2 * MiB;
constexpr size_t WS_EDN = WS_EGU + 64 * MiB;
constexpr size_t WS_MG = WS_EDN + 32 * MiB;
constexpr size_t WS_EG = WS_MG + 20 * MiB;
constexpr size_t WS_XN = WS_EG + 8 * MiB;
constexpr size_t WS_P = WS_XN + 32 * MiB;
constexpr size_t WS_XG = WS_P;
constexpr size_t WS_HID = WS_XG + (size_t)MOE_MAXROWS * 1024 * 2;
constexpr size_t WS_YEXP = WS_HID + (size_t)MOE_MAXROWS * 512 * 2;
constexpr size_t WS_DT = WS_P + 216 * MiB;
constexpr size_t WS_UH = WS_DT + 1 * MiB;
constexpr size_t WS_HLOC = WS_UH + 20 * MiB;
constexpr size_t WS_YCAT = WS_HLOC + 8 * MiB;
constexpr size_t WS_SST = WS_YCAT + 64 * MiB;
constexpr size_t WS_MOE = WS_SST + 32 * MiB;
constexpr size_t WS_ASUM = WS_MOE + 1 * MiB;
constexpr size_t WS_END = WS_ASUM + 64 * 1024;
static_assert(WS_YEXP + (size_t)MOE_MAXROWS * 1024 * 2 <= WS_DT, "MoE overlay fits in P");
constexpr int CW_BAR = 4096;
constexpr int CW_CNT = 16384;

constexpr int NWAVES = 8, NTHR = 512;
constexpr int LDS_BYTES = 163840;
constexpr int RING_BYTES = 131072;
constexpr int MISC_OFF = 160 * 1024 - 256;

__device__ __forceinline__ unsigned f2bf(float f) { unsigned u = __builtin_bit_cast(unsigned, f); return (u + 0x7fffu + ((u >> 16) & 1u)) >> 16; }
typedef float f32x2_t __attribute__((ext_vector_type(2)));
typedef __bf16 bf16x2_t __attribute__((ext_vector_type(2)));
__device__ __forceinline__ unsigned pk2(float lo, float hi) { f32x2_t v = {lo, hi}; bf16x2_t b = __builtin_convertvector(v, bf16x2_t); return __builtin_bit_cast(unsigned, b); }
__device__ __forceinline__ float bf2f(unsigned b) { return __builtin_bit_cast(float, b << 16); }
__device__ __forceinline__ float bflo(unsigned w) { return __builtin_bit_cast(float, w << 16); }
__device__ __forceinline__ float bfhi(unsigned w) { return __builtin_bit_cast(float, w & 0xffff0000u); }
#define WS_DPP(v, ctrl, rmask) __builtin_bit_cast(float, __builtin_amdgcn_update_dpp(0, __builtin_bit_cast(int, v), ctrl, rmask, 0xF, false))
__device__ __forceinline__ float wave_sum(float v) {
    v += WS_DPP(v, 0xB1, 0xF);
    v += WS_DPP(v, 0x4E, 0xF);
    v += WS_DPP(v, 0x141, 0xF);
    v += WS_DPP(v, 0x140, 0xF);
    v += WS_DPP(v, 0x142, 0xA);
    v += WS_DPP(v, 0x143, 0xC);
    return __builtin_bit_cast(float, __builtin_amdgcn_readlane(__builtin_bit_cast(int, v), 63));
}
__device__ __forceinline__ float frcp(float x) { return __builtin_amdgcn_rcpf(x); }
__device__ __forceinline__ float sigmoidf_(float x) { return frcp(1.0f + __expf(-x)); }
__device__ __forceinline__ float siluf_(float x) { return x * frcp(1.0f + __expf(-x)); }
__device__ __forceinline__ float gelu_tanh_(float x) { const float u = 0.7978845608f * (x + 0.044715f * x * x * x); return x * frcp(1.0f + __expf(-2.0f * u)); }
__device__ __forceinline__ float softplusf_(float x) { return x > 20.f ? x : log1pf(__expf(x)); }

typedef float f32x16 __attribute__((ext_vector_type(16)));
#define MFMA32(a, b, c) __builtin_amdgcn_mfma_f32_32x32x16_bf16((a), (b), (c), 0, 0, 0)
__device__ __forceinline__ unsigned cvtpk(float lo, float hi) { f32x2_t v = {lo, hi}; bf16x2_t b = __builtin_convertvector(v, bf16x2_t); return __builtin_bit_cast(unsigned, b); }
__device__ __forceinline__ void pin_frag(bf16x8& f) { u32x4 t = __builtin_bit_cast(u32x4, f); asm volatile("s_nop 1" : "+v"(t)); f = __builtin_bit_cast(bf16x8, t); }
__device__ __forceinline__ void settle_acc(f32x16& x) { asm volatile("s_nop 15\n\ts_nop 3" : "+v"(x)); }
__device__ __forceinline__ bf16x8 pack8v(const float (&v)[8]) { u32x4 p; p.x = cvtpk(v[0], v[1]); p.y = cvtpk(v[2], v[3]); p.z = cvtpk(v[4], v[5]); p.w = cvtpk(v[6], v[7]); return __builtin_bit_cast(bf16x8, p); }

#define XB_TMO      128
#define XB_XCNT(j)  (256  + 64 * (j))
#define XB_XSUB(j)  (1280 + 64 * (j))
#define XB_XGEN(j)  (2304 + 64 * (j))
#define XB_TOP      3328
#define XB_TOPGEN   3392
#define XCD_BAR_WORDS 3456
#define XB_SPIN_CAP (1u << 18)
__device__ __forceinline__ unsigned xb_ld(unsigned* p)              { return __hip_atomic_load(p, __ATOMIC_RELAXED, __HIP_MEMORY_SCOPE_AGENT); }
__device__ __forceinline__ unsigned xb_add(unsigned* p, unsigned v) { return __hip_atomic_fetch_add(p, v, __ATOMIC_RELAXED, __HIP_MEMORY_SCOPE_AGENT); }
__device__ __forceinline__ unsigned xb_xcc_id() { return (unsigned)__builtin_amdgcn_s_getreg((3 << 11) | 20) & 0xFu; }
#define XB_SPIN(cond, bar) do { unsigned _sp = 0; while (cond) { __builtin_amdgcn_s_sleep(1); \
    if ((++_sp & 255u) == 0u) { if (xb_ld(&(bar)[XB_TMO])) break; if (_sp > XB_SPIN_CAP) { atomicAdd(&(bar)[XB_TMO], 1u); break; } } } } while (0)
struct XcdBarrier { unsigned* bar; unsigned x; volatile LAS unsigned* st; };
__device__ __forceinline__ XcdBarrier xcd_barrier_post(unsigned* bar, volatile LAS unsigned* st) {
    XcdBarrier b; b.bar = bar; b.x = xb_xcc_id(); b.st = st;
    if (threadIdx.x == 0) (void)xb_add(&bar[XB_XCNT(b.x)], 1u);
    return b;
}
__device__ __forceinline__ void xcd_barrier_complete(unsigned* bar, unsigned x, unsigned& nloc, unsigned& nx) {
    const unsigned G = gridDim.x * gridDim.y * gridDim.z;
    unsigned sum, cnt, mine, sp = 0u;
    for (;;) {
        sum = 0u; cnt = 0u; mine = 0u;
#pragma unroll
        for (unsigned j = 0; j < 16; ++j) { const unsigned c = xb_ld(&bar[XB_XCNT(j)]); sum += c; cnt += (c > 0u) ? 1u : 0u; mine = (j == x) ? c : mine; }
        if (sum == G) break;
        __builtin_amdgcn_s_sleep(1);
        if ((++sp & 255u) == 0u) { if (xb_ld(&bar[XB_TMO])) break; if (sp > XB_SPIN_CAP) { atomicAdd(&bar[XB_TMO], 1u); break; } }
    }
    nloc = mine > 0u ? mine : 1u; nx = cnt > 0u ? cnt : 1u;
}
__device__ __forceinline__ void xcd_barrier(const XcdBarrier& b) {
    asm volatile("s_waitcnt vmcnt(0)" ::: "memory");
    __syncthreads();
    if (threadIdx.x == 0) {
        unsigned* bar = b.bar;
        __builtin_amdgcn_s_waitcnt(0);
        unsigned nloc = b.st[0], nx = b.st[1];
        if (nloc == 0u) { xcd_barrier_complete(bar, b.x, nloc, nx); b.st[0] = nloc; b.st[1] = nx; }
        const unsigned old = xb_add(&bar[XB_XSUB(b.x)], 1u);
        const unsigned gen = old / nloc;
        if (old + 1u == (gen + 1u) * nloc) {
            __builtin_amdgcn_fence(__ATOMIC_RELEASE, "agent");
            asm volatile("s_waitcnt vmcnt(0)" ::: "memory");
            const unsigned og = xb_add(&bar[XB_TOP], 1u);
            const unsigned tg = og / nx;
            if (og + 1u == (tg + 1u) * nx) xb_add(&bar[XB_TOPGEN], 1u);
            else XB_SPIN(xb_ld(&bar[XB_TOPGEN]) == tg, bar);
            __builtin_amdgcn_fence(__ATOMIC_ACQUIRE, "agent");
            xb_add(&bar[XB_XGEN(b.x)], 1u);
            asm volatile("s_waitcnt vmcnt(0)" ::: "memory");
        } else {
            XB_SPIN(xb_ld(&bar[XB_XGEN(b.x)]) == gen, bar);
            __builtin_amdgcn_fence(__ATOMIC_ACQUIRE, "agent");
            asm volatile("s_waitcnt vmcnt(0)" ::: "memory");
        }
    }
    __syncthreads();
}

namespace pg8 {
constexpr int BM = 256, BK = 64, HALF = 128, HTB = HALF * BK * 2, STAGE_BYTES = 8 * HTB, NXCD = 8, WGM = 8;
__host__ __device__ __forceinline__ int lds_byte(int r, int c) { const int st = (r >> 4) * 2 + (c >> 5), rr = r & 15, cc = c & 31, ob = rr * 64 + cc * 2; return st * 1024 + (ob ^ (((ob >> 9) & 1) << 5)); }
__host__ __device__ __forceinline__ void stage_rc(int b, int& R, int& C) { const int st = b / 1024, sb = b % 1024, swz = sb ^ (((sb >> 9) & 1) << 5); R = (st >> 1) * 16 + swz / 64; C = (st & 1) * 32 + (swz % 64) / 2; }
__host__ __device__ __forceinline__ int perm32(int rho) { const int n = rho >> 4, i = rho & 15; return 8 * (i >> 2) + 4 * n + (i & 3); }

struct Unit { const char* A; const char* B; int nt; int pm, pn, aux; };

__device__ __forceinline__ void tile_order(int L, int nM, int nN, int& pm, int& pn) {
    const int nwg = nM * nN; int wgid = L;
    { const int q = nwg / NXCD, r = nwg % NXCD, xcd = wgid % NXCD, off = wgid / NXCD; wgid = (xcd < r ? xcd * (q + 1) : r * (q + 1) + (xcd - r) * q) + off; }
    const int nig = WGM * nN, gid = wgid / nig, fm = gid * WGM, gsz = (nM - fm) < WGM ? (nM - fm) : WGM;
    pm = fm + ((wgid % nig) % gsz); pn = (wgid % nig) / gsz;
}
__device__ __forceinline__ unsigned cvt_pk_bf16(float lo, float hi) { unsigned r; asm volatile("v_cvt_pk_bf16_f32 %0, %1, %2" : "=v"(r) : "v"(lo), "v"(hi)); return r; }
__device__ __forceinline__ u32x4 pack8(const f32x4 v0, const f32x4 v1) { u32x4 w; w.x = cvt_pk_bf16(v0[0], v0[1]); w.y = cvt_pk_bf16(v0[2], v0[3]); w.z = cvt_pk_bf16(v1[0], v1[1]); w.w = cvt_pk_bf16(v1[2], v1[3]); return w; }

template <unsigned lda, unsigned ldb, class Epi, class Sched>
__device__ __forceinline__ void gemm_phase(const int tid, LAS unsigned char* lds, const Sched& S, const Epi& E) {
    const int wid = __builtin_amdgcn_readfirstlane(tid >> 6), lane = tid & 63, wr = wid >> 2, wc = wid & 3, fr = lane & 15, fq = lane >> 4;
    unsigned voffA[2], voffB[2];
#pragma unroll
    for (int i = 0; i < 2; ++i) { int R, C; stage_rc(tid * 16 + i * 8192, R, C); const int Rb = Epi::PERM ? ((R & ~31) + perm32(R & 31)) : R;
        voffA[i] = (unsigned)R * lda + (unsigned)C * 2u; voffB[i] = (unsigned)Rb * ldb + (unsigned)C * 2u; }
    const size_t kstep = (size_t)(BK * 2);
    const size_t hstepA = (size_t)HALF * lda, hstepB = (size_t)HALF * ldb;
    const unsigned ldsw = (unsigned)wid * 1024u;
    const int aoff = lds_byte(wr * 64 + fr, fq * 8), boff = lds_byte(wc * 32 + fr, fq * 8);
#define PG8_SA(b, h) (((b) * 2 + (h)) * HTB)
#define PG8_SB(b, h) ((4 + (b) * 2 + (h)) * HTB)
#define PG8_STAGE(bufoff, gbase, voff) do { const char* _gb = (const char*)(gbase); asm volatile("" : "+s"(_gb)); _Pragma("unroll") for (int _i = 0; _i < 2; ++_i) \
        __builtin_amdgcn_global_load_lds((const unsigned*)(_gb + (voff)[_i]), (LAS unsigned*)(lds + (bufoff) + ldsw + _i * 8192), 16, 0, 0); } while (0)
#define PG8_LDA(dst, b, h) do { _Pragma("unroll") for (int m = 0; m < 4; ++m) _Pragma("unroll") for (int k = 0; k < 2; ++k) dst[m][k] = *(const LAS bf16x8*)(lds + PG8_SA(b, h) + aoff + m * 2048 + k * 1024); } while (0)
#define PG8_LDB(dst, b, h) do { _Pragma("unroll") for (int n = 0; n < 2; ++n) _Pragma("unroll") for (int k = 0; k < 2; ++k) dst[n][k] = *(const LAS bf16x8*)(lds + PG8_SB(b, h) + boff + n * 2048 + k * 1024); } while (0)
#define PG8_MMA(ai, bj, At, Bt) do { __builtin_amdgcn_s_setprio(1); _Pragma("unroll") for (int m = 0; m < 4; ++m) _Pragma("unroll") for (int n = 0; n < 2; ++n) _Pragma("unroll") for (int k = 0; k < 2; ++k) \
        acc[ai][bj][m][n] = __builtin_amdgcn_mfma_f32_16x16x32_bf16(Bt[n][k], At[m][k], acc[ai][bj][m][n], 0, 0, 0); __builtin_amdgcn_s_setprio(0); } while (0)
#define PG8_WAIT_V(n) asm volatile("s_waitcnt vmcnt(" #n ")" ::: "memory")
#define PG8_WAIT_L(n) asm volatile("s_waitcnt lgkmcnt(" #n ")" ::: "memory")
#define PG8_BAR __builtin_amdgcn_s_barrier()
#define PG8_SCHED __builtin_amdgcn_sched_barrier(0)
    Unit cur, nxt; int ui = 0;
    if (!S.next(0, cur)) return;
    f32x4 acc[2][2][4][2];
#pragma unroll
    for (int a = 0; a < 2; ++a)
#pragma unroll
        for (int b = 0; b < 2; ++b)
#pragma unroll
            for (int m = 0; m < 4; ++m)
#pragma unroll
                for (int n = 0; n < 2; ++n) acc[a][b][m][n] = (f32x4){0.f, 0.f, 0.f, 0.f};
    bf16x8 At[4][2], B0[2][2], B1[2][2];
    const char* cA = cur.A; const char* cB = cur.B;
    PG8_STAGE(PG8_SB(0, 0), cB, voffB); PG8_STAGE(PG8_SB(0, 1), cB + hstepB, voffB); PG8_STAGE(PG8_SA(0, 0), cA, voffA); PG8_STAGE(PG8_SA(0, 1), cA + hstepA, voffA);
    if (wr == 1) PG8_BAR;
    PG8_WAIT_V(2); PG8_BAR;
    PG8_STAGE(PG8_SB(1, 0), cB + kstep, voffB); PG8_STAGE(PG8_SA(1, 0), cA + kstep, voffA); PG8_STAGE(PG8_SB(1, 1), cB + hstepB + kstep, voffB);
    PG8_WAIT_V(6); PG8_BAR;
    for (;;) {
        const bool has_next = S.next(ui + 1, nxt);
        const char* nA = has_next ? nxt.A : cA; const char* nB = has_next ? nxt.B : cB;
        const int nt = cur.nt;
        for (int t = 0; t < nt; t += 2) {
            const bool last = (t == nt - 2);
            const char* a1 = cA + (size_t)(t + 1) * kstep;
            const char* a2 = last ? nA : cA + (size_t)(t + 2) * kstep; const char* b2 = last ? nB : cB + (size_t)(t + 2) * kstep;
            const char* a3 = a2 + kstep; const char* b3 = b2 + kstep;
            PG8_LDB(B0, 0, 0); PG8_LDB(B1, 0, 1); PG8_SCHED; PG8_LDA(At, 0, 0); PG8_STAGE(PG8_SA(1, 1), a1 + hstepA, voffA);
            PG8_WAIT_V(8); PG8_WAIT_L(0); PG8_BAR; PG8_MMA(0, 0, At, B0); PG8_MMA(0, 1, At, B1); PG8_BAR; PG8_SCHED;
            PG8_LDA(At, 0, 1); PG8_STAGE(PG8_SB(0, 0), b2, voffB); PG8_STAGE(PG8_SB(0, 1), b2 + hstepB, voffB); PG8_STAGE(PG8_SA(0, 0), a2, voffA);
            PG8_WAIT_V(8); PG8_WAIT_L(0); PG8_BAR; PG8_MMA(1, 0, At, B0); PG8_MMA(1, 1, At, B1); PG8_BAR; PG8_SCHED;
            PG8_LDB(B0, 1, 0); PG8_LDB(B1, 1, 1); PG8_SCHED; PG8_LDA(At, 1, 0); PG8_STAGE(PG8_SA(0, 1), a2 + hstepA, voffA);
            PG8_WAIT_V(8); PG8_WAIT_L(0); PG8_BAR; PG8_MMA(0, 0, At, B0); PG8_MMA(0, 1, At, B1); PG8_BAR; PG8_SCHED;
            PG8_LDA(At, 1, 1); PG8_STAGE(PG8_SB(1, 0), b3, voffB); PG8_STAGE(PG8_SB(1, 1), b3 + hstepB, voffB); PG8_STAGE(PG8_SA(1, 0), a3, voffA);
            PG8_WAIT_V(8); PG8_WAIT_L(0); PG8_BAR; PG8_MMA(1, 0, At, B0); PG8_MMA(1, 1, At, B1); PG8_BAR; PG8_SCHED;
            if constexpr (Epi::HAS_MID) { if (t + 2 == 8 || t + 2 == 16) { E.mid(acc, cur, t + 2, wr, wc, fr, fq); PG8_SCHED; } }
        }
        if (wr == 0) PG8_BAR;
        E(acc, cur, wr, wc, fr, fq);
        if (!has_next) break;
#pragma unroll
        for (int a = 0; a < 2; ++a)
#pragma unroll
            for (int b = 0; b < 2; ++b)
#pragma unroll
                for (int m = 0; m < 4; ++m)
#pragma unroll
                    for (int n = 0; n < 2; ++n) acc[a][b][m][n] = (f32x4){0.f, 0.f, 0.f, 0.f};
        cur = nxt; cA = nA; cB = nB; ++ui;
        if (wr == 1) PG8_BAR;
    }
    PG8_WAIT_V(0);
    PG8_BAR;
#undef PG8_SA
#undef PG8_SB
#undef PG8_STAGE
#undef PG8_LDA
#undef PG8_LDB
#undef PG8_MMA
#undef PG8_WAIT_V
#undef PG8_WAIT_L
#undef PG8_BAR
#undef PG8_SCHED
}
}

struct Frame {
    LAS unsigned char* lds;
    volatile LAS unsigned* MISC;
    unsigned* ctl;
    int tid, lane, wave, G, bid;
    const float* const __attribute__((address_space(4)))* in;
    float* out; unsigned char* ws;
};
enum { IN_X = 0, IN_NORM1, IN_WIN, IN_BGATE, IN_LRE, IN_LIM, IN_BRE, IN_BIM, IN_CRE, IN_CIM, IN_S5D, IN_LOGDT, IN_GLU1, IN_GLU2, IN_QG, IN_KG, IN_SINK,
       IN_CONVW, IN_CONVB, IN_DTB, IN_ALOG, IN_SSDD, IN_SSDG, IN_PS5, IN_PATTN, IN_PSSD, IN_WOUT, IN_NORM2, IN_WRG, IN_BRG, IN_WRE, IN_BRE_, IN_EG, IN_EU, IN_ED, N_INPUTS };

#define LDS_WAIT() asm volatile("s_waitcnt lgkmcnt(0)" ::: "memory")
#define VM_WAIT() asm volatile("s_waitcnt vmcnt(0)" ::: "memory")

using pg8::Unit; using pg8::pack8;
struct EpiProj {
    static constexpr bool PERM = true, HAS_MID = false;
    unsigned char* ws; const float* bgate;
    __device__ __forceinline__ void operator()(const f32x4 (&acc)[2][2][4][2], const Unit& u, int wr, int wc, int fr, int fq) const {
        bf16_t* P = (bf16_t*)(ws + WS_P); bf16_t* UH = (bf16_t*)(ws + WS_UH); float* DT = (float*)(ws + WS_DT);
        const int row0 = u.pm * 256 + wr * 64 + fr;
        if (u.pn < 2) {
#pragma unroll
            for (int ai = 0; ai < 2; ++ai)
#pragma unroll
                for (int m = 0; m < 4; ++m) { const int row = row0 + ai * 128 + m * 16, r = row >> 5, s = row & 31;
#pragma unroll
                    for (int bj = 0; bj < 2; ++bj) { const int col = u.pn * 256 + bj * 128 + wc * 32 + 8 * fq, g = col >> 4, c0 = col & 15;
                        *(u32x4*)(UH + ((size_t)(g * S5_ROWS + r) * S5_K + 128 + s * 16 + c0)) = pack8(acc[ai][bj][m][0], acc[ai][bj][m][1]); } }
        } else {
            const int colb = u.pn * 256 + wc * 32 + 8 * fq;
            f32x4 bv[2][2];
#pragma unroll
            for (int bj = 0; bj < 2; ++bj)
#pragma unroll
                for (int n = 0; n < 2; ++n) bv[bj][n] = (u.pn >= 15) ? *(const f32x4*)(bgate + (colb - C_G) + bj * 128 + 4 * n) : (f32x4){0.f, 0.f, 0.f, 0.f};
#pragma unroll
            for (int ai = 0; ai < 2; ++ai)
#pragma unroll
                for (int m = 0; m < 4; ++m) { const int row = row0 + ai * 128 + m * 16;
#pragma unroll
                    for (int bj = 0; bj < 2; ++bj) { f32x4 v0 = acc[ai][bj][m][0] + bv[bj][0], v1 = acc[ai][bj][m][1] + bv[bj][1];
                        if (u.pn >= 15) {
#pragma unroll
                            for (int j = 0; j < 4; ++j) { v0[j] = fmaxf(sigmoidf_(v0[j]), 1e-30f); v1[j] = fmaxf(sigmoidf_(v1[j]), 1e-30f); } }
                        *(u32x4*)(P + (size_t)row * NINP + colb + bj * 128) = pack8(v0, v1); }
                    if (u.pn == 14 && wc == 0 && fq < 2) { float* d = DT + (size_t)row * 16 + 8 * fq; *(f32x4*)d = acc[ai][0][m][0]; *(f32x4*)(d + 4) = acc[ai][0][m][1]; } }
        }
    }
};
struct EpiHloc {
    static constexpr bool PERM = false, HAS_MID = false;
    float* H;
    __device__ __forceinline__ void operator()(const f32x4 (&acc)[2][2][4][2], const Unit& u, int wr, int wc, int fr, int fq) const {
#pragma unroll
        for (int ai = 0; ai < 2; ++ai)
#pragma unroll
            for (int m = 0; m < 4; ++m) { const int r = u.pm * 256 + ai * 128 + wr * 64 + m * 16 + fr; float* rowp = H + ((size_t)(u.aux * S5_ROWS + r) * 128) + wc * 32 + 4 * fq;
#pragma unroll
                for (int n = 0; n < 2; ++n) *(f32x4*)(rowp + 16 * n) = acc[ai][0][m][n]; }
    }
};
struct EpiS5Y {
    static constexpr bool PERM = true, HAS_MID = false;
    bf16_t* Y;
    __device__ __forceinline__ void operator()(const f32x4 (&acc)[2][2][4][2], const Unit& u, int wr, int wc, int fr, int fq) const {
#pragma unroll
        for (int ai = 0; ai < 2; ++ai)
#pragma unroll
            for (int m = 0; m < 4; ++m) { const int r = u.pm * 256 + ai * 128 + wr * 64 + m * 16 + fr;
#pragma unroll
                for (int bj = 0; bj < 2; ++bj) { const int n0 = u.pn * 256 + bj * 128 + wc * 32 + 8 * fq, t = n0 >> 4, c0 = n0 & 15;
                    f32x4 v0 = acc[ai][bj][m][0], v1 = acc[ai][bj][m][1];
#pragma unroll
                    for (int j = 0; j < 4; ++j) { v0[j] = gelu_tanh_(v0[j]); v1[j] = gelu_tanh_(v1[j]); }
                    *(u32x4*)(Y + ((size_t)(r * S5_TC + t) * 512 + u.aux * 16 + c0)) = pack8(v0, v1); } }
    }
};
struct EpiGlu {
    static constexpr bool PERM = true, HAS_MID = false;
    bf16_t* Y;
    __device__ __forceinline__ void operator()(const f32x4 (&acc)[2][2][4][2], const Unit& u, int wr, int wc, int fr, int fq) const {
#pragma unroll
        for (int ai = 0; ai < 2; ++ai)
#pragma unroll
            for (int m = 0; m < 4; ++m) { const int row = u.pm * 256 + ai * 128 + wr * 64 + m * 16 + fr;
                f32x4 v0 = acc[ai][0][m][0], v1 = acc[ai][0][m][1]; const f32x4 g0 = acc[ai][1][m][0], g1 = acc[ai][1][m][1];
#pragma unroll
                for (int j = 0; j < 4; ++j) { v0[j] *= sigmoidf_(g0[j]); v1[j] *= sigmoidf_(g1[j]); }
                *(u32x4*)(Y + (size_t)row * 2048 + u.pn * 128 + wc * 32 + 8 * fq) = pack8(v0, v1); }
    }
};
struct EpiSwiGlu {
    static constexpr bool PERM = true, HAS_MID = false;
    bf16_t* Y; const float* RSG;
    __device__ __forceinline__ void operator()(const f32x4 (&acc)[2][2][4][2], const Unit& u, int wr, int wc, int fr, int fq) const {
#pragma unroll
        for (int ai = 0; ai < 2; ++ai)
#pragma unroll
            for (int m = 0; m < 4; ++m) { const int row = u.pm * 256 + ai * 128 + wr * 64 + m * 16 + fr;
                f32x4 v0 = acc[ai][0][m][0], v1 = acc[ai][0][m][1]; const f32x4 g0 = acc[ai][1][m][0], g1 = acc[ai][1][m][1]; const float rr = 1.f;
#pragma unroll
                for (int j = 0; j < 4; ++j) { v0[j] = siluf_(v0[j] * rr) * (g0[j] * rr); v1[j] = siluf_(v1[j] * rr) * (g1[j] * rr); }
                *(u32x4*)(Y + (size_t)row * 512 + u.pn * 128 + wc * 32 + 8 * fq) = pack8(v0, v1); }
    }
};
struct EpiPlainBf16 {
    static constexpr bool PERM = true, HAS_MID = false;
    bf16_t* O;
    __device__ __forceinline__ void operator()(const f32x4 (&acc)[2][2][4][2], const Unit& u, int wr, int wc, int fr, int fq) const {
#pragma unroll
        for (int ai = 0; ai < 2; ++ai)
#pragma unroll
            for (int m = 0; m < 4; ++m) { const int row = u.pm * 256 + ai * 128 + wr * 64 + m * 16 + fr;
#pragma unroll
                for (int bj = 0; bj < 2; ++bj) *(u32x4*)(O + (size_t)row * 1024 + u.pn * 256 + bj * 128 + wc * 32 + 8 * fq) = pack8(acc[ai][bj][m][0], acc[ai][bj][m][1]); }
    }
};
struct EpiMerged {
    static constexpr bool PERM = true, HAS_MID = true;
    unsigned char* ws;
    __device__ __forceinline__ static float lclamp(float l) { return fminf(fmaxf(l, -30.f), 30.f); }
    __device__ __forceinline__ void mid(f32x4 (&acc)[2][2][4][2], const Unit& u, int kt, int wr, int wc, int fr, int fq) const {
        const int br = (kt == 8) ? 0 : 1; const bf16_t* P = (const bf16_t*)(ws + WS_P);
#pragma unroll
        for (int ai = 0; ai < 2; ++ai)
#pragma unroll
            for (int m = 0; m < 4; ++m) { const int row = u.pm * 256 + ai * 128 + wr * 64 + m * 16 + fr;
#pragma unroll
                for (int bj = 0; bj < 2; ++bj) { const bf16_t* gp = P + (size_t)row * NINP + C_G + br * 1024 + u.pn * 256 + bj * 128 + wc * 32 + 8 * fq;
                    const u32x4 la = *(const u32x4*)gp, lb = *(const u32x4*)(gp + 1024);
#pragma unroll
                    for (int j = 0; j < 4; ++j) { const unsigned wa = la[j], wb = lb[j];
                        const float r0 = bflo(wa) * frcp(bflo(wb)), r1 = bfhi(wa) * frcp(bfhi(wb));
                        if (j < 2) { acc[ai][bj][m][0][2 * j] *= r0; acc[ai][bj][m][0][2 * j + 1] *= r1; } else { acc[ai][bj][m][1][2 * j - 4] *= r0; acc[ai][bj][m][1][2 * j - 3] *= r1; } } }
                if (m == 3) asm volatile("" ::: "memory"); }
    }
    __device__ __forceinline__ void operator()(const f32x4 (&acc)[2][2][4][2], const Unit& u, int wr, int wc, int fr, int fq) const {
        const bf16_t* P = (const bf16_t*)(ws + WS_P); bf16_t* O = (bf16_t*)(ws + WS_XN);
#pragma unroll
        for (int ai = 0; ai < 2; ++ai)
#pragma unroll
            for (int m = 0; m < 4; ++m) { const int row = u.pm * 256 + ai * 128 + wr * 64 + m * 16 + fr;
#pragma unroll
                for (int bj = 0; bj < 2; ++bj) { const int col = u.pn * 256 + bj * 128 + wc * 32 + 8 * fq;
                    const u32x4 lc = *(const u32x4*)(P + (size_t)row * NINP + C_G + 2048 + col);
                    f32x4 v0 = acc[ai][bj][m][0], v1 = acc[ai][bj][m][1];
                    v0[0] *= bflo(lc[0]); v0[1] *= bfhi(lc[0]); v0[2] *= bflo(lc[1]); v0[3] *= bfhi(lc[1]);
                    v1[0] *= bflo(lc[2]); v1[1] *= bfhi(lc[2]); v1[2] *= bflo(lc[3]); v1[3] *= bfhi(lc[3]);
                    *(u32x4*)(O + (size_t)row * 1024 + col) = pack8(v0, v1); }
                if (m == 3) asm volatile("" ::: "memory"); }
    }
};
struct EpiResid {
    static constexpr bool PERM = false, HAS_MID = false;
    const float* resid; float* out;
    __device__ __forceinline__ void operator()(const f32x4 (&acc)[2][2][4][2], const Unit& u, int wr, int wc, int fr, int fq) const {
#pragma unroll
        for (int ai = 0; ai < 2; ++ai)
#pragma unroll
            for (int m = 0; m < 4; ++m) { const size_t off = (size_t)(u.pm * 256 + ai * 128 + wr * 64 + m * 16 + fr) * 1024 + u.pn * 256 + wc * 32 + 4 * fq;
#pragma unroll
                for (int bj = 0; bj < 2; ++bj)
#pragma unroll
                    for (int n = 0; n < 2; ++n) { const f32x4 rv = *(const f32x4*)(resid + off + bj * 128 + n * 16); *(f32x4*)(out + off + bj * 128 + n * 16) = rv + acc[ai][bj][m][n]; } }
    }
};

template <unsigned lda, unsigned ldb, int nM, int nN, int NT>
struct SchedDense {
    const char* A; const char* B; int G, c;
    __device__ __forceinline__ bool next(int i, Unit& u) const {
        const int L = i * G + c; if (L >= nM * nN) return false;
        int pm, pn; pg8::tile_order(L, nM, nN, pm, pn);
        u.A = A + (size_t)pm * 256 * lda; u.B = B + (size_t)pn * 256 * ldb; u.nt = NT; u.pm = pm; u.pn = pn; u.aux = 0; return true;
    }
};
struct SchedS5P1 {
    const char* UH; const char* EG; int G, c;
    __device__ __forceinline__ bool next(int i, Unit& u) const {
        const int L = i * G + c; if (L >= 64) return false;
        const int g = L >> 1, pm = L & 1;
        u.A = UH + ((size_t)(g * S5_ROWS + pm * 256) * S5_K + 128) * 2; u.B = EG + (size_t)g * 256 * 512 * 2; u.nt = 8; u.pm = pm; u.pn = 0; u.aux = g; return true;
    }
};
struct SchedS5Main {
    const char* UH; const char* MG; int G, c;
    __device__ __forceinline__ bool next(int i, Unit& u) const {
        const int L = i * G + c; if (L >= 128) return false;
        const int g = L >> 2, pm = (L >> 1) & 1, pn = L & 1;
        u.A = UH + (size_t)(g * S5_ROWS + pm * 256) * S5_K * 2; u.B = MG + (size_t)(g * S5_N + pn * 256) * S5_K * 2; u.nt = 2 + 4 * (pn + 1); u.pm = pm; u.pn = pn; u.aux = g; return true;
    }
};
template <unsigned lda, size_t bexp  , size_t btile  , int NT>
struct SchedMoe {
    const char* A; const char* B; int ntiles, G, c; const volatile LAS int* tile_e;
    __device__ __forceinline__ bool next(int i, Unit& u) const {
        const int L = i * G + c; if (L >= ntiles * 4) return false;
        int pm, pn; pg8::tile_order(L, ntiles, 4, pm, pn);
        const int e = __builtin_amdgcn_readfirstlane(tile_e[pm]);
        u.A = A + (size_t)pm * 256 * lda; u.B = B + (size_t)e * bexp + (size_t)pn * btile; u.nt = NT; u.pm = pm; u.pn = pn; u.aux = e; return true;
    }
};

__device__ __forceinline__ void transpose_item(const float* W, int ldw, int ncols, bf16_t* WT, int ldt, int kofs, int mode, int p0, int p1, LAS float* scr, int k0, int n0, int lane) {
    float wv[32];
#pragma unroll
    for (int i = 0; i < 32; ++i) { const int kk = 2 * i + (lane >> 5), n = n0 + (lane & 31); wv[i] = (n < ncols) ? W[(size_t)(k0 + kk) * ldw + n] : 0.f; }
#pragma unroll
    for (int i = 0; i < 32; ++i) { const int kk = 2 * i + (lane >> 5); scr[kk * 33 + (lane & 31)] = wv[i]; }
    LDS_WAIT(); asm volatile("" ::: "memory");
    const int c = lane & 7;
#pragma unroll
    for (int j = 0; j < 4; ++j) { const int nn = (lane >> 3) + 8 * j, n = n0 + nn; const LAS float* s = scr + (8 * c) * 33 + nn;
        u32x4 o; o.x = pk2(s[0 * 33], s[1 * 33]); o.y = pk2(s[2 * 33], s[3 * 33]); o.z = pk2(s[4 * 33], s[5 * 33]); o.w = pk2(s[6 * 33], s[7 * 33]);
        const int drow = (mode == 0) ? n + (n >= p0 ? p1 : 0) : ((n >> 7) * 256 + (n & 127) + 128 * p0);
        if (n < ncols) *(u32x4*)(WT + (size_t)drow * ldt + kofs + k0 + 8 * c) = o; }
    LDS_WAIT(); asm volatile("" ::: "memory");
}
__device__ __forceinline__ void convert_weights(Frame& F, int layer) {
    LAS float* scr = (LAS float*)(F.lds + F.wave * 16384);
    const int gw = F.bid * NWAVES + F.wave, NGW = F.G * NWAVES;
    bf16_t* WIN = (bf16_t*)(F.ws + WS_WIN); bf16_t* WGLU = (bf16_t*)(F.ws + WS_WGLU); bf16_t* PCAT = (bf16_t*)(F.ws + WS_PCAT); bf16_t* WOUT = (bf16_t*)(F.ws + WS_WOUT);
    bf16_t* EGU = (bf16_t*)(F.ws + WS_EGU); bf16_t* EDN = (bf16_t*)(F.ws + WS_EDN);
    constexpr int I_WIN = 16 * 209, I_GLU = 8 * 16, I_P5 = 8 * 32, I_PS = 16 * 32, I_WO = 16 * 32, I_EG = 32 * 256, I_ED = 32 * 256;
    constexpr int NITEMS = I_WIN + 2 * I_GLU + 2 * I_P5 + I_PS + I_WO + 2 * I_EG + I_ED;
    for (int it = gw; it < NITEMS; it += NGW) {
        int r = it;
        if (r < I_WIN) { transpose_item(F.in[IN_WIN] + (size_t)layer * DM * NIN, NIN, NIN, WIN, DM, 0, 0, 3600, 240, scr, 64 * (r / 209), 32 * (r % 209), F.lane); continue; } r -= I_WIN;
        if (r < I_GLU) { transpose_item(F.in[IN_GLU1] + (size_t)layer * 512 * 512, 512, 512, WGLU, 512, 0, 1, 0, 0, scr, 64 * (r / 16), 32 * (r % 16), F.lane); continue; } r -= I_GLU;
        if (r < I_GLU) { transpose_item(F.in[IN_GLU2] + (size_t)layer * 512 * 512, 512, 512, WGLU, 512, 0, 1, 1, 0, scr, 64 * (r / 16), 32 * (r % 16), F.lane); continue; } r -= I_GLU;
        if (r < I_P5) { transpose_item(F.in[IN_PS5] + (size_t)layer * 512 * 1024, 1024, 1024, PCAT, 2048, 0, 0, 1 << 30, 0, scr, 64 * (r / 32), 32 * (r % 32), F.lane); continue; } r -= I_P5;
        if (r < I_P5) { transpose_item(F.in[IN_PATTN] + (size_t)layer * 512 * 1024, 1024, 1024, PCAT, 2048, 512, 0, 1 << 30, 0, scr, 64 * (r / 32), 32 * (r % 32), F.lane); continue; } r -= I_P5;
        if (r < I_PS) { transpose_item(F.in[IN_PSSD] + (size_t)layer * 1024 * 1024, 1024, 1024, PCAT, 2048, 1024, 0, 1 << 30, 0, scr, 64 * (r / 32), 32 * (r % 32), F.lane); continue; } r -= I_PS;
        if (r < I_WO) { transpose_item(F.in[IN_WOUT] + (size_t)layer * 1024 * 1024, 1024, 1024, WOUT, 1024, 0, 0, 1 << 30, 0, scr, 64 * (r / 32), 32 * (r % 32), F.lane); continue; } r -= I_WO;
        if (r < I_EG) { const int e = r >> 8, q = r & 255; transpose_item(F.in[IN_EG] + ((size_t)layer * 32 + e) * 1024 * 512, 512, 512, EGU + (size_t)e * 1024 * 1024, 1024, 0, 1, 0, 0, scr, 64 * (q / 16), 32 * (q % 16), F.lane); continue; } r -= I_EG;
        if (r < I_EG) { const int e = r >> 8, q = r & 255; transpose_item(F.in[IN_EU] + ((size_t)layer * 32 + e) * 1024 * 512, 512, 512, EGU + (size_t)e * 1024 * 1024, 1024, 0, 1, 1, 0, scr, 64 * (q / 16), 32 * (q % 16), F.lane); continue; } r -= I_EG;
        { const int e = r >> 8, q = r & 255; transpose_item(F.in[IN_ED] + ((size_t)layer * 32 + e) * 512 * 1024, 1024, 1024, EDN + (size_t)e * 1024 * 512, 512, 0, 0, 1 << 30, 0, scr, 64 * (q / 32), 32 * (q % 32), F.lane); }
    }
}
__device__ __forceinline__ void sincos_fast(float x, float& s, float& c) {
    const float k = rintf(x * 0.15915494309189535f);
    float r = fmaf(-k, 6.2831854820251465f, x); r = fmaf(-k, -1.7484555e-07f, r);
    s = __sinf(r); c = __cosf(r);
}
__device__ __forceinline__ void sincos_red(float x, float& s, float& c) {
    const float k = rintf(x * 0.15915494309189535f);
    float r = fmaf(-k, 6.2831854820251465f, x); r = fmaf(-k, -1.7484555e-07f, r);
    s = sinf(r); c = cosf(r);
}
__device__ __forceinline__ void s5_build(Frame& F, int layer) {
    LAS float* pw = (LAS float*)F.lds;
    LAS float* Bb = pw + 33 * 64 * 2;
    LAS float* Cc = Bb + 64 * 16 * 2;
    LAS float* Kd = Cc + 16 * 64 * 2;
    bf16_t* MG = (bf16_t*)(F.ws + WS_MG); bf16_t* EG = (bf16_t*)(F.ws + WS_EG);
    for (int w = F.bid; w < 256; w += F.G) {
        const int g = w >> 3, part = w & 7, gi = layer * 32 + g;
        __syncthreads();
        const float dt = __expf(F.in[IN_LOGDT][gi]);
        for (int i = F.tid; i < 33 * 64; i += NTHR) { const int d = i >> 6, p = i & 63; const float lr = F.in[IN_LRE][gi * 64 + p], li = F.in[IN_LIM][gi * 64 + p];
            float s, c; sincos_red((float)d * li * dt, s, c); const float mg = __expf((float)d * lr * dt); pw[2 * i] = mg * c; pw[2 * i + 1] = mg * s; }
        for (int i = F.tid; i < 64 * 16; i += NTHR) { const int p = i >> 4; const float lr = F.in[IN_LRE][gi * 64 + p], li = F.in[IN_LIM][gi * 64 + p];
            float s, c; sincos_red(li * dt, s, c); const float mg = __expf(lr * dt), are = mg * c, aim = mg * s, nr = are - 1.f, den = lr * lr + li * li;
            const float fre = (nr * lr + aim * li) / den, fim = (aim * lr - nr * li) / den;
            const float br = F.in[IN_BRE][(size_t)gi * 1024 + i], bi = F.in[IN_BIM][(size_t)gi * 1024 + i];
            Bb[2 * i] = fre * br - fim * bi; Bb[2 * i + 1] = fre * bi + fim * br; }
        for (int i = F.tid; i < 16 * 64; i += NTHR) { Cc[2 * i] = F.in[IN_CRE][(size_t)gi * 1024 + i]; Cc[2 * i + 1] = F.in[IN_CIM][(size_t)gi * 1024 + i]; }
        __syncthreads();
        { const int d = F.tid >> 4, c = F.tid & 15; float acc[16];
#pragma unroll
          for (int j = 0; j < 16; ++j) acc[j] = 0.f;
          for (int p = 0; p < 64; ++p) { const float cr = Cc[2 * (c * 64 + p)], ci = Cc[2 * (c * 64 + p) + 1], pr = pw[2 * (d * 64 + p)], pi = pw[2 * (d * 64 + p) + 1];
              const float xr = cr * pr - ci * pi, xi = cr * pi + ci * pr;
#pragma unroll
              for (int q = 0; q < 8; ++q) { const f32x4 bb = *(const LAS f32x4*)(Bb + 2 * (p * 16) + 4 * q); acc[2 * q] += xr * bb.x - xi * bb.y; acc[2 * q + 1] += xr * bb.z - xi * bb.w; } }
#pragma unroll
          for (int j = 0; j < 16; ++j) Kd[(d * 16 + c) * 16 + j] = acc[j]; }
        __syncthreads();
        for (int v = F.tid; v < 64 * 80; v += NTHR) { const int n = part * 64 + v / 80, k0 = (v % 80) * 8, t = n >> 4, c = n & 15; float o[8];
            if (k0 < 128) { const int im = k0 >= 64, p0 = k0 & 63;
#pragma unroll
                for (int j = 0; j < 8; ++j) { const int p = p0 + j; const float cr = Cc[2 * (c * 64 + p)], ci = Cc[2 * (c * 64 + p) + 1], pr = pw[2 * ((t + 1) * 64 + p)], pi = pw[2 * ((t + 1) * 64 + p) + 1];
                    o[j] = im ? -(cr * pi + ci * pr) : (cr * pr - ci * pi); }
            } else { const int s = (k0 - 128) >> 4, c0 = (k0 - 128) & 15;
#pragma unroll
                for (int j = 0; j < 8; ++j) { float x = 0.f; if (s <= t) { x = Kd[(t - s) * 256 + c * 16 + c0 + j]; if (s == t && c == c0 + j) x += F.in[IN_S5D][layer * 512 + g * 16 + c]; } o[j] = x; } }
            u32x4 q; q.x = pk2(o[0], o[1]); q.y = pk2(o[2], o[3]); q.z = pk2(o[4], o[5]); q.w = pk2(o[6], o[7]);
            *(u32x4*)(MG + ((size_t)(g * S5_N + n) * S5_K + k0)) = q; }
        for (int v = F.tid; v < 16 * 64; v += NTHR) { const int jr = part * 16 + v / 64, k0 = (v % 64) * 8, im = jr >= 64, p = jr & 63, s = k0 >> 4, c0 = k0 & 15; float o[8];
            const float pr = pw[2 * ((S5_TC - 1 - s) * 64 + p)], pi = pw[2 * ((S5_TC - 1 - s) * 64 + p) + 1];
#pragma unroll
            for (int j = 0; j < 8; ++j) { const float br = Bb[2 * (p * 16 + c0 + j)], bi = Bb[2 * (p * 16 + c0 + j) + 1]; o[j] = im ? (pr * bi + pi * br) : (pr * br - pi * bi); }
            u32x4 q; q.x = pk2(o[0], o[1]); q.y = pk2(o[2], o[3]); q.z = pk2(o[4], o[5]); q.w = pk2(o[6], o[7]);
            *(u32x4*)(EG + ((size_t)(g * 256 + jr) * 512 + k0)) = q; }
    }
    __syncthreads();
}
__device__ __forceinline__ void rms_row_to_bf16(const float* xrow, const float* gain, bf16_t* orow, int lane) {
    const f32x4* xr = (const f32x4*)xrow + lane; const f32x4* gr = (const f32x4*)gain + lane;
    f32x4 v[4]; float s = 0.f;
#pragma unroll
    for (int j = 0; j < 4; ++j) { v[j] = xr[64 * j]; s += (v[j].x * v[j].x + v[j].y * v[j].y) + (v[j].z * v[j].z + v[j].w * v[j].w); }
    const float rstd = __builtin_amdgcn_rsqf(wave_sum(s) * (1.f / DM) + NORM_EPS);
    unsigned long long* o8 = (unsigned long long*)orow + lane;
#pragma unroll
    for (int j = 0; j < 4; ++j) { const f32x4 gv = gr[64 * j]; o8[64 * j] = (unsigned long long)pk2(v[j].x * rstd * gv.x, v[j].y * rstd * gv.y) | ((unsigned long long)pk2(v[j].z * rstd * gv.z, v[j].w * rstd * gv.w) << 32); }
}
__device__ __forceinline__ void rmsnorm_rows(Frame& F, const float* x, const float* gain, bf16_t* o) {
    const int gw = F.bid * NWAVES + F.wave, NGW = F.G * NWAVES;
    for (int m = gw; m < T; m += NGW) rms_row_to_bf16(x + (size_t)m * DM, gain, o + (size_t)m * DM, F.lane);
}

__device__ __forceinline__ void s5_scan(Frame& F, int layer) {
    const float* HL = (const float*)(F.ws + WS_HLOC); bf16_t* UH = (bf16_t*)(F.ws + WS_UH);
    for (int i = (F.G - 1 - F.bid) * NTHR + F.tid; i < BATCH * 32 * 64; i += F.G * NTHR) {
        const int p = i & 63, g = (i >> 6) & 31, b = i >> 11, gi = layer * 32 + g;
        const float dt = __expf(F.in[IN_LOGDT][gi]), lr = F.in[IN_LRE][gi * 64 + p], li = F.in[IN_LIM][gi * 64 + p];
        float s, c; sincos_red((float)S5_TC * li * dt, s, c); const float mg = __expf((float)S5_TC * lr * dt), ar = mg * c, ai = mg * s;
        float hr = 0.f, hi = 0.f;
        const int nch = SEQ / S5_TC;
        for (int c0 = 0; c0 < nch; c0 += 32) { float lr_[32], li_[32];
#pragma unroll
            for (int k = 0; k < 32; ++k) { const size_t r = (size_t)g * S5_ROWS + b * nch + c0 + k; lr_[k] = HL[r * 128 + p]; li_[k] = HL[r * 128 + 64 + p]; }
#pragma unroll
            for (int k = 0; k < 32; ++k) { const size_t r = (size_t)g * S5_ROWS + b * nch + c0 + k;
                UH[r * S5_K + p] = (bf16_t)f2bf(hr); UH[r * S5_K + 64 + p] = (bf16_t)f2bf(hi);
                const float nr = ar * hr - ai * hi + lr_[k], ni = ar * hi + ai * hr + li_[k]; hr = nr; hi = ni; } }
    }
}

__device__ __forceinline__ void ssd_stage_bc(Frame& F, int layer, int b, int ch, int grp, LAS float* Bs, LAS float* Cs, LAS float* dts, LAS float* das) {
    const bf16_t* P = (const bf16_t*)(F.ws + WS_P); const float* DT = (const float*)(F.ws + WS_DT);
    const float* cw = F.in[IN_CONVW] + layer * 4 * 1280; const float* cb = F.in[IN_CONVB] + layer * 1280;
    const int l0 = ch * 128; const size_t row0 = (size_t)b * SEQ + l0;
    for (int i = F.tid; i < 2 * 128 * 64; i += NTHR) { const int isC = i >> 13, t = (i >> 6) & 127, n = i & 63;
        const int col = (isC ? C_C : C_B) + grp * 64 + n, cc = 1024 + isC * 128 + grp * 64 + n; float a = cb[cc];
#pragma unroll
        for (int j = 0; j < 4; ++j) { const int l = l0 + t - 3 + j; if (l >= 0) a += cw[j * 1280 + cc] * bf2f(P[(row0 + t - 3 + j) * NINP + col]); }
        (isC ? Cs : Bs)[t * 64 + n] = siluf_(a); }
    for (int i = F.tid; i < 128 * 8; i += NTHR) { const int t = i >> 3, hh = i & 7, h = grp * 8 + hh;
        const float dt = softplusf_(DT[(row0 + t) * 16 + h] + F.in[IN_DTB][layer * 16 + h]); dts[i] = dt; das[i] = dt * (-__expf(F.in[IN_ALOG][layer * 16 + h])); }
}
template <bool OUT>
__device__ __forceinline__ void ssd_units(Frame& F, int layer) {
    LAS float* Bs = (LAS float*)F.lds; LAS float* Cs = Bs + 128 * 64; LAS float* dts = Cs + 128 * 64; LAS float* das = dts + 128 * 8; LAS float* ssq = das + 128 * 8;
    const bf16_t* P = (const bf16_t*)(F.ws + WS_P); float* SST = (float*)(F.ws + WS_SST); float* ASUM = (float*)(F.ws + WS_ASUM); bf16_t* YC = (bf16_t*)(F.ws + WS_YCAT);
    const float* cw = F.in[IN_CONVW] + layer * 4 * 1280; const float* cb = F.in[IN_CONVB] + layer * 1280;
    for (int u = F.bid; u < BATCH * SSD_NCH * 2; u += F.G) {
        const int grp = u & 1, ch = (u >> 1) & 31, b = u >> 6;
        __syncthreads();
        ssd_stage_bc(F, layer, b, ch, grp, Bs, Cs, dts, das);
        __syncthreads();
        const int hh = F.wave, h = grp * 8 + hh, p = F.lane, cx = h * 64 + p;
        const float w0 = cw[cx], w1 = cw[1280 + cx], w2 = cw[2560 + cx], w3 = cw[3840 + cx], bias = cb[cx], dsk = F.in[IN_SSDD][layer * 16 + h];
        const int l0 = ch * 128; const size_t row0 = (size_t)b * SEQ + l0;
        const bf16_t* xp = P + row0 * NINP + C_XS + cx;
        float x0 = 0.f, x1 = 0.f, x2 = 0.f;
        if (l0 > 0) { x0 = bf2f(xp[-3 * (ptrdiff_t)NINP]); x1 = bf2f(xp[-2 * (ptrdiff_t)NINP]); x2 = bf2f(xp[-1 * (ptrdiff_t)NINP]); }
        float st[64];
        float* sp = SST + ((((size_t)b * SSD_NCH + ch) * 16 + h) * 64 + p) * 64;
        if (OUT) {
#pragma unroll
            for (int n = 0; n < 64; n += 4) { const f32x4 v = *(const f32x4*)(sp + n); st[n] = v.x; st[n + 1] = v.y; st[n + 2] = v.z; st[n + 3] = v.w; }
        } else {
#pragma unroll
            for (int n = 0; n < 64; ++n) st[n] = 0.f;
        }
        float asum = 0.f;
#pragma unroll 4
        for (int t = 0; t < 128; ++t) {
            const float x3 = bf2f(xp[(size_t)t * NINP]);
            const float xs = siluf_(bias + w0 * x0 + w1 * x1 + w2 * x2 + w3 * x3);
            x0 = x1; x1 = x2; x2 = x3;
            const float dt = dts[t * 8 + hh], a = das[t * 8 + hh], da = __expf(a), xdt = xs * dt;
            asum += a;
            float y = 0.f;
#pragma unroll
            for (int n = 0; n < 64; n += 4) { const f32x4 bv = *(const LAS f32x4*)(Bs + t * 64 + n);
                st[n] = da * st[n] + bv.x * xdt; st[n + 1] = da * st[n + 1] + bv.y * xdt; st[n + 2] = da * st[n + 2] + bv.z * xdt; st[n + 3] = da * st[n + 3] + bv.w * xdt;
                if (OUT) { const f32x4 cv = *(const LAS f32x4*)(Cs + t * 64 + n); y += (cv.x * st[n] + cv.y * st[n + 1]) + (cv.z * st[n + 2] + cv.w * st[n + 3]); } }
            if (OUT) {
                const float z = bf2f(P[(row0 + t) * NINP + C_Z + cx]);
                const float yz = (y + dsk * xs) * siluf_(z);
                const float q = wave_sum(yz * yz);
                if (p == 0) ssq[t * 8 + hh] = q;
                YC[(row0 + t) * 2048 + 1024 + cx] = (bf16_t)f2bf(yz);
            }
        }
        if (!OUT) {
#pragma unroll
            for (int n = 0; n < 64; n += 4) *(f32x4*)(sp + n) = (f32x4){st[n], st[n + 1], st[n + 2], st[n + 3]};
            if (p == 0) ASUM[((size_t)b * SSD_NCH + ch) * 16 + h] = asum;
        } else {
            __syncthreads();
            const float ng = F.in[IN_SSDG][layer * 1024 + cx];
            for (int t = 0; t < 128; ++t) { float q = 0.f;
#pragma unroll
                for (int j = 0; j < 8; ++j) q += ssq[t * 8 + j];
                const float rs = __builtin_amdgcn_rsqf(q * (1.f / 512.f) + NORM_EPS);
                bf16_t* yp = YC + (row0 + t) * 2048 + 1024 + cx; *yp = (bf16_t)f2bf(bf2f(*yp) * rs * ng); }
        }
    }
}
__device__ __forceinline__ void ssd_scan(Frame& F) {
    bf16_t* SST = (bf16_t*)(F.ws + WS_SST); const float* ASUM = (const float*)(F.ws + WS_ASUM);
    for (int i = F.bid * NTHR + F.tid; i < BATCH * 16 * 512; i += F.G * NTHR) {
        const int pn = (i & 511) * 8, h = (i >> 9) & 15, b = i >> 13; float s[8];
#pragma unroll
        for (int j = 0; j < 8; ++j) s[j] = 0.f;
        u32x4 loc[SSD_NCH]; float dec[SSD_NCH];
#pragma unroll
        for (int ch = 0; ch < SSD_NCH; ++ch) { loc[ch] = *(const u32x4*)(SST + (((size_t)b * SSD_NCH + ch) * 16 + h) * 4096 + pn); dec[ch] = ASUM[((size_t)b * SSD_NCH + ch) * 16 + h]; }
#pragma unroll
        for (int ch = 0; ch < SSD_NCH; ++ch) { u32x4 o; o.x = pk2(s[0], s[1]); o.y = pk2(s[2], s[3]); o.z = pk2(s[4], s[5]); o.w = pk2(s[6], s[7]);
            *(u32x4*)(SST + (((size_t)b * SSD_NCH + ch) * 16 + h) * 4096 + pn) = o; const float d = __expf(dec[ch]);
#pragma unroll
            for (int j = 0; j < 4; ++j) { s[2 * j] = s[2 * j] * d + bflo(loc[ch][j]); s[2 * j + 1] = s[2 * j + 1] * d + bfhi(loc[ch][j]); } }
    }
}

__device__ __forceinline__ void attn_units(Frame& F, int layer) {
    LAS float* Ks = (LAS float*)F.lds; LAS float* Vs = Ks + 256 * 64;
    const bf16_t* P = (const bf16_t*)(F.ws + WS_P); bf16_t* YC = (bf16_t*)(F.ws + WS_YCAT);
    const float* qg = F.in[IN_QG] + layer * 64; const float* kg = F.in[IN_KG] + layer * 64;
    for (int u = F.bid; u < BATCH * 32 * 2; u += F.G) {
        const int kvh = u & 1, qb = (u >> 1) & 31, b = u >> 6, q0 = qb * 128;
        int lane = F.lane; asm volatile("" : "+v"(lane));
        __syncthreads();
        for (int jr = F.wave; jr < 256; jr += NWAVES) { const int l = q0 - 128 + jr; float kv = 0.f, vv = 0.f;
            if (l >= 0) { const size_t row = (size_t)b * SEQ + l; const float x = bf2f(P[row * NINP + C_K + kvh * 64 + lane]); vv = bf2f(P[row * NINP + C_V + kvh * 64 + lane]);
                const float rs = __builtin_amdgcn_rsqf(wave_sum(x * x) * (1.f / 64.f) + NORM_EPS); const float xn = x * rs * kg[lane];
                const float other = __shfl_xor(xn, 32); const int i = lane & 31; const float inv = exp2f(-(float)i * (13.287712379549449f / 32.f));
                float s, c; sincos_fast((float)l * inv, s, c);
                kv = (lane < 32) ? (xn * c - other * s) : (xn * c + other * s); }
            Ks[jr * 64 + lane] = kv; Vs[jr * 64 + lane] = vv; }
        __syncthreads();
        const int hh = F.wave >> 1, head = kvh * 4 + hh, qi = q0 + (F.wave & 1) * 64 + lane; const size_t row = (size_t)b * SEQ + qi;
        float q[64];
        { const u32x4* qp = (const u32x4*)(P + row * NINP + C_Q + head * 64); float ss = 0.f;
#pragma unroll
          for (int j = 0; j < 8; ++j) { const u32x4 w = qp[j];
#pragma unroll
              for (int e = 0; e < 4; ++e) { q[8 * j + 2 * e] = bflo(w[e]); q[8 * j + 2 * e + 1] = bfhi(w[e]); } }
#pragma unroll
          for (int d = 0; d < 64; ++d) ss += q[d] * q[d];
          const float rs = __builtin_amdgcn_rsqf(ss * (1.f / 64.f) + NORM_EPS);
#pragma unroll
          for (int d = 0; d < 64; ++d) q[d] = q[d] * rs * qg[d];
#pragma unroll
          for (int i = 0; i < 32; ++i) { const float inv = exp2f(-(float)i * (13.287712379549449f / 32.f)); float s, c; sincos_fast((float)qi * inv, s, c);
              const float a = q[i], bq = q[i + 32]; q[i] = (a * c - bq * s) * 0.125f; q[i + 32] = (bq * c + a * s) * 0.125f; } }
        float o[64];
#pragma unroll
        for (int d = 0; d < 64; ++d) o[d] = 0.f;
        float mx = F.in[IN_SINK][layer * 8 + head], l = 1.f;
        const int qa = q0 + (F.wave & 1) * 64;
        int jlo = qa - 127 - (q0 - 128); if (q0 == 0 && jlo < 128) jlo = 128; const int jhi = qa + 63 - (q0 - 128);
        for (int jr = jlo; jr <= jhi; ++jr) { const int j = q0 - 128 + jr; const bool ok = (j <= qi) && (qi - j < 128);
            float s = 0.f;
#pragma unroll
            for (int d = 0; d < 64; d += 4) { const f32x4 kv = *(const LAS f32x4*)(Ks + jr * 64 + d); s += (q[d] * kv.x + q[d + 1] * kv.y) + (q[d + 2] * kv.z + q[d + 3] * kv.w); if ((d & 12) == 12) __builtin_amdgcn_sched_barrier(0); }
            if (ok) { const float mn = fmaxf(mx, s), al = __expf(mx - mn), pe = __expf(s - mn); l = l * al + pe; mx = mn;
#pragma unroll
                for (int d = 0; d < 64; d += 4) { const f32x4 vv = *(const LAS f32x4*)(Vs + jr * 64 + d); o[d] = o[d] * al + pe * vv.x; o[d + 1] = o[d + 1] * al + pe * vv.y; o[d + 2] = o[d + 2] * al + pe * vv.z; o[d + 3] = o[d + 3] * al + pe * vv.w; if ((d & 12) == 12) __builtin_amdgcn_sched_barrier(0); } } }
        const float il = 1.f / l; u32x4* op = (u32x4*)(YC + row * 2048 + 512 + head * 64);
#pragma unroll
        for (int j = 0; j < 8; ++j) { u32x4 w; w.x = pk2(o[8 * j] * il, o[8 * j + 1] * il); w.y = pk2(o[8 * j + 2] * il, o[8 * j + 3] * il); w.z = pk2(o[8 * j + 4] * il, o[8 * j + 5] * il); w.w = pk2(o[8 * j + 6] * il, o[8 * j + 7] * il); op[j] = w; }
    }
}

typedef short bf16x8_t __attribute__((ext_vector_type(8)));
__device__ __forceinline__ void split_hi_lo(const f32x4 a, const f32x4 b, bf16x8& hi, bf16x8& lo) {
    u32x4 h; h.x = cvtpk(a.x, a.y); h.y = cvtpk(a.z, a.w); h.z = cvtpk(b.x, b.y); h.w = cvtpk(b.z, b.w);
    u32x4 l; l.x = cvtpk(a.x - bflo(h.x), a.y - bfhi(h.x)); l.y = cvtpk(a.z - bflo(h.y), a.w - bfhi(h.y)); l.z = cvtpk(b.x - bflo(h.z), b.y - bfhi(h.z)); l.w = cvtpk(b.z - bflo(h.w), b.w - bfhi(h.w));
    hi = __builtin_bit_cast(bf16x8, h); lo = __builtin_bit_cast(bf16x8, l);
}
__device__ __forceinline__ void router_phase(Frame& F, int layer) {
    constexpr int WROW = 2064;
    LAS unsigned char* Whi = F.lds; LAS unsigned char* Wlo = F.lds + 36 * WROW;
    LAS float* part = (LAS float*)F.lds;
    volatile LAS unsigned* lcnt = (volatile LAS unsigned*)(F.lds + 148 * 1024);
    const float* wrg = F.in[IN_WRG] + (size_t)layer * 1024 * 4; const float* wre = F.in[IN_WRE] + (size_t)layer * 1024 * 32; const float* gain = F.in[IN_NORM2] + layer * 1024;
    const float* X = F.out; bf16_t* H2 = (bf16_t*)(F.ws + WS_XN);
    int* EID = (int*)(F.ws + WS_MOE); float* EW = (float*)(F.ws + WS_MOE + 128 * 1024); int* SLOT = (int*)(F.ws + WS_MOE + 256 * 1024); float* RS = (float*)(F.ws + WS_MOE + 640 * 1024);
    __syncthreads();
    for (int k = F.tid; k < 1024; k += NTHR) { const float g = gain[k]; const f32x4 wg = *(const f32x4*)(wrg + k * 4);
        float w[36]; w[0] = wg.x; w[1] = wg.y; w[2] = wg.z; w[3] = wg.w;
#pragma unroll
        for (int q = 0; q < 8; ++q) { const f32x4 v = *(const f32x4*)(wre + k * 32 + 4 * q); w[4 + 4 * q] = v.x; w[5 + 4 * q] = v.y; w[6 + 4 * q] = v.z; w[7 + 4 * q] = v.w; }
#pragma unroll
        for (int e = 0; e < 36; ++e) { const float x = w[e] * g; const unsigned h = f2bf(x); const unsigned l = f2bf(x - bf2f(h));
            *(LAS unsigned short*)(Whi + e * WROW + k * 2) = (unsigned short)h; *(LAS unsigned short*)(Wlo + e * WROW + k * 2) = (unsigned short)l; } }
    if (F.tid < 32) lcnt[F.tid] = 0u;
    __syncthreads();
    const int TPB = T / F.G;
    int lane = F.lane; asm volatile("" : "+v"(lane));
    const int mt = F.wave & 3, kh = F.wave >> 2, row = lane & 15, kg = lane >> 4;
    const int m = F.bid * TPB + 16 * mt + row;
    f32x4 acc[3] = {{0.f, 0.f, 0.f, 0.f}, {0.f, 0.f, 0.f, 0.f}, {0.f, 0.f, 0.f, 0.f}}; float ss = 0.f;
    int er[3]; er[0] = row; er[1] = 16 + row; er[2] = (32 + row < 36) ? 32 + row : 35;
    if (kh == 0)
#pragma unroll 1
    for (int kb = 0; kb < 4; ++kb) {
        f32x4 xa[8][2];
#pragma unroll
        for (int ks = 0; ks < 8; ++ks) { const float* xp = X + (size_t)m * DM + 256 * kb + 32 * ks + 8 * kg; xa[ks][0] = *(const f32x4*)xp; xa[ks][1] = *(const f32x4*)(xp + 4); }
#pragma unroll
        for (int ks = 0; ks < 8; ++ks) { const int k0 = 256 * kb + 32 * ks + 8 * kg;
            const f32x4 a = xa[ks][0], b = xa[ks][1];
            ss += (a.x * a.x + a.y * a.y) + (a.z * a.z + a.w * a.w) + (b.x * b.x + b.y * b.y) + (b.z * b.z + b.w * b.w);
            bf16x8 ah, al; split_hi_lo(a, b, ah, al); pin_frag(ah); pin_frag(al);
#pragma unroll
            for (int nt = 0; nt < 3; ++nt) { const bf16x8 bh = *(const LAS bf16x8*)(Whi + er[nt] * WROW + k0 * 2), bl = *(const LAS bf16x8*)(Wlo + er[nt] * WROW + k0 * 2);
                acc[nt] = __builtin_amdgcn_mfma_f32_16x16x32_bf16(ah, bh, acc[nt], 0, 0, 0);
                acc[nt] = __builtin_amdgcn_mfma_f32_16x16x32_bf16(ah, bl, acc[nt], 0, 0, 0);
                acc[nt] = __builtin_amdgcn_mfma_f32_16x16x32_bf16(al, bh, acc[nt], 0, 0, 0); } }
    }
    ss += __shfl_xor(ss, 16); ss += __shfl_xor(ss, 32);
    __syncthreads();
    LAS float* ssq = part + 4 * 3 * 64 * 4; LAS float* lg = ssq + 128; volatile LAS int* elist = (volatile LAS int*)(lg + 64 * 40);
    if (kh == 0) {
        const float rstd_row = __builtin_amdgcn_rsqf(ss * (1.f / DM) + NORM_EPS);
        if (kg == 0) { ssq[64 + 16 * mt + row] = rstd_row; RS[m] = rstd_row; }
    }
    __syncthreads();
    if (kh == 0) {
#pragma unroll
        for (int nt = 0; nt < 3; ++nt)
#pragma unroll
            for (int rg = 0; rg < 4; ++rg) { const int e = row + 16 * nt, tk = 16 * mt + 4 * kg + rg; if (e < 36) lg[tk * 40 + e] = acc[nt][rg] * ssq[64 + tk]; }
    }
    __syncthreads();
    if (F.tid < TPB) { const int tk = F.tid, mm = F.bid * TPB + tk; const LAS float* L = lg + tk * 40;
        float gl[4];
#pragma unroll
        for (int k = 0; k < 4; ++k) gl[k] = L[k] + F.in[IN_BRG][layer * 4 + k];
        int gs = 0; float gbest = gl[0];
#pragma unroll
        for (int k = 1; k < 4; ++k) if (gl[k] > gbest) { gbest = gl[k]; gs = k; }
        float den = 0.f;
#pragma unroll
        for (int k = 0; k < 4; ++k) den += __expf(gl[k] - gbest);
        const float pgrp = 1.f / den;
        float el[8];
#pragma unroll
        for (int k = 0; k < 8; ++k) el[k] = L[4 + gs * 8 + k] + F.in[IN_BRE_][layer * 32 + gs * 8 + k];
        int i0 = 0; float v0 = el[0];
#pragma unroll
        for (int k = 1; k < 8; ++k) if (el[k] > v0) { v0 = el[k]; i0 = k; }
        int i1 = -1; float v1 = -3.0e38f;
#pragma unroll
        for (int k = 0; k < 8; ++k) if (k != i0 && el[k] > v1) { v1 = el[k]; i1 = k; }
        const float e1 = __expf(v1 - v0), w0 = pgrp / (1.f + e1), w1 = pgrp * e1 / (1.f + e1);
        const int ea = gs * 8 + i0, eb = gs * 8 + i1;
        EID[2 * mm] = ea; EID[2 * mm + 1] = eb; EW[2 * mm] = w0; EW[2 * mm + 1] = w1;
        elist[2 * tk] = ea; elist[2 * tk + 1] = eb;
    }
    __syncthreads();
    if (F.tid < 32) { const int e = F.tid; int c = 0;
        for (int i = 0; i < 2 * TPB; ++i) { if (elist[i] == e) { SLOT[2 * (F.bid * TPB) + i] = c; ++c; } }
        ((unsigned*)(F.ws + WS_MOE + 512 * 1024))[(size_t)F.bid * 32 + e] = (unsigned)c; }
    __syncthreads();
}
__device__ __forceinline__ int moe_tables(Frame& F, int layer, volatile LAS int* offs, volatile LAS int* tile_e) {
    volatile LAS int* psum = offs + 256;
    const unsigned* CNTB = (const unsigned*)(F.ws + WS_MOE + 512 * 1024);
    __syncthreads();
    { const int e = F.tid & 31, part = F.tid >> 5; int tot = 0, pre = 0; const int per = (F.G + 15) / 16;
      for (int bb = part * per; bb < (part + 1) * per && bb < F.G; ++bb) { const int c = (int)CNTB[(size_t)bb * 32 + e]; tot += c; pre += (bb < F.bid) ? c : 0; }
      psum[part * 32 + e] = tot; psum[512 + part * 32 + e] = pre; }
    __syncthreads();
    if (F.tid < 64) {
        int c = 0, pre = 0;
        if (F.tid < 32) for (int part = 0; part < 16; ++part) { c += psum[part * 32 + F.tid]; pre += psum[512 + part * 32 + F.tid]; }
        const int tl = (c + 255) >> 8; int incl = tl;
#pragma unroll
        for (int o = 1; o < 32; o <<= 1) { const int v = __shfl_up(incl, o); if (F.tid >= o) incl += v; }
        const int excl = incl - tl;
        if (F.tid < 32) { offs[F.tid] = excl * 256 + pre; for (int k = 0; k < tl; ++k) tile_e[excl + k] = F.tid; }
        if (F.tid == 31) offs[32] = incl;
    }
    __syncthreads();
    return __builtin_amdgcn_readfirstlane(offs[32]);
}
__device__ __forceinline__ void gather_phase(Frame& F, int layer, volatile LAS int* offs) {
    const float* X = F.out; const float* gain = F.in[IN_NORM2] + layer * 1024; const float* RS = (const float*)(F.ws + WS_MOE + 640 * 1024); bf16_t* XG = (bf16_t*)(F.ws + WS_XG);
    const int* EID = (const int*)(F.ws + WS_MOE); const int* SLOT = (const int*)(F.ws + WS_MOE + 256 * 1024); int* POS = (int*)(F.ws + WS_MOE + 384 * 1024);
    const int TPB = T / F.G;
    for (int m = F.bid * TPB + F.wave; m < (F.bid + 1) * TPB; m += NWAVES) {
        const f32x4* xr = (const f32x4*)(X + (size_t)m * DM) + F.lane; const f32x4* gr = (const f32x4*)gain + F.lane; const float rs = RS[m];
        u32x2 o[4];
#pragma unroll
        for (int j = 0; j < 4; ++j) { const f32x4 v = xr[64 * j], g = gr[64 * j]; o[j].x = pk2(v.x * rs * g.x, v.y * rs * g.y); o[j].y = pk2(v.z * rs * g.z, v.w * rs * g.w); }
#pragma unroll
        for (int k = 0; k < 2; ++k) { const int pos = offs[EID[2 * m + k]] + SLOT[2 * m + k]; u32x2* dst = (u32x2*)(XG + (size_t)pos * DM) + F.lane;
#pragma unroll
            for (int j = 0; j < 4; ++j) dst[64 * j] = o[j];
            if (F.lane == 0) POS[2 * m + k] = pos; }
    }
}
__device__ __forceinline__ void combine_phase(Frame& F, const float* gain_next, bool dry = false) {
    const bf16_t* Y = (const bf16_t*)(F.ws + WS_YEXP); const float* EW = (const float*)(F.ws + WS_MOE + 128 * 1024); const int* POS = (const int*)(F.ws + WS_MOE + 384 * 1024);
    bf16_t* XN = (bf16_t*)(F.ws + WS_XN);
    const int gw = F.bid * NWAVES + F.wave, NGW = F.G * NWAVES;
    for (int m = gw; m < T; m += NGW) {
        const float w0 = EW[2 * m], w1 = EW[2 * m + 1]; const int p0 = POS[2 * m], p1 = POS[2 * m + 1];
        f32x4* xr = (f32x4*)(F.out + (size_t)m * DM) + F.lane;
        const u32x2* y0 = (const u32x2*)(Y + (size_t)p0 * DM) + F.lane; const u32x2* y1 = (const u32x2*)(Y + (size_t)p1 * DM) + F.lane;
        f32x4 v[4]; float s = 0.f;
#pragma unroll
        for (int j = 0; j < 4; ++j) { v[j] = xr[64 * j]; const u32x2 a = y0[64 * j], b = y1[64 * j];
            v[j].x += w0 * bflo(a.x) + w1 * bflo(b.x); v[j].y += w0 * bfhi(a.x) + w1 * bfhi(b.x); v[j].z += w0 * bflo(a.y) + w1 * bflo(b.y); v[j].w += w0 * bfhi(a.y) + w1 * bfhi(b.y);
            if (!dry) xr[64 * j] = v[j]; s += (v[j].x * v[j].x + v[j].y * v[j].y) + (v[j].z * v[j].z + v[j].w * v[j].w); }
        if (gain_next) { const float rstd = __builtin_amdgcn_rsqf(wave_sum(s) * (1.f / DM) + NORM_EPS); const f32x4* gr = (const f32x4*)gain_next + F.lane;
            unsigned long long* o8 = (unsigned long long*)(XN + (size_t)m * DM) + F.lane;
#pragma unroll
            for (int j = 0; j < 4; ++j) { const f32x4 gv = gr[64 * j]; o8[64 * j] = (unsigned long long)pk2(v[j].x * rstd * gv.x, v[j].y * rstd * gv.y) | ((unsigned long long)pk2(v[j].z * rstd * gv.z, v[j].w * rstd * gv.w) << 32); } }
    }
}

__device__ __forceinline__ int crow32(int reg, int hh) { return (reg & 3) + 8 * (reg >> 2) + 4 * hh; }
__device__ __forceinline__ float wave_incl_scan(float v, int lane) {
#pragma unroll
    for (int o = 1; o < 64; o <<= 1) { const float t = __shfl_up(v, o); if (lane >= o) v += t; }
    return v;
}
__device__ __forceinline__ void conv_frag(const LAS unsigned char* raw, int chan, int ks, int hh, float w0, float w1, float w2, float w3, float bias, float (&out)[8]) {
#pragma unroll
    for (int run = 0; run < 2; ++run) { const int lb = 16 * ks + 8 * run + 4 * hh; float x[7];
#pragma unroll
        for (int i = 0; i < 7; ++i) x[i] = bf2f(*(const LAS unsigned short*)(raw + (lb + i) * 128 + chan * 2));
#pragma unroll
        for (int j = 0; j < 4; ++j) out[4 * run + j] = siluf_(bias + w0 * x[j] + w1 * x[j + 1] + w2 * x[j + 2] + w3 * x[j + 3]); }
}
constexpr int RAWT = 131 * 128;
__device__ __forceinline__ void stage_raw(const bf16_t* P, size_t row0, int l0, int col, LAS unsigned char* dst, int idx0, int stride) {
    for (int base = idx0; base < 131 * 8; base += 8 * stride) { u32x4 v[8];
#pragma unroll
        for (int q = 0; q < 8; ++q) { const int idx = base + q * stride, r = idx >> 3, c8 = idx & 7; v[q] = (u32x4){0u, 0u, 0u, 0u};
            if (idx < 131 * 8 && l0 - 3 + r >= 0) v[q] = *(const u32x4*)(P + (row0 + r - 3) * NINP + col + c8 * 8); }
#pragma unroll
        for (int q = 0; q < 8; ++q) { const int idx = base + q * stride, r = idx >> 3, c8 = idx & 7; if (idx < 131 * 8) *(LAS u32x4*)(dst + r * 128 + c8 * 16) = v[q]; } }
}
__device__ __forceinline__ bf16_t* xf_base(unsigned char* ws, int b, int ch, int h) { return (bf16_t*)(ws + ((b < 2) ? WS_XN : WS_SST) + 16 * MiB) + ((size_t)(((b & 1) * SSD_NCH + ch) * 16 + h)) * 8192; }
__device__ __forceinline__ void ssdA_mfma(Frame& F, int layer) {
    const bf16_t* P = (const bf16_t*)(F.ws + WS_P); const float* DT = (const float*)(F.ws + WS_DT); bf16_t* SST = (bf16_t*)(F.ws + WS_SST); float* ASUM = (float*)(F.ws + WS_ASUM);
    const float* cw = F.in[IN_CONVW] + layer * 4 * 1280; const float* cb = F.in[IN_CONVB] + layer * 1280;
    LAS unsigned char* rawX = F.lds + F.wave * RAWT; LAS unsigned char* rawB = F.lds + 8 * RAWT; LAS float* ftab = (LAS float*)(F.lds + 9 * RAWT) + F.wave * 128;
    for (int u = F.bid; u < BATCH * SSD_NCH * 2; u += F.G) {
        const int grp = u & 1, ch = (u >> 1) & 31, b = u >> 6, h = grp * 8 + F.wave, l0 = ch * 128; const size_t row0 = (size_t)b * SEQ + l0;
        int lane = F.lane; asm volatile("" : "+v"(lane));
        const int r = lane & 31, hh = lane >> 5;
        __syncthreads();
        stage_raw(P, row0, l0, C_XS + h * 64, rawX, lane, 64);
        stage_raw(P, row0, l0, C_B + grp * 64, rawB, F.tid, NTHR);
        { const float dtb = F.in[IN_DTB][layer * 16 + h], A = -__expf(F.in[IN_ALOG][layer * 16 + h]);
          const float dt0 = softplusf_(DT[(row0 + lane) * 16 + h] + dtb), dt1 = softplusf_(DT[(row0 + 64 + lane) * 16 + h] + dtb);
          const float s0 = wave_incl_scan(dt0 * A, lane); const float tot0 = __builtin_bit_cast(float, __builtin_amdgcn_readlane(__builtin_bit_cast(int, s0), 63));
          const float s1 = wave_incl_scan(dt1 * A, lane) + tot0; const float tot = __builtin_bit_cast(float, __builtin_amdgcn_readlane(__builtin_bit_cast(int, s1), 63));
          ftab[lane] = dt0 * __expf(tot - s0); ftab[64 + lane] = dt1 * __expf(tot - s1);
          if (lane == 0) ASUM[((size_t)b * SSD_NCH + ch) * 16 + h] = tot; }
        __syncthreads();
        bf16x8 bfr[2];
#pragma unroll
        for (int q = 0; q < 2; ++q) { const int idx = F.wave * 2 + q, nt = idx >> 3, ks = idx & 7, cc = 1024 + grp * 64 + 32 * nt + r; float v[8];
            conv_frag(rawB, 32 * nt + r, ks, hh, cw[cc], cw[1280 + cc], cw[2560 + cc], cw[3840 + cc], cb[cc], v); bfr[q] = pack8v(v); }
        bf16x8 xw[2][8];
        bf16_t* xf = xf_base(F.ws, b, ch, h);
#pragma unroll
        for (int pt = 0; pt < 2; ++pt) { const int cx = h * 64 + 32 * pt + r; const float w0 = cw[cx], w1 = cw[1280 + cx], w2 = cw[2560 + cx], w3 = cw[3840 + cx], bias = cb[cx];
#pragma unroll
            for (int ks = 0; ks < 8; ++ks) { float v[8]; conv_frag(rawX, 32 * pt + r, ks, hh, w0, w1, w2, w3, bias, v);
                *(bf16x8*)(xf + ((pt * 8 + ks) * 64 + lane) * 8) = pack8v(v);
                const f32x4 fa = *(const LAS f32x4*)(ftab + 16 * ks + 4 * hh), fb = *(const LAS f32x4*)(ftab + 16 * ks + 8 + 4 * hh);
                v[0] *= fa.x; v[1] *= fa.y; v[2] *= fa.z; v[3] *= fa.w; v[4] *= fb.x; v[5] *= fb.y; v[6] *= fb.z; v[7] *= fb.w; { u32x4 pq = __builtin_bit_cast(u32x4, pack8v(v)); asm volatile("" : "+v"(pq) :: "memory"); xw[pt][ks] = __builtin_bit_cast(bf16x8, pq); } } }
        __syncthreads();
#pragma unroll
        for (int q = 0; q < 2; ++q) *(LAS bf16x8*)(rawB + (F.wave * 2 + q) * 1024 + lane * 16) = bfr[q];
        __syncthreads();
        f32x16 acc[2][2];
#pragma unroll
        for (int pt = 0; pt < 2; ++pt)
#pragma unroll
            for (int nt = 0; nt < 2; ++nt)
#pragma unroll
                for (int i = 0; i < 16; ++i) acc[pt][nt][i] = 0.f;
#pragma unroll
        for (int ks = 0; ks < 8; ++ks)
#pragma unroll
            for (int nt = 0; nt < 2; ++nt) { const bf16x8 bq = *(const LAS bf16x8*)(rawB + (nt * 8 + ks) * 1024 + lane * 16);
#pragma unroll
                for (int pt = 0; pt < 2; ++pt) acc[pt][nt] = MFMA32(xw[pt][ks], bq, acc[pt][nt]); }
        bf16_t* sp = SST + (((size_t)b * SSD_NCH + ch) * 16 + h) * 4096;
        settle_acc(acc[0][0]); settle_acc(acc[0][1]); settle_acc(acc[1][0]); settle_acc(acc[1][1]);
#pragma unroll
        for (int pt = 0; pt < 2; ++pt)
#pragma unroll
            for (int nt = 0; nt < 2; ++nt)
#pragma unroll
                for (int i = 0; i < 16; ++i) sp[(32 * pt + crow32(i, hh)) * 64 + 32 * nt + r] = (bf16_t)f2bf(acc[pt][nt][i]);
    }
}
__device__ __forceinline__ void ssdC_mfma(Frame& F, int layer) {
    const bf16_t* P = (const bf16_t*)(F.ws + WS_P); const float* DT = (const float*)(F.ws + WS_DT); const bf16_t* SST = (const bf16_t*)(F.ws + WS_SST); bf16_t* YC = (bf16_t*)(F.ws + WS_YCAT);
    const float* cw = F.in[IN_CONVW] + layer * 4 * 1280; const float* cb = F.in[IN_CONVB] + layer * 1280;
    LAS unsigned char* rawX = F.lds + F.wave * RAWT;
    LAS unsigned char* Bn = F.lds; LAS unsigned char* Cn = F.lds + 18432;
    LAS float* atab = (LAS float*)(F.lds + 36864) + F.wave * 128; LAS float* dtab = (LAS float*)(F.lds + 40960) + F.wave * 128;
    LAS float* ssqp = (LAS float*)(F.lds + 45056); LAS float* gtab = (LAS float*)(F.lds + 49152) + F.wave * 64;
    LAS unsigned char* zt = F.lds + 51200 + F.wave * 4608;
    for (int u = F.bid; u < BATCH * SSD_NCH * 2; u += F.G) {
        const int grp = u & 1, ch = (u >> 1) & 31, b = u >> 6, h = grp * 8 + F.wave, l0 = ch * 128; const size_t row0 = (size_t)b * SEQ + l0;
        int lane = F.lane; asm volatile("" : "+v"(lane));
        const int r = lane & 31, hh = lane >> 5;
        bf16x8 xsf[2][8];
        { const bf16_t* xf = xf_base(F.ws, b, ch, h);
#pragma unroll
          for (int pt = 0; pt < 2; ++pt)
#pragma unroll
              for (int ks = 0; ks < 8; ++ks) xsf[pt][ks] = *(const bf16x8*)(xf + ((pt * 8 + ks) * 64 + lane) * 8); }
        __syncthreads();
        for (int it = F.tid; it < 128 * 16; it += NTHR) { const int l = it >> 4, c8 = it & 15, isC = c8 >> 3, col = (isC ? C_C : C_B) + grp * 64 + (c8 & 7) * 8, cc = 1024 + isC * 128 + grp * 64 + (c8 & 7) * 8;
            float a[8];
#pragma unroll
            for (int e = 0; e < 8; ++e) a[e] = cb[cc + e];
#pragma unroll
            for (int j = 0; j < 4; ++j) { if (l0 + l - 3 + j >= 0) { const u32x4 xv = *(const u32x4*)(P + (row0 + l - 3 + j) * NINP + col);
#pragma unroll
                for (int e = 0; e < 4; ++e) { a[2 * e] += cw[j * 1280 + cc + 2 * e] * bflo(xv[e]); a[2 * e + 1] += cw[j * 1280 + cc + 2 * e + 1] * bfhi(xv[e]); } } }
            u32x4 o; o.x = cvtpk(siluf_(a[0]), siluf_(a[1])); o.y = cvtpk(siluf_(a[2]), siluf_(a[3])); o.z = cvtpk(siluf_(a[4]), siluf_(a[5])); o.w = cvtpk(siluf_(a[6]), siluf_(a[7]));
            *(LAS u32x4*)((isC ? Cn : Bn) + l * 144 + (c8 & 7) * 16) = o; }
        { const float dtb = F.in[IN_DTB][layer * 16 + h], A = -__expf(F.in[IN_ALOG][layer * 16 + h]);
          const float dt0 = softplusf_(DT[(row0 + lane) * 16 + h] + dtb), dt1 = softplusf_(DT[(row0 + 64 + lane) * 16 + h] + dtb);
          const float s0 = wave_incl_scan(dt0 * A, lane); const float tot0 = __builtin_bit_cast(float, __builtin_amdgcn_readlane(__builtin_bit_cast(int, s0), 63));
          const float s1 = wave_incl_scan(dt1 * A, lane) + tot0;
          atab[lane] = s0; atab[64 + lane] = s1; dtab[lane] = dt0; dtab[64 + lane] = dt1; gtab[lane] = F.in[IN_SSDG][layer * 1024 + h * 64 + lane]; }
        const bf16_t* sp = SST + (((size_t)b * SSD_NCH + ch) * 16 + h) * 4096;
        const float dsk = F.in[IN_SSDD][layer * 16 + h];
        LAS unsigned char* pf = F.lds + 90112 + F.wave * 8192;
#pragma unroll
        for (int pt = 0; pt < 2; ++pt)
#pragma unroll
            for (int ks = 0; ks < 4; ++ks) *(LAS bf16x8*)(pf + ((pt * 4 + ks) * 64 + lane) * 16) = *(const bf16x8*)(sp + (32 * pt + r) * 64 + 16 * ks + 8 * hh);
        __syncthreads();
#pragma unroll 1
        for (int li = 0; li < 4; ++li) {
            const size_t rowt = row0 + 32 * li;
            u32x4 zreg[4];
#pragma unroll
            for (int q = 0; q < 4; ++q) { const int idx = lane + 64 * q, rr = idx >> 3, c8 = idx & 7; zreg[q] = *(const u32x4*)(P + (rowt + rr) * NINP + C_Z + h * 64 + c8 * 8); }
            bf16x8 Cf[4];
#pragma unroll
            for (int ks = 0; ks < 4; ++ks) Cf[ks] = *(const LAS bf16x8*)(Cn + (32 * li + r) * 144 + (16 * ks + 8 * hh) * 2);
            f32x16 acc[2];
#pragma unroll
            for (int pt = 0; pt < 2; ++pt)
#pragma unroll
                for (int i = 0; i < 16; ++i) acc[pt][i] = 0.f;
#pragma unroll
            for (int ks = 0; ks < 4; ++ks)
#pragma unroll
                for (int pt = 0; pt < 2; ++pt) acc[pt] = MFMA32(*(const LAS bf16x8*)(pf + ((pt * 4 + ks) * 64 + lane) * 16), Cf[ks], acc[pt]);
            const float al = atab[32 * li + r], el = __expf(al); const int lrel = 32 * li + r;
            settle_acc(acc[0]); settle_acc(acc[1]);
#pragma unroll
            for (int pt = 0; pt < 2; ++pt)
#pragma unroll
                for (int i = 0; i < 16; ++i) acc[pt][i] *= el;
#pragma unroll
            for (int si = 0; si < 4; ++si) if (si <= li) {
                f32x16 X;
#pragma unroll
                for (int i = 0; i < 16; ++i) X[i] = 0.f;
#pragma unroll
                for (int ks = 0; ks < 4; ++ks) { const bf16x8 Bq = *(const LAS bf16x8*)(Bn + (32 * si + r) * 144 + (16 * ks + 8 * hh) * 2); X = MFMA32(Bq, Cf[ks], X); }
                settle_acc(X);
#pragma unroll
                for (int g4 = 0; g4 < 4; ++g4) { const int sb = 32 * si + 8 * g4 + 4 * hh; const f32x4 av = *(const LAS f32x4*)(atab + sb), dv = *(const LAS f32x4*)(dtab + sb);
#pragma unroll
                    for (int j = 0; j < 4; ++j) { const int s = sb + j; float arg = al - av[j]; if (si == li && s > lrel) arg = -100.f;
                        float x = X[4 * g4 + j] * (__expf(arg) * dv[j]); if (si == li && s > lrel) x = 0.f; if (si == li && s == lrel) x += dsk; X[4 * g4 + j] = x; } }
#pragma unroll
                for (int kq = 0; kq < 2; ++kq) { const float v[8] = {X[8 * kq], X[8 * kq + 1], X[8 * kq + 2], X[8 * kq + 3], X[8 * kq + 4], X[8 * kq + 5], X[8 * kq + 6], X[8 * kq + 7]}; bf16x8 Xf = pack8v(v); pin_frag(Xf);
#pragma unroll
                    for (int pt = 0; pt < 2; ++pt) { bf16x8 a;
#pragma unroll
                        for (int q = 0; q < 4; ++q) a = (si == q) ? xsf[pt][2 * q + kq] : a;
                        acc[pt] = MFMA32(a, Xf, acc[pt]); } }
            }
            settle_acc(acc[0]); settle_acc(acc[1]);
#pragma unroll
            for (int q = 0; q < 4; ++q) { const int idx = lane + 64 * q, rr = idx >> 3, c8 = idx & 7; *(LAS u32x4*)(zt + rr * 144 + c8 * 16) = zreg[q]; }
            float qs = 0.f;
#pragma unroll
            for (int pt = 0; pt < 2; ++pt)
#pragma unroll
                for (int g4 = 0; g4 < 4; ++g4) { const u32x2 zz = *(const LAS u32x2*)(zt + r * 144 + (32 * pt + 8 * g4 + 4 * hh) * 2);
                    const float z0 = bflo(zz.x), z1 = bfhi(zz.x), z2 = bflo(zz.y), z3 = bfhi(zz.y);
                    float y0 = acc[pt][4 * g4] * siluf_(z0), y1 = acc[pt][4 * g4 + 1] * siluf_(z1), y2 = acc[pt][4 * g4 + 2] * siluf_(z2), y3 = acc[pt][4 * g4 + 3] * siluf_(z3);
                    acc[pt][4 * g4] = y0; acc[pt][4 * g4 + 1] = y1; acc[pt][4 * g4 + 2] = y2; acc[pt][4 * g4 + 3] = y3; qs += (y0 * y0 + y1 * y1) + (y2 * y2 + y3 * y3); }
            qs += __shfl_xor(qs, 32);
            if (hh == 0) ssqp[(32 * li + r) * 8 + F.wave] = qs;
            __syncthreads();
            { const f32x4 qa = *(const LAS f32x4*)(ssqp + (32 * li + r) * 8), qb = *(const LAS f32x4*)(ssqp + (32 * li + r) * 8 + 4);
              const float rs = __builtin_amdgcn_rsqf(((qa.x + qa.y) + (qa.z + qa.w) + (qb.x + qb.y) + (qb.z + qb.w)) * (1.f / 512.f) + NORM_EPS);
#pragma unroll
              for (int pt = 0; pt < 2; ++pt)
#pragma unroll
                  for (int g4 = 0; g4 < 4; ++g4) { const int p0 = 32 * pt + 8 * g4 + 4 * hh; const f32x4 gv = *(const LAS f32x4*)(gtab + p0);
                      u32x2 o; o.x = cvtpk(acc[pt][4 * g4] * rs * gv.x, acc[pt][4 * g4 + 1] * rs * gv.y); o.y = cvtpk(acc[pt][4 * g4 + 2] * rs * gv.z, acc[pt][4 * g4 + 3] * rs * gv.w);
                      *(LAS u32x2*)(zt + r * 144 + p0 * 2) = o; } }
#pragma unroll
            for (int q = 0; q < 4; ++q) { const int idx = lane + 64 * q, rr = idx >> 3, c8 = idx & 7; *(u32x4*)(YC + (rowt + rr) * 2048 + 1024 + h * 64 + c8 * 8) = *(const LAS u32x4*)(zt + rr * 144 + c8 * 16); }
        }
    }
}

__device__ __forceinline__ void attn_mfma(Frame& F, int layer) {
    LAS unsigned char* Kn = F.lds; LAS unsigned char* VT = F.lds + 36864;
    const bf16_t* P = (const bf16_t*)(F.ws + WS_P); bf16_t* YC = (bf16_t*)(F.ws + WS_YCAT);
    const float* qg = F.in[IN_QG] + layer * 64; const float* kg = F.in[IN_KG] + layer * 64;
    for (int u = F.bid; u < BATCH * 32 * 2; u += F.G) {
        const int kvh = u & 1, qb = (u >> 1) & 31, b = u >> 6, q0 = qb * 128;
        int lane = F.lane; asm volatile("" : "+v"(lane));
        const int r = lane & 31, hh = lane >> 5;
        __syncthreads();
        for (int jr = F.wave; jr < 256; jr += NWAVES) { const int l = q0 - 128 + jr; float kv = 0.f;
            if (l >= 0) { const size_t row = (size_t)b * SEQ + l; const float x = bf2f(P[row * NINP + C_K + kvh * 64 + lane]);
                const float rs = __builtin_amdgcn_rsqf(wave_sum(x * x) * (1.f / 64.f) + NORM_EPS); const float xn = x * rs * kg[lane];
                const float other = __shfl_xor(xn, 32); const int i = lane & 31; const float inv = exp2f(-(float)i * (13.287712379549449f / 32.f));
                float s, c; sincos_fast((float)l * inv, s, c);
                kv = (lane < 32) ? (xn * c - other * s) : (xn * c + other * s); }
            *(LAS unsigned short*)(Kn + jr * 144 + lane * 2) = (unsigned short)f2bf(kv); }
#pragma unroll
        for (int q = 0; q < 4; ++q) { const int it = F.tid + NTHR * q, d = it & 63, ko = it >> 6; unsigned short v[8];
#pragma unroll
            for (int e = 0; e < 8; ++e) { const int l = q0 - 128 + 8 * ko + e; v[e] = (l >= 0) ? P[((size_t)b * SEQ + l) * NINP + C_V + kvh * 64 + d] : (unsigned short)0; }
            u32x4 o; o.x = v[0] | ((unsigned)v[1] << 16); o.y = v[2] | ((unsigned)v[3] << 16); o.z = v[4] | ((unsigned)v[5] << 16); o.w = v[6] | ((unsigned)v[7] << 16);
            *(LAS u32x4*)(VT + d * 528 + ko * 16) = o; }
        __syncthreads();
        const int hd = F.wave >> 1, head = kvh * 4 + hd, qhalf = F.wave & 1; const float sink = F.in[IN_SINK][layer * 8 + head];
#pragma unroll 1
        for (int jt = 0; jt < 2; ++jt) {
            const int qt = q0 + 64 * qhalf + 32 * jt, qi = qt + r, t0 = 2 * qhalf + jt; const size_t row = (size_t)b * SEQ + qi;
            bf16x8 Qf[4];
            { float qv[4][8]; float ss = 0.f;
#pragma unroll
              for (int ks = 0; ks < 4; ++ks) { const u32x4 w = *(const u32x4*)(P + row * NINP + C_Q + head * 64 + 16 * ks + 8 * hh);
#pragma unroll
                  for (int e = 0; e < 4; ++e) { qv[ks][2 * e] = bflo(w[e]); qv[ks][2 * e + 1] = bfhi(w[e]); ss += qv[ks][2 * e] * qv[ks][2 * e] + qv[ks][2 * e + 1] * qv[ks][2 * e + 1]; } }
              ss += __shfl_xor(ss, 32);
              const float rs = __builtin_amdgcn_rsqf(ss * (1.f / 64.f) + NORM_EPS);
#pragma unroll
              for (int ks = 0; ks < 4; ++ks)
#pragma unroll
                  for (int e = 0; e < 8; ++e) qv[ks][e] *= rs * qg[16 * ks + 8 * hh + e];
#pragma unroll
              for (int ks = 0; ks < 2; ++ks)
#pragma unroll
                  for (int e = 0; e < 8; ++e) { const int i = 16 * ks + 8 * hh + e; const float inv = exp2f(-(float)i * (13.287712379549449f / 32.f)); float s, c; sincos_fast((float)qi * inv, s, c);
                      const float a = qv[ks][e], bq = qv[ks + 2][e]; qv[ks][e] = (a * c - bq * s) * 0.125f; qv[ks + 2][e] = (bq * c + a * s) * 0.125f; }
#pragma unroll
              for (int ks = 0; ks < 4; ++ks) { Qf[ks] = pack8v(qv[ks]); pin_frag(Qf[ks]); } }
            f32x16 acc[2];
#pragma unroll
            for (int dt = 0; dt < 2; ++dt)
#pragma unroll
                for (int i = 0; i < 16; ++i) acc[dt][i] = 0.f;
            float m = sink, lsum = 1.f;
#pragma unroll
            for (int tt = 0; tt < 5; ++tt) { const int t = t0 + tt;
                if (q0 == 0 && t < 4) continue;
                f32x16 X;
#pragma unroll
                for (int i = 0; i < 16; ++i) X[i] = 0.f;
#pragma unroll
                for (int ks = 0; ks < 4; ++ks) { const bf16x8 Kq = *(const LAS bf16x8*)(Kn + (32 * t + r) * 144 + (16 * ks + 8 * hh) * 2); X = MFMA32(Kq, Qf[ks], X); }
                settle_acc(X);
                if (tt == 0) {
#pragma unroll
                    for (int i = 0; i < 16; ++i) if (!(r < crow32(i, hh))) X[i] = -INFINITY; }
                if (tt == 4) {
#pragma unroll
                    for (int i = 0; i < 16; ++i) if (!(crow32(i, hh) <= r)) X[i] = -INFINITY; }
                float mx = X[0];
#pragma unroll
                for (int i = 1; i < 16; ++i) mx = fmaxf(mx, X[i]);
                mx = fmaxf(mx, __shfl_xor(mx, 32));
                const float mn = fmaxf(m, mx), al = __expf(m - mn); m = mn;
                float ps = 0.f;
#pragma unroll
                for (int i = 0; i < 16; ++i) { X[i] = __expf(X[i] - mn); ps += X[i]; }
                ps += __shfl_xor(ps, 32);
                lsum = lsum * al + ps;
                settle_acc(acc[0]); settle_acc(acc[1]);
#pragma unroll
                for (int dt = 0; dt < 2; ++dt)
#pragma unroll
                    for (int i = 0; i < 16; ++i) acc[dt][i] *= al;
#pragma unroll
                for (int kq = 0; kq < 2; ++kq) { const float v[8] = {X[8 * kq], X[8 * kq + 1], X[8 * kq + 2], X[8 * kq + 3], X[8 * kq + 4], X[8 * kq + 5], X[8 * kq + 6], X[8 * kq + 7]}; bf16x8 Pf = pack8v(v); pin_frag(Pf);
#pragma unroll
                    for (int dt = 0; dt < 2; ++dt) { const LAS unsigned char* vp = VT + (32 * dt + r) * 528 + (32 * t + 16 * kq + 4 * hh) * 2;
                        const u32x2 va = *(const LAS u32x2*)vp, vb = *(const LAS u32x2*)(vp + 16); const u32x4 vv = {va.x, va.y, vb.x, vb.y}; bf16x8 Vf = __builtin_bit_cast(bf16x8, vv); pin_frag(Vf);
                        acc[dt] = MFMA32(Vf, Pf, acc[dt]); } }
            }
            const float il = 1.f / lsum; settle_acc(acc[0]); settle_acc(acc[1]);
#pragma unroll
            for (int dt = 0; dt < 2; ++dt)
#pragma unroll
                for (int g4 = 0; g4 < 4; ++g4) { u32x2 o; o.x = cvtpk(acc[dt][4 * g4] * il, acc[dt][4 * g4 + 1] * il); o.y = cvtpk(acc[dt][4 * g4 + 2] * il, acc[dt][4 * g4 + 3] * il);
                    *(u32x2*)(YC + row * 2048 + 512 + head * 64 + 32 * dt + 8 * g4 + 4 * hh) = o; }
        }
    }
}

#ifndef MK_PER_PHASE
#define MK_PER_PHASE 0
#endif
constexpr int NPH = 13;
constexpr int TAB_OFF = 150 * 1024;
struct Args { const float* in[N_INPUTS]; float* out; unsigned char* ws; int gp_lo, gp_hi; };
static_assert(sizeof(Args) == (N_INPUTS + 2) * 8 + 8, "no padding in Args");

#ifndef PROBE_ID
#define PROBE_ID 0
#endif
#ifndef PROBE_N
#define PROBE_N 1
#endif
#define REP(id) for (int _r = 0; _r < ((id) == PROBE_ID ? 1 + PROBE_N : 1); ++_r)
extern __shared__ __attribute__((aligned(16))) unsigned char lds_raw[];
__device__ __forceinline__ LAS unsigned char* lds_raw_base() { return (LAS unsigned char*)lds_raw; }
#define LAUNDER() do { asm volatile("" : "+s"(F.in), "+s"(F.ws), "+s"(F.out), "+s"(F.ctl), "+s"(F.bid), "+s"(F.G)); asm volatile("" : "+v"(F.tid)); F.lane = F.tid & 63; F.wave = __builtin_amdgcn_readfirstlane(F.tid >> 6); } while (0)
template <int layer>
__device__ __forceinline__ void layer_body(Frame& F, const int lo, const int hi, const bool rerun) {
    volatile LAS int* offs = (volatile LAS int*)(F.lds + TAB_OFF); volatile LAS int* tile_e = offs + 64;
    XcdBarrier bar; bar.bar = F.ctl + CW_BAR; bar.x = xb_xcc_id(); bar.st = F.MISC;
#define GP(k) (layer * NPH + (k))
#ifdef ONLY_PH
#define IN(k) (((k) == ONLY_PH) && lo <= GP(k) && GP(k) < hi)
#else
#define IN(k) (lo <= GP(k) && GP(k) < hi)
#endif
#define WSB ((const char*)F.ws)
#ifdef DIAG_GP
#define STAMP0(k) do { if (GP(k) == DIAG_GP) { const unsigned t_ = (unsigned)__builtin_amdgcn_s_memrealtime(); if (threadIdx.x == 0) *(volatile LAS unsigned*)((LAS unsigned char*)lds_raw_base() + MISC_OFF + 32) = t_; } } while (0)
#define STAMP1(k) do { if (GP(k) == DIAG_GP) { const unsigned t_ = (unsigned)__builtin_amdgcn_s_memrealtime(); if (threadIdx.x == 0) *(volatile LAS unsigned*)((LAS unsigned char*)lds_raw_base() + MISC_OFF + 40) = t_; } } while (0)
#else
#define STAMP0(k)
#define STAMP1(k)
#endif
#define SEAM(k) do { if (!MK_PER_PHASE && IN(k) && GP(k) + 1 < hi) { xcd_barrier(bar); if (PROBE_ID == 19) { xcd_barrier(bar); xcd_barrier(bar); } } STAMP1(k); } while (0)
        if (IN(0) && layer == 0) { LAUNDER(); STAMP0(0);
            REP(1) { convert_weights(F, 0); __syncthreads(); } REP(2) s5_build(F, 0);
            REP(3) rmsnorm_rows(F, F.in[IN_X], F.in[IN_NORM1], (bf16_t*)(F.ws + WS_XN));
            SEAM(0);
        }
        if (IN(1)) { LAUNDER(); STAMP0(1);
            SchedDense<2048u, 2048u, T / 256, NINP / 256, 16> S{WSB + WS_XN, WSB + WS_WIN, F.G, F.bid};
            EpiProj E{F.ws, F.in[IN_BGATE] + layer * 3072};
            REP(4) pg8::gemm_phase<2048u, 2048u>(F.tid, F.lds, S, E);
            SEAM(1);
        }
        if (IN(2)) { LAUNDER(); STAMP0(2);
            SchedS5P1 S{WSB + WS_UH, WSB + WS_EG, F.G, F.bid};
            EpiHloc E{(float*)(F.ws + WS_HLOC)};
            REP(5) pg8::gemm_phase<(unsigned)(S5_K * 2), 1024u>(F.tid, F.lds, S, E);
            REP(6) ssdA_mfma(F, layer);
            REP(8) attn_mfma(F, layer);
            SEAM(2);
        }
        if (IN(3)) { LAUNDER(); STAMP0(3);
            REP(7) s5_scan(F, layer);
            if (!rerun) ssd_scan(F);
            SEAM(3);
        }
        if (IN(4)) { LAUNDER(); STAMP0(4);
            SchedS5Main S{WSB + WS_UH, WSB + WS_MG, F.G, F.bid};
            EpiS5Y E{(bf16_t*)(F.ws + WS_XN)};
            REP(9) pg8::gemm_phase<(unsigned)(S5_K * 2), (unsigned)(S5_K * 2)>(F.tid, F.lds, S, E);
            REP(10) ssdC_mfma(F, layer);
            SEAM(4);
        }
        if (IN(5)) { LAUNDER(); STAMP0(5);
            SchedDense<1024u, 1024u, T / 256, 4, 8> S{WSB + WS_XN, WSB + WS_WGLU, F.G, F.bid};
            EpiGlu E{(bf16_t*)(F.ws + WS_YCAT)};
            REP(11) pg8::gemm_phase<1024u, 1024u>(F.tid, F.lds, S, E);
            SEAM(5);
        }
        if (IN(6)) { LAUNDER(); STAMP0(6);
            SchedDense<4096u, 4096u, T / 256, 4, 32> S{WSB + WS_YCAT, WSB + WS_PCAT, F.G, F.bid};
            EpiMerged E{F.ws};
            REP(12) pg8::gemm_phase<4096u, 4096u>(F.tid, F.lds, S, E);
            SEAM(6);
        }
        if (IN(7)) { LAUNDER(); STAMP0(7);
            SchedDense<2048u, 2048u, T / 256, 4, 16> S{WSB + WS_XN, WSB + WS_WOUT, F.G, F.bid};
            EpiResid E{layer == 0 ? F.in[IN_X] : (const float*)F.out, F.out};
            REP(layer == 0 ? 13 : -1) pg8::gemm_phase<2048u, 2048u>(F.tid, F.lds, S, E);
            SEAM(7);
        }
        if (IN(8)) { LAUNDER(); STAMP0(8); REP(17) router_phase(F, layer); SEAM(8); }
        if (IN(9)) { LAUNDER(); STAMP0(9); (void)moe_tables(F, layer, offs, tile_e); REP(14) gather_phase(F, layer, offs); SEAM(9); }
        if (IN(10)) { LAUNDER(); STAMP0(10);
            const int ntiles = moe_tables(F, layer, offs, tile_e);
            SchedMoe<2048u, (size_t)1024 * 1024 * 2, (size_t)256 * 2048, 16> S{WSB + WS_XG, WSB + WS_EGU, ntiles, F.G, F.bid, tile_e};
            EpiSwiGlu E{(bf16_t*)(F.ws + WS_HID), (const float*)(F.ws + WS_MOE + 704 * 1024)};
            REP(15) pg8::gemm_phase<2048u, 2048u>(F.tid, F.lds, S, E);
            SEAM(10);
        }
        if (IN(11)) { LAUNDER(); STAMP0(11);
            const int ntiles = moe_tables(F, layer, offs, tile_e);
            SchedMoe<1024u, (size_t)1024 * 512 * 2, (size_t)256 * 1024, 8> S{WSB + WS_HID, WSB + WS_EDN, ntiles, F.G, F.bid, tile_e};
            EpiPlainBf16 E{(bf16_t*)(F.ws + WS_YEXP)};
            REP(16) pg8::gemm_phase<1024u, 1024u>(F.tid, F.lds, S, E);
            SEAM(11);
        }
        if (IN(12)) { LAUNDER(); STAMP0(12);
            if (PROBE_ID == 18) combine_phase(F, F.in[IN_NORM1], true);
            combine_phase(F, layer + 1 < DEPTH ? F.in[IN_NORM1] + (layer + 1) * 1024 : nullptr);
            if (layer + 1 < DEPTH) { __syncthreads(); convert_weights(F, layer + 1); __syncthreads(); s5_build(F, layer + 1); }
            SEAM(12);
        }
#undef GP
#undef IN
#undef SEAM
#undef WSB
}
__global__ void __launch_bounds__(NTHR, 2) fwd(Args args) {
    Frame F;
    F.lds = (LAS unsigned char*)lds_raw;
    F.MISC = (volatile LAS unsigned*)(F.lds + MISC_OFF);
    F.tid = threadIdx.x; F.lane = F.tid & 63; F.wave = __builtin_amdgcn_readfirstlane(F.tid >> 6);
    F.G = gridDim.x; F.bid = blockIdx.x;
    const __attribute__((address_space(4))) char* ka = (const __attribute__((address_space(4))) char*)__builtin_amdgcn_kernarg_segment_ptr();
    F.in = (const float* const __attribute__((address_space(4)))*)ka;
    F.out = *(float* const __attribute__((address_space(4)))*)(ka + N_INPUTS * 8); F.ws = *(unsigned char* const __attribute__((address_space(4)))*)(ka + N_INPUTS * 8 + 8); F.ctl = (unsigned*)(F.ws + WS_CTL);
    if (F.tid < 64) F.MISC[F.tid] = 0u;
    __syncthreads();
    XcdBarrier bar; bar.bar = F.ctl + CW_BAR; bar.x = 0; bar.st = nullptr;
    if (!MK_PER_PHASE) bar = xcd_barrier_post(F.ctl + CW_BAR, F.MISC);
    const int lo = *(const __attribute__((address_space(4))) int*)(ka + N_INPUTS * 8 + 16), hi_raw = *(const __attribute__((address_space(4))) int*)(ka + N_INPUTS * 8 + 20), hi = hi_raw & 0xffff;

    layer_body<0>(F, lo, hi, (hi_raw >> 16) != 0);
    layer_body<1>(F, lo, hi, (hi_raw >> 16) != 0);
#ifdef DIAG_GP
    __syncthreads();
    if (blockIdx.x == 0 && threadIdx.x == 0) { const unsigned t0 = *(volatile LAS unsigned*)((LAS unsigned char*)lds_raw_base() + MISC_OFF + 32), t1 = *(volatile LAS unsigned*)((LAS unsigned char*)lds_raw_base() + MISC_OFF + 40); float* o_ = *(float* const __attribute__((address_space(4)))*)((const __attribute__((address_space(4))) char*)__builtin_amdgcn_kernarg_segment_ptr() + N_INPUTS * 8); asm volatile("s_waitcnt vmcnt(0)" ::: "memory"); o_[0] = (float)(t1 - t0); }
#endif
}

extern "C" void kernel_launch(void* const* d_in, const int* in_sizes, int n_in, void* d_out, int out_size, void* d_ws, size_t ws_size, hipStream_t stream) {
    static int grid = 0;
    if (grid == 0) {
        if (n_in != N_INPUTS || out_size != T * DM || ws_size < WS_END) { fprintf(stderr, "kernel_launch: unexpected shapes (n_in %d out %d ws %zu need %zu)\n", n_in, out_size, ws_size, (size_t)WS_END); grid = -1; return; }
        int dev = 0, cus = 0, per_cu = 0;
        if (hipGetDevice(&dev) != hipSuccess || hipDeviceGetAttribute(&cus, hipDeviceAttributeMultiprocessorCount, dev) != hipSuccess) { grid = -1; return; }
        if (hipFuncSetAttribute((const void*)fwd, hipFuncAttributeMaxDynamicSharedMemorySize, LDS_BYTES) != hipSuccess) { fprintf(stderr, "kernel_launch: hipFuncSetAttribute failed\n"); grid = -1; return; }
        if (hipOccupancyMaxActiveBlocksPerMultiprocessor(&per_cu, (const void*)fwd, NTHR, LDS_BYTES) != hipSuccess || per_cu < 1) fprintf(stderr, "kernel_launch: occupancy query reports %d\n", per_cu);
        (void)hipGetLastError();
        grid = cus;
    }
    if (grid < 0) return;
    (void)hipMemsetAsync((char*)d_ws + WS_CTL, 0, CTL_ZERO_BYTES, stream);
    Args a{};
    for (int i = 0; i < N_INPUTS; ++i) a.in[i] = (const float*)d_in[i];
    a.out = (float*)d_out; a.ws = (unsigned char*)d_ws;
#if MK_PER_PHASE
    for (int gp = 0; gp < DEPTH * NPH; ++gp) {
        if (gp == NPH) continue;
        a.gp_lo = gp; a.gp_hi = gp + 1;
        int nrep = 1;
#ifdef PP_REP_GP
        if (gp == PP_REP_GP) nrep = 1 + PP_REP_N;
#endif
        for (int rr = 0; rr < nrep; ++rr) { a.gp_hi = (gp + 1) | (rr > 0 ? 0x10000 : 0); hipLaunchKernelGGL(fwd, dim3(grid), dim3(NTHR), LDS_BYTES, stream, a); }
    }
#else
    a.gp_lo = 0; a.gp_hi = DEPTH * NPH;
    hipLaunchKernelGGL(fwd, dim3(grid), dim3(NTHR), LDS_BYTES, stream, a);
#endif
}
```

```cpp
#include <hip/hip_runtime.h>
#include <cstdio>
#include <cstdint>

#define LAS __attribute__((address_space(3)))
#define GAS __attribute__((address_space(1)))
typedef unsigned short bf16_t;
typedef short bf16x8 __attribute__((ext_vector_type(8)));
typedef float f32x4 __attribute__((ext_vector_type(4)));
typedef float f32x2 __attribute__((ext_vector_type(2)));
typedef unsigned u32x4 __attribute__((ext_vector_type(4)));
typedef unsigned u32x2 __attribute__((ext_vector_type(2)));

constexpr int BATCH = 4, SEQ = 4096, DM = 1024, T = BATCH * SEQ, DEPTH = 2;
constexpr int NIN = 6672, NINP = 6912;
constexpr int C_U = 0, C_Q = 512, C_K = 1024, C_V = 1152, C_Z = 1280, C_XS = 2304, C_B = 3328, C_C = 3456, C_DT = 3584, C_G = 3840;
constexpr int S5_TC = 32, S5_ROWS = T / S5_TC  , S5_K = 128 + S5_TC * 16  , S5_N = S5_TC * 16  ;
constexpr int SSD_NCH = SEQ / 128;
constexpr int MOE_MAXROWS = 2 * T + 32 * 256;
constexpr float NORM_EPS = 1e-6f;

constexpr size_t MiB = 1u << 20;
constexpr size_t WS_CTL = 0, CTL_ZERO_BYTES = 1 * MiB;
constexpr size_t WS_WIN = 1 * MiB;
constexpr size_t WS_WGLU = WS_WIN + (size_t)NINP * DM * 2;
constexpr size_t WS_PCAT = WS_WGLU + 1 * MiB;
constexpr size_t WS_WOUT = WS_PCAT + 4 * MiB;
constexpr size_t WS_EGU = WS_WOUT + 2 * MiB;
constexpr size_t WS_EDN = WS_EGU + 64 * MiB;
constexpr size_t WS_MG = WS_EDN + 32 * MiB;
constexpr size_t WS_EG = WS_MG + 20 * MiB;
constexpr size_t WS_XN = WS_EG + 8 * MiB;
constexpr size_t WS_P = WS_XN + 32 * MiB;
constexpr size_t WS_XG = WS_P;
constexpr size_t WS_HID = WS_XG + (size_t)MOE_MAXROWS * 1024 * 2;
constexpr size_t WS_YEXP = WS_HID + (size_t)MOE_MAXROWS * 512 * 2;
constexpr size_t WS_DT = WS_P + 216 * MiB;
constexpr size_t WS_UH = WS_DT + 1 * MiB;
constexpr size_t WS_HLOC = WS_UH + 20 * MiB;
constexpr size_t WS_YCAT = WS_HLOC + 8 * MiB;
constexpr size_t WS_SST = WS_YCAT + 64 * MiB;
constexpr size_t WS_MOE = WS_SST + 32 * MiB;
constexpr size_t WS_ASUM = WS_MOE + 1 * MiB;
constexpr size_t WS_END = WS_ASUM + 64 * 1024;
static_assert(WS_YEXP + (size_t)MOE_MAXROWS * 1024 * 2 <= WS_DT, "MoE overlay fits in P");
constexpr int CW_BAR = 4096;
constexpr int CW_CNT = 16384;

constexpr int NWAVES = 8, NTHR = 512;
constexpr int LDS_BYTES = 163840;
constexpr int RING_BYTES = 131072;
constexpr int MISC_OFF = 160 * 1024 - 256;

__device__ __forceinline__ unsigned f2bf(float f) { unsigned u = __builtin_bit_cast(unsigned, f); return (u + 0x7fffu + ((u >> 16) & 1u)) >> 16; }
typedef float f32x2_t __attribute__((ext_vector_type(2)));
typedef __bf16 bf16x2_t __attribute__((ext_vector_type(2)));
__device__ __forceinline__ unsigned pk2(float lo, float hi) { f32x2_t v = {lo, hi}; bf16x2_t b = __builtin_convertvector(v, bf16x2_t); return __builtin_bit_cast(unsigned, b); }
__device__ __forceinline__ float bf2f(unsigned b) { return __builtin_bit_cast(float, b << 16); }
__device__ __forceinline__ float bflo(unsigned w) { return __builtin_bit_cast(float, w << 16); }
__device__ __forceinline__ float bfhi(unsigned w) { return __builtin_bit_cast(float, w & 0xffff0000u); }
#define WS_DPP(v, ctrl, rmask) __builtin_bit_cast(float, __builtin_amdgcn_update_dpp(0, __builtin_bit_cast(int, v), ctrl, rmask, 0xF, false))
__device__ __forceinline__ float wave_sum(float v) {
    v += WS_DPP(v, 0xB1, 0xF);
    v += WS_DPP(v, 0x4E, 0xF);
    v += WS_DPP(v, 0x141, 0xF);
    v += WS_DPP(v, 0x140, 0xF);
    v += WS_DPP(v, 0x142, 0xA);
    v += WS_DPP(v, 0x143, 0xC);
    return __builtin_bit_cast(float, __builtin_amdgcn_readlane(__builtin_bit_cast(int, v), 63));
}
__device__ __forceinline__ float frcp(float x) { return __builtin_amdgcn_rcpf(x); }
__device__ __forceinline__ float sigmoidf_(float x) { return frcp(1.0f + __expf(-x)); }
__device__ __forceinline__ float siluf_(float x) { return x * frcp(1.0f + __expf(-x)); }
__device__ __forceinline__ float gelu_tanh_(float x) { const float u = 0.7978845608f * (x + 0.044715f * x * x * x); return x * frcp(1.0f + __expf(-2.0f * u)); }
__device__ __forceinline__ float softplusf_(float x) { return x > 20.f ? x : log1pf(__expf(x)); }

typedef float f32x16 __attribute__((ext_vector_type(16)));
#define MFMA32(a, b, c) __builtin_amdgcn_mfma_f32_32x32x16_bf16((a), (b), (c), 0, 0, 0)
__device__ __forceinline__ unsigned cvtpk(float lo, float hi) { f32x2_t v = {lo, hi}; bf16x2_t b = __builtin_convertvector(v, bf16x2_t); return __builtin_bit_cast(unsigned, b); }
__device__ __forceinline__ void pin_frag(bf16x8& f) { u32x4 t = __builtin_bit_cast(u32x4, f); asm volatile("s_nop 1" : "+v"(t)); f = __builtin_bit_cast(bf16x8, t); }
__device__ __forceinline__ void settle_acc(f32x16& x) { asm volatile("s_nop 15\n\ts_nop 3" : "+v"(x)); }
__device__ __forceinline__ bf16x8 pack8v(const float (&v)[8]) { u32x4 p; p.x = cvtpk(v[0], v[1]); p.y = cvtpk(v[2], v[3]); p.z = cvtpk(v[4], v[5]); p.w = cvtpk(v[6], v[7]); return __builtin_bit_cast(bf16x8, p); }

#define XB_TMO      128
#define XB_XCNT(j)  (256  + 64 * (j))
#define XB_XSUB(j)  (1280 + 64 * (j))
#define XB_XGEN(j)  (2304 + 64 * (j))
#define XB_TOP      3328
#define XB_TOPGEN   3392
#define XCD_BAR_WORDS 3456
#define XB_SPIN_CAP (1u << 18)
__device__ __forceinline__ unsigned xb_ld(unsigned* p)              { return __hip_atomic_load(p, __ATOMIC_RELAXED, __HIP_MEMORY_SCOPE_AGENT); }
__device__ __forceinline__ unsigned xb_add(unsigned* p, unsigned v) { return __hip_atomic_fetch_add(p, v, __ATOMIC_RELAXED, __HIP_MEMORY_SCOPE_AGENT); }
__device__ __forceinline__ unsigned xb_xcc_id() { return (unsigned)__builtin_amdgcn_s_getreg((3 << 11) | 20) & 0xFu; }
#define XB_SPIN(cond, bar) do { unsigned _sp = 0; while (cond) { __builtin_amdgcn_s_sleep(1); \
    if ((++_sp & 255u) == 0u) { if (xb_ld(&(bar)[XB_TMO])) break; if (_sp > XB_SPIN_CAP) { atomicAdd(&(bar)[XB_TMO], 1u); break; } } } } while (0)
struct XcdBarrier { unsigned* bar; unsigned x; volatile LAS unsigned* st; };
__device__ __forceinline__ XcdBarrier xcd_barrier_post(unsigned* bar, volatile LAS unsigned* st) {
    XcdBarrier b; b.bar = bar; b.x = xb_xcc_id(); b.st = st;
    if (threadIdx.x == 0) (void)xb_add(&bar[XB_XCNT(b.x)], 1u);
    return b;
}
__device__ __forceinline__ void xcd_barrier_complete(unsigned* bar, unsigned x, unsigned& nloc, unsigned& nx) {
    const unsigned G = gridDim.x * gridDim.y * gridDim.z;
    unsigned sum, cnt, mine, sp = 0u;
    for (;;) {
        sum = 0u; cnt = 0u; mine = 0u;
#pragma unroll
        for (unsigned j = 0; j < 16; ++j) { const unsigned c = xb_ld(&bar[XB_XCNT(j)]); sum += c; cnt += (c > 0u) ? 1u : 0u; mine = (j == x) ? c : mine; }
        if (sum == G) break;
        __builtin_amdgcn_s_sleep(1);
        if ((++sp & 255u) == 0u) { if (xb_ld(&bar[XB_TMO])) break; if (sp > XB_SPIN_CAP) { atomicAdd(&bar[XB_TMO], 1u); break; } }
    }
    nloc = mine > 0u ? mine : 1u; nx = cnt > 0u ? cnt : 1u;
}
__device__ __forceinline__ void xcd_barrier(const XcdBarrier& b) {
    asm volatile("s_waitcnt vmcnt(0)" ::: "memory");
    __syncthreads();
    if (threadIdx.x == 0) {
        unsigned* bar = b.bar;
        __builtin_amdgcn_s_waitcnt(0);
        unsigned nloc = b.st[0], nx = b.st[1];
        if (nloc == 0u) { xcd_barrier_complete(bar, b.x, nloc, nx); b.st[0] = nloc; b.st[1] = nx; }
        const unsigned old = xb_add(&bar[XB_XSUB(b.x)], 1u);
        const unsigned gen = old / nloc;
        if (old + 1u == (gen + 1u) * nloc) {
            __builtin_amdgcn_fence(__ATOMIC_RELEASE, "agent");
            asm volatile("s_waitcnt vmcnt(0)" ::: "memory");
            const unsigned og = xb_add(&bar[XB_TOP], 1u);
            const unsigned tg = og / nx;
            if (og + 1u == (tg + 1u) * nx) xb_add(&bar[XB_TOPGEN], 1u);
            else XB_SPIN(xb_ld(&bar[XB_TOPGEN]) == tg, bar);
            __builtin_amdgcn_fence(__ATOMIC_ACQUIRE, "agent");
            xb_add(&bar[XB_XGEN(b.x)], 1u);
            asm volatile("s_waitcnt vmcnt(0)" ::: "memory");
        } else {
            XB_SPIN(xb_ld(&bar[XB_XGEN(b.x)]) == gen, bar);
            __builtin_amdgcn_fence(__ATOMIC_ACQUIRE, "agent");
            asm volatile("s_waitcnt vmcnt(0)" ::: "memory");
        }
    }
    __syncthreads();
}

namespace pg8 {
constexpr int BM = 256, BK = 64, HALF = 128, HTB = HALF * BK * 2, STAGE_BYTES = 8 * HTB, NXCD = 8, WGM = 8;
__host__ __device__ __forceinline__ int lds_byte(int r, int c) { const int st = (r >> 4) * 2 + (c >> 5), rr = r & 15, cc = c & 31, ob = rr * 64 + cc * 2; return st * 1024 + (ob ^ (((ob >> 9) & 1) << 5)); }
__host__ __device__ __forceinline__ void stage_rc(int b, int& R, int& C) { const int st = b / 1024, sb = b % 1024, swz = sb ^ (((sb >> 9) & 1) << 5); R = (st >> 1) * 16 + swz / 64; C = (st & 1) * 32 + (swz % 64) / 2; }
__host__ __device__ __forceinline__ int perm32(int rho) { const int n = rho >> 4, i = rho & 15; return 8 * (i >> 2) + 4 * n + (i & 3); }

struct Unit { const char* A; const char* B; int nt; int pm, pn, aux; };

__device__ __forceinline__ void tile_order(int L, int nM, int nN, int& pm, int& pn) {
    const int nwg = nM * nN; int wgid = L;
    { const int q = nwg / NXCD, r = nwg % NXCD, xcd = wgid % NXCD, off = wgid / NXCD; wgid = (xcd < r ? xcd * (q + 1) : r * (q + 1) + (xcd - r) * q) + off; }
    const int nig = WGM * nN, gid = wgid / nig, fm = gid * WGM, gsz = (nM - fm) < WGM ? (nM - fm) : WGM;
    pm = fm + ((wgid % nig) % gsz); pn = (wgid % nig) / gsz;
}
__device__ __forceinline__ unsigned cvt_pk_bf16(float lo, float hi) { unsigned r; asm volatile("v_cvt_pk_bf16_f32 %0, %1, %2" : "=v"(r) : "v"(lo), "v"(hi)); return r; }
__device__ __forceinline__ u32x4 pack8(const f32x4 v0, const f32x4 v1) { u32x4 w; w.x = cvt_pk_bf16(v0[0], v0[1]); w.y = cvt_pk_bf16(v0[2], v0[3]); w.z = cvt_pk_bf16(v1[0], v1[1]); w.w = cvt_pk_bf16(v1[2], v1[3]); return w; }

template <unsigned lda, unsigned ldb, class Epi, class Sched>
__device__ __forceinline__ void gemm_phase(const int tid, LAS unsigned char* lds, const Sched& S, const Epi& E) {
    const int wid = __builtin_amdgcn_readfirstlane(tid >> 6), lane = tid & 63, wr = wid >> 2, wc = wid & 3, fr = lane & 15, fq = lane >> 4;
    unsigned voffA[2], voffB[2];
#pragma unroll
    for (int i = 0; i < 2; ++i) { int R, C; stage_rc(tid * 16 + i * 8192, R, C); const int Rb = Epi::PERM ? ((R & ~31) + perm32(R & 31)) : R;
        voffA[i] = (unsigned)R * lda + (unsigned)C * 2u; voffB[i] = (unsigned)Rb * ldb + (unsigned)C * 2u; }
    const size_t kstep = (size_t)(BK * 2);
    const size_t hstepA = (size_t)HALF * lda, hstepB = (size_t)HALF * ldb;
    const unsigned ldsw = (unsigned)wid * 1024u;
    const int aoff = lds_byte(wr * 64 + fr, fq * 8), boff = lds_byte(wc * 32 + fr, fq * 8);
#define PG8_SA(b, h) (((b) * 2 + (h)) * HTB)
#define PG8_SB(b, h) ((4 + (b) * 2 + (h)) * HTB)
#define PG8_STAGE(bufoff, gbase, voff) do { const char* _gb = (const char*)(gbase); asm volatile("" : "+s"(_gb)); _Pragma("unroll") for (int _i = 0; _i < 2; ++_i) \
        __builtin_amdgcn_global_load_lds((const unsigned*)(_gb + (voff)[_i]), (LAS unsigned*)(lds + (bufoff) + ldsw + _i * 8192), 16, 0, 0); } while (0)
#define PG8_LDA(dst, b, h) do { _Pragma("unroll") for (int m = 0; m < 4; ++m) _Pragma("unroll") for (int k = 0; k < 2; ++k) dst[m][k] = *(const LAS bf16x8*)(lds + PG8_SA(b, h) + aoff + m * 2048 + k * 1024); } while (0)
#define PG8_LDB(dst, b, h) do { _Pragma("unroll") for (int n = 0; n < 2; ++n) _Pragma("unroll") for (int k = 0; k < 2; ++k) dst[n][k] = *(const LAS bf16x8*)(lds + PG8_SB(b, h) + boff + n * 2048 + k * 1024); } while (0)
#define PG8_MMA(ai, bj, At, Bt) do { __builtin_amdgcn_s_setprio(1); _Pragma("unroll") for (int m = 0; m < 4; ++m) _Pragma("unroll") for (int n = 0; n < 2; ++n) _Pragma("unroll") for (int k = 0; k < 2; ++k) \
        acc[ai][bj][m][n] = __builtin_amdgcn_mfma_f32_16x16x32_bf16(Bt[n][k], At[m][k], acc[ai][bj][m][n], 0, 0, 0); __builtin_amdgcn_s_setprio(0); } while (0)
#define PG8_WAIT_V(n) asm volatile("s_waitcnt vmcnt(" #n ")" ::: "memory")
#define PG8_WAIT_L(n) asm volatile("s_waitcnt lgkmcnt(" #n ")" ::: "memory")
#define PG8_BAR __builtin_amdgcn_s_barrier()
#define PG8_SCHED __builtin_amdgcn_sched_barrier(0)
    Unit cur, nxt; int ui = 0;
    if (!S.next(0, cur)) return;
    f32x4 acc[2][2][4][2];
#pragma unroll
    for (int a = 0; a < 2; ++a)
#pragma unroll
        for (int b = 0; b < 2; ++b)
#pragma unroll
            for (int m = 0; m < 4; ++m)
#pragma unroll
                for (int n = 0; n < 2; ++n) acc[a][b][m][n] = (f32x4){0.f, 0.f, 0.f, 0.f};
    bf16x8 At[4][2], B0[2][2], B1[2][2];
    const char* cA = cur.A; const char* cB = cur.B;
    PG8_STAGE(PG8_SB(0, 0), cB, voffB); PG8_STAGE(PG8_SB(0, 1), cB + hstepB, voffB); PG8_STAGE(PG8_SA(0, 0), cA, voffA); PG8_STAGE(PG8_SA(0, 1), cA + hstepA, voffA);
    if (wr == 1) PG8_BAR;
    PG8_WAIT_V(2); PG8_BAR;
    PG8_STAGE(PG8_SB(1, 0), cB + kstep, voffB); PG8_STAGE(PG8_SA(1, 0), cA + kstep, voffA); PG8_STAGE(PG8_SB(1, 1), cB + hstepB + kstep, voffB);
    PG8_WAIT_V(6); PG8_BAR;
    for (;;) {
        const bool has_next = S.next(ui + 1, nxt);
        const char* nA = has_next ? nxt.A : cA; const char* nB = has_next ? nxt.B : cB;
        const int nt = cur.nt;
        for (int t = 0; t < nt; t += 2) {
            const bool last = (t == nt - 2);
            const char* a1 = cA + (size_t)(t + 1) * kstep;
            const char* a2 = last ? nA : cA + (size_t)(t + 2) * kstep; const char* b2 = last ? nB : cB + (size_t)(t + 2) * kstep;
            const char* a3 = a2 + kstep; const char* b3 = b2 + kstep;
            PG8_LDB(B0, 0, 0); PG8_LDB(B1, 0, 1); PG8_SCHED; PG8_LDA(At, 0, 0); PG8_STAGE(PG8_SA(1, 1), a1 + hstepA, voffA);
            PG8_WAIT_V(8); PG8_WAIT_L(0); PG8_BAR; PG8_MMA(0, 0, At, B0); PG8_MMA(0, 1, At, B1); PG8_BAR; PG8_SCHED;
            PG8_LDA(At, 0, 1); PG8_STAGE(PG8_SB(0, 0), b2, voffB); PG8_STAGE(PG8_SB(0, 1), b2 + hstepB, voffB); PG8_STAGE(PG8_SA(0, 0), a2, voffA);
            PG8_WAIT_V(8); PG8_WAIT_L(0); PG8_BAR; PG8_MMA(1, 0, At, B0); PG8_MMA(1, 1, At, B1); PG8_BAR; PG8_SCHED;
            PG8_LDB(B0, 1, 0); PG8_LDB(B1, 1, 1); PG8_SCHED; PG8_LDA(At, 1, 0); PG8_STAGE(PG8_SA(0, 1), a2 + hstepA, voffA);
            PG8_WAIT_V(8); PG8_WAIT_L(0); PG8_BAR; PG8_MMA(0, 0, At, B0); PG8_MMA(0, 1, At, B1); PG8_BAR; PG8_SCHED;
            PG8_LDA(At, 1, 1); PG8_STAGE(PG8_SB(1, 0), b3, voffB); PG8_STAGE(PG8_SB(1, 1), b3 + hstepB, voffB); PG8_STAGE(PG8_SA(1, 0), a3, voffA);
            PG8_WAIT_V(8); PG8_WAIT_L(0); PG8_BAR; PG8_MMA(1, 0, At, B0); PG8_MMA(1, 1, At, B1); PG8_BAR; PG8_SCHED;
            if constexpr (Epi::HAS_MID) { if (t + 2 == 8 || t + 2 == 16) { E.mid(acc, cur, t + 2, wr, wc, fr, fq); PG8_SCHED; } }
        }
        if (wr == 0) PG8_BAR;
        E(acc, cur, wr, wc, fr, fq);
        if (!has_next) break;
#pragma unroll
        for (int a = 0; a < 2; ++a)
#pragma unroll
            for (int b = 0; b < 2; ++b)
#pragma unroll
                for (int m = 0; m < 4; ++m)
#pragma unroll
                    for (int n = 0; n < 2; ++n) acc[a][b][m][n] = (f32x4){0.f, 0.f, 0.f, 0.f};
        cur = nxt; cA = nA; cB = nB; ++ui;
        if (wr == 1) PG8_BAR;
    }
    PG8_WAIT_V(0);
    PG8_BAR;
#undef PG8_SA
#undef PG8_SB
#undef PG8_STAGE
#undef PG8_LDA
#undef PG8_LDB
#undef PG8_MMA
#undef PG8_WAIT_V
#undef PG8_WAIT_L
#undef PG8_BAR
#undef PG8_SCHED
}
}

struct Frame {
    LAS unsigned char* lds;
    volatile LAS unsigned* MISC;
    unsigned* ctl;
    int tid, lane, wave, G, bid;
    const float* const __attribute__((address_space(4)))* in;
    float* out; unsigned char* ws;
};
enum { IN_X = 0, IN_NORM1, IN_WIN, IN_BGATE, IN_LRE, IN_LIM, IN_BRE, IN_BIM, IN_CRE, IN_CIM, IN_S5D, IN_LOGDT, IN_GLU1, IN_GLU2, IN_QG, IN_KG, IN_SINK,
       IN_CONVW, IN_CONVB, IN_DTB, IN_ALOG, IN_SSDD, IN_SSDG, IN_PS5, IN_PATTN, IN_PSSD, IN_WOUT, IN_NORM2, IN_WRG, IN_BRG, IN_WRE, IN_BRE_, IN_EG, IN_EU, IN_ED, N_INPUTS };

#define LDS_WAIT() asm volatile("s_waitcnt lgkmcnt(0)" ::: "memory")
#define VM_WAIT() asm volatile("s_waitcnt vmcnt(0)" ::: "memory")

using pg8::Unit; using pg8::pack8;
struct EpiProj {
    static constexpr bool PERM = true, HAS_MID = false;
    unsigned char* ws; const float* bgate;
    __device__ __forceinline__ void operator()(const f32x4 (&acc)[2][2][4][2], const Unit& u, int wr, int wc, int fr, int fq) const {
        bf16_t* P = (bf16_t*)(ws + WS_P); bf16_t* UH = (bf16_t*)(ws + WS_UH); float* DT = (float*)(ws + WS_DT);
        const int row0 = u.pm * 256 + wr * 64 + fr;
        if (u.pn < 2) {
#pragma unroll
            for (int ai = 0; ai < 2; ++ai)
#pragma unroll
                for (int m = 0; m < 4; ++m) { const int row = row0 + ai * 128 + m * 16, r = row >> 5, s = row & 31;
#pragma unroll
                    for (int bj = 0; bj < 2; ++bj) { const int col = u.pn * 256 + bj * 128 + wc * 32 + 8 * fq, g = col >> 4, c0 = col & 15;
                        *(u32x4*)(UH + ((size_t)(g * S5_ROWS + r) * S5_K + 128 + s * 16 + c0)) = pack8(acc[ai][bj][m][0], acc[ai][bj][m][1]); } }
        } else {
            const int colb = u.pn * 256 + wc * 32 + 8 * fq;
            f32x4 bv[2][2];
#pragma unroll
            for (int bj = 0; bj < 2; ++bj)
#pragma unroll
                for (int n = 0; n < 2; ++n) bv[bj][n] = (u.pn >= 15) ? *(const f32x4*)(bgate + (colb - C_G) + bj * 128 + 4 * n) : (f32x4){0.f, 0.f, 0.f, 0.f};
#pragma unroll
            for (int ai = 0; ai < 2; ++ai)
#pragma unroll
                for (int m = 0; m < 4; ++m) { const int row = row0 + ai * 128 + m * 16;
#pragma unroll
                    for (int bj = 0; bj < 2; ++bj) { f32x4 v0 = acc[ai][bj][m][0] + bv[bj][0], v1 = acc[ai][bj][m][1] + bv[bj][1];
                        if (u.pn >= 15) {
#pragma unroll
                            for (int j = 0; j < 4; ++j) { v0[j] = fmaxf(sigmoidf_(v0[j]), 1e-30f); v1[j] = fmaxf(sigmoidf_(v1[j]), 1e-30f); } }
                        *(u32x4*)(P + (size_t)row * NINP + colb + bj * 128) = pack8(v0, v1); }
                    if (u.pn == 14 && wc == 0 && fq < 2) { float* d = DT + (size_t)row * 16 + 8 * fq; *(f32x4*)d = acc[ai][0][m][0]; *(f32x4*)(d + 4) = acc[ai][0][m][1]; } }
        }
    }
};
struct EpiHloc {
    static constexpr bool PERM = false, HAS_MID = false;
    float* H;
    __device__ __forceinline__ void operator()(const f32x4 (&acc)[2][2][4][2], const Unit& u, int wr, int wc, int fr, int fq) const {
#pragma unroll
        for (int ai = 0; ai < 2; ++ai)
#pragma unroll
            for (int m = 0; m < 4; ++m) { const int r = u.pm * 256 + ai * 128 + wr * 64 + m * 16 + fr; float* rowp = H + ((size_t)(u.aux * S5_ROWS + r) * 128) + wc * 32 + 4 * fq;
#pragma unroll
                for (int n = 0; n < 2; ++n) *(f32x4*)(rowp + 16 * n) = acc[ai][0][m][n]; }
    }
};
struct EpiS5Y {
    static constexpr bool PERM = true, HAS_MID = false;
    bf16_t* Y;
    __device__ __forceinline__ void operator()(const f32x4 (&acc)[2][2][4][2], const Unit& u, int wr, int wc, int fr, int fq) const {
#pragma unroll
        for (int ai = 0; ai < 2; ++ai)
#pragma unroll
            for (int m = 0; m < 4; ++m) { const int r = u.pm * 256 + ai * 128 + wr * 64 + m * 16 + fr;
#pragma unroll
                for (int bj = 0; bj < 2; ++bj) { const int n0 = u.pn * 256 + bj * 128 + wc * 32 + 8 * fq, t = n0 >> 4, c0 = n0 & 15;
                    f32x4 v0 = acc[ai][bj][m][0], v1 = acc[ai][bj][m][1];
#pragma unroll
                    for (int j = 0; j < 4; ++j) { v0[j] = gelu_tanh_(v0[j]); v1[j] = gelu_tanh_(v1[j]); }
                    *(u32x4*)(Y + ((size_t)(r * S5_TC + t) * 512 + u.aux * 16 + c0)) = pack8(v0, v1); } }
    }
};
struct EpiGlu {
    static constexpr bool PERM = true, HAS_MID = false;
    bf16_t* Y;
    __device__ __forceinline__ void operator()(const f32x4 (&acc)[2][2][4][2], const Unit& u, int wr, int wc, int fr, int fq) const {
#pragma unroll
        for (int ai = 0; ai < 2; ++ai)
#pragma unroll
            for (int m = 0; m < 4; ++m) { const int row = u.pm * 256 + ai * 128 + wr * 64 + m * 16 + fr;
                f32x4 v0 = acc[ai][0][m][0], v1 = acc[ai][0][m][1]; const f32x4 g0 = acc[ai][1][m][0], g1 = acc[ai][1][m][1];
#pragma unroll
                for (int j = 0; j < 4; ++j) { v0[j] *= sigmoidf_(g0[j]); v1[j] *= sigmoidf_(g1[j]); }
                *(u32x4*)(Y + (size_t)row * 2048 + u.pn * 128 + wc * 32 + 8 * fq) = pack8(v0, v1); }
    }
};
struct EpiSwiGlu {
    static constexpr bool PERM = true, HAS_MID = false;
    bf16_t* Y; const float* RSG;
    __device__ __forceinline__ void operator()(const f32x4 (&acc)[2][2][4][2], const Unit& u, int wr, int wc, int fr, int fq) const {
#pragma unroll
        for (int ai = 0; ai < 2; ++ai)
#pragma unroll
            for (int m = 0; m < 4; ++m) { const int row = u.pm * 256 + ai * 128 + wr * 64 + m * 16 + fr;
                f32x4 v0 = acc[ai][0][m][0], v1 = acc[ai][0][m][1]; const f32x4 g0 = acc[ai][1][m][0], g1 = acc[ai][1][m][1]; const float rr = 1.f;
#pragma unroll
                for (int j = 0; j < 4; ++j) { v0[j] = siluf_(v0[j] * rr) * (g0[j] * rr); v1[j] = siluf_(v1[j] * rr) * (g1[j] * rr); }
                *(u32x4*)(Y + (size_t)row * 512 + u.pn * 128 + wc * 32 + 8 * fq) = pack8(v0, v1); }
    }
};
struct EpiPlainBf16 {
    static constexpr bool PERM = true, HAS_MID = false;
    bf16_t* O;
    __device__ __forceinline__ void operator()(const f32x4 (&acc)[2][2][4][2], const Unit& u, int wr, int wc, int fr, int fq) const {
#pragma unroll
        for (int ai = 0; ai < 2; ++ai)
#pragma unroll
            for (int m = 0; m < 4; ++m) { const int row = u.pm * 256 + ai * 128 + wr * 64 + m * 16 + fr;
#pragma unroll
                for (int bj = 0; bj < 2; ++bj) *(u32x4*)(O + (size_t)row * 1024 + u.pn * 256 + bj * 128 + wc * 32 + 8 * fq) = pack8(acc[ai][bj][m][0], acc[ai][bj][m][1]); }
    }
};
struct EpiMerged {
    static constexpr bool PERM = true, HAS_MID = true;
    unsigned char* ws;
    __device__ __forceinline__ static float lclamp(float l) { return fminf(fmaxf(l, -30.f), 30.f); }
    __device__ __forceinline__ void mid(f32x4 (&acc)[2][2][4][2], const Unit& u, int kt, int wr, int wc, int fr, int fq) const {
        const int br = (kt == 8) ? 0 : 1; const bf16_t* P = (const bf16_t*)(ws + WS_P);
#pragma unroll
        for (int ai = 0; ai < 2; ++ai)
#pragma unroll
            for (int m = 0; m < 4; ++m) { const int row = u.pm * 256 + ai * 128 + wr * 64 + m * 16 + fr;
#pragma unroll
                for (int bj = 0; bj < 2; ++bj) { const bf16_t* gp = P + (size_t)row * NINP + C_G + br * 1024 + u.pn * 256 + bj * 128 + wc * 32 + 8 * fq;
                    const u32x4 la = *(const u32x4*)gp, lb = *(const u32x4*)(gp + 1024);
#pragma unroll
                    for (int j = 0; j < 4; ++j) { const unsigned wa = la[j], wb = lb[j];
                        const float r0 = bflo(wa) * frcp(bflo(wb)), r1 = bfhi(wa) * frcp(bfhi(wb));
                        if (j < 2) { acc[ai][bj][m][0][2 * j] *= r0; acc[ai][bj][m][0][2 * j + 1] *= r1; } else { acc[ai][bj][m][1][2 * j - 4] *= r0; acc[ai][bj][m][1][2 * j - 3] *= r1; } } }
                if (m == 3) asm volatile("" ::: "memory"); }
    }
    __device__ __forceinline__ void operator()(const f32x4 (&acc)[2][2][4][2], const Unit& u, int wr, int wc, int fr, int fq) const {
        const bf16_t* P = (const bf16_t*)(ws + WS_P); bf16_t* O = (bf16_t*)(ws + WS_XN);
#pragma unroll
        for (int ai = 0; ai < 2; ++ai)
#pragma unroll
            for (int m = 0; m < 4; ++m) { const int row = u.pm * 256 + ai * 128 + wr * 64 + m * 16 + fr;
#pragma unroll
                for (int bj = 0; bj < 2; ++bj) { const int col = u.pn * 256 + bj * 128 + wc * 32 + 8 * fq;
                    const u32x4 lc = *(const u32x4*)(P + (size_t)row * NINP + C_G + 2048 + col);
                    f32x4 v0 = acc[ai][bj][m][0], v1 = acc[ai][bj][m][1];
                    v0[0] *= bflo(lc[0]); v0[1] *= bfhi(lc[0]); v0[2] *= bflo(lc[1]); v0[3] *= bfhi(lc[1]);
                    v1[0] *= bflo(lc[2]); v1[1] *= bfhi(lc[2]); v1[2] *= bflo(lc[3]); v1[3] *= bfhi(lc[3]);
                    *(u32x4*)(O + (size_t)row * 1024 + col) = pack8(v0, v1); }
                if (m == 3) asm volatile("" ::: "memory"); }
    }
};
struct EpiResid {
    static constexpr bool PERM = false, HAS_MID = false;
    const float* resid; float* out;
    __device__ __forceinline__ void operator()(const f32x4 (&acc)[2][2][4][2], const Unit& u, int wr, int wc, int fr, int fq) const {
#pragma unroll
        for (int ai = 0; ai < 2; ++ai)
#pragma unroll
            for (int m = 0; m < 4; ++m) { const size_t off = (size_t)(u.pm * 256 + ai * 128 + wr * 64 + m * 16 + fr) * 1024 + u.pn * 256 + wc * 32 + 4 * fq;
#pragma unroll
                for (int bj = 0; bj < 2; ++bj)
#pragma unroll
                    for (int n = 0; n < 2; ++n) { const f32x4 rv = *(const f32x4*)(resid + off + bj * 128 + n * 16); *(f32x4*)(out + off + bj * 128 + n * 16) = rv + acc[ai][bj][m][n]; } }
    }
};

template <unsigned lda, unsigned ldb, int nM, int nN, int NT>
struct SchedDense {
    const char* A; const char* B; int G, c;
    __device__ __forceinline__ bool next(int i, Unit& u) const {
        const int L = i * G + c; if (L >= nM * nN) return false;
        int pm, pn; pg8::tile_order(L, nM, nN, pm, pn);
        u.A = A + (size_t)pm * 256 * lda; u.B = B + (size_t)pn * 256 * ldb; u.nt = NT; u.pm = pm; u.pn = pn; u.aux = 0; return true;
    }
};
struct SchedS5P1 {
    const char* UH; const char* EG; int G, c;
    __device__ __forceinline__ bool next(int i, Unit& u) const {
        const int L = i * G + c; if (L >= 64) return false;
        const int g = L >> 1, pm = L & 1;
        u.A = UH + ((size_t)(g * S5_ROWS + pm * 256) * S5_K + 128) * 2; u.B = EG + (size_t)g * 256 * 512 * 2; u.nt = 8; u.pm = pm; u.pn = 0; u.aux = g; return true;
    }
};
struct SchedS5Main {
    const char* UH; const char* MG; int G, c;
    __device__ __forceinline__ bool next(int i, Unit& u) const {
        const int L = i * G + c; if (L >= 128) return false;
        const int g = L >> 2, pm = (L >> 1) & 1, pn = L & 1;
        u.A = UH + (size_t)(g * S5_ROWS + pm * 256) * S5_K * 2; u.B = MG + (size_t)(g * S5_N + pn * 256) * S5_K * 2; u.nt = 2 + 4 * (pn + 1); u.pm = pm; u.pn = pn; u.aux = g; return true;
    }
};
template <unsigned lda, size_t bexp  , size_t btile  , int NT>
struct SchedMoe {
    const char* A; const char* B; int ntiles, G, c; const volatile LAS int* tile_e;
    __device__ __forceinline__ bool next(int i, Unit& u) const {
        const int L = i * G + c; if (L >= ntiles * 4) return false;
        int pm, pn; pg8::tile_order(L, ntiles, 4, pm, pn);
        const int e = __builtin_amdgcn_readfirstlane(tile_e[pm]);
        u.A = A + (size_t)pm * 256 * lda; u.B = B + (size_t)e * bexp + (size_t)pn * btile; u.nt = NT; u.pm = pm; u.pn = pn; u.aux = e; return true;
    }
};

__device__ __forceinline__ void transpose_item(const float* W, int ldw, int ncols, bf16_t* WT, int ldt, int kofs, int mode, int p0, int p1, LAS float* scr, int k0, int n0, int lane) {
    float wv[32];
#pragma unroll
    for (int i = 0; i < 32; ++i) { const int kk = 2 * i + (lane >> 5), n = n0 + (lane & 31); wv[i] = (n < ncols) ? W[(size_t)(k0 + kk) * ldw + n] : 0.f; }
#pragma unroll
    for (int i = 0; i < 32; ++i) { const int kk = 2 * i + (lane >> 5); scr[kk * 33 + (lane & 31)] = wv[i]; }
    LDS_WAIT(); asm volatile("" ::: "memory");
    const int c = lane & 7;
#pragma unroll
    for (int j = 0; j < 4; ++j) { const int nn = (lane >> 3) + 8 * j, n = n0 + nn; const LAS float* s = scr + (8 * c) * 33 + nn;
        u32x4 o; o.x = pk2(s[0 * 33], s[1 * 33]); o.y = pk2(s[2 * 33], s[3 * 33]); o.z = pk2(s[4 * 33], s[5 * 33]); o.w = pk2(s[6 * 33], s[7 * 33]);
        const int drow = (mode == 0) ? n + (n >= p0 ? p1 : 0) : ((n >> 7) * 256 + (n & 127) + 128 * p0);
        if (n < ncols) *(u32x4*)(WT + (size_t)drow * ldt + kofs + k0 + 8 * c) = o; }
    LDS_WAIT(); asm volatile("" ::: "memory");
}
__device__ __forceinline__ void convert_weights(Frame& F, int layer) {
    LAS float* scr = (LAS float*)(F.lds + F.wave * 16384);
    const int gw = F.bid * NWAVES + F.wave, NGW = F.G * NWAVES;
    bf16_t* WIN = (bf16_t*)(F.ws + WS_WIN); bf16_t* WGLU = (bf16_t*)(F.ws + WS_WGLU); bf16_t* PCAT = (bf16_t*)(F.ws + WS_PCAT); bf16_t* WOUT = (bf16_t*)(F.ws + WS_WOUT);
    bf16_t* EGU = (bf16_t*)(F.ws + WS_EGU); bf16_t* EDN = (bf16_t*)(F.ws + WS_EDN);
    constexpr int I_WIN = 16 * 209, I_GLU = 8 * 16, I_P5 = 8 * 32, I_PS = 16 * 32, I_WO = 16 * 32, I_EG = 32 * 256, I_ED = 32 * 256;
    constexpr int NITEMS = I_WIN + 2 * I_GLU + 2 * I_P5 + I_PS + I_WO + 2 * I_EG + I_ED;
    for (int it = gw; it < NITEMS; it += NGW) {
        int r = it;
        if (r < I_WIN) { transpose_item(F.in[IN_WIN] + (size_t)layer * DM * NIN, NIN, NIN, WIN, DM, 0, 0, 3600, 240, scr, 64 * (r / 209), 32 * (r % 209), F.lane); continue; } r -= I_WIN;
        if (r < I_GLU) { transpose_item(F.in[IN_GLU1] + (size_t)layer * 512 * 512, 512, 512, WGLU, 512, 0, 1, 0, 0, scr, 64 * (r / 16), 32 * (r % 16), F.lane); continue; } r -= I_GLU;
        if (r < I_GLU) { transpose_item(F.in[IN_GLU2] + (size_t)layer * 512 * 512, 512, 512, WGLU, 512, 0, 1, 1, 0, scr, 64 * (r / 16), 32 * (r % 16), F.lane); continue; } r -= I_GLU;
        if (r < I_P5) { transpose_item(F.in[IN_PS5] + (size_t)layer * 512 * 1024, 1024, 1024, PCAT, 2048, 0, 0, 1 << 30, 0, scr, 64 * (r / 32), 32 * (r % 32), F.lane); continue; } r -= I_P5;
        if (r < I_P5) { transpose_item(F.in[IN_PATTN] + (size_t)layer * 512 * 1024, 1024, 1024, PCAT, 2048, 512, 0, 1 << 30, 0, scr, 64 * (r / 32), 32 * (r % 32), F.lane); continue; } r -= I_P5;
        if (r < I_PS) { transpose_item(F.in[IN_PSSD] + (size_t)layer * 1024 * 1024, 1024, 1024, PCAT, 2048, 1024, 0, 1 << 30, 0, scr, 64 * (r / 32), 32 * (r % 32), F.lane); continue; } r -= I_PS;
        if (r < I_WO) { transpose_item(F.in[IN_WOUT] + (size_t)layer * 1024 * 1024, 1024, 1024, WOUT, 1024, 0, 0, 1 << 30, 0, scr, 64 * (r / 32), 32 * (r % 32), F.lane); continue; } r -= I_WO;
        if (r < I_EG) { const int e = r >> 8, q = r & 255; transpose_item(F.in[IN_EG] + ((size_t)layer * 32 + e) * 1024 * 512, 512, 512, EGU + (size_t)e * 1024 * 1024, 1024, 0, 1, 0, 0, scr, 64 * (q / 16), 32 * (q % 16), F.lane); continue; } r -= I_EG;
        if (r < I_EG) { const int e = r >> 8, q = r & 255; transpose_item(F.in[IN_EU] + ((size_t)layer * 32 + e) * 1024 * 512, 512, 512, EGU + (size_t)e * 1024 * 1024, 1024, 0, 1, 1, 0, scr, 64 * (q / 16), 32 * (q % 16), F.lane); continue; } r -= I_EG;
        { const int e = r >> 8, q = r & 255; transpose_item(F.in[IN_ED] + ((size_t)layer * 32 + e) * 512 * 1024, 1024, 1024, EDN + (size_t)e * 1024 * 512, 512, 0, 0, 1 << 30, 0, scr, 64 * (q / 32), 32 * (q % 32), F.lane); }
    }
}
__device__ __forceinline__ void sincos_fast(float x, float& s, float& c) {
    const float k = rintf(x * 0.15915494309189535f);
    float r = fmaf(-k, 6.2831854820251465f, x); r = fmaf(-k, -1.7484555e-07f, r);
    s = __sinf(r); c = __cosf(r);
}
__device__ __forceinline__ void sincos_red(float x, float& s, float& c) {
    const float k = rintf(x * 0.15915494309189535f);
    float r = fmaf(-k, 6.2831854820251465f, x); r = fmaf(-k, -1.7484555e-07f, r);
    s = sinf(r); c = cosf(r);
}
__device__ __forceinline__ void s5_build(Frame& F, int layer) {
    LAS float* pw = (LAS float*)F.lds;
    LAS float* Bb = pw + 33 * 64 * 2;
    LAS float* Cc = Bb + 64 * 16 * 2;
    LAS float* Kd = Cc + 16 * 64 * 2;
    bf16_t* MG = (bf16_t*)(F.ws + WS_MG); bf16_t* EG = (bf16_t*)(F.ws + WS_EG);
    for (int w = F.bid; w < 256; w += F.G) {
        const int g = w >> 3, part = w & 7, gi = layer * 32 + g;
        __syncthreads();
        const float dt = __expf(F.in[IN_LOGDT][gi]);
        for (int i = F.tid; i < 33 * 64; i += NTHR) { const int d = i >> 6, p = i & 63; const float lr = F.in[IN_LRE][gi * 64 + p], li = F.in[IN_LIM][gi * 64 + p];
            float s, c; sincos_red((float)d * li * dt, s, c); const float mg = __expf((float)d * lr * dt); pw[2 * i] = mg * c; pw[2 * i + 1] = mg * s; }
        for (int i = F.tid; i < 64 * 16; i += NTHR) { const int p = i >> 4; const float lr = F.in[IN_LRE][gi * 64 + p], li = F.in[IN_LIM][gi * 64 + p];
            float s, c; sincos_red(li * dt, s, c); const float mg = __expf(lr * dt), are = mg * c, aim = mg * s, nr = are - 1.f, den = lr * lr + li * li;
            const float fre = (nr * lr + aim * li) / den, fim = (aim * lr - nr * li) / den;
            const float br = F.in[IN_BRE][(size_t)gi * 1024 + i], bi = F.in[IN_BIM][(size_t)gi * 1024 + i];
            Bb[2 * i] = fre * br - fim * bi; Bb[2 * i + 1] = fre * bi + fim * br; }
        for (int i = F.tid; i < 16 * 64; i += NTHR) { Cc[2 * i] = F.in[IN_CRE][(size_t)gi * 1024 + i]; Cc[2 * i + 1] = F.in[IN_CIM][(size_t)gi * 1024 + i]; }
        __syncthreads();
        { const int d = F.tid >> 4, c = F.tid & 15; float acc[16];
#pragma unroll
          for (int j = 0; j < 16; ++j) acc[j] = 0.f;
          for (int p = 0; p < 64; ++p) { const float cr = Cc[2 * (c * 64 + p)], ci = Cc[2 * (c * 64 + p) + 1], pr = pw[2 * (d * 64 + p)], pi = pw[2 * (d * 64 + p) + 1];
              const float xr = cr * pr - ci * pi, xi = cr * pi + ci * pr;
#pragma unroll
              for (int q = 0; q < 8; ++q) { const f32x4 bb = *(const LAS f32x4*)(Bb + 2 * (p * 16) + 4 * q); acc[2 * q] += xr * bb.x - xi * bb.y; acc[2 * q + 1] += xr * bb.z - xi * bb.w; } }
#pragma unroll
          for (int j = 0; j < 16; ++j) Kd[(d * 16 + c) * 16 + j] = acc[j]; }
        __syncthreads();
        for (int v = F.tid; v < 64 * 80; v += NTHR) { const int n = part * 64 + v / 80, k0 = (v % 80) * 8, t = n >> 4, c = n & 15; float o[8];
            if (k0 < 128) { const int im = k0 >= 64, p0 = k0 & 63;
#pragma unroll
                for (int j = 0; j < 8; ++j) { const int p = p0 + j; const float cr = Cc[2 * (c * 64 + p)], ci = Cc[2 * (c * 64 + p) + 1], pr = pw[2 * ((t + 1) * 64 + p)], pi = pw[2 * ((t + 1) * 64 + p) + 1];
                    o[j] = im ? -(cr * pi + ci * pr) : (cr * pr - ci * pi); }
            } else { const int s = (k0 - 128) >> 4, c0 = (k0 - 128) & 15;
#pragma unroll
                for (int j = 0; j < 8; ++j) { float x = 0.f; if (s <= t) { x = Kd[(t - s) * 256 + c * 16 + c0 + j]; if (s == t && c == c0 + j) x += F.in[IN_S5D][layer * 512 + g * 16 + c]; } o[j] = x; } }
            u32x4 q; q.x = pk2(o[0], o[1]); q.y = pk2(o[2], o[3]); q.z = pk2(o[4], o[5]); q.w = pk2(o[6], o[7]);
            *(u32x4*)(MG + ((size_t)(g * S5_N + n) * S5_K + k0)) = q; }
        for (int v = F.tid; v < 16 * 64; v += NTHR) { const int jr = part * 16 + v / 64, k0 = (v % 64) * 8, im = jr >= 64, p = jr & 63, s = k0 >> 4, c0 = k0 & 15; float o[8];
            const float pr = pw[2 * ((S5_TC - 1 - s) * 64 + p)], pi = pw[2 * ((S5_TC - 1 - s) * 64 + p) + 1];
#pragma unroll
            for (int j = 0; j < 8; ++j) { const float br = Bb[2 * (p * 16 + c0 + j)], bi = Bb[2 * (p * 16 + c0 + j) + 1]; o[j] = im ? (pr * bi + pi * br) : (pr * br - pi * bi); }
            u32x4 q; q.x = pk2(o[0], o[1]); q.y = pk2(o[2], o[3]); q.z = pk2(o[4], o[5]); q.w = pk2(o[6], o[7]);
            *(u32x4*)(EG + ((size_t)(g * 256 + jr) * 512 + k0)) = q; }
    }
    __syncthreads();
}
__device__ __forceinline__ void rms_row_to_bf16(const float* xrow, const float* gain, bf16_t* orow, int lane) {
    const f32x4* xr = (const f32x4*)xrow + lane; const f32x4* gr = (const f32x4*)gain + lane;
    f32x4 v[4]; float s = 0.f;
#pragma unroll
    for (int j = 0; j < 4; ++j) { v[j] = xr[64 * j]; s += (v[j].x * v[j].x + v[j].y * v[j].y) + (v[j].z * v[j].z + v[j].w * v[j].w); }
    const float rstd = __builtin_amdgcn_rsqf(wave_sum(s) * (1.f / DM) + NORM_EPS);
    unsigned long long* o8 = (unsigned long long*)orow + lane;
#pragma unroll
    for (int j = 0; j < 4; ++j) { const f32x4 gv = gr[64 * j]; o8[64 * j] = (unsigned long long)pk2(v[j].x * rstd * gv.x, v[j].y * rstd * gv.y) | ((unsigned long long)pk2(v[j].z * rstd * gv.z, v[j].w * rstd * gv.w) << 32); }
}
__device__ __forceinline__ void rmsnorm_rows(Frame& F, const float* x, const float* gain, bf16_t* o) {
    const int gw = F.bid * NWAVES + F.wave, NGW = F.G * NWAVES;
    for (int m = gw; m < T; m += NGW) rms_row_to_bf16(x + (size_t)m * DM, gain, o + (size_t)m * DM, F.lane);
}

__device__ __forceinline__ void s5_scan(Frame& F, int layer) {
    const float* HL = (const float*)(F.ws + WS_HLOC); bf16_t* UH = (bf16_t*)(F.ws + WS_UH);
    for (int i = (F.G - 1 - F.bid) * NTHR + F.tid; i < BATCH * 32 * 64; i += F.G * NTHR) {
        const int p = i & 63, g = (i >> 6) & 31, b = i >> 11, gi = layer * 32 + g;
        const float dt = __expf(F.in[IN_LOGDT][gi]), lr = F.in[IN_LRE][gi * 64 + p], li = F.in[IN_LIM][gi * 64 + p];
        float s, c; sincos_red((float)S5_TC * li * dt, s, c); const float mg = __expf((float)S5_TC * lr * dt), ar = mg * c, ai = mg * s;
        float hr = 0.f, hi = 0.f;
        const int nch = SEQ / S5_TC;
        for (int c0 = 0; c0 < nch; c0 += 32) { float lr_[32], li_[32];
#pragma unroll
            for (int k = 0; k < 32; ++k) { const size_t r = (size_t)g * S5_ROWS + b * nch + c0 + k; lr_[k] = HL[r * 128 + p]; li_[k] = HL[r * 128 + 64 + p]; }
#pragma unroll
            for (int k = 0; k < 32; ++k) { const size_t r = (size_t)g * S5_ROWS + b * nch + c0 + k;
                UH[r * S5_K + p] = (bf16_t)f2bf(hr); UH[r * S5_K + 64 + p] = (bf16_t)f2bf(hi);
                const float nr = ar * hr - ai * hi + lr_[k], ni = ar * hi + ai * hr + li_[k]; hr = nr; hi = ni; } }
    }
}

__device__ __forceinline__ void ssd_stage_bc(Frame& F, int layer, int b, int ch, int grp, LAS float* Bs, LAS float* Cs, LAS float* dts, LAS float* das) {
    const bf16_t* P = (const bf16_t*)(F.ws + WS_P); const float* DT = (const float*)(F.ws + WS_DT);
    const float* cw = F.in[IN_CONVW] + layer * 4 * 1280; const float* cb = F.in[IN_CONVB] + layer * 1280;
    const int l0 = ch * 128; const size_t row0 = (size_t)b * SEQ + l0;
    for (int i = F.tid; i < 2 * 128 * 64; i += NTHR) { const int isC = i >> 13, t = (i >> 6) & 127, n = i & 63;
        const int col = (isC ? C_C : C_B) + grp * 64 + n, cc = 1024 + isC * 128 + grp * 64 + n; float a = cb[cc];
#pragma unroll
        for (int j = 0; j < 4; ++j) { const int l = l0 + t - 3 + j; if (l >= 0) a += cw[j * 1280 + cc] * bf2f(P[(row0 + t - 3 + j) * NINP + col]); }
        (isC ? Cs : Bs)[t * 64 + n] = siluf_(a); }
    for (int i = F.tid; i < 128 * 8; i += NTHR) { const int t = i >> 3, hh = i & 7, h = grp * 8 + hh;
        const float dt = softplusf_(DT[(row0 + t) * 16 + h] + F.in[IN_DTB][layer * 16 + h]); dts[i] = dt; das[i] = dt * (-__expf(F.in[IN_ALOG][layer * 16 + h])); }
}
template <bool OUT>
__device__ __forceinline__ void ssd_units(Frame& F, int layer) {
    LAS float* Bs = (LAS float*)F.lds; LAS float* Cs = Bs + 128 * 64; LAS float* dts = Cs + 128 * 64; LAS float* das = dts + 128 * 8; LAS float* ssq = das + 128 * 8;
    const bf16_t* P = (const bf16_t*)(F.ws + WS_P); float* SST = (float*)(F.ws + WS_SST); float* ASUM = (float*)(F.ws + WS_ASUM); bf16_t* YC = (bf16_t*)(F.ws + WS_YCAT);
    const float* cw = F.in[IN_CONVW] + layer * 4 * 1280; const float* cb = F.in[IN_CONVB] + layer * 1280;
    for (int u = F.bid; u < BATCH * SSD_NCH * 2; u += F.G) {
        const int grp = u & 1, ch = (u >> 1) & 31, b = u >> 6;
        __syncthreads();
        ssd_stage_bc(F, layer, b, ch, grp, Bs, Cs, dts, das);
        __syncthreads();
        const int hh = F.wave, h = grp * 8 + hh, p = F.lane, cx = h * 64 + p;
        const float w0 = cw[cx], w1 = cw[1280 + cx], w2 = cw[2560 + cx], w3 = cw[3840 + cx], bias = cb[cx], dsk = F.in[IN_SSDD][layer * 16 + h];
        const int l0 = ch * 128; const size_t row0 = (size_t)b * SEQ + l0;
        const bf16_t* xp = P + row0 * NINP + C_XS + cx;
        float x0 = 0.f, x1 = 0.f, x2 = 0.f;
        if (l0 > 0) { x0 = bf2f(xp[-3 * (ptrdiff_t)NINP]); x1 = bf2f(xp[-2 * (ptrdiff_t)NINP]); x2 = bf2f(xp[-1 * (ptrdiff_t)NINP]); }
        float st[64];
        float* sp = SST + ((((size_t)b * SSD_NCH + ch) * 16 + h) * 64 + p) * 64;
        if (OUT) {
#pragma unroll
            for (int n = 0; n < 64; n += 4) { const f32x4 v = *(const f32x4*)(sp + n); st[n] = v.x; st[n + 1] = v.y; st[n + 2] = v.z; st[n + 3] = v.w; }
        } else {
#pragma unroll
            for (int n = 0; n < 64; ++n) st[n] = 0.f;
        }
        float asum = 0.f;
#pragma unroll 4
        for (int t = 0; t < 128; ++t) {
            const float x3 = bf2f(xp[(size_t)t * NINP]);
            const float xs = siluf_(bias + w0 * x0 + w1 * x1 + w2 * x2 + w3 * x3);
            x0 = x1; x1 = x2; x2 = x3;
            const float dt = dts[t * 8 + hh], a = das[t * 8 + hh], da = __expf(a), xdt = xs * dt;
            asum += a;
            float y = 0.f;
#pragma unroll
            for (int n = 0; n < 64; n += 4) { const f32x4 bv = *(const LAS f32x4*)(Bs + t * 64 + n);
                st[n] = da * st[n] + bv.x * xdt; st[n + 1] = da * st[n + 1] + bv.y * xdt; st[n + 2] = da * st[n + 2] + bv.z * xdt; st[n + 3] = da * st[n + 3] + bv.w * xdt;
                if (OUT) { const f32x4 cv = *(const LAS f32x4*)(Cs + t * 64 + n); y += (cv.x * st[n] + cv.y * st[n + 1]) + (cv.z * st[n + 2] + cv.w * st[n + 3]); } }
            if (OUT) {
                const float z = bf2f(P[(row0 + t) * NINP + C_Z + cx]);
                const float yz = (y + dsk * xs) * siluf_(z);
                const float q = wave_sum(yz * yz);
                if (p == 0) ssq[t * 8 + hh] = q;
                YC[(row0 + t) * 2048 + 1024 + cx] = (bf16_t)f2bf(yz);
            }
        }
        if (!OUT) {
#pragma unroll
            for (int n = 0; n < 64; n += 4) *(f32x4*)(sp + n) = (f32x4){st[n], st[n + 1], st[n + 2], st[n + 3]};
            if (p == 0) ASUM[((size_t)b * SSD_NCH + ch) * 16 + h] = asum;
        } else {
            __syncthreads();
            const float ng = F.in[IN_SSDG][layer * 1024 + cx];
            for (int t = 0; t < 128; ++t) { float q = 0.f;
#pragma unroll
                for (int j = 0; j < 8; ++j) q += ssq[t * 8 + j];
                const float rs = __builtin_amdgcn_rsqf(q * (1.f / 512.f) + NORM_EPS);
                bf16_t* yp = YC + (row0 + t) * 2048 + 1024 + cx; *yp = (bf16_t)f2bf(bf2f(*yp) * rs * ng); }
        }
    }
}
__device__ __forceinline__ void ssd_scan(Frame& F) {
    bf16_t* SST = (bf16_t*)(F.ws + WS_SST); const float* ASUM = (const float*)(F.ws + WS_ASUM);
    for (int i = F.bid * NTHR + F.tid; i < BATCH * 16 * 512; i += F.G * NTHR) {
        const int pn = (i & 511) * 8, h = (i >> 9) & 15, b = i >> 13; float s[8];
#pragma unroll
        for (int j = 0; j < 8; ++j) s[j] = 0.f;
        u32x4 loc[SSD_NCH]; float dec[SSD_NCH];
#pragma unroll
        for (int ch = 0; ch < SSD_NCH; ++ch) { loc[ch] = *(const u32x4*)(SST + (((size_t)b * SSD_NCH + ch) * 16 + h) * 4096 + pn); dec[ch] = ASUM[((size_t)b * SSD_NCH + ch) * 16 + h]; }
#pragma unroll
        for (int ch = 0; ch < SSD_NCH; ++ch) { u32x4 o; o.x = pk2(s[0], s[1]); o.y = pk2(s[2], s[3]); o.z = pk2(s[4], s[5]); o.w = pk2(s[6], s[7]);
            *(u32x4*)(SST + (((size_t)b * SSD_NCH + ch) * 16 + h) * 4096 + pn) = o; const float d = __expf(dec[ch]);
#pragma unroll
            for (int j = 0; j < 4; ++j) { s[2 * j] = s[2 * j] * d + bflo(loc[ch][j]); s[2 * j + 1] = s[2 * j + 1] * d + bfhi(loc[ch][j]); } }
    }
}

__device__ __forceinline__ void attn_units(Frame& F, int layer) {
    LAS float* Ks = (LAS float*)F.lds; LAS float* Vs = Ks + 256 * 64;
    const bf16_t* P = (const bf16_t*)(F.ws + WS_P); bf16_t* YC = (bf16_t*)(F.ws + WS_YCAT);
    const float* qg = F.in[IN_QG] + layer * 64; const float* kg = F.in[IN_KG] + layer * 64;
    for (int u = F.bid; u < BATCH * 32 * 2; u += F.G) {
        const int kvh = u & 1, qb = (u >> 1) & 31, b = u >> 6, q0 = qb * 128;
        int lane = F.lane; asm volatile("" : "+v"(lane));
        __syncthreads();
        for (int jr = F.wave; jr < 256; jr += NWAVES) { const int l = q0 - 128 + jr; float kv = 0.f, vv = 0.f;
            if (l >= 0) { const size_t row = (size_t)b * SEQ + l; const float x = bf2f(P[row * NINP + C_K + kvh * 64 + lane]); vv = bf2f(P[row * NINP + C_V + kvh * 64 + lane]);
                const float rs = __builtin_amdgcn_rsqf(wave_sum(x * x) * (1.f / 64.f) + NORM_EPS); const float xn = x * rs * kg[lane];
                const float other = __shfl_xor(xn, 32); const int i = lane & 31; const float inv = exp2f(-(float)i * (13.287712379549449f / 32.f));
                float s, c; sincos_fast((float)l * inv, s, c);
                kv = (lane < 32) ? (xn * c - other * s) : (xn * c + other * s); }
            Ks[jr * 64 + lane] = kv; Vs[jr * 64 + lane] = vv; }
        __syncthreads();
        const int hh = F.wave >> 1, head = kvh * 4 + hh, qi = q0 + (F.wave & 1) * 64 + lane; const size_t row = (size_t)b * SEQ + qi;
        float q[64];
        { const u32x4* qp = (const u32x4*)(P + row * NINP + C_Q + head * 64); float ss = 0.f;
#pragma unroll
          for (int j = 0; j < 8; ++j) { const u32x4 w = qp[j];
#pragma unroll
              for (int e = 0; e < 4; ++e) { q[8 * j + 2 * e] = bflo(w[e]); q[8 * j + 2 * e + 1] = bfhi(w[e]); } }
#pragma unroll
          for (int d = 0; d < 64; ++d) ss += q[d] * q[d];
          const float rs = __builtin_amdgcn_rsqf(ss * (1.f / 64.f) + NORM_EPS);
#pragma unroll
          for (int d = 0; d < 64; ++d) q[d] = q[d] * rs * qg[d];
#pragma unroll
          for (int i = 0; i < 32; ++i) { const float inv = exp2f(-(float)i * (13.287712379549449f / 32.f)); float s, c; sincos_fast((float)qi * inv, s, c);
              const float a = q[i], bq = q[i + 32]; q[i] = (a * c - bq * s) * 0.125f; q[i + 32] = (bq * c + a * s) * 0.125f; } }
        float o[64];
#pragma unroll
        for (int d = 0; d < 64; ++d) o[d] = 0.f;
        float mx = F.in[IN_SINK][layer * 8 + head], l = 1.f;
        const int qa = q0 + (F.wave & 1) * 64;
        int jlo = qa - 127 - (q0 - 128); if (q0 == 0 && jlo < 128) jlo = 128; const int jhi = qa + 63 - (q0 - 128);
        for (int jr = jlo; jr <= jhi; ++jr) { const int j = q0 - 128 + jr; const bool ok = (j <= qi) && (qi - j < 128);
            float s = 0.f;
#pragma unroll
            for (int d = 0; d < 64; d += 4) { const f32x4 kv = *(const LAS f32x4*)(Ks + jr * 64 + d); s += (q[d] * kv.x + q[d + 1] * kv.y) + (q[d + 2] * kv.z + q[d + 3] * kv.w); if ((d & 12) == 12) __builtin_amdgcn_sched_barrier(0); }
            if (ok) { const float mn = fmaxf(mx, s), al = __expf(mx - mn), pe = __expf(s - mn); l = l * al + pe; mx = mn;
#pragma unroll
                for (int d = 0; d < 64; d += 4) { const f32x4 vv = *(const LAS f32x4*)(Vs + jr * 64 + d); o[d] = o[d] * al + pe * vv.x; o[d + 1] = o[d + 1] * al + pe * vv.y; o[d + 2] = o[d + 2] * al + pe * vv.z; o[d + 3] = o[d + 3] * al + pe * vv.w; if ((d & 12) == 12) __builtin_amdgcn_sched_barrier(0); } } }
        const float il = 1.f / l; u32x4* op = (u32x4*)(YC + row * 2048 + 512 + head * 64);
#pragma unroll
        for (int j = 0; j < 8; ++j) { u32x4 w; w.x = pk2(o[8 * j] * il, o[8 * j + 1] * il); w.y = pk2(o[8 * j + 2] * il, o[8 * j + 3] * il); w.z = pk2(o[8 * j + 4] * il, o[8 * j + 5] * il); w.w = pk2(o[8 * j + 6] * il, o[8 * j + 7] * il); op[j] = w; }
    }
}

typedef short bf16x8_t __attribute__((ext_vector_type(8)));
__device__ __forceinline__ void split_hi_lo(const f32x4 a, const f32x4 b, bf16x8& hi, bf16x8& lo) {
    u32x4 h; h.x = cvtpk(a.x, a.y); h.y = cvtpk(a.z, a.w); h.z = cvtpk(b.x, b.y); h.w = cvtpk(b.z, b.w);
    u32x4 l; l.x = cvtpk(a.x - bflo(h.x), a.y - bfhi(h.x)); l.y = cvtpk(a.z - bflo(h.y), a.w - bfhi(h.y)); l.z = cvtpk(b.x - bflo(h.z), b.y - bfhi(h.z)); l.w = cvtpk(b.z - bflo(h.w), b.w - bfhi(h.w));
    hi = __builtin_bit_cast(bf16x8, h); lo = __builtin_bit_cast(bf16x8, l);
}
__device__ __forceinline__ void router_phase(Frame& F, int layer) {
    constexpr int WROW = 2064;
    LAS unsigned char* Whi = F.lds; LAS unsigned char* Wlo = F.lds + 36 * WROW;
    LAS float* part = (LAS float*)F.lds;
    volatile LAS unsigned* lcnt = (volatile LAS unsigned*)(F.lds + 148 * 1024);
    const float* wrg = F.in[IN_WRG] + (size_t)layer * 1024 * 4; const float* wre = F.in[IN_WRE] + (size_t)layer * 1024 * 32; const float* gain = F.in[IN_NORM2] + layer * 1024;
    const float* X = F.out; bf16_t* H2 = (bf16_t*)(F.ws + WS_XN);
    int* EID = (int*)(F.ws + WS_MOE); float* EW = (float*)(F.ws + WS_MOE + 128 * 1024); int* SLOT = (int*)(F.ws + WS_MOE + 256 * 1024); float* RS = (float*)(F.ws + WS_MOE + 640 * 1024);
    __syncthreads();
    for (int k = F.tid; k < 1024; k += NTHR) { const float g = gain[k]; const f32x4 wg = *(const f32x4*)(wrg + k * 4);
        float w[36]; w[0] = wg.x; w[1] = wg.y; w[2] = wg.z; w[3] = wg.w;
#pragma unroll
        for (int q = 0; q < 8; ++q) { const f32x4 v = *(const f32x4*)(wre + k * 32 + 4 * q); w[4 + 4 * q] = v.x; w[5 + 4 * q] = v.y; w[6 + 4 * q] = v.z; w[7 + 4 * q] = v.w; }
#pragma unroll
        for (int e = 0; e < 36; ++e) { const float x = w[e] * g; const unsigned h = f2bf(x); const unsigned l = f2bf(x - bf2f(h));
            *(LAS unsigned short*)(Whi + e * WROW + k * 2) = (unsigned short)h; *(LAS unsigned short*)(Wlo + e * WROW + k * 2) = (unsigned short)l; } }
    if (F.tid < 32) lcnt[F.tid] = 0u;
    __syncthreads();
    const int TPB = T / F.G;
    int lane = F.lane; asm volatile("" : "+v"(lane));
    const int mt = F.wave & 3, kh = F.wave >> 2, row = lane & 15, kg = lane >> 4;
    const int m = F.bid * TPB + 16 * mt + row;
    f32x4 acc[3] = {{0.f, 0.f, 0.f, 0.f}, {0.f, 0.f, 0.f, 0.f}, {0.f, 0.f, 0.f, 0.f}}; float ss = 0.f;
    int er[3]; er[0] = row; er[1] = 16 + row; er[2] = (32 + row < 36) ? 32 + row : 35;
    if (kh == 0)
#pragma unroll 1
    for (int kb = 0; kb < 4; ++kb) {
        f32x4 xa[8][2];
#pragma unroll
        for (int ks = 0; ks < 8; ++ks) { const float* xp = X + (size_t)m * DM + 256 * kb + 32 * ks + 8 * kg; xa[ks][0] = *(const f32x4*)xp; xa[ks][1] = *(const f32x4*)(xp + 4); }
#pragma unroll
        for (int ks = 0; ks < 8; ++ks) { const int k0 = 256 * kb + 32 * ks + 8 * kg;
            const f32x4 a = xa[ks][0], b = xa[ks][1];
            ss += (a.x * a.x + a.y * a.y) + (a.z * a.z + a.w * a.w) + (b.x * b.x + b.y * b.y) + (b.z * b.z + b.w * b.w);
            bf16x8 ah, al; split_hi_lo(a, b, ah, al); pin_frag(ah); pin_frag(al);
#pragma unroll
            for (int nt = 0; nt < 3; ++nt) { const bf16x8 bh = *(const LAS bf16x8*)(Whi + er[nt] * WROW + k0 * 2), bl = *(const LAS bf16x8*)(Wlo + er[nt] * WROW + k0 * 2);
                acc[nt] = __builtin_amdgcn_mfma_f32_16x16x32_bf16(ah, bh, acc[nt], 0, 0, 0);
                acc[nt] = __builtin_amdgcn_mfma_f32_16x16x32_bf16(ah, bl, acc[nt], 0, 0, 0);
                acc[nt] = __builtin_amdgcn_mfma_f32_16x16x32_bf16(al, bh, acc[nt], 0, 0, 0); } }
    }
    ss += __shfl_xor(ss, 16); ss += __shfl_xor(ss, 32);
    __syncthreads();
    LAS float* ssq = part + 4 * 3 * 64 * 4; LAS float* lg = ssq + 128; volatile LAS int* elist = (volatile LAS int*)(lg + 64 * 40);
    if (kh == 0) {
        const float rstd_row = __builtin_amdgcn_rsqf(ss * (1.f / DM) + NORM_EPS);
        if (kg == 0) { ssq[64 + 16 * mt + row] = rstd_row; RS[m] = rstd_row; }
    }
    __syncthreads();
    if (kh == 0) {
#pragma unroll
        for (int nt = 0; nt < 3; ++nt)
#pragma unroll
            for (int rg = 0; rg < 4; ++rg) { const int e = row + 16 * nt, tk = 16 * mt + 4 * kg + rg; if (e < 36) lg[tk * 40 + e] = acc[nt][rg] * ssq[64 + tk]; }
    }
    __syncthreads();
    if (F.tid < TPB) { const int tk = F.tid, mm = F.bid * TPB + tk; const LAS float* L = lg + tk * 40;
        float gl[4];
#pragma unroll
        for (int k = 0; k < 4; ++k) gl[k] = L[k] + F.in[IN_BRG][layer * 4 + k];
        int gs = 0; float gbest = gl[0];
#pragma unroll
        for (int k = 1; k < 4; ++k) if (gl[k] > gbest) { gbest = gl[k]; gs = k; }
        float den = 0.f;
#pragma unroll
        for (int k = 0; k < 4; ++k) den += __expf(gl[k] - gbest);
        const float pgrp = 1.f / den;
        float el[8];
#pragma unroll
        for (int k = 0; k < 8; ++k) el[k] = L[4 + gs * 8 + k] + F.in[IN_BRE_][layer * 32 + gs * 8 + k];
        int i0 = 0; float v0 = el[0];
#pragma unroll
        for (int k = 1; k < 8; ++k) if (el[k] > v0) { v0 = el[k]; i0 = k; }
        int i1 = -1; float v1 = -3.0e38f;
#pragma unroll
        for (int k = 0; k < 8; ++k) if (k != i0 && el[k] > v1) { v1 = el[k]; i1 = k; }
        const float e1 = __expf(v1 - v0), w0 = pgrp / (1.f + e1), w1 = pgrp * e1 / (1.f + e1);
        const int ea = gs * 8 + i0, eb = gs * 8 + i1;
        EID[2 * mm] = ea; EID[2 * mm + 1] = eb; EW[2 * mm] = w0; EW[2 * mm + 1] = w1;
        elist[2 * tk] = ea; elist[2 * tk + 1] = eb;
    }
    __syncthreads();
    if (F.tid < 32) { const int e = F.tid; int c = 0;
        for (int i = 0; i < 2 * TPB; ++i) { if (elist[i] == e) { SLOT[2 * (F.bid * TPB) + i] = c; ++c; } }
        ((unsigned*)(F.ws + WS_MOE + 512 * 1024))[(size_t)F.bid * 32 + e] = (unsigned)c; }
    __syncthreads();
}
__device__ __forceinline__ int moe_tables(Frame& F, int layer, volatile LAS int* offs, volatile LAS int* tile_e) {
    volatile LAS int* psum = offs + 256;
    const unsigned* CNTB = (const unsigned*)(F.ws + WS_MOE + 512 * 1024);
    __syncthreads();
    { const int e = F.tid & 31, part = F.tid >> 5; int tot = 0, pre = 0; const int per = (F.G + 15) / 16;
      for (int bb = part * per; bb < (part + 1) * per && bb < F.G; ++bb) { const int c = (int)CNTB[(size_t)bb * 32 + e]; tot += c; pre += (bb < F.bid) ? c : 0; }
      psum[part * 32 + e] = tot; psum[512 + part * 32 + e] = pre; }
    __syncthreads();
    if (F.tid < 64) {
        int c = 0, pre = 0;
        if (F.tid < 32) for (int part = 0; part < 16; ++part) { c += psum[part * 32 + F.tid]; pre += psum[512 + part * 32 + F.tid]; }
        const int tl = (c + 255) >> 8; int incl = tl;
#pragma unroll
        for (int o = 1; o < 32; o <<= 1) { const int v = __shfl_up(incl, o); if (F.tid >= o) incl += v; }
        const int excl = incl - tl;
        if (F.tid < 32) { offs[F.tid] = excl * 256 + pre; for (int k = 0; k < tl; ++k) tile_e[excl + k] = F.tid; }
        if (F.tid == 31) offs[32] = incl;
    }
    __syncthreads();
    return __builtin_amdgcn_readfirstlane(offs[32]);
}
__device__ __forceinline__ void gather_phase(Frame& F, int layer, volatile LAS int* offs) {
    const float* X = F.out; const float* gain = F.in[IN_NORM2] + layer * 1024; const float* RS = (const float*)(F.ws + WS_MOE + 640 * 1024); bf16_t* XG = (bf16_t*)(F.ws + WS_XG);
    const int* EID = (const int*)(F.ws + WS_MOE); const int* SLOT = (const int*)(F.ws + WS_MOE + 256 * 1024); int* POS = (int*)(F.ws + WS_MOE + 384 * 1024);
    const int TPB = T / F.G;
    for (int m = F.bid * TPB + F.wave; m < (F.bid + 1) * TPB; m += NWAVES) {
        const f32x4* xr = (const f32x4*)(X + (size_t)m * DM) + F.lane; const f32x4* gr = (const f32x4*)gain + F.lane; const float rs = RS[m];
        u32x2 o[4];
#pragma unroll
        for (int j = 0; j < 4; ++j) { const f32x4 v = xr[64 * j], g = gr[64 * j]; o[j].x = pk2(v.x * rs * g.x, v.y * rs * g.y); o[j].y = pk2(v.z * rs * g.z, v.w * rs * g.w); }
#pragma unroll
        for (int k = 0; k < 2; ++k) { const int pos = offs[EID[2 * m + k]] + SLOT[2 * m + k]; u32x2* dst = (u32x2*)(XG + (size_t)pos * DM) + F.lane;
#pragma unroll
            for (int j = 0; j < 4; ++j) dst[64 * j] = o[j];
            if (F.lane == 0) POS[2 * m + k] = pos; }
    }
}
__device__ __forceinline__ void combine_phase(Frame& F, const float* gain_next, bool dry = false) {
    const bf16_t* Y = (const bf16_t*)(F.ws + WS_YEXP); const float* EW = (const float*)(F.ws + WS_MOE + 128 * 1024); const int* POS = (const int*)(F.ws + WS_MOE + 384 * 1024);
    bf16_t* XN = (bf16_t*)(F.ws + WS_XN);
    const int gw = F.bid * NWAVES + F.wave, NGW = F.G * NWAVES;
    for (int m = gw; m < T; m += NGW) {
        const float w0 = EW[2 * m], w1 = EW[2 * m + 1]; const int p0 = POS[2 * m], p1 = POS[2 * m + 1];
        f32x4* xr = (f32x4*)(F.out + (size_t)m * DM) + F.lane;
        const u32x2* y0 = (const u32x2*)(Y + (size_t)p0 * DM) + F.lane; const u32x2* y1 = (const u32x2*)(Y + (size_t)p1 * DM) + F.lane;
        f32x4 v[4]; float s = 0.f;
#pragma unroll
        for (int j = 0; j < 4; ++j) { v[j] = xr[64 * j]; const u32x2 a = y0[64 * j], b = y1[64 * j];
            v[j].x += w0 * bflo(a.x) + w1 * bflo(b.x); v[j].y += w0 * bfhi(a.x) + w1 * bfhi(b.x); v[j].z += w0 * bflo(a.y) + w1 * bflo(b.y); v[j].w += w0 * bfhi(a.y) + w1 * bfhi(b.y);
            if (!dry) xr[64 * j] = v[j]; s += (v[j].x * v[j].x + v[j].y * v[j].y) + (v[j].z * v[j].z + v[j].w * v[j].w); }
        if (gain_next) { const float rstd = __builtin_amdgcn_rsqf(wave_sum(s) * (1.f / DM) + NORM_EPS); const f32x4* gr = (const f32x4*)gain_next + F.lane;
            unsigned long long* o8 = (unsigned long long*)(XN + (size_t)m * DM) + F.lane;
#pragma unroll
            for (int j = 0; j < 4; ++j) { const f32x4 gv = gr[64 * j]; o8[64 * j] = (unsigned long long)pk2(v[j].x * rstd * gv.x, v[j].y * rstd * gv.y) | ((unsigned long long)pk2(v[j].z * rstd * gv.z, v[j].w * rstd * gv.w) << 32); } }
    }
}

__device__ __forceinline__ int crow32(int reg, int hh) { return (reg & 3) + 8 * (reg >> 2) + 4 * hh; }
__device__ __forceinline__ float wave_incl_scan(float v, int lane) {
#pragma unroll
    for (int o = 1; o < 64; o <<= 1) { const float t = __shfl_up(v, o); if (lane >= o) v += t; }
    return v;
}
__device__ __forceinline__ void conv_frag(const LAS unsigned char* raw, int chan, int ks, int hh, float w0, float w1, float w2, float w3, float bias, float (&out)[8]) {
#pragma unroll
    for (int run = 0; run < 2; ++run) { const int lb = 16 * ks + 8 * run + 4 * hh; float x[7];
#pragma unroll
        for (int i = 0; i < 7; ++i) x[i] = bf2f(*(const LAS unsigned short*)(raw + (lb + i) * 128 + chan * 2));
#pragma unroll
        for (int j = 0; j < 4; ++j) out[4 * run + j] = siluf_(bias + w0 * x[j] + w1 * x[j + 1] + w2 * x[j + 2] + w3 * x[j + 3]); }
}
constexpr int RAWT = 131 * 128;
__device__ __forceinline__ void stage_raw(const bf16_t* P, size_t row0, int l0, int col, LAS unsigned char* dst, int idx0, int stride) {
    for (int base = idx0; base < 131 * 8; base += 8 * stride) { u32x4 v[8];
#pragma unroll
        for (int q = 0; q < 8; ++q) { const int idx = base + q * stride, r = idx >> 3, c8 = idx & 7; v[q] = (u32x4){0u, 0u, 0u, 0u};
            if (idx < 131 * 8 && l0 - 3 + r >= 0) v[q] = *(const u32x4*)(P + (row0 + r - 3) * NINP + col + c8 * 8); }
#pragma unroll
        for (int q = 0; q < 8; ++q) { const int idx = base + q * stride, r = idx >> 3, c8 = idx & 7; if (idx < 131 * 8) *(LAS u32x4*)(dst + r * 128 + c8 * 16) = v[q]; } }
}
__device__ __forceinline__ bf16_t* xf_base(unsigned char* ws, int b, int ch, int h) { return (bf16_t*)(ws + ((b < 2) ? WS_XN : WS_SST) + 16 * MiB) + ((size_t)(((b & 1) * SSD_NCH + ch) * 16 + h)) * 8192; }
__device__ __forceinline__ void ssdA_mfma(Frame& F, int layer) {
    const bf16_t* P = (const bf16_t*)(F.ws + WS_P); const float* DT = (const float*)(F.ws + WS_DT); bf16_t* SST = (bf16_t*)(F.ws + WS_SST); float* ASUM = (float*)(F.ws + WS_ASUM);
    const float* cw = F.in[IN_CONVW] + layer * 4 * 1280; const float* cb = F.in[IN_CONVB] + layer * 1280;
    LAS unsigned char* rawX = F.lds + F.wave * RAWT; LAS unsigned char* rawB = F.lds + 8 * RAWT; LAS float* ftab = (LAS float*)(F.lds + 9 * RAWT) + F.wave * 128;
    for (int u = F.bid; u < BATCH * SSD_NCH * 2; u += F.G) {
        const int grp = u & 1, ch = (u >> 1) & 31, b = u >> 6, h = grp * 8 + F.wave, l0 = ch * 128; const size_t row0 = (size_t)b * SEQ + l0;
        int lane = F.lane; asm volatile("" : "+v"(lane));
        const int r = lane & 31, hh = lane >> 5;
        __syncthreads();
        stage_raw(P, row0, l0, C_XS + h * 64, rawX, lane, 64);
        stage_raw(P, row0, l0, C_B + grp * 64, rawB, F.tid, NTHR);
        { const float dtb = F.in[IN_DTB][layer * 16 + h], A = -__expf(F.in[IN_ALOG][layer * 16 + h]);
          const float dt0 = softplusf_(DT[(row0 + lane) * 16 + h] + dtb), dt1 = softplusf_(DT[(row0 + 64 + lane) * 16 + h] + dtb);
          const float s0 = wave_incl_scan(dt0 * A, lane); const float tot0 = __builtin_bit_cast(float, __builtin_amdgcn_readlane(__builtin_bit_cast(int, s0), 63));
          const float s1 = wave_incl_scan(dt1 * A, lane) + tot0; const float tot = __builtin_bit_cast(float, __builtin_amdgcn_readlane(__builtin_bit_cast(int, s1), 63));
          ftab[lane] = dt0 * __expf(tot - s0); ftab[64 + lane] = dt1 * __expf(tot - s1);
          if (lane == 0) ASUM[((size_t)b * SSD_NCH + ch) * 16 + h] = tot; }
        __syncthreads();
        bf16x8 bfr[2];
#pragma unroll
        for (int q = 0; q < 2; ++q) { const int idx = F.wave * 2 + q, nt = idx >> 3, ks = idx & 7, cc = 1024 + grp * 64 + 32 * nt + r; float v[8];
            conv_frag(rawB, 32 * nt + r, ks, hh, cw[cc], cw[1280 + cc], cw[2560 + cc], cw[3840 + cc], cb[cc], v); bfr[q] = pack8v(v); }
        bf16x8 xw[2][8];
        bf16_t* xf = xf_base(F.ws, b, ch, h);
#pragma unroll
        for (int pt = 0; pt < 2; ++pt) { const int cx = h * 64 + 32 * pt + r; const float w0 = cw[cx], w1 = cw[1280 + cx], w2 = cw[2560 + cx], w3 = cw[3840 + cx], bias = cb[cx];
#pragma unroll
            for (int ks = 0; ks < 8; ++ks) { float v[8]; conv_frag(rawX, 32 * pt + r, ks, hh, w0, w1, w2, w3, bias, v);
                *(bf16x8*)(xf + ((pt * 8 + ks) * 64 + lane) * 8) = pack8v(v);
                const f32x4 fa = *(const LAS f32x4*)(ftab + 16 * ks + 4 * hh), fb = *(const LAS f32x4*)(ftab + 16 * ks + 8 + 4 * hh);
                v[0] *= fa.x; v[1] *= fa.y; v[2] *= fa.z; v[3] *= fa.w; v[4] *= fb.x; v[5] *= fb.y; v[6] *= fb.z; v[7] *= fb.w; { u32x4 pq = __builtin_bit_cast(u32x4, pack8v(v)); asm volatile("" : "+v"(pq) :: "memory"); xw[pt][ks] = __builtin_bit_cast(bf16x8, pq); } } }
        __syncthreads();
#pragma unroll
        for (int q = 0; q < 2; ++q) *(LAS bf16x8*)(rawB + (F.wave * 2 + q) * 1024 + lane * 16) = bfr[q];
        __syncthreads();
        f32x16 acc[2][2];
#pragma unroll
        for (int pt = 0; pt < 2; ++pt)
#pragma unroll
            for (int nt = 0; nt < 2; ++nt)
#pragma unroll
                for (int i = 0; i < 16; ++i) acc[pt][nt][i] = 0.f;
#pragma unroll
        for (int ks = 0; ks < 8; ++ks)
#pragma unroll
            for (int nt = 0; nt < 2; ++nt) { const bf16x8 bq = *(const LAS bf16x8*)(rawB + (nt * 8 + ks) * 1024 + lane * 16);
#pragma unroll
                for (int pt = 0; pt < 2; ++pt) acc[pt][nt] = MFMA32(xw[pt][ks], bq, acc[pt][nt]); }
        bf16_t* sp = SST + (((size_t)b * SSD_NCH + ch) * 16 + h) * 4096;
        settle_acc(acc[0][0]); settle_acc(acc[0][1]); settle_acc(acc[1][0]); settle_acc(acc[1][1]);
#pragma unroll
        for (int pt = 0; pt < 2; ++pt)
#pragma unroll
            for (int nt = 0; nt < 2; ++nt)
#pragma unroll
                for (int i = 0; i < 16; ++i) sp[(32 * pt + crow32(i, hh)) * 64 + 32 * nt + r] = (bf16_t)f2bf(acc[pt][nt][i]);
    }
}
__device__ __forceinline__ void ssdC_mfma(Frame& F, int layer) {
    const bf16_t* P = (const bf16_t*)(F.ws + WS_P); const float* DT = (const float*)(F.ws + WS_DT); const bf16_t* SST = (const bf16_t*)(F.ws + WS_SST); bf16_t* YC = (bf16_t*)(F.ws + WS_YCAT);
    const float* cw = F.in[IN_CONVW] + layer * 4 * 1280; const float* cb = F.in[IN_CONVB] + layer * 1280;
    LAS unsigned char* rawX = F.lds + F.wave * RAWT;
    LAS unsigned char* Bn = F.lds; LAS unsigned char* Cn = F.lds + 18432;
    LAS float* atab = (LAS float*)(F.lds + 36864) + F.wave * 128; LAS float* dtab = (LAS float*)(F.lds + 40960) + F.wave * 128;
    LAS float* ssqp = (LAS float*)(F.lds + 45056); LAS float* gtab = (LAS float*)(F.lds + 49152) + F.wave * 64;
    LAS unsigned char* zt = F.lds + 51200 + F.wave * 4608;
    for (int u = F.bid; u < BATCH * SSD_NCH * 2; u += F.G) {
        const int grp = u & 1, ch = (u >> 1) & 31, b = u >> 6, h = grp * 8 + F.wave, l0 = ch * 128; const size_t row0 = (size_t)b * SEQ + l0;
        int lane = F.lane; asm volatile("" : "+v"(lane));
        const int r = lane & 31, hh = lane >> 5;
        bf16x8 xsf[2][8];
        { const bf16_t* xf = xf_base(F.ws, b, ch, h);
#pragma unroll
          for (int pt = 0; pt < 2; ++pt)
#pragma unroll
              for (int ks = 0; ks < 8; ++ks) xsf[pt][ks] = *(const bf16x8*)(xf + ((pt * 8 + ks) * 64 + lane) * 8); }
        __syncthreads();
        for (int it = F.tid; it < 128 * 16; it += NTHR) { const int l = it >> 4, c8 = it & 15, isC = c8 >> 3, col = (isC ? C_C : C_B) + grp * 64 + (c8 & 7) * 8, cc = 1024 + isC * 128 + grp * 64 + (c8 & 7) * 8;
            float a[8];
#pragma unroll
            for (int e = 0; e < 8; ++e) a[e] = cb[cc + e];
#pragma unroll
            for (int j = 0; j < 4; ++j) { if (l0 + l - 3 + j >= 0) { const u32x4 xv = *(const u32x4*)(P + (row0 + l - 3 + j) * NINP + col);
#pragma unroll
                for (int e = 0; e < 4; ++e) { a[2 * e] += cw[j * 1280 + cc + 2 * e] * bflo(xv[e]); a[2 * e + 1] += cw[j * 1280 + cc + 2 * e + 1] * bfhi(xv[e]); } } }
            u32x4 o; o.x = cvtpk(siluf_(a[0]), siluf_(a[1])); o.y = cvtpk(siluf_(a[2]), siluf_(a[3])); o.z = cvtpk(siluf_(a[4]), siluf_(a[5])); o.w = cvtpk(siluf_(a[6]), siluf_(a[7]));
            *(LAS u32x4*)((isC ? Cn : Bn) + l * 144 + (c8 & 7) * 16) = o; }
        { const float dtb = F.in[IN_DTB][layer * 16 + h], A = -__expf(F.in[IN_ALOG][layer * 16 + h]);
          const float dt0 = softplusf_(DT[(row0 + lane) * 16 + h] + dtb), dt1 = softplusf_(DT[(row0 + 64 + lane) * 16 + h] + dtb);
          const float s0 = wave_incl_scan(dt0 * A, lane); const float tot0 = __builtin_bit_cast(float, __builtin_amdgcn_readlane(__builtin_bit_cast(int, s0), 63));
          const float s1 = wave_incl_scan(dt1 * A, lane) + tot0;
          atab[lane] = s0; atab[64 + lane] = s1; dtab[lane] = dt0; dtab[64 + lane] = dt1; gtab[lane] = F.in[IN_SSDG][layer * 1024 + h * 64 + lane]; }
        const bf16_t* sp = SST + (((size_t)b * SSD_NCH + ch) * 16 + h) * 4096;
        const float dsk = F.in[IN_SSDD][layer * 16 + h];
        LAS unsigned char* pf = F.lds + 90112 + F.wave * 8192;
#pragma unroll
        for (int pt = 0; pt < 2; ++pt)
#pragma unroll
            for (int ks = 0; ks < 4; ++ks) *(LAS bf16x8*)(pf + ((pt * 4 + ks) * 64 + lane) * 16) = *(const bf16x8*)(sp + (32 * pt + r) * 64 + 16 * ks + 8 * hh);
        __syncthreads();
#pragma unroll 1
        for (int li = 0; li < 4; ++li) {
            const size_t rowt = row0 + 32 * li;
            u32x4 zreg[4];
#pragma unroll
            for (int q = 0; q < 4; ++q) { const int idx = lane + 64 * q, rr = idx >> 3, c8 = idx & 7; zreg[q] = *(const u32x4*)(P + (rowt + rr) * NINP + C_Z + h * 64 + c8 * 8); }
            bf16x8 Cf[4];
#pragma unroll
            for (int ks = 0; ks < 4; ++ks) Cf[ks] = *(const LAS bf16x8*)(Cn + (32 * li + r) * 144 + (16 * ks + 8 * hh) * 2);
            f32x16 acc[2];
#pragma unroll
            for (int pt = 0; pt < 2; ++pt)
#pragma unroll
                for (int i = 0; i < 16; ++i) acc[pt][i] = 0.f;
#pragma unroll
            for (int ks = 0; ks < 4; ++ks)
#pragma unroll
                for (int pt = 0; pt < 2; ++pt) acc[pt] = MFMA32(*(const LAS bf16x8*)(pf + ((pt * 4 + ks) * 64 + lane) * 16), Cf[ks], acc[pt]);
            const float al = atab[32 * li + r], el = __expf(al); const int lrel = 32 * li + r;
            settle_acc(acc[0]); settle_acc(acc[1]);
#pragma unroll
            for (int pt = 0; pt < 2; ++pt)
#pragma unroll
                for (int i = 0; i < 16; ++i) acc[pt][i] *= el;
#pragma unroll
            for (int si = 0; si < 4; ++si) if (si <= li) {
                f32x16 X;
#pragma unroll
                for (int i = 0; i < 16; ++i) X[i] = 0.f;
#pragma unroll
                for (int ks = 0; ks < 4; ++ks) { const bf16x8 Bq = *(const LAS bf16x8*)(Bn + (32 * si + r) * 144 + (16 * ks + 8 * hh) * 2); X = MFMA32(Bq, Cf[ks], X); }
                settle_acc(X);
#pragma unroll
                for (int g4 = 0; g4 < 4; ++g4) { const int sb = 32 * si + 8 * g4 + 4 * hh; const f32x4 av = *(const LAS f32x4*)(atab + sb), dv = *(const LAS f32x4*)(dtab + sb);
#pragma unroll
                    for (int j = 0; j < 4; ++j) { const int s = sb + j; float arg = al - av[j]; if (si == li && s > lrel) arg = -100.f;
                        float x = X[4 * g4 + j] * (__expf(arg) * dv[j]); if (si == li && s > lrel) x = 0.f; if (si == li && s == lrel) x += dsk; X[4 * g4 + j] = x; } }
#pragma unroll
                for (int kq = 0; kq < 2; ++kq) { const float v[8] = {X[8 * kq], X[8 * kq + 1], X[8 * kq + 2], X[8 * kq + 3], X[8 * kq + 4], X[8 * kq + 5], X[8 * kq + 6], X[8 * kq + 7]}; bf16x8 Xf = pack8v(v); pin_frag(Xf);
#pragma unroll
                    for (int pt = 0; pt < 2; ++pt) { bf16x8 a;
#pragma unroll
                        for (int q = 0; q < 4; ++q) a = (si == q) ? xsf[pt][2 * q + kq] : a;
                        acc[pt] = MFMA32(a, Xf, acc[pt]); } }
            }
            settle_acc(acc[0]); settle_acc(acc[1]);
#pragma unroll
            for (int q = 0; q < 4; ++q) { const int idx = lane + 64 * q, rr = idx >> 3, c8 = idx & 7; *(LAS u32x4*)(zt + rr * 144 + c8 * 16) = zreg[q]; }
            float qs = 0.f;
#pragma unroll
            for (int pt = 0; pt < 2; ++pt)
#pragma unroll
                for (int g4 = 0; g4 < 4; ++g4) { const u32x2 zz = *(const LAS u32x2*)(zt + r * 144 + (32 * pt + 8 * g4 + 4 * hh) * 2);
                    const float z0 = bflo(zz.x), z1 = bfhi(zz.x), z2 = bflo(zz.y), z3 = bfhi(zz.y);
                    float y0 = acc[pt][4 * g4] * siluf_(z0), y1 = acc[pt][4 * g4 + 1] * siluf_(z1), y2 = acc[pt][4 * g4 + 2] * siluf_(z2), y3 = acc[pt][4 * g4 + 3] * siluf_(z3);
                    acc[pt][4 * g4] = y0; acc[pt][4 * g4 + 1] = y1; acc[pt][4 * g4 + 2] = y2; acc[pt][4 * g4 + 3] = y3; qs += (y0 * y0 + y1 * y1) + (y2 * y2 + y3 * y3); }
            qs += __shfl_xor(qs, 32);
            if (hh == 0) ssqp[(32 * li + r) * 8 + F.wave] = qs;
            __syncthreads();
            { const f32x4 qa = *(const LAS f32x4*)(ssqp + (32 * li + r) * 8), qb = *(const LAS f32x4*)(ssqp + (32 * li + r) * 8 + 4);
              const float rs = __builtin_amdgcn_rsqf(((qa.x + qa.y) + (qa.z + qa.w) + (qb.x + qb.y) + (qb.z + qb.w)) * (1.f / 512.f) + NORM_EPS);
#pragma unroll
              for (int pt = 0; pt < 2; ++pt)
#pragma unroll
                  for (int g4 = 0; g4 < 4; ++g4) { const int p0 = 32 * pt + 8 * g4 + 4 * hh; const f32x4 gv = *(const LAS f32x4*)(gtab + p0);
                      u32x2 o; o.x = cvtpk(acc[pt][4 * g4] * rs * gv.x, acc[pt][4 * g4 + 1] * rs * gv.y); o.y = cvtpk(acc[pt][4 * g4 + 2] * rs * gv.z, acc[pt][4 * g4 + 3] * rs * gv.w);
                      *(LAS u32x2*)(zt + r * 144 + p0 * 2) = o; } }
#pragma unroll
            for (int q = 0; q < 4; ++q) { const int idx = lane + 64 * q, rr = idx >> 3, c8 = idx & 7; *(u32x4*)(YC + (rowt + rr) * 2048 + 1024 + h * 64 + c8 * 8) = *(const LAS u32x4*)(zt + rr * 144 + c8 * 16); }
        }
    }
}

__device__ __forceinline__ void attn_mfma(Frame& F, int layer) {
    LAS unsigned char* Kn = F.lds; LAS unsigned char* VT = F.lds + 36864;
    const bf16_t* P = (const bf16_t*)(F.ws + WS_P); bf16_t* YC = (bf16_t*)(F.ws + WS_YCAT);
    const float* qg = F.in[IN_QG] + layer * 64; const float* kg = F.in[IN_KG] + layer * 64;
    for (int u = F.bid; u < BATCH * 32 * 2; u += F.G) {
        const int kvh = u & 1, qb = (u >> 1) & 31, b = u >> 6, q0 = qb * 128;
        int lane = F.lane; asm volatile("" : "+v"(lane));
        const int r = lane & 31, hh = lane >> 5;
        __syncthreads();
#pragma unroll
        for (int pass = 0; pass < 2; ++pass) { const int jr = pass * 128 + (F.tid >> 2), j4 = F.tid & 3, l = q0 - 128 + jr;
            u32x4 lo = {0u, 0u, 0u, 0u}, hi = {0u, 0u, 0u, 0u};
            if (l >= 0) { const bf16_t* kp = P + ((size_t)b * SEQ + l) * NINP + C_K + kvh * 64 + 8 * j4; lo = *(const u32x4*)kp; hi = *(const u32x4*)(kp + 32); }
            float x1[8], x2[8]; float ss = 0.f;
#pragma unroll
            for (int e = 0; e < 4; ++e) { x1[2 * e] = bflo(lo[e]); x1[2 * e + 1] = bfhi(lo[e]); x2[2 * e] = bflo(hi[e]); x2[2 * e + 1] = bfhi(hi[e]); }
#pragma unroll
            for (int e = 0; e < 8; ++e) ss += x1[e] * x1[e] + x2[e] * x2[e];
            ss += WS_DPP(ss, 0xB1, 0xF); ss += WS_DPP(ss, 0x4E, 0xF);
            const float rs = __builtin_amdgcn_rsqf(ss * (1.f / 64.f) + NORM_EPS);
            float o1[8], o2[8];
#pragma unroll
            for (int e = 0; e < 8; ++e) { const int i = 8 * j4 + e; const float inv = exp2f(-(float)i * (13.287712379549449f / 32.f)); float s, c; sincos_fast((float)l * inv, s, c);
                const float a = x1[e] * rs * kg[i], bq = x2[e] * rs * kg[i + 32]; o1[e] = a * c - bq * s; o2[e] = bq * c + a * s; }
            u32x4 w1, w2; w1.x = cvtpk(o1[0], o1[1]); w1.y = cvtpk(o1[2], o1[3]); w1.z = cvtpk(o1[4], o1[5]); w1.w = cvtpk(o1[6], o1[7]);
            w2.x = cvtpk(o2[0], o2[1]); w2.y = cvtpk(o2[2], o2[3]); w2.z = cvtpk(o2[4], o2[5]); w2.w = cvtpk(o2[6], o2[7]);
            if (l < 0) { w1 = (u32x4){0u, 0u, 0u, 0u}; w2 = w1; }
            *(LAS u32x4*)(Kn + jr * 144 + 16 * j4) = w1; *(LAS u32x4*)(Kn + jr * 144 + 64 + 16 * j4) = w2; }
#pragma unroll
        for (int q = 0; q < 4; ++q) { const int it = F.tid + NTHR * q, d = it & 63, ko = it >> 6; unsigned short v[8];
#pragma unroll
            for (int e = 0; e < 8; ++e) { const int l = q0 - 128 + 8 * ko + e; v[e] = (l >= 0) ? P[((size_t)b * SEQ + l) * NINP + C_V + kvh * 64 + d] : (unsigned short)0; }
            u32x4 o; o.x = v[0] | ((unsigned)v[1] << 16); o.y = v[2] | ((unsigned)v[3] << 16); o.z = v[4] | ((unsigned)v[5] << 16); o.w = v[6] | ((unsigned)v[7] << 16);
            *(LAS u32x4*)(VT + d * 528 + ko * 16) = o; }
        __syncthreads();
        const int hd = F.wave >> 1, head = kvh * 4 + hd, qhalf = F.wave & 1; const float sink = F.in[IN_SINK][layer * 8 + head];
#pragma unroll 1
        for (int jt = 0; jt < 2; ++jt) {
            const int qt = q0 + 64 * qhalf + 32 * jt, qi = qt + r, t0 = 2 * qhalf + jt; const size_t row = (size_t)b * SEQ + qi;
            bf16x8 Qf[4];
            { float qv[4][8]; float ss = 0.f;
#pragma unroll
              for (int ks = 0; ks < 4; ++ks) { const u32x4 w = *(const u32x4*)(P + row * NINP + C_Q + head * 64 + 16 * ks + 8 * hh);
#pragma unroll
                  for (int e = 0; e < 4; ++e) { qv[ks][2 * e] = bflo(w[e]); qv[ks][2 * e + 1] = bfhi(w[e]); ss += qv[ks][2 * e] * qv[ks][2 * e] + qv[ks][2 * e + 1] * qv[ks][2 * e + 1]; } }
              ss += __shfl_xor(ss, 32);
              const float rs = __builtin_amdgcn_rsqf(ss * (1.f / 64.f) + NORM_EPS);
#pragma unroll
              for (int ks = 0; ks < 4; ++ks)
#pragma unroll
                  for (int e = 0; e < 8; ++e) qv[ks][e] *= rs * qg[16 * ks + 8 * hh + e];
#pragma unroll
              for (int ks = 0; ks < 2; ++ks)
#pragma unroll
                  for (int e = 0; e < 8; ++e) { const int i = 16 * ks + 8 * hh + e; const float inv = exp2f(-(float)i * (13.287712379549449f / 32.f)); float s, c; sincos_fast((float)qi * inv, s, c);
                      const float a = qv[ks][e], bq = qv[ks + 2][e]; qv[ks][e] = (a * c - bq * s) * 0.125f; qv[ks + 2][e] = (bq * c + a * s) * 0.125f; }
#pragma unroll
              for (int ks = 0; ks < 4; ++ks) { Qf[ks] = pack8v(qv[ks]); pin_frag(Qf[ks]); } }
            f32x16 acc[2];
#pragma unroll
            for (int dt = 0; dt < 2; ++dt)
#pragma unroll
                for (int i = 0; i < 16; ++i) acc[dt][i] = 0.f;
            float m = sink, lsum = 1.f;
#pragma unroll
            for (int tt = 0; tt < 5; ++tt) { const int t = t0 + tt;
                if (q0 == 0 && t < 4) continue;
                f32x16 X;
#pragma unroll
                for (int i = 0; i < 16; ++i) X[i] = 0.f;
#pragma unroll
                for (int ks = 0; ks < 4; ++ks) { const bf16x8 Kq = *(const LAS bf16x8*)(Kn + (32 * t + r) * 144 + (16 * ks + 8 * hh) * 2); X = MFMA32(Kq, Qf[ks], X); }
                settle_acc(X);
                if (tt == 0) {
#pragma unroll
                    for (int i = 0; i < 16; ++i) if (!(r < crow32(i, hh))) X[i] = -INFINITY; }
                if (tt == 4) {
#pragma unroll
                    for (int i = 0; i < 16; ++i) if (!(crow32(i, hh) <= r)) X[i] = -INFINITY; }
                float mx = X[0];
#pragma unroll
                for (int i = 1; i < 16; ++i) mx = fmaxf(mx, X[i]);
                mx = fmaxf(mx, __shfl_xor(mx, 32));
                const float mn = fmaxf(m, mx), al = __expf(m - mn); m = mn;
                float ps = 0.f;
#pragma unroll
                for (int i = 0; i < 16; ++i) { X[i] = __expf(X[i] - mn); ps += X[i]; }
                ps += __shfl_xor(ps, 32);
                lsum = lsum * al + ps;
                settle_acc(acc[0]); settle_acc(acc[1]);
#pragma unroll
                for (int dt = 0; dt < 2; ++dt)
#pragma unroll
                    for (int i = 0; i < 16; ++i) acc[dt][i] *= al;
#pragma unroll
                for (int kq = 0; kq < 2; ++kq) { const float v[8] = {X[8 * kq], X[8 * kq + 1], X[8 * kq + 2], X[8 * kq + 3], X[8 * kq + 4], X[8 * kq + 5], X[8 * kq + 6], X[8 * kq + 7]}; bf16x8 Pf = pack8v(v); pin_frag(Pf);
#pragma unroll
                    for (int dt = 0; dt < 2; ++dt) { const LAS unsigned char* vp = VT + (32 * dt + r) * 528 + (32 * t + 16 * kq + 4 * hh) * 2;
                        const u32x2 va = *(const LAS u32x2*)vp, vb = *(const LAS u32x2*)(vp + 16); const u32x4 vv = {va.x, va.y, vb.x, vb.y}; bf16x8 Vf = __builtin_bit_cast(bf16x8, vv); pin_frag(Vf);
                        acc[dt] = MFMA32(Vf, Pf, acc[dt]); } }
            }
            const float il = 1.f / lsum; settle_acc(acc[0]); settle_acc(acc[1]);
#pragma unroll
            for (int dt = 0; dt < 2; ++dt)
#pragma unroll
                for (int g4 = 0; g4 < 4; ++g4) { u32x2 o; o.x = cvtpk(acc[dt][4 * g4] * il, acc[dt][4 * g4 + 1] * il); o.y = cvtpk(acc[dt][4 * g4 + 2] * il, acc[dt][4 * g4 + 3] * il);
                    *(u32x2*)(YC + row * 2048 + 512 + head * 64 + 32 * dt + 8 * g4 + 4 * hh) = o; }
        }
    }
}

#ifndef MK_PER_PHASE
#define MK_PER_PHASE 0
#endif
constexpr int NPH = 13;
constexpr int TAB_OFF = 150 * 1024;
struct Args { const float* in[N_INPUTS]; float* out; unsigned char* ws; int gp_lo, gp_hi; };
static_assert(sizeof(Args) == (N_INPUTS + 2) * 8 + 8, "no padding in Args");

#ifndef PROBE_ID
#define PROBE_ID 0
#endif
#ifndef PROBE_N
#define PROBE_N 1
#endif
#define REP(id) for (int _r = 0; _r < ((id) == PROBE_ID ? 1 + PROBE_N : 1); ++_r)
extern __shared__ __attribute__((aligned(16))) unsigned char lds_raw[];
__device__ __forceinline__ LAS unsigned char* lds_raw_base() { return (LAS unsigned char*)lds_raw; }
#define LAUNDER() do { asm volatile("" : "+s"(F.in), "+s"(F.ws), "+s"(F.out), "+s"(F.ctl), "+s"(F.bid), "+s"(F.G)); asm volatile("" : "+v"(F.tid)); F.lane = F.tid & 63; F.wave = __builtin_amdgcn_readfirstlane(F.tid >> 6); } while (0)
template <int layer>
__device__ __forceinline__ void layer_body(Frame& F, const int lo, const int hi, const bool rerun) {
    volatile LAS int* offs = (volatile LAS int*)(F.lds + TAB_OFF); volatile LAS int* tile_e = offs + 64;
    XcdBarrier bar; bar.bar = F.ctl + CW_BAR; bar.x = xb_xcc_id(); bar.st = F.MISC;
#define GP(k) (layer * NPH + (k))
#ifdef ONLY_PH
#define IN(k) (((k) == ONLY_PH) && lo <= GP(k) && GP(k) < hi)
#else
#define IN(k) (lo <= GP(k) && GP(k) < hi)
#endif
#define WSB ((const char*)F.ws)
#ifdef DIAG_GP
#define STAMP0(k) do { if (GP(k) == DIAG_GP) { const unsigned t_ = (unsigned)__builtin_amdgcn_s_memrealtime(); if (threadIdx.x == 0) *(volatile LAS unsigned*)((LAS unsigned char*)lds_raw_base() + MISC_OFF + 32) = t_; } } while (0)
#define STAMP1(k) do { if (GP(k) == DIAG_GP) { const unsigned t_ = (unsigned)__builtin_amdgcn_s_memrealtime(); if (threadIdx.x == 0) *(volatile LAS unsigned*)((LAS unsigned char*)lds_raw_base() + MISC_OFF + 40) = t_; } } while (0)
#else
#define STAMP0(k)
#define STAMP1(k)
#endif
#define SEAM(k) do { if (!MK_PER_PHASE && IN(k) && GP(k) + 1 < hi) { xcd_barrier(bar); if (PROBE_ID == 19) { xcd_barrier(bar); xcd_barrier(bar); } } STAMP1(k); } while (0)
        if (IN(0) && layer == 0) { LAUNDER(); STAMP0(0);
            REP(1) { convert_weights(F, 0); __syncthreads(); } REP(2) s5_build(F, 0);
            REP(3) rmsnorm_rows(F, F.in[IN_X], F.in[IN_NORM1], (bf16_t*)(F.ws + WS_XN));
            SEAM(0);
        }
        if (IN(1)) { LAUNDER(); STAMP0(1);
            SchedDense<2048u, 2048u, T / 256, NINP / 256, 16> S{WSB + WS_XN, WSB + WS_WIN, F.G, F.bid};
            EpiProj E{F.ws, F.in[IN_BGATE] + layer * 3072};
            REP(4) pg8::gemm_phase<2048u, 2048u>(F.tid, F.lds, S, E);
            SEAM(1);
        }
        if (IN(2)) { LAUNDER(); STAMP0(2);
            SchedS5P1 S{WSB + WS_UH, WSB + WS_EG, F.G, F.bid};
            EpiHloc E{(float*)(F.ws + WS_HLOC)};
            REP(5) pg8::gemm_phase<(unsigned)(S5_K * 2), 1024u>(F.tid, F.lds, S, E);
            REP(6) ssdA_mfma(F, layer);
            REP(8) attn_mfma(F, layer);
            SEAM(2);
        }
        if (IN(3)) { LAUNDER(); STAMP0(3);
            REP(7) s5_scan(F, layer);
            if (!rerun) ssd_scan(F);
            SEAM(3);
        }
        if (IN(4)) { LAUNDER(); STAMP0(4);
            SchedS5Main S{WSB + WS_UH, WSB + WS_MG, F.G, F.bid};
            EpiS5Y E{(bf16_t*)(F.ws + WS_XN)};
            REP(9) pg8::gemm_phase<(unsigned)(S5_K * 2), (unsigned)(S5_K * 2)>(F.tid, F.lds, S, E);
            REP(10) ssdC_mfma(F, layer);
            SEAM(4);
        }
        if (IN(5)) { LAUNDER(); STAMP0(5);
            SchedDense<1024u, 1024u, T / 256, 4, 8> S{WSB + WS_XN, WSB + WS_WGLU, F.G, F.bid};
            EpiGlu E{(bf16_t*)(F.ws + WS_YCAT)};
            REP(11) pg8::gemm_phase<1024u, 1024u>(F.tid, F.lds, S, E);
            SEAM(5);
        }
        if (IN(6)) { LAUNDER(); STAMP0(6);
            SchedDense<4096u, 4096u, T / 256, 4, 32> S{WSB + WS_YCAT, WSB + WS_PCAT, F.G, F.bid};
            EpiMerged E{F.ws};
            REP(12) pg8::gemm_phase<4096u, 4096u>(F.tid, F.lds, S, E);
            SEAM(6);
        }
        if (IN(7)) { LAUNDER(); STAMP0(7);
            SchedDense<2048u, 2048u, T / 256, 4, 16> S{WSB + WS_XN, WSB + WS_WOUT, F.G, F.bid};
            EpiResid E{layer == 0 ? F.in[IN_X] : (const float*)F.out, F.out};
            REP(layer == 0 ? 13 : -1) pg8::gemm_phase<2048u, 2048u>(F.tid, F.lds, S, E);
            SEAM(7);
        }
        if (IN(8)) { LAUNDER(); STAMP0(8); REP(17) router_phase(F, layer); SEAM(8); }
        if (IN(9)) { LAUNDER(); STAMP0(9); (void)moe_tables(F, layer, offs, tile_e); REP(14) gather_phase(F, layer, offs); SEAM(9); }
        if (IN(10)) { LAUNDER(); STAMP0(10);
            const int ntiles = moe_tables(F, layer, offs, tile_e);
            SchedMoe<2048u, (size_t)1024 * 1024 * 2, (size_t)256 * 2048, 16> S{WSB + WS_XG, WSB + WS_EGU, ntiles, F.G, F.bid, tile_e};
            EpiSwiGlu E{(bf16_t*)(F.ws + WS_HID), (const float*)(F.ws + WS_MOE + 704 * 1024)};
            REP(15) pg8::gemm_phase<2048u, 2048u>(F.tid, F.lds, S, E);
            SEAM(10);
        }
        if (IN(11)) { LAUNDER(); STAMP0(11);
            const int ntiles = moe_tables(F, layer, offs, tile_e);
            SchedMoe<1024u, (size_t)1024 * 512 * 2, (size_t)256 * 1024, 8> S{WSB + WS_HID, WSB + WS_EDN, ntiles, F.G, F.bid, tile_e};
            EpiPlainBf16 E{(bf16_t*)(F.ws + WS_YEXP)};
            REP(16) pg8::gemm_phase<1024u, 1024u>(F.tid, F.lds, S, E);
            SEAM(11);
        }
        if (IN(12)) { LAUNDER(); STAMP0(12);
            if (PROBE_ID == 18) combine_phase(F, F.in[IN_NORM1], true);
            combine_phase(F, layer + 1 < DEPTH ? F.in[IN_NORM1] + (layer + 1) * 1024 : nullptr);
            if (layer + 1 < DEPTH) { __syncthreads(); convert_weights(F, layer + 1); __syncthreads(); s5_build(F, layer + 1); }
            SEAM(12);
        }
#undef GP
#undef IN
#undef SEAM
#undef WSB
}
__global__ void __launch_bounds__(NTHR, 2) fwd(Args args) {
    Frame F;
    F.lds = (LAS unsigned char*)lds_raw;
    F.MISC = (volatile LAS unsigned*)(F.lds + MISC_OFF);
    F.tid = threadIdx.x; F.lane = F.tid & 63; F.wave = __builtin_amdgcn_readfirstlane(F.tid >> 6);
    F.G = gridDim.x; F.bid = blockIdx.x;
    const __attribute__((address_space(4))) char* ka = (const __attribute__((address_space(4))) char*)__builtin_amdgcn_kernarg_segment_ptr();
    F.in = (const float* const __attribute__((address_space(4)))*)ka;
    F.out = *(float* const __attribute__((address_space(4)))*)(ka + N_INPUTS * 8); F.ws = *(unsigned char* const __attribute__((address_space(4)))*)(ka + N_INPUTS * 8 + 8); F.ctl = (unsigned*)(F.ws + WS_CTL);
    if (F.tid < 64) F.MISC[F.tid] = 0u;
    __syncthreads();
    XcdBarrier bar; bar.bar = F.ctl + CW_BAR; bar.x = 0; bar.st = nullptr;
    if (!MK_PER_PHASE) bar = xcd_barrier_post(F.ctl + CW_BAR, F.MISC);
    const int lo = *(const __attribute__((address_space(4))) int*)(ka + N_INPUTS * 8 + 16), hi_raw = *(const __attribute__((address_space(4))) int*)(ka + N_INPUTS * 8 + 20), hi = hi_raw & 0xffff;

    layer_body<0>(F, lo, hi, (hi_raw >> 16) != 0);
    layer_body<1>(F, lo, hi, (hi_raw >> 16) != 0);
#ifdef DIAG_GP
    __syncthreads();
    if (blockIdx.x == 0 && threadIdx.x == 0) { const unsigned t0 = *(volatile LAS unsigned*)((LAS unsigned char*)lds_raw_base() + MISC_OFF + 32), t1 = *(volatile LAS unsigned*)((LAS unsigned char*)lds_raw_base() + MISC_OFF + 40); float* o_ = *(float* const __attribute__((address_space(4)))*)((const __attribute__((address_space(4))) char*)__builtin_amdgcn_kernarg_segment_ptr() + N_INPUTS * 8); asm volatile("s_waitcnt vmcnt(0)" ::: "memory"); o_[0] = (float)(t1 - t0); }
#endif
}

extern "C" void kernel_launch(void* const* d_in, const int* in_sizes, int n_in, void* d_out, int out_size, void* d_ws, size_t ws_size, hipStream_t stream) {
    static int grid = 0;
    if (grid == 0) {
        if (n_in != N_INPUTS || out_size != T * DM || ws_size < WS_END) { fprintf(stderr, "kernel_launch: unexpected shapes (n_in %d out %d ws %zu need %zu)\n", n_in, out_size, ws_size, (size_t)WS_END); grid = -1; return; }
        int dev = 0, cus = 0, per_cu = 0;
        if (hipGetDevice(&dev) != hipSuccess || hipDeviceGetAttribute(&cus, hipDeviceAttributeMultiprocessorCount, dev) != hipSuccess) { grid = -1; return; }
        if (hipFuncSetAttribute((const void*)fwd, hipFuncAttributeMaxDynamicSharedMemorySize, LDS_BYTES) != hipSuccess) { fprintf(stderr, "kernel_launch: hipFuncSetAttribute failed\n"); grid = -1; return; }
        if (hipOccupancyMaxActiveBlocksPerMultiprocessor(&per_cu, (const void*)fwd, NTHR, LDS_BYTES) != hipSuccess || per_cu < 1) fprintf(stderr, "kernel_launch: occupancy query reports %d\n", per_cu);
        (void)hipGetLastError();
        grid = cus;
    }
    if (grid < 0) return;
    (void)hipMemsetAsync((char*)d_ws + WS_CTL, 0, CTL_ZERO_BYTES, stream);
    Args a{};
    for (int i = 0; i < N_INPUTS; ++i) a.in[i] = (const float*)d_in[i];
    a.out = (float*)d_out; a.ws = (unsigned char*)d_ws;
#if MK_PER_PHASE
    for (int gp = 0; gp < DEPTH * NPH; ++gp) {
        if (gp == NPH) continue;
        a.gp_lo = gp; a.gp_hi = gp + 1;
        int nrep = 1;
#ifdef PP_REP_GP
        if (gp == PP_REP_GP) nrep = 1 + PP_REP_N;
#endif
        for (int rr = 0; rr < nrep; ++rr) { a.gp_hi = (gp + 1) | (rr > 0 ? 0x10000 : 0); hipLaunchKernelGGL(fwd, dim3(grid), dim3(NTHR), LDS_BYTES, stream, a); }
    }
#else
    a.gp_lo = 0; a.gp_hi = DEPTH * NPH;
    hipLaunchKernelGGL(fwd, dim3(grid), dim3(NTHR), LDS_BYTES, stream, a);
#endif
}
```

```cpp
#include <hip/hip_runtime.h>
#include <cstdio>
#include <cstdint>

#define LAS __attribute__((address_space(3)))
#define GAS __attribute__((address_space(1)))
typedef unsigned short bf16_t;
typedef short bf16x8 __attribute__((ext_vector_type(8)));
typedef float f32x4 __attribute__((ext_vector_type(4)));
typedef float f32x2 __attribute__((ext_vector_type(2)));
typedef unsigned u32x4 __attribute__((ext_vector_type(4)));
typedef unsigned u32x2 __attribute__((ext_vector_type(2)));

constexpr int BATCH = 4, SEQ = 4096, DM = 1024, T = BATCH * SEQ, DEPTH = 2;
constexpr int NIN = 6672, NINP = 6912;
constexpr int C_U = 0, C_Q = 512, C_K = 1024, C_V = 1152, C_Z = 1280, C_XS = 2304, C_B = 3328, C_C = 3456, C_DT = 3584, C_G = 3840;
constexpr int S5_TC = 32, S5_ROWS = T / S5_TC  , S5_K = 128 + S5_TC * 16  , S5_N = S5_TC * 16  ;
constexpr int SSD_NCH = SEQ / 128;
constexpr int MOE_MAXROWS = 2 * T + 32 * 256;
constexpr float NORM_EPS = 1e-6f;

constexpr size_t MiB = 1u << 20;
constexpr size_t WS_CTL = 0, CTL_ZERO_BYTES = 1 * MiB;
constexpr size_t WS_WIN = 1 * MiB;
constexpr size_t WS_WGLU = WS_WIN + (size_t)NINP * DM * 2;
constexpr size_t WS_PCAT = WS_WGLU + 1 * MiB;
constexpr size_t WS_WOUT = WS_PCAT + 4 * MiB;
constexpr size_t WS_EGU = WS_WOUT + 2 * MiB;
constexpr size_t WS_EDN = WS_EGU + 64 * MiB;
constexpr size_t WS_MG = WS_EDN + 32 * MiB;
constexpr size_t WS_EG = WS_MG + 20 * MiB;
constexpr size_t WS_XN = WS_EG + 8 * MiB;
constexpr size_t WS_P = WS_XN + 32 * MiB;
constexpr size_t WS_XG = WS_P;
constexpr size_t WS_HID = WS_XG + (size_t)MOE_MAXROWS * 1024 * 2;
constexpr size_t WS_YEXP = WS_HID + (size_t)MOE_MAXROWS * 512 * 2;
constexpr size_t WS_DT = WS_P + 216 * MiB;
constexpr size_t WS_UH = WS_DT + 1 * MiB;
constexpr size_t WS_HLOC = WS_UH + 20 * MiB;
constexpr size_t WS_YCAT = WS_HLOC + 8 * MiB;
constexpr size_t WS_SST = WS_YCAT + 64 * MiB;
constexpr size_t WS_MOE = WS_SST + 32 * MiB;
constexpr size_t WS_ASUM = WS_MOE + 1 * MiB;
constexpr size_t WS_END = WS_ASUM + 64 * 1024;
static_assert(WS_YEXP + (size_t)MOE_MAXROWS * 1024 * 2 <= WS_DT, "MoE overlay fits in P");
constexpr int CW_BAR = 4096;
constexpr int CW_CNT = 16384;

constexpr int NWAVES = 8, NTHR = 512;
constexpr int LDS_BYTES = 163840;
constexpr int RING_BYTES = 131072;
constexpr int MISC_OFF = 160 * 1024 - 256;

__device__ __forceinline__ unsigned f2bf(float f) { unsigned u = __builtin_bit_cast(unsigned, f); return (u + 0x7fffu + ((u >> 16) & 1u)) >> 16; }
typedef float f32x2_t __attribute__((ext_vector_type(2)));
typedef __bf16 bf16x2_t __attribute__((ext_vector_type(2)));
__device__ __forceinline__ unsigned pk2(float lo, float hi) { f32x2_t v = {lo, hi}; bf16x2_t b = __builtin_convertvector(v, bf16x2_t); return __builtin_bit_cast(unsigned, b); }
__device__ __forceinline__ float bf2f(unsigned b) { return __builtin_bit_cast(float, b << 16); }
__device__ __forceinline__ float bflo(unsigned w) { return __builtin_bit_cast(float, w << 16); }
__device__ __forceinline__ float bfhi(unsigned w) { return __builtin_bit_cast(float, w & 0xffff0000u); }
#define WS_DPP(v, ctrl, rmask) __builtin_bit_cast(float, __builtin_amdgcn_update_dpp(0, __builtin_bit_cast(int, v), ctrl, rmask, 0xF, false))
__device__ __forceinline__ float wave_sum(float v) {
    v += WS_DPP(v, 0xB1, 0xF);
    v += WS_DPP(v, 0x4E, 0xF);
    v += WS_DPP(v, 0x141, 0xF);
    v += WS_DPP(v, 0x140, 0xF);
    v += WS_DPP(v, 0x142, 0xA);
    v += WS_DPP(v, 0x143, 0xC);
    return __builtin_bit_cast(float, __builtin_amdgcn_readlane(__builtin_bit_cast(int, v), 63));
}
__device__ __forceinline__ float frcp(float x) { return __builtin_amdgcn_rcpf(x); }
__device__ __forceinline__ float sigmoidf_(float x) { return frcp(1.0f + __expf(-x)); }
__device__ __forceinline__ float siluf_(float x) { return x * frcp(1.0f + __expf(-x)); }
__device__ __forceinline__ float gelu_tanh_(float x) { const float u = 0.7978845608f * (x + 0.044715f * x * x * x); return x * frcp(1.0f + __expf(-2.0f * u)); }
__device__ __forceinline__ float softplusf_(float x) { return x > 20.f ? x : log1pf(__expf(x)); }

typedef float f32x16 __attribute__((ext_vector_type(16)));
#define MFMA32(a, b, c) __builtin_amdgcn_mfma_f32_32x32x16_bf16((a), (b), (c), 0, 0, 0)
__device__ __forceinline__ unsigned cvtpk(float lo, float hi) { f32x2_t v = {lo, hi}; bf16x2_t b = __builtin_convertvector(v, bf16x2_t); return __builtin_bit_cast(unsigned, b); }
__device__ __forceinline__ void pin_frag(bf16x8& f) { u32x4 t = __builtin_bit_cast(u32x4, f); asm volatile("s_nop 1" : "+v"(t)); f = __builtin_bit_cast(bf16x8, t); }
__device__ __forceinline__ void settle_acc(f32x16& x) { asm volatile("s_nop 15\n\ts_nop 3" : "+v"(x)); }
__device__ __forceinline__ bf16x8 pack8v(const float (&v)[8]) { u32x4 p; p.x = cvtpk(v[0], v[1]); p.y = cvtpk(v[2], v[3]); p.z = cvtpk(v[4], v[5]); p.w = cvtpk(v[6], v[7]); return __builtin_bit_cast(bf16x8, p); }

#define XB_TMO      128
#define XB_XCNT(j)  (256  + 64 * (j))
#define XB_XSUB(j)  (1280 + 64 * (j))
#define XB_XGEN(j)  (2304 + 64 * (j))
#define XB_TOP      3328
#define XB_TOPGEN   3392
#define XCD_BAR_WORDS 3456
#define XB_SPIN_CAP (1u << 18)
__device__ __forceinline__ unsigned xb_ld(unsigned* p)              { return __hip_atomic_load(p, __ATOMIC_RELAXED, __HIP_MEMORY_SCOPE_AGENT); }
__device__ __forceinline__ unsigned xb_add(unsigned* p, unsigned v) { return __hip_atomic_fetch_add(p, v, __ATOMIC_RELAXED, __HIP_MEMORY_SCOPE_AGENT); }
__device__ __forceinline__ unsigned xb_xcc_id() { return (unsigned)__builtin_amdgcn_s_getreg((3 << 11) | 20) & 0xFu; }
#define XB_SPIN(cond, bar) do { unsigned _sp = 0; while (cond) { __builtin_amdgcn_s_sleep(1); \
    if ((++_sp & 255u) == 0u) { if (xb_ld(&(bar)[XB_TMO])) break; if (_sp > XB_SPIN_CAP) { atomicAdd(&(bar)[XB_TMO], 1u); break; } } } } while (0)
struct XcdBarrier { unsigned* bar; unsigned x; volatile LAS unsigned* st; };
__device__ __forceinline__ XcdBarrier xcd_barrier_post(unsigned* bar, volatile LAS unsigned* st) {
    XcdBarrier b; b.bar = bar; b.x = xb_xcc_id(); b.st = st;
    if (threadIdx.x == 0) (void)xb_add(&bar[XB_XCNT(b.x)], 1u);
    return b;
}
__device__ __forceinline__ void xcd_barrier_complete(unsigned* bar, unsigned x, unsigned& nloc, unsigned& nx) {
    const unsigned G = gridDim.x * gridDim.y * gridDim.z;
    unsigned sum, cnt, mine, sp = 0u;
    for (;;) {
        sum = 0u; cnt = 0u; mine = 0u;
#pragma unroll
        for (unsigned j = 0; j < 16; ++j) { const unsigned c = xb_ld(&bar[XB_XCNT(j)]); sum += c; cnt += (c > 0u) ? 1u : 0u; mine = (j == x) ? c : mine; }
        if (sum == G) break;
        __builtin_amdgcn_s_sleep(1);
        if ((++sp & 255u) == 0u) { if (xb_ld(&bar[XB_TMO])) break; if (sp > XB_SPIN_CAP) { atomicAdd(&bar[XB_TMO], 1u); break; } }
    }
    nloc = mine > 0u ? mine : 1u; nx = cnt > 0u ? cnt : 1u;
}
__device__ __forceinline__ void xcd_barrier(const XcdBarrier& b) {
    asm volatile("s_waitcnt vmcnt(0)" ::: "memory");
    __syncthreads();
    if (threadIdx.x == 0) {
        unsigned* bar = b.bar;
        __builtin_amdgcn_s_waitcnt(0);
        unsigned nloc = b.st[0], nx = b.st[1];
        if (nloc == 0u) { xcd_barrier_complete(bar, b.x, nloc, nx); b.st[0] = nloc; b.st[1] = nx; }
        const unsigned old = xb_add(&bar[XB_XSUB(b.x)], 1u);
        const unsigned gen = old / nloc;
        if (old + 1u == (gen + 1u) * nloc) {
            __builtin_amdgcn_fence(__ATOMIC_RELEASE, "agent");
            asm volatile("s_waitcnt vmcnt(0)" ::: "memory");
            const unsigned og = xb_add(&bar[XB_TOP], 1u);
            const unsigned tg = og / nx;
            if (og + 1u == (tg + 1u) * nx) xb_add(&bar[XB_TOPGEN], 1u);
            else XB_SPIN(xb_ld(&bar[XB_TOPGEN]) == tg, bar);
            __builtin_amdgcn_fence(__ATOMIC_ACQUIRE, "agent");
            xb_add(&bar[XB_XGEN(b.x)], 1u);
            asm volatile("s_waitcnt vmcnt(0)" ::: "memory");
        } else {
            XB_SPIN(xb_ld(&bar[XB_XGEN(b.x)]) == gen, bar);
            __builtin_amdgcn_fence(__ATOMIC_ACQUIRE, "agent");
            asm volatile("s_waitcnt vmcnt(0)" ::: "memory");
        }
    }
    __syncthreads();
}

namespace pg8 {
constexpr int BM = 256, BK = 64, HALF = 128, HTB = HALF * BK * 2, STAGE_BYTES = 8 * HTB, NXCD = 8, WGM = 8;
__host__ __device__ __forceinline__ int lds_byte(int r, int c) { const int st = (r >> 4) * 2 + (c >> 5), rr = r & 15, cc = c & 31, ob = rr * 64 + cc * 2; return st * 1024 + (ob ^ (((ob >> 9) & 1) << 5)); }
__host__ __device__ __forceinline__ void stage_rc(int b, int& R, int& C) { const int st = b / 1024, sb = b % 1024, swz = sb ^ (((sb >> 9) & 1) << 5); R = (st >> 1) * 16 + swz / 64; C = (st & 1) * 32 + (swz % 64) / 2; }
__host__ __device__ __forceinline__ int perm32(int rho) { const int n = rho >> 4, i = rho & 15; return 8 * (i >> 2) + 4 * n + (i & 3); }

struct Unit { const char* A; const char* B; int nt; int pm, pn, aux; };

__device__ __forceinline__ void tile_order(int L, int nM, int nN, int& pm, int& pn) {
    const int nwg = nM * nN; int wgid = L;
    { const int q = nwg / NXCD, r = nwg % NXCD, xcd = wgid % NXCD, off = wgid / NXCD; wgid = (xcd < r ? xcd * (q + 1) : r * (q + 1) + (xcd - r) * q) + off; }
    const int nig = WGM * nN, gid = wgid / nig, fm = gid * WGM, gsz = (nM - fm) < WGM ? (nM - fm) : WGM;
    pm = fm + ((wgid % nig) % gsz); pn = (wgid % nig) / gsz;
}
__device__ __forceinline__ unsigned cvt_pk_bf16(float lo, float hi) { unsigned r; asm volatile("v_cvt_pk_bf16_f32 %0, %1, %2" : "=v"(r) : "v"(lo), "v"(hi)); return r; }
__device__ __forceinline__ u32x4 pack8(const f32x4 v0, const f32x4 v1) { u32x4 w; w.x = cvt_pk_bf16(v0[0], v0[1]); w.y = cvt_pk_bf16(v0[2], v0[3]); w.z = cvt_pk_bf16(v1[0], v1[1]); w.w = cvt_pk_bf16(v1[2], v1[3]); return w; }

template <unsigned lda, unsigned ldb, class Epi, class Sched>
__device__ __forceinline__ void gemm_phase(const int tid, LAS unsigned char* lds, const Sched& S, const Epi& E) {
    const int wid = __builtin_amdgcn_readfirstlane(tid >> 6), lane = tid & 63, wr = wid >> 2, wc = wid & 3, fr = lane & 15, fq = lane >> 4;
    unsigned voffA[2], voffB[2];
#pragma unroll
    for (int i = 0; i < 2; ++i) { int R, C; stage_rc(tid * 16 + i * 8192, R, C); const int Rb = Epi::PERM ? ((R & ~31) + perm32(R & 31)) : R;
        voffA[i] = (unsigned)R * lda + (unsigned)C * 2u; voffB[i] = (unsigned)Rb * ldb + (unsigned)C * 2u; }
    const size_t kstep = (size_t)(BK * 2);
    const size_t hstepA = (size_t)HALF * lda, hstepB = (size_t)HALF * ldb;
    const unsigned ldsw = (unsigned)wid * 1024u;
    const int aoff = lds_byte(wr * 64 + fr, fq * 8), boff = lds_byte(wc * 32 + fr, fq * 8);
#define PG8_SA(b, h) (((b) * 2 + (h)) * HTB)
#define PG8_SB(b, h) ((4 + (b) * 2 + (h)) * HTB)
#define PG8_STAGE(bufoff, gbase, voff) do { const char* _gb = (const char*)(gbase); asm volatile("" : "+s"(_gb)); _Pragma("unroll") for (int _i = 0; _i < 2; ++_i) \
        __builtin_amdgcn_global_load_lds((const unsigned*)(_gb + (voff)[_i]), (LAS unsigned*)(lds + (bufoff) + ldsw + _i * 8192), 16, 0, 0); } while (0)
#define PG8_LDA(dst, b, h) do { _Pragma("unroll") for (int m = 0; m < 4; ++m) _Pragma("unroll") for (int k = 0; k < 2; ++k) dst[m][k] = *(const LAS bf16x8*)(lds + PG8_SA(b, h) + aoff + m * 2048 + k * 1024); } while (0)
#define PG8_LDB(dst, b, h) do { _Pragma("unroll") for (int n = 0; n < 2; ++n) _Pragma("unroll") for (int k = 0; k < 2; ++k) dst[n][k] = *(const LAS bf16x8*)(lds + PG8_SB(b, h) + boff + n * 2048 + k * 1024); } while (0)
#define PG8_MMA(ai, bj, At, Bt) do { __builtin_amdgcn_s_setprio(1); _Pragma("unroll") for (int m = 0; m < 4; ++m) _Pragma("unroll") for (int n = 0; n < 2; ++n) _Pragma("unroll") for (int k = 0; k < 2; ++k) \
        acc[ai][bj][m][n] = __builtin_amdgcn_mfma_f32_16x16x32_bf16(Bt[n][k], At[m][k], acc[ai][bj][m][n], 0, 0, 0); __builtin_amdgcn_s_setprio(0); } while (0)
#define PG8_WAIT_V(n) asm volatile("s_waitcnt vmcnt(" #n ")" ::: "memory")
#define PG8_WAIT_L(n) asm volatile("s_waitcnt lgkmcnt(" #n ")" ::: "memory")
#define PG8_BAR __builtin_amdgcn_s_barrier()
#define PG8_SCHED __builtin_amdgcn_sched_barrier(0)
    Unit cur, nxt; int ui = 0;
    if (!S.next(0, cur)) return;
    f32x4 acc[2][2][4][2];
#pragma unroll
    for (int a = 0; a < 2; ++a)
#pragma unroll
        for (int b = 0; b < 2; ++b)
#pragma unroll
            for (int m = 0; m < 4; ++m)
#pragma unroll
                for (int n = 0; n < 2; ++n) acc[a][b][m][n] = (f32x4){0.f, 0.f, 0.f, 0.f};
    bf16x8 At[4][2], B0[2][2], B1[2][2];
    const char* cA = cur.A; const char* cB = cur.B;
    PG8_STAGE(PG8_SB(0, 0), cB, voffB); PG8_STAGE(PG8_SB(0, 1), cB + hstepB, voffB); PG8_STAGE(PG8_SA(0, 0), cA, voffA); PG8_STAGE(PG8_SA(0, 1), cA + hstepA, voffA);
    if (wr == 1) PG8_BAR;
    PG8_WAIT_V(2); PG8_BAR;
    PG8_STAGE(PG8_SB(1, 0), cB + kstep, voffB); PG8_STAGE(PG8_SA(1, 0), cA + kstep, voffA); PG8_STAGE(PG8_SB(1, 1), cB + hstepB + kstep, voffB);
    PG8_WAIT_V(6); PG8_BAR;
    for (;;) {
        const bool has_next = S.next(ui + 1, nxt);
        const char* nA = has_next ? nxt.A : cA; const char* nB = has_next ? nxt.B : cB;
        const int nt = cur.nt;
        for (int t = 0; t < nt; t += 2) {
            const bool last = (t == nt - 2);
            const char* a1 = cA + (size_t)(t + 1) * kstep;
            const char* a2 = last ? nA : cA + (size_t)(t + 2) * kstep; const char* b2 = last ? nB : cB + (size_t)(t + 2) * kstep;
            const char* a3 = a2 + kstep; const char* b3 = b2 + kstep;
            PG8_LDB(B0, 0, 0); PG8_LDB(B1, 0, 1); PG8_SCHED; PG8_LDA(At, 0, 0); PG8_STAGE(PG8_SA(1, 1), a1 + hstepA, voffA);
            PG8_WAIT_V(8); PG8_WAIT_L(0); PG8_BAR; PG8_MMA(0, 0, At, B0); PG8_MMA(0, 1, At, B1); PG8_BAR; PG8_SCHED;
            PG8_LDA(At, 0, 1); PG8_STAGE(PG8_SB(0, 0), b2, voffB); PG8_STAGE(PG8_SB(0, 1), b2 + hstepB, voffB); PG8_STAGE(PG8_SA(0, 0), a2, voffA);
            PG8_WAIT_V(8); PG8_WAIT_L(0); PG8_BAR; PG8_MMA(1, 0, At, B0); PG8_MMA(1, 1, At, B1); PG8_BAR; PG8_SCHED;
            PG8_LDB(B0, 1, 0); PG8_LDB(B1, 1, 1); PG8_SCHED; PG8_LDA(At, 1, 0); PG8_STAGE(PG8_SA(0, 1), a2 + hstepA, voffA);
            PG8_WAIT_V(8); PG8_WAIT_L(0); PG8_BAR; PG8_MMA(0, 0, At, B0); PG8_MMA(0, 1, At, B1); PG8_BAR; PG8_SCHED;
            PG8_LDA(At, 1, 1); PG8_STAGE(PG8_SB(1, 0), b3, voffB); PG8_STAGE(PG8_SB(1, 1), b3 + hstepB, voffB); PG8_STAGE(PG8_SA(1, 0), a3, voffA);
            PG8_WAIT_V(8); PG8_WAIT_L(0); PG8_BAR; PG8_MMA(1, 0, At, B0); PG8_MMA(1, 1, At, B1); PG8_BAR; PG8_SCHED;
            if constexpr (Epi::HAS_MID) { if (t + 2 == 8 || t + 2 == 16) { E.mid(acc, cur, t + 2, wr, wc, fr, fq); PG8_SCHED; } }
        }
        if (wr == 0) PG8_BAR;
        E(acc, cur, wr, wc, fr, fq);
        if (!has_next) break;
#pragma unroll
        for (int a = 0; a < 2; ++a)
#pragma unroll
            for (int b = 0; b < 2; ++b)
#pragma unroll
                for (int m = 0; m < 4; ++m)
#pragma unroll
                    for (int n = 0; n < 2; ++n) acc[a][b][m][n] = (f32x4){0.f, 0.f, 0.f, 0.f};
        cur = nxt; cA = nA; cB = nB; ++ui;
        if (wr == 1) PG8_BAR;
    }
    PG8_WAIT_V(0);
    PG8_BAR;
#undef PG8_SA
#undef PG8_SB
#undef PG8_STAGE
#undef PG8_LDA
#undef PG8_LDB
#undef PG8_MMA
#undef PG8_WAIT_V
#undef PG8_WAIT_L
#undef PG8_BAR
#undef PG8_SCHED
}
}

struct Frame {
    LAS unsigned char* lds;
    volatile LAS unsigned* MISC;
    unsigned* ctl;
    int tid, lane, wave, G, bid;
    const float* const __attribute__((address_space(4)))* in;
    float* out; unsigned char* ws;
};
enum { IN_X = 0, IN_NORM1, IN_WIN, IN_BGATE, IN_LRE, IN_LIM, IN_BRE, IN_BIM, IN_CRE, IN_CIM, IN_S5D, IN_LOGDT, IN_GLU1, IN_GLU2, IN_QG, IN_KG, IN_SINK,
       IN_CONVW, IN_CONVB, IN_DTB, IN_ALOG, IN_SSDD, IN_SSDG, IN_PS5, IN_PATTN, IN_PSSD, IN_WOUT, IN_NORM2, IN_WRG, IN_BRG, IN_WRE, IN_BRE_, IN_EG, IN_EU, IN_ED, N_INPUTS };

#define LDS_WAIT() asm volatile("s_waitcnt lgkmcnt(0)" ::: "memory")
#define VM_WAIT() asm volatile("s_waitcnt vmcnt(0)" ::: "memory")

using pg8::Unit; using pg8::pack8;
struct EpiProj {
    static constexpr bool PERM = true, HAS_MID = false;
    unsigned char* ws; const float* bgate;
    __device__ __forceinline__ void operator()(const f32x4 (&acc)[2][2][4][2], const Unit& u, int wr, int wc, int fr, int fq) const {
        bf16_t* P = (bf16_t*)(ws + WS_P); bf16_t* UH = (bf16_t*)(ws + WS_UH); float* DT = (float*)(ws + WS_DT);
        const int row0 = u.pm * 256 + wr * 64 + fr;
        if (u.pn < 2) {
#pragma unroll
            for (int ai = 0; ai < 2; ++ai)
#pragma unroll
                for (int m = 0; m < 4; ++m) { const int row = row0 + ai * 128 + m * 16, r = row >> 5, s = row & 31;
#pragma unroll
                    for (int bj = 0; bj < 2; ++bj) { const int col = u.pn * 256 + bj * 128 + wc * 32 + 8 * fq, g = col >> 4, c0 = col & 15;
                        *(u32x4*)(UH + ((size_t)(g * S5_ROWS + r) * S5_K + 128 + s * 16 + c0)) = pack8(acc[ai][bj][m][0], acc[ai][bj][m][1]); } }
        } else {
            const int colb = u.pn * 256 + wc * 32 + 8 * fq;
            f32x4 bv[2][2];
#pragma unroll
            for (int bj = 0; bj < 2; ++bj)
#pragma unroll
                for (int n = 0; n < 2; ++n) bv[bj][n] = (u.pn >= 15) ? *(const f32x4*)(bgate + (colb - C_G) + bj * 128 + 4 * n) : (f32x4){0.f, 0.f, 0.f, 0.f};
#pragma unroll
            for (int ai = 0; ai < 2; ++ai)
#pragma unroll
                for (int m = 0; m < 4; ++m) { const int row = row0 + ai * 128 + m * 16;
#pragma unroll
                    for (int bj = 0; bj < 2; ++bj) { f32x4 v0 = acc[ai][bj][m][0] + bv[bj][0], v1 = acc[ai][bj][m][1] + bv[bj][1];
                        if (u.pn >= 15) {
#pragma unroll
                            for (int j = 0; j < 4; ++j) { v0[j] = fmaxf(sigmoidf_(v0[j]), 1e-30f); v1[j] = fmaxf(sigmoidf_(v1[j]), 1e-30f); } }
                        *(u32x4*)(P + (size_t)row * NINP + colb + bj * 128) = pack8(v0, v1); }
                    if (u.pn == 14 && wc == 0 && fq < 2) { float* d = DT + (size_t)row * 16 + 8 * fq; *(f32x4*)d = acc[ai][0][m][0]; *(f32x4*)(d + 4) = acc[ai][0][m][1]; } }
        }
    }
};
struct EpiHloc {
    static constexpr bool PERM = false, HAS_MID = false;
    float* H;
    __device__ __forceinline__ void operator()(const f32x4 (&acc)[2][2][4][2], const Unit& u, int wr, int wc, int fr, int fq) const {
#pragma unroll
        for (int ai = 0; ai < 2; ++ai)
#pragma unroll
            for (int m = 0; m < 4; ++m) { const int r = u.pm * 256 + ai * 128 + wr * 64 + m * 16 + fr; float* rowp = H + ((size_t)(u.aux * S5_ROWS + r) * 128) + wc * 32 + 4 * fq;
#pragma unroll
                for (int n = 0; n < 2; ++n) *(f32x4*)(rowp + 16 * n) = acc[ai][0][m][n]; }
    }
};
struct EpiS5Y {
    static constexpr bool PERM = true, HAS_MID = false;
    bf16_t* Y;
    __device__ __forceinline__ void operator()(const f32x4 (&acc)[2][2][4][2], const Unit& u, int wr, int wc, int fr, int fq) const {
#pragma unroll
        for (int ai = 0; ai < 2; ++ai)
#pragma unroll
            for (int m = 0; m < 4; ++m) { const int r = u.pm * 256 + ai * 128 + wr * 64 + m * 16 + fr;
#pragma unroll
                for (int bj = 0; bj < 2; ++bj) { const int n0 = u.pn * 256 + bj * 128 + wc * 32 + 8 * fq, t = n0 >> 4, c0 = n0 & 15;
                    f32x4 v0 = acc[ai][bj][m][0], v1 = acc[ai][bj][m][1];
#pragma unroll
                    for (int j = 0; j < 4; ++j) { v0[j] = gelu_tanh_(v0[j]); v1[j] = gelu_tanh_(v1[j]); }
                    *(u32x4*)(Y + ((size_t)(r * S5_TC + t) * 512 + u.aux * 16 + c0)) = pack8(v0, v1); } }
    }
};
struct EpiGlu {
    static constexpr bool PERM = true, HAS_MID = false;
    bf16_t* Y;
    __device__ __forceinline__ void operator()(const f32x4 (&acc)[2][2][4][2], const Unit& u, int wr, int wc, int fr, int fq) const {
#pragma unroll
        for (int ai = 0; ai < 2; ++ai)
#pragma unroll
            for (int m = 0; m < 4; ++m) { const int row = u.pm * 256 + ai * 128 + wr * 64 + m * 16 + fr;
                f32x4 v0 = acc[ai][0][m][0], v1 = acc[ai][0][m][1]; const f32x4 g0 = acc[ai][1][m][0], g1 = acc[ai][1][m][1];
#pragma unroll
                for (int j = 0; j < 4; ++j) { v0[j] *= sigmoidf_(g0[j]); v1[j] *= sigmoidf_(g1[j]); }
                *(u32x4*)(Y + (size_t)row * 2048 + u.pn * 128 + wc * 32 + 8 * fq) = pack8(v0, v1); }
    }
};
struct EpiSwiGlu {
    static constexpr bool PERM = true, HAS_MID = false;
    bf16_t* Y; const float* RSG;
    __device__ __forceinline__ void operator()(const f32x4 (&acc)[2][2][4][2], const Unit& u, int wr, int wc, int fr, int fq) const {
#pragma unroll
        for (int ai = 0; ai < 2; ++ai)
#pragma unroll
            for (int m = 0; m < 4; ++m) { const int row = u.pm * 256 + ai * 128 + wr * 64 + m * 16 + fr;
                f32x4 v0 = acc[ai][0][m][0], v1 = acc[ai][0][m][1]; const f32x4 g0 = acc[ai][1][m][0], g1 = acc[ai][1][m][1]; const float rr = 1.f;
#pragma unroll
                for (int j = 0; j < 4; ++j) { v0[j] = siluf_(v0[j] * rr) * (g0[j] * rr); v1[j] = siluf_(v1[j] * rr) * (g1[j] * rr); }
                *(u32x4*)(Y + (size_t)row * 512 + u.pn * 128 + wc * 32 + 8 * fq) = pack8(v0, v1); }
    }
};
struct EpiPlainBf16 {
    static constexpr bool PERM = true, HAS_MID = false;
    bf16_t* O;
    __device__ __forceinline__ void operator()(const f32x4 (&acc)[2][2][4][2], const Unit& u, int wr, int wc, int fr, int fq) const {
#pragma unroll
        for (int ai = 0; ai < 2; ++ai)
#pragma unroll
            for (int m = 0; m < 4; ++m) { const int row = u.pm * 256 + ai * 128 + wr * 64 + m * 16 + fr;
#pragma unroll
                for (int bj = 0; bj < 2; ++bj) *(u32x4*)(O + (size_t)row * 1024 + u.pn * 256 + bj * 128 + wc * 32 + 8 * fq) = pack8(acc[ai][bj][m][0], acc[ai][bj][m][1]); }
    }
};
struct EpiMerged {
    static constexpr bool PERM = true, HAS_MID = true;
    unsigned char* ws;
    __device__ __forceinline__ static float lclamp(float l) { return fminf(fmaxf(l, -30.f), 30.f); }
    __device__ __forceinline__ void mid(f32x4 (&acc)[2][2][4][2], const Unit& u, int kt, int wr, int wc, int fr, int fq) const {
        const int br = (kt == 8) ? 0 : 1; const bf16_t* P = (const bf16_t*)(ws + WS_P);
#pragma unroll
        for (int ai = 0; ai < 2; ++ai)
#pragma unroll
            for (int m = 0; m < 4; ++m) { const int row = u.pm * 256 + ai * 128 + wr * 64 + m * 16 + fr;
#pragma unroll
                for (int bj = 0; bj < 2; ++bj) { const bf16_t* gp = P + (size_t)row * NINP + C_G + br * 1024 + u.pn * 256 + bj * 128 + wc * 32 + 8 * fq;
                    const u32x4 la = *(const u32x4*)gp, lb = *(const u32x4*)(gp + 1024);
#pragma unroll
                    for (int j = 0; j < 4; ++j) { const unsigned wa = la[j], wb = lb[j];
                        const float r0 = bflo(wa) * frcp(bflo(wb)), r1 = bfhi(wa) * frcp(bfhi(wb));
                        if (j < 2) { acc[ai][bj][m][0][2 * j] *= r0; acc[ai][bj][m][0][2 * j + 1] *= r1; } else { acc[ai][bj][m][1][2 * j - 4] *= r0; acc[ai][bj][m][1][2 * j - 3] *= r1; } } }
                if (m == 3) asm volatile("" ::: "memory"); }
    }
    __device__ __forceinline__ void operator()(const f32x4 (&acc)[2][2][4][2], const Unit& u, int wr, int wc, int fr, int fq) const {
        const bf16_t* P = (const bf16_t*)(ws + WS_P); bf16_t* O = (bf16_t*)(ws + WS_XN);
#pragma unroll
        for (int ai = 0; ai < 2; ++ai)
#pragma unroll
            for (int m = 0; m < 4; ++m) { const int row = u.pm * 256 + ai * 128 + wr * 64 + m * 16 + fr;
#pragma unroll
                for (int bj = 0; bj < 2; ++bj) { const int col = u.pn * 256 + bj * 128 + wc * 32 + 8 * fq;
                    const u32x4 lc = *(const u32x4*)(P + (size_t)row * NINP + C_G + 2048 + col);
                    f32x4 v0 = acc[ai][bj][m][0], v1 = acc[ai][bj][m][1];
                    v0[0] *= bflo(lc[0]); v0[1] *= bfhi(lc[0]); v0[2] *= bflo(lc[1]); v0[3] *= bfhi(lc[1]);
                    v1[0] *= bflo(lc[2]); v1[1] *= bfhi(lc[2]); v1[2] *= bflo(lc[3]); v1[3] *= bfhi(lc[3]);
                    *(u32x4*)(O + (size_t)row * 1024 + col) = pack8(v0, v1); }
                if (m == 3) asm volatile("" ::: "memory"); }
    }
};
struct EpiResid {
    static constexpr bool PERM = false, HAS_MID = false;
    const float* resid; float* out;
    __device__ __forceinline__ void operator()(const f32x4 (&acc)[2][2][4][2], const Unit& u, int wr, int wc, int fr, int fq) const {
#pragma unroll
        for (int ai = 0; ai < 2; ++ai)
#pragma unroll
            for (int m = 0; m < 4; ++m) { const size_t off = (size_t)(u.pm * 256 + ai * 128 + wr * 64 + m * 16 + fr) * 1024 + u.pn * 256 + wc * 32 + 4 * fq;
#pragma unroll
                for (int bj = 0; bj < 2; ++bj)
#pragma unroll
                    for (int n = 0; n < 2; ++n) { const f32x4 rv = *(const f32x4*)(resid + off + bj * 128 + n * 16); *(f32x4*)(out + off + bj * 128 + n * 16) = rv + acc[ai][bj][m][n]; } }
    }
};

template <unsigned lda, unsigned ldb, int nM, int nN, int NT>
struct SchedDense {
    const char* A; const char* B; int G, c;
    __device__ __forceinline__ bool next(int i, Unit& u) const {
        const int L = i * G + c; if (L >= nM * nN) return false;
        int pm, pn; pg8::tile_order(L, nM, nN, pm, pn);
        u.A = A + (size_t)pm * 256 * lda; u.B = B + (size_t)pn * 256 * ldb; u.nt = NT; u.pm = pm; u.pn = pn; u.aux = 0; return true;
    }
};
struct SchedS5P1 {
    const char* UH; const char* EG; int G, c;
    __device__ __forceinline__ bool next(int i, Unit& u) const {
        const int L = i * G + c; if (L >= 64) return false;
        const int g = L >> 1, pm = L & 1;
        u.A = UH + ((size_t)(g * S5_ROWS + pm * 256) * S5_K + 128) * 2; u.B = EG + (size_t)g * 256 * 512 * 2; u.nt = 8; u.pm = pm; u.pn = 0; u.aux = g; return true;
    }
};
struct SchedS5Main {
    const char* UH; const char* MG; int G, c;
    __device__ __forceinline__ bool next(int i, Unit& u) const {
        const int L = i * G + c; if (L >= 128) return false;
        const int g = L >> 2, pm = (L >> 1) & 1, pn = L & 1;
        u.A = UH + (size_t)(g * S5_ROWS + pm * 256) * S5_K * 2; u.B = MG + (size_t)(g * S5_N + pn * 256) * S5_K * 2; u.nt = 2 + 4 * (pn + 1); u.pm = pm; u.pn = pn; u.aux = g; return true;
    }
};
template <unsigned lda, size_t bexp  , size_t btile  , int NT>
struct SchedMoe {
    const char* A; const char* B; int ntiles, G, c; const volatile LAS int* tile_e;
    __device__ __forceinline__ bool next(int i, Unit& u) const {
        const int L = i * G + c; if (L >= ntiles * 4) return false;
        int pm, pn; pg8::tile_order(L, ntiles, 4, pm, pn);
        const int e = __builtin_amdgcn_readfirstlane(tile_e[pm]);
        u.A = A + (size_t)pm * 256 * lda; u.B = B + (size_t)e * bexp + (size_t)pn * btile; u.nt = NT; u.pm = pm; u.pn = pn; u.aux = e; return true;
    }
};

__device__ __forceinline__ void transpose_item(const float* W, int ldw, int ncols, bf16_t* WT, int ldt, int kofs, int mode, int p0, int p1, LAS float* scr, int k0, int n0, int lane) {
    float wv[32];
#pragma unroll
    for (int i = 0; i < 32; ++i) { const int kk = 2 * i + (lane >> 5), n = n0 + (lane & 31); wv[i] = (n < ncols) ? W[(size_t)(k0 + kk) * ldw + n] : 0.f; }
#pragma unroll
    for (int i = 0; i < 32; ++i) { const int kk = 2 * i + (lane >> 5); scr[kk * 33 + (lane & 31)] = wv[i]; }
    LDS_WAIT(); asm volatile("" ::: "memory");
    const int c = lane & 7;
#pragma unroll
    for (int j = 0; j < 4; ++j) { const int nn = (lane >> 3) + 8 * j, n = n0 + nn; const LAS float* s = scr + (8 * c) * 33 + nn;
        u32x4 o; o.x = pk2(s[0 * 33], s[1 * 33]); o.y = pk2(s[2 * 33], s[3 * 33]); o.z = pk2(s[4 * 33], s[5 * 33]); o.w = pk2(s[6 * 33], s[7 * 33]);
        const int drow = (mode == 0) ? n + (n >= p0 ? p1 : 0) : ((n >> 7) * 256 + (n & 127) + 128 * p0);
        if (n < ncols) *(u32x4*)(WT + (size_t)drow * ldt + kofs + k0 + 8 * c) = o; }
    LDS_WAIT(); asm volatile("" ::: "memory");
}
__device__ __forceinline__ void convert_weights(Frame& F, int layer) {
    LAS float* scr = (LAS float*)(F.lds + F.wave * 16384);
    const int gw = F.bid * NWAVES + F.wave, NGW = F.G * NWAVES;
    bf16_t* WIN = (bf16_t*)(F.ws + WS_WIN); bf16_t* WGLU = (bf16_t*)(F.ws + WS_WGLU); bf16_t* PCAT = (bf16_t*)(F.ws + WS_PCAT); bf16_t* WOUT = (bf16_t*)(F.ws + WS_WOUT);
    bf16_t* EGU = (bf16_t*)(F.ws + WS_EGU); bf16_t* EDN = (bf16_t*)(F.ws + WS_EDN);
    constexpr int I_WIN = 16 * 209, I_GLU = 8 * 16, I_P5 = 8 * 32, I_PS = 16 * 32, I_WO = 16 * 32, I_EG = 32 * 256, I_ED = 32 * 256;
    constexpr int NITEMS = I_WIN + 2 * I_GLU + 2 * I_P5 + I_PS + I_WO + 2 * I_EG + I_ED;
    for (int it = gw; it < NITEMS; it += NGW) {
        int r = it;
        if (r < I_WIN) { transpose_item(F.in[IN_WIN] + (size_t)layer * DM * NIN, NIN, NIN, WIN, DM, 0, 0, 3600, 240, scr, 64 * (r / 209), 32 * (r % 209), F.lane); continue; } r -= I_WIN;
        if (r < I_GLU) { transpose_item(F.in[IN_GLU1] + (size_t)layer * 512 * 512, 512, 512, WGLU, 512, 0, 1, 0, 0, scr, 64 * (r / 16), 32 * (r % 16), F.lane); continue; } r -= I_GLU;
        if (r < I_GLU) { transpose_item(F.in[IN_GLU2] + (size_t)layer * 512 * 512, 512, 512, WGLU, 512, 0, 1, 1, 0, scr, 64 * (r / 16), 32 * (r % 16), F.lane); continue; } r -= I_GLU;
        if (r < I_P5) { transpose_item(F.in[IN_PS5] + (size_t)layer * 512 * 1024, 1024, 1024, PCAT, 2048, 0, 0, 1 << 30, 0, scr, 64 * (r / 32), 32 * (r % 32), F.lane); continue; } r -= I_P5;
        if (r < I_P5) { transpose_item(F.in[IN_PATTN] + (size_t)layer * 512 * 1024, 1024, 1024, PCAT, 2048, 512, 0, 1 << 30, 0, scr, 64 * (r / 32), 32 * (r % 32), F.lane); continue; } r -= I_P5;
        if (r < I_PS) { transpose_item(F.in[IN_PSSD] + (size_t)layer * 1024 * 1024, 1024, 1024, PCAT, 2048, 1024, 0, 1 << 30, 0, scr, 64 * (r / 32), 32 * (r % 32), F.lane); continue; } r -= I_PS;
        if (r < I_WO) { transpose_item(F.in[IN_WOUT] + (size_t)layer * 1024 * 1024, 1024, 1024, WOUT, 1024, 0, 0, 1 << 30, 0, scr, 64 * (r / 32), 32 * (r % 32), F.lane); continue; } r -= I_WO;
        if (r < I_EG) { const int e = r >> 8, q = r & 255; transpose_item(F.in[IN_EG] + ((size_t)layer * 32 + e) * 1024 * 512, 512, 512, EGU + (size_t)e * 1024 * 1024, 1024, 0, 1, 0, 0, scr, 64 * (q / 16), 32 * (q % 16), F.lane); continue; } r -= I_EG;
        if (r < I_EG) { const int e = r >> 8, q = r & 255; transpose_item(F.in[IN_EU] + ((size_t)layer * 32 + e) * 1024 * 512, 512, 512, EGU + (size_t)e * 1024 * 1024, 1024, 0, 1, 1, 0, scr, 64 * (q / 16), 32 * (q % 16), F.lane); continue; } r -= I_EG;
        { const int e = r >> 8, q = r & 255; transpose_item(F.in[IN_ED] + ((size_t)layer * 32 + e) * 512 * 1024, 1024, 1024, EDN + (size_t)e * 1024 * 512, 512, 0, 0, 1 << 30, 0, scr, 64 * (q / 32), 32 * (q % 32), F.lane); }
    }
}
__device__ __forceinline__ void sincos_fast(float x, float& s, float& c) {
    const float k = rintf(x * 0.15915494309189535f);
    float r = fmaf(-k, 6.2831854820251465f, x); r = fmaf(-k, -1.7484555e-07f, r);
    s = __sinf(r); c = __cosf(r);
}
__device__ __forceinline__ void sincos_red(float x, float& s, float& c) {
    const float k = rintf(x * 0.15915494309189535f);
    float r = fmaf(-k, 6.2831854820251465f, x); r = fmaf(-k, -1.7484555e-07f, r);
    s = sinf(r); c = cosf(r);
}
__device__ __forceinline__ void s5_build(Frame& F, int layer) {
    LAS float* pw = (LAS float*)F.lds;
    LAS float* Bb = pw + 33 * 64 * 2;
    LAS float* Cc = Bb + 64 * 16 * 2;
    LAS float* Kd = Cc + 16 * 64 * 2;
    bf16_t* MG = (bf16_t*)(F.ws + WS_MG); bf16_t* EG = (bf16_t*)(F.ws + WS_EG);
    for (int w = F.bid; w < 256; w += F.G) {
        const int g = w >> 3, part = w & 7, gi = layer * 32 + g;
        __syncthreads();
        const float dt = __expf(F.in[IN_LOGDT][gi]);
        for (int i = F.tid; i < 33 * 64; i += NTHR) { const int d = i >> 6, p = i & 63; const float lr = F.in[IN_LRE][gi * 64 + p], li = F.in[IN_LIM][gi * 64 + p];
            float s, c; sincos_red((float)d * li * dt, s, c); const float mg = __expf((float)d * lr * dt); pw[2 * i] = mg * c; pw[2 * i + 1] = mg * s; }
        for (int i = F.tid; i < 64 * 16; i += NTHR) { const int p = i >> 4; const float lr = F.in[IN_LRE][gi * 64 + p], li = F.in[IN_LIM][gi * 64 + p];
            float s, c; sincos_red(li * dt, s, c); const float mg = __expf(lr * dt), are = mg * c, aim = mg * s, nr = are - 1.f, den = lr * lr + li * li;
            const float fre = (nr * lr + aim * li) / den, fim = (aim * lr - nr * li) / den;
            const float br = F.in[IN_BRE][(size_t)gi * 1024 + i], bi = F.in[IN_BIM][(size_t)gi * 1024 + i];
            Bb[2 * i] = fre * br - fim * bi; Bb[2 * i + 1] = fre * bi + fim * br; }
        for (int i = F.tid; i < 16 * 64; i += NTHR) { Cc[2 * i] = F.in[IN_CRE][(size_t)gi * 1024 + i]; Cc[2 * i + 1] = F.in[IN_CIM][(size_t)gi * 1024 + i]; }
        __syncthreads();
        { const int d = F.tid >> 4, c = F.tid & 15; float acc[16];
#pragma unroll
          for (int j = 0; j < 16; ++j) acc[j] = 0.f;
          for (int p = 0; p < 64; ++p) { const float cr = Cc[2 * (c * 64 + p)], ci = Cc[2 * (c * 64 + p) + 1], pr = pw[2 * (d * 64 + p)], pi = pw[2 * (d * 64 + p) + 1];
              const float xr = cr * pr - ci * pi, xi = cr * pi + ci * pr;
#pragma unroll
              for (int q = 0; q < 8; ++q) { const f32x4 bb = *(const LAS f32x4*)(Bb + 2 * (p * 16) + 4 * q); acc[2 * q] += xr * bb.x - xi * bb.y; acc[2 * q + 1] += xr * bb.z - xi * bb.w; } }
#pragma unroll
          for (int j = 0; j < 16; ++j) Kd[(d * 16 + c) * 16 + j] = acc[j]; }
        __syncthreads();
        for (int v = F.tid; v < 64 * 80; v += NTHR) { const int n = part * 64 + v / 80, k0 = (v % 80) * 8, t = n >> 4, c = n & 15; float o[8];
            if (k0 < 128) { const int im = k0 >= 64, p0 = k0 & 63;
#pragma unroll
                for (int j = 0; j < 8; ++j) { const int p = p0 + j; const float cr = Cc[2 * (c * 64 + p)], ci = Cc[2 * (c * 64 + p) + 1], pr = pw[2 * ((t + 1) * 64 + p)], pi = pw[2 * ((t + 1) * 64 + p) + 1];
                    o[j] = im ? -(cr * pi + ci * pr) : (cr * pr - ci * pi); }
            } else { const int s = (k0 - 128) >> 4, c0 = (k0 - 128) & 15;
#pragma unroll
                for (int j = 0; j < 8; ++j) { float x = 0.f; if (s <= t) { x = Kd[(t - s) * 256 + c * 16 + c0 + j]; if (s == t && c == c0 + j) x += F.in[IN_S5D][layer * 512 + g * 16 + c]; } o[j] = x; } }
            u32x4 q; q.x = pk2(o[0], o[1]); q.y = pk2(o[2], o[3]); q.z = pk2(o[4], o[5]); q.w = pk2(o[6], o[7]);
            *(u32x4*)(MG + ((size_t)(g * S5_N + n) * S5_K + k0)) = q; }
        for (int v = F.tid; v < 16 * 64; v += NTHR) { const int jr = part * 16 + v / 64, k0 = (v % 64) * 8, im = jr >= 64, p = jr & 63, s = k0 >> 4, c0 = k0 & 15; float o[8];
            const float pr = pw[2 * ((S5_TC - 1 - s) * 64 + p)], pi = pw[2 * ((S5_TC - 1 - s) * 64 + p) + 1];
#pragma unroll
            for (int j = 0; j < 8; ++j) { const float br = Bb[2 * (p * 16 + c0 + j)], bi = Bb[2 * (p * 16 + c0 + j) + 1]; o[j] = im ? (pr * bi + pi * br) : (pr * br - pi * bi); }
            u32x4 q; q.x = pk2(o[0], o[1]); q.y = pk2(o[2], o[3]); q.z = pk2(o[4], o[5]); q.w = pk2(o[6], o[7]);
            *(u32x4*)(EG + ((size_t)(g * 256 + jr) * 512 + k0)) = q; }
    }
    __syncthreads();
}
__device__ __forceinline__ void rms_row_to_bf16(const float* xrow, const float* gain, bf16_t* orow, int lane) {
    const f32x4* xr = (const f32x4*)xrow + lane; const f32x4* gr = (const f32x4*)gain + lane;
    f32x4 v[4]; float s = 0.f;
#pragma unroll
    for (int j = 0; j < 4; ++j) { v[j] = xr[64 * j]; s += (v[j].x * v[j].x + v[j].y * v[j].y) + (v[j].z * v[j].z + v[j].w * v[j].w); }
    const float rstd = __builtin_amdgcn_rsqf(wave_sum(s) * (1.f / DM) + NORM_EPS);
    unsigned long long* o8 = (unsigned long long*)orow + lane;
#pragma unroll
    for (int j = 0; j < 4; ++j) { const f32x4 gv = gr[64 * j]; o8[64 * j] = (unsigned long long)pk2(v[j].x * rstd * gv.x, v[j].y * rstd * gv.y) | ((unsigned long long)pk2(v[j].z * rstd * gv.z, v[j].w * rstd * gv.w) << 32); }
}
__device__ __forceinline__ void rmsnorm_rows(Frame& F, const float* x, const float* gain, bf16_t* o) {
    const int gw = F.bid * NWAVES + F.wave, NGW = F.G * NWAVES;
    for (int m = gw; m < T; m += NGW) rms_row_to_bf16(x + (size_t)m * DM, gain, o + (size_t)m * DM, F.lane);
}

__device__ __forceinline__ void s5_scan(Frame& F, int layer) {
    const float* HL = (const float*)(F.ws + WS_HLOC); bf16_t* UH = (bf16_t*)(F.ws + WS_UH);
    for (int i = (F.G - 1 - F.bid) * NTHR + F.tid; i < BATCH * 32 * 64; i += F.G * NTHR) {
        const int p = i & 63, g = (i >> 6) & 31, b = i >> 11, gi = layer * 32 + g;
        const float dt = __expf(F.in[IN_LOGDT][gi]), lr = F.in[IN_LRE][gi * 64 + p], li = F.in[IN_LIM][gi * 64 + p];
        float s, c; sincos_red((float)S5_TC * li * dt, s, c); const float mg = __expf((float)S5_TC * lr * dt), ar = mg * c, ai = mg * s;
        float hr = 0.f, hi = 0.f;
        const int nch = SEQ / S5_TC;
        for (int c0 = 0; c0 < nch; c0 += 32) { float lr_[32], li_[32];
#pragma unroll
            for (int k = 0; k < 32; ++k) { const size_t r = (size_t)g * S5_ROWS + b * nch + c0 + k; lr_[k] = HL[r * 128 + p]; li_[k] = HL[r * 128 + 64 + p]; }
#pragma unroll
            for (int k = 0; k < 32; ++k) { const size_t r = (size_t)g * S5_ROWS + b * nch + c0 + k;
                UH[r * S5_K + p] = (bf16_t)f2bf(hr); UH[r * S5_K + 64 + p] = (bf16_t)f2bf(hi);
                const float nr = ar * hr - ai * hi + lr_[k], ni = ar * hi + ai * hr + li_[k]; hr = nr; hi = ni; } }
    }
}

__device__ __forceinline__ void ssd_stage_bc(Frame& F, int layer, int b, int ch, int grp, LAS float* Bs, LAS float* Cs, LAS float* dts, LAS float* das) {
    const bf16_t* P = (const bf16_t*)(F.ws + WS_P); const float* DT = (const float*)(F.ws + WS_DT);
    const float* cw = F.in[IN_CONVW] + layer * 4 * 1280; const float* cb = F.in[IN_CONVB] + layer * 1280;
    const int l0 = ch * 128; const size_t row0 = (size_t)b * SEQ + l0;
    for (int i = F.tid; i < 2 * 128 * 64; i += NTHR) { const int isC = i >> 13, t = (i >> 6) & 127, n = i & 63;
        const int col = (isC ? C_C : C_B) + grp * 64 + n, cc = 1024 + isC * 128 + grp * 64 + n; float a = cb[cc];
#pragma unroll
        for (int j = 0; j < 4; ++j) { const int l = l0 + t - 3 + j; if (l >= 0) a += cw[j * 1280 + cc] * bf2f(P[(row0 + t - 3 + j) * NINP + col]); }
        (isC ? Cs : Bs)[t * 64 + n] = siluf_(a); }
    for (int i = F.tid; i < 128 * 8; i += NTHR) { const int t = i >> 3, hh = i & 7, h = grp * 8 + hh;
        const float dt = softplusf_(DT[(row0 + t) * 16 + h] + F.in[IN_DTB][layer * 16 + h]); dts[i] = dt; das[i] = dt * (-__expf(F.in[IN_ALOG][layer * 16 + h])); }
}
template <bool OUT>
__device__ __forceinline__ void ssd_units(Frame& F, int layer) {
    LAS float* Bs = (LAS float*)F.lds; LAS float* Cs = Bs + 128 * 64; LAS float* dts = Cs + 128 * 64; LAS float* das = dts + 128 * 8; LAS float* ssq = das + 128 * 8;
    const bf16_t* P = (const bf16_t*)(F.ws + WS_P); float* SST = (float*)(F.ws + WS_SST); float* ASUM = (float*)(F.ws + WS_ASUM); bf16_t* YC = (bf16_t*)(F.ws + WS_YCAT);
    const float* cw = F.in[IN_CONVW] + layer * 4 * 1280; const float* cb = F.in[IN_CONVB] + layer * 1280;
    for (int u = F.bid; u < BATCH * SSD_NCH * 2; u += F.G) {
        const int grp = u & 1, ch = (u >> 1) & 31, b = u >> 6;
        __syncthreads();
        ssd_stage_bc(F, layer, b, ch, grp, Bs, Cs, dts, das);
        __syncthreads();
        const int hh = F.wave, h = grp * 8 + hh, p = F.lane, cx = h * 64 + p;
        const float w0 = cw[cx], w1 = cw[1280 + cx], w2 = cw[2560 + cx], w3 = cw[3840 + cx], bias = cb[cx], dsk = F.in[IN_SSDD][layer * 16 + h];
        const int l0 = ch * 128; const size_t row0 = (size_t)b * SEQ + l0;
        const bf16_t* xp = P + row0 * NINP + C_XS + cx;
        float x0 = 0.f, x1 = 0.f, x2 = 0.f;
        if (l0 > 0) { x0 = bf2f(xp[-3 * (ptrdiff_t)NINP]); x1 = bf2f(xp[-2 * (ptrdiff_t)NINP]); x2 = bf2f(xp[-1 * (ptrdiff_t)NINP]); }
        float st[64];
        float* sp = SST + ((((size_t)b * SSD_NCH + ch) * 16 + h) * 64 + p) * 64;
        if (OUT) {
#pragma unroll
            for (int n = 0; n < 64; n += 4) { const f32x4 v = *(const f32x4*)(sp + n); st[n] = v.x; st[n + 1] = v.y; st[n + 2] = v.z; st[n + 3] = v.w; }
        } else {
#pragma unroll
            for (int n = 0; n < 64; ++n) st[n] = 0.f;
        }
        float asum = 0.f;
#pragma unroll 4
        for (int t = 0; t < 128; ++t) {
            const float x3 = bf2f(xp[(size_t)t * NINP]);
            const float xs = siluf_(bias + w0 * x0 + w1 * x1 + w2 * x2 + w3 * x3);
            x0 = x1; x1 = x2; x2 = x3;
            const float dt = dts[t * 8 + hh], a = das[t * 8 + hh], da = __expf(a), xdt = xs * dt;
            asum += a;
            float y = 0.f;
#pragma unroll
            for (int n = 0; n < 64; n += 4) { const f32x4 bv = *(const LAS f32x4*)(Bs + t * 64 + n);
                st[n] = da * st[n] + bv.x * xdt; st[n + 1] = da * st[n + 1] + bv.y * xdt; st[n + 2] = da * st[n + 2] + bv.z * xdt; st[n + 3] = da * st[n + 3] + bv.w * xdt;
                if (OUT) { const f32x4 cv = *(const LAS f32x4*)(Cs + t * 64 + n); y += (cv.x * st[n] + cv.y * st[n + 1]) + (cv.z * st[n + 2] + cv.w * st[n + 3]); } }
            if (OUT) {
                const float z = bf2f(P[(row0 + t) * NINP + C_Z + cx]);
                const float yz = (y + dsk * xs) * siluf_(z);
                const float q = wave_sum(yz * yz);
                if (p == 0) ssq[t * 8 + hh] = q;
                YC[(row0 + t) * 2048 + 1024 + cx] = (bf16_t)f2bf(yz);
            }
        }
        if (!OUT) {
#pragma unroll
            for (int n = 0; n < 64; n += 4) *(f32x4*)(sp + n) = (f32x4){st[n], st[n + 1], st[n + 2], st[n + 3]};
            if (p == 0) ASUM[((size_t)b * SSD_NCH + ch) * 16 + h] = asum;
        } else {
            __syncthreads();
            const float ng = F.in[IN_SSDG][layer * 1024 + cx];
            for (int t = 0; t < 128; ++t) { float q = 0.f;
#pragma unroll
                for (int j = 0; j < 8; ++j) q += ssq[t * 8 + j];
                const float rs = __builtin_amdgcn_rsqf(q * (1.f / 512.f) + NORM_EPS);
                bf16_t* yp = YC + (row0 + t) * 2048 + 1024 + cx; *yp = (bf16_t)f2bf(bf2f(*yp) * rs * ng); }
        }
    }
}
__device__ __forceinline__ void ssd_scan(Frame& F) {
    bf16_t* SST = (bf16_t*)(F.ws + WS_SST); const float* ASUM = (const float*)(F.ws + WS_ASUM);
    for (int i = F.bid * NTHR + F.tid; i < BATCH * 16 * 512; i += F.G * NTHR) {
        const int pn = (i & 511) * 8, h = (i >> 9) & 15, b = i >> 13; float s[8];
#pragma unroll
        for (int j = 0; j < 8; ++j) s[j] = 0.f;
        u32x4 loc[SSD_NCH]; float dec[SSD_NCH];
#pragma unroll
        for (int ch = 0; ch < SSD_NCH; ++ch) { loc[ch] = *(const u32x4*)(SST + (((size_t)b * SSD_NCH + ch) * 16 + h) * 4096 + pn); dec[ch] = ASUM[((size_t)b * SSD_NCH + ch) * 16 + h]; }
#pragma unroll
        for (int ch = 0; ch < SSD_NCH; ++ch) { u32x4 o; o.x = pk2(s[0], s[1]); o.y = pk2(s[2], s[3]); o.z = pk2(s[4], s[5]); o.w = pk2(s[6], s[7]);
            *(u32x4*)(SST + (((size_t)b * SSD_NCH + ch) * 16 + h) * 4096 + pn) = o; const float d = __expf(dec[ch]);
#pragma unroll
            for (int j = 0; j < 4; ++j) { s[2 * j] = s[2 * j] * d + bflo(loc[ch][j]); s[2 * j + 1] = s[2 * j + 1] * d + bfhi(loc[ch][j]); } }
    }
}

__device__ __forceinline__ void attn_units(Frame& F, int layer) {
    LAS float* Ks = (LAS float*)F.lds; LAS float* Vs = Ks + 256 * 64;
    const bf16_t* P = (const bf16_t*)(F.ws + WS_P); bf16_t* YC = (bf16_t*)(F.ws + WS_YCAT);
    const float* qg = F.in[IN_QG] + layer * 64; const float* kg = F.in[IN_KG] + layer * 64;
    for (int u = F.bid; u < BATCH * 32 * 2; u += F.G) {
        const int kvh = u & 1, qb = (u >> 1) & 31, b = u >> 6, q0 = qb * 128;
        int lane = F.lane; asm volatile("" : "+v"(lane));
        __syncthreads();
        for (int jr = F.wave; jr < 256; jr += NWAVES) { const int l = q0 - 128 + jr; float kv = 0.f, vv = 0.f;
            if (l >= 0) { const size_t row = (size_t)b * SEQ + l; const float x = bf2f(P[row * NINP + C_K + kvh * 64 + lane]); vv = bf2f(P[row * NINP + C_V + kvh * 64 + lane]);
                const float rs = __builtin_amdgcn_rsqf(wave_sum(x * x) * (1.f / 64.f) + NORM_EPS); const float xn = x * rs * kg[lane];
                const float other = __shfl_xor(xn, 32); const int i = lane & 31; const float inv = exp2f(-(float)i * (13.287712379549449f / 32.f));
                float s, c; sincos_fast((float)l * inv, s, c);
                kv = (lane < 32) ? (xn * c - other * s) : (xn * c + other * s); }
            Ks[jr * 64 + lane] = kv; Vs[jr * 64 + lane] = vv; }
        __syncthreads();
        const int hh = F.wave >> 1, head = kvh * 4 + hh, qi = q0 + (F.wave & 1) * 64 + lane; const size_t row = (size_t)b * SEQ + qi;
        float q[64];
        { const u32x4* qp = (const u32x4*)(P + row * NINP + C_Q + head * 64); float ss = 0.f;
#pragma unroll
          for (int j = 0; j < 8; ++j) { const u32x4 w = qp[j];
#pragma unroll
              for (int e = 0; e < 4; ++e) { q[8 * j + 2 * e] = bflo(w[e]); q[8 * j + 2 * e + 1] = bfhi(w[e]); } }
#pragma unroll
          for (int d = 0; d < 64; ++d) ss += q[d] * q[d];
          const float rs = __builtin_amdgcn_rsqf(ss * (1.f / 64.f) + NORM_EPS);
#pragma unroll
          for (int d = 0; d < 64; ++d) q[d] = q[d] * rs * qg[d];
#pragma unroll
          for (int i = 0; i < 32; ++i) { const float inv = exp2f(-(float)i * (13.287712379549449f / 32.f)); float s, c; sincos_fast((float)qi * inv, s, c);
              const float a = q[i], bq = q[i + 32]; q[i] = (a * c - bq * s) * 0.125f; q[i + 32] = (bq * c + a * s) * 0.125f; } }
        float o[64];
#pragma unroll
        for (int d = 0; d < 64; ++d) o[d] = 0.f;
        float mx = F.in[IN_SINK][layer * 8 + head], l = 1.f;
        const int qa = q0 + (F.wave & 1) * 64;
        int jlo = qa - 127 - (q0 - 128); if (q0 == 0 && jlo < 128) jlo = 128; const int jhi = qa + 63 - (q0 - 128);
        for (int jr = jlo; jr <= jhi; ++jr) { const int j = q0 - 128 + jr; const bool ok = (j <= qi) && (qi - j < 128);
            float s = 0.f;
#pragma unroll
            for (int d = 0; d < 64; d += 4) { const f32x4 kv = *(const LAS f32x4*)(Ks + jr * 64 + d); s += (q[d] * kv.x + q[d + 1] * kv.y) + (q[d + 2] * kv.z + q[d + 3] * kv.w); if ((d & 12) == 12) __builtin_amdgcn_sched_barrier(0); }
            if (ok) { const float mn = fmaxf(mx, s), al = __expf(mx - mn), pe = __expf(s - mn); l = l * al + pe; mx = mn;
#pragma unroll
                for (int d = 0; d < 64; d += 4) { const f32x4 vv = *(const LAS f32x4*)(Vs + jr * 64 + d); o[d] = o[d] * al + pe * vv.x; o[d + 1] = o[d + 1] * al + pe * vv.y; o[d + 2] = o[d + 2] * al + pe * vv.z; o[d + 3] = o[d + 3] * al + pe * vv.w; if ((d & 12) == 12) __builtin_amdgcn_sched_barrier(0); } } }
        const float il = 1.f / l; u32x4* op = (u32x4*)(YC + row * 2048 + 512 + head * 64);
#pragma unroll
        for (int j = 0; j < 8; ++j) { u32x4 w; w.x = pk2(o[8 * j] * il, o[8 * j + 1] * il); w.y = pk2(o[8 * j + 2] * il, o[8 * j + 3] * il); w.z = pk2(o[8 * j + 4] * il, o[8 * j + 5] * il); w.w = pk2(o[8 * j + 6] * il, o[8 * j + 7] * il); op[j] = w; }
    }
}

typedef short bf16x8_t __attribute__((ext_vector_type(8)));
__device__ __forceinline__ void split_hi_lo(const f32x4 a, const f32x4 b, bf16x8& hi, bf16x8& lo) {
    u32x4 h; h.x = cvtpk(a.x, a.y); h.y = cvtpk(a.z, a.w); h.z = cvtpk(b.x, b.y); h.w = cvtpk(b.z, b.w);
    u32x4 l; l.x = cvtpk(a.x - bflo(h.x), a.y - bfhi(h.x)); l.y = cvtpk(a.z - bflo(h.y), a.w - bfhi(h.y)); l.z = cvtpk(b.x - bflo(h.z), b.y - bfhi(h.z)); l.w = cvtpk(b.z - bflo(h.w), b.w - bfhi(h.w));
    hi = __builtin_bit_cast(bf16x8, h); lo = __builtin_bit_cast(bf16x8, l);
}
__device__ __forceinline__ void router_phase(Frame& F, int layer) {
    constexpr int WROW = 2064;
    LAS unsigned char* Whi = F.lds; LAS unsigned char* Wlo = F.lds + 36 * WROW;
    LAS float* part = (LAS float*)F.lds;
    volatile LAS unsigned* lcnt = (volatile LAS unsigned*)(F.lds + 148 * 1024);
    const float* wrg = F.in[IN_WRG] + (size_t)layer * 1024 * 4; const float* wre = F.in[IN_WRE] + (size_t)layer * 1024 * 32; const float* gain = F.in[IN_NORM2] + layer * 1024;
    const float* X = F.out; bf16_t* H2 = (bf16_t*)(F.ws + WS_XN);
    int* EID = (int*)(F.ws + WS_MOE); float* EW = (float*)(F.ws + WS_MOE + 128 * 1024); int* SLOT = (int*)(F.ws + WS_MOE + 256 * 1024); float* RS = (float*)(F.ws + WS_MOE + 640 * 1024);
    __syncthreads();
    for (int k = F.tid; k < 1024; k += NTHR) { const float g = gain[k]; const f32x4 wg = *(const f32x4*)(wrg + k * 4);
        float w[36]; w[0] = wg.x; w[1] = wg.y; w[2] = wg.z; w[3] = wg.w;
#pragma unroll
        for (int q = 0; q < 8; ++q) { const f32x4 v = *(const f32x4*)(wre + k * 32 + 4 * q); w[4 + 4 * q] = v.x; w[5 + 4 * q] = v.y; w[6 + 4 * q] = v.z; w[7 + 4 * q] = v.w; }
#pragma unroll
        for (int e = 0; e < 36; ++e) { const float x = w[e] * g; const unsigned h = f2bf(x); const unsigned l = f2bf(x - bf2f(h));
            *(LAS unsigned short*)(Whi + e * WROW + k * 2) = (unsigned short)h; *(LAS unsigned short*)(Wlo + e * WROW + k * 2) = (unsigned short)l; } }
    if (F.tid < 32) lcnt[F.tid] = 0u;
    __syncthreads();
    const int TPB = T / F.G;
    int lane = F.lane; asm volatile("" : "+v"(lane));
    const int mt = F.wave & 3, kh = F.wave >> 2, row = lane & 15, kg = lane >> 4;
    const int m = F.bid * TPB + 16 * mt + row;
    f32x4 acc[3] = {{0.f, 0.f, 0.f, 0.f}, {0.f, 0.f, 0.f, 0.f}, {0.f, 0.f, 0.f, 0.f}}; float ss = 0.f;
    int er[3]; er[0] = row; er[1] = 16 + row; er[2] = (32 + row < 36) ? 32 + row : 35;
    if (kh == 0)
#pragma unroll 1
    for (int kb = 0; kb < 4; ++kb) {
        f32x4 xa[8][2];
#pragma unroll
        for (int ks = 0; ks < 8; ++ks) { const float* xp = X + (size_t)m * DM + 256 * kb + 32 * ks + 8 * kg; xa[ks][0] = *(const f32x4*)xp; xa[ks][1] = *(const f32x4*)(xp + 4); }
#pragma unroll
        for (int ks = 0; ks < 8; ++ks) { const int k0 = 256 * kb + 32 * ks + 8 * kg;
            const f32x4 a = xa[ks][0], b = xa[ks][1];
            ss += (a.x * a.x + a.y * a.y) + (a.z * a.z + a.w * a.w) + (b.x * b.x + b.y * b.y) + (b.z * b.z + b.w * b.w);
            bf16x8 ah, al; split_hi_lo(a, b, ah, al); pin_frag(ah); pin_frag(al);
#pragma unroll
            for (int nt = 0; nt < 3; ++nt) { const bf16x8 bh = *(const LAS bf16x8*)(Whi + er[nt] * WROW + k0 * 2), bl = *(const LAS bf16x8*)(Wlo + er[nt] * WROW + k0 * 2);
                acc[nt] = __builtin_amdgcn_mfma_f32_16x16x32_bf16(ah, bh, acc[nt], 0, 0, 0);
                acc[nt] = __builtin_amdgcn_mfma_f32_16x16x32_bf16(ah, bl, acc[nt], 0, 0, 0);
                acc[nt] = __builtin_amdgcn_mfma_f32_16x16x32_bf16(al, bh, acc[nt], 0, 0, 0); } }
    }
    ss += __shfl_xor(ss, 16); ss += __shfl_xor(ss, 32);
    __syncthreads();
    LAS float* ssq = part + 4 * 3 * 64 * 4; LAS float* lg = ssq + 128; volatile LAS int* elist = (volatile LAS int*)(lg + 64 * 40);
    if (kh == 0) {
        const float rstd_row = __builtin_amdgcn_rsqf(ss * (1.f / DM) + NORM_EPS);
        if (kg == 0) { ssq[64 + 16 * mt + row] = rstd_row; RS[m] = rstd_row; }
    }
    __syncthreads();
    if (kh == 0) {
#pragma unroll
        for (int nt = 0; nt < 3; ++nt)
#pragma unroll
            for (int rg = 0; rg < 4; ++rg) { const int e = row + 16 * nt, tk = 16 * mt + 4 * kg + rg; if (e < 36) lg[tk * 40 + e] = acc[nt][rg] * ssq[64 + tk]; }
    }
    __syncthreads();
    if (F.tid < TPB) { const int tk = F.tid, mm = F.bid * TPB + tk; const LAS float* L = lg + tk * 40;
        float gl[4];
#pragma unroll
        for (int k = 0; k < 4; ++k) gl[k] = L[k] + F.in[IN_BRG][layer * 4 + k];
        int gs = 0; float gbest = gl[0];
#pragma unroll
        for (int k = 1; k < 4; ++k) if (gl[k] > gbest) { gbest = gl[k]; gs = k; }
        float den = 0.f;
#pragma unroll
        for (int k = 0; k < 4; ++k) den += __expf(gl[k] - gbest);
        const float pgrp = 1.f / den;
        float el[8];
#pragma unroll
        for (int k = 0; k < 8; ++k) el[k] = L[4 + gs * 8 + k] + F.in[IN_BRE_][layer * 32 + gs * 8 + k];
        int i0 = 0; float v0 = el[0];
#pragma unroll
        for (int k = 1; k < 8; ++k) if (el[k] > v0) { v0 = el[k]; i0 = k; }
        int i1 = -1; float v1 = -3.0e38f;
#pragma unroll
        for (int k = 0; k < 8; ++k) if (k != i0 && el[k] > v1) { v1 = el[k]; i1 = k; }
        const float e1 = __expf(v1 - v0), w0 = pgrp / (1.f + e1), w1 = pgrp * e1 / (1.f + e1);
        const int ea = gs * 8 + i0, eb = gs * 8 + i1;
        EID[2 * mm] = ea; EID[2 * mm + 1] = eb; EW[2 * mm] = w0; EW[2 * mm + 1] = w1;
        elist[2 * tk] = ea; elist[2 * tk + 1] = eb;
    }
    __syncthreads();
    if (F.tid < 32) { const int e = F.tid; int c = 0;
        for (int i = 0; i < 2 * TPB; ++i) { if (elist[i] == e) { SLOT[2 * (F.bid * TPB) + i] = c; ++c; } }
        ((unsigned*)(F.ws + WS_MOE + 512 * 1024))[(size_t)F.bid * 32 + e] = (unsigned)c; }
    __syncthreads();
}
__device__ __forceinline__ int moe_tables(Frame& F, int layer, volatile LAS int* offs, volatile LAS int* tile_e) {
    volatile LAS int* psum = offs + 256;
    const unsigned* CNTB = (const unsigned*)(F.ws + WS_MOE + 512 * 1024);
    __syncthreads();
    { const int e = F.tid & 31, part = F.tid >> 5; int tot = 0, pre = 0; const int per = (F.G + 15) / 16;
      for (int bb = part * per; bb < (part + 1) * per && bb < F.G; ++bb) { const int c = (int)CNTB[(size_t)bb * 32 + e]; tot += c; pre += (bb < F.bid) ? c : 0; }
      psum[part * 32 + e] = tot; psum[512 + part * 32 + e] = pre; }
    __syncthreads();
    if (F.tid < 64) {
        int c = 0, pre = 0;
        if (F.tid < 32) for (int part = 0; part < 16; ++part) { c += psum[part * 32 + F.tid]; pre += psum[512 + part * 32 + F.tid]; }
        const int tl = (c + 255) >> 8; int incl = tl;
#pragma unroll
        for (int o = 1; o < 32; o <<= 1) { const int v = __shfl_up(incl, o); if (F.tid >= o) incl += v; }
        const int excl = incl - tl;
        if (F.tid < 32) { offs[F.tid] = excl * 256 + pre; for (int k = 0; k < tl; ++k) tile_e[excl + k] = F.tid; }
        if (F.tid == 31) offs[32] = incl;
    }
    __syncthreads();
    return __builtin_amdgcn_readfirstlane(offs[32]);
}
__device__ __forceinline__ void gather_phase(Frame& F, int layer, volatile LAS int* offs) {
    const float* X = F.out; const float* gain = F.in[IN_NORM2] + layer * 1024; const float* RS = (const float*)(F.ws + WS_MOE + 640 * 1024); bf16_t* XG = (bf16_t*)(F.ws + WS_XG);
    const int* EID = (const int*)(F.ws + WS_MOE); const int* SLOT = (const int*)(F.ws + WS_MOE + 256 * 1024); int* POS = (int*)(F.ws + WS_MOE + 384 * 1024);
    const int TPB = T / F.G;
    for (int m = F.bid * TPB + F.wave; m < (F.bid + 1) * TPB; m += NWAVES) {
        const f32x4* xr = (const f32x4*)(X + (size_t)m * DM) + F.lane; const f32x4* gr = (const f32x4*)gain + F.lane; const float rs = RS[m];
        u32x2 o[4];
#pragma unroll
        for (int j = 0; j < 4; ++j) { const f32x4 v = xr[64 * j], g = gr[64 * j]; o[j].x = pk2(v.x * rs * g.x, v.y * rs * g.y); o[j].y = pk2(v.z * rs * g.z, v.w * rs * g.w); }
#pragma unroll
        for (int k = 0; k < 2; ++k) { const int pos = offs[EID[2 * m + k]] + SLOT[2 * m + k]; u32x2* dst = (u32x2*)(XG + (size_t)pos * DM) + F.lane;
#pragma unroll
            for (int j = 0; j < 4; ++j) dst[64 * j] = o[j];
            if (F.lane == 0) POS[2 * m + k] = pos; }
    }
}
__device__ __forceinline__ void combine_phase(Frame& F, const float* gain_next, bool dry = false) {
    const bf16_t* Y = (const bf16_t*)(F.ws + WS_YEXP); const float* EW = (const float*)(F.ws + WS_MOE + 128 * 1024); const int* POS = (const int*)(F.ws + WS_MOE + 384 * 1024);
    bf16_t* XN = (bf16_t*)(F.ws + WS_XN);
    const int gw = F.bid * NWAVES + F.wave, NGW = F.G * NWAVES;
    for (int m = gw; m < T; m += NGW) {
        const float w0 = EW[2 * m], w1 = EW[2 * m + 1]; const int p0 = POS[2 * m], p1 = POS[2 * m + 1];
        f32x4* xr = (f32x4*)(F.out + (size_t)m * DM) + F.lane;
        const u32x2* y0 = (const u32x2*)(Y + (size_t)p0 * DM) + F.lane; const u32x2* y1 = (const u32x2*)(Y + (size_t)p1 * DM) + F.lane;
        f32x4 v[4]; float s = 0.f;
#pragma unroll
        for (int j = 0; j < 4; ++j) { v[j] = xr[64 * j]; const u32x2 a = y0[64 * j], b = y1[64 * j];
            v[j].x += w0 * bflo(a.x) + w1 * bflo(b.x); v[j].y += w0 * bfhi(a.x) + w1 * bfhi(b.x); v[j].z += w0 * bflo(a.y) + w1 * bflo(b.y); v[j].w += w0 * bfhi(a.y) + w1 * bfhi(b.y);
            if (!dry) xr[64 * j] = v[j]; s += (v[j].x * v[j].x + v[j].y * v[j].y) + (v[j].z * v[j].z + v[j].w * v[j].w); }
        if (gain_next) { const float rstd = __builtin_amdgcn_rsqf(wave_sum(s) * (1.f / DM) + NORM_EPS); const f32x4* gr = (const f32x4*)gain_next + F.lane;
            unsigned long long* o8 = (unsigned long long*)(XN + (size_t)m * DM) + F.lane;
#pragma unroll
            for (int j = 0; j < 4; ++j) { const f32x4 gv = gr[64 * j]; o8[64 * j] = (unsigned long long)pk2(v[j].x * rstd * gv.x, v[j].y * rstd * gv.y) | ((unsigned long long)pk2(v[j].z * rstd * gv.z, v[j].w * rstd * gv.w) << 32); } }
    }
}

__device__ __forceinline__ int crow32(int reg, int hh) { return (reg & 3) + 8 * (reg >> 2) + 4 * hh; }
__device__ __forceinline__ float wave_incl_scan(float v, int lane) {
#pragma unroll
    for (int o = 1; o < 64; o <<= 1) { const float t = __shfl_up(v, o); if (lane >= o) v += t; }
    return v;
}
__device__ __forceinline__ void conv_frag(const LAS unsigned char* raw, int chan, int ks, int hh, float w0, float w1, float w2, float w3, float bias, float (&out)[8]) {
#pragma unroll
    for (int run = 0; run < 2; ++run) { const int lb = 16 * ks + 8 * run + 4 * hh; float x[7];
#pragma unroll
        for (int i = 0; i < 7; ++i) x[i] = bf2f(*(const LAS unsigned short*)(raw + (lb + i) * 128 + chan * 2));
#pragma unroll
        for (int j = 0; j < 4; ++j) out[4 * run + j] = siluf_(bias + w0 * x[j] + w1 * x[j + 1] + w2 * x[j + 2] + w3 * x[j + 3]); }
}
constexpr int RAWT = 131 * 128;
__device__ __forceinline__ void stage_raw(const bf16_t* P, size_t row0, int l0, int col, LAS unsigned char* dst, int idx0, int stride) {
    for (int base = idx0; base < 131 * 8; base += 8 * stride) { u32x4 v[8];
#pragma unroll
        for (int q = 0; q < 8; ++q) { const int idx = base + q * stride, r = idx >> 3, c8 = idx & 7; v[q] = (u32x4){0u, 0u, 0u, 0u};
            if (idx < 131 * 8 && l0 - 3 + r >= 0) v[q] = *(const u32x4*)(P + (row0 + r - 3) * NINP + col + c8 * 8); }
#pragma unroll
        for (int q = 0; q < 8; ++q) { const int idx = base + q * stride, r = idx >> 3, c8 = idx & 7; if (idx < 131 * 8) *(LAS u32x4*)(dst + r * 128 + c8 * 16) = v[q]; } }
}
__device__ __forceinline__ bf16_t* xf_base(unsigned char* ws, int b, int ch, int h) { return (bf16_t*)(ws + ((b < 2) ? WS_XN : WS_SST) + 16 * MiB) + ((size_t)(((b & 1) * SSD_NCH + ch) * 16 + h)) * 8192; }
__device__ __forceinline__ void ssdA_mfma(Frame& F, int layer) {
    const bf16_t* P = (const bf16_t*)(F.ws + WS_P); const float* DT = (const float*)(F.ws + WS_DT); bf16_t* SST = (bf16_t*)(F.ws + WS_SST); float* ASUM = (float*)(F.ws + WS_ASUM);
    const float* cw = F.in[IN_CONVW] + layer * 4 * 1280; const float* cb = F.in[IN_CONVB] + layer * 1280;
    LAS unsigned char* rawX = F.lds + F.wave * RAWT; LAS unsigned char* rawB = F.lds + 8 * RAWT; LAS float* ftab = (LAS float*)(F.lds + 9 * RAWT) + F.wave * 128;
    for (int u = F.bid; u < BATCH * SSD_NCH * 2; u += F.G) {
        const int grp = u & 1, ch = (u >> 1) & 31, b = u >> 6, h = grp * 8 + F.wave, l0 = ch * 128; const size_t row0 = (size_t)b * SEQ + l0;
        int lane = F.lane; asm volatile("" : "+v"(lane));
        const int r = lane & 31, hh = lane >> 5;
        __syncthreads();
        stage_raw(P, row0, l0, C_XS + h * 64, rawX, lane, 64);
        stage_raw(P, row0, l0, C_B + grp * 64, rawB, F.tid, NTHR);
        { const float dtb = F.in[IN_DTB][layer * 16 + h], A = -__expf(F.in[IN_ALOG][layer * 16 + h]);
          const float dt0 = softplusf_(DT[(row0 + lane) * 16 + h] + dtb), dt1 = softplusf_(DT[(row0 + 64 + lane) * 16 + h] + dtb);
          const float s0 = wave_incl_scan(dt0 * A, lane); const float tot0 = __builtin_bit_cast(float, __builtin_amdgcn_readlane(__builtin_bit_cast(int, s0), 63));
          const float s1 = wave_incl_scan(dt1 * A, lane) + tot0; const float tot = __builtin_bit_cast(float, __builtin_amdgcn_readlane(__builtin_bit_cast(int, s1), 63));
          ftab[lane] = dt0 * __expf(tot - s0); ftab[64 + lane] = dt1 * __expf(tot - s1);
          if (lane == 0) ASUM[((size_t)b * SSD_NCH + ch) * 16 + h] = tot; }
        __syncthreads();
        bf16x8 bfr[2];
#pragma unroll
        for (int q = 0; q < 2; ++q) { const int idx = F.wave * 2 + q, nt = idx >> 3, ks = idx & 7, cc = 1024 + grp * 64 + 32 * nt + r; float v[8];
            conv_frag(rawB, 32 * nt + r, ks, hh, cw[cc], cw[1280 + cc], cw[2560 + cc], cw[3840 + cc], cb[cc], v); bfr[q] = pack8v(v); }
        bf16x8 xw[2][8];
        bf16_t* xf = xf_base(F.ws, b, ch, h);
#pragma unroll
        for (int pt = 0; pt < 2; ++pt) { const int cx = h * 64 + 32 * pt + r; const float w0 = cw[cx], w1 = cw[1280 + cx], w2 = cw[2560 + cx], w3 = cw[3840 + cx], bias = cb[cx];
#pragma unroll
            for (int ks = 0; ks < 8; ++ks) { float v[8]; conv_frag(rawX, 32 * pt + r, ks, hh, w0, w1, w2, w3, bias, v);
                *(bf16x8*)(xf + ((pt * 8 + ks) * 64 + lane) * 8) = pack8v(v);
                const f32x4 fa = *(const LAS f32x4*)(ftab + 16 * ks + 4 * hh), fb = *(const LAS f32x4*)(ftab + 16 * ks + 8 + 4 * hh);
                v[0] *= fa.x; v[1] *= fa.y; v[2] *= fa.z; v[3] *= fa.w; v[4] *= fb.x; v[5] *= fb.y; v[6] *= fb.z; v[7] *= fb.w; { u32x4 pq = __builtin_bit_cast(u32x4, pack8v(v)); asm volatile("" : "+v"(pq) :: "memory"); xw[pt][ks] = __builtin_bit_cast(bf16x8, pq); } } }
        __syncthreads();
#pragma unroll
        for (int q = 0; q < 2; ++q) *(LAS bf16x8*)(rawB + (F.wave * 2 + q) * 1024 + lane * 16) = bfr[q];
        __syncthreads();
        f32x16 acc[2][2];
#pragma unroll
        for (int pt = 0; pt < 2; ++pt)
#pragma unroll
            for (int nt = 0; nt < 2; ++nt)
#pragma unroll
                for (int i = 0; i < 16; ++i) acc[pt][nt][i] = 0.f;
#pragma unroll
        for (int ks = 0; ks < 8; ++ks)
#pragma unroll
            for (int nt = 0; nt < 2; ++nt) { const bf16x8 bq = *(const LAS bf16x8*)(rawB + (nt * 8 + ks) * 1024 + lane * 16);
#pragma unroll
                for (int pt = 0; pt < 2; ++pt) acc[pt][nt] = MFMA32(xw[pt][ks], bq, acc[pt][nt]); }
        bf16_t* sp = SST + (((size_t)b * SSD_NCH + ch) * 16 + h) * 4096;
        settle_acc(acc[0][0]); settle_acc(acc[0][1]); settle_acc(acc[1][0]); settle_acc(acc[1][1]);
#pragma unroll
        for (int pt = 0; pt < 2; ++pt)
#pragma unroll
            for (int nt = 0; nt < 2; ++nt)
#pragma unroll
                for (int i = 0; i < 16; ++i) sp[(32 * pt + crow32(i, hh)) * 64 + 32 * nt + r] = (bf16_t)f2bf(acc[pt][nt][i]);
    }
}
__device__ __forceinline__ void ssdC_mfma(Frame& F, int layer) {
    const bf16_t* P = (const bf16_t*)(F.ws + WS_P); const float* DT = (const float*)(F.ws + WS_DT); const bf16_t* SST = (const bf16_t*)(F.ws + WS_SST); bf16_t* YC = (bf16_t*)(F.ws + WS_YCAT);
    const float* cw = F.in[IN_CONVW] + layer * 4 * 1280; const float* cb = F.in[IN_CONVB] + layer * 1280;
    LAS unsigned char* rawX = F.lds + F.wave * RAWT;
    LAS unsigned char* Bn = F.lds; LAS unsigned char* Cn = F.lds + 18432;
    LAS float* atab = (LAS float*)(F.lds + 36864) + F.wave * 128; LAS float* dtab = (LAS float*)(F.lds + 40960) + F.wave * 128;
    LAS float* ssqp = (LAS float*)(F.lds + 45056); LAS float* gtab = (LAS float*)(F.lds + 49152) + F.wave * 64;
    LAS unsigned char* zt = F.lds + 51200 + F.wave * 4608;
    for (int u = F.bid; u < BATCH * SSD_NCH * 2; u += F.G) {
        const int grp = u & 1, ch = (u >> 1) & 31, b = u >> 6, h = grp * 8 + F.wave, l0 = ch * 128; const size_t row0 = (size_t)b * SEQ + l0;
        int lane = F.lane; asm volatile("" : "+v"(lane));
        const int r = lane & 31, hh = lane >> 5;
        bf16x8 xsf[2][8];
        { const bf16_t* xf = xf_base(F.ws, b, ch, h);
#pragma unroll
          for (int pt = 0; pt < 2; ++pt)
#pragma unroll
              for (int ks = 0; ks < 8; ++ks) xsf[pt][ks] = *(const bf16x8*)(xf + ((pt * 8 + ks) * 64 + lane) * 8); }
        __syncthreads();
        for (int it = F.tid; it < 128 * 16; it += NTHR) { const int l = it >> 4, c8 = it & 15, isC = c8 >> 3, col = (isC ? C_C : C_B) + grp * 64 + (c8 & 7) * 8, cc = 1024 + isC * 128 + grp * 64 + (c8 & 7) * 8;
            float a[8];
#pragma unroll
            for (int e = 0; e < 8; ++e) a[e] = cb[cc + e];
#pragma unroll
            for (int j = 0; j < 4; ++j) { if (l0 + l - 3 + j >= 0) { const u32x4 xv = *(const u32x4*)(P + (row0 + l - 3 + j) * NINP + col);
#pragma unroll
                for (int e = 0; e < 4; ++e) { a[2 * e] += cw[j * 1280 + cc + 2 * e] * bflo(xv[e]); a[2 * e + 1] += cw[j * 1280 + cc + 2 * e + 1] * bfhi(xv[e]); } } }
            u32x4 o; o.x = cvtpk(siluf_(a[0]), siluf_(a[1])); o.y = cvtpk(siluf_(a[2]), siluf_(a[3])); o.z = cvtpk(siluf_(a[4]), siluf_(a[5])); o.w = cvtpk(siluf_(a[6]), siluf_(a[7]));
            *(LAS u32x4*)((isC ? Cn : Bn) + l * 144 + (c8 & 7) * 16) = o; }
        { const float dtb = F.in[IN_DTB][layer * 16 + h], A = -__expf(F.in[IN_ALOG][layer * 16 + h]);
          const float dt0 = softplusf_(DT[(row0 + lane) * 16 + h] + dtb), dt1 = softplusf_(DT[(row0 + 64 + lane) * 16 + h] + dtb);
          const float s0 = wave_incl_scan(dt0 * A, lane); const float tot0 = __builtin_bit_cast(float, __builtin_amdgcn_readlane(__builtin_bit_cast(int, s0), 63));
          const float s1 = wave_incl_scan(dt1 * A, lane) + tot0;
          atab[lane] = s0; atab[64 + lane] = s1; dtab[lane] = dt0; dtab[64 + lane] = dt1; gtab[lane] = F.in[IN_SSDG][layer * 1024 + h * 64 + lane]; }
        const bf16_t* sp = SST + (((size_t)b * SSD_NCH + ch) * 16 + h) * 4096;
        const float dsk = F.in[IN_SSDD][layer * 16 + h];
        LAS unsigned char* pf = F.lds + 90112 + F.wave * 8192;
#pragma unroll
        for (int pt = 0; pt < 2; ++pt)
#pragma unroll
            for (int ks = 0; ks < 4; ++ks) *(LAS bf16x8*)(pf + ((pt * 4 + ks) * 64 + lane) * 16) = *(const bf16x8*)(sp + (32 * pt + r) * 64 + 16 * ks + 8 * hh);
        __syncthreads();
#pragma unroll 1
        for (int li = 0; li < 4; ++li) {
            const size_t rowt = row0 + 32 * li;
            u32x4 zreg[4];
#pragma unroll
            for (int q = 0; q < 4; ++q) { const int idx = lane + 64 * q, rr = idx >> 3, c8 = idx & 7; zreg[q] = *(const u32x4*)(P + (rowt + rr) * NINP + C_Z + h * 64 + c8 * 8); }
            bf16x8 Cf[4];
#pragma unroll
            for (int ks = 0; ks < 4; ++ks) Cf[ks] = *(const LAS bf16x8*)(Cn + (32 * li + r) * 144 + (16 * ks + 8 * hh) * 2);
            f32x16 acc[2];
#pragma unroll
            for (int pt = 0; pt < 2; ++pt)
#pragma unroll
                for (int i = 0; i < 16; ++i) acc[pt][i] = 0.f;
#pragma unroll
            for (int ks = 0; ks < 4; ++ks)
#pragma unroll
                for (int pt = 0; pt < 2; ++pt) acc[pt] = MFMA32(*(const LAS bf16x8*)(pf + ((pt * 4 + ks) * 64 + lane) * 16), Cf[ks], acc[pt]);
            const float al = atab[32 * li + r], el = __expf(al); const int lrel = 32 * li + r;
            settle_acc(acc[0]); settle_acc(acc[1]);
#pragma unroll
            for (int pt = 0; pt < 2; ++pt)
#pragma unroll
                for (int i = 0; i < 16; ++i) acc[pt][i] *= el;
#pragma unroll
            for (int si = 0; si < 4; ++si) if (si <= li) {
                f32x16 X;
#pragma unroll
                for (int i = 0; i < 16; ++i) X[i] = 0.f;
#pragma unroll
                for (int ks = 0; ks < 4; ++ks) { const bf16x8 Bq = *(const LAS bf16x8*)(Bn + (32 * si + r) * 144 + (16 * ks + 8 * hh) * 2); X = MFMA32(Bq, Cf[ks], X); }
                settle_acc(X);
#pragma unroll
                for (int g4 = 0; g4 < 4; ++g4) { const int sb = 32 * si + 8 * g4 + 4 * hh; const f32x4 av = *(const LAS f32x4*)(atab + sb), dv = *(const LAS f32x4*)(dtab + sb);
#pragma unroll
                    for (int j = 0; j < 4; ++j) { const int s = sb + j; float arg = al - av[j]; if (si == li && s > lrel) arg = -100.f;
                        float x = X[4 * g4 + j] * (__expf(arg) * dv[j]); if (si == li && s > lrel) x = 0.f; if (si == li && s == lrel) x += dsk; X[4 * g4 + j] = x; } }
#pragma unroll
                for (int kq = 0; kq < 2; ++kq) { const float v[8] = {X[8 * kq], X[8 * kq + 1], X[8 * kq + 2], X[8 * kq + 3], X[8 * kq + 4], X[8 * kq + 5], X[8 * kq + 6], X[8 * kq + 7]}; bf16x8 Xf = pack8v(v); pin_frag(Xf);
#pragma unroll
                    for (int pt = 0; pt < 2; ++pt) { bf16x8 a;
#pragma unroll
                        for (int q = 0; q < 4; ++q) a = (si == q) ? xsf[pt][2 * q + kq] : a;
                        acc[pt] = MFMA32(a, Xf, acc[pt]); } }
            }
            settle_acc(acc[0]); settle_acc(acc[1]);
#pragma unroll
            for (int q = 0; q < 4; ++q) { const int idx = lane + 64 * q, rr = idx >> 3, c8 = idx & 7; *(LAS u32x4*)(zt + rr * 144 + c8 * 16) = zreg[q]; }
            float qs = 0.f;
#pragma unroll
            for (int pt = 0; pt < 2; ++pt)
#pragma unroll
                for (int g4 = 0; g4 < 4; ++g4) { const u32x2 zz = *(const LAS u32x2*)(zt + r * 144 + (32 * pt + 8 * g4 + 4 * hh) * 2);
                    const float z0 = bflo(zz.x), z1 = bfhi(zz.x), z2 = bflo(zz.y), z3 = bfhi(zz.y);
                    float y0 = acc[pt][4 * g4] * siluf_(z0), y1 = acc[pt][4 * g4 + 1] * siluf_(z1), y2 = acc[pt][4 * g4 + 2] * siluf_(z2), y3 = acc[pt][4 * g4 + 3] * siluf_(z3);
                    acc[pt][4 * g4] = y0; acc[pt][4 * g4 + 1] = y1; acc[pt][4 * g4 + 2] = y2; acc[pt][4 * g4 + 3] = y3; qs += (y0 * y0 + y1 * y1) + (y2 * y2 + y3 * y3); }
            qs += __shfl_xor(qs, 32);
            if (hh == 0) ssqp[(32 * li + r) * 8 + F.wave] = qs;
            __syncthreads();
            { const f32x4 qa = *(const LAS f32x4*)(ssqp + (32 * li + r) * 8), qb = *(const LAS f32x4*)(ssqp + (32 * li + r) * 8 + 4);
              const float rs = __builtin_amdgcn_rsqf(((qa.x + qa.y) + (qa.z + qa.w) + (qb.x + qb.y) + (qb.z + qb.w)) * (1.f / 512.f) + NORM_EPS);
#pragma unroll
              for (int pt = 0; pt < 2; ++pt)
#pragma unroll
                  for (int g4 = 0; g4 < 4; ++g4) { const int p0 = 32 * pt + 8 * g4 + 4 * hh; const f32x4 gv = *(const LAS f32x4*)(gtab + p0);
                      u32x2 o; o.x = cvtpk(acc[pt][4 * g4] * rs * gv.x, acc[pt][4 * g4 + 1] * rs * gv.y); o.y = cvtpk(acc[pt][4 * g4 + 2] * rs * gv.z, acc[pt][4 * g4 + 3] * rs * gv.w);
                      *(LAS u32x2*)(zt + r * 144 + p0 * 2) = o; } }
#pragma unroll
            for (int q = 0; q < 4; ++q) { const int idx = lane + 64 * q, rr = idx >> 3, c8 = idx & 7; *(u32x4*)(YC + (rowt + rr) * 2048 + 1024 + h * 64 + c8 * 8) = *(const LAS u32x4*)(zt + rr * 144 + c8 * 16); }
        }
    }
}

typedef short v4i16_t __attribute__((ext_vector_type(4)));
__device__ __forceinline__ void attn_mfma(Frame& F, int layer) {
    LAS unsigned char* Kn = F.lds; LAS unsigned char* VT = F.lds + 36864;
    const bf16_t* P = (const bf16_t*)(F.ws + WS_P); bf16_t* YC = (bf16_t*)(F.ws + WS_YCAT);
    const float* qg = F.in[IN_QG] + layer * 64; const float* kg = F.in[IN_KG] + layer * 64;
    for (int u = F.bid; u < BATCH * 32 * 2; u += F.G) {
        const int kvh = u & 1, qb = (u >> 1) & 31, b = u >> 6, q0 = qb * 128;
        int lane = F.lane; asm volatile("" : "+v"(lane));
        const int r = lane & 31, hh = lane >> 5;
        __syncthreads();
#pragma unroll
        for (int pass = 0; pass < 2; ++pass) { const int jr = pass * 128 + (F.tid >> 2), j4 = F.tid & 3, l = q0 - 128 + jr;
            u32x4 lo = {0u, 0u, 0u, 0u}, hi = {0u, 0u, 0u, 0u};
            if (l >= 0) { const bf16_t* kp = P + ((size_t)b * SEQ + l) * NINP + C_K + kvh * 64 + 8 * j4; lo = *(const u32x4*)kp; hi = *(const u32x4*)(kp + 32); }
            float x1[8], x2[8]; float ss = 0.f;
#pragma unroll
            for (int e = 0; e < 4; ++e) { x1[2 * e] = bflo(lo[e]); x1[2 * e + 1] = bfhi(lo[e]); x2[2 * e] = bflo(hi[e]); x2[2 * e + 1] = bfhi(hi[e]); }
#pragma unroll
            for (int e = 0; e < 8; ++e) ss += x1[e] * x1[e] + x2[e] * x2[e];
            ss += WS_DPP(ss, 0xB1, 0xF); ss += WS_DPP(ss, 0x4E, 0xF);
            const float rs = __builtin_amdgcn_rsqf(ss * (1.f / 64.f) + NORM_EPS);
            float o1[8], o2[8];
#pragma unroll
            for (int e = 0; e < 8; ++e) { const int i = 8 * j4 + e; const float inv = exp2f(-(float)i * (13.287712379549449f / 32.f)); float s, c; sincos_fast((float)l * inv, s, c);
                const float a = x1[e] * rs * kg[i], bq = x2[e] * rs * kg[i + 32]; o1[e] = a * c - bq * s; o2[e] = bq * c + a * s; }
            u32x4 w1, w2; w1.x = cvtpk(o1[0], o1[1]); w1.y = cvtpk(o1[2], o1[3]); w1.z = cvtpk(o1[4], o1[5]); w1.w = cvtpk(o1[6], o1[7]);
            w2.x = cvtpk(o2[0], o2[1]); w2.y = cvtpk(o2[2], o2[3]); w2.z = cvtpk(o2[4], o2[5]); w2.w = cvtpk(o2[6], o2[7]);
            if (l < 0) { w1 = (u32x4){0u, 0u, 0u, 0u}; w2 = w1; }
            *(LAS u32x4*)(Kn + jr * 144 + 16 * j4) = w1; *(LAS u32x4*)(Kn + jr * 144 + 64 + 16 * j4) = w2; }
        { u32x4 vr[4];
#pragma unroll
          for (int q = 0; q < 4; ++q) { const int it = F.tid + NTHR * q, jr = it >> 3, c = it & 7, l = q0 - 128 + jr;
              vr[q] = (l >= 0) ? *(const u32x4*)(P + ((size_t)b * SEQ + l) * NINP + C_V + kvh * 64 + 8 * c) : (u32x4){0u, 0u, 0u, 0u}; }
#pragma unroll
          for (int q = 0; q < 4; ++q) { const int it = F.tid + NTHR * q, jr = it >> 3, c = it & 7; *(LAS u32x4*)(VT + jr * 192 + c * 16) = vr[q]; } }
        __syncthreads();
        const int hd = F.wave >> 1, head = kvh * 4 + hd, qhalf = F.wave & 1; const float sink = F.in[IN_SINK][layer * 8 + head];
#pragma unroll 1
        for (int jt = 0; jt < 2; ++jt) {
            const int qt = q0 + 64 * qhalf + 32 * jt, qi = qt + r, t0 = 2 * qhalf + jt; const size_t row = (size_t)b * SEQ + qi;
            bf16x8 Qf[4];
            { float qv[4][8]; float ss = 0.f;
#pragma unroll
              for (int ks = 0; ks < 4; ++ks) { const u32x4 w = *(const u32x4*)(P + row * NINP + C_Q + head * 64 + 16 * ks + 8 * hh);
#pragma unroll
                  for (int e = 0; e < 4; ++e) { qv[ks][2 * e] = bflo(w[e]); qv[ks][2 * e + 1] = bfhi(w[e]); ss += qv[ks][2 * e] * qv[ks][2 * e] + qv[ks][2 * e + 1] * qv[ks][2 * e + 1]; } }
              ss += __shfl_xor(ss, 32);
              const float rs = __builtin_amdgcn_rsqf(ss * (1.f / 64.f) + NORM_EPS);
#pragma unroll
              for (int ks = 0; ks < 4; ++ks)
#pragma unroll
                  for (int e = 0; e < 8; ++e) qv[ks][e] *= rs * qg[16 * ks + 8 * hh + e];
#pragma unroll
              for (int ks = 0; ks < 2; ++ks)
#pragma unroll
                  for (int e = 0; e < 8; ++e) { const int i = 16 * ks + 8 * hh + e; const float inv = exp2f(-(float)i * (13.287712379549449f / 32.f)); float s, c; sincos_fast((float)qi * inv, s, c);
                      const float a = qv[ks][e], bq = qv[ks + 2][e]; qv[ks][e] = (a * c - bq * s) * 0.125f; qv[ks + 2][e] = (bq * c + a * s) * 0.125f; }
#pragma unroll
              for (int ks = 0; ks < 4; ++ks) { Qf[ks] = pack8v(qv[ks]); pin_frag(Qf[ks]); } }
            f32x16 acc[2];
#pragma unroll
            for (int dt = 0; dt < 2; ++dt)
#pragma unroll
                for (int i = 0; i < 16; ++i) acc[dt][i] = 0.f;
            float m = sink, lsum = 1.f;
#pragma unroll
            for (int tt = 0; tt < 5; ++tt) { const int t = t0 + tt;
                if (q0 == 0 && t < 4) continue;
                f32x16 X;
#pragma unroll
                for (int i = 0; i < 16; ++i) X[i] = 0.f;
#pragma unroll
                for (int ks = 0; ks < 4; ++ks) { const bf16x8 Kq = *(const LAS bf16x8*)(Kn + (32 * t + r) * 144 + (16 * ks + 8 * hh) * 2); X = MFMA32(Kq, Qf[ks], X); }
                settle_acc(X);
                if (tt == 0) {
#pragma unroll
                    for (int i = 0; i < 16; ++i) if (!(r < crow32(i, hh))) X[i] = -INFINITY; }
                if (tt == 4) {
#pragma unroll
                    for (int i = 0; i < 16; ++i) if (!(crow32(i, hh) <= r)) X[i] = -INFINITY; }
                float mx = X[0];
#pragma unroll
                for (int i = 1; i < 16; ++i) mx = fmaxf(mx, X[i]);
                mx = fmaxf(mx, __shfl_xor(mx, 32));
                const float mn = fmaxf(m, mx), al = __expf(m - mn); m = mn;
                float ps = 0.f;
#pragma unroll
                for (int i = 0; i < 16; ++i) { X[i] = __expf(X[i] - mn); ps += X[i]; }
                ps += __shfl_xor(ps, 32);
                lsum = lsum * al + ps;
                settle_acc(acc[0]); settle_acc(acc[1]);
#pragma unroll
                for (int dt = 0; dt < 2; ++dt)
#pragma unroll
                    for (int i = 0; i < 16; ++i) acc[dt][i] *= al;
#pragma unroll
                for (int kq = 0; kq < 2; ++kq) { const float v[8] = {X[8 * kq], X[8 * kq + 1], X[8 * kq + 2], X[8 * kq + 3], X[8 * kq + 4], X[8 * kq + 5], X[8 * kq + 6], X[8 * kq + 7]}; bf16x8 Pf = pack8v(v); pin_frag(Pf);
#pragma unroll
                    for (int dt = 0; dt < 2; ++dt) { const LAS unsigned char* vp = VT + (32 * t + 16 * kq + 4 * hh + ((lane & 15) >> 2)) * 192 + (32 * dt + 16 * ((lane >> 4) & 1) + 4 * (lane & 3)) * 2;
                        const v4i16_t va = __builtin_amdgcn_ds_read_tr16_b64_v4i16((LAS v4i16_t*)vp), vb = __builtin_amdgcn_ds_read_tr16_b64_v4i16((LAS v4i16_t*)(vp + 8 * 192));
                        bf16x8 Vf = {va[0], va[1], va[2], va[3], vb[0], vb[1], vb[2], vb[3]}; pin_frag(Vf);
                        acc[dt] = MFMA32(Vf, Pf, acc[dt]); } }
            }
            const float il = 1.f / lsum; settle_acc(acc[0]); settle_acc(acc[1]);
#pragma unroll
            for (int dt = 0; dt < 2; ++dt)
#pragma unroll
                for (int g4 = 0; g4 < 4; ++g4) { u32x2 o; o.x = cvtpk(acc[dt][4 * g4] * il, acc[dt][4 * g4 + 1] * il); o.y = cvtpk(acc[dt][4 * g4 + 2] * il, acc[dt][4 * g4 + 3] * il);
                    *(u32x2*)(YC + row * 2048 + 512 + head * 64 + 32 * dt + 8 * g4 + 4 * hh) = o; }
        }
    }
}

#ifndef MK_PER_PHASE
#define MK_PER_PHASE 0
#endif
constexpr int NPH = 13;
constexpr int TAB_OFF = 150 * 1024;
struct Args { const float* in[N_INPUTS]; float* out; unsigned char* ws; int gp_lo, gp_hi; };
static_assert(sizeof(Args) == (N_INPUTS + 2) * 8 + 8, "no padding in Args");

#ifndef PROBE_ID
#define PROBE_ID 0
#endif
#ifndef PROBE_N
#define PROBE_N 1
#endif
#define REP(id) for (int _r = 0; _r < ((id) == PROBE_ID ? 1 + PROBE_N : 1); ++_r)
extern __shared__ __attribute__((aligned(16))) unsigned char lds_raw[];
__device__ __forceinline__ LAS unsigned char* lds_raw_base() { return (LAS unsigned char*)lds_raw; }
#define LAUNDER() do { asm volatile("" : "+s"(F.in), "+s"(F.ws), "+s"(F.out), "+s"(F.ctl), "+s"(F.bid), "+s"(F.G)); asm volatile("" : "+v"(F.tid)); F.lane = F.tid & 63; F.wave = __builtin_amdgcn_readfirstlane(F.tid >> 6); } while (0)
template <int layer>
__device__ __forceinline__ void layer_body(Frame& F, const int lo, const int hi, const bool rerun) {
    volatile LAS int* offs = (volatile LAS int*)(F.lds + TAB_OFF); volatile LAS int* tile_e = offs + 64;
    XcdBarrier bar; bar.bar = F.ctl + CW_BAR; bar.x = xb_xcc_id(); bar.st = F.MISC;
#define GP(k) (layer * NPH + (k))
#ifdef ONLY_PH
#define IN(k) (((k) == ONLY_PH) && lo <= GP(k) && GP(k) < hi)
#else
#define IN(k) (lo <= GP(k) && GP(k) < hi)
#endif
#define WSB ((const char*)F.ws)
#ifdef DIAG_GP
#define STAMP0(k) do { if (GP(k) == DIAG_GP) { const unsigned t_ = (unsigned)__builtin_amdgcn_s_memrealtime(); if (threadIdx.x == 0) *(volatile LAS unsigned*)((LAS unsigned char*)lds_raw_base() + MISC_OFF + 32) = t_; } } while (0)
#define STAMP1(k) do { if (GP(k) == DIAG_GP) { const unsigned t_ = (unsigned)__builtin_amdgcn_s_memrealtime(); if (threadIdx.x == 0) *(volatile LAS unsigned*)((LAS unsigned char*)lds_raw_base() + MISC_OFF + 40) = t_; } } while (0)
#else
#define STAMP0(k)
#define STAMP1(k)
#endif
#define SEAM(k) do { if (!MK_PER_PHASE && IN(k) && GP(k) + 1 < hi) { xcd_barrier(bar); if (PROBE_ID == 19) { xcd_barrier(bar); xcd_barrier(bar); } } STAMP1(k); } while (0)
        if (IN(0) && layer == 0) { LAUNDER(); STAMP0(0);
            REP(1) { convert_weights(F, 0); __syncthreads(); } REP(2) s5_build(F, 0);
            REP(3) rmsnorm_rows(F, F.in[IN_X], F.in[IN_NORM1], (bf16_t*)(F.ws + WS_XN));
            SEAM(0);
        }
        if (IN(1)) { LAUNDER(); STAMP0(1);
            SchedDense<2048u, 2048u, T / 256, NINP / 256, 16> S{WSB + WS_XN, WSB + WS_WIN, F.G, F.bid};
            EpiProj E{F.ws, F.in[IN_BGATE] + layer * 3072};
            REP(4) pg8::gemm_phase<2048u, 2048u>(F.tid, F.lds, S, E);
            SEAM(1);
        }
        if (IN(2)) { LAUNDER(); STAMP0(2);
            SchedS5P1 S{WSB + WS_UH, WSB + WS_EG, F.G, F.bid};
            EpiHloc E{(float*)(F.ws + WS_HLOC)};
            REP(5) pg8::gemm_phase<(unsigned)(S5_K * 2), 1024u>(F.tid, F.lds, S, E);
            REP(6) ssdA_mfma(F, layer);
            REP(8) attn_mfma(F, layer);
            SEAM(2);
        }
        if (IN(3)) { LAUNDER(); STAMP0(3);
            REP(7) s5_scan(F, layer);
            if (!rerun) ssd_scan(F);
            SEAM(3);
        }
        if (IN(4)) { LAUNDER(); STAMP0(4);
            SchedS5Main S{WSB + WS_UH, WSB + WS_MG, F.G, F.bid};
            EpiS5Y E{(bf16_t*)(F.ws + WS_XN)};
            REP(9) pg8::gemm_phase<(unsigned)(S5_K * 2), (unsigned)(S5_K * 2)>(F.tid, F.lds, S, E);
            REP(10) ssdC_mfma(F, layer);
            SEAM(4);
        }
        if (IN(5)) { LAUNDER(); STAMP0(5);
            SchedDense<1024u, 1024u, T / 256, 4, 8> S{WSB + WS_XN, WSB + WS_WGLU, F.G, F.bid};
            EpiGlu E{(bf16_t*)(F.ws + WS_YCAT)};
            REP(11) pg8::gemm_phase<1024u, 1024u>(F.tid, F.lds, S, E);
            SEAM(5);
        }
        if (IN(6)) { LAUNDER(); STAMP0(6);
            SchedDense<4096u, 4096u, T / 256, 4, 32> S{WSB + WS_YCAT, WSB + WS_PCAT, F.G, F.bid};
            EpiMerged E{F.ws};
            REP(12) pg8::gemm_phase<4096u, 4096u>(F.tid, F.lds, S, E);
            SEAM(6);
        }
        if (IN(7)) { LAUNDER(); STAMP0(7);
            SchedDense<2048u, 2048u, T / 256, 4, 16> S{WSB + WS_XN, WSB + WS_WOUT, F.G, F.bid};
            EpiResid E{layer == 0 ? F.in[IN_X] : (const float*)F.out, F.out};
            REP(layer == 0 ? 13 : -1) pg8::gemm_phase<2048u, 2048u>(F.tid, F.lds, S, E);
            SEAM(7);
        }
        if (IN(8)) { LAUNDER(); STAMP0(8); REP(17) router_phase(F, layer); SEAM(8); }
        if (IN(9)) { LAUNDER(); STAMP0(9); (void)moe_tables(F, layer, offs, tile_e); REP(14) gather_phase(F, layer, offs); SEAM(9); }
        if (IN(10)) { LAUNDER(); STAMP0(10);
            const int ntiles = moe_tables(F, layer, offs, tile_e);
            SchedMoe<2048u, (size_t)1024 * 1024 * 2, (size_t)256 * 2048, 16> S{WSB + WS_XG, WSB + WS_EGU, ntiles, F.G, F.bid, tile_e};
            EpiSwiGlu E{(bf16_t*)(F.ws + WS_HID), (const float*)(F.ws + WS_MOE + 704 * 1024)};
            REP(15) pg8::gemm_phase<2048u, 2048u>(F.tid, F.lds, S, E);
            SEAM(10);
        }
        if (IN(11)) { LAUNDER(); STAMP0(11);
            const int ntiles = moe_tables(F, layer, offs, tile_e);
            SchedMoe<1024u, (size_t)1024 * 512 * 2, (size_t)256 * 1024, 8> S{WSB + WS_HID, WSB + WS_EDN, ntiles, F.G, F.bid, tile_e};
            EpiPlainBf16 E{(bf16_t*)(F.ws + WS_YEXP)};
            REP(16) pg8::gemm_phase<1024u, 1024u>(F.tid, F.lds, S, E);
            SEAM(11);
        }
        if (IN(12)) { LAUNDER(); STAMP0(12);
            if (PROBE_ID == 18) combine_phase(F, F.in[IN_NORM1], true);
            combine_phase(F, layer + 1 < DEPTH ? F.in[IN_NORM1] + (layer + 1) * 1024 : nullptr);
            if (layer + 1 < DEPTH) { __syncthreads(); convert_weights(F, layer + 1); __syncthreads(); s5_build(F, layer + 1); }
            SEAM(12);
        }
#undef GP
#undef IN
#undef SEAM
#undef WSB
}
__global__ void __launch_bounds__(NTHR, 2) fwd(Args args) {
    Frame F;
    F.lds = (LAS unsigned char*)lds_raw;
    F.MISC = (volatile LAS unsigned*)(F.lds + MISC_OFF);
    F.tid = threadIdx.x; F.lane = F.tid & 63; F.wave = __builtin_amdgcn_readfirstlane(F.tid >> 6);
    F.G = gridDim.x; F.bid = blockIdx.x;
    const __attribute__((address_space(4))) char* ka = (const __attribute__((address_space(4))) char*)__builtin_amdgcn_kernarg_segment_ptr();
    F.in = (const float* const __attribute__((address_space(4)))*)ka;
    F.out = *(float* const __attribute__((address_space(4)))*)(ka + N_INPUTS * 8); F.ws = *(unsigned char* const __attribute__((address_space(4)))*)(ka + N_INPUTS * 8 + 8); F.ctl = (unsigned*)(F.ws + WS_CTL);
    if (F.tid < 64) F.MISC[F.tid] = 0u;
    __syncthreads();
    XcdBarrier bar; bar.bar = F.ctl + CW_BAR; bar.x = 0; bar.st = nullptr;
    if (!MK_PER_PHASE) bar = xcd_barrier_post(F.ctl + CW_BAR, F.MISC);
    const int lo = *(const __attribute__((address_space(4))) int*)(ka + N_INPUTS * 8 + 16), hi_raw = *(const __attribute__((address_space(4))) int*)(ka + N_INPUTS * 8 + 20), hi = hi_raw & 0xffff;

    layer_body<0>(F, lo, hi, (hi_raw >> 16) != 0);
    layer_body<1>(F, lo, hi, (hi_raw >> 16) != 0);
#ifdef DIAG_GP
    __syncthreads();
    if (blockIdx.x == 0 && threadIdx.x == 0) { const unsigned t0 = *(volatile LAS unsigned*)((LAS unsigned char*)lds_raw_base() + MISC_OFF + 32), t1 = *(volatile LAS unsigned*)((LAS unsigned char*)lds_raw_base() + MISC_OFF + 40); float* o_ = *(float* const __attribute__((address_space(4)))*)((const __attribute__((address_space(4))) char*)__builtin_amdgcn_kernarg_segment_ptr() + N_INPUTS * 8); asm volatile("s_waitcnt vmcnt(0)" ::: "memory"); o_[0] = (float)(t1 - t0); }
#endif
}

extern "C" void kernel_launch(void* const* d_in, const int* in_sizes, int n_in, void* d_out, int out_size, void* d_ws, size_t ws_size, hipStream_t stream) {
    static int grid = 0;
    if (grid == 0) {
        if (n_in != N_INPUTS || out_size != T * DM || ws_size < WS_END) { fprintf(stderr, "kernel_launch: unexpected shapes (n_in %d out %d ws %zu need %zu)\n", n_in, out_size, ws_size, (size_t)WS_END); grid = -1; return; }
        int dev = 0, cus = 0, per_cu = 0;
        if (hipGetDevice(&dev) != hipSuccess || hipDeviceGetAttribute(&cus, hipDeviceAttributeMultiprocessorCount, dev) != hipSuccess) { grid = -1; return; }
        if (hipFuncSetAttribute((const void*)fwd, hipFuncAttributeMaxDynamicSharedMemorySize, LDS_BYTES) != hipSuccess) { fprintf(stderr, "kernel_launch: hipFuncSetAttribute failed\n"); grid = -1; return; }
        if (hipOccupancyMaxActiveBlocksPerMultiprocessor(&per_cu, (const void*)fwd, NTHR, LDS_BYTES) != hipSuccess || per_cu < 1) fprintf(stderr, "kernel_launch: occupancy query reports %d\n", per_cu);
        (void)hipGetLastError();
        grid = cus;
    }
    if (grid < 0) return;
    (void)hipMemsetAsync((char*)d_ws + WS_CTL, 0, CTL_ZERO_BYTES, stream);
    Args a{};
    for (int i = 0; i < N_INPUTS; ++i) a.in[i] = (const float*)d_in[i];
    a.out = (float*)d_out; a.ws = (unsigned char*)d_ws;
#if MK_PER_PHASE
    for (int gp = 0; gp < DEPTH * NPH; ++gp) {
        if (gp == NPH) continue;
        a.gp_lo = gp; a.gp_hi = gp + 1;
        int nrep = 1;
#ifdef PP_REP_GP
        if (gp == PP_REP_GP) nrep = 1 + PP_REP_N;
#endif
        for (int rr = 0; rr < nrep; ++rr) { a.gp_hi = (gp + 1) | (rr > 0 ? 0x10000 : 0); hipLaunchKernelGGL(fwd, dim3(grid), dim3(NTHR), LDS_BYTES, stream, a); }
    }
#else
    a.gp_lo = 0; a.gp_hi = DEPTH * NPH;
    hipLaunchKernelGGL(fwd, dim3(grid), dim3(NTHR), LDS_BYTES, stream, a);
#endif
}
```

```cpp
#include <hip/hip_runtime.h>
#include <cstdio>
#include <cstdint>

#define LAS __attribute__((address_space(3)))
#define GAS __attribute__((address_space(1)))
typedef unsigned short bf16_t;
typedef short bf16x8 __attribute__((ext_vector_type(8)));
typedef float f32x4 __attribute__((ext_vector_type(4)));
typedef float f32x2 __attribute__((ext_vector_type(2)));
typedef unsigned u32x4 __attribute__((ext_vector_type(4)));
typedef unsigned u32x2 __attribute__((ext_vector_type(2)));

constexpr int BATCH = 4, SEQ = 4096, DM = 1024, T = BATCH * SEQ, DEPTH = 2;
constexpr int NIN = 6672, NINP = 6912;
constexpr int C_U = 0, C_Q = 512, C_K = 1024, C_V = 1152, C_Z = 1280, C_XS = 2304, C_B = 3328, C_C = 3456, C_DT = 3584, C_G = 3840;
constexpr int S5_TC = 32, S5_ROWS = T / S5_TC  , S5_K = 128 + S5_TC * 16  , S5_N = S5_TC * 16  ;
constexpr int SSD_NCH = SEQ / 128;
constexpr int MOE_MAXROWS = 2 * T + 32 * 256;
constexpr float NORM_EPS = 1e-6f;

constexpr size_t MiB = 1u << 20;
constexpr size_t WS_CTL = 0, CTL_ZERO_BYTES = 1 * MiB;
constexpr size_t WS_WIN = 1 * MiB;
constexpr size_t WS_WGLU = WS_WIN + (size_t)NINP * DM * 2;
constexpr size_t WS_PCAT = WS_WGLU + 1 * MiB;
constexpr size_t WS_WOUT = WS_PCAT + 4 * MiB;
constexpr size_t WS_EGU = WS_WOUT + 2 * MiB;
constexpr size_t WS_EDN = WS_EGU + 64 * MiB;
constexpr size_t WS_MG = WS_EDN + 32 * MiB;
constexpr size_t WS_EG = WS_MG + 20 * MiB;
constexpr size_t WS_XN = WS_EG + 8 * MiB;
constexpr size_t WS_P = WS_XN + 32 * MiB;
constexpr size_t WS_XG = WS_P;
constexpr size_t WS_HID = WS_XG + (size_t)MOE_MAXROWS * 1024 * 2;
constexpr size_t WS_YEXP = WS_HID + (size_t)MOE_MAXROWS * 512 * 2;
constexpr size_t WS_DT = WS_P + 216 * MiB;
constexpr size_t WS_UH = WS_DT + 1 * MiB;
constexpr size_t WS_HLOC = WS_UH + 20 * MiB;
constexpr size_t WS_YCAT = WS_HLOC + 8 * MiB;
constexpr size_t WS_SST = WS_YCAT + 64 * MiB;
constexpr size_t WS_MOE = WS_SST + 32 * MiB;
constexpr size_t WS_ASUM = WS_MOE + 1 * MiB;
constexpr size_t WS_END = WS_ASUM + 64 * 1024;
static_assert(WS_YEXP + (size_t)MOE_MAXROWS * 1024 * 2 <= WS_DT, "MoE overlay fits in P");
constexpr int CW_BAR = 4096;
constexpr int CW_CNT = 16384;

constexpr int NWAVES = 8, NTHR = 512;
constexpr int LDS_BYTES = 163840;
constexpr int RING_BYTES = 131072;
constexpr int MISC_OFF = 160 * 1024 - 256;

__device__ __forceinline__ unsigned f2bf(float f) { unsigned u = __builtin_bit_cast(unsigned, f); return (u + 0x7fffu + ((u >> 16) & 1u)) >> 16; }
typedef float f32x2_t __attribute__((ext_vector_type(2)));
typedef __bf16 bf16x2_t __attribute__((ext_vector_type(2)));
__device__ __forceinline__ unsigned pk2(float lo, float hi) { f32x2_t v = {lo, hi}; bf16x2_t b = __builtin_convertvector(v, bf16x2_t); return __builtin_bit_cast(unsigned, b); }
__device__ __forceinline__ float bf2f(unsigned b) { return __builtin_bit_cast(float, b << 16); }
__device__ __forceinline__ float bflo(unsigned w) { return __builtin_bit_cast(float, w << 16); }
__device__ __forceinline__ float bfhi(unsigned w) { return __builtin_bit_cast(float, w & 0xffff0000u); }
#define WS_DPP(v, ctrl, rmask) __builtin_bit_cast(float, __builtin_amdgcn_update_dpp(0, __builtin_bit_cast(int, v), ctrl, rmask, 0xF, false))
__device__ __forceinline__ float wave_sum(float v) {
    v += WS_DPP(v, 0xB1, 0xF);
    v += WS_DPP(v, 0x4E, 0xF);
    v += WS_DPP(v, 0x141, 0xF);
    v += WS_DPP(v, 0x140, 0xF);
    v += WS_DPP(v, 0x142, 0xA);
    v += WS_DPP(v, 0x143, 0xC);
    return __builtin_bit_cast(float, __builtin_amdgcn_readlane(__builtin_bit_cast(int, v), 63));
}
__device__ __forceinline__ float frcp(float x) { return __builtin_amdgcn_rcpf(x); }
__device__ __forceinline__ float sigmoidf_(float x) { return frcp(1.0f + __expf(-x)); }
__device__ __forceinline__ float siluf_(float x) { return x * frcp(1.0f + __expf(-x)); }
__device__ __forceinline__ float gelu_tanh_(float x) { const float u = 0.7978845608f * (x + 0.044715f * x * x * x); return x * frcp(1.0f + __expf(-2.0f * u)); }
__device__ __forceinline__ float softplusf_(float x) { return x > 20.f ? x : log1pf(__expf(x)); }

typedef float f32x16 __attribute__((ext_vector_type(16)));
#define MFMA32(a, b, c) __builtin_amdgcn_mfma_f32_32x32x16_bf16((a), (b), (c), 0, 0, 0)
__device__ __forceinline__ unsigned cvtpk(float lo, float hi) { f32x2_t v = {lo, hi}; bf16x2_t b = __builtin_convertvector(v, bf16x2_t); return __builtin_bit_cast(unsigned, b); }
__device__ __forceinline__ void pin_frag(bf16x8& f) { u32x4 t = __builtin_bit_cast(u32x4, f); asm volatile("s_nop 1" : "+v"(t)); f = __builtin_bit_cast(bf16x8, t); }
__device__ __forceinline__ void settle_acc(f32x16& x) { asm volatile("s_nop 15\n\ts_nop 3" : "+v"(x)); }
__device__ __forceinline__ bf16x8 pack8v(const float (&v)[8]) { u32x4 p; p.x = cvtpk(v[0], v[1]); p.y = cvtpk(v[2], v[3]); p.z = cvtpk(v[4], v[5]); p.w = cvtpk(v[6], v[7]); return __builtin_bit_cast(bf16x8, p); }

#define XB_TMO      128
#define XB_XCNT(j)  (256  + 64 * (j))
#define XB_XSUB(j)  (1280 + 64 * (j))
#define XB_XGEN(j)  (2304 + 64 * (j))
#define XB_TOP      3328
#define XB_TOPGEN   3392
#define XCD_BAR_WORDS 3456
#define XB_SPIN_CAP (1u << 18)
__device__ __forceinline__ unsigned xb_ld(unsigned* p)              { return __hip_atomic_load(p, __ATOMIC_RELAXED, __HIP_MEMORY_SCOPE_AGENT); }
__device__ __forceinline__ unsigned xb_add(unsigned* p, unsigned v) { return __hip_atomic_fetch_add(p, v, __ATOMIC_RELAXED, __HIP_MEMORY_SCOPE_AGENT); }
__device__ __forceinline__ unsigned xb_xcc_id() { return (unsigned)__builtin_amdgcn_s_getreg((3 << 11) | 20) & 0xFu; }
#define XB_SPIN(cond, bar) do { unsigned _sp = 0; while (cond) { __builtin_amdgcn_s_sleep(1); \
    if ((++_sp & 255u) == 0u) { if (xb_ld(&(bar)[XB_TMO])) break; if (_sp > XB_SPIN_CAP) { atomicAdd(&(bar)[XB_TMO], 1u); break; } } } } while (0)
struct XcdBarrier { unsigned* bar; unsigned x; volatile LAS unsigned* st; };
__device__ __forceinline__ XcdBarrier xcd_barrier_post(unsigned* bar, volatile LAS unsigned* st) {
    XcdBarrier b; b.bar = bar; b.x = xb_xcc_id(); b.st = st;
    if (threadIdx.x == 0) (void)xb_add(&bar[XB_XCNT(b.x)], 1u);
    return b;
}
__device__ __forceinline__ void xcd_barrier_complete(unsigned* bar, unsigned x, unsigned& nloc, unsigned& nx) {
    const unsigned G = gridDim.x * gridDim.y * gridDim.z;
    unsigned sum, cnt, mine, sp = 0u;
    for (;;) {
        sum = 0u; cnt = 0u; mine = 0u;
#pragma unroll
        for (unsigned j = 0; j < 16; ++j) { const unsigned c = xb_ld(&bar[XB_XCNT(j)]); sum += c; cnt += (c > 0u) ? 1u : 0u; mine = (j == x) ? c : mine; }
        if (sum == G) break;
        __builtin_amdgcn_s_sleep(1);
        if ((++sp & 255u) == 0u) { if (xb_ld(&bar[XB_TMO])) break; if (sp > XB_SPIN_CAP) { atomicAdd(&bar[XB_TMO], 1u); break; } }
    }
    nloc = mine > 0u ? mine : 1u; nx = cnt > 0u ? cnt : 1u;
}
__device__ __forceinline__ void xcd_barrier(const XcdBarrier& b) {
    asm volatile("s_waitcnt vmcnt(0)" ::: "memory");
    __syncthreads();
    if (threadIdx.x == 0) {
        unsigned* bar = b.bar;
        __builtin_amdgcn_s_waitcnt(0);
        unsigned nloc = b.st[0], nx = b.st[1];
        if (nloc == 0u) { xcd_barrier_complete(bar, b.x, nloc, nx); b.st[0] = nloc; b.st[1] = nx; }
        const unsigned old = xb_add(&bar[XB_XSUB(b.x)], 1u);
        const unsigned gen = old / nloc;
        if (old + 1u == (gen + 1u) * nloc) {
            __builtin_amdgcn_fence(__ATOMIC_RELEASE, "agent");
            asm volatile("s_waitcnt vmcnt(0)" ::: "memory");
            const unsigned og = xb_add(&bar[XB_TOP], 1u);
            const unsigned tg = og / nx;
            if (og + 1u == (tg + 1u) * nx) xb_add(&bar[XB_TOPGEN], 1u);
            else XB_SPIN(xb_ld(&bar[XB_TOPGEN]) == tg, bar);
            __builtin_amdgcn_fence(__ATOMIC_ACQUIRE, "agent");
            xb_add(&bar[XB_XGEN(b.x)], 1u);
            asm volatile("s_waitcnt vmcnt(0)" ::: "memory");
        } else {
            XB_SPIN(xb_ld(&bar[XB_XGEN(b.x)]) == gen, bar);
            __builtin_amdgcn_fence(__ATOMIC_ACQUIRE, "agent");
            asm volatile("s_waitcnt vmcnt(0)" ::: "memory");
        }
    }
    __syncthreads();
}

namespace pg8 {
constexpr int BM = 256, BK = 64, HALF = 128, HTB = HALF * BK * 2, STAGE_BYTES = 8 * HTB, NXCD = 8, WGM = 8;
__host__ __device__ __forceinline__ int lds_byte(int r, int c) { const int st = (r >> 4) * 2 + (c >> 5), rr = r & 15, cc = c & 31, ob = rr * 64 + cc * 2; return st * 1024 + (ob ^ (((ob >> 9) & 1) << 5)); }
__host__ __device__ __forceinline__ void stage_rc(int b, int& R, int& C) { const int st = b / 1024, sb = b % 1024, swz = sb ^ (((sb >> 9) & 1) << 5); R = (st >> 1) * 16 + swz / 64; C = (st & 1) * 32 + (swz % 64) / 2; }
__host__ __device__ __forceinline__ int perm32(int rho) { const int n = rho >> 4, i = rho & 15; return 8 * (i >> 2) + 4 * n + (i & 3); }

struct Unit { const char* A; const char* B; int nt; int pm, pn, aux; };

__device__ __forceinline__ void tile_order(int L, int nM, int nN, int& pm, int& pn) {
    const int nwg = nM * nN; int wgid = L;
    { const int q = nwg / NXCD, r = nwg % NXCD, xcd = wgid % NXCD, off = wgid / NXCD; wgid = (xcd < r ? xcd * (q + 1) : r * (q + 1) + (xcd - r) * q) + off; }
    const int nig = WGM * nN, gid = wgid / nig, fm = gid * WGM, gsz = (nM - fm) < WGM ? (nM - fm) : WGM;
    pm = fm + ((wgid % nig) % gsz); pn = (wgid % nig) / gsz;
}
__device__ __forceinline__ unsigned cvt_pk_bf16(float lo, float hi) { unsigned r; asm volatile("v_cvt_pk_bf16_f32 %0, %1, %2" : "=v"(r) : "v"(lo), "v"(hi)); return r; }
__device__ __forceinline__ u32x4 pack8(const f32x4 v0, const f32x4 v1) { u32x4 w; w.x = cvt_pk_bf16(v0[0], v0[1]); w.y = cvt_pk_bf16(v0[2], v0[3]); w.z = cvt_pk_bf16(v1[0], v1[1]); w.w = cvt_pk_bf16(v1[2], v1[3]); return w; }

template <unsigned lda, unsigned ldb, class Epi, class Sched>
__device__ __forceinline__ void gemm_phase(const int tid, LAS unsigned char* lds, const Sched& S, const Epi& E) {
    const int wid = __builtin_amdgcn_readfirstlane(tid >> 6), lane = tid & 63, wr = wid >> 2, wc = wid & 3, fr = lane & 15, fq = lane >> 4;
    unsigned voffA[2], voffB[2];
#pragma unroll
    for (int i = 0; i < 2; ++i) { int R, C; stage_rc(tid * 16 + i * 8192, R, C); const int Rb = Epi::PERM ? ((R & ~31) + perm32(R & 31)) : R;
        voffA[i] = (unsigned)R * lda + (unsigned)C * 2u; voffB[i] = (unsigned)Rb * ldb + (unsigned)C * 2u; }
    const size_t kstep = (size_t)(BK * 2);
    const size_t hstepA = (size_t)HALF * lda, hstepB = (size_t)HALF * ldb;
    const unsigned ldsw = (unsigned)wid * 1024u;
    const int aoff = lds_byte(wr * 64 + fr, fq * 8), boff = lds_byte(wc * 32 + fr, fq * 8);
#define PG8_SA(b, h) (((b) * 2 + (h)) * HTB)
#define PG8_SB(b, h) ((4 + (b) * 2 + (h)) * HTB)
#define PG8_STAGE(bufoff, gbase, voff) do { const char* _gb = (const char*)(gbase); asm volatile("" : "+s"(_gb)); _Pragma("unroll") for (int _i = 0; _i < 2; ++_i) \
        __builtin_amdgcn_global_load_lds((const unsigned*)(_gb + (voff)[_i]), (LAS unsigned*)(lds + (bufoff) + ldsw + _i * 8192), 16, 0, 0); } while (0)
#define PG8_LDA(dst, b, h) do { _Pragma("unroll") for (int m = 0; m < 4; ++m) _Pragma("unroll") for (int k = 0; k < 2; ++k) dst[m][k] = *(const LAS bf16x8*)(lds + PG8_SA(b, h) + aoff + m * 2048 + k * 1024); } while (0)
#define PG8_LDB(dst, b, h) do { _Pragma("unroll") for (int n = 0; n < 2; ++n) _Pragma("unroll") for (int k = 0; k < 2; ++k) dst[n][k] = *(const LAS bf16x8*)(lds + PG8_SB(b, h) + boff + n * 2048 + k * 1024); } while (0)
#define PG8_MMA(ai, bj, At, Bt) do { __builtin_amdgcn_s_setprio(1); _Pragma("unroll") for (int m = 0; m < 4; ++m) _Pragma("unroll") for (int n = 0; n < 2; ++n) _Pragma("unroll") for (int k = 0; k < 2; ++k) \
        acc[ai][bj][m][n] = __builtin_amdgcn_mfma_f32_16x16x32_bf16(Bt[n][k], At[m][k], acc[ai][bj][m][n], 0, 0, 0); __builtin_amdgcn_s_setprio(0); } while (0)
#define PG8_WAIT_V(n) asm volatile("s_waitcnt vmcnt(" #n ")" ::: "memory")
#define PG8_WAIT_L(n) asm volatile("s_waitcnt lgkmcnt(" #n ")" ::: "memory")
#define PG8_BAR __builtin_amdgcn_s_barrier()
#define PG8_SCHED __builtin_amdgcn_sched_barrier(0)
    Unit cur, nxt; int ui = 0;
    if (!S.next(0, cur)) return;
    f32x4 acc[2][2][4][2];
#pragma unroll
    for (int a = 0; a < 2; ++a)
#pragma unroll
        for (int b = 0; b < 2; ++b)
#pragma unroll
            for (int m = 0; m < 4; ++m)
#pragma unroll
                for (int n = 0; n < 2; ++n) acc[a][b][m][n] = (f32x4){0.f, 0.f, 0.f, 0.f};
    bf16x8 At[4][2], B0[2][2], B1[2][2];
    const char* cA = cur.A; const char* cB = cur.B;
    PG8_STAGE(PG8_SB(0, 0), cB, voffB); PG8_STAGE(PG8_SB(0, 1), cB + hstepB, voffB); PG8_STAGE(PG8_SA(0, 0), cA, voffA); PG8_STAGE(PG8_SA(0, 1), cA + hstepA, voffA);
    if (wr == 1) PG8_BAR;
    PG8_WAIT_V(2); PG8_BAR;
    PG8_STAGE(PG8_SB(1, 0), cB + kstep, voffB); PG8_STAGE(PG8_SA(1, 0), cA + kstep, voffA); PG8_STAGE(PG8_SB(1, 1), cB + hstepB + kstep, voffB);
    PG8_WAIT_V(6); PG8_BAR;
    for (;;) {
        const bool has_next = S.next(ui + 1, nxt);
        const char* nA = has_next ? nxt.A : cA; const char* nB = has_next ? nxt.B : cB;
        const int nt = cur.nt;
        for (int t = 0; t < nt; t += 2) {
            const bool last = (t == nt - 2);
            const char* a1 = cA + (size_t)(t + 1) * kstep;
            const char* a2 = last ? nA : cA + (size_t)(t + 2) * kstep; const char* b2 = last ? nB : cB + (size_t)(t + 2) * kstep;
            const char* a3 = a2 + kstep; const char* b3 = b2 + kstep;
            PG8_LDB(B0, 0, 0); PG8_LDB(B1, 0, 1); PG8_SCHED; PG8_LDA(At, 0, 0); PG8_STAGE(PG8_SA(1, 1), a1 + hstepA, voffA);
            PG8_WAIT_V(8); PG8_WAIT_L(0); PG8_BAR; PG8_MMA(0, 0, At, B0); PG8_MMA(0, 1, At, B1); PG8_BAR; PG8_SCHED;
            PG8_LDA(At, 0, 1); PG8_STAGE(PG8_SB(0, 0), b2, voffB); PG8_STAGE(PG8_SB(0, 1), b2 + hstepB, voffB); PG8_STAGE(PG8_SA(0, 0), a2, voffA);
            PG8_WAIT_V(8); PG8_WAIT_L(0); PG8_BAR; PG8_MMA(1, 0, At, B0); PG8_MMA(1, 1, At, B1); PG8_BAR; PG8_SCHED;
            PG8_LDB(B0, 1, 0); PG8_LDB(B1, 1, 1); PG8_SCHED; PG8_LDA(At, 1, 0); PG8_STAGE(PG8_SA(0, 1), a2 + hstepA, voffA);
            PG8_WAIT_V(8); PG8_WAIT_L(0); PG8_BAR; PG8_MMA(0, 0, At, B0); PG8_MMA(0, 1, At, B1); PG8_BAR; PG8_SCHED;
            PG8_LDA(At, 1, 1); PG8_STAGE(PG8_SB(1, 0), b3, voffB); PG8_STAGE(PG8_SB(1, 1), b3 + hstepB, voffB); PG8_STAGE(PG8_SA(1, 0), a3, voffA);
            PG8_WAIT_V(8); PG8_WAIT_L(0); PG8_BAR; PG8_MMA(1, 0, At, B0); PG8_MMA(1, 1, At, B1); PG8_BAR; PG8_SCHED;
            if constexpr (Epi::HAS_MID) { if (t + 2 == 8 || t + 2 == 16) { E.mid(acc, cur, t + 2, wr, wc, fr, fq); PG8_SCHED; } }
        }
        if (wr == 0) PG8_BAR;
        E(acc, cur, wr, wc, fr, fq);
        if (!has_next) break;
#pragma unroll
        for (int a = 0; a < 2; ++a)
#pragma unroll
            for (int b = 0; b < 2; ++b)
#pragma unroll
                for (int m = 0; m < 4; ++m)
#pragma unroll
                    for (int n = 0; n < 2; ++n) acc[a][b][m][n] = (f32x4){0.f, 0.f, 0.f, 0.f};
        cur = nxt; cA = nA; cB = nB; ++ui;
        if (wr == 1) PG8_BAR;
    }
    PG8_WAIT_V(0);
    PG8_BAR;
#undef PG8_SA
#undef PG8_SB
#undef PG8_STAGE
#undef PG8_LDA
#undef PG8_LDB
#undef PG8_MMA
#undef PG8_WAIT_V
#undef PG8_WAIT_L
#undef PG8_BAR
#undef PG8_SCHED
}
}

struct Frame {
    LAS unsigned char* lds;
    volatile LAS unsigned* MISC;
    unsigned* ctl;
    int tid, lane, wave, G, bid;
    const float* const __attribute__((address_space(4)))* in;
    float* out; unsigned char* ws;
};
enum { IN_X = 0, IN_NORM1, IN_WIN, IN_BGATE, IN_LRE, IN_LIM, IN_BRE, IN_BIM, IN_CRE, IN_CIM, IN_S5D, IN_LOGDT, IN_GLU1, IN_GLU2, IN_QG, IN_KG, IN_SINK,
       IN_CONVW, IN_CONVB, IN_DTB, IN_ALOG, IN_SSDD, IN_SSDG, IN_PS5, IN_PATTN, IN_PSSD, IN_WOUT, IN_NORM2, IN_WRG, IN_BRG, IN_WRE, IN_BRE_, IN_EG, IN_EU, IN_ED, N_INPUTS };

#define LDS_WAIT() asm volatile("s_waitcnt lgkmcnt(0)" ::: "memory")
#define VM_WAIT() asm volatile("s_waitcnt vmcnt(0)" ::: "memory")

using pg8::Unit; using pg8::pack8;
struct EpiProj {
    static constexpr bool PERM = true, HAS_MID = false;
    unsigned char* ws; const float* bgate;
    __device__ __forceinline__ void operator()(const f32x4 (&acc)[2][2][4][2], const Unit& u, int wr, int wc, int fr, int fq) const {
        bf16_t* P = (bf16_t*)(ws + WS_P); bf16_t* UH = (bf16_t*)(ws + WS_UH); float* DT = (float*)(ws + WS_DT);
        const int row0 = u.pm * 256 + wr * 64 + fr;
        if (u.pn < 2) {
#pragma unroll
            for (int ai = 0; ai < 2; ++ai)
#pragma unroll
                for (int m = 0; m < 4; ++m) { const int row = row0 + ai * 128 + m * 16, r = row >> 5, s = row & 31;
#pragma unroll
                    for (int bj = 0; bj < 2; ++bj) { const int col = u.pn * 256 + bj * 128 + wc * 32 + 8 * fq, g = col >> 4, c0 = col & 15;
                        *(u32x4*)(UH + ((size_t)(g * S5_ROWS + r) * S5_K + 128 + s * 16 + c0)) = pack8(acc[ai][bj][m][0], acc[ai][bj][m][1]); } }
        } else {
            const int colb = u.pn * 256 + wc * 32 + 8 * fq;
            f32x4 bv[2][2];
#pragma unroll
            for (int bj = 0; bj < 2; ++bj)
#pragma unroll
                for (int n = 0; n < 2; ++n) bv[bj][n] = (u.pn >= 15) ? *(const f32x4*)(bgate + (colb - C_G) + bj * 128 + 4 * n) : (f32x4){0.f, 0.f, 0.f, 0.f};
#pragma unroll
            for (int ai = 0; ai < 2; ++ai)
#pragma unroll
                for (int m = 0; m < 4; ++m) { const int row = row0 + ai * 128 + m * 16;
#pragma unroll
                    for (int bj = 0; bj < 2; ++bj) { f32x4 v0 = acc[ai][bj][m][0] + bv[bj][0], v1 = acc[ai][bj][m][1] + bv[bj][1];
                        if (u.pn >= 15) {
#pragma unroll
                            for (int j = 0; j < 4; ++j) { v0[j] = fmaxf(sigmoidf_(v0[j]), 1e-30f); v1[j] = fmaxf(sigmoidf_(v1[j]), 1e-30f); } }
                        *(u32x4*)(P + (size_t)row * NINP + colb + bj * 128) = pack8(v0, v1); }
                    if (u.pn == 14 && wc == 0 && fq < 2) { float* d = DT + (size_t)row * 16 + 8 * fq; *(f32x4*)d = acc[ai][0][m][0]; *(f32x4*)(d + 4) = acc[ai][0][m][1]; } }
        }
    }
};
struct EpiHloc {
    static constexpr bool PERM = false, HAS_MID = false;
    float* H;
    __device__ __forceinline__ void operator()(const f32x4 (&acc)[2][2][4][2], const Unit& u, int wr, int wc, int fr, int fq) const {
#pragma unroll
        for (int ai = 0; ai < 2; ++ai)
#pragma unroll
            for (int m = 0; m < 4; ++m) { const int r = u.pm * 256 + ai * 128 + wr * 64 + m * 16 + fr; float* rowp = H + ((size_t)(u.aux * S5_ROWS + r) * 128) + wc * 32 + 4 * fq;
#pragma unroll
                for (int n = 0; n < 2; ++n) *(f32x4*)(rowp + 16 * n) = acc[ai][0][m][n]; }
    }
};
struct EpiS5Y {
    static constexpr bool PERM = true, HAS_MID = false;
    bf16_t* Y;
    __device__ __forceinline__ void operator()(const f32x4 (&acc)[2][2][4][2], const Unit& u, int wr, int wc, int fr, int fq) const {
#pragma unroll
        for (int ai = 0; ai < 2; ++ai)
#pragma unroll
            for (int m = 0; m < 4; ++m) { const int r = u.pm * 256 + ai * 128 + wr * 64 + m * 16 + fr;
#pragma unroll
                for (int bj = 0; bj < 2; ++bj) { const int n0 = u.pn * 256 + bj * 128 + wc * 32 + 8 * fq, t = n0 >> 4, c0 = n0 & 15;
                    f32x4 v0 = acc[ai][bj][m][0], v1 = acc[ai][bj][m][1];
#pragma unroll
                    for (int j = 0; j < 4; ++j) { v0[j] = gelu_tanh_(v0[j]); v1[j] = gelu_tanh_(v1[j]); }
                    *(u32x4*)(Y + ((size_t)(r * S5_TC + t) * 512 + u.aux * 16 + c0)) = pack8(v0, v1); } }
    }
};
struct EpiGlu {
    static constexpr bool PERM = true, HAS_MID = false;
    bf16_t* Y;
    __device__ __forceinline__ void operator()(const f32x4 (&acc)[2][2][4][2], const Unit& u, int wr, int wc, int fr, int fq) const {
#pragma unroll
        for (int ai = 0; ai < 2; ++ai)
#pragma unroll
            for (int m = 0; m < 4; ++m) { const int row = u.pm * 256 + ai * 128 + wr * 64 + m * 16 + fr;
                f32x4 v0 = acc[ai][0][m][0], v1 = acc[ai][0][m][1]; const f32x4 g0 = acc[ai][1][m][0], g1 = acc[ai][1][m][1];
#pragma unroll
                for (int j = 0; j < 4; ++j) { v0[j] *= sigmoidf_(g0[j]); v1[j] *= sigmoidf_(g1[j]); }
                *(u32x4*)(Y + (size_t)row * 2048 + u.pn * 128 + wc * 32 + 8 * fq) = pack8(v0, v1); }
    }
};
struct EpiSwiGlu {
    static constexpr bool PERM = true, HAS_MID = false;
    bf16_t* Y; const float* RSG;
    __device__ __forceinline__ void operator()(const f32x4 (&acc)[2][2][4][2], const Unit& u, int wr, int wc, int fr, int fq) const {
#pragma unroll
        for (int ai = 0; ai < 2; ++ai)
#pragma unroll
            for (int m = 0; m < 4; ++m) { const int row = u.pm * 256 + ai * 128 + wr * 64 + m * 16 + fr;
                f32x4 v0 = acc[ai][0][m][0], v1 = acc[ai][0][m][1]; const f32x4 g0 = acc[ai][1][m][0], g1 = acc[ai][1][m][1]; const float rr = 1.f;
#pragma unroll
                for (int j = 0; j < 4; ++j) { v0[j] = siluf_(v0[j] * rr) * (g0[j] * rr); v1[j] = siluf_(v1[j] * rr) * (g1[j] * rr); }
                *(u32x4*)(Y + (size_t)row * 512 + u.pn * 128 + wc * 32 + 8 * fq) = pack8(v0, v1); }
    }
};
struct EpiPlainBf16 {
    static constexpr bool PERM = true, HAS_MID = false;
    bf16_t* O;
    __device__ __forceinline__ void operator()(const f32x4 (&acc)[2][2][4][2], const Unit& u, int wr, int wc, int fr, int fq) const {
#pragma unroll
        for (int ai = 0; ai < 2; ++ai)
#pragma unroll
            for (int m = 0; m < 4; ++m) { const int row = u.pm * 256 + ai * 128 + wr * 64 + m * 16 + fr;
#pragma unroll
                for (int bj = 0; bj < 2; ++bj) *(u32x4*)(O + (size_t)row * 1024 + u.pn * 256 + bj * 128 + wc * 32 + 8 * fq) = pack8(acc[ai][bj][m][0], acc[ai][bj][m][1]); }
    }
};
struct EpiMerged {
    static constexpr bool PERM = true, HAS_MID = true;
    unsigned char* ws;
    __device__ __forceinline__ static float lclamp(float l) { return fminf(fmaxf(l, -30.f), 30.f); }
    __device__ __forceinline__ void mid(f32x4 (&acc)[2][2][4][2], const Unit& u, int kt, int wr, int wc, int fr, int fq) const {
        const int br = (kt == 8) ? 0 : 1; const bf16_t* P = (const bf16_t*)(ws + WS_P);
#pragma unroll
        for (int ai = 0; ai < 2; ++ai)
#pragma unroll
            for (int m = 0; m < 4; ++m) { const int row = u.pm * 256 + ai * 128 + wr * 64 + m * 16 + fr;
#pragma unroll
                for (int bj = 0; bj < 2; ++bj) { const bf16_t* gp = P + (size_t)row * NINP + C_G + br * 1024 + u.pn * 256 + bj * 128 + wc * 32 + 8 * fq;
                    const u32x4 la = *(const u32x4*)gp, lb = *(const u32x4*)(gp + 1024);
#pragma unroll
                    for (int j = 0; j < 4; ++j) { const unsigned wa = la[j], wb = lb[j];
                        const float r0 = bflo(wa) * frcp(bflo(wb)), r1 = bfhi(wa) * frcp(bfhi(wb));
                        if (j < 2) { acc[ai][bj][m][0][2 * j] *= r0; acc[ai][bj][m][0][2 * j + 1] *= r1; } else { acc[ai][bj][m][1][2 * j - 4] *= r0; acc[ai][bj][m][1][2 * j - 3] *= r1; } } }
                if (m == 3) asm volatile("" ::: "memory"); }
    }
    __device__ __forceinline__ void operator()(const f32x4 (&acc)[2][2][4][2], const Unit& u, int wr, int wc, int fr, int fq) const {
        const bf16_t* P = (const bf16_t*)(ws + WS_P); bf16_t* O = (bf16_t*)(ws + WS_XN);
#pragma unroll
        for (int ai = 0; ai < 2; ++ai)
#pragma unroll
            for (int m = 0; m < 4; ++m) { const int row = u.pm * 256 + ai * 128 + wr * 64 + m * 16 + fr;
#pragma unroll
                for (int bj = 0; bj < 2; ++bj) { const int col = u.pn * 256 + bj * 128 + wc * 32 + 8 * fq;
                    const u32x4 lc = *(const u32x4*)(P + (size_t)row * NINP + C_G + 2048 + col);
                    f32x4 v0 = acc[ai][bj][m][0], v1 = acc[ai][bj][m][1];
                    v0[0] *= bflo(lc[0]); v0[1] *= bfhi(lc[0]); v0[2] *= bflo(lc[1]); v0[3] *= bfhi(lc[1]);
                    v1[0] *= bflo(lc[2]); v1[1] *= bfhi(lc[2]); v1[2] *= bflo(lc[3]); v1[3] *= bfhi(lc[3]);
                    *(u32x4*)(O + (size_t)row * 1024 + col) = pack8(v0, v1); }
                if (m == 3) asm volatile("" ::: "memory"); }
    }
};
struct EpiResid {
    static constexpr bool PERM = false, HAS_MID = false;
    const float* resid; float* out;
    __device__ __forceinline__ void operator()(const f32x4 (&acc)[2][2][4][2], const Unit& u, int wr, int wc, int fr, int fq) const {
#pragma unroll
        for (int ai = 0; ai < 2; ++ai)
#pragma unroll
            for (int m = 0; m < 4; ++m) { const size_t off = (size_t)(u.pm * 256 + ai * 128 + wr * 64 + m * 16 + fr) * 1024 + u.pn * 256 + wc * 32 + 4 * fq;
#pragma unroll
                for (int bj = 0; bj < 2; ++bj)
#pragma unroll
                    for (int n = 0; n < 2; ++n) { const f32x4 rv = *(const f32x4*)(resid + off + bj * 128 + n * 16); *(f32x4*)(out + off + bj * 128 + n * 16) = rv + acc[ai][bj][m][n]; } }
    }
};

template <unsigned lda, unsigned ldb, int nM, int nN, int NT>
struct SchedDense {
    const char* A; const char* B; int G, c;
    __device__ __forceinline__ bool next(int i, Unit& u) const {
        const int L = i * G + c; if (L >= nM * nN) return false;
        int pm, pn; pg8::tile_order(L, nM, nN, pm, pn);
        u.A = A + (size_t)pm * 256 * lda; u.B = B + (size_t)pn * 256 * ldb; u.nt = NT; u.pm = pm; u.pn = pn; u.aux = 0; return true;
    }
};
struct SchedS5P1 {
    const char* UH; const char* EG; int G, c;
    __device__ __forceinline__ bool next(int i, Unit& u) const {
        const int L = i * G + c; if (L >= 64) return false;
        const int g = L >> 1, pm = L & 1;
        u.A = UH + ((size_t)(g * S5_ROWS + pm * 256) * S5_K + 128) * 2; u.B = EG + (size_t)g * 256 * 512 * 2; u.nt = 8; u.pm = pm; u.pn = 0; u.aux = g; return true;
    }
};
struct SchedS5Main {
    const char* UH; const char* MG; int G, c;
    __device__ __forceinline__ bool next(int i, Unit& u) const {
        const int L = i * G + c; if (L >= 128) return false;
        const int g = L >> 2, pm = (L >> 1) & 1, pn = L & 1;
        u.A = UH + (size_t)(g * S5_ROWS + pm * 256) * S5_K * 2; u.B = MG + (size_t)(g * S5_N + pn * 256) * S5_K * 2; u.nt = 2 + 4 * (pn + 1); u.pm = pm; u.pn = pn; u.aux = g; return true;
    }
};
template <unsigned lda, size_t bexp  , size_t btile  , int NT>
struct SchedMoe {
    const char* A; const char* B; int ntiles, G, c; const volatile LAS int* tile_e;
    __device__ __forceinline__ bool next(int i, Unit& u) const {
        const int L = i * G + c; if (L >= ntiles * 4) return false;
        int pm, pn; pg8::tile_order(L, ntiles, 4, pm, pn);
        const int e = __builtin_amdgcn_readfirstlane(tile_e[pm]);
        u.A = A + (size_t)pm * 256 * lda; u.B = B + (size_t)e * bexp + (size_t)pn * btile; u.nt = NT; u.pm = pm; u.pn = pn; u.aux = e; return true;
    }
};

__device__ __forceinline__ void transpose_item(const float* W, int ldw, int ncols, bf16_t* WT, int ldt, int kofs, int mode, int p0, int p1, LAS float* scr, int k0, int n0, int lane) {
    float wv[32];
#pragma unroll
    for (int i = 0; i < 32; ++i) { const int kk = 2 * i + (lane >> 5), n = n0 + (lane & 31); wv[i] = (n < ncols) ? W[(size_t)(k0 + kk) * ldw + n] : 0.f; }
#pragma unroll
    for (int i = 0; i < 32; ++i) { const int kk = 2 * i + (lane >> 5); scr[kk * 33 + (lane & 31)] = wv[i]; }
    LDS_WAIT(); asm volatile("" ::: "memory");
    const int c = lane & 7;
#pragma unroll
    for (int j = 0; j < 4; ++j) { const int nn = (lane >> 3) + 8 * j, n = n0 + nn; const LAS float* s = scr + (8 * c) * 33 + nn;
        u32x4 o; o.x = pk2(s[0 * 33], s[1 * 33]); o.y = pk2(s[2 * 33], s[3 * 33]); o.z = pk2(s[4 * 33], s[5 * 33]); o.w = pk2(s[6 * 33], s[7 * 33]);
        const int drow = (mode == 0) ? n + (n >= p0 ? p1 : 0) : ((n >> 7) * 256 + (n & 127) + 128 * p0);
        if (n < ncols) *(u32x4*)(WT + (size_t)drow * ldt + kofs + k0 + 8 * c) = o; }
    LDS_WAIT(); asm volatile("" ::: "memory");
}
__device__ __forceinline__ void convert_weights(Frame& F, int layer) {
    LAS float* scr = (LAS float*)(F.lds + F.wave * 16384);
    const int gw = F.bid * NWAVES + F.wave, NGW = F.G * NWAVES;
    bf16_t* WIN = (bf16_t*)(F.ws + WS_WIN); bf16_t* WGLU = (bf16_t*)(F.ws + WS_WGLU); bf16_t* PCAT = (bf16_t*)(F.ws + WS_PCAT); bf16_t* WOUT = (bf16_t*)(F.ws + WS_WOUT);
    bf16_t* EGU = (bf16_t*)(F.ws + WS_EGU); bf16_t* EDN = (bf16_t*)(F.ws + WS_EDN);
    constexpr int I_WIN = 16 * 209, I_GLU = 8 * 16, I_P5 = 8 * 32, I_PS = 16 * 32, I_WO = 16 * 32, I_EG = 32 * 256, I_ED = 32 * 256;
    constexpr int NITEMS = I_WIN + 2 * I_GLU + 2 * I_P5 + I_PS + I_WO + 2 * I_EG + I_ED;
    for (int it = gw; it < NITEMS; it += NGW) {
        int r = it;
        if (r < I_WIN) { transpose_item(F.in[IN_WIN] + (size_t)layer * DM * NIN, NIN, NIN, WIN, DM, 0, 0, 3600, 240, scr, 64 * (r / 209), 32 * (r % 209), F.lane); continue; } r -= I_WIN;
        if (r < I_GLU) { transpose_item(F.in[IN_GLU1] + (size_t)layer * 512 * 512, 512, 512, WGLU, 512, 0, 1, 0, 0, scr, 64 * (r / 16), 32 * (r % 16), F.lane); continue; } r -= I_GLU;
        if (r < I_GLU) { transpose_item(F.in[IN_GLU2] + (size_t)layer * 512 * 512, 512, 512, WGLU, 512, 0, 1, 1, 0, scr, 64 * (r / 16), 32 * (r % 16), F.lane); continue; } r -= I_GLU;
        if (r < I_P5) { transpose_item(F.in[IN_PS5] + (size_t)layer * 512 * 1024, 1024, 1024, PCAT, 2048, 0, 0, 1 << 30, 0, scr, 64 * (r / 32), 32 * (r % 32), F.lane); continue; } r -= I_P5;
        if (r < I_P5) { transpose_item(F.in[IN_PATTN] + (size_t)layer * 512 * 1024, 1024, 1024, PCAT, 2048, 512, 0, 1 << 30, 0, scr, 64 * (r / 32), 32 * (r % 32), F.lane); continue; } r -= I_P5;
        if (r < I_PS) { transpose_item(F.in[IN_PSSD] + (size_t)layer * 1024 * 1024, 1024, 1024, PCAT, 2048, 1024, 0, 1 << 30, 0, scr, 64 * (r / 32), 32 * (r % 32), F.lane); continue; } r -= I_PS;
        if (r < I_WO) { transpose_item(F.in[IN_WOUT] + (size_t)layer * 1024 * 1024, 1024, 1024, WOUT, 1024, 0, 0, 1 << 30, 0, scr, 64 * (r / 32), 32 * (r % 32), F.lane); continue; } r -= I_WO;
        if (r < I_EG) { const int e = r >> 8, q = r & 255; transpose_item(F.in[IN_EG] + ((size_t)layer * 32 + e) * 1024 * 512, 512, 512, EGU + (size_t)e * 1024 * 1024, 1024, 0, 1, 0, 0, scr, 64 * (q / 16), 32 * (q % 16), F.lane); continue; } r -= I_EG;
        if (r < I_EG) { const int e = r >> 8, q = r & 255; transpose_item(F.in[IN_EU] + ((size_t)layer * 32 + e) * 1024 * 512, 512, 512, EGU + (size_t)e * 1024 * 1024, 1024, 0, 1, 1, 0, scr, 64 * (q / 16), 32 * (q % 16), F.lane); continue; } r -= I_EG;
        { const int e = r >> 8, q = r & 255; transpose_item(F.in[IN_ED] + ((size_t)layer * 32 + e) * 512 * 1024, 1024, 1024, EDN + (size_t)e * 1024 * 512, 512, 0, 0, 1 << 30, 0, scr, 64 * (q / 32), 32 * (q % 32), F.lane); }
    }
}
__device__ __forceinline__ void sincos_fast(float x, float& s, float& c) {
    const float k = rintf(x * 0.15915494309189535f);
    float r = fmaf(-k, 6.2831854820251465f, x); r = fmaf(-k, -1.7484555e-07f, r);
    s = __sinf(r); c = __cosf(r);
}
__device__ __forceinline__ void sincos_red(float x, float& s, float& c) {
    const float k = rintf(x * 0.15915494309189535f);
    float r = fmaf(-k, 6.2831854820251465f, x); r = fmaf(-k, -1.7484555e-07f, r);
    s = sinf(r); c = cosf(r);
}
__device__ __forceinline__ void s5_build(Frame& F, int layer) {
    LAS float* pw = (LAS float*)F.lds;
    LAS float* Bb = pw + 33 * 64 * 2;
    LAS float* Cc = Bb + 64 * 16 * 2;
    LAS float* Kd = Cc + 16 * 64 * 2;
    bf16_t* MG = (bf16_t*)(F.ws + WS_MG); bf16_t* EG = (bf16_t*)(F.ws + WS_EG);
    for (int w = F.bid; w < 256; w += F.G) {
        const int g = w >> 3, part = w & 7, gi = layer * 32 + g;
        __syncthreads();
        const float dt = __expf(F.in[IN_LOGDT][gi]);
        for (int i = F.tid; i < 33 * 64; i += NTHR) { const int d = i >> 6, p = i & 63; const float lr = F.in[IN_LRE][gi * 64 + p], li = F.in[IN_LIM][gi * 64 + p];
            float s, c; sincos_red((float)d * li * dt, s, c); const float mg = __expf((float)d * lr * dt); pw[2 * i] = mg * c; pw[2 * i + 1] = mg * s; }
        for (int i = F.tid; i < 64 * 16; i += NTHR) { const int p = i >> 4; const float lr = F.in[IN_LRE][gi * 64 + p], li = F.in[IN_LIM][gi * 64 + p];
            float s, c; sincos_red(li * dt, s, c); const float mg = __expf(lr * dt), are = mg * c, aim = mg * s, nr = are - 1.f, den = lr * lr + li * li;
            const float fre = (nr * lr + aim * li) / den, fim = (aim * lr - nr * li) / den;
            const float br = F.in[IN_BRE][(size_t)gi * 1024 + i], bi = F.in[IN_BIM][(size_t)gi * 1024 + i];
            Bb[2 * i] = fre * br - fim * bi; Bb[2 * i + 1] = fre * bi + fim * br; }
        for (int i = F.tid; i < 16 * 64; i += NTHR) { Cc[2 * i] = F.in[IN_CRE][(size_t)gi * 1024 + i]; Cc[2 * i + 1] = F.in[IN_CIM][(size_t)gi * 1024 + i]; }
        __syncthreads();
        { const int d = F.tid >> 4, c = F.tid & 15; float acc[16];
#pragma unroll
          for (int j = 0; j < 16; ++j) acc[j] = 0.f;
          for (int p = 0; p < 64; ++p) { const float cr = Cc[2 * (c * 64 + p)], ci = Cc[2 * (c * 64 + p) + 1], pr = pw[2 * (d * 64 + p)], pi = pw[2 * (d * 64 + p) + 1];
              const float xr = cr * pr - ci * pi, xi = cr * pi + ci * pr;
#pragma unroll
              for (int q = 0; q < 8; ++q) { const f32x4 bb = *(const LAS f32x4*)(Bb + 2 * (p * 16) + 4 * q); acc[2 * q] += xr * bb.x - xi * bb.y; acc[2 * q + 1] += xr * bb.z - xi * bb.w; } }
#pragma unroll
          for (int j = 0; j < 16; ++j) Kd[(d * 16 + c) * 16 + j] = acc[j]; }
        __syncthreads();
        for (int v = F.tid; v < 64 * 80; v += NTHR) { const int n = part * 64 + v / 80, k0 = (v % 80) * 8, t = n >> 4, c = n & 15; float o[8];
            if (k0 < 128) { const int im = k0 >= 64, p0 = k0 & 63;
#pragma unroll
                for (int j = 0; j < 8; ++j) { const int p = p0 + j; const float cr = Cc[2 * (c * 64 + p)], ci = Cc[2 * (c * 64 + p) + 1], pr = pw[2 * ((t + 1) * 64 + p)], pi = pw[2 * ((t + 1) * 64 + p) + 1];
                    o[j] = im ? -(cr * pi + ci * pr) : (cr * pr - ci * pi); }
            } else { const int s = (k0 - 128) >> 4, c0 = (k0 - 128) & 15;
#pragma unroll
                for (int j = 0; j < 8; ++j) { float x = 0.f; if (s <= t) { x = Kd[(t - s) * 256 + c * 16 + c0 + j]; if (s == t && c == c0 + j) x += F.in[IN_S5D][layer * 512 + g * 16 + c]; } o[j] = x; } }
            u32x4 q; q.x = pk2(o[0], o[1]); q.y = pk2(o[2], o[3]); q.z = pk2(o[4], o[5]); q.w = pk2(o[6], o[7]);
            *(u32x4*)(MG + ((size_t)(g * S5_N + n) * S5_K + k0)) = q; }
        for (int v = F.tid; v < 16 * 64; v += NTHR) { const int jr = part * 16 + v / 64, k0 = (v % 64) * 8, im = jr >= 64, p = jr & 63, s = k0 >> 4, c0 = k0 & 15; float o[8];
            const float pr = pw[2 * ((S5_TC - 1 - s) * 64 + p)], pi = pw[2 * ((S5_TC - 1 - s) * 64 + p) + 1];
#pragma unroll
            for (int j = 0; j < 8; ++j) { const float br = Bb[2 * (p * 16 + c0 + j)], bi = Bb[2 * (p * 16 + c0 + j) + 1]; o[j] = im ? (pr * bi + pi * br) : (pr * br - pi * bi); }
            u32x4 q; q.x = pk2(o[0], o[1]); q.y = pk2(o[2], o[3]); q.z = pk2(o[4], o[5]); q.w = pk2(o[6], o[7]);
            *(u32x4*)(EG + ((size_t)(g * 256 + jr) * 512 + k0)) = q; }
    }
    __syncthreads();
}
__device__ __forceinline__ void rms_row_to_bf16(const float* xrow, const float* gain, bf16_t* orow, int lane) {
    const f32x4* xr = (const f32x4*)xrow + lane; const f32x4* gr = (const f32x4*)gain + lane;
    f32x4 v[4]; float s = 0.f;
#pragma unroll
    for (int j = 0; j < 4; ++j) { v[j] = xr[64 * j]; s += (v[j].x * v[j].x + v[j].y * v[j].y) + (v[j].z * v[j].z + v[j].w * v[j].w); }
    const float rstd = __builtin_amdgcn_rsqf(wave_sum(s) * (1.f / DM) + NORM_EPS);
    unsigned long long* o8 = (unsigned long long*)orow + lane;
#pragma unroll
    for (int j = 0; j < 4; ++j) { const f32x4 gv = gr[64 * j]; o8[64 * j] = (unsigned long long)pk2(v[j].x * rstd * gv.x, v[j].y * rstd * gv.y) | ((unsigned long long)pk2(v[j].z * rstd * gv.z, v[j].w * rstd * gv.w) << 32); }
}
__device__ __forceinline__ void rmsnorm_rows(Frame& F, const float* x, const float* gain, bf16_t* o) {
    const int gw = F.bid * NWAVES + F.wave, NGW = F.G * NWAVES;
    for (int m = gw; m < T; m += NGW) rms_row_to_bf16(x + (size_t)m * DM, gain, o + (size_t)m * DM, F.lane);
}

__device__ __forceinline__ void s5_scan(Frame& F, int layer) {
    const float* HL = (const float*)(F.ws + WS_HLOC); bf16_t* UH = (bf16_t*)(F.ws + WS_UH);
    for (int i = (F.G - 1 - F.bid) * NTHR + F.tid; i < BATCH * 32 * 64; i += F.G * NTHR) {
        const int p = i & 63, g = (i >> 6) & 31, b = i >> 11, gi = layer * 32 + g;
        const float dt = __expf(F.in[IN_LOGDT][gi]), lr = F.in[IN_LRE][gi * 64 + p], li = F.in[IN_LIM][gi * 64 + p];
        float s, c; sincos_red((float)S5_TC * li * dt, s, c); const float mg = __expf((float)S5_TC * lr * dt), ar = mg * c, ai = mg * s;
        float hr = 0.f, hi = 0.f;
        const int nch = SEQ / S5_TC;
        for (int c0 = 0; c0 < nch; c0 += 32) { float lr_[32], li_[32];
#pragma unroll
            for (int k = 0; k < 32; ++k) { const size_t r = (size_t)g * S5_ROWS + b * nch + c0 + k; lr_[k] = HL[r * 128 + p]; li_[k] = HL[r * 128 + 64 + p]; }
#pragma unroll
            for (int k = 0; k < 32; ++k) { const size_t r = (size_t)g * S5_ROWS + b * nch + c0 + k;
                UH[r * S5_K + p] = (bf16_t)f2bf(hr); UH[r * S5_K + 64 + p] = (bf16_t)f2bf(hi);
                const float nr = ar * hr - ai * hi + lr_[k], ni = ar * hi + ai * hr + li_[k]; hr = nr; hi = ni; } }
    }
}

__device__ __forceinline__ void ssd_stage_bc(Frame& F, int layer, int b, int ch, int grp, LAS float* Bs, LAS float* Cs, LAS float* dts, LAS float* das) {
    const bf16_t* P = (const bf16_t*)(F.ws + WS_P); const float* DT = (const float*)(F.ws + WS_DT);
    const float* cw = F.in[IN_CONVW] + layer * 4 * 1280; const float* cb = F.in[IN_CONVB] + layer * 1280;
    const int l0 = ch * 128; const size_t row0 = (size_t)b * SEQ + l0;
    for (int i = F.tid; i < 2 * 128 * 64; i += NTHR) { const int isC = i >> 13, t = (i >> 6) & 127, n = i & 63;
        const int col = (isC ? C_C : C_B) + grp * 64 + n, cc = 1024 + isC * 128 + grp * 64 + n; float a = cb[cc];
#pragma unroll
        for (int j = 0; j < 4; ++j) { const int l = l0 + t - 3 + j; if (l >= 0) a += cw[j * 1280 + cc] * bf2f(P[(row0 + t - 3 + j) * NINP + col]); }
        (isC ? Cs : Bs)[t * 64 + n] = siluf_(a); }
    for (int i = F.tid; i < 128 * 8; i += NTHR) { const int t = i >> 3, hh = i & 7, h = grp * 8 + hh;
        const float dt = softplusf_(DT[(row0 + t) * 16 + h] + F.in[IN_DTB][layer * 16 + h]); dts[i] = dt; das[i] = dt * (-__expf(F.in[IN_ALOG][layer * 16 + h])); }
}
template <bool OUT>
__device__ __forceinline__ void ssd_units(Frame& F, int layer) {
    LAS float* Bs = (LAS float*)F.lds; LAS float* Cs = Bs + 128 * 64; LAS float* dts = Cs + 128 * 64; LAS float* das = dts + 128 * 8; LAS float* ssq = das + 128 * 8;
    const bf16_t* P = (const bf16_t*)(F.ws + WS_P); float* SST = (float*)(F.ws + WS_SST); float* ASUM = (float*)(F.ws + WS_ASUM); bf16_t* YC = (bf16_t*)(F.ws + WS_YCAT);
    const float* cw = F.in[IN_CONVW] + layer * 4 * 1280; const float* cb = F.in[IN_CONVB] + layer * 1280;
    for (int u = F.bid; u < BATCH * SSD_NCH * 2; u += F.G) {
        const int grp = u & 1, ch = (u >> 1) & 31, b = u >> 6;
        __syncthreads();
        ssd_stage_bc(F, layer, b, ch, grp, Bs, Cs, dts, das);
        __syncthreads();
        const int hh = F.wave, h = grp * 8 + hh, p = F.lane, cx = h * 64 + p;
        const float w0 = cw[cx], w1 = cw[1280 + cx], w2 = cw[2560 + cx], w3 = cw[3840 + cx], bias = cb[cx], dsk = F.in[IN_SSDD][layer * 16 + h];
        const int l0 = ch * 128; const size_t row0 = (size_t)b * SEQ + l0;
        const bf16_t* xp = P + row0 * NINP + C_XS + cx;
        float x0 = 0.f, x1 = 0.f, x2 = 0.f;
        if (l0 > 0) { x0 = bf2f(xp[-3 * (ptrdiff_t)NINP]); x1 = bf2f(xp[-2 * (ptrdiff_t)NINP]); x2 = bf2f(xp[-1 * (ptrdiff_t)NINP]); }
        float st[64];
        float* sp = SST + ((((size_t)b * SSD_NCH + ch) * 16 + h) * 64 + p) * 64;
        if (OUT) {
#pragma unroll
            for (int n = 0; n < 64; n += 4) { const f32x4 v = *(const f32x4*)(sp + n); st[n] = v.x; st[n + 1] = v.y; st[n + 2] = v.z; st[n + 3] = v.w; }
        } else {
#pragma unroll
            for (int n = 0; n < 64; ++n) st[n] = 0.f;
        }
        float asum = 0.f;
#pragma unroll 4
        for (int t = 0; t < 128; ++t) {
            const float x3 = bf2f(xp[(size_t)t * NINP]);
            const float xs = siluf_(bias + w0 * x0 + w1 * x1 + w2 * x2 + w3 * x3);
            x0 = x1; x1 = x2; x2 = x3;
            const float dt = dts[t * 8 + hh], a = das[t * 8 + hh], da = __expf(a), xdt = xs * dt;
            asum += a;
            float y = 0.f;
#pragma unroll
            for (int n = 0; n < 64; n += 4) { const f32x4 bv = *(const LAS f32x4*)(Bs + t * 64 + n);
                st[n] = da * st[n] + bv.x * xdt; st[n + 1] = da * st[n + 1] + bv.y * xdt; st[n + 2] = da * st[n + 2] + bv.z * xdt; st[n + 3] = da * st[n + 3] + bv.w * xdt;
                if (OUT) { const f32x4 cv = *(const LAS f32x4*)(Cs + t * 64 + n); y += (cv.x * st[n] + cv.y * st[n + 1]) + (cv.z * st[n + 2] + cv.w * st[n + 3]); } }
            if (OUT) {
                const float z = bf2f(P[(row0 + t) * NINP + C_Z + cx]);
                const float yz = (y + dsk * xs) * siluf_(z);
                const float q = wave_sum(yz * yz);
                if (p == 0) ssq[t * 8 + hh] = q;
                YC[(row0 + t) * 2048 + 1024 + cx] = (bf16_t)f2bf(yz);
            }
        }
        if (!OUT) {
#pragma unroll
            for (int n = 0; n < 64; n += 4) *(f32x4*)(sp + n) = (f32x4){st[n], st[n + 1], st[n + 2], st[n + 3]};
            if (p == 0) ASUM[((size_t)b * SSD_NCH + ch) * 16 + h] = asum;
        } else {
            __syncthreads();
            const float ng = F.in[IN_SSDG][layer * 1024 + cx];
            for (int t = 0; t < 128; ++t) { float q = 0.f;
#pragma unroll
                for (int j = 0; j < 8; ++j) q += ssq[t * 8 + j];
                const float rs = __builtin_amdgcn_rsqf(q * (1.f / 512.f) + NORM_EPS);
                bf16_t* yp = YC + (row0 + t) * 2048 + 1024 + cx; *yp = (bf16_t)f2bf(bf2f(*yp) * rs * ng); }
        }
    }
}
__device__ __forceinline__ void ssd_scan(Frame& F) {
    bf16_t* SST = (bf16_t*)(F.ws + WS_SST); const float* ASUM = (const float*)(F.ws + WS_ASUM);
    for (int i = F.bid * NTHR + F.tid; i < BATCH * 16 * 512; i += F.G * NTHR) {
        const int pn = (i & 511) * 8, h = (i >> 9) & 15, b = i >> 13; float s[8];
#pragma unroll
        for (int j = 0; j < 8; ++j) s[j] = 0.f;
        u32x4 loc[SSD_NCH]; float dec[SSD_NCH];
#pragma unroll
        for (int ch = 0; ch < SSD_NCH; ++ch) { loc[ch] = *(const u32x4*)(SST + (((size_t)b * SSD_NCH + ch) * 16 + h) * 4096 + pn); dec[ch] = ASUM[((size_t)b * SSD_NCH + ch) * 16 + h]; }
#pragma unroll
        for (int ch = 0; ch < SSD_NCH; ++ch) { u32x4 o; o.x = pk2(s[0], s[1]); o.y = pk2(s[2], s[3]); o.z = pk2(s[4], s[5]); o.w = pk2(s[6], s[7]);
            *(u32x4*)(SST + (((size_t)b * SSD_NCH + ch) * 16 + h) * 4096 + pn) = o; const float d = __expf(dec[ch]);
#pragma unroll
            for (int j = 0; j < 4; ++j) { s[2 * j] = s[2 * j] * d + bflo(loc[ch][j]); s[2 * j + 1] = s[2 * j + 1] * d + bfhi(loc[ch][j]); } }
    }
}

__device__ __forceinline__ void attn_units(Frame& F, int layer) {
    LAS float* Ks = (LAS float*)F.lds; LAS float* Vs = Ks + 256 * 64;
    const bf16_t* P = (const bf16_t*)(F.ws + WS_P); bf16_t* YC = (bf16_t*)(F.ws + WS_YCAT);
    const float* qg = F.in[IN_QG] + layer * 64; const float* kg = F.in[IN_KG] + layer * 64;
    for (int u = F.bid; u < BATCH * 32 * 2; u += F.G) {
        const int kvh = u & 1, qb = (u >> 1) & 31, b = u >> 6, q0 = qb * 128;
        int lane = F.lane; asm volatile("" : "+v"(lane));
        __syncthreads();
        for (int jr = F.wave; jr < 256; jr += NWAVES) { const int l = q0 - 128 + jr; float kv = 0.f, vv = 0.f;
            if (l >= 0) { const size_t row = (size_t)b * SEQ + l; const float x = bf2f(P[row * NINP + C_K + kvh * 64 + lane]); vv = bf2f(P[row * NINP + C_V + kvh * 64 + lane]);
                const float rs = __builtin_amdgcn_rsqf(wave_sum(x * x) * (1.f / 64.f) + NORM_EPS); const float xn = x * rs * kg[lane];
                const float other = __shfl_xor(xn, 32); const int i = lane & 31; const float inv = exp2f(-(float)i * (13.287712379549449f / 32.f));
                float s, c; sincos_fast((float)l * inv, s, c);
                kv = (lane < 32) ? (xn * c - other * s) : (xn * c + other * s); }
            Ks[jr * 64 + lane] = kv; Vs[jr * 64 + lane] = vv; }
        __syncthreads();
        const int hh = F.wave >> 1, head = kvh * 4 + hh, qi = q0 + (F.wave & 1) * 64 + lane; const size_t row = (size_t)b * SEQ + qi;
        float q[64];
        { const u32x4* qp = (const u32x4*)(P + row * NINP + C_Q + head * 64); float ss = 0.f;
#pragma unroll
          for (int j = 0; j < 8; ++j) { const u32x4 w = qp[j];
#pragma unroll
              for (int e = 0; e < 4; ++e) { q[8 * j + 2 * e] = bflo(w[e]); q[8 * j + 2 * e + 1] = bfhi(w[e]); } }
#pragma unroll
          for (int d = 0; d < 64; ++d) ss += q[d] * q[d];
          const float rs = __builtin_amdgcn_rsqf(ss * (1.f / 64.f) + NORM_EPS);
#pragma unroll
          for (int d = 0; d < 64; ++d) q[d] = q[d] * rs * qg[d];
#pragma unroll
          for (int i = 0; i < 32; ++i) { const float inv = exp2f(-(float)i * (13.287712379549449f / 32.f)); float s, c; sincos_fast((float)qi * inv, s, c);
              const float a = q[i], bq = q[i + 32]; q[i] = (a * c - bq * s) * 0.125f; q[i + 32] = (bq * c + a * s) * 0.125f; } }
        float o[64];
#pragma unroll
        for (int d = 0; d < 64; ++d) o[d] = 0.f;
        float mx = F.in[IN_SINK][layer * 8 + head], l = 1.f;
        const int qa = q0 + (F.wave & 1) * 64;
        int jlo = qa - 127 - (q0 - 128); if (q0 == 0 && jlo < 128) jlo = 128; const int jhi = qa + 63 - (q0 - 128);
        for (int jr = jlo; jr <= jhi; ++jr) { const int j = q0 - 128 + jr; const bool ok = (j <= qi) && (qi - j < 128);
            float s = 0.f;
#pragma unroll
            for (int d = 0; d < 64; d += 4) { const f32x4 kv = *(const LAS f32x4*)(Ks + jr * 64 + d); s += (q[d] * kv.x + q[d + 1] * kv.y) + (q[d + 2] * kv.z + q[d + 3] * kv.w); if ((d & 12) == 12) __builtin_amdgcn_sched_barrier(0); }
            if (ok) { const float mn = fmaxf(mx, s), al = __expf(mx - mn), pe = __expf(s - mn); l = l * al + pe; mx = mn;
#pragma unroll
                for (int d = 0; d < 64; d += 4) { const f32x4 vv = *(const LAS f32x4*)(Vs + jr * 64 + d); o[d] = o[d] * al + pe * vv.x; o[d + 1] = o[d + 1] * al + pe * vv.y; o[d + 2] = o[d + 2] * al + pe * vv.z; o[d + 3] = o[d + 3] * al + pe * vv.w; if ((d & 12) == 12) __builtin_amdgcn_sched_barrier(0); } } }
        const float il = 1.f / l; u32x4* op = (u32x4*)(YC + row * 2048 + 512 + head * 64);
#pragma unroll
        for (int j = 0; j < 8; ++j) { u32x4 w; w.x = pk2(o[8 * j] * il, o[8 * j + 1] * il); w.y = pk2(o[8 * j + 2] * il, o[8 * j + 3] * il); w.z = pk2(o[8 * j + 4] * il, o[8 * j + 5] * il); w.w = pk2(o[8 * j + 6] * il, o[8 * j + 7] * il); op[j] = w; }
    }
}

typedef short bf16x8_t __attribute__((ext_vector_type(8)));
__device__ __forceinline__ void split_hi_lo(const f32x4 a, const f32x4 b, bf16x8& hi, bf16x8& lo) {
    u32x4 h; h.x = cvtpk(a.x, a.y); h.y = cvtpk(a.z, a.w); h.z = cvtpk(b.x, b.y); h.w = cvtpk(b.z, b.w);
    u32x4 l; l.x = cvtpk(a.x - bflo(h.x), a.y - bfhi(h.x)); l.y = cvtpk(a.z - bflo(h.y), a.w - bfhi(h.y)); l.z = cvtpk(b.x - bflo(h.z), b.y - bfhi(h.z)); l.w = cvtpk(b.z - bflo(h.w), b.w - bfhi(h.w));
    hi = __builtin_bit_cast(bf16x8, h); lo = __builtin_bit_cast(bf16x8, l);
}
__device__ __forceinline__ void router_phase(Frame& F, int layer) {
    constexpr int WROW = 2064;
    LAS unsigned char* Whi = F.lds; LAS unsigned char* Wlo = F.lds + 36 * WROW;
    LAS float* part = (LAS float*)F.lds;
    volatile LAS unsigned* lcnt = (volatile LAS unsigned*)(F.lds + 148 * 1024);
    const float* wrg = F.in[IN_WRG] + (size_t)layer * 1024 * 4; const float* wre = F.in[IN_WRE] + (size_t)layer * 1024 * 32; const float* gain = F.in[IN_NORM2] + layer * 1024;
    const float* X = F.out; bf16_t* H2 = (bf16_t*)(F.ws + WS_XN);
    int* EID = (int*)(F.ws + WS_MOE); float* EW = (float*)(F.ws + WS_MOE + 128 * 1024); int* SLOT = (int*)(F.ws + WS_MOE + 256 * 1024); float* RS = (float*)(F.ws + WS_MOE + 640 * 1024);
    __syncthreads();
    for (int k = F.tid; k < 1024; k += NTHR) { const float g = gain[k]; const f32x4 wg = *(const f32x4*)(wrg + k * 4);
        float w[36]; w[0] = wg.x; w[1] = wg.y; w[2] = wg.z; w[3] = wg.w;
#pragma unroll
        for (int q = 0; q < 8; ++q) { const f32x4 v = *(const f32x4*)(wre + k * 32 + 4 * q); w[4 + 4 * q] = v.x; w[5 + 4 * q] = v.y; w[6 + 4 * q] = v.z; w[7 + 4 * q] = v.w; }
#pragma unroll
        for (int e = 0; e < 36; ++e) { const float x = w[e] * g; const unsigned h = f2bf(x); const unsigned l = f2bf(x - bf2f(h));
            *(LAS unsigned short*)(Whi + e * WROW + k * 2) = (unsigned short)h; *(LAS unsigned short*)(Wlo + e * WROW + k * 2) = (unsigned short)l; } }
    if (F.tid < 32) lcnt[F.tid] = 0u;
    __syncthreads();
    const int TPB = T / F.G;
    int lane = F.lane; asm volatile("" : "+v"(lane));
    const int mt = F.wave & 3, kh = F.wave >> 2, row = lane & 15, kg = lane >> 4;
    const int m = F.bid * TPB + 16 * mt + row;
    f32x4 acc[3] = {{0.f, 0.f, 0.f, 0.f}, {0.f, 0.f, 0.f, 0.f}, {0.f, 0.f, 0.f, 0.f}}; float ss = 0.f;
    int er[3]; er[0] = row; er[1] = 16 + row; er[2] = (32 + row < 36) ? 32 + row : 35;
    if (kh == 0)
#pragma unroll 1
    for (int kb = 0; kb < 4; ++kb) {
        f32x4 xa[8][2];
#pragma unroll
        for (int ks = 0; ks < 8; ++ks) { const float* xp = X + (size_t)m * DM + 256 * kb + 32 * ks + 8 * kg; xa[ks][0] = *(const f32x4*)xp; xa[ks][1] = *(const f32x4*)(xp + 4); }
#pragma unroll
        for (int ks = 0; ks < 8; ++ks) { const int k0 = 256 * kb + 32 * ks + 8 * kg;
            const f32x4 a = xa[ks][0], b = xa[ks][1];
            ss += (a.x * a.x + a.y * a.y) + (a.z * a.z + a.w * a.w) + (b.x * b.x + b.y * b.y) + (b.z * b.z + b.w * b.w);
            bf16x8 ah, al; split_hi_lo(a, b, ah, al); pin_frag(ah); pin_frag(al);
#pragma unroll
            for (int nt = 0; nt < 3; ++nt) { const bf16x8 bh = *(const LAS bf16x8*)(Whi + er[nt] * WROW + k0 * 2), bl = *(const LAS bf16x8*)(Wlo + er[nt] * WROW + k0 * 2);
                acc[nt] = __builtin_amdgcn_mfma_f32_16x16x32_bf16(ah, bh, acc[nt], 0, 0, 0);
                acc[nt] = __builtin_amdgcn_mfma_f32_16x16x32_bf16(ah, bl, acc[nt], 0, 0, 0);
                acc[nt] = __builtin_amdgcn_mfma_f32_16x16x32_bf16(al, bh, acc[nt], 0, 0, 0); } }
    }
    ss += __shfl_xor(ss, 16); ss += __shfl_xor(ss, 32);
    __syncthreads();
    LAS float* ssq = part + 4 * 3 * 64 * 4; LAS float* lg = ssq + 128; volatile LAS int* elist = (volatile LAS int*)(lg + 64 * 40);
    if (kh == 0) {
        const float rstd_row = __builtin_amdgcn_rsqf(ss * (1.f / DM) + NORM_EPS);
        if (kg == 0) { ssq[64 + 16 * mt + row] = rstd_row; RS[m] = rstd_row; }
    }
    __syncthreads();
    if (kh == 0) {
#pragma unroll
        for (int nt = 0; nt < 3; ++nt)
#pragma unroll
            for (int rg = 0; rg < 4; ++rg) { const int e = row + 16 * nt, tk = 16 * mt + 4 * kg + rg; if (e < 36) lg[tk * 40 + e] = acc[nt][rg] * ssq[64 + tk]; }
    }
    __syncthreads();
    if (F.tid < TPB) { const int tk = F.tid, mm = F.bid * TPB + tk; const LAS float* L = lg + tk * 40;
        float gl[4];
#pragma unroll
        for (int k = 0; k < 4; ++k) gl[k] = L[k] + F.in[IN_BRG][layer * 4 + k];
        int gs = 0; float gbest = gl[0];
#pragma unroll
        for (int k = 1; k < 4; ++k) if (gl[k] > gbest) { gbest = gl[k]; gs = k; }
        float den = 0.f;
#pragma unroll
        for (int k = 0; k < 4; ++k) den += __expf(gl[k] - gbest);
        const float pgrp = 1.f / den;
        float el[8];
#pragma unroll
        for (int k = 0; k < 8; ++k) el[k] = L[4 + gs * 8 + k] + F.in[IN_BRE_][layer * 32 + gs * 8 + k];
        int i0 = 0; float v0 = el[0];
#pragma unroll
        for (int k = 1; k < 8; ++k) if (el[k] > v0) { v0 = el[k]; i0 = k; }
        int i1 = -1; float v1 = -3.0e38f;
#pragma unroll
        for (int k = 0; k < 8; ++k) if (k != i0 && el[k] > v1) { v1 = el[k]; i1 = k; }
        const float e1 = __expf(v1 - v0), w0 = pgrp / (1.f + e1), w1 = pgrp * e1 / (1.f + e1);
        const int ea = gs * 8 + i0, eb = gs * 8 + i1;
        EID[2 * mm] = ea; EID[2 * mm + 1] = eb; EW[2 * mm] = w0; EW[2 * mm + 1] = w1;
        elist[2 * tk] = ea; elist[2 * tk + 1] = eb;
    }
    __syncthreads();
    if (F.tid < 32) { const int e = F.tid; int c = 0;
        for (int i = 0; i < 2 * TPB; ++i) { if (elist[i] == e) { SLOT[2 * (F.bid * TPB) + i] = c; ++c; } }
        ((unsigned*)(F.ws + WS_MOE + 512 * 1024))[(size_t)F.bid * 32 + e] = (unsigned)c; }
    __syncthreads();
}
__device__ __forceinline__ int moe_tables(Frame& F, int layer, volatile LAS int* offs, volatile LAS int* tile_e) {
    volatile LAS int* psum = offs + 256;
    const unsigned* CNTB = (const unsigned*)(F.ws + WS_MOE + 512 * 1024);
    __syncthreads();
    { const int e = F.tid & 31, part = F.tid >> 5; int tot = 0, pre = 0; const int per = (F.G + 15) / 16;
      for (int bb = part * per; bb < (part + 1) * per && bb < F.G; ++bb) { const int c = (int)CNTB[(size_t)bb * 32 + e]; tot += c; pre += (bb < F.bid) ? c : 0; }
      psum[part * 32 + e] = tot; psum[512 + part * 32 + e] = pre; }
    __syncthreads();
    if (F.tid < 64) {
        int c = 0, pre = 0;
        if (F.tid < 32) for (int part = 0; part < 16; ++part) { c += psum[part * 32 + F.tid]; pre += psum[512 + part * 32 + F.tid]; }
        const int tl = (c + 255) >> 8; int incl = tl;
#pragma unroll
        for (int o = 1; o < 32; o <<= 1) { const int v = __shfl_up(incl, o); if (F.tid >= o) incl += v; }
        const int excl = incl - tl;
        if (F.tid < 32) { offs[F.tid] = excl * 256 + pre; for (int k = 0; k < tl; ++k) tile_e[excl + k] = F.tid; }
        if (F.tid == 31) offs[32] = incl;
    }
    __syncthreads();
    return __builtin_amdgcn_readfirstlane(offs[32]);
}
__device__ __forceinline__ void gather_phase(Frame& F, int layer, volatile LAS int* offs) {
    const float* X = F.out; const float* gain = F.in[IN_NORM2] + layer * 1024; const float* RS = (const float*)(F.ws + WS_MOE + 640 * 1024); bf16_t* XG = (bf16_t*)(F.ws + WS_XG);
    const int* EID = (const int*)(F.ws + WS_MOE); const int* SLOT = (const int*)(F.ws + WS_MOE + 256 * 1024); int* POS = (int*)(F.ws + WS_MOE + 384 * 1024);
    const int TPB = T / F.G;
    for (int m = F.bid * TPB + F.wave; m < (F.bid + 1) * TPB; m += NWAVES) {
        const f32x4* xr = (const f32x4*)(X + (size_t)m * DM) + F.lane; const f32x4* gr = (const f32x4*)gain + F.lane; const float rs = RS[m];
        u32x2 o[4];
#pragma unroll
        for (int j = 0; j < 4; ++j) { const f32x4 v = xr[64 * j], g = gr[64 * j]; o[j].x = pk2(v.x * rs * g.x, v.y * rs * g.y); o[j].y = pk2(v.z * rs * g.z, v.w * rs * g.w); }
#pragma unroll
        for (int k = 0; k < 2; ++k) { const int pos = offs[EID[2 * m + k]] + SLOT[2 * m + k]; u32x2* dst = (u32x2*)(XG + (size_t)pos * DM) + F.lane;
#pragma unroll
            for (int j = 0; j < 4; ++j) dst[64 * j] = o[j];
            if (F.lane == 0) POS[2 * m + k] = pos; }
    }
}
__device__ __forceinline__ void combine_phase(Frame& F, const float* gain_next, bool dry = false) {
    const bf16_t* Y = (const bf16_t*)(F.ws + WS_YEXP); const float* EW = (const float*)(F.ws + WS_MOE + 128 * 1024); const int* POS = (const int*)(F.ws + WS_MOE + 384 * 1024);
    bf16_t* XN = (bf16_t*)(F.ws + WS_XN);
    const int gw = F.bid * NWAVES + F.wave, NGW = F.G * NWAVES;
    for (int m = gw; m < T; m += NGW) {
        const float w0 = EW[2 * m], w1 = EW[2 * m + 1]; const int p0 = POS[2 * m], p1 = POS[2 * m + 1];
        f32x4* xr = (f32x4*)(F.out + (size_t)m * DM) + F.lane;
        const u32x2* y0 = (const u32x2*)(Y + (size_t)p0 * DM) + F.lane; const u32x2* y1 = (const u32x2*)(Y + (size_t)p1 * DM) + F.lane;
        f32x4 v[4]; float s = 0.f;
#pragma unroll
        for (int j = 0; j < 4; ++j) { v[j] = xr[64 * j]; const u32x2 a = y0[64 * j], b = y1[64 * j];
            v[j].x += w0 * bflo(a.x) + w1 * bflo(b.x); v[j].y += w0 * bfhi(a.x) + w1 * bfhi(b.x); v[j].z += w0 * bflo(a.y) + w1 * bflo(b.y); v[j].w += w0 * bfhi(a.y) + w1 * bfhi(b.y);
            if (!dry) xr[64 * j] = v[j]; s += (v[j].x * v[j].x + v[j].y * v[j].y) + (v[j].z * v[j].z + v[j].w * v[j].w); }
        if (gain_next) { const float rstd = __builtin_amdgcn_rsqf(wave_sum(s) * (1.f / DM) + NORM_EPS); const f32x4* gr = (const f32x4*)gain_next + F.lane;
            unsigned long long* o8 = (unsigned long long*)(XN + (size_t)m * DM) + F.lane;
#pragma unroll
            for (int j = 0; j < 4; ++j) { const f32x4 gv = gr[64 * j]; o8[64 * j] = (unsigned long long)pk2(v[j].x * rstd * gv.x, v[j].y * rstd * gv.y) | ((unsigned long long)pk2(v[j].z * rstd * gv.z, v[j].w * rstd * gv.w) << 32); } }
    }
}

__device__ __forceinline__ int crow32(int reg, int hh) { return (reg & 3) + 8 * (reg >> 2) + 4 * hh; }
__device__ __forceinline__ float wave_incl_scan(float v, int lane) {
#pragma unroll
    for (int o = 1; o < 64; o <<= 1) { const float t = __shfl_up(v, o); if (lane >= o) v += t; }
    return v;
}
__device__ __forceinline__ void conv_frag(const LAS unsigned char* raw, int chan, int ks, int hh, float w0, float w1, float w2, float w3, float bias, float (&out)[8]) {
#pragma unroll
    for (int run = 0; run < 2; ++run) { const int lb = 16 * ks + 8 * run + 4 * hh; float x[7];
#pragma unroll
        for (int i = 0; i < 7; ++i) x[i] = bf2f(*(const LAS unsigned short*)(raw + (lb + i) * 128 + chan * 2));
#pragma unroll
        for (int j = 0; j < 4; ++j) out[4 * run + j] = siluf_(bias + w0 * x[j] + w1 * x[j + 1] + w2 * x[j + 2] + w3 * x[j + 3]); }
}
constexpr int RAWT = 131 * 128;
__device__ __forceinline__ void stage_raw(const bf16_t* P, size_t row0, int l0, int col, LAS unsigned char* dst, int idx0, int stride) {
    for (int base = idx0; base < 131 * 8; base += 8 * stride) { u32x4 v[8];
#pragma unroll
        for (int q = 0; q < 8; ++q) { const int idx = base + q * stride, r = idx >> 3, c8 = idx & 7; v[q] = (u32x4){0u, 0u, 0u, 0u};
            if (idx < 131 * 8 && l0 - 3 + r >= 0) v[q] = *(const u32x4*)(P + (row0 + r - 3) * NINP + col + c8 * 8); }
#pragma unroll
        for (int q = 0; q < 8; ++q) { const int idx = base + q * stride, r = idx >> 3, c8 = idx & 7; if (idx < 131 * 8) *(LAS u32x4*)(dst + r * 128 + c8 * 16) = v[q]; } }
}
__device__ __forceinline__ bf16_t* xf_base(unsigned char* ws, int b, int ch, int h) { return (bf16_t*)(ws + ((b < 2) ? WS_XN : WS_SST) + 16 * MiB) + ((size_t)(((b & 1) * SSD_NCH + ch) * 16 + h)) * 8192; }
__device__ __forceinline__ void ssdA_mfma(Frame& F, int layer) {
    const bf16_t* P = (const bf16_t*)(F.ws + WS_P); const float* DT = (const float*)(F.ws + WS_DT); bf16_t* SST = (bf16_t*)(F.ws + WS_SST); float* ASUM = (float*)(F.ws + WS_ASUM);
    const float* cw = F.in[IN_CONVW] + layer * 4 * 1280; const float* cb = F.in[IN_CONVB] + layer * 1280;
    LAS unsigned char* rawX = F.lds + F.wave * RAWT; LAS unsigned char* rawB = F.lds + 8 * RAWT; LAS float* ftab = (LAS float*)(F.lds + 9 * RAWT) + F.wave * 128;
    for (int u = F.bid; u < BATCH * SSD_NCH * 2; u += F.G) {
        const int grp = u & 1, ch = (u >> 1) & 31, b = u >> 6, h = grp * 8 + F.wave, l0 = ch * 128; const size_t row0 = (size_t)b * SEQ + l0;
        int lane = F.lane; asm volatile("" : "+v"(lane));
        const int r = lane & 31, hh = lane >> 5;
        __syncthreads();
        stage_raw(P, row0, l0, C_XS + h * 64, rawX, lane, 64);
        stage_raw(P, row0, l0, C_B + grp * 64, rawB, F.tid, NTHR);
        { const float dtb = F.in[IN_DTB][layer * 16 + h], A = -__expf(F.in[IN_ALOG][layer * 16 + h]);
          const float dt0 = softplusf_(DT[(row0 + lane) * 16 + h] + dtb), dt1 = softplusf_(DT[(row0 + 64 + lane) * 16 + h] + dtb);
          const float s0 = wave_incl_scan(dt0 * A, lane); const float tot0 = __builtin_bit_cast(float, __builtin_amdgcn_readlane(__builtin_bit_cast(int, s0), 63));
          const float s1 = wave_incl_scan(dt1 * A, lane) + tot0; const float tot = __builtin_bit_cast(float, __builtin_amdgcn_readlane(__builtin_bit_cast(int, s1), 63));
          ftab[lane] = dt0 * __expf(tot - s0); ftab[64 + lane] = dt1 * __expf(tot - s1);
          if (lane == 0) ASUM[((size_t)b * SSD_NCH + ch) * 16 + h] = tot; }
        __syncthreads();
        bf16x8 bfr[2];
#pragma unroll
        for (int q = 0; q < 2; ++q) { const int idx = F.wave * 2 + q, nt = idx >> 3, ks = idx & 7, cc = 1024 + grp * 64 + 32 * nt + r; float v[8];
            conv_frag(rawB, 32 * nt + r, ks, hh, cw[cc], cw[1280 + cc], cw[2560 + cc], cw[3840 + cc], cb[cc], v); bfr[q] = pack8v(v); }
        bf16x8 xw[2][8];
        bf16_t* xf = xf_base(F.ws, b, ch, h);
#pragma unroll
        for (int pt = 0; pt < 2; ++pt) { const int cx = h * 64 + 32 * pt + r; const float w0 = cw[cx], w1 = cw[1280 + cx], w2 = cw[2560 + cx], w3 = cw[3840 + cx], bias = cb[cx];
#pragma unroll
            for (int ks = 0; ks < 8; ++ks) { float v[8]; conv_frag(rawX, 32 * pt + r, ks, hh, w0, w1, w2, w3, bias, v);
                *(bf16x8*)(xf + ((pt * 8 + ks) * 64 + lane) * 8) = pack8v(v);
                const f32x4 fa = *(const LAS f32x4*)(ftab + 16 * ks + 4 * hh), fb = *(const LAS f32x4*)(ftab + 16 * ks + 8 + 4 * hh);
                v[0] *= fa.x; v[1] *= fa.y; v[2] *= fa.z; v[3] *= fa.w; v[4] *= fb.x; v[5] *= fb.y; v[6] *= fb.z; v[7] *= fb.w; { u32x4 pq = __builtin_bit_cast(u32x4, pack8v(v)); asm volatile("" : "+v"(pq) :: "memory"); xw[pt][ks] = __builtin_bit_cast(bf16x8, pq); } } }
        __syncthreads();
#pragma unroll
        for (int q = 0; q < 2; ++q) *(LAS bf16x8*)(rawB + (F.wave * 2 + q) * 1024 + lane * 16) = bfr[q];
        __syncthreads();
        f32x16 acc[2][2];
#pragma unroll
        for (int pt = 0; pt < 2; ++pt)
#pragma unroll
            for (int nt = 0; nt < 2; ++nt)
#pragma unroll
                for (int i = 0; i < 16; ++i) acc[pt][nt][i] = 0.f;
#pragma unroll
        for (int ks = 0; ks < 8; ++ks)
#pragma unroll
            for (int nt = 0; nt < 2; ++nt) { const bf16x8 bq = *(const LAS bf16x8*)(rawB + (nt * 8 + ks) * 1024 + lane * 16);
#pragma unroll
                for (int pt = 0; pt < 2; ++pt) acc[pt][nt] = MFMA32(xw[pt][ks], bq, acc[pt][nt]); }
        bf16_t* sp = SST + (((size_t)b * SSD_NCH + ch) * 16 + h) * 4096;
        settle_acc(acc[0][0]); settle_acc(acc[0][1]); settle_acc(acc[1][0]); settle_acc(acc[1][1]);
#pragma unroll
        for (int pt = 0; pt < 2; ++pt)
#pragma unroll
            for (int nt = 0; nt < 2; ++nt)
#pragma unroll
                for (int i = 0; i < 16; ++i) sp[(32 * pt + crow32(i, hh)) * 64 + 32 * nt + r] = (bf16_t)f2bf(acc[pt][nt][i]);
    }
}
__device__ __forceinline__ void ssdC_mfma(Frame& F, int layer) {
    const bf16_t* P = (const bf16_t*)(F.ws + WS_P); const float* DT = (const float*)(F.ws + WS_DT); const bf16_t* SST = (const bf16_t*)(F.ws + WS_SST); bf16_t* YC = (bf16_t*)(F.ws + WS_YCAT);
    const float* cw = F.in[IN_CONVW] + layer * 4 * 1280; const float* cb = F.in[IN_CONVB] + layer * 1280;
    LAS unsigned char* rawX = F.lds + F.wave * RAWT;
    LAS unsigned char* Bn = F.lds; LAS unsigned char* Cn = F.lds + 18432;
    LAS float* atab = (LAS float*)(F.lds + 36864) + F.wave * 128; LAS float* dtab = (LAS float*)(F.lds + 40960) + F.wave * 128;
    LAS float* ssqp = (LAS float*)(F.lds + 45056); LAS float* gtab = (LAS float*)(F.lds + 49152) + F.wave * 64;
    LAS unsigned char* zt = F.lds + 51200 + F.wave * 4608;
    for (int u = F.bid; u < BATCH * SSD_NCH * 2; u += F.G) {
        const int grp = u & 1, ch = (u >> 1) & 31, b = u >> 6, h = grp * 8 + F.wave, l0 = ch * 128; const size_t row0 = (size_t)b * SEQ + l0;
        int lane = F.lane; asm volatile("" : "+v"(lane));
        const int r = lane & 31, hh = lane >> 5;
        bf16x8 xsf[2][8];
        { const bf16_t* xf = xf_base(F.ws, b, ch, h);
#pragma unroll
          for (int pt = 0; pt < 2; ++pt)
#pragma unroll
              for (int ks = 0; ks < 8; ++ks) xsf[pt][ks] = *(const bf16x8*)(xf + ((pt * 8 + ks) * 64 + lane) * 8); }
        __syncthreads();
        for (int it = F.tid; it < 128 * 16; it += NTHR) { const int l = it >> 4, c8 = it & 15, isC = c8 >> 3, col = (isC ? C_C : C_B) + grp * 64 + (c8 & 7) * 8, cc = 1024 + isC * 128 + grp * 64 + (c8 & 7) * 8;
            float a[8];
#pragma unroll
            for (int e = 0; e < 8; ++e) a[e] = cb[cc + e];
#pragma unroll
            for (int j = 0; j < 4; ++j) { if (l0 + l - 3 + j >= 0) { const u32x4 xv = *(const u32x4*)(P + (row0 + l - 3 + j) * NINP + col);
#pragma unroll
                for (int e = 0; e < 4; ++e) { a[2 * e] += cw[j * 1280 + cc + 2 * e] * bflo(xv[e]); a[2 * e + 1] += cw[j * 1280 + cc + 2 * e + 1] * bfhi(xv[e]); } } }
            u32x4 o; o.x = cvtpk(siluf_(a[0]), siluf_(a[1])); o.y = cvtpk(siluf_(a[2]), siluf_(a[3])); o.z = cvtpk(siluf_(a[4]), siluf_(a[5])); o.w = cvtpk(siluf_(a[6]), siluf_(a[7]));
            *(LAS u32x4*)((isC ? Cn : Bn) + l * 144 + (c8 & 7) * 16) = o; }
        LAS float* ttab = (LAS float*)(F.lds + 155648) + F.wave * 128;
        { const float dtb = F.in[IN_DTB][layer * 16 + h], A = -__expf(F.in[IN_ALOG][layer * 16 + h]);
          const float dt0 = softplusf_(DT[(row0 + lane) * 16 + h] + dtb), dt1 = softplusf_(DT[(row0 + 64 + lane) * 16 + h] + dtb);
          const float s0 = wave_incl_scan(dt0 * A, lane); const float tot0 = __builtin_bit_cast(float, __builtin_amdgcn_readlane(__builtin_bit_cast(int, s0), 63));
          const float s1 = wave_incl_scan(dt1 * A, lane) + tot0;
          atab[lane] = s0; atab[64 + lane] = s1; dtab[lane] = dt0; dtab[64 + lane] = dt1; gtab[lane] = F.in[IN_SSDG][layer * 1024 + h * 64 + lane];
          const float e0_ = __builtin_bit_cast(float, __builtin_amdgcn_readlane(__builtin_bit_cast(int, s0), 31)), e1_ = tot0,
                      e2_ = __builtin_bit_cast(float, __builtin_amdgcn_readlane(__builtin_bit_cast(int, s1), 31)), e3_ = __builtin_bit_cast(float, __builtin_amdgcn_readlane(__builtin_bit_cast(int, s1), 63));
          ttab[lane] = __expf((lane < 32 ? e0_ : e1_) - s0) * dt0; ttab[64 + lane] = __expf((lane < 32 ? e2_ : e3_) - s1) * dt1; }
        const bf16_t* sp = SST + (((size_t)b * SSD_NCH + ch) * 16 + h) * 4096;
        const float dsk = F.in[IN_SSDD][layer * 16 + h];
        LAS unsigned char* pf = F.lds + 90112 + F.wave * 8192;
#pragma unroll
        for (int pt = 0; pt < 2; ++pt)
#pragma unroll
            for (int ks = 0; ks < 4; ++ks) *(LAS bf16x8*)(pf + ((pt * 4 + ks) * 64 + lane) * 16) = *(const bf16x8*)(sp + (32 * pt + r) * 64 + 16 * ks + 8 * hh);
        __syncthreads();
#pragma unroll
        for (int li = 0; li < 4; ++li) {
            const size_t rowt = row0 + 32 * li;
            u32x4 zreg[4];
#pragma unroll
            for (int q = 0; q < 4; ++q) { const int idx = lane + 64 * q, rr = idx >> 3, c8 = idx & 7; zreg[q] = *(const u32x4*)(P + (rowt + rr) * NINP + C_Z + h * 64 + c8 * 8); }
            bf16x8 Cf[4];
#pragma unroll
            for (int ks = 0; ks < 4; ++ks) Cf[ks] = *(const LAS bf16x8*)(Cn + (32 * li + r) * 144 + (16 * ks + 8 * hh) * 2);
            f32x16 acc[2];
#pragma unroll
            for (int pt = 0; pt < 2; ++pt)
#pragma unroll
                for (int i = 0; i < 16; ++i) acc[pt][i] = 0.f;
#pragma unroll
            for (int ks = 0; ks < 4; ++ks)
#pragma unroll
                for (int pt = 0; pt < 2; ++pt) acc[pt] = MFMA32(*(const LAS bf16x8*)(pf + ((pt * 4 + ks) * 64 + lane) * 16), Cf[ks], acc[pt]);
            const float al = atab[32 * li + r], el = __expf(al); const int lrel = 32 * li + r;
            settle_acc(acc[0]); settle_acc(acc[1]);
#pragma unroll
            for (int pt = 0; pt < 2; ++pt)
#pragma unroll
                for (int i = 0; i < 16; ++i) acc[pt][i] *= el;
#pragma unroll
            for (int si = 0; si < 4; ++si) if (si <= li) {
                f32x16 X;
#pragma unroll
                for (int i = 0; i < 16; ++i) X[i] = 0.f;
#pragma unroll
                for (int ks = 0; ks < 4; ++ks) { const bf16x8 Bq = *(const LAS bf16x8*)(Bn + (32 * si + r) * 144 + (16 * ks + 8 * hh) * 2); X = MFMA32(Bq, Cf[ks], X); }
                settle_acc(X);
                if (si < li) {
                    const float fl = __expf(al - atab[32 * si + 31]);
#pragma unroll
                    for (int g4 = 0; g4 < 4; ++g4) { const f32x4 tv = *(const LAS f32x4*)(ttab + 32 * si + 8 * g4 + 4 * hh);
#pragma unroll
                        for (int j = 0; j < 4; ++j) X[4 * g4 + j] *= fl * tv[j]; }
                } else {
#pragma unroll
                    for (int g4 = 0; g4 < 4; ++g4) { const int sb = 32 * si + 8 * g4 + 4 * hh; const f32x4 av = *(const LAS f32x4*)(atab + sb), dv = *(const LAS f32x4*)(dtab + sb);
#pragma unroll
                        for (int j = 0; j < 4; ++j) { const int s = sb + j; const bool keep = s <= lrel; const float arg = keep ? al - av[j] : -100.f;
                            float x = X[4 * g4 + j] * (__expf(arg) * dv[j]); x = keep ? x : 0.f; if (s == lrel) x += dsk; X[4 * g4 + j] = x; } }
                }
#pragma unroll
                for (int kq = 0; kq < 2; ++kq) { const float v[8] = {X[8 * kq], X[8 * kq + 1], X[8 * kq + 2], X[8 * kq + 3], X[8 * kq + 4], X[8 * kq + 5], X[8 * kq + 6], X[8 * kq + 7]}; bf16x8 Xf = pack8v(v); pin_frag(Xf);
#pragma unroll
                    for (int pt = 0; pt < 2; ++pt) { bf16x8 a;
#pragma unroll
                        for (int q = 0; q < 4; ++q) a = (si == q) ? xsf[pt][2 * q + kq] : a;
                        acc[pt] = MFMA32(a, Xf, acc[pt]); } }
            }
            settle_acc(acc[0]); settle_acc(acc[1]);
#pragma unroll
            for (int q = 0; q < 4; ++q) { const int idx = lane + 64 * q, rr = idx >> 3, c8 = idx & 7; *(LAS u32x4*)(zt + rr * 144 + c8 * 16) = zreg[q]; }
            float qs = 0.f;
#pragma unroll
            for (int pt = 0; pt < 2; ++pt)
#pragma unroll
                for (int g4 = 0; g4 < 4; ++g4) { const u32x2 zz = *(const LAS u32x2*)(zt + r * 144 + (32 * pt + 8 * g4 + 4 * hh) * 2);
                    const float z0 = bflo(zz.x), z1 = bfhi(zz.x), z2 = bflo(zz.y), z3 = bfhi(zz.y);
                    float y0 = acc[pt][4 * g4] * siluf_(z0), y1 = acc[pt][4 * g4 + 1] * siluf_(z1), y2 = acc[pt][4 * g4 + 2] * siluf_(z2), y3 = acc[pt][4 * g4 + 3] * siluf_(z3);
                    acc[pt][4 * g4] = y0; acc[pt][4 * g4 + 1] = y1; acc[pt][4 * g4 + 2] = y2; acc[pt][4 * g4 + 3] = y3; qs += (y0 * y0 + y1 * y1) + (y2 * y2 + y3 * y3); }
            qs += __shfl_xor(qs, 32);
            if (hh == 0) ssqp[(32 * li + r) * 8 + F.wave] = qs;
            __syncthreads();
            { const f32x4 qa = *(const LAS f32x4*)(ssqp + (32 * li + r) * 8), qb = *(const LAS f32x4*)(ssqp + (32 * li + r) * 8 + 4);
              const float rs = __builtin_amdgcn_rsqf(((qa.x + qa.y) + (qa.z + qa.w) + (qb.x + qb.y) + (qb.z + qb.w)) * (1.f / 512.f) + NORM_EPS);
#pragma unroll
              for (int pt = 0; pt < 2; ++pt)
#pragma unroll
                  for (int g4 = 0; g4 < 4; ++g4) { const int p0 = 32 * pt + 8 * g4 + 4 * hh; const f32x4 gv = *(const LAS f32x4*)(gtab + p0);
                      u32x2 o; o.x = cvtpk(acc[pt][4 * g4] * rs * gv.x, acc[pt][4 * g4 + 1] * rs * gv.y); o.y = cvtpk(acc[pt][4 * g4 + 2] * rs * gv.z, acc[pt][4 * g4 + 3] * rs * gv.w);
                      *(LAS u32x2*)(zt + r * 144 + p0 * 2) = o; } }
#pragma unroll
            for (int q = 0; q < 4; ++q) { const int idx = lane + 64 * q, rr = idx >> 3, c8 = idx & 7; *(u32x4*)(YC + (rowt + rr) * 2048 + 1024 + h * 64 + c8 * 8) = *(const LAS u32x4*)(zt + rr * 144 + c8 * 16); }
        }
    }
}

typedef short v4i16_t __attribute__((ext_vector_type(4)));
__device__ __forceinline__ void attn_mfma(Frame& F, int layer) {
    LAS unsigned char* Kn = F.lds; LAS unsigned char* VT = F.lds + 36864;
    const bf16_t* P = (const bf16_t*)(F.ws + WS_P); bf16_t* YC = (bf16_t*)(F.ws + WS_YCAT);
    const float* qg = F.in[IN_QG] + layer * 64; const float* kg = F.in[IN_KG] + layer * 64;
    for (int u = F.bid; u < BATCH * 32 * 2; u += F.G) {
        const int kvh = u & 1, qb = (u >> 1) & 31, b = u >> 6, q0 = qb * 128;
        int lane = F.lane; asm volatile("" : "+v"(lane));
        const int r = lane & 31, hh = lane >> 5;
        __syncthreads();
#pragma unroll
        for (int pass = 0; pass < 2; ++pass) { const int jr = pass * 128 + (F.tid >> 2), j4 = F.tid & 3, l = q0 - 128 + jr;
            u32x4 lo = {0u, 0u, 0u, 0u}, hi = {0u, 0u, 0u, 0u};
            if (l >= 0) { const bf16_t* kp = P + ((size_t)b * SEQ + l) * NINP + C_K + kvh * 64 + 8 * j4; lo = *(const u32x4*)kp; hi = *(const u32x4*)(kp + 32); }
            float x1[8], x2[8]; float ss = 0.f;
#pragma unroll
            for (int e = 0; e < 4; ++e) { x1[2 * e] = bflo(lo[e]); x1[2 * e + 1] = bfhi(lo[e]); x2[2 * e] = bflo(hi[e]); x2[2 * e + 1] = bfhi(hi[e]); }
#pragma unroll
            for (int e = 0; e < 8; ++e) ss += x1[e] * x1[e] + x2[e] * x2[e];
            ss += WS_DPP(ss, 0xB1, 0xF); ss += WS_DPP(ss, 0x4E, 0xF);
            const float rs = __builtin_amdgcn_rsqf(ss * (1.f / 64.f) + NORM_EPS);
            float o1[8], o2[8];
#pragma unroll
            for (int e = 0; e < 8; ++e) { const int i = 8 * j4 + e; const float inv = exp2f(-(float)i * (13.287712379549449f / 32.f)); float s, c; sincos_fast((float)l * inv, s, c);
                const float a = x1[e] * rs * kg[i], bq = x2[e] * rs * kg[i + 32]; o1[e] = a * c - bq * s; o2[e] = bq * c + a * s; }
            u32x4 w1, w2; w1.x = cvtpk(o1[0], o1[1]); w1.y = cvtpk(o1[2], o1[3]); w1.z = cvtpk(o1[4], o1[5]); w1.w = cvtpk(o1[6], o1[7]);
            w2.x = cvtpk(o2[0], o2[1]); w2.y = cvtpk(o2[2], o2[3]); w2.z = cvtpk(o2[4], o2[5]); w2.w = cvtpk(o2[6], o2[7]);
            if (l < 0) { w1 = (u32x4){0u, 0u, 0u, 0u}; w2 = w1; }
            *(LAS u32x4*)(Kn + jr * 144 + 16 * j4) = w1; *(LAS u32x4*)(Kn + jr * 144 + 64 + 16 * j4) = w2; }
        { u32x4 vr[4];
#pragma unroll
          for (int q = 0; q < 4; ++q) { const int it = F.tid + NTHR * q, jr = it >> 3, c = it & 7, l = q0 - 128 + jr;
              vr[q] = (l >= 0) ? *(const u32x4*)(P + ((size_t)b * SEQ + l) * NINP + C_V + kvh * 64 + 8 * c) : (u32x4){0u, 0u, 0u, 0u}; }
#pragma unroll
          for (int q = 0; q < 4; ++q) { const int it = F.tid + NTHR * q, jr = it >> 3, c = it & 7; *(LAS u32x4*)(VT + jr * 192 + c * 16) = vr[q]; } }
        __syncthreads();
        const int hd = F.wave >> 1, head = kvh * 4 + hd, qhalf = F.wave & 1; const float sink = F.in[IN_SINK][layer * 8 + head];
#pragma unroll 1
        for (int jt = 0; jt < 2; ++jt) {
            const int qt = q0 + 64 * qhalf + 32 * jt, qi = qt + r, t0 = 2 * qhalf + jt; const size_t row = (size_t)b * SEQ + qi;
            bf16x8 Qf[4];
            { float qv[4][8]; float ss = 0.f;
#pragma unroll
              for (int ks = 0; ks < 4; ++ks) { const u32x4 w = *(const u32x4*)(P + row * NINP + C_Q + head * 64 + 16 * ks + 8 * hh);
#pragma unroll
                  for (int e = 0; e < 4; ++e) { qv[ks][2 * e] = bflo(w[e]); qv[ks][2 * e + 1] = bfhi(w[e]); ss += qv[ks][2 * e] * qv[ks][2 * e] + qv[ks][2 * e + 1] * qv[ks][2 * e + 1]; } }
              ss += __shfl_xor(ss, 32);
              const float rs = __builtin_amdgcn_rsqf(ss * (1.f / 64.f) + NORM_EPS);
#pragma unroll
              for (int ks = 0; ks < 4; ++ks)
#pragma unroll
                  for (int e = 0; e < 8; ++e) qv[ks][e] *= rs * qg[16 * ks + 8 * hh + e];
#pragma unroll
              for (int ks = 0; ks < 2; ++ks)
#pragma unroll
                  for (int e = 0; e < 8; ++e) { const int i = 16 * ks + 8 * hh + e; const float inv = exp2f(-(float)i * (13.287712379549449f / 32.f)); float s, c; sincos_fast((float)qi * inv, s, c);
                      const float a = qv[ks][e], bq = qv[ks + 2][e]; qv[ks][e] = (a * c - bq * s) * 0.125f; qv[ks + 2][e] = (bq * c + a * s) * 0.125f; }
#pragma unroll
              for (int ks = 0; ks < 4; ++ks) { Qf[ks] = pack8v(qv[ks]); pin_frag(Qf[ks]); } }
            f32x16 acc[2];
#pragma unroll
            for (int dt = 0; dt < 2; ++dt)
#pragma unroll
                for (int i = 0; i < 16; ++i) acc[dt][i] = 0.f;
            float m = sink, lsum = 1.f;
#pragma unroll
            for (int tt = 0; tt < 5; ++tt) { const int t = t0 + tt;
                if (q0 == 0 && t < 4) continue;
                f32x16 X;
#pragma unroll
                for (int i = 0; i < 16; ++i) X[i] = 0.f;
#pragma unroll
                for (int ks = 0; ks < 4; ++ks) { const bf16x8 Kq = *(const LAS bf16x8*)(Kn + (32 * t + r) * 144 + (16 * ks + 8 * hh) * 2); X = MFMA32(Kq, Qf[ks], X); }
                settle_acc(X);
                if (tt == 0) {
#pragma unroll
                    for (int i = 0; i < 16; ++i) if (!(r < crow32(i, hh))) X[i] = -INFINITY; }
                if (tt == 4) {
#pragma unroll
                    for (int i = 0; i < 16; ++i) if (!(crow32(i, hh) <= r)) X[i] = -INFINITY; }
                float mx = X[0];
#pragma unroll
                for (int i = 1; i < 16; ++i) mx = fmaxf(mx, X[i]);
                mx = fmaxf(mx, __shfl_xor(mx, 32));
                const float mn = fmaxf(m, mx), al = __expf(m - mn); m = mn;
                float ps = 0.f;
#pragma unroll
                for (int i = 0; i < 16; ++i) { X[i] = __expf(X[i] - mn); ps += X[i]; }
                ps += __shfl_xor(ps, 32);
                lsum = lsum * al + ps;
                settle_acc(acc[0]); settle_acc(acc[1]);
#pragma unroll
                for (int dt = 0; dt < 2; ++dt)
#pragma unroll
                    for (int i = 0; i < 16; ++i) acc[dt][i] *= al;
#pragma unroll
                for (int kq = 0; kq < 2; ++kq) { const float v[8] = {X[8 * kq], X[8 * kq + 1], X[8 * kq + 2], X[8 * kq + 3], X[8 * kq + 4], X[8 * kq + 5], X[8 * kq + 6], X[8 * kq + 7]}; bf16x8 Pf = pack8v(v); pin_frag(Pf);
#pragma unroll
                    for (int dt = 0; dt < 2; ++dt) { const LAS unsigned char* vp = VT + (32 * t + 16 * kq + 4 * hh + ((lane & 15) >> 2)) * 192 + (32 * dt + 16 * ((lane >> 4) & 1) + 4 * (lane & 3)) * 2;
                        const v4i16_t va = __builtin_amdgcn_ds_read_tr16_b64_v4i16((LAS v4i16_t*)vp), vb = __builtin_amdgcn_ds_read_tr16_b64_v4i16((LAS v4i16_t*)(vp + 8 * 192));
                        bf16x8 Vf = {va[0], va[1], va[2], va[3], vb[0], vb[1], vb[2], vb[3]}; pin_frag(Vf);
                        acc[dt] = MFMA32(Vf, Pf, acc[dt]); } }
            }
            const float il = 1.f / lsum; settle_acc(acc[0]); settle_acc(acc[1]);
            LAS unsigned char* og = F.lds + 86016 + F.wave * 4608;
#pragma unroll
            for (int dt = 0; dt < 2; ++dt)
#pragma unroll
                for (int g4 = 0; g4 < 4; ++g4) { u32x2 o; o.x = cvtpk(acc[dt][4 * g4] * il, acc[dt][4 * g4 + 1] * il); o.y = cvtpk(acc[dt][4 * g4 + 2] * il, acc[dt][4 * g4 + 3] * il);
                    *(LAS u32x2*)(og + r * 144 + (32 * dt + 8 * g4 + 4 * hh) * 2) = o; }
#pragma unroll
            for (int q = 0; q < 4; ++q) { const int idx = lane + 64 * q, rr = idx >> 3, c8 = idx & 7;
                *(u32x4*)(YC + ((size_t)b * SEQ + qt + rr) * 2048 + 512 + head * 64 + c8 * 8) = *(const LAS u32x4*)(og + rr * 144 + c8 * 16); }
        }
    }
}

#ifndef MK_PER_PHASE
#define MK_PER_PHASE 0
#endif
constexpr int NPH = 13;
constexpr int TAB_OFF = 150 * 1024;
struct Args { const float* in[N_INPUTS]; float* out; unsigned char* ws; int gp_lo, gp_hi; };
static_assert(sizeof(Args) == (N_INPUTS + 2) * 8 + 8, "no padding in Args");

#ifndef PROBE_ID
#define PROBE_ID 0
#endif
#ifndef PROBE_N
#define PROBE_N 1
#endif
#define REP(id) for (int _r = 0; _r < ((id) == PROBE_ID ? 1 + PROBE_N : 1); ++_r)
extern __shared__ __attribute__((aligned(16))) unsigned char lds_raw[];
__device__ __forceinline__ LAS unsigned char* lds_raw_base() { return (LAS unsigned char*)lds_raw; }
#define LAUNDER() do { asm volatile("" : "+s"(F.in), "+s"(F.ws), "+s"(F.out), "+s"(F.ctl), "+s"(F.bid), "+s"(F.G)); asm volatile("" : "+v"(F.tid)); F.lane = F.tid & 63; F.wave = __builtin_amdgcn_readfirstlane(F.tid >> 6); } while (0)
template <int layer>
__device__ __forceinline__ void layer_body(Frame& F, const int lo, const int hi, const bool rerun) {
    volatile LAS int* offs = (volatile LAS int*)(F.lds + TAB_OFF); volatile LAS int* tile_e = offs + 64;
    XcdBarrier bar; bar.bar = F.ctl + CW_BAR; bar.x = xb_xcc_id(); bar.st = F.MISC;
#define GP(k) (layer * NPH + (k))
#ifdef ONLY_PH
#define IN(k) (((k) == ONLY_PH) && lo <= GP(k) && GP(k) < hi)
#else
#define IN(k) (lo <= GP(k) && GP(k) < hi)
#endif
#define WSB ((const char*)F.ws)
#ifdef DIAG_GP
#define STAMP0(k) do { if (GP(k) == DIAG_GP) { const unsigned t_ = (unsigned)__builtin_amdgcn_s_memrealtime(); if (threadIdx.x == 0) *(volatile LAS unsigned*)((LAS unsigned char*)lds_raw_base() + MISC_OFF + 32) = t_; } } while (0)
#define STAMP1(k) do { if (GP(k) == DIAG_GP) { const unsigned t_ = (unsigned)__builtin_amdgcn_s_memrealtime(); if (threadIdx.x == 0) *(volatile LAS unsigned*)((LAS unsigned char*)lds_raw_base() + MISC_OFF + 40) = t_; } } while (0)
#else
#define STAMP0(k)
#define STAMP1(k)
#endif
#define SEAM(k) do { if (!MK_PER_PHASE && IN(k) && GP(k) + 1 < hi) { xcd_barrier(bar); if (PROBE_ID == 19) { xcd_barrier(bar); xcd_barrier(bar); } } STAMP1(k); } while (0)
        if (IN(0) && layer == 0) { LAUNDER(); STAMP0(0);
            REP(1) { convert_weights(F, 0); __syncthreads(); } REP(2) s5_build(F, 0);
            REP(3) rmsnorm_rows(F, F.in[IN_X], F.in[IN_NORM1], (bf16_t*)(F.ws + WS_XN));
            SEAM(0);
        }
        if (IN(1)) { LAUNDER(); STAMP0(1);
            SchedDense<2048u, 2048u, T / 256, NINP / 256, 16> S{WSB + WS_XN, WSB + WS_WIN, F.G, F.bid};
            EpiProj E{F.ws, F.in[IN_BGATE] + layer * 3072};
            REP(4) pg8::gemm_phase<2048u, 2048u>(F.tid, F.lds, S, E);
            SEAM(1);
        }
        if (IN(2)) { LAUNDER(); STAMP0(2);
            SchedS5P1 S{WSB + WS_UH, WSB + WS_EG, F.G, F.bid};
            EpiHloc E{(float*)(F.ws + WS_HLOC)};
            REP(5) pg8::gemm_phase<(unsigned)(S5_K * 2), 1024u>(F.tid, F.lds, S, E);
            REP(6) ssdA_mfma(F, layer);
            REP(8) attn_mfma(F, layer);
            SEAM(2);
        }
        if (IN(3)) { LAUNDER(); STAMP0(3);
            REP(7) s5_scan(F, layer);
            if (!rerun) ssd_scan(F);
            SEAM(3);
        }
        if (IN(4)) { LAUNDER(); STAMP0(4);
            SchedS5Main S{WSB + WS_UH, WSB + WS_MG, F.G, F.bid};
            EpiS5Y E{(bf16_t*)(F.ws + WS_XN)};
            REP(9) pg8::gemm_phase<(unsigned)(S5_K * 2), (unsigned)(S5_K * 2)>(F.tid, F.lds, S, E);
            REP(10) ssdC_mfma(F, layer);
            SEAM(4);
        }
        if (IN(5)) { LAUNDER(); STAMP0(5);
            SchedDense<1024u, 1024u, T / 256, 4, 8> S{WSB + WS_XN, WSB + WS_WGLU, F.G, F.bid};
            EpiGlu E{(bf16_t*)(F.ws + WS_YCAT)};
            REP(11) pg8::gemm_phase<1024u, 1024u>(F.tid, F.lds, S, E);
            SEAM(5);
        }
        if (IN(6)) { LAUNDER(); STAMP0(6);
            SchedDense<4096u, 4096u, T / 256, 4, 32> S{WSB + WS_YCAT, WSB + WS_PCAT, F.G, F.bid};
            EpiMerged E{F.ws};
            REP(12) pg8::gemm_phase<4096u, 4096u>(F.tid, F.lds, S, E);
            SEAM(6);
        }
        if (IN(7)) { LAUNDER(); STAMP0(7);
            SchedDense<2048u, 2048u, T / 256, 4, 16> S{WSB + WS_XN, WSB + WS_WOUT, F.G, F.bid};
            EpiResid E{layer == 0 ? F.in[IN_X] : (const float*)F.out, F.out};
            REP(layer == 0 ? 13 : -1) pg8::gemm_phase<2048u, 2048u>(F.tid, F.lds, S, E);
            SEAM(7);
        }
        if (IN(8)) { LAUNDER(); STAMP0(8); REP(17) router_phase(F, layer); SEAM(8); }
        if (IN(9)) { LAUNDER(); STAMP0(9); (void)moe_tables(F, layer, offs, tile_e); REP(14) gather_phase(F, layer, offs); SEAM(9); }
        if (IN(10)) { LAUNDER(); STAMP0(10);
            const int ntiles = moe_tables(F, layer, offs, tile_e);
            SchedMoe<2048u, (size_t)1024 * 1024 * 2, (size_t)256 * 2048, 16> S{WSB + WS_XG, WSB + WS_EGU, ntiles, F.G, F.bid, tile_e};
            EpiSwiGlu E{(bf16_t*)(F.ws + WS_HID), (const float*)(F.ws + WS_MOE + 704 * 1024)};
            REP(15) pg8::gemm_phase<2048u, 2048u>(F.tid, F.lds, S, E);
            SEAM(10);
        }
        if (IN(11)) { LAUNDER(); STAMP0(11);
            const int ntiles = moe_tables(F, layer, offs, tile_e);
            SchedMoe<1024u, (size_t)1024 * 512 * 2, (size_t)256 * 1024, 8> S{WSB + WS_HID, WSB + WS_EDN, ntiles, F.G, F.bid, tile_e};
            EpiPlainBf16 E{(bf16_t*)(F.ws + WS_YEXP)};
            REP(16) pg8::gemm_phase<1024u, 1024u>(F.tid, F.lds, S, E);
            SEAM(11);
        }
        if (IN(12)) { LAUNDER(); STAMP0(12);
            if (PROBE_ID == 18) combine_phase(F, F.in[IN_NORM1], true);
            combine_phase(F, layer + 1 < DEPTH ? F.in[IN_NORM1] + (layer + 1) * 1024 : nullptr);
            if (layer + 1 < DEPTH) { __syncthreads(); convert_weights(F, layer + 1); __syncthreads(); s5_build(F, layer + 1); }
            SEAM(12);
        }
#undef GP
#undef IN
#undef SEAM
#undef WSB
}
__global__ void __launch_bounds__(NTHR, 2) fwd(Args args) {
    Frame F;
    F.lds = (LAS unsigned char*)lds_raw;
    F.MISC = (volatile LAS unsigned*)(F.lds + MISC_OFF);
    F.tid = threadIdx.x; F.lane = F.tid & 63; F.wave = __builtin_amdgcn_readfirstlane(F.tid >> 6);
    F.G = gridDim.x; F.bid = blockIdx.x;
    const __attribute__((address_space(4))) char* ka = (const __attribute__((address_space(4))) char*)__builtin_amdgcn_kernarg_segment_ptr();
    F.in = (const float* const __attribute__((address_space(4)))*)ka;
    F.out = *(float* const __attribute__((address_space(4)))*)(ka + N_INPUTS * 8); F.ws = *(unsigned char* const __attribute__((address_space(4)))*)(ka + N_INPUTS * 8 + 8); F.ctl = (unsigned*)(F.ws + WS_CTL);
    if (F.tid < 64) F.MISC[F.tid] = 0u;
    __syncthreads();
    XcdBarrier bar; bar.bar = F.ctl + CW_BAR; bar.x = 0; bar.st = nullptr;
    if (!MK_PER_PHASE) bar = xcd_barrier_post(F.ctl + CW_BAR, F.MISC);
    const int lo = *(const __attribute__((address_space(4))) int*)(ka + N_INPUTS * 8 + 16), hi_raw = *(const __attribute__((address_space(4))) int*)(ka + N_INPUTS * 8 + 20), hi = hi_raw & 0xffff;

    layer_body<0>(F, lo, hi, (hi_raw >> 16) != 0);
    layer_body<1>(F, lo, hi, (hi_raw >> 16) != 0);
#ifdef DIAG_GP
    __syncthreads();
    if (blockIdx.x == 0 && threadIdx.x == 0) { const unsigned t0 = *(volatile LAS unsigned*)((LAS unsigned char*)lds_raw_base() + MISC_OFF + 32), t1 = *(volatile LAS unsigned*)((LAS unsigned char*)lds_raw_base() + MISC_OFF + 40); float* o_ = *(float* const __attribute__((address_space(4)))*)((const __attribute__((address_space(4))) char*)__builtin_amdgcn_kernarg_segment_ptr() + N_INPUTS * 8); asm volatile("s_waitcnt vmcnt(0)" ::: "memory"); o_[0] = (float)(t1 - t0); }
#endif
}

extern "C" void kernel_launch(void* const* d_in, const int* in_sizes, int n_in, void* d_out, int out_size, void* d_ws, size_t ws_size, hipStream_t stream) {
    static int grid = 0;
    if (grid == 0) {
        if (n_in != N_INPUTS || out_size != T * DM || ws_size < WS_END) { fprintf(stderr, "kernel_launch: unexpected shapes (n_in %d out %d ws %zu need %zu)\n", n_in, out_size, ws_size, (size_t)WS_END); grid = -1; return; }
        int dev = 0, cus = 0, per_cu = 0;
        if (hipGetDevice(&dev) != hipSuccess || hipDeviceGetAttribute(&cus, hipDeviceAttributeMultiprocessorCount, dev) != hipSuccess) { grid = -1; return; }
        if (hipFuncSetAttribute((const void*)fwd, hipFuncAttributeMaxDynamicSharedMemorySize, LDS_BYTES) != hipSuccess) { fprintf(stderr, "kernel_launch: hipFuncSetAttribute failed\n"); grid = -1; return; }
        if (hipOccupancyMaxActiveBlocksPerMultiprocessor(&per_cu, (const void*)fwd, NTHR, LDS_BYTES) != hipSuccess || per_cu < 1) fprintf(stderr, "kernel_launch: occupancy query reports %d\n", per_cu);
        (void)hipGetLastError();
        grid = cus;
    }
    if (grid < 0) return;
    (void)hipMemsetAsync((char*)d_ws + WS_CTL, 0, CTL_ZERO_BYTES, stream);
    Args a{};
    for (int i = 0; i < N_INPUTS; ++i) a.in[i] = (const float*)d_in[i];
    a.out = (float*)d_out; a.ws = (unsigned char*)d_ws;
#if MK_PER_PHASE
    for (int gp = 0; gp < DEPTH * NPH; ++gp) {
        if (gp == NPH) continue;
        a.gp_lo = gp; a.gp_hi = gp + 1;
        int nrep = 1;
#ifdef PP_REP_GP
        if (gp == PP_REP_GP) nrep = 1 + PP_REP_N;
#endif
        for (int rr = 0; rr < nrep; ++rr) { a.gp_hi = (gp + 1) | (rr > 0 ? 0x10000 : 0); hipLaunchKernelGGL(fwd, dim3(grid), dim3(NTHR), LDS_BYTES, stream, a); }
    }
#else
    a.gp_lo = 0; a.gp_hi = DEPTH * NPH;
    hipLaunchKernelGGL(fwd, dim3(grid), dim3(NTHR), LDS_BYTES, stream, a);
#endif
}
```
